# Optimizing an MI355X kernel written in HIP

```python
import math
import jax, jax.numpy as jnp
from jax import lax
import numpy as np

D_MODEL = 1024
BATCH = 1
SEQ = 16384
DEPTH = 2

N_EVEN = (DEPTH + 1) // 2
N_ODD = DEPTH // 2

LRU_WIDTH = 512
LRU_BLOCKS = 8
LRU_BLOCK = LRU_WIDTH // LRU_BLOCKS
LRU_CONV = 4
LRU_C = 8.0

MLA_HEADS = 8
Q_LORA = 256
KV_LORA = 128
QK_NOPE = 64
QK_ROPE = 32
V_HEAD = 64
ROPE_THETA = 10000.0
Q_BLOCK = 128

EVEN_IN = 2 * LRU_WIDTH + Q_LORA + KV_LORA + QK_ROPE
EVEN_MIX = LRU_WIDTH + MLA_HEADS * V_HEAD

M_HEADS = 4
M_QK = 128
M_V = 256
M_CHUNK = 64
GATE_CAP = 15.0
ODD_IN = 2 * M_HEADS * M_QK + 2 * M_HEADS * M_V + 2 * M_HEADS
ODD_MIX = M_HEADS * M_V

D_FF = 2816
FFN_CONV = 3
EPS = 1e-6

kernel_name = "hybrid_rglru_mla_mlstm_convffn"


def rms_norm(x, g):
    xf = x.astype(jnp.float32)
    y = xf * lax.rsqrt(jnp.mean(xf * xf, axis=-1, keepdims=True) + EPS)
    return (y * g.astype(jnp.float32)).astype(x.dtype)


def causal_dwconv(x, w, b):
    k = w.shape[0]
    s = x.shape[1]
    xp = jnp.pad(x, ((0, 0), (k - 1, 0), (0, 0)))
    y = b
    for j in range(k):
        y = y + xp[:, j:j + s] * w[j]
    return y


def rope_cos_sin(positions):
    half = QK_ROPE // 2
    inv_freq = ROPE_THETA ** (-jnp.arange(half, dtype=jnp.float32) / half)
    ang = positions.astype(jnp.float32)[..., None] * inv_freq
    return jnp.cos(ang), jnp.sin(ang)


def apply_rope(x, cos, sin):
    x1, x2 = jnp.split(x.astype(jnp.float32), 2, axis=-1)
    return jnp.concatenate([x1 * cos - x2 * sin, x2 * cos + x1 * sin], axis=-1).astype(x.dtype)


def rg_lru(xr, gate, conv_w, conv_b, w_a, b_a, w_x, b_x, lam):
    bsz, s, _ = xr.shape
    xc = causal_dwconv(xr, conv_w, conv_b).astype(jnp.float32)
    xb = xc.reshape(bsz, s, LRU_BLOCKS, LRU_BLOCK)
    r = jax.nn.sigmoid(jnp.einsum("bsgi,gij->bsgj", xb, w_a.astype(jnp.float32)) + b_a).reshape(bsz, s, LRU_WIDTH)
    i = jax.nn.sigmoid(jnp.einsum("bsgi,gij->bsgj", xb, w_x.astype(jnp.float32)) + b_x).reshape(bsz, s, LRU_WIDTH)
    log_a = -LRU_C * r * jax.nn.softplus(-lam.astype(jnp.float32))
    a = jnp.exp(log_a)
    u = jnp.sqrt(-jnp.expm1(2.0 * log_a)) * (i * xc)

    def combine(left, right):
        a1, b1 = left
        a2, b2 = right
        return a1 * a2, a2 * b1 + b2

    _, h = lax.associative_scan(combine, (a, u), axis=1)
    return (h * jax.nn.gelu(gate.astype(jnp.float32))).astype(xr.dtype)


def causal_attention(q, k, v):
    bsz, s, h, dq = q.shape
    nb = s // Q_BLOCK
    qb = jnp.moveaxis(q.reshape(bsz, nb, Q_BLOCK, h, dq), 1, 0)
    key_idx = jnp.arange(s)
    neg = jnp.finfo(jnp.float32).min

    def one_block(args):
        blk, qi = args
        sc = jnp.einsum("bqhd,bkhd->bhqk", qi, k).astype(jnp.float32)
        q_idx = blk * Q_BLOCK + jnp.arange(Q_BLOCK)
        sc = jnp.where(key_idx[None, :] <= q_idx[:, None], sc, neg)
        p = jax.nn.softmax(sc, axis=-1).astype(v.dtype)
        return jnp.einsum("bhqk,bkhd->bqhd", p, v)

    out = lax.map(one_block, (jnp.arange(nb), qb))
    return jnp.moveaxis(out, 0, 1).reshape(bsz, s, h, v.shape[-1])


def mla(q_lat, kv_lat, k_rope, positions, q_norm_g, w_qb, kv_norm_g, w_kvb):
    bsz, s, _ = q_lat.shape
    q = (rms_norm(q_lat, q_norm_g) @ w_qb).reshape(bsz, s, MLA_HEADS, QK_NOPE + QK_ROPE)
    kv = (rms_norm(kv_lat, kv_norm_g) @ w_kvb).reshape(bsz, s, MLA_HEADS, QK_NOPE + V_HEAD)
    k_nope, v = kv[..., :QK_NOPE], kv[..., QK_NOPE:]
    cos, sin = rope_cos_sin(positions)
    q_pe = apply_rope(q[..., QK_NOPE:], cos[:, :, None, :], sin[:, :, None, :])
    k_pe = apply_rope(k_rope, cos, sin)
    scale = (QK_NOPE + QK_ROPE) ** -0.5
    q_full = jnp.concatenate([q[..., :QK_NOPE], q_pe], axis=-1) * scale
    k_full = jnp.concatenate([k_nope, jnp.broadcast_to(k_pe[:, :, None, :], (bsz, s, MLA_HEADS, QK_ROPE))], axis=-1)
    out = causal_attention(q_full, k_full, v)
    return out.reshape(bsz, s, MLA_HEADS * V_HEAD)


def even_mixer(h, positions, w_in, lru_conv_w, lru_conv_b, lru_w_a, lru_b_a, lru_w_x, lru_b_x, lru_lambda,
               q_norm_g, w_qb, kv_norm_g, w_kvb, w_out):
    z = h @ w_in
    c1 = LRU_WIDTH
    c2 = 2 * LRU_WIDTH
    c3 = c2 + Q_LORA
    c4 = c3 + KV_LORA
    xr, gate, q_lat, kv_lat, k_rope = jnp.split(z, [c1, c2, c3, c4], axis=-1)
    y_lru = rg_lru(xr, gate, lru_conv_w, lru_conv_b, lru_w_a, lru_b_a, lru_w_x, lru_b_x, lru_lambda)
    y_mla = mla(q_lat, kv_lat, k_rope, positions, q_norm_g, w_qb, kv_norm_g, w_kvb)
    return jnp.concatenate([y_lru, y_mla.astype(y_lru.dtype)], axis=-1) @ w_out


def chunk_view(t, nc):
    bsz, s, h = t.shape[:3]
    t = t.reshape(bsz, nc, M_CHUNK, h, *t.shape[3:])
    return jnp.moveaxis(t, (1, 3), (0, 2))


def mlstm(q, k, v, i_pre, f_pre):
    bsz, s, h, dk = q.shape
    dv = v.shape[-1]
    nc = s // M_CHUNK
    q = q * dk ** -0.5
    log_f = jax.nn.log_sigmoid(f_pre)
    causal = jnp.tril(jnp.ones((M_CHUNK, M_CHUNK), dtype=bool))

    def step(carry, inp):
        c_st, n_st, m_st = carry
        qc, kc, vc, ic, fc = inp
        b = jnp.cumsum(fc, axis=-1)
        d = jnp.where(causal, b[..., :, None] - b[..., None, :] + ic[..., None, :], -jnp.inf)
        inter = b + m_st[..., None]
        m_t = jnp.maximum(inter, jnp.max(d, axis=-1))
        w = jnp.exp(d - m_t[..., None])
        g = jnp.exp(inter - m_t)
        sc = jnp.einsum("bhtd,bhsd->bhts", qc, kc) * w
        num = g[..., None] * jnp.einsum("bhtd,bhde->bhte", qc, c_st) + jnp.einsum("bhts,bhse->bhte", sc, vc)
        den = g * jnp.einsum("bhtd,bhd->bht", qc, n_st) + jnp.sum(sc, axis=-1)
        h_out = num / jnp.maximum(jnp.abs(den), jnp.exp(-m_t))[..., None]
        b_last = b[..., -1]
        w_end = b_last[..., None] - b + ic
        m_new = jnp.maximum(b_last + m_st, jnp.max(w_end, axis=-1))
        g_end = jnp.exp(b_last + m_st - m_new)
        w_s = jnp.exp(w_end - m_new[..., None])
        c_new = g_end[..., None, None] * c_st + jnp.einsum("bhs,bhsd,bhse->bhde", w_s, kc, vc)
        n_new = g_end[..., None] * n_st + jnp.einsum("bhs,bhsd->bhd", w_s, kc)
        return (c_new, n_new, m_new), h_out

    init = (jnp.zeros((bsz, h, dk, dv), jnp.float32), jnp.zeros((bsz, h, dk), jnp.float32),
            jnp.zeros((bsz, h), jnp.float32))
    xs = (chunk_view(q, nc), chunk_view(k, nc), chunk_view(v, nc), chunk_view(i_pre, nc), chunk_view(log_f, nc))
    _, hs = lax.scan(step, init, xs)
    return jnp.moveaxis(hs, (0, 2), (1, 3)).reshape(bsz, s, h, dv)


def soft_cap(t):
    return GATE_CAP * jnp.tanh(t / GATE_CAP)


def odd_mixer(h, w_in, b_igate, b_fgate, out_norm_g, w_out):
    bsz, s, _ = h.shape
    z = (h @ w_in).astype(jnp.float32)
    c1 = M_HEADS * M_QK
    c2 = 2 * c1
    c3 = c2 + M_HEADS * M_V
    c4 = c3 + M_HEADS * M_V
    c5 = c4 + M_HEADS
    q, k, v, o, ig, fg = jnp.split(z, [c1, c2, c3, c4, c5], axis=-1)
    ig = soft_cap(ig + b_igate.astype(jnp.float32))
    fg = soft_cap(fg + b_fgate.astype(jnp.float32))
    hh = mlstm(q.reshape(bsz, s, M_HEADS, M_QK), k.reshape(bsz, s, M_HEADS, M_QK),
               v.reshape(bsz, s, M_HEADS, M_V), ig, fg)
    hh = hh * lax.rsqrt(jnp.mean(hh * hh, axis=-1, keepdims=True) + EPS)
    y = hh.reshape(bsz, s, ODD_MIX) * out_norm_g.astype(jnp.float32) * jax.nn.sigmoid(o)
    return y.astype(h.dtype) @ w_out


def conv_ffn(h, w_up, conv_w, conv_b, w_down):
    u = causal_dwconv(h @ w_up, conv_w, conv_b)
    g, val = jnp.split(u, 2, axis=-1)
    return (jax.nn.silu(g) * val) @ w_down


def setup_inputs(seed: int = 0) -> dict:
    key = jax.random.key(seed)
    ks = iter(jax.random.split(key, 40))

    def w(shape, fan_in):
        return jax.random.normal(next(ks), shape, jnp.float32) * fan_in ** -0.5

    def gain(shape):
        return 1.0 + 0.05 * jax.random.normal(next(ks), shape, jnp.float32)

    def bias(shape, scale=0.02):
        return scale * jax.random.normal(next(ks), shape, jnp.float32)

    x = jax.random.normal(next(ks), (BATCH, SEQ, D_MODEL), jnp.float32)
    positions = jnp.broadcast_to(jnp.arange(SEQ, dtype=jnp.int32)[None, :], (BATCH, SEQ))
    a_init = jax.random.uniform(next(ks), (N_EVEN, LRU_WIDTH), jnp.float32, minval=0.9, maxval=0.999)
    lru_lambda = jnp.log(a_init) - jnp.log1p(-a_init)
    return {
        "x": x,
        "positions": positions,
        "e_norm_g": gain((N_EVEN, D_MODEL)),
        "e_w_in": w((N_EVEN, D_MODEL, EVEN_IN), D_MODEL),
        "e_lru_conv_w": w((N_EVEN, LRU_CONV, LRU_WIDTH), LRU_CONV),
        "e_lru_conv_b": bias((N_EVEN, LRU_WIDTH)),
        "e_lru_w_a": w((N_EVEN, LRU_BLOCKS, LRU_BLOCK, LRU_BLOCK), LRU_BLOCK),
        "e_lru_b_a": bias((N_EVEN, LRU_BLOCKS, LRU_BLOCK)),
        "e_lru_w_x": w((N_EVEN, LRU_BLOCKS, LRU_BLOCK, LRU_BLOCK), LRU_BLOCK),
        "e_lru_b_x": bias((N_EVEN, LRU_BLOCKS, LRU_BLOCK)),
        "e_lru_lambda": lru_lambda,
        "e_q_norm_g": gain((N_EVEN, Q_LORA)),
        "e_w_qb": w((N_EVEN, Q_LORA, MLA_HEADS * (QK_NOPE + QK_ROPE)), Q_LORA),
        "e_kv_norm_g": gain((N_EVEN, KV_LORA)),
        "e_w_kvb": w((N_EVEN, KV_LORA, MLA_HEADS * (QK_NOPE + V_HEAD)), KV_LORA),
        "e_w_out": w((N_EVEN, EVEN_MIX, D_MODEL), EVEN_MIX),
        "o_norm_g": gain((N_ODD, D_MODEL)),
        "o_w_in": w((N_ODD, D_MODEL, ODD_IN), D_MODEL),
        "o_b_igate": bias((N_ODD, M_HEADS), 0.1),
        "o_b_fgate": 3.0 + 3.0 * jax.random.uniform(next(ks), (N_ODD, M_HEADS), jnp.float32),
        "o_out_norm_g": gain((N_ODD, ODD_MIX)),
        "o_w_out": w((N_ODD, ODD_MIX, D_MODEL), ODD_MIX),
        "f_norm_g": gain((DEPTH, D_MODEL)),
        "f_w_up": w((DEPTH, D_MODEL, 2 * D_FF), D_MODEL),
        "f_conv_w": w((DEPTH, FFN_CONV, 2 * D_FF), FFN_CONV),
        "f_conv_b": bias((DEPTH, 2 * D_FF)),
        "f_w_down": w((DEPTH, D_FF, D_MODEL), D_FF),
        "final_norm_g": gain((D_MODEL,)),
    }


def reference(x, positions, e_norm_g, e_w_in, e_lru_conv_w, e_lru_conv_b, e_lru_w_a, e_lru_b_a, e_lru_w_x,
              e_lru_b_x, e_lru_lambda, e_q_norm_g, e_w_qb, e_kv_norm_g, e_w_kvb, e_w_out, o_norm_g, o_w_in,
              o_b_igate, o_b_fgate, o_out_norm_g, o_w_out, f_norm_g, f_w_up, f_conv_w, f_conv_b, f_w_down,
              final_norm_g):
    h = x
    for layer in range(DEPTH):
        j = layer // 2
        if layer % 2 == 0:
            h = h + even_mixer(rms_norm(h, e_norm_g[j]), positions, e_w_in[j], e_lru_conv_w[j], e_lru_conv_b[j],
                               e_lru_w_a[j], e_lru_b_a[j], e_lru_w_x[j], e_lru_b_x[j], e_lru_lambda[j],
                               e_q_norm_g[j], e_w_qb[j], e_kv_norm_g[j], e_w_kvb[j], e_w_out[j])
        else:
            h = h + odd_mixer(rms_norm(h, o_norm_g[j]), o_w_in[j], o_b_igate[j], o_b_fgate[j],
                              o_out_norm_g[j], o_w_out[j])
        h = h + conv_ffn(rms_norm(h, f_norm_g[layer]), f_w_up[layer], f_conv_w[layer], f_conv_b[layer],
                         f_w_down[layer])
    return rms_norm(h, final_norm_g)
```

```cpp
#include <hip/hip_runtime.h>
#include <hip/hip_cooperative_groups.h>
#include <cstdio>
#include <cstdint>
namespace cg = cooperative_groups;

typedef unsigned short bf16_t;
typedef short bf16x8 __attribute__((ext_vector_type(8)));
typedef short s16x4 __attribute__((ext_vector_type(4)));
typedef float f32x2 __attribute__((ext_vector_type(2)));
typedef float f32x4 __attribute__((ext_vector_type(4)));
typedef float f32x16 __attribute__((ext_vector_type(16)));
typedef unsigned u32x2 __attribute__((ext_vector_type(2)));
typedef unsigned u32x4 __attribute__((ext_vector_type(4)));
typedef __bf16 bf16x2_t __attribute__((ext_vector_type(2)));
#define LAS __attribute__((address_space(3)))
#define DI __device__ __forceinline__

constexpr int S = 16384;
constexpr float EPS = 1e-6f;
constexpr float LOG2E = 1.4426950408889634f;

constexpr size_t O_W1T = 0;
constexpr size_t O_WQT = O_W1T + (size_t)1536 * 1024 * 2;
constexpr size_t O_WKT = O_WQT + (size_t)768 * 256 * 2;
constexpr size_t O_WVT = O_WKT + (size_t)512 * 256 * 2;
constexpr size_t O_WRIT = O_WVT + (size_t)512 * 256 * 2;
constexpr size_t O_WO1T = O_WRIT + (size_t)1024 * 512 * 2;
constexpr size_t O_WUPT = O_WO1T + (size_t)1024 * 1024 * 2;
constexpr size_t SZ_WUPT = (size_t)5632 * 1024 * 2;
constexpr size_t O_WDNT = O_WUPT + 2 * SZ_WUPT;
constexpr size_t SZ_WDNT = (size_t)1024 * 2816 * 2;
constexpr size_t O_WOINT = O_WDNT + 2 * SZ_WDNT;
constexpr size_t O_WO2T = O_WOINT + (size_t)3072 * 1024 * 2;
constexpr size_t O_ROWSS = O_WO2T + (size_t)1024 * 1024 * 2;
constexpr size_t O_RSQ = O_ROWSS + (size_t)5 * S * 4;
constexpr size_t O_RSKV = O_RSQ + (size_t)S * 4;
constexpr size_t O_CSTAB = O_RSKV + (size_t)S * 4;
constexpr size_t O_CHA = O_CSTAB + (size_t)S * 32 * 4;
constexpr size_t O_CHH = O_CHA + (size_t)256 * 512 * 4;
constexpr size_t O_GB = O_CHH + (size_t)256 * 512 * 4;
constexpr size_t O_GE = O_GB + (size_t)4 * S * 4;
constexpr size_t O_GPM = O_GE + (size_t)4 * S * 4;
constexpr size_t O_BL = O_GPM + (size_t)4 * S * 4;
constexpr size_t O_ML = O_BL + 4096;
constexpr size_t O_MST = O_ML + 4096;
constexpr size_t O_NST = O_MST + 4096;
constexpr size_t O_BAR = O_NST + (size_t)256 * 4 * 128 * 4;
constexpr size_t BAR_BYTES = 16384;
constexpr size_t O_XB = O_BAR + BAR_BYTES;
constexpr size_t XB_ROWS = 16648;
constexpr size_t O_ARENA = O_XB + XB_ROWS * 2048;
constexpr size_t O_Z = O_ARENA;
constexpr size_t O_XC = O_Z + (size_t)S * 1536 * 2;
constexpr size_t O_QB = O_XC + (size_t)S * 512 * 2;
constexpr size_t O_KB = O_QB + (size_t)8 * S * 96 * 2;
constexpr size_t O_VT = O_KB + (size_t)8 * S * 96 * 2;
constexpr size_t O_MIX = O_VT + (size_t)512 * S * 2;
constexpr size_t O_END0 = O_MIX + (size_t)S * 1024 * 2;
constexpr size_t O_ACT = O_ARENA;
constexpr size_t O_RI = O_XB;
constexpr size_t O_CST = O_XB;
constexpr size_t O_QOK = O_CST + (size_t)256 * 4 * 256 * 128 * 2;
constexpr size_t O_KVT = O_QOK + (size_t)S * 2048 * 2;
constexpr size_t O_END1 = O_KVT + (size_t)1536 * S * 2;
constexpr size_t WS_NEED = (O_END0 > O_END1 ? O_END0 : O_END1);
static_assert(WS_NEED <= (size_t)268435456, "workspace");
static_assert(O_QOK >= O_ARENA, "QOK must not overlap XB");
static_assert(O_ACT + (size_t)(S + 240) * 2816 * 2 <= (size_t)268435456, "act");

constexpr int LDS_BYTES = 147456;

struct Args {
    const float* in[28];
    float* out;
    unsigned char* ws;
    int pad; int pad2;
};

struct ArgP { const __attribute__((address_space(4))) Args* p;
    DI const float* in(int i) const { return p->in[i]; } DI float* out() const { return p->out; } DI unsigned char* ws() const { return p->ws; } };
DI unsigned pk2(float lo, float hi) { f32x2 v = {lo, hi}; bf16x2_t b = __builtin_convertvector(v, bf16x2_t); return __builtin_bit_cast(unsigned, b); }
DI bf16_t f2bf(float f) { return (bf16_t)(pk2(f, 0.f) & 0xffffu); }
DI int ltid(int wv) { asm volatile("" : "+s"(wv)); int l = __builtin_amdgcn_mbcnt_hi(~0u, __builtin_amdgcn_mbcnt_lo(~0u, 0u)); return wv * 64 + l; }
DI int lbid() { int t = blockIdx.x; asm volatile("" : "+s"(t)); return t; }
DI float bf2f(bf16_t b) { return __uint_as_float(((unsigned)b) << 16); }
DI float bflo(unsigned u) { return __uint_as_float(u << 16); }
DI float bfhi(unsigned u) { return __uint_as_float(u & 0xffff0000u); }
DI float wave_sum(float v) {
#pragma unroll
    for (int o = 1; o < 64; o <<= 1) v += __shfl_xor(v, o);
    return v;
}
DI float fexp(float x) { return __builtin_amdgcn_exp2f(x * LOG2E); }
DI float sigmoidf_(float x) { return __builtin_amdgcn_rcpf(1.f + fexp(-x)); }
DI int crow(int r, int hi) { return (r & 3) + 8 * (r >> 2) + 4 * hi; }
DI float rs_from_ss(float ss) { return rsqrtf(ss * (1.f / 1024.f) + EPS); }

namespace pg8 {
constexpr int BM = 256, BK = 64, HALF = 128, HTB = HALF * BK * 2, STAGE_BYTES = 8 * HTB, NXCD = 8, WGM = 8;
DI int lds_byte(int r, int c) { const int st = (r >> 4) * 2 + (c >> 5), rr = r & 15, cc = c & 31, ob = rr * 64 + cc * 2; return st * 1024 + (ob ^ (((ob >> 9) & 1) << 5)); }
DI void stage_rc(int b, int& R, int& C) { const int st = b / 1024, sb = b % 1024, swz = sb ^ (((sb >> 9) & 1) << 5); R = (st >> 1) * 16 + swz / 64; C = (st & 1) * 32 + (swz % 64) / 2; }
DI int perm32(int rho) { const int n = rho >> 4, i = rho & 15; return 8 * (i >> 2) + 4 * n + (i & 3); }
struct Unit { int pm, pn; };
struct StaticOrder {
    int nM, nN, nwg, G, c;
    DI void init(int nM_, int nN_, int G_, int c_) { nM = nM_; nN = nN_; nwg = nM * nN; G = G_; c = c_; }
    DI bool next(int i, Unit& u) const {
        const long L = (long)i * G + c; if (L >= nwg) return false;
        int wgid = (int)L; { const int q = nwg / NXCD, r = nwg % NXCD, xcd = wgid % NXCD, off = wgid / NXCD; wgid = (xcd < r ? xcd * (q + 1) : r * (q + 1) + (xcd - r) * q) + off; }
        const int nig = WGM * nN, gid = wgid / nig, fm = gid * WGM, gsz = (nM - fm) < WGM ? (nM - fm) : WGM;
        u.pm = fm + ((wgid % nig) % gsz); u.pn = (wgid % nig) / gsz; return true;
    }
};

template <bool AMAP, class Epi>
DI void gemm_phase(int wv, LAS unsigned char* lds, const bf16_t* A, int lda, const bf16_t* Bt, int ldb, int K_, int nM, int nN, const Epi& E) {
    int K = K_; asm volatile("" : "+s"(K));
    const int tid = ltid(wv), wid = __builtin_amdgcn_readfirstlane(tid >> 6), lane = tid & 63, wr = wid >> 2, wc = wid & 3, fr = lane & 15, fq = lane >> 4;
    const int nt = K / BK;
    StaticOrder SO; SO.init(nM, nN, (int)gridDim.x, lbid());
    int voffA[2], voffB[2];
#pragma unroll
    for (int i = 0; i < 2; ++i) { int R, C; stage_rc(tid * 16 + i * 8192, R, C); const int Rb = (R & ~31) + perm32(R & 31);
        const int Ra = AMAP ? (62 * (R >> 6) + (R & 63) - 2) : R;
        voffA[i] = (Ra * lda + C) * 2; voffB[i] = (Rb * ldb + C) * 2; }
    const size_t kstep = (size_t)(BK * 2);
    const size_t hstepA = (size_t)(AMAP ? 124 : 128) * lda * 2, hstepB = (size_t)HALF * ldb * 2;
    const size_t tstepA = 2 * hstepA, tstepB = 2 * hstepB;
    const unsigned ldsw = (unsigned)wid * 1024u;
    const int aoff = lds_byte(wr * 64 + fr, fq * 8), boff = lds_byte(wc * 32 + fr, fq * 8);
#define PG8_SA(b, h) (((b) * 2 + (h)) * HTB)
#define PG8_SB(b, h) ((4 + (b) * 2 + (h)) * HTB)
#define PG8_STAGE(bufoff, gbase, voff) do { _Pragma("unroll") for (int _i = 0; _i < 2; ++_i) \
        __builtin_amdgcn_global_load_lds((const unsigned*)((const char*)(gbase) + (long)(voff)[_i]), (LAS unsigned*)(lds + (bufoff) + ldsw + _i * 8192), 16, 0, 0); } while (0)
#define PG8_LDA(dst, b, h) do { _Pragma("unroll") for (int m = 0; m < 4; ++m) _Pragma("unroll") for (int k = 0; k < 2; ++k) dst[m][k] = *(const LAS bf16x8*)(lds + PG8_SA(b, h) + aoff + m * 2048 + k * 1024); } while (0)
#define PG8_LDB(dst, b, h) do { _Pragma("unroll") for (int n = 0; n < 2; ++n) _Pragma("unroll") for (int k = 0; k < 2; ++k) dst[n][k] = *(const LAS bf16x8*)(lds + PG8_SB(b, h) + boff + n * 2048 + k * 1024); } while (0)
#define PG8_MMA(ai, bj, At, Bt_) do { __builtin_amdgcn_s_setprio(1); _Pragma("unroll") for (int m = 0; m < 4; ++m) _Pragma("unroll") for (int n = 0; n < 2; ++n) _Pragma("unroll") for (int k = 0; k < 2; ++k) \
        acc[ai][bj][m][n] = __builtin_amdgcn_mfma_f32_16x16x32_bf16(Bt_[n][k], At[m][k], acc[ai][bj][m][n], 0, 0, 0); __builtin_amdgcn_s_setprio(0); } while (0)
#define PG8_WAIT_V(n) asm volatile("s_waitcnt vmcnt(" #n ")" ::: "memory")
#define PG8_WAIT_L(n) asm volatile("s_waitcnt lgkmcnt(" #n ")" ::: "memory")
#define PG8_BAR __builtin_amdgcn_s_barrier()
#define PG8_SCHED __builtin_amdgcn_sched_barrier(0)
    Unit cur, nxt; int ui = 0;
    if (!SO.next(0, cur)) return;
    f32x4 acc[2][2][4][2];
#pragma unroll
    for (int a = 0; a < 2; ++a)
#pragma unroll
        for (int b = 0; b < 2; ++b)
#pragma unroll
            for (int m = 0; m < 4; ++m)
#pragma unroll
                for (int n = 0; n < 2; ++n) acc[a][b][m][n] = (f32x4){0.f, 0.f, 0.f, 0.f};
    bf16x8 At[4][2], B0[2][2], B1[2][2];
    const char* cA = (const char*)A + (size_t)cur.pm * tstepA; const char* cB = (const char*)Bt + (size_t)cur.pn * tstepB;
    PG8_STAGE(PG8_SB(0, 0), cB, voffB); PG8_STAGE(PG8_SA(0, 0), cA, voffA); PG8_STAGE(PG8_SB(0, 1), cB + hstepB, voffB); PG8_STAGE(PG8_SA(0, 1), cA + hstepA, voffA);
    if (wr == 1) PG8_BAR;
    PG8_WAIT_V(4); PG8_BAR;
    PG8_STAGE(PG8_SB(1, 0), cB + kstep, voffB); PG8_STAGE(PG8_SA(1, 0), cA + kstep, voffA); PG8_STAGE(PG8_SB(1, 1), cB + hstepB + kstep, voffB);
    PG8_WAIT_V(6); PG8_BAR;
    for (;;) {
        const bool has_next = SO.next(ui + 1, nxt);
        const char* nA = has_next ? (const char*)A + (size_t)nxt.pm * tstepA : cA; const char* nB = has_next ? (const char*)Bt + (size_t)nxt.pn * tstepB : cB;
        for (int t = 0; t < nt; t += 2) {
            const bool last = (t == nt - 2);
            const char* a1 = cA + (size_t)(t + 1) * kstep;
            const char* a2 = last ? nA : cA + (size_t)(t + 2) * kstep; const char* b2 = last ? nB : cB + (size_t)(t + 2) * kstep;
            const char* a3 = a2 + kstep; const char* b3 = b2 + kstep;
            PG8_LDB(B0, 0, 0); PG8_SCHED; PG8_LDA(At, 0, 0); PG8_STAGE(PG8_SA(1, 1), a1 + hstepA, voffA);
            PG8_WAIT_L(8); PG8_BAR; PG8_WAIT_L(0); PG8_MMA(0, 0, At, B0); PG8_BAR; PG8_SCHED;
            PG8_LDB(B1, 0, 1); PG8_STAGE(PG8_SB(0, 0), b2, voffB);
            PG8_BAR; PG8_WAIT_L(0); PG8_MMA(0, 1, At, B1); PG8_BAR;
            PG8_LDA(At, 0, 1); PG8_STAGE(PG8_SA(0, 0), a2, voffA);
            PG8_BAR; PG8_WAIT_L(0); PG8_MMA(1, 0, At, B0); PG8_BAR; PG8_SCHED;
            PG8_STAGE(PG8_SB(0, 1), b2 + hstepB, voffB);
            PG8_WAIT_V(6); PG8_BAR; PG8_MMA(1, 1, At, B1); PG8_BAR;
            PG8_LDB(B0, 1, 0); PG8_SCHED; PG8_LDA(At, 1, 0); PG8_STAGE(PG8_SA(0, 1), a2 + hstepA, voffA);
            PG8_WAIT_L(8); PG8_BAR; PG8_WAIT_L(0); PG8_MMA(0, 0, At, B0); PG8_BAR; PG8_SCHED;
            PG8_LDB(B1, 1, 1); PG8_STAGE(PG8_SB(1, 0), b3, voffB);
            PG8_BAR; PG8_WAIT_L(0); PG8_MMA(0, 1, At, B1); PG8_BAR;
            PG8_LDA(At, 1, 1); PG8_STAGE(PG8_SA(1, 0), a3, voffA);
            PG8_BAR; PG8_WAIT_L(0); PG8_MMA(1, 0, At, B0); PG8_BAR; PG8_SCHED;
            PG8_STAGE(PG8_SB(1, 1), b3 + hstepB, voffB);
            PG8_WAIT_V(6); PG8_BAR; PG8_MMA(1, 1, At, B1); PG8_BAR;
        }
        E(acc, cur, wr, wc, fr, fq);
        if (!has_next) break;
#pragma unroll
        for (int a = 0; a < 2; ++a)
#pragma unroll
            for (int b = 0; b < 2; ++b)
#pragma unroll
                for (int m = 0; m < 4; ++m)
#pragma unroll
                    for (int n = 0; n < 2; ++n) acc[a][b][m][n] = (f32x4){0.f, 0.f, 0.f, 0.f};
        cur = nxt; cA = nA; cB = nB; ++ui;
    }
    PG8_WAIT_V(0);
    if (wr == 0) PG8_BAR;
    PG8_BAR;
#undef PG8_SA
#undef PG8_SB
#undef PG8_STAGE
#undef PG8_LDA
#undef PG8_LDB
#undef PG8_MMA
#undef PG8_WAIT_V
#undef PG8_WAIT_L
#undef PG8_BAR
#undef PG8_SCHED
}
}
using pg8::Unit;
typedef f32x4 AccT[2][2][4][2];

template <int SMODE> struct EpiRowBf16 {
    bf16_t* O; int ldc; const float* sc;
    DI void operator()(const AccT& acc, const Unit& u, int wr, int wc, int fr, int fq) const {
        const int row0 = u.pm * 256 + wr * 64 + fr, col0 = u.pn * 256 + wc * 32 + 8 * fq;
#pragma unroll
        for (int ai = 0; ai < 2; ++ai)
#pragma unroll
            for (int m = 0; m < 4; ++m) { const int row = row0 + ai * 128 + m * 16;
                float s = 1.f; if (SMODE == 1) s = rs_from_ss(sc[row]); if (SMODE == 2) s = sc[row];
                bf16_t* rowp = O + (size_t)row * ldc + col0;
#pragma unroll
                for (int bj = 0; bj < 2; ++bj) { const f32x4 v0 = acc[ai][bj][m][0] * s, v1 = acc[ai][bj][m][1] * s;
                    u32x4 w; w.x = pk2(v0[0], v0[1]); w.y = pk2(v0[2], v0[3]); w.z = pk2(v1[0], v1[1]); w.w = pk2(v1[2], v1[3]);
                    *(u32x4*)(rowp + bj * 128) = w; } }
    }
};
template <int SMODE> struct EpiColBf16 {
    bf16_t* O; int ldc; const float* sc;
    DI void operator()(const AccT& acc, const Unit& u, int wr, int wc, int fr, int fq) const {
        const int row0 = u.pm * 256 + wr * 64 + fr, col0 = u.pn * 256 + wc * 32 + 8 * fq;
#pragma unroll
        for (int bj = 0; bj < 2; ++bj) { float s[8];
#pragma unroll
            for (int j = 0; j < 8; ++j) { const float x = sc[col0 + bj * 128 + j]; s[j] = (SMODE == 1) ? rs_from_ss(x) : x; }
#pragma unroll
            for (int ai = 0; ai < 2; ++ai)
#pragma unroll
                for (int m = 0; m < 4; ++m) { const int row = row0 + ai * 128 + m * 16; const f32x4 v0 = acc[ai][bj][m][0], v1 = acc[ai][bj][m][1];
                    u32x4 w; w.x = pk2(v0[0] * s[0], v0[1] * s[1]); w.y = pk2(v0[2] * s[2], v0[3] * s[3]); w.z = pk2(v1[0] * s[4], v1[1] * s[5]); w.w = pk2(v1[2] * s[6], v1[3] * s[7]);
                    *(u32x4*)(O + (size_t)row * ldc + col0 + bj * 128) = w; } }
    }
};
struct EpiQ {
    bf16_t* QB; const float* rsq; const float* cstab;
    DI void operator()(const AccT& acc, const Unit& u, int wr, int wc, int fr, int fq) const {
        const int row0 = u.pm * 256 + wr * 64 + fr, col0 = u.pn * 256 + wc * 32 + 8 * fq;
        const float QS = 0.10206207261596577f * LOG2E;
#pragma unroll
        for (int ai = 0; ai < 2; ++ai)
#pragma unroll
            for (int m = 0; m < 4; ++m) { const int t = row0 + ai * 128 + m * 16; const float s = rsq[t] * QS;
#pragma unroll
                for (int bj = 0; bj < 2; ++bj) { const int c = col0 + bj * 128, h = c / 96, d = c - h * 96;
                    f32x4 v0 = acc[ai][bj][m][0] * s, v1 = acc[ai][bj][m][1] * s;
                    if (d >= 64) { const int i0 = (d - 64) >> 1; const f32x4 cs0 = *(const f32x4*)(cstab + (size_t)t * 32 + 2 * i0), cs1 = *(const f32x4*)(cstab + (size_t)t * 32 + 2 * i0 + 4);
                        f32x4 a, b;
                        a[0] = v0[0] * cs0[0] - v0[1] * cs0[1]; a[1] = v0[1] * cs0[0] + v0[0] * cs0[1];
                        a[2] = v0[2] * cs0[2] - v0[3] * cs0[3]; a[3] = v0[3] * cs0[2] + v0[2] * cs0[3];
                        b[0] = v1[0] * cs1[0] - v1[1] * cs1[1]; b[1] = v1[1] * cs1[0] + v1[0] * cs1[1];
                        b[2] = v1[2] * cs1[2] - v1[3] * cs1[3]; b[3] = v1[3] * cs1[2] + v1[2] * cs1[3];
                        v0 = a; v1 = b; }
                    u32x4 w; w.x = pk2(v0[0], v0[1]); w.y = pk2(v0[2], v0[3]); w.z = pk2(v1[0], v1[1]); w.w = pk2(v1[2], v1[3]);
                    *(u32x4*)(QB + ((size_t)h * S + t) * 96 + d) = w; } }
    }
};
struct EpiK {
    bf16_t* KB; const float* rskv;
    DI void operator()(const AccT& acc, const Unit& u, int wr, int wc, int fr, int fq) const {
        const int row0 = u.pm * 256 + wr * 64 + fr, col0 = u.pn * 256 + wc * 32 + 8 * fq;
#pragma unroll
        for (int ai = 0; ai < 2; ++ai)
#pragma unroll
            for (int m = 0; m < 4; ++m) { const int t = row0 + ai * 128 + m * 16; const float s = rskv[t];
#pragma unroll
                for (int bj = 0; bj < 2; ++bj) { const int c = col0 + bj * 128, h = c >> 6, d = c & 63;
                    const f32x4 v0 = acc[ai][bj][m][0] * s, v1 = acc[ai][bj][m][1] * s;
                    u32x4 w; w.x = pk2(v0[0], v0[1]); w.y = pk2(v0[2], v0[3]); w.z = pk2(v1[0], v1[1]); w.w = pk2(v1[2], v1[3]);
                    *(u32x4*)(KB + ((size_t)h * S + t) * 96 + d) = w; } }
    }
};
struct EpiRes {
    const float* res; float* HF; bf16_t* XB; float* rowss; int dry;
    DI void operator()(const AccT& acc, const Unit& u, int wr, int wc, int fr, int fq) const {
        const int row0 = u.pm * 256 + wr * 64 + fr, col0 = u.pn * 256 + wc * 32 + 8 * fq;
#pragma unroll
        for (int ai = 0; ai < 2; ++ai)
#pragma unroll
            for (int m = 0; m < 4; ++m) { const int t = row0 + ai * 128 + m * 16; float ss = 0.f;
#pragma unroll
                for (int bj = 0; bj < 2; ++bj) { const size_t o = (size_t)t * 1024 + col0 + bj * 128;
                    const f32x4 r0 = *(const f32x4*)(res + o), r1 = *(const f32x4*)(res + o + 4);
                    const f32x4 v0 = acc[ai][bj][m][0] + r0, v1 = acc[ai][bj][m][1] + r1;
                    if (!dry) { *(f32x4*)(HF + o) = v0; *(f32x4*)(HF + o + 4) = v1; }
                    u32x4 w; w.x = pk2(v0[0], v0[1]); w.y = pk2(v0[2], v0[3]); w.z = pk2(v1[0], v1[1]); w.w = pk2(v1[2], v1[3]);
                    if (!dry) *(u32x4*)(XB + o) = w;
                    ss += v0[0] * v0[0] + v0[1] * v0[1] + v0[2] * v0[2] + v0[3] * v0[3] + v1[0] * v1[0] + v1[1] * v1[1] + v1[2] * v1[2] + v1[3] * v1[3]; }
                ss += __shfl_xor(ss, 16); ss += __shfl_xor(ss, 32);
                if (fq == 0 && !dry) atomicAdd(rowss + t, ss); }
    }
};
DI float dpp_prev1(float cur, float prevm) {
    const int o = __builtin_amdgcn_update_dpp(0, __builtin_bit_cast(int, prevm), 0x121, 0xf, 0xf, false);
    return __builtin_bit_cast(float, __builtin_amdgcn_update_dpp(o, __builtin_bit_cast(int, cur), 0x111, 0xf, 0xf, false));
}
DI float dpp_prev2(float cur, float prevm) {
    const int o = __builtin_amdgcn_update_dpp(0, __builtin_bit_cast(int, prevm), 0x122, 0xf, 0xf, false);
    return __builtin_bit_cast(float, __builtin_amdgcn_update_dpp(o, __builtin_bit_cast(int, cur), 0x112, 0xf, 0xf, false));
}
struct EpiUp {
    bf16_t* ACT; const float* rowss; const float* cw; const float* cb; LAS unsigned char* plds;
    DI void operator()(const AccT& acc, const Unit& u, int wr, int wc, int fr, int fq) const {
        const int cl = u.pn * 128 + wc * 32 + 8 * fq;
        LAS float* P = (LAS float*)(plds + (wr * 4 + wc) * 1024);
        { const int lane = fq * 16 + fr, kind = lane >> 3, c4 = 4 * (lane & 7), k3 = kind & 3;
          const float* src = (k3 == 0 ? cb : cw + (k3 - 1) * 5632) + (kind >= 4 ? 2816 : 0) + u.pn * 128 + wc * 32 + c4;
          *(LAS f32x4*)(P + kind * 32 + c4) = *(const f32x4*)src; }
#pragma unroll
        for (int ai = 0; ai < 2; ++ai) {
            const int tok0 = u.pm * 248 + 62 * (2 * ai + wr) - 2 + fr;
            float rs[4];
#pragma unroll
            for (int m = 0; m < 4; ++m) { const int t = tok0 + 16 * m; const int tc = t < 0 ? 0 : (t >= S ? S - 1 : t); const float r = rs_from_ss(rowss[tc]); rs[m] = t < 0 ? 0.f : r; }
            const int row0 = fr < 2 ? (S + 236 + fr) : tok0;
#pragma unroll
            for (int n = 0; n < 2; ++n) {
                const int lc = 8 * fq + 4 * n;
                unsigned wpk[4][2];
#pragma unroll
                for (int jp = 0; jp < 2; ++jp) {
                    const f32x2 bg = *(const LAS f32x2*)(P + lc + 2 * jp), g0 = *(const LAS f32x2*)(P + 32 + lc + 2 * jp), g1 = *(const LAS f32x2*)(P + 64 + lc + 2 * jp), g2 = *(const LAS f32x2*)(P + 96 + lc + 2 * jp);
                    const f32x2 bv = *(const LAS f32x2*)(P + 128 + lc + 2 * jp), v0 = *(const LAS f32x2*)(P + 160 + lc + 2 * jp), v1 = *(const LAS f32x2*)(P + 192 + lc + 2 * jp), v2 = *(const LAS f32x2*)(P + 224 + lc + 2 * jp);
                    f32x2 G[4], V[4];
#pragma unroll
                    for (int m = 0; m < 4; ++m) { G[m] = (f32x2){acc[ai][0][m][n][2 * jp], acc[ai][0][m][n][2 * jp + 1]} * rs[m]; V[m] = (f32x2){acc[ai][1][m][n][2 * jp], acc[ai][1][m][n][2 * jp + 1]} * rs[m]; }
#pragma unroll
                    for (int m = 0; m < 4; ++m) {
                        const f32x2 zz = {0.f, 0.f}; const f32x2 Gp = m ? G[m - 1] : zz, Vp = m ? V[m - 1] : zz;
                        const f32x2 gp1 = {dpp_prev1(G[m].x, Gp.x), dpp_prev1(G[m].y, Gp.y)}, gp2 = {dpp_prev2(G[m].x, Gp.x), dpp_prev2(G[m].y, Gp.y)};
                        const f32x2 vp1 = {dpp_prev1(V[m].x, Vp.x), dpp_prev1(V[m].y, Vp.y)}, vp2 = {dpp_prev2(V[m].x, Vp.x), dpp_prev2(V[m].y, Vp.y)};
                        const f32x2 gc = bg + g0 * gp2 + g1 * gp1 + g2 * G[m];
                        const f32x2 vc = bv + v0 * vp2 + v1 * vp1 + v2 * V[m];
                        const f32x2 xe = gc * (-LOG2E);
                        f32x2 dn = {__builtin_amdgcn_exp2f(xe.x), __builtin_amdgcn_exp2f(xe.y)}; dn = dn + 1.0f;
                        const f32x2 rc = {__builtin_amdgcn_rcpf(dn.x), __builtin_amdgcn_rcpf(dn.y)};
                        const f32x2 rr = gc * rc * vc;
                        wpk[m][jp] = pk2(rr.x, rr.y); }
                }
#pragma unroll
                for (int m = 0; m < 4; ++m) { const int row = m ? tok0 + 16 * m : row0;
                    *(u32x2*)(ACT + (size_t)row * 2816 + cl + 4 * n) = (u32x2){wpk[m][0], wpk[m][1]}; }
                __builtin_amdgcn_sched_barrier(0);
            }
        }
    }
};

template <class F> DI void tr_items(const F& f, int Kdst, int Nrows, bf16_t* WT, LAS float* scr, int gw, int NGW, int lane, int& cum) {
    const int nblk = Nrows / 32, nitems = (Kdst / 64) * nblk;
    int first = (gw - cum) % NGW; if (first < 0) first += NGW; cum = (cum + nitems) % NGW;
    for (int item = first; item < nitems; item += NGW) {
        const int kb = item / nblk, nb = item % nblk, k0 = 64 * kb, n0 = 32 * nb;
        float tv[32];
#pragma unroll
        for (int i = 0; i < 32; ++i) tv[i] = f(k0 + 2 * i + (lane >> 5), n0 + (lane & 31));
#pragma unroll
        for (int i = 0; i < 32; ++i) scr[(2 * i + (lane >> 5)) * 33 + (lane & 31)] = tv[i];
        asm volatile("s_waitcnt lgkmcnt(0)" ::: "memory");
        const int c = lane & 7;
#pragma unroll
        for (int j = 0; j < 4; ++j) { const int n = (lane >> 3) + 8 * j; const LAS float* s = scr + (8 * c) * 33 + n;
            u32x4 o; o.x = pk2(s[0 * 33], s[1 * 33]); o.y = pk2(s[2 * 33], s[3 * 33]); o.z = pk2(s[4 * 33], s[5 * 33]); o.w = pk2(s[6 * 33], s[7 * 33]);
            *(u32x4*)(WT + (size_t)(n0 + n) * Kdst + k0 + 8 * c) = o; }
        asm volatile("s_waitcnt lgkmcnt(0)" ::: "memory");
    }
}
struct FW1 { const float* W; const float* g; DI float operator()(int k, int n) const { return n < 1440 ? W[(size_t)k * 1440 + n] * g[k] : 0.f; } };
struct FWQ { const float* W; const float* g; DI float operator()(int k, int n) const { const int h = n / 96, d = n - h * 96; int c = d; if (d >= 64) { const int r = d - 64; c = 64 + (r >> 1) + 16 * (r & 1); } return W[(size_t)k * 768 + h * 96 + c] * g[k]; } };
struct FWKV { const float* W; const float* g; int off; DI float operator()(int k, int n) const { return k < 128 ? W[(size_t)k * 1024 + (n >> 6) * 128 + off + (n & 63)] * g[k] : 0.f; } };
struct FWRI { const float* Wa; const float* Wx; DI float operator()(int k, int n) const { const float* W = n < 512 ? Wa : Wx; const int ch = n & 511, g = ch >> 6, j = ch & 63; return (k >> 6) == g ? W[(size_t)k * 64 + j] : 0.f; } };
struct FWP { const float* W; int N; DI float operator()(int k, int n) const { return W[(size_t)k * N + n]; } };
struct FWUP { const float* W; const float* g; DI float operator()(int k, int n) const { const int pn = n >> 8, r = n & 255; const int c = r < 128 ? 128 * pn + r : 2816 + 128 * pn + r - 128; return W[(size_t)k * 5632 + c] * g[k]; } };
struct FWOIN { const float* W; const float* g; DI float operator()(int k, int n) const {
    int c; float s = 1.f; if (n < 512) { c = n; s = 0.08838834764831845f; } else if (n < 1536) c = 2048 + (n - 512); else if (n < 2048) c = 512 + (n - 1536); else c = 1024 + (n - 2048);
    return W[(size_t)k * 3080 + c] * g[k] * s; } };

#ifndef PROPART
#define PROPART 7
#endif
DI void phase_prologue(int wv, const ArgP a, LAS unsigned char* lds, int parts) {
    unsigned char* ws = a.ws();
    const int tid = ltid(wv), wave = tid >> 6, lane = tid & 63;
    LAS float* scr = (LAS float*)(lds + wave * 8448);
    const int gw = blockIdx.x * 8 + wave, NGW = gridDim.x * 8; int cum = 0;
    if (parts & 1) {
    { FW1 f{a.in(3), a.in(2)}; tr_items(f, 1024, 1536, (bf16_t*)(ws + O_W1T), scr, gw, NGW, lane, cum); }
    { FWQ f{a.in(12), a.in(11)}; tr_items(f, 256, 768, (bf16_t*)(ws + O_WQT), scr, gw, NGW, lane, cum); }
    { FWKV f{a.in(14), a.in(13), 0}; tr_items(f, 256, 512, (bf16_t*)(ws + O_WKT), scr, gw, NGW, lane, cum); }
    { FWKV f{a.in(14), a.in(13), 64}; tr_items(f, 256, 512, (bf16_t*)(ws + O_WVT), scr, gw, NGW, lane, cum); }
    { FWRI f{a.in(6), a.in(8)}; tr_items(f, 512, 1024, (bf16_t*)(ws + O_WRIT), scr, gw, NGW, lane, cum); }
    { FWP f{a.in(15), 1024}; tr_items(f, 1024, 1024, (bf16_t*)(ws + O_WO1T), scr, gw, NGW, lane, cum); }
    for (int l = 0; l < 2; ++l) {
        { FWUP f{a.in(23) + (size_t)l * 1024 * 5632, a.in(22) + l * 1024}; tr_items(f, 1024, 5632, (bf16_t*)(ws + O_WUPT + l * SZ_WUPT), scr, gw, NGW, lane, cum); }
        { FWP f{a.in(26) + (size_t)l * 2816 * 1024, 1024}; tr_items(f, 2816, 1024, (bf16_t*)(ws + O_WDNT + l * SZ_WDNT), scr, gw, NGW, lane, cum); }
    }
    { FWOIN f{a.in(17), a.in(16)}; tr_items(f, 1024, 3072, (bf16_t*)(ws + O_WOINT), scr, gw, NGW, lane, cum); }
    { FWP f{a.in(21), 1024}; tr_items(f, 1024, 1024, (bf16_t*)(ws + O_WO2T), scr, gw, NGW, lane, cum); }
    }
    if (parts & 2) {
    const float* x = a.in(0); bf16_t* XB = (bf16_t*)(ws + O_XB) + 2 * 1024; float* rowss = (float*)(ws + O_ROWSS);
#pragma unroll 4
    for (int t = gw; t < S; t += NGW) {
        float ss = 0.f;
#pragma unroll
        for (int j = 0; j < 4; ++j) { const f32x4 v = *(const f32x4*)(x + (size_t)t * 1024 + j * 256 + lane * 4);
            ss += v[0] * v[0] + v[1] * v[1] + v[2] * v[2] + v[3] * v[3];
            u32x2 w; w.x = pk2(v[0], v[1]); w.y = pk2(v[2], v[3]); *(u32x2*)(XB + (size_t)t * 1024 + j * 256 + lane * 4) = w; }
        ss = wave_sum(ss);
        if (lane == 0) rowss[t] = ss;
        if (lane >= 1 && lane < 5) rowss[(size_t)lane * S + t] = 0.f;
    }
    }
    if (parts & 4) {
    const int* pos = (const int*)a.in(1); float* cst = (float*)(ws + O_CSTAB);
    for (int e = blockIdx.x * 512 + tid; e < S * 16; e += gridDim.x * 512) { const int t = e >> 4, i = e & 15;
        const float invf = __builtin_amdgcn_exp2f(-(float)i * (13.287712379549449f / 16.f)); const float ang = (float)pos[t] * invf;
        const float k = rintf(ang * 0.15915494309189535f);
        float r = fmaf(-k, 6.28318548202514648f, ang); r = fmaf(-k, -1.7484555e-7f, r);
        const float rr = r * 0.15915494309189535f;
        cst[2 * e] = __builtin_amdgcn_cosf(rr); cst[2 * e + 1] = __builtin_amdgcn_sinf(rr); }
    }
}

DI void phase_l0_prep(int wv, const ArgP a) {
    unsigned char* ws = a.ws();
    const bf16_t* Z = (const bf16_t*)(ws + O_Z); bf16_t* XC = (bf16_t*)(ws + O_XC); bf16_t* KB = (bf16_t*)(ws + O_KB);
    float* rsq = (float*)(ws + O_RSQ); float* rskv = (float*)(ws + O_RSKV); const float* cst = (const float*)(ws + O_CSTAB);
    const float* cw = a.in(4); const float* cb = a.in(5);
    const int tid = ltid(wv), wave = tid >> 6, lane = tid & 63;
#pragma unroll 2
    for (int e = blockIdx.x * 512 + tid; e < S * 64; e += gridDim.x * 512) { const int t = e >> 6, c0 = (e & 63) * 8;
        float acc[8];
#pragma unroll
        for (int j = 0; j < 8; ++j) acc[j] = cb[c0 + j];
#pragma unroll
        for (int k = 0; k < 4; ++k) { const int tt = t - 3 + k; if (tt < 0) continue;
            const u32x4 v = *(const u32x4*)(Z + (size_t)tt * 1536 + c0);
            const f32x4 w0 = *(const f32x4*)(cw + k * 512 + c0), w1 = *(const f32x4*)(cw + k * 512 + c0 + 4);
            acc[0] += w0[0] * bflo(v.x); acc[1] += w0[1] * bfhi(v.x); acc[2] += w0[2] * bflo(v.y); acc[3] += w0[3] * bfhi(v.y);
            acc[4] += w1[0] * bflo(v.z); acc[5] += w1[1] * bfhi(v.z); acc[6] += w1[2] * bflo(v.w); acc[7] += w1[3] * bfhi(v.w); }
        u32x4 o; o.x = pk2(acc[0], acc[1]); o.y = pk2(acc[2], acc[3]); o.z = pk2(acc[4], acc[5]); o.w = pk2(acc[6], acc[7]);
        *(u32x4*)(XC + (size_t)t * 512 + c0) = o; }
#pragma unroll 4
    for (int t = blockIdx.x * 8 + wave; t < S; t += gridDim.x * 8) {
        const bf16_t* zr = Z + (size_t)t * 1536;
        float sq = 0.f, skv = 0.f;
        { const u32x2 v = *(const u32x2*)(zr + 1024 + lane * 4); const float p0 = bflo(v.x), p1 = bfhi(v.x), p2 = bflo(v.y), p3 = bfhi(v.y); sq = p0 * p0 + p1 * p1 + p2 * p2 + p3 * p3; }
        { const unsigned v = *(const unsigned*)(zr + 1280 + lane * 2); const float p0 = bflo(v), p1 = bfhi(v); skv = p0 * p0 + p1 * p1; }
        sq = wave_sum(sq); skv = wave_sum(skv);
        if (lane == 0) { rsq[t] = rsqrtf(sq * (1.f / 256.f) + EPS); rskv[t] = rsqrtf(skv * (1.f / 128.f) + EPS); }
        if (lane < 16) { const float x1 = bf2f(zr[1408 + lane]), x2 = bf2f(zr[1424 + lane]); const float c = cst[(size_t)t * 32 + 2 * lane], s = cst[(size_t)t * 32 + 2 * lane + 1];
            const unsigned w = pk2(x1 * c - x2 * s, x2 * c + x1 * s);
#pragma unroll
            for (int h = 0; h < 8; ++h) *(unsigned*)(KB + ((size_t)h * S + t) * 96 + 64 + 2 * lane) = w; }
    }
}

DI void lru_coeff(float rpre, float ipre, float xc, float sp8, float& av, float& uv) {
    const float r = sigmoidf_(rpre), ig = sigmoidf_(ipre);
    const float la = -sp8 * r;
    av = fexp(la);
    uv = sqrtf(fmaxf(-expm1f(2.f * la), 0.f)) * (ig * xc);
}
DI void phase_lru_s1(int wv, const ArgP a) {
    unsigned char* ws = a.ws(); const int ch = ltid(wv);
    const bf16_t* RI = (const bf16_t*)(ws + O_RI); const bf16_t* XC = (const bf16_t*)(ws + O_XC);
    float* CHA = (float*)(ws + O_CHA); float* CHH = (float*)(ws + O_CHH);
    const float ba = a.in(7)[ch], bx = a.in(9)[ch]; const float lam = a.in(10)[ch];
    const float sp8 = 8.f * log1pf(expf(-lam));
    for (int c = blockIdx.x; c < 256; c += gridDim.x) {
        float A = 1.f, H = 0.f;
#pragma unroll 8
        for (int i = 0; i < 64; ++i) { const size_t t = (size_t)c * 64 + i;
            float av, uv; lru_coeff(bf2f(RI[t * 1024 + ch]) + ba, bf2f(RI[t * 1024 + 512 + ch]) + bx, bf2f(XC[t * 512 + ch]), sp8, av, uv);
            A *= av; H = av * H + uv; }
        CHA[c * 512 + ch] = A; CHH[c * 512 + ch] = H;
    }
}
DI void phase_lru_s3(int wv, const ArgP a) {
    unsigned char* ws = a.ws(); const int ch = ltid(wv);
    const bf16_t* RI = (const bf16_t*)(ws + O_RI); const bf16_t* XC = (const bf16_t*)(ws + O_XC); const bf16_t* Z = (const bf16_t*)(ws + O_Z);
    const float* CHA = (const float*)(ws + O_CHA); const float* CHH = (const float*)(ws + O_CHH); bf16_t* MIX = (bf16_t*)(ws + O_MIX);
    const float ba = a.in(7)[ch], bx = a.in(9)[ch]; const float lam = a.in(10)[ch];
    const float sp8 = 8.f * log1pf(expf(-lam));
    for (int c = blockIdx.x; c < 256; c += gridDim.x) {
        float H = 0.f;
#pragma unroll 8
        for (int cc = 0; cc < c; ++cc) H = CHA[cc * 512 + ch] * H + CHH[cc * 512 + ch];
#pragma unroll 4
        for (int i = 0; i < 64; ++i) { const size_t t = (size_t)c * 64 + i;
            float av, uv; lru_coeff(bf2f(RI[t * 1024 + ch]) + ba, bf2f(RI[t * 1024 + 512 + ch]) + bx, bf2f(XC[t * 512 + ch]), sp8, av, uv);
            H = av * H + uv;
            const float g = bf2f(Z[t * 1536 + 512 + ch]);
            const float y = 0.7978845608028654f * (g + 0.044715f * g * g * g);
            const float th = 1.f - 2.f * __builtin_amdgcn_rcpf(1.f + fexp(2.f * y));
            MIX[t * 1024 + ch] = f2bf(H * 0.5f * g * (1.f + th)); }
    }
}

constexpr int AT_KROW = 208, AT_VROW = 136, AT_KT = 64 * AT_KROW, AT_VT = 64 * AT_VROW;
DI float rowmax32(const f32x16& p0, const f32x16& p1) {
    float a = fmaxf(fmaxf(p0[0], p0[1]), p1[0]), b = fmaxf(fmaxf(p0[2], p0[3]), p1[1]); a = fmaxf(fmaxf(a, p1[2]), p1[3]);
#pragma unroll
    for (int r = 4; r < 16; r += 4) { a = fmaxf(fmaxf(a, p0[r]), p0[r + 1]); b = fmaxf(fmaxf(b, p0[r + 2]), p0[r + 3]); a = fmaxf(fmaxf(a, p1[r]), p1[r + 1]); b = fmaxf(fmaxf(b, p1[r + 2]), p1[r + 3]); }
    const float m = fmaxf(a, b);
    return fmaxf(m, __shfl_xor(m, 32));
}
DI void attn_unit(int wv, int h, int qb, const bf16_t* QB, const bf16_t* KB, const bf16_t* VT, bf16_t* MIX, LAS unsigned char* lds) {
    const int tid = ltid(wv), lane = tid & 63, r32 = lane & 31, hi = lane >> 5; const int wid = __builtin_amdgcn_readfirstlane(tid >> 6);
    const int qg = qb * 256 + wid * 32 + r32;
    const bf16_t* Kh = KB + (size_t)h * S * 96; const bf16_t* Vh = VT + (size_t)h * 64 * S;
    bf16x8 qf[6];
    { const bf16_t* qp = QB + ((size_t)h * S + qg) * 96 + 8 * hi;
#pragma unroll
      for (int s = 0; s < 6; ++s) qf[s] = *(const bf16x8*)(qp + 16 * s); }
    f32x16 o0 = {}, o1 = {}, negm = {};
    float mref = 0.f, lrun = 0.f;
    const int NT = 4 * qb + 4, wlim = 4 * qb + (wid >> 1);
    const int kc0 = tid, kkey0 = kc0 / 12, kpart0 = kc0 % 12;
    const int kc1 = tid + 512, kkey1 = kc1 / 12, kpart1 = kc1 % 12;
    const int vdv = tid >> 3, vpart = tid & 7;
    u32x4 rk0, rk1 = {}, rv;
#define AT_LOADK(t_) do { const size_t kb_ = (size_t)(t_) * 64; rk0 = *(const u32x4*)(Kh + (kb_ + kkey0) * 96 + kpart0 * 8); if (tid < 256) rk1 = *(const u32x4*)(Kh + (kb_ + kkey1) * 96 + kpart1 * 8); } while (0)
#define AT_LOADV(t_) do { rv = *(const u32x4*)(Vh + (size_t)vdv * S + (size_t)(t_) * 64 + vpart * 8); } while (0)
#define AT_WRITEK(t_) do { LAS unsigned char* Ks_ = lds + ((t_) & 1) * AT_KT; *(LAS u32x4*)(Ks_ + kkey0 * AT_KROW + kpart0 * 16) = rk0; if (tid < 256) *(LAS u32x4*)(Ks_ + kkey1 * AT_KROW + kpart1 * 16) = rk1; } while (0)
#define AT_WRITEV(t_) do { LAS unsigned char* Vs_ = lds + 2 * AT_KT + ((t_) & 1) * AT_VT; *(LAS u32x2*)(Vs_ + vdv * AT_VROW + vpart * 16) = (u32x2){rv.x, rv.y}; *(LAS u32x2*)(Vs_ + vdv * AT_VROW + vpart * 16 + 8) = (u32x2){rv.z, rv.w}; } while (0)
#define AT_QK(P0, P1, t_) do { const LAS unsigned char* Ks_ = lds + ((t_) & 1) * AT_KT + r32 * AT_KROW + 16 * hi; f32x16 c0_ = negm, c1_ = negm; \
        _Pragma("unroll") for (int s = 0; s < 6; ++s) { const bf16x8 k0_ = *(const LAS bf16x8*)(Ks_ + 32 * s), k1_ = *(const LAS bf16x8*)(Ks_ + 32 * AT_KROW + 32 * s); \
            c0_ = __builtin_amdgcn_mfma_f32_32x32x16_bf16(k0_, qf[s], c0_, 0, 0, 0); c1_ = __builtin_amdgcn_mfma_f32_32x32x16_bf16(k1_, qf[s], c1_, 0, 0, 0); } \
        P0 = c0_; P1 = c1_; } while (0)
#define AT_SM1(P0, P1, MOFF, t_, MASK) do { \
        { const float d_ = mref - MOFF; if (__any(d_ != 0.f)) { _Pragma("unroll") for (int r = 0; r < 16; ++r) { P0[r] -= d_; P1[r] -= d_; } } } \
        if (MASK && (t_) == wlim) { const int kbase_ = (t_) * 64 + 4 * hi; \
            _Pragma("unroll") for (int r = 0; r < 16; ++r) { const int kv_ = kbase_ + (r & 3) + 8 * (r >> 2); if (kv_ > qg) P0[r] = -1e30f; if (kv_ + 32 > qg) P1[r] = -1e30f; } } \
        const float mx_ = rowmax32(P0, P1); \
        if ((t_) == 0 || __any(mx_ > 8.f)) { const float dl_ = ((t_) == 0) ? mx_ : fmaxf(mx_, 0.f); mref += dl_; \
            _Pragma("unroll") for (int r = 0; r < 16; ++r) { P0[r] -= dl_; P1[r] -= dl_; } \
            const float al_ = __builtin_amdgcn_exp2f(-dl_); lrun *= al_; \
            _Pragma("unroll") for (int r = 0; r < 16; ++r) { o0[r] *= al_; o1[r] *= al_; negm[r] = -mref; } asm volatile("" : "+v"(negm)); } \
    } while (0)
#define AT_SM2(P0, P1, t_) do { \
        float ps_ = 0.f; \
        _Pragma("unroll") for (int r = 0; r < 16; ++r) { P0[r] = __builtin_amdgcn_exp2f(P0[r]); P1[r] = __builtin_amdgcn_exp2f(P1[r]); ps_ += P0[r] + P1[r]; } \
        lrun += ps_; \
        const LAS unsigned char* Vs_ = lds + 2 * AT_KT + ((t_) & 1) * AT_VT + r32 * AT_VROW + 8 * hi; \
        _Pragma("unroll") for (int ks = 0; ks < 4; ++ks) { u32x4 w_; \
            if (ks < 2) { w_.x = pk2(P0[8 * ks], P0[8 * ks + 1]); w_.y = pk2(P0[8 * ks + 2], P0[8 * ks + 3]); w_.z = pk2(P0[8 * ks + 4], P0[8 * ks + 5]); w_.w = pk2(P0[8 * ks + 6], P0[8 * ks + 7]); } \
            else { w_.x = pk2(P1[8 * ks - 16], P1[8 * ks - 15]); w_.y = pk2(P1[8 * ks - 14], P1[8 * ks - 13]); w_.z = pk2(P1[8 * ks - 12], P1[8 * ks - 11]); w_.w = pk2(P1[8 * ks - 10], P1[8 * ks - 9]); } \
            const bf16x8 pa_ = __builtin_bit_cast(bf16x8, w_); \
            const u32x2 a0_ = *(const LAS u32x2*)(Vs_ + 32 * ks), a1_ = *(const LAS u32x2*)(Vs_ + 32 * ks + 16); \
            const u32x2 b0_ = *(const LAS u32x2*)(Vs_ + 32 * AT_VROW + 32 * ks), b1_ = *(const LAS u32x2*)(Vs_ + 32 * AT_VROW + 32 * ks + 16); \
            o0 = __builtin_amdgcn_mfma_f32_32x32x16_bf16(__builtin_bit_cast(bf16x8, (u32x4){a0_.x, a0_.y, a1_.x, a1_.y}), pa_, o0, 0, 0, 0); \
            o1 = __builtin_amdgcn_mfma_f32_32x32x16_bf16(__builtin_bit_cast(bf16x8, (u32x4){b0_.x, b0_.y, b1_.x, b1_.y}), pa_, o1, 0, 0, 0); } \
    } while (0)
#define AT_STEPM(C0, C1, MC, N0, N1, MN, t_) do { \
        AT_WRITEK((t_) + 1); AT_WRITEV(t_); \
        __syncthreads(); \
        AT_LOADK((t_) + 2); AT_LOADV((t_) + 1); \
        AT_SM1(C0, C1, MC, t_, 0); MN = mref; AT_QK(N0, N1, (t_) + 1); AT_SM2(C0, C1, t_); \
    } while (0)
#define AT_STEPB(C0, C1, MC, N0, N1, MN, t_) do { \
        if ((t_) + 1 < NT) AT_WRITEK((t_) + 1); AT_WRITEV(t_); \
        __syncthreads(); \
        if ((t_) + 2 < NT) AT_LOADK((t_) + 2); if ((t_) + 1 < NT) AT_LOADV((t_) + 1); \
        if ((t_) + 1 <= wlim) { MN = mref; AT_QK(N0, N1, (t_) + 1); } \
        if ((t_) <= wlim) { AT_SM1(C0, C1, MC, t_, 1); AT_SM2(C0, C1, t_); } \
    } while (0)
    f32x16 pA0, pA1, pB0 = {}, pB1 = {}; float mA = 0.f, mB = 0.f;
    AT_LOADK(0); AT_WRITEK(0);
    __syncthreads();
    AT_LOADK(1); AT_LOADV(0);
    AT_QK(pA0, pA1, 0);
    int t = 0;
    for (; t < 4 * qb; t += 2) {
        AT_STEPM(pA0, pA1, mA, pB0, pB1, mB, t);
        AT_STEPM(pB0, pB1, mB, pA0, pA1, mA, t + 1);
    }
    for (; t < NT; t += 2) {
        AT_STEPB(pA0, pA1, mA, pB0, pB1, mB, t);
        AT_STEPB(pB0, pB1, mB, pA0, pA1, mA, t + 1);
    }
#undef AT_STEPM
#undef AT_STEPB
#undef AT_LOADK
#undef AT_LOADV
#undef AT_WRITEK
#undef AT_WRITEV
#undef AT_QK
#undef AT_SM1
#undef AT_SM2
    lrun += __shfl_xor(lrun, 32);
    const float inv = 1.f / lrun;
    bf16_t* op = MIX + (size_t)qg * 1024 + 512 + h * 64;
#pragma unroll
    for (int g = 0; g < 4; ++g) { const int dv = 8 * g + 4 * hi;
        u32x2 w; w.x = pk2(o0[4 * g] * inv, o0[4 * g + 1] * inv); w.y = pk2(o0[4 * g + 2] * inv, o0[4 * g + 3] * inv); *(u32x2*)(op + dv) = w;
        u32x2 w2; w2.x = pk2(o1[4 * g] * inv, o1[4 * g + 1] * inv); w2.y = pk2(o1[4 * g + 2] * inv, o1[4 * g + 3] * inv); *(u32x2*)(op + 32 + dv) = w2; }
    __syncthreads();
}
DI void phase_attn(int wv, const ArgP a, LAS unsigned char* lds) {
    unsigned char* ws = a.ws();
    const bf16_t* QB = (const bf16_t*)(ws + O_QB); const bf16_t* KB = (const bf16_t*)(ws + O_KB); const bf16_t* VT = (const bf16_t*)(ws + O_VT); bf16_t* MIX = (bf16_t*)(ws + O_MIX);
    for (int b = blockIdx.x; b < 256; b += gridDim.x) {
        const int v = (b & 7) * 32 + (b >> 3), h = v >> 5, s = v & 31;
        attn_unit(wv, h, 63 - s, QB, KB, VT, MIX, lds);
        attn_unit(wv, h, s, QB, KB, VT, MIX, lds);
    }
}

DI void phase_m_gates(int wv, const ArgP a, LAS unsigned char* lds) {
    unsigned char* ws = a.ws(); const int tid = ltid(wv), wave = tid >> 6, lane = tid & 63;
    const float* HF = a.out(); const float* rowss = (const float*)(ws + O_ROWSS) + 2 * S;
    const float* Wg = a.in(17); const float* gn = a.in(16);
    LAS float* wgs = (LAS float*)lds;
    LAS float* pre = (LAS float*)(lds + 32768);
    float* GB = (float*)(ws + O_GB); float* GE = (float*)(ws + O_GE); float* GPM = (float*)(ws + O_GPM);
    float* BL = (float*)(ws + O_BL); float* ML = (float*)(ws + O_ML);
    for (int e = tid; e < 8192; e += 512) { const int k = e >> 3, j = e & 7; wgs[e] = Wg[(size_t)k * 3080 + 3072 + j] * gn[k]; }
    __syncthreads();
    for (int c = blockIdx.x; c < 256; c += gridDim.x) {
#pragma unroll 4
        for (int i = 0; i < 8; ++i) { const int t = c * 64 + wave * 8 + i;
            float acc[8];
#pragma unroll
            for (int j = 0; j < 8; ++j) acc[j] = 0.f;
#pragma unroll
            for (int jj = 0; jj < 4; ++jj) { const int k0 = jj * 256 + lane * 4; const f32x4 hv = *(const f32x4*)(HF + (size_t)t * 1024 + k0);
#pragma unroll
                for (int kk = 0; kk < 4; ++kk) { const f32x4 w0 = *(const LAS f32x4*)(wgs + (k0 + kk) * 8), w1 = *(const LAS f32x4*)(wgs + (k0 + kk) * 8 + 4);
                    acc[0] += hv[kk] * w0[0]; acc[1] += hv[kk] * w0[1]; acc[2] += hv[kk] * w0[2]; acc[3] += hv[kk] * w0[3];
                    acc[4] += hv[kk] * w1[0]; acc[5] += hv[kk] * w1[1]; acc[6] += hv[kk] * w1[2]; acc[7] += hv[kk] * w1[3]; } }
            const float rs = rs_from_ss(rowss[t]);
#pragma unroll
            for (int j = 0; j < 8; ++j) { const float v = wave_sum(acc[j]) * rs; if (lane == j) pre[(wave * 8 + i) * 8 + j] = v; }
        }
        __syncthreads();
        if (tid < 4) { const int h = tid; const float bi = a.in(18)[h], bfg = a.in(19)[h];
            float b = 0.f, pm = -1e30f;
            for (int i = 0; i < 64; ++i) {
                const float ig = 15.f * tanhf((pre[i * 8 + h] + bi) * (1.f / 15.f));
                const float fg = 15.f * tanhf((pre[i * 8 + 4 + h] + bfg) * (1.f / 15.f));
                const float lf = -log1pf(expf(-fg));
                b += lf; const float e = ig - b; pm = fmaxf(pm, e);
                const size_t o = (size_t)h * S + c * 64 + i; GB[o] = b; GE[o] = e; GPM[o] = pm; }
            BL[c * 4 + h] = b; ML[c * 4 + h] = b + pm; }
        __syncthreads();
    }
}
DI void phase_m_dc(int wv, const ArgP a) {
    unsigned char* ws = a.ws(); const int tid = ltid(wv), lane = tid & 63, r32 = lane & 31, hi = lane >> 5; const int w = __builtin_amdgcn_readfirstlane(tid >> 6);
    const float* BL = (const float*)(ws + O_BL); const float* ML = (const float*)(ws + O_ML); float* NST = (float*)(ws + O_NST);
    const float* GE = (const float*)(ws + O_GE); const bf16_t* KVT = (const bf16_t*)(ws + O_KVT); bf16_t* CST = (bf16_t*)(ws + O_CST);
    for (int u = blockIdx.x; u < 1024; u += gridDim.x) {
        const int c = u >> 2, h = u & 3; const size_t t0 = (size_t)c * 64;
        const float emax = ML[c * 4 + h] - BL[c * 4 + h];
        bf16x8 bfr[4];
        { const bf16_t* vp = KVT + (size_t)(512 + h * 256 + 32 * w + r32) * S + t0 + 8 * hi; const float* gp = GE + (size_t)h * S + t0 + 8 * hi;
#pragma unroll
          for (int ks = 0; ks < 4; ++ks) { const u32x4 v = *(const u32x4*)(vp + 16 * ks); const f32x4 e0 = *(const f32x4*)(gp + 16 * ks), e1 = *(const f32x4*)(gp + 16 * ks + 4);
              u32x4 o; o.x = pk2(bflo(v.x) * fexp(e0[0] - emax), bfhi(v.x) * fexp(e0[1] - emax)); o.y = pk2(bflo(v.y) * fexp(e0[2] - emax), bfhi(v.y) * fexp(e0[3] - emax));
              o.z = pk2(bflo(v.z) * fexp(e1[0] - emax), bfhi(v.z) * fexp(e1[1] - emax)); o.w = pk2(bflo(v.w) * fexp(e1[2] - emax), bfhi(v.w) * fexp(e1[3] - emax));
              bfr[ks] = __builtin_bit_cast(bf16x8, o); } }
        const bf16_t* kp = KVT + (size_t)(h * 128 + r32) * S + t0 + 8 * hi;
        bf16_t* op = CST + ((size_t)(c * 4 + h) * 256 + 32 * w + r32) * 128 + 4 * hi;
#pragma unroll
        for (int rb = 0; rb < 4; ++rb) { f32x16 acc = {};
#pragma unroll
            for (int ks = 0; ks < 4; ++ks) { const bf16x8 ka = *(const bf16x8*)(kp + (size_t)(32 * rb) * S + 16 * ks); acc = __builtin_amdgcn_mfma_f32_32x32x16_bf16(ka, bfr[ks], acc, 0, 0, 0); }
#pragma unroll
            for (int g = 0; g < 4; ++g) { u32x2 o; o.x = pk2(acc[4 * g], acc[4 * g + 1]); o.y = pk2(acc[4 * g + 2], acc[4 * g + 3]); *(u32x2*)(op + 32 * rb + 8 * g) = o; } }
        if (tid < 128) { const bf16_t* kr = KVT + (size_t)(h * 128 + tid) * S + t0; const float* gp = GE + (size_t)h * S + t0; float s = 0.f;
#pragma unroll
            for (int p = 0; p < 8; ++p) { const u32x4 v = *(const u32x4*)(kr + 8 * p); const f32x4 e0 = *(const f32x4*)(gp + 8 * p), e1 = *(const f32x4*)(gp + 8 * p + 4);
                s += bflo(v.x) * fexp(e0[0] - emax) + bfhi(v.x) * fexp(e0[1] - emax) + bflo(v.y) * fexp(e0[2] - emax) + bfhi(v.y) * fexp(e0[3] - emax)
                   + bflo(v.z) * fexp(e1[0] - emax) + bfhi(v.z) * fexp(e1[1] - emax) + bflo(v.w) * fexp(e1[2] - emax) + bfhi(v.w) * fexp(e1[3] - emax); }
            NST[(size_t)(c * 4 + h) * 128 + tid] = s; }
    }
}
DI void phase_m_comb(int wv, const ArgP a, LAS unsigned char* lds, int dry) {
    unsigned char* ws = a.ws(); const int tid = ltid(wv);
    const float* BL = (const float*)(ws + O_BL); const float* ML = (const float*)(ws + O_ML); float* MST = (float*)(ws + O_MST); float* NST = (float*)(ws + O_NST);
    bf16_t* CST = (bf16_t*)(ws + O_CST);
    LAS float* bls = (LAS float*)lds; LAS float* mls = bls + 1024; LAS float* ga = mls + 1024; LAS float* gb = ga + 1024;
    for (int e = tid; e < 1024; e += 512) { bls[e] = BL[e]; mls[e] = ML[e]; }
    __syncthreads();
    if (tid < 4) { const int h = tid; float m = 0.f;
        for (int c = 0; c < 256; ++c) { const float bl = bls[c * 4 + h], ml = mls[c * 4 + h]; const float mn = fmaxf(bl + m, ml);
            ga[c * 4 + h] = fexp(bl + m - mn); gb[c * 4 + h] = fexp(ml - mn);
            if (blockIdx.x == 0 && !dry) MST[c * 4 + h] = m;
            m = mn; } }
    __syncthreads();
    for (int eb = blockIdx.x; eb < 129; eb += gridDim.x) {
        if (eb < 128) { const int h = eb >> 5; unsigned* p = (unsigned*)(CST + (size_t)h * 32768 + (size_t)(eb & 31) * 1024 + 2 * tid); float C0 = 0.f, C1 = 0.f;
            for (int c = 0; c < 256; c += 32) { unsigned d[32];
#pragma unroll
                for (int k = 0; k < 32; ++k) d[k] = p[(size_t)(c + k) * 65536];
#pragma unroll
                for (int k = 0; k < 32; ++k) { if (!dry) p[(size_t)(c + k) * 65536] = pk2(C0, C1); const float a_ = ga[(c + k) * 4 + h], b_ = gb[(c + k) * 4 + h]; C0 = a_ * C0 + b_ * bflo(d[k]); C1 = a_ * C1 + b_ * bfhi(d[k]); } }
        } else { const int h = tid >> 7; float* p = NST + tid; float C = 0.f;
            for (int c = 0; c < 256; c += 8) { float d[8];
#pragma unroll
                for (int k = 0; k < 8; ++k) d[k] = p[(size_t)(c + k) * 512];
#pragma unroll
                for (int k = 0; k < 8; ++k) { if (!dry) p[(size_t)(c + k) * 512] = C; C = ga[(c + k) * 4 + h] * C + gb[(c + k) * 4 + h] * d[k]; } } }
    }
    __syncthreads();
}
constexpr int MC_QROW = 272, MC_SROW = 144;
constexpr int MC_QS = 0, MC_KS = 64 * MC_QROW, MC_SC = 2 * 64 * MC_QROW, MC_F = MC_SC + 64 * MC_SROW;
DI void phase_m_out(int wv, const ArgP a, LAS unsigned char* lds, int dry) {
    unsigned char* ws = a.ws(); const int tid = ltid(wv), lane = tid & 63, r32 = lane & 31, hi = lane >> 5; const int w = __builtin_amdgcn_readfirstlane(tid >> 6);
    bf16_t* QOK = (bf16_t*)(ws + O_QOK); const bf16_t* KVT = (const bf16_t*)(ws + O_KVT); const bf16_t* CST = (const bf16_t*)(ws + O_CST);
    const float* GB = (const float*)(ws + O_GB); const float* GE = (const float*)(ws + O_GE); const float* GPM = (const float*)(ws + O_GPM);
    const float* MST = (const float*)(ws + O_MST); const float* NST = (const float*)(ws + O_NST); const float* ong = a.in(20);
    LAS unsigned char* Qs = lds + MC_QS; LAS unsigned char* Ks = lds + MC_KS; LAS unsigned char* Sc = lds + MC_SC;
    LAS float* F = (LAS float*)(lds + MC_F);
    LAS float* f_b = F, *f_e = F + 64, *f_m = F + 128, *f_g = F + 192, *f_qn = F + 256, *f_ps = F + 320  , *f_n = F + 576  , *f_part = F + 704  ;
    for (int u = blockIdx.x; u < 1024; u += gridDim.x) {
        const int c = u >> 2, h = u & 3; const size_t t0 = (size_t)c * 64;
        for (int e = tid; e < 1024; e += 512) { const int r = e >> 4, p = e & 15;
            *(LAS u32x4*)(Qs + r * MC_QROW + p * 16) = *(const u32x4*)(QOK + (t0 + r) * 2048 + h * 128 + p * 8);
            *(LAS u32x4*)(Ks + r * MC_QROW + p * 16) = *(const u32x4*)(QOK + (t0 + r) * 2048 + 1536 + h * 128 + p * 8); }
        if (tid < 64) { const float mstv = MST[c * 4 + h]; const float b = GB[(size_t)h * S + t0 + tid], e = GE[(size_t)h * S + t0 + tid], pm = GPM[(size_t)h * S + t0 + tid];
            const float m = b + fmaxf(mstv, pm); f_b[tid] = b; f_e[tid] = e; f_m[tid] = m; f_g[tid] = fexp(b + mstv - m); }
        if (tid >= 64 && tid < 192) f_n[tid - 64] = NST[(size_t)(c * 4 + h) * 128 + tid - 64];
        __syncthreads();
        if (w < 4) {
            const int sb = w & 1, tb = w >> 1; const int tl = 32 * tb + r32;
            f32x16 x = {};
#pragma unroll
            for (int ks = 0; ks < 8; ++ks) {
                const bf16x8 ka = *(const LAS bf16x8*)(Ks + (32 * sb + r32) * MC_QROW + (16 * ks + 8 * hi) * 2);
                const bf16x8 qb = *(const LAS bf16x8*)(Qs + tl * MC_QROW + (16 * ks + 8 * hi) * 2);
                x = __builtin_amdgcn_mfma_f32_32x32x16_bf16(ka, qb, x, 0, 0, 0); }
            const float bt = f_b[tl], mt = f_m[tl]; float ps = 0.f;
#pragma unroll
            for (int g = 0; g < 4; ++g) { float v[4];
#pragma unroll
                for (int j = 0; j < 4; ++j) { const int sl = 32 * sb + 8 * g + 4 * hi + j; const float wgt = (sl <= tl) ? fexp(bt + f_e[sl] - mt) : 0.f; v[j] = x[4 * g + j] * wgt; ps += v[j]; }
                u32x2 o; o.x = pk2(v[0], v[1]); o.y = pk2(v[2], v[3]);
                *(LAS u32x2*)(Sc + tl * MC_SROW + (32 * sb + 8 * g + 4 * hi) * 2) = o; }
            f_ps[(sb * 2 + hi) * 64 + tl] = ps;
        } else {
            const int tl = 16 * (w - 4) + (lane >> 2), qq = lane & 3; float s = 0.f;
#pragma unroll
            for (int p = 0; p < 4; ++p) { const u32x4 v = *(const LAS u32x4*)(Qs + tl * MC_QROW + (32 * qq + 8 * p) * 2); LAS float* np = f_n + 32 * qq + 8 * p;
                s += bflo(v.x) * np[0] + bfhi(v.x) * np[1] + bflo(v.y) * np[2] + bfhi(v.y) * np[3] + bflo(v.z) * np[4] + bfhi(v.z) * np[5] + bflo(v.w) * np[6] + bfhi(v.w) * np[7]; }
            s += __shfl_xor(s, 1); s += __shfl_xor(s, 2);
            if (qq == 0) f_qn[tl] = s;
        }
        __syncthreads();
        f32x16 acc0 = {}, acc1 = {};
        { const bf16_t* cp = CST + ((size_t)(c * 4 + h) * 256 + 32 * w + r32) * 128 + 8 * hi;
#pragma unroll
          for (int ks = 0; ks < 8; ++ks) { const bf16x8 ca = *(const bf16x8*)(cp + 16 * ks);
              const bf16x8 q0 = *(const LAS bf16x8*)(Qs + r32 * MC_QROW + (16 * ks + 8 * hi) * 2), q1 = *(const LAS bf16x8*)(Qs + (32 + r32) * MC_QROW + (16 * ks + 8 * hi) * 2);
              acc0 = __builtin_amdgcn_mfma_f32_32x32x16_bf16(ca, q0, acc0, 0, 0, 0); acc1 = __builtin_amdgcn_mfma_f32_32x32x16_bf16(ca, q1, acc1, 0, 0, 0); } }
        const float g0 = f_g[r32], g1 = f_g[32 + r32];
#pragma unroll
        for (int r = 0; r < 16; ++r) { acc0[r] *= g0; acc1[r] *= g1; }
        { const bf16_t* vp = KVT + (size_t)(512 + h * 256 + 32 * w + r32) * S + t0 + 8 * hi;
#pragma unroll
          for (int ks = 0; ks < 4; ++ks) { const bf16x8 va = *(const bf16x8*)(vp + 16 * ks);
              const bf16x8 s0 = *(const LAS bf16x8*)(Sc + r32 * MC_SROW + (16 * ks + 8 * hi) * 2), s1 = *(const LAS bf16x8*)(Sc + (32 + r32) * MC_SROW + (16 * ks + 8 * hi) * 2);
              acc0 = __builtin_amdgcn_mfma_f32_32x32x16_bf16(va, s0, acc0, 0, 0, 0); acc1 = __builtin_amdgcn_mfma_f32_32x32x16_bf16(va, s1, acc1, 0, 0, 0); } }
        float inv[2];
#pragma unroll
        for (int tb = 0; tb < 2; ++tb) { const int tl = 32 * tb + r32;
            const float den = f_g[tl] * f_qn[tl] + f_ps[tl] + f_ps[64 + tl] + f_ps[128 + tl] + f_ps[192 + tl];
            inv[tb] = 1.f / fmaxf(fabsf(den), fexp(-f_m[tl])); }
        float ss0 = 0.f, ss1 = 0.f;
#pragma unroll
        for (int r = 0; r < 16; ++r) { acc0[r] *= inv[0]; acc1[r] *= inv[1]; ss0 += acc0[r] * acc0[r]; ss1 += acc1[r] * acc1[r]; }
        ss0 += __shfl_xor(ss0, 32); ss1 += __shfl_xor(ss1, 32);
        if (hi == 0) { f_part[w * 64 + r32] = ss0; f_part[w * 64 + 32 + r32] = ss1; }
        __syncthreads();
        float rn[2];
#pragma unroll
        for (int tb = 0; tb < 2; ++tb) { float s = 0.f;
#pragma unroll
            for (int ww = 0; ww < 8; ++ww) s += f_part[ww * 64 + 32 * tb + r32];
            rn[tb] = rsqrtf(s * (1.f / 256.f) + EPS); }
#pragma unroll
        for (int tb = 0; tb < 2; ++tb) { bf16_t* op = QOK + (t0 + 32 * tb + r32) * 2048 + 512 + h * 256 + 32 * w;
#pragma unroll
            for (int g = 0; g < 4; ++g) { const int dv = 8 * g + 4 * hi; const u32x2 ov = *(const u32x2*)(op + dv);
                const f32x4 gg = *(const f32x4*)(ong + h * 256 + 32 * w + dv);
                const float og[4] = {bflo(ov.x), bfhi(ov.x), bflo(ov.y), bfhi(ov.y)}; float y[4];
#pragma unroll
                for (int j = 0; j < 4; ++j) { const float hv = (tb ? acc1[4 * g + j] : acc0[4 * g + j]) * rn[tb]; y[j] = hv * gg[j] * sigmoidf_(og[j]); }
                u32x2 o; o.x = pk2(y[0], y[1]); o.y = pk2(y[2], y[3]); if (!dry) *(u32x2*)(op + dv) = o; } }
        __syncthreads();
    }
}

DI void phase_final(int wv, const ArgP a) {
    float* out = a.out(); const float* rowss = (const float*)(a.ws() + O_ROWSS) + 4 * S; const float* g = a.in(27);
    for (size_t e = (size_t)blockIdx.x * 512 + ltid(wv); e < (size_t)S * 256; e += (size_t)gridDim.x * 512) { const int t = (int)(e >> 8), c = (int)(e & 255) * 4;
        const float rs = rs_from_ss(rowss[t]); f32x4 v = *(f32x4*)(out + (size_t)t * 1024 + c); const f32x4 gg = *(const f32x4*)(g + c);
        v = v * rs * gg; *(f32x4*)(out + (size_t)t * 1024 + c) = v; }
}

#ifndef DIS
#define DIS 0u
#endif
#ifndef REP
#define REP 0u
#endif
#ifndef XSYNC
#define XSYNC 0
#endif

#define XB_TMO      128
#define XB_XCNT(j)  (256  + 64 * (j))
#define XB_XSUB(j)  (1280 + 64 * (j))
#define XB_XGEN(j)  (2304 + 64 * (j))
#define XB_TOP      3328
#define XB_TOPGEN   3392
#define XB_SPIN_CAP (1u << 18)
DI unsigned xb_ld(unsigned* p) { return __hip_atomic_load(p, __ATOMIC_RELAXED, __HIP_MEMORY_SCOPE_AGENT); }
DI unsigned xb_add(unsigned* p, unsigned v) { return __hip_atomic_fetch_add(p, v, __ATOMIC_RELAXED, __HIP_MEMORY_SCOPE_AGENT); }
DI unsigned xb_xcc_id() { return (unsigned)__builtin_amdgcn_s_getreg((3 << 11) | 20) & 0xFu; }
#define XB_SPIN(cond, bar) do { unsigned _sp = 0; while (cond) { __builtin_amdgcn_s_sleep(1); \
    if ((++_sp & 255u) == 0u) { if (xb_ld(&(bar)[XB_TMO])) break; if (_sp > XB_SPIN_CAP) { atomicAdd(&(bar)[XB_TMO], 1u); break; } } } } while (0)
DI void xcd_barrier_complete(unsigned* bar, unsigned x, unsigned& nloc, unsigned& nx) {
    const unsigned G = gridDim.x;
    unsigned sum, cnt, mine, sp = 0u;
    for (;;) {
        sum = 0u; cnt = 0u; mine = 0u;
#pragma unroll
        for (unsigned j = 0; j < 16; ++j) { const unsigned c = xb_ld(&bar[XB_XCNT(j)]); sum += c; cnt += (c > 0u) ? 1u : 0u; mine = (j == x) ? c : mine; }
        if (sum == G) break;
        __builtin_amdgcn_s_sleep(1);
        if ((++sp & 255u) == 0u) { if (xb_ld(&bar[XB_TMO])) break; if (sp > XB_SPIN_CAP) { atomicAdd(&bar[XB_TMO], 1u); break; } }
    }
    nloc = mine > 0u ? mine : 1u; nx = cnt > 0u ? cnt : 1u;
}
DI void xcd_barrier(int wv, unsigned* bar, volatile LAS unsigned* st) {
    asm volatile("s_waitcnt vmcnt(0)" ::: "memory");
    __syncthreads();
    if (ltid(wv) == 0) {
        const unsigned x = xb_xcc_id();
        __builtin_amdgcn_s_waitcnt(0);
        unsigned nloc = st[0], nx = st[1];
        if (nloc == 0u) { xcd_barrier_complete(bar, x, nloc, nx); st[0] = nloc; st[1] = nx; }
        const unsigned old = xb_add(&bar[XB_XSUB(x)], 1u);
        const unsigned gen = old / nloc;
        if (old + 1u == (gen + 1u) * nloc) {
            __builtin_amdgcn_fence(__ATOMIC_RELEASE, "agent");
            asm volatile("s_waitcnt vmcnt(0)" ::: "memory");
            const unsigned og = xb_add(&bar[XB_TOP], 1u);
            const unsigned tg = og / nx;
            if (og + 1u == (tg + 1u) * nx) xb_add(&bar[XB_TOPGEN], 1u);
            else XB_SPIN(xb_ld(&bar[XB_TOPGEN]) == tg, bar);
            __builtin_amdgcn_fence(__ATOMIC_ACQUIRE, "agent");
            xb_add(&bar[XB_XGEN(x)], 1u);
            asm volatile("s_waitcnt vmcnt(0)" ::: "memory");
        } else {
            XB_SPIN(xb_ld(&bar[XB_XGEN(x)]) == gen, bar);
            __builtin_amdgcn_fence(__ATOMIC_ACQUIRE, "agent");
            asm volatile("s_waitcnt vmcnt(0)" ::: "memory");
        }
    }
    __syncthreads();
}
DI ArgP getargs() { ArgP r; r.p = (const __attribute__((address_space(4))) Args*)__builtin_amdgcn_kernarg_segment_ptr(); asm volatile("" : "+s"(r.p)); return r; }
#define WSB (getargs().ws())
#define XBP ((bf16_t*)(getargs().ws() + O_XB) + 2 * 1024)
#define RSS ((float*)(getargs().ws() + O_ROWSS))
#define HFP (getargs().out())
__global__ void __launch_bounds__(512, 2) fwd_kernel(Args a_unused) {
    extern __shared__ __attribute__((aligned(16))) unsigned char shm[];
    LAS unsigned char* lds = (LAS unsigned char*)shm;
    const int wv = __builtin_amdgcn_readfirstlane(threadIdx.x >> 6);
#define BARW ((unsigned*)(getargs().ws() + O_BAR))
#define BARST ((volatile LAS unsigned*)(lds + 139264))
#define GSYNC() xcd_barrier(wv, BARW, BARST)
    { unsigned* barw0 = BARW; if (threadIdx.x == 0) { BARST[0] = 0u; BARST[1] = 0u; (void)xb_add(&barw0[XB_XCNT(xb_xcc_id())], 1u); } }
    if (getargs().p->pad == 0x7fffffff) cg::this_grid().sync();

#if !(DIS & (1u << 0))
    for (int rep_ = 0; rep_ < ((REP >> 0) & 1u) + 1; ++rep_) { const int dry_ = rep_ < (int)((REP >> 0) & 1u); (void)dry_;
    phase_prologue(wv, getargs(), lds, dry_ ? PROPART : 7);
    }
#endif
    GSYNC();
#if !(DIS & (1u << 1))
    for (int rep_ = 0; rep_ < ((REP >> 1) & 1u) + 1; ++rep_) { const int dry_ = rep_ < (int)((REP >> 1) & 1u); (void)dry_;
    { EpiRowBf16<1> E{(bf16_t*)(WSB + O_Z), 1536, RSS};
      pg8::gemm_phase<false>(wv, lds, XBP, 1024, (const bf16_t*)(WSB + O_W1T), 1024, 1024, 64, 6, E); }
    }
#endif
    GSYNC();
#if !(DIS & (1u << 2))
    for (int rep_ = 0; rep_ < ((REP >> 2) & 1u) + 1; ++rep_) { const int dry_ = rep_ < (int)((REP >> 2) & 1u); (void)dry_;
    phase_l0_prep(wv, getargs());
    }
#endif
    GSYNC();
#if !(DIS & (1u << 3))
    for (int rep_ = 0; rep_ < ((REP >> 3) & 1u) + 1; ++rep_) { const int dry_ = rep_ < (int)((REP >> 3) & 1u); (void)dry_;
    { EpiRowBf16<0> E{(bf16_t*)(WSB + O_RI), 1024, nullptr};
      pg8::gemm_phase<false>(wv, lds, (const bf16_t*)(WSB + O_XC), 512, (const bf16_t*)(WSB + O_WRIT), 512, 512, 64, 4, E); }
    }
#endif
#if !(DIS & (1u << 4))
    for (int rep_ = 0; rep_ < ((REP >> 4) & 1u) + 1; ++rep_) { const int dry_ = rep_ < (int)((REP >> 4) & 1u); (void)dry_;
    { EpiQ E{(bf16_t*)(WSB + O_QB), (const float*)(WSB + O_RSQ), (const float*)(WSB + O_CSTAB)};
      pg8::gemm_phase<false>(wv, lds, (const bf16_t*)(WSB + O_Z) + 1024, 1536, (const bf16_t*)(WSB + O_WQT), 256, 256, 64, 3, E); }
    }
#endif
#if !(DIS & (1u << 5))
    for (int rep_ = 0; rep_ < ((REP >> 5) & 1u) + 1; ++rep_) { const int dry_ = rep_ < (int)((REP >> 5) & 1u); (void)dry_;
    { EpiK E{(bf16_t*)(WSB + O_KB), (const float*)(WSB + O_RSKV)};
      pg8::gemm_phase<false>(wv, lds, (const bf16_t*)(WSB + O_Z) + 1280, 1536, (const bf16_t*)(WSB + O_WKT), 256, 256, 64, 2, E); }
    }
#endif
#if !(DIS & (1u << 6))
    for (int rep_ = 0; rep_ < ((REP >> 6) & 1u) + 1; ++rep_) { const int dry_ = rep_ < (int)((REP >> 6) & 1u); (void)dry_;
    { EpiColBf16<2> E{(bf16_t*)(WSB + O_VT), S, (const float*)(WSB + O_RSKV)};
      pg8::gemm_phase<false>(wv, lds, (const bf16_t*)(WSB + O_WVT), 256, (const bf16_t*)(WSB + O_Z) + 1280, 1536, 256, 2, 64, E); }
    }
#endif
    GSYNC();
#if !(DIS & (1u << 7))
    for (int rep_ = 0; rep_ < ((REP >> 7) & 1u) + 1; ++rep_) { const int dry_ = rep_ < (int)((REP >> 7) & 1u); (void)dry_;
    phase_lru_s1(wv, getargs());
    }
#endif
    GSYNC();
#if !(DIS & (1u << 8))
    for (int rep_ = 0; rep_ < ((REP >> 8) & 1u) + 1; ++rep_) { const int dry_ = rep_ < (int)((REP >> 8) & 1u); (void)dry_;
    phase_lru_s3(wv, getargs());
    }
#endif
#if !(DIS & (1u << 9))
    for (int rep_ = 0; rep_ < ((REP >> 9) & 1u) + 1; ++rep_) { const int dry_ = rep_ < (int)((REP >> 9) & 1u); (void)dry_;
    phase_attn(wv, getargs(), lds);
    }
#endif
    GSYNC();
#if !(DIS & (1u << 10))
    for (int rep_ = 0; rep_ < ((REP >> 10) & 1u) + 1; ++rep_) { const int dry_ = rep_ < (int)((REP >> 10) & 1u); (void)dry_;
    { EpiRes E{getargs().in(0), HFP, XBP, RSS + 1 * S, dry_};
      pg8::gemm_phase<false>(wv, lds, (const bf16_t*)(WSB + O_MIX), 1024, (const bf16_t*)(WSB + O_WO1T), 1024, 1024, 64, 4, E); }
    }
#endif
    GSYNC();
#if !(DIS & (1u << 11))
    for (int rep_ = 0; rep_ < ((REP >> 11) & 1u) + 1; ++rep_) { const int dry_ = rep_ < (int)((REP >> 11) & 1u); (void)dry_;
    { EpiUp E{(bf16_t*)(WSB + O_ACT), RSS + 1 * S, getargs().in(24), getargs().in(25), lds + 131072};
      pg8::gemm_phase<true>(wv, lds, XBP, 1024, (const bf16_t*)(WSB + O_WUPT), 1024, 1024, 67, 22, E); }
    }
#endif
    GSYNC();
#if !(DIS & (1u << 12))
    for (int rep_ = 0; rep_ < ((REP >> 12) & 1u) + 1; ++rep_) { const int dry_ = rep_ < (int)((REP >> 12) & 1u); (void)dry_;
    { EpiRes E{HFP, HFP, XBP, RSS + 2 * S, dry_};
      pg8::gemm_phase<false>(wv, lds, (const bf16_t*)(WSB + O_ACT), 2816, (const bf16_t*)(WSB + O_WDNT), 2816, 2816, 64, 4, E); }
    }
#endif
    GSYNC();
#if !(DIS & (1u << 13))
    for (int rep_ = 0; rep_ < ((REP >> 13) & 1u) + 1; ++rep_) { const int dry_ = rep_ < (int)((REP >> 13) & 1u); (void)dry_;
    { EpiRowBf16<1> E{(bf16_t*)(WSB + O_QOK), 2048, RSS + 2 * S};
      pg8::gemm_phase<false>(wv, lds, XBP, 1024, (const bf16_t*)(WSB + O_WOINT), 1024, 1024, 64, 8, E); }
    }
#endif
#if !(DIS & (1u << 14))
    for (int rep_ = 0; rep_ < ((REP >> 14) & 1u) + 1; ++rep_) { const int dry_ = rep_ < (int)((REP >> 14) & 1u); (void)dry_;
    { EpiColBf16<1> E{(bf16_t*)(WSB + O_KVT), S, RSS + 2 * S};
      pg8::gemm_phase<false>(wv, lds, (const bf16_t*)(WSB + O_WOINT) + (size_t)1536 * 1024, 1024, XBP, 1024, 1024, 6, 64, E); }
    }
#endif
#if !(DIS & (1u << 15))
    for (int rep_ = 0; rep_ < ((REP >> 15) & 1u) + 1; ++rep_) { const int dry_ = rep_ < (int)((REP >> 15) & 1u); (void)dry_;
    phase_m_gates(wv, getargs(), lds);
    }
#endif
    GSYNC();
#if !(DIS & (1u << 16))
    for (int rep_ = 0; rep_ < ((REP >> 16) & 1u) + 1; ++rep_) { const int dry_ = rep_ < (int)((REP >> 16) & 1u); (void)dry_;
    phase_m_dc(wv, getargs());
    }
#endif
    GSYNC();
#if !(DIS & (1u << 22))
    for (int rep_ = 0; rep_ < ((REP >> 22) & 1u) + 1; ++rep_) { const int dry_ = rep_ < (int)((REP >> 22) & 1u); (void)dry_;
    phase_m_comb(wv, getargs(), lds, dry_);
    }
#endif
    GSYNC();
#if !(DIS & (1u << 17))
    for (int rep_ = 0; rep_ < ((REP >> 17) & 1u) + 1; ++rep_) { const int dry_ = rep_ < (int)((REP >> 17) & 1u); (void)dry_;
    phase_m_out(wv, getargs(), lds, dry_);
    }
#endif
    GSYNC();
#if !(DIS & (1u << 18))
    for (int rep_ = 0; rep_ < ((REP >> 18) & 1u) + 1; ++rep_) { const int dry_ = rep_ < (int)((REP >> 18) & 1u); (void)dry_;
    { EpiRes E{HFP, HFP, XBP, RSS + 3 * S, dry_};
      pg8::gemm_phase<false>(wv, lds, (const bf16_t*)(WSB + O_QOK) + 512, 2048, (const bf16_t*)(WSB + O_WO2T), 1024, 1024, 64, 4, E); }
    }
#endif
    GSYNC();
#if !(DIS & (1u << 19))
    for (int rep_ = 0; rep_ < ((REP >> 19) & 1u) + 1; ++rep_) { const int dry_ = rep_ < (int)((REP >> 19) & 1u); (void)dry_;
    { EpiUp E{(bf16_t*)(WSB + O_ACT), RSS + 3 * S, getargs().in(24) + 3 * 5632, getargs().in(25) + 5632, lds + 131072};
      pg8::gemm_phase<true>(wv, lds, XBP, 1024, (const bf16_t*)(WSB + O_WUPT + SZ_WUPT), 1024, 1024, 67, 22, E); }
    }
#endif
    GSYNC();
#if !(DIS & (1u << 20))
    for (int rep_ = 0; rep_ < ((REP >> 20) & 1u) + 1; ++rep_) { const int dry_ = rep_ < (int)((REP >> 20) & 1u); (void)dry_;
    { EpiRes E{HFP, HFP, XBP, RSS + 4 * S, dry_};
      pg8::gemm_phase<false>(wv, lds, (const bf16_t*)(WSB + O_ACT), 2816, (const bf16_t*)(WSB + O_WDNT + SZ_WDNT), 2816, 2816, 64, 4, E); }
    }
#endif
    GSYNC();
#if !(DIS & (1u << 21))
    for (int rep_ = 0; rep_ < ((REP >> 21) & 1u) + 1; ++rep_) { const int dry_ = rep_ < (int)((REP >> 21) & 1u); (void)dry_;
    phase_final(wv, getargs());
    }
#endif
    for (int i = 0; i < XSYNC; ++i) GSYNC();
}

extern "C" void kernel_launch(void* const* d_in, const int* in_sizes, int n_in, void* d_out, int out_size, void* d_ws, size_t ws_size, hipStream_t stream) {
    static int grid = 0;
    if (grid == 0) {
        if (n_in != 28 || out_size != S * 1024 || ws_size < WS_NEED) { fprintf(stderr, "kernel_launch: unexpected shapes (n_in %d out %d ws %zu need %zu)\n", n_in, out_size, ws_size, (size_t)WS_NEED); grid = -1; return; }
        int dev = 0, cus = 0, per_cu = 0;
        (void)hipGetDevice(&dev);
        (void)hipDeviceGetAttribute(&cus, hipDeviceAttributeMultiprocessorCount, dev);
        if (hipFuncSetAttribute((const void*)fwd_kernel, hipFuncAttributeMaxDynamicSharedMemorySize, LDS_BYTES) != hipSuccess) { fprintf(stderr, "kernel_launch: hipFuncSetAttribute failed\n"); grid = -1; return; }
        if (hipOccupancyMaxActiveBlocksPerMultiprocessor(&per_cu, (const void*)fwd_kernel, 512, LDS_BYTES) != hipSuccess || per_cu < 1) { fprintf(stderr, "kernel_launch: occupancy query says %d\n", per_cu); per_cu = 1; }
        (void)hipGetLastError();
        grid = cus * 1;
        if (grid > 256) grid = 256;
    }
    if (grid < 0) return;
    Args a{};
    for (int i = 0; i < 28; ++i) a.in[i] = (const float*)d_in[i];
    a.out = (float*)d_out; a.ws = (unsigned char*)d_ws;
    if (hipMemsetAsync((char*)d_ws + O_BAR, 0, BAR_BYTES, stream) != hipSuccess) { fprintf(stderr, "kernel_launch: memset failed\n"); return; }
    void* args[] = {&a};
    hipError_t e = hipLaunchCooperativeKernel((void*)fwd_kernel, dim3(grid), dim3(512), args, LDS_BYTES, stream);
    if (e != hipSuccess) fprintf(stderr, "kernel_launch: cooperative launch failed: %s (grid %d)\n", hipGetErrorString(e), grid);
}
```

```cpp
#include <hip/hip_runtime.h>
#include <hip/hip_cooperative_groups.h>
#include <cstdio>
#include <cstdint>
namespace cg = cooperative_groups;

typedef unsigned short bf16_t;
typedef short bf16x8 __attribute__((ext_vector_type(8)));
typedef short s16x4 __attribute__((ext_vector_type(4)));
typedef float f32x2 __attribute__((ext_vector_type(2)));
typedef float f32x4 __attribute__((ext_vector_type(4)));
typedef float f32x16 __attribute__((ext_vector_type(16)));
typedef unsigned u32x2 __attribute__((ext_vector_type(2)));
typedef unsigned u32x4 __attribute__((ext_vector_type(4)));
typedef __bf16 bf16x2_t __attribute__((ext_vector_type(2)));
#define LAS __attribute__((address_space(3)))
#define DI __device__ __forceinline__

constexpr int S = 16384;
constexpr float EPS = 1e-6f;
constexpr float LOG2E = 1.4426950408889634f;

constexpr size_t O_W1T = 0;
constexpr size_t O_WQT = O_W1T + (size_t)1536 * 1024 * 2;
constexpr size_t O_WKT = O_WQT + (size_t)768 * 256 * 2;
constexpr size_t O_WVT = O_WKT + (size_t)512 * 256 * 2;
constexpr size_t O_WRIT = O_WVT + (size_t)512 * 256 * 2;
constexpr size_t O_WO1T = O_WRIT + (size_t)1024 * 512 * 2;
constexpr size_t O_WUPT = O_WO1T + (size_t)1024 * 1024 * 2;
constexpr size_t SZ_WUPT = (size_t)5632 * 1024 * 2;
constexpr size_t O_WDNT = O_WUPT + 2 * SZ_WUPT;
constexpr size_t SZ_WDNT = (size_t)1024 * 2816 * 2;
constexpr size_t O_WOINT = O_WDNT + 2 * SZ_WDNT;
constexpr size_t O_WO2T = O_WOINT + (size_t)3072 * 1024 * 2;
constexpr size_t O_ROWSS = O_WO2T + (size_t)1024 * 1024 * 2;
constexpr size_t O_RSQ = O_ROWSS + (size_t)5 * S * 4;
constexpr size_t O_RSKV = O_RSQ + (size_t)S * 4;
constexpr size_t O_CSTAB = O_RSKV + (size_t)S * 4;
constexpr size_t O_CHA = O_CSTAB + (size_t)S * 32 * 4;
constexpr size_t O_CHH = O_CHA + (size_t)256 * 512 * 4;
constexpr size_t O_GB = O_CHH + (size_t)256 * 512 * 4;
constexpr size_t O_GE = O_GB + (size_t)4 * S * 4;
constexpr size_t O_GPM = O_GE + (size_t)4 * S * 4;
constexpr size_t O_BL = O_GPM + (size_t)4 * S * 4;
constexpr size_t O_ML = O_BL + 4096;
constexpr size_t O_MST = O_ML + 4096;
constexpr size_t O_NST = O_MST + 4096;
constexpr size_t O_BAR = O_NST + (size_t)256 * 4 * 128 * 4;
constexpr size_t BAR_BYTES = 16384;
constexpr size_t O_XB = O_BAR + BAR_BYTES;
constexpr size_t XB_ROWS = 16648;
constexpr size_t O_ARENA = O_XB + XB_ROWS * 2048;
constexpr size_t O_Z = O_ARENA;
constexpr size_t O_XC = O_Z + (size_t)S * 1536 * 2;
constexpr size_t O_QB = O_XC + (size_t)S * 512 * 2;
constexpr size_t O_KB = O_QB + (size_t)8 * S * 96 * 2;
constexpr size_t O_VT = O_KB + (size_t)8 * S * 96 * 2;
constexpr size_t O_MIX = O_VT + (size_t)512 * S * 2;
constexpr size_t O_END0 = O_MIX + (size_t)S * 1024 * 2;
constexpr size_t O_ACT = O_ARENA;
constexpr size_t O_RI = O_XB;
constexpr size_t O_CST = O_XB;
constexpr size_t O_QOK = O_CST + (size_t)256 * 4 * 256 * 128 * 2;
constexpr size_t O_KVT = O_QOK + (size_t)S * 2048 * 2;
constexpr size_t O_END1 = O_KVT + (size_t)1536 * S * 2;
constexpr size_t WS_NEED = (O_END0 > O_END1 ? O_END0 : O_END1);
static_assert(WS_NEED <= (size_t)268435456, "workspace");
static_assert(O_QOK >= O_ARENA, "QOK must not overlap XB");
static_assert(O_ACT + (size_t)(S + 240) * 2816 * 2 <= (size_t)268435456, "act");

constexpr int LDS_BYTES = 147456;

struct Args {
    const float* in[28];
    float* out;
    unsigned char* ws;
    int pad; int pad2;
};

struct ArgP { const __attribute__((address_space(4))) Args* p;
    DI const float* in(int i) const { return p->in[i]; } DI float* out() const { return p->out; } DI unsigned char* ws() const { return p->ws; } };
DI unsigned pk2(float lo, float hi) { f32x2 v = {lo, hi}; bf16x2_t b = __builtin_convertvector(v, bf16x2_t); return __builtin_bit_cast(unsigned, b); }
DI bf16_t f2bf(float f) { return (bf16_t)(pk2(f, 0.f) & 0xffffu); }
DI int ltid(int wv) { asm volatile("" : "+s"(wv)); int l = __builtin_amdgcn_mbcnt_hi(~0u, __builtin_amdgcn_mbcnt_lo(~0u, 0u)); return wv * 64 + l; }
DI int lbid() { int t = blockIdx.x; asm volatile("" : "+s"(t)); return t; }
DI float bf2f(bf16_t b) { return __uint_as_float(((unsigned)b) << 16); }
DI float bflo(unsigned u) { return __uint_as_float(u << 16); }
DI float bfhi(unsigned u) { return __uint_as_float(u & 0xffff0000u); }
DI float wave_sum(float v) {
#pragma unroll
    for (int o = 1; o < 64; o <<= 1) v += __shfl_xor(v, o);
    return v;
}
DI float fexp(float x) { return __builtin_amdgcn_exp2f(x * LOG2E); }
DI float sigmoidf_(float x) { return __builtin_amdgcn_rcpf(1.f + fexp(-x)); }
DI int crow(int r, int hi) { return (r & 3) + 8 * (r >> 2) + 4 * hi; }
DI float rs_from_ss(float ss) { return rsqrtf(ss * (1.f / 1024.f) + EPS); }

namespace pg8 {
constexpr int BM = 256, BK = 64, HALF = 128, HTB = HALF * BK * 2, STAGE_BYTES = 8 * HTB, NXCD = 8, WGM = 8;
DI int lds_byte(int r, int c) { const int st = (r >> 4) * 2 + (c >> 5), rr = r & 15, cc = c & 31, ob = rr * 64 + cc * 2; return st * 1024 + (ob ^ (((ob >> 9) & 1) << 5)); }
DI void stage_rc(int b, int& R, int& C) { const int st = b / 1024, sb = b % 1024, swz = sb ^ (((sb >> 9) & 1) << 5); R = (st >> 1) * 16 + swz / 64; C = (st & 1) * 32 + (swz % 64) / 2; }
DI int perm32(int rho) { const int n = rho >> 4, i = rho & 15; return 8 * (i >> 2) + 4 * n + (i & 3); }
struct Unit { int pm, pn; };
struct StaticOrder {
    int nM, nN, nwg, G, c;
    DI void init(int nM_, int nN_, int G_, int c_) { nM = nM_; nN = nN_; nwg = nM * nN; G = G_; c = c_; }
    DI bool next(int i, Unit& u) const {
        const long L = (long)i * G + c; if (L >= nwg) return false;
        int wgid = (int)L; { const int q = nwg / NXCD, r = nwg % NXCD, xcd = wgid % NXCD, off = wgid / NXCD; wgid = (xcd < r ? xcd * (q + 1) : r * (q + 1) + (xcd - r) * q) + off; }
        const int nig = WGM * nN, gid = wgid / nig, fm = gid * WGM, gsz = (nM - fm) < WGM ? (nM - fm) : WGM;
        u.pm = fm + ((wgid % nig) % gsz); u.pn = (wgid % nig) / gsz; return true;
    }
};

template <bool AMAP, class Epi>
DI void gemm_phase(int wv, LAS unsigned char* lds, const bf16_t* A, int lda, const bf16_t* Bt, int ldb, int K_, int nM, int nN, const Epi& E, int rot = 0) {
    int K = K_; asm volatile("" : "+s"(K));
    const int tid = ltid(wv), wid = __builtin_amdgcn_readfirstlane(tid >> 6), lane = tid & 63, wr = wid >> 2, wc = wid & 3, fr = lane & 15, fq = lane >> 4;
    const int nt = K / BK;
    StaticOrder SO; { int c_ = lbid() - rot; if (c_ < 0) c_ += (int)gridDim.x; SO.init(nM, nN, (int)gridDim.x, c_); }
    unsigned voffA[2], voffB[2];
#pragma unroll
    for (int i = 0; i < 2; ++i) { int R, C; stage_rc(tid * 16 + i * 8192, R, C); const int Rb = (R & ~31) + perm32(R & 31);
        const int Ra = AMAP ? (62 * (R >> 6) + (R & 63) - 2) : R;
        voffA[i] = (unsigned)((Ra + (AMAP ? 2 : 0)) * lda + C) * 2u; voffB[i] = (unsigned)(Rb * ldb + C) * 2u; }
    const size_t kstep = (size_t)(BK * 2);
    const size_t hstepA = (size_t)(AMAP ? 124 : 128) * lda * 2, hstepB = (size_t)HALF * ldb * 2;
    const size_t tstepA = 2 * hstepA, tstepB = 2 * hstepB;
    const unsigned ldsw = (unsigned)wid * 1024u;
    const int aoff = lds_byte(wr * 64 + fr, fq * 8), boff = lds_byte(wc * 32 + fr, fq * 8);
#define PG8_SA(b, h) (((b) * 2 + (h)) * HTB)
#define PG8_SB(b, h) ((4 + (b) * 2 + (h)) * HTB)
#define PG8_STAGE(bufoff, gbase, voff) do { _Pragma("unroll") for (int _i = 0; _i < 2; ++_i) \
        __builtin_amdgcn_global_load_lds((const unsigned*)((const char*)(gbase) + (voff)[_i]), (LAS unsigned*)(lds + (bufoff) + ldsw + _i * 8192), 16, 0, 0); } while (0)
#define PG8_LDA(dst, b, h) do { _Pragma("unroll") for (int m = 0; m < 4; ++m) _Pragma("unroll") for (int k = 0; k < 2; ++k) dst[m][k] = *(const LAS bf16x8*)(lds + PG8_SA(b, h) + aoff + m * 2048 + k * 1024); } while (0)
#define PG8_LDB(dst, b, h) do { _Pragma("unroll") for (int n = 0; n < 2; ++n) _Pragma("unroll") for (int k = 0; k < 2; ++k) dst[n][k] = *(const LAS bf16x8*)(lds + PG8_SB(b, h) + boff + n * 2048 + k * 1024); } while (0)
#define PG8_MMA(ai, bj, At, Bt_) do { __builtin_amdgcn_s_setprio(1); _Pragma("unroll") for (int m = 0; m < 4; ++m) _Pragma("unroll") for (int n = 0; n < 2; ++n) _Pragma("unroll") for (int k = 0; k < 2; ++k) \
        acc[ai][bj][m][n] = __builtin_amdgcn_mfma_f32_16x16x32_bf16(Bt_[n][k], At[m][k], acc[ai][bj][m][n], 0, 0, 0); __builtin_amdgcn_s_setprio(0); } while (0)
#define PG8_WAIT_V(n) asm volatile("s_waitcnt vmcnt(" #n ")" ::: "memory")
#define PG8_WAIT_L(n) asm volatile("s_waitcnt lgkmcnt(" #n ")" ::: "memory")
#define PG8_BAR __builtin_amdgcn_s_barrier()
#define PG8_SCHED __builtin_amdgcn_sched_barrier(0)
    if (AMAP) A -= 2 * lda;
    Unit cur, nxt; int ui = 0;
    if (!SO.next(0, cur)) return;
    f32x4 acc[2][2][4][2];
#pragma unroll
    for (int a = 0; a < 2; ++a)
#pragma unroll
        for (int b = 0; b < 2; ++b)
#pragma unroll
            for (int m = 0; m < 4; ++m)
#pragma unroll
                for (int n = 0; n < 2; ++n) acc[a][b][m][n] = (f32x4){0.f, 0.f, 0.f, 0.f};
    bf16x8 At[4][2], B0[2][2], B1[2][2];
    const char* cA = (const char*)A + (size_t)cur.pm * tstepA; const char* cB = (const char*)Bt + (size_t)cur.pn * tstepB;
    PG8_STAGE(PG8_SB(0, 0), cB, voffB); PG8_STAGE(PG8_SA(0, 0), cA, voffA); PG8_STAGE(PG8_SB(0, 1), cB + hstepB, voffB); PG8_STAGE(PG8_SA(0, 1), cA + hstepA, voffA);
    if (wr == 1) PG8_BAR;
    PG8_WAIT_V(4); PG8_BAR;
    PG8_STAGE(PG8_SB(1, 0), cB + kstep, voffB); PG8_STAGE(PG8_SA(1, 0), cA + kstep, voffA); PG8_STAGE(PG8_SB(1, 1), cB + hstepB + kstep, voffB);
    PG8_WAIT_V(6); PG8_BAR;
    for (;;) {
        const bool has_next = SO.next(ui + 1, nxt);
        const char* nA = has_next ? (const char*)A + (size_t)nxt.pm * tstepA : cA; const char* nB = has_next ? (const char*)Bt + (size_t)nxt.pn * tstepB : cB;
        for (int t = 0; t < nt; t += 2) {
            const bool last = (t == nt - 2);
            const char* a1 = cA + (size_t)(t + 1) * kstep;
            const char* a2 = last ? nA : cA + (size_t)(t + 2) * kstep; const char* b2 = last ? nB : cB + (size_t)(t + 2) * kstep;
            const char* a3 = a2 + kstep; const char* b3 = b2 + kstep;
            PG8_LDB(B0, 0, 0); PG8_SCHED; PG8_LDA(At, 0, 0); PG8_STAGE(PG8_SA(1, 1), a1 + hstepA, voffA);
            PG8_WAIT_L(8); PG8_BAR; PG8_WAIT_L(0); PG8_MMA(0, 0, At, B0); PG8_BAR; PG8_SCHED;
            PG8_LDB(B1, 0, 1); PG8_STAGE(PG8_SB(0, 0), b2, voffB);
            PG8_BAR; PG8_WAIT_L(0); PG8_MMA(0, 1, At, B1); PG8_BAR;
            PG8_LDA(At, 0, 1); PG8_STAGE(PG8_SA(0, 0), a2, voffA);
            PG8_BAR; PG8_WAIT_L(0); PG8_MMA(1, 0, At, B0); PG8_BAR; PG8_SCHED;
            PG8_STAGE(PG8_SB(0, 1), b2 + hstepB, voffB);
            PG8_WAIT_V(6); PG8_BAR; PG8_MMA(1, 1, At, B1); PG8_BAR;
            PG8_LDB(B0, 1, 0); PG8_SCHED; PG8_LDA(At, 1, 0); PG8_STAGE(PG8_SA(0, 1), a2 + hstepA, voffA);
            PG8_WAIT_L(8); PG8_BAR; PG8_WAIT_L(0); PG8_MMA(0, 0, At, B0); PG8_BAR; PG8_SCHED;
            PG8_LDB(B1, 1, 1); PG8_STAGE(PG8_SB(1, 0), b3, voffB);
            PG8_BAR; PG8_WAIT_L(0); PG8_MMA(0, 1, At, B1); PG8_BAR;
            PG8_LDA(At, 1, 1); PG8_STAGE(PG8_SA(1, 0), a3, voffA);
            PG8_BAR; PG8_WAIT_L(0); PG8_MMA(1, 0, At, B0); PG8_BAR; PG8_SCHED;
            PG8_STAGE(PG8_SB(1, 1), b3 + hstepB, voffB);
            PG8_WAIT_V(6); PG8_BAR; PG8_MMA(1, 1, At, B1); PG8_BAR;
        }
        E(acc, cur, wr, wc, fr, fq);
        if (!has_next) break;
#pragma unroll
        for (int a = 0; a < 2; ++a)
#pragma unroll
            for (int b = 0; b < 2; ++b)
#pragma unroll
                for (int m = 0; m < 4; ++m)
#pragma unroll
                    for (int n = 0; n < 2; ++n) acc[a][b][m][n] = (f32x4){0.f, 0.f, 0.f, 0.f};
        cur = nxt; cA = nA; cB = nB; ++ui;
    }
    PG8_WAIT_V(0);
    if (wr == 0) PG8_BAR;
    PG8_BAR;
#undef PG8_SA
#undef PG8_SB
#undef PG8_STAGE
#undef PG8_LDA
#undef PG8_LDB
#undef PG8_MMA
#undef PG8_WAIT_V
#undef PG8_WAIT_L
#undef PG8_BAR
#undef PG8_SCHED
}
}
using pg8::Unit;
typedef f32x4 AccT[2][2][4][2];

template <int SMODE> struct EpiRowBf16 {
    bf16_t* O; int ldc; const float* sc;
    DI void operator()(const AccT& acc, const Unit& u, int wr, int wc, int fr, int fq) const {
        const int row0 = u.pm * 256 + wr * 64 + fr, col0 = u.pn * 256 + wc * 32 + 8 * fq;
#pragma unroll
        for (int ai = 0; ai < 2; ++ai)
#pragma unroll
            for (int m = 0; m < 4; ++m) { const int row = row0 + ai * 128 + m * 16;
                float s = 1.f; if (SMODE == 1) s = rs_from_ss(sc[row]); if (SMODE == 2) s = sc[row];
                bf16_t* rowp = O + (size_t)row * ldc + col0;
#pragma unroll
                for (int bj = 0; bj < 2; ++bj) { const f32x4 v0 = acc[ai][bj][m][0] * s, v1 = acc[ai][bj][m][1] * s;
                    u32x4 w; w.x = pk2(v0[0], v0[1]); w.y = pk2(v0[2], v0[3]); w.z = pk2(v1[0], v1[1]); w.w = pk2(v1[2], v1[3]);
                    *(u32x4*)(rowp + bj * 128) = w; } }
    }
};
template <int SMODE> struct EpiColBf16 {
    bf16_t* O; int ldc; const float* sc;
    DI void operator()(const AccT& acc, const Unit& u, int wr, int wc, int fr, int fq) const {
        const int row0 = u.pm * 256 + wr * 64 + fr, col0 = u.pn * 256 + wc * 32 + 8 * fq;
#pragma unroll
        for (int bj = 0; bj < 2; ++bj) { float s[8];
#pragma unroll
            for (int j = 0; j < 8; ++j) { const float x = sc[col0 + bj * 128 + j]; s[j] = (SMODE == 1) ? rs_from_ss(x) : x; }
#pragma unroll
            for (int ai = 0; ai < 2; ++ai)
#pragma unroll
                for (int m = 0; m < 4; ++m) { const int row = row0 + ai * 128 + m * 16; const f32x4 v0 = acc[ai][bj][m][0], v1 = acc[ai][bj][m][1];
                    u32x4 w; w.x = pk2(v0[0] * s[0], v0[1] * s[1]); w.y = pk2(v0[2] * s[2], v0[3] * s[3]); w.z = pk2(v1[0] * s[4], v1[1] * s[5]); w.w = pk2(v1[2] * s[6], v1[3] * s[7]);
                    *(u32x4*)(O + (size_t)row * ldc + col0 + bj * 128) = w; } }
    }
};
struct EpiQ {
    bf16_t* QB; const float* rsq; const float* cstab;
    DI void operator()(const AccT& acc, const Unit& u, int wr, int wc, int fr, int fq) const {
        const int row0 = u.pm * 256 + wr * 64 + fr, col0 = u.pn * 256 + wc * 32 + 8 * fq;
        const float QS = 0.10206207261596577f * LOG2E;
#pragma unroll
        for (int ai = 0; ai < 2; ++ai)
#pragma unroll
            for (int m = 0; m < 4; ++m) { const int t = row0 + ai * 128 + m * 16; const float s = rsq[t] * QS;
#pragma unroll
                for (int bj = 0; bj < 2; ++bj) { const int c = col0 + bj * 128, h = c / 96, d = c - h * 96;
                    f32x4 v0 = acc[ai][bj][m][0] * s, v1 = acc[ai][bj][m][1] * s;
                    if (d >= 64) { const int i0 = (d - 64) >> 1; const f32x4 cs0 = *(const f32x4*)(cstab + (size_t)t * 32 + 2 * i0), cs1 = *(const f32x4*)(cstab + (size_t)t * 32 + 2 * i0 + 4);
                        f32x4 a, b;
                        a[0] = v0[0] * cs0[0] - v0[1] * cs0[1]; a[1] = v0[1] * cs0[0] + v0[0] * cs0[1];
                        a[2] = v0[2] * cs0[2] - v0[3] * cs0[3]; a[3] = v0[3] * cs0[2] + v0[2] * cs0[3];
                        b[0] = v1[0] * cs1[0] - v1[1] * cs1[1]; b[1] = v1[1] * cs1[0] + v1[0] * cs1[1];
                        b[2] = v1[2] * cs1[2] - v1[3] * cs1[3]; b[3] = v1[3] * cs1[2] + v1[2] * cs1[3];
                        v0 = a; v1 = b; }
                    u32x4 w; w.x = pk2(v0[0], v0[1]); w.y = pk2(v0[2], v0[3]); w.z = pk2(v1[0], v1[1]); w.w = pk2(v1[2], v1[3]);
                    *(u32x4*)(QB + ((size_t)h * S + t) * 96 + d) = w; } }
    }
};
struct EpiK {
    bf16_t* KB; const float* rskv;
    DI void operator()(const AccT& acc, const Unit& u, int wr, int wc, int fr, int fq) const {
        const int row0 = u.pm * 256 + wr * 64 + fr, col0 = u.pn * 256 + wc * 32 + 8 * fq;
#pragma unroll
        for (int ai = 0; ai < 2; ++ai)
#pragma unroll
            for (int m = 0; m < 4; ++m) { const int t = row0 + ai * 128 + m * 16; const float s = rskv[t];
#pragma unroll
                for (int bj = 0; bj < 2; ++bj) { const int c = col0 + bj * 128, h = c >> 6, d = c & 63;
                    const f32x4 v0 = acc[ai][bj][m][0] * s, v1 = acc[ai][bj][m][1] * s;
                    u32x4 w; w.x = pk2(v0[0], v0[1]); w.y = pk2(v0[2], v0[3]); w.z = pk2(v1[0], v1[1]); w.w = pk2(v1[2], v1[3]);
                    *(u32x4*)(KB + ((size_t)h * S + t) * 96 + d) = w; } }
    }
};
struct EpiRes {
    const float* res; float* HF; bf16_t* XB; float* rowss; int dry;
    DI void operator()(const AccT& acc, const Unit& u, int wr, int wc, int fr, int fq) const {
        const int row0 = u.pm * 256 + wr * 64 + fr, col0 = u.pn * 256 + wc * 32 + 8 * fq;
#pragma unroll
        for (int ai = 0; ai < 2; ++ai)
#pragma unroll
            for (int m = 0; m < 4; ++m) { const int t = row0 + ai * 128 + m * 16; float ss = 0.f;
#pragma unroll
                for (int bj = 0; bj < 2; ++bj) { const size_t o = (size_t)t * 1024 + col0 + bj * 128;
                    const f32x4 r0 = *(const f32x4*)(res + o), r1 = *(const f32x4*)(res + o + 4);
                    const f32x4 v0 = acc[ai][bj][m][0] + r0, v1 = acc[ai][bj][m][1] + r1;
                    if (!dry) { *(f32x4*)(HF + o) = v0; *(f32x4*)(HF + o + 4) = v1; }
                    u32x4 w; w.x = pk2(v0[0], v0[1]); w.y = pk2(v0[2], v0[3]); w.z = pk2(v1[0], v1[1]); w.w = pk2(v1[2], v1[3]);
                    if (!dry) *(u32x4*)(XB + o) = w;
                    ss += v0[0] * v0[0] + v0[1] * v0[1] + v0[2] * v0[2] + v0[3] * v0[3] + v1[0] * v1[0] + v1[1] * v1[1] + v1[2] * v1[2] + v1[3] * v1[3]; }
                ss += __shfl_xor(ss, 16); ss += __shfl_xor(ss, 32);
                if (fq == 0 && !dry) atomicAdd(rowss + t, ss); }
    }
};
DI float dpp_prev1(float cur, float prevm) {
    const int o = __builtin_amdgcn_update_dpp(0, __builtin_bit_cast(int, prevm), 0x121, 0xf, 0xf, false);
    return __builtin_bit_cast(float, __builtin_amdgcn_update_dpp(o, __builtin_bit_cast(int, cur), 0x111, 0xf, 0xf, false));
}
DI float dpp_prev2(float cur, float prevm) {
    const int o = __builtin_amdgcn_update_dpp(0, __builtin_bit_cast(int, prevm), 0x122, 0xf, 0xf, false);
    return __builtin_bit_cast(float, __builtin_amdgcn_update_dpp(o, __builtin_bit_cast(int, cur), 0x112, 0xf, 0xf, false));
}
struct EpiUp {
    bf16_t* ACT; const float* rowss; const float* cw; const float* cb; LAS unsigned char* plds;
    DI void operator()(const AccT& acc, const Unit& u, int wr, int wc, int fr, int fq) const {
        const int cl = u.pn * 128 + wc * 32 + 8 * fq;
        LAS float* P = (LAS float*)(plds + (wr * 4 + wc) * 1024);
        { const int lane = fq * 16 + fr, kind = lane >> 3, c4 = 4 * (lane & 7), k3 = kind & 3;
          const float* src = (k3 == 0 ? cb : cw + (k3 - 1) * 5632) + (kind >= 4 ? 2816 : 0) + u.pn * 128 + wc * 32 + c4;
          *(LAS f32x4*)(P + kind * 32 + c4) = *(const f32x4*)src; }
#pragma unroll
        for (int ai = 0; ai < 2; ++ai) {
            const int tok0 = u.pm * 248 + 62 * (2 * ai + wr) - 2 + fr;
            float rs[4];
#pragma unroll
            for (int m = 0; m < 4; ++m) { const int t = tok0 + 16 * m; const int tc = t < 0 ? 0 : (t >= S ? S - 1 : t); const float r = rs_from_ss(rowss[tc]); rs[m] = t < 0 ? 0.f : r; }
            const int row0 = fr < 2 ? (S + 236 + fr) : tok0;
#pragma unroll
            for (int n = 0; n < 2; ++n) {
                const int lc = 8 * fq + 4 * n;
                unsigned wpk[4][2];
#pragma unroll
                for (int jp = 0; jp < 2; ++jp) {
                    const f32x2 bg = *(const LAS f32x2*)(P + lc + 2 * jp), g0 = *(const LAS f32x2*)(P + 32 + lc + 2 * jp), g1 = *(const LAS f32x2*)(P + 64 + lc + 2 * jp), g2 = *(const LAS f32x2*)(P + 96 + lc + 2 * jp);
                    const f32x2 bv = *(const LAS f32x2*)(P + 128 + lc + 2 * jp), v0 = *(const LAS f32x2*)(P + 160 + lc + 2 * jp), v1 = *(const LAS f32x2*)(P + 192 + lc + 2 * jp), v2 = *(const LAS f32x2*)(P + 224 + lc + 2 * jp);
                    f32x2 G[4], V[4];
#pragma unroll
                    for (int m = 0; m < 4; ++m) { G[m] = (f32x2){acc[ai][0][m][n][2 * jp], acc[ai][0][m][n][2 * jp + 1]} * rs[m]; V[m] = (f32x2){acc[ai][1][m][n][2 * jp], acc[ai][1][m][n][2 * jp + 1]} * rs[m]; }
#pragma unroll
                    for (int m = 0; m < 4; ++m) {
                        const f32x2 zz = {0.f, 0.f}; const f32x2 Gp = m ? G[m - 1] : zz, Vp = m ? V[m - 1] : zz;
                        const f32x2 gp1 = {dpp_prev1(G[m].x, Gp.x), dpp_prev1(G[m].y, Gp.y)}, gp2 = {dpp_prev2(G[m].x, Gp.x), dpp_prev2(G[m].y, Gp.y)};
                        const f32x2 vp1 = {dpp_prev1(V[m].x, Vp.x), dpp_prev1(V[m].y, Vp.y)}, vp2 = {dpp_prev2(V[m].x, Vp.x), dpp_prev2(V[m].y, Vp.y)};
                        const f32x2 gc = bg + g0 * gp2 + g1 * gp1 + g2 * G[m];
                        const f32x2 vc = bv + v0 * vp2 + v1 * vp1 + v2 * V[m];
                        const f32x2 xe = gc * (-LOG2E);
                        f32x2 dn = {__builtin_amdgcn_exp2f(xe.x), __builtin_amdgcn_exp2f(xe.y)}; dn = dn + 1.0f;
                        const f32x2 rc = {__builtin_amdgcn_rcpf(dn.x), __builtin_amdgcn_rcpf(dn.y)};
                        const f32x2 rr = gc * rc * vc;
                        wpk[m][jp] = pk2(rr.x, rr.y); }
                }
#pragma unroll
                for (int m = 0; m < 4; ++m) { const int row = m ? tok0 + 16 * m : row0;
                    *(u32x2*)(ACT + (size_t)row * 2816 + cl + 4 * n) = (u32x2){wpk[m][0], wpk[m][1]}; }
                __builtin_amdgcn_sched_barrier(0);
            }
        }
    }
};

template <class F> DI void tr_items(const F& f, int Kdst, int Nrows, bf16_t* WT, LAS float* scr, int gw, int NGW, int lane, int& cum) {
    const int nblk = Nrows / 32, nitems = (Kdst / 64) * nblk;
    int first = (gw - cum) % NGW; if (first < 0) first += NGW; cum = (cum + nitems) % NGW;
    for (int item = first; item < nitems; item += NGW) {
        const int kb = item / nblk, nb = item % nblk, k0 = 64 * kb, n0 = 32 * nb;
        float tv[32];
#pragma unroll
        for (int i = 0; i < 32; ++i) tv[i] = f(k0 + 2 * i + (lane >> 5), n0 + (lane & 31));
#pragma unroll
        for (int i = 0; i < 32; ++i) scr[(2 * i + (lane >> 5)) * 33 + (lane & 31)] = tv[i];
        asm volatile("s_waitcnt lgkmcnt(0)" ::: "memory");
        const int c = lane & 7;
#pragma unroll
        for (int j = 0; j < 4; ++j) { const int n = (lane >> 3) + 8 * j; const LAS float* s = scr + (8 * c) * 33 + n;
            u32x4 o; o.x = pk2(s[0 * 33], s[1 * 33]); o.y = pk2(s[2 * 33], s[3 * 33]); o.z = pk2(s[4 * 33], s[5 * 33]); o.w = pk2(s[6 * 33], s[7 * 33]);
            *(u32x4*)(WT + (size_t)(n0 + n) * Kdst + k0 + 8 * c) = o; }
        asm volatile("s_waitcnt lgkmcnt(0)" ::: "memory");
    }
}
struct FW1 { const float* W; const float* g; DI float operator()(int k, int n) const { return n < 1440 ? W[(size_t)k * 1440 + n] * g[k] : 0.f; } };
struct FWQ { const float* W; const float* g; DI float operator()(int k, int n) const { const int h = n / 96, d = n - h * 96; int c = d; if (d >= 64) { const int r = d - 64; c = 64 + (r >> 1) + 16 * (r & 1); } return W[(size_t)k * 768 + h * 96 + c] * g[k]; } };
struct FWKV { const float* W; const float* g; int off; DI float operator()(int k, int n) const { return k < 128 ? W[(size_t)k * 1024 + (n >> 6) * 128 + off + (n & 63)] * g[k] : 0.f; } };
struct FWRI { const float* Wa; const float* Wx; DI float operator()(int k, int n) const { const float* W = n < 512 ? Wa : Wx; const int ch = n & 511, g = ch >> 6, j = ch & 63; return (k >> 6) == g ? W[(size_t)k * 64 + j] : 0.f; } };
struct FWP { const float* W; int N; DI float operator()(int k, int n) const { return W[(size_t)k * N + n]; } };
struct FWUP { const float* W; const float* g; DI float operator()(int k, int n) const { const int pn = n >> 8, r = n & 255; const int c = r < 128 ? 128 * pn + r : 2816 + 128 * pn + r - 128; return W[(size_t)k * 5632 + c] * g[k]; } };
struct FWOIN { const float* W; const float* g; DI float operator()(int k, int n) const {
    int c; float s = 1.f; if (n < 512) { c = n; s = 0.08838834764831845f; } else if (n < 1536) c = 2048 + (n - 512); else if (n < 2048) c = 512 + (n - 1536); else c = 1024 + (n - 2048);
    return W[(size_t)k * 3080 + c] * g[k] * s; } };

#ifndef PROPART
#define PROPART 7
#endif
DI void phase_prologue(int wv, const ArgP a, LAS unsigned char* lds, int parts) {
    unsigned char* ws = a.ws();
    const int tid = ltid(wv), wave = tid >> 6, lane = tid & 63;
    LAS float* scr = (LAS float*)(lds + wave * 8448);
    const int gw = blockIdx.x * 8 + wave, NGW = gridDim.x * 8; int cum = 0;
    if (parts & 1) {
    { FW1 f{a.in(3), a.in(2)}; tr_items(f, 1024, 1536, (bf16_t*)(ws + O_W1T), scr, gw, NGW, lane, cum); }
    { FWQ f{a.in(12), a.in(11)}; tr_items(f, 256, 768, (bf16_t*)(ws + O_WQT), scr, gw, NGW, lane, cum); }
    { FWKV f{a.in(14), a.in(13), 0}; tr_items(f, 256, 512, (bf16_t*)(ws + O_WKT), scr, gw, NGW, lane, cum); }
    { FWKV f{a.in(14), a.in(13), 64}; tr_items(f, 256, 512, (bf16_t*)(ws + O_WVT), scr, gw, NGW, lane, cum); }
    { FWRI f{a.in(6), a.in(8)}; tr_items(f, 512, 1024, (bf16_t*)(ws + O_WRIT), scr, gw, NGW, lane, cum); }
    { FWP f{a.in(15), 1024}; tr_items(f, 1024, 1024, (bf16_t*)(ws + O_WO1T), scr, gw, NGW, lane, cum); }
    for (int l = 0; l < 2; ++l) {
        { FWUP f{a.in(23) + (size_t)l * 1024 * 5632, a.in(22) + l * 1024}; tr_items(f, 1024, 5632, (bf16_t*)(ws + O_WUPT + l * SZ_WUPT), scr, gw, NGW, lane, cum); }
        { FWP f{a.in(26) + (size_t)l * 2816 * 1024, 1024}; tr_items(f, 2816, 1024, (bf16_t*)(ws + O_WDNT + l * SZ_WDNT), scr, gw, NGW, lane, cum); }
    }
    { FWOIN f{a.in(17), a.in(16)}; tr_items(f, 1024, 3072, (bf16_t*)(ws + O_WOINT), scr, gw, NGW, lane, cum); }
    { FWP f{a.in(21), 1024}; tr_items(f, 1024, 1024, (bf16_t*)(ws + O_WO2T), scr, gw, NGW, lane, cum); }
    }
    if (parts & 2) {
    const float* x = a.in(0); bf16_t* XB = (bf16_t*)(ws + O_XB) + 2 * 1024; float* rowss = (float*)(ws + O_ROWSS);
#pragma unroll 4
    for (int t = gw; t < S; t += NGW) {
        float ss = 0.f;
#pragma unroll
        for (int j = 0; j < 4; ++j) { const f32x4 v = *(const f32x4*)(x + (size_t)t * 1024 + j * 256 + lane * 4);
            ss += v[0] * v[0] + v[1] * v[1] + v[2] * v[2] + v[3] * v[3];
            u32x2 w; w.x = pk2(v[0], v[1]); w.y = pk2(v[2], v[3]); *(u32x2*)(XB + (size_t)t * 1024 + j * 256 + lane * 4) = w; }
        ss = wave_sum(ss);
        if (lane == 0) rowss[t] = ss;
        if (lane >= 1 && lane < 5) rowss[(size_t)lane * S + t] = 0.f;
    }
    }
    if (parts & 4) {
    const int* pos = (const int*)a.in(1); float* cst = (float*)(ws + O_CSTAB);
    for (int e = blockIdx.x * 512 + tid; e < S * 16; e += gridDim.x * 512) { const int t = e >> 4, i = e & 15;
        const float invf = __builtin_amdgcn_exp2f(-(float)i * (13.287712379549449f / 16.f)); const float ang = (float)pos[t] * invf;
        const float k = rintf(ang * 0.15915494309189535f);
        float r = fmaf(-k, 6.28318548202514648f, ang); r = fmaf(-k, -1.7484555e-7f, r);
        const float rr = r * 0.15915494309189535f;
        cst[2 * e] = __builtin_amdgcn_cosf(rr); cst[2 * e + 1] = __builtin_amdgcn_sinf(rr); }
    }
}

DI void phase_l0_prep(int wv, const ArgP a) {
    unsigned char* ws = a.ws();
    const bf16_t* Z = (const bf16_t*)(ws + O_Z); bf16_t* XC = (bf16_t*)(ws + O_XC); bf16_t* KB = (bf16_t*)(ws + O_KB);
    float* rsq = (float*)(ws + O_RSQ); float* rskv = (float*)(ws + O_RSKV); const float* cst = (const float*)(ws + O_CSTAB);
    const float* cw = a.in(4); const float* cb = a.in(5);
    const int tid = ltid(wv), wave = tid >> 6, lane = tid & 63;
#pragma unroll 2
    for (int e = blockIdx.x * 512 + tid; e < S * 64; e += gridDim.x * 512) { const int t = e >> 6, c0 = (e & 63) * 8;
        float acc[8];
#pragma unroll
        for (int j = 0; j < 8; ++j) acc[j] = cb[c0 + j];
#pragma unroll
        for (int k = 0; k < 4; ++k) { const int tt = t - 3 + k; if (tt < 0) continue;
            const u32x4 v = *(const u32x4*)(Z + (size_t)tt * 1536 + c0);
            const f32x4 w0 = *(const f32x4*)(cw + k * 512 + c0), w1 = *(const f32x4*)(cw + k * 512 + c0 + 4);
            acc[0] += w0[0] * bflo(v.x); acc[1] += w0[1] * bfhi(v.x); acc[2] += w0[2] * bflo(v.y); acc[3] += w0[3] * bfhi(v.y);
            acc[4] += w1[0] * bflo(v.z); acc[5] += w1[1] * bfhi(v.z); acc[6] += w1[2] * bflo(v.w); acc[7] += w1[3] * bfhi(v.w); }
        u32x4 o; o.x = pk2(acc[0], acc[1]); o.y = pk2(acc[2], acc[3]); o.z = pk2(acc[4], acc[5]); o.w = pk2(acc[6], acc[7]);
        *(u32x4*)(XC + (size_t)t * 512 + c0) = o; }
#pragma unroll 4
    for (int t = blockIdx.x * 8 + wave; t < S; t += gridDim.x * 8) {
        const bf16_t* zr = Z + (size_t)t * 1536;
        float sq = 0.f, skv = 0.f;
        { const u32x2 v = *(const u32x2*)(zr + 1024 + lane * 4); const float p0 = bflo(v.x), p1 = bfhi(v.x), p2 = bflo(v.y), p3 = bfhi(v.y); sq = p0 * p0 + p1 * p1 + p2 * p2 + p3 * p3; }
        { const unsigned v = *(const unsigned*)(zr + 1280 + lane * 2); const float p0 = bflo(v), p1 = bfhi(v); skv = p0 * p0 + p1 * p1; }
        sq = wave_sum(sq); skv = wave_sum(skv);
        if (lane == 0) { rsq[t] = rsqrtf(sq * (1.f / 256.f) + EPS); rskv[t] = rsqrtf(skv * (1.f / 128.f) + EPS); }
        if (lane < 16) { const float x1 = bf2f(zr[1408 + lane]), x2 = bf2f(zr[1424 + lane]); const float c = cst[(size_t)t * 32 + 2 * lane], s = cst[(size_t)t * 32 + 2 * lane + 1];
            const unsigned w = pk2(x1 * c - x2 * s, x2 * c + x1 * s);
#pragma unroll
            for (int h = 0; h < 8; ++h) *(unsigned*)(KB + ((size_t)h * S + t) * 96 + 64 + 2 * lane) = w; }
    }
}

DI void lru_coeff(float rpre, float ipre, float xc, float sp8, float& av, float& uv) {
    const float r = sigmoidf_(rpre), ig = sigmoidf_(ipre);
    const float la = -sp8 * r;
    av = fexp(la);
    uv = sqrtf(fmaxf(-expm1f(2.f * la), 0.f)) * (ig * xc);
}
DI void phase_lru_s1(int wv, const ArgP a) {
    unsigned char* ws = a.ws(); const int ch = ltid(wv);
    const bf16_t* RI = (const bf16_t*)(ws + O_RI); const bf16_t* XC = (const bf16_t*)(ws + O_XC);
    float* CHA = (float*)(ws + O_CHA); float* CHH = (float*)(ws + O_CHH);
    const float ba = a.in(7)[ch], bx = a.in(9)[ch]; const float lam = a.in(10)[ch];
    const float sp8 = 8.f * log1pf(expf(-lam));
    for (int c = blockIdx.x; c < 256; c += gridDim.x) {
        float A = 1.f, H = 0.f;
#pragma unroll 8
        for (int i = 0; i < 64; ++i) { const size_t t = (size_t)c * 64 + i;
            float av, uv; lru_coeff(bf2f(RI[t * 1024 + ch]) + ba, bf2f(RI[t * 1024 + 512 + ch]) + bx, bf2f(XC[t * 512 + ch]), sp8, av, uv);
            A *= av; H = av * H + uv; }
        CHA[c * 512 + ch] = A; CHH[c * 512 + ch] = H;
    }
}
DI void phase_lru_s3(int wv, const ArgP a) {
    unsigned char* ws = a.ws(); const int ch = ltid(wv);
    const bf16_t* RI = (const bf16_t*)(ws + O_RI); const bf16_t* XC = (const bf16_t*)(ws + O_XC); const bf16_t* Z = (const bf16_t*)(ws + O_Z);
    const float* CHA = (const float*)(ws + O_CHA); const float* CHH = (const float*)(ws + O_CHH); bf16_t* MIX = (bf16_t*)(ws + O_MIX);
    const float ba = a.in(7)[ch], bx = a.in(9)[ch]; const float lam = a.in(10)[ch];
    const float sp8 = 8.f * log1pf(expf(-lam));
    for (int c = blockIdx.x; c < 256; c += gridDim.x) {
        float H = 0.f;
#pragma unroll 8
        for (int cc = 0; cc < c; ++cc) H = CHA[cc * 512 + ch] * H + CHH[cc * 512 + ch];
#pragma unroll 4
        for (int i = 0; i < 64; ++i) { const size_t t = (size_t)c * 64 + i;
            float av, uv; lru_coeff(bf2f(RI[t * 1024 + ch]) + ba, bf2f(RI[t * 1024 + 512 + ch]) + bx, bf2f(XC[t * 512 + ch]), sp8, av, uv);
            H = av * H + uv;
            const float g = bf2f(Z[t * 1536 + 512 + ch]);
            const float y = 0.7978845608028654f * (g + 0.044715f * g * g * g);
            const float th = 1.f - 2.f * __builtin_amdgcn_rcpf(1.f + fexp(2.f * y));
            MIX[t * 1024 + ch] = f2bf(H * 0.5f * g * (1.f + th)); }
    }
}

constexpr int AT_KROW = 208, AT_VROW = 136, AT_KT = 64 * AT_KROW, AT_VT = 64 * AT_VROW;
DI float rowmax32(const f32x16& p0, const f32x16& p1) {
    float a = fmaxf(fmaxf(p0[0], p0[1]), p1[0]), b = fmaxf(fmaxf(p0[2], p0[3]), p1[1]); a = fmaxf(fmaxf(a, p1[2]), p1[3]);
#pragma unroll
    for (int r = 4; r < 16; r += 4) { a = fmaxf(fmaxf(a, p0[r]), p0[r + 1]); b = fmaxf(fmaxf(b, p0[r + 2]), p0[r + 3]); a = fmaxf(fmaxf(a, p1[r]), p1[r + 1]); b = fmaxf(fmaxf(b, p1[r + 2]), p1[r + 3]); }
    const float m = fmaxf(a, b);
    return fmaxf(m, __shfl_xor(m, 32));
}
DI void attn_unit(int wv, int h, int qb, const bf16_t* QB, const bf16_t* KB, const bf16_t* VT, bf16_t* MIX, LAS unsigned char* lds) {
    const int tid = ltid(wv), lane = tid & 63, r32 = lane & 31, hi = lane >> 5; const int wid = __builtin_amdgcn_readfirstlane(tid >> 6);
    const int qg = qb * 256 + wid * 32 + r32;
    const bf16_t* Kh = KB + (size_t)h * S * 96; const bf16_t* Vh = VT + (size_t)h * 64 * S;
    bf16x8 qf[6];
    { const bf16_t* qp = QB + ((size_t)h * S + qg) * 96 + 8 * hi;
#pragma unroll
      for (int s = 0; s < 6; ++s) qf[s] = *(const bf16x8*)(qp + 16 * s); }
    f32x16 o0 = {}, o1 = {}, negm = {};
    float mref = 0.f, lrun = 0.f;
    const int NT = 4 * qb + 4, wlim = 4 * qb + (wid >> 1);
    const int kc0 = tid, kkey0 = kc0 / 12, kpart0 = kc0 % 12;
    const int kc1 = tid + 512, kkey1 = kc1 / 12, kpart1 = kc1 % 12;
    const int vdv = tid >> 3, vpart = tid & 7;
    u32x4 rk0, rk1 = {}, rv;
#define AT_LOADK(t_) do { const size_t kb_ = (size_t)(t_) * 64; rk0 = *(const u32x4*)(Kh + (kb_ + kkey0) * 96 + kpart0 * 8); if (tid < 256) rk1 = *(const u32x4*)(Kh + (kb_ + kkey1) * 96 + kpart1 * 8); } while (0)
#define AT_LOADV(t_) do { rv = *(const u32x4*)(Vh + (size_t)vdv * S + (size_t)(t_) * 64 + vpart * 8); } while (0)
#define AT_WRITEK(t_) do { LAS unsigned char* Ks_ = lds + ((t_) & 1) * AT_KT; *(LAS u32x4*)(Ks_ + kkey0 * AT_KROW + kpart0 * 16) = rk0; if (tid < 256) *(LAS u32x4*)(Ks_ + kkey1 * AT_KROW + kpart1 * 16) = rk1; } while (0)
#define AT_WRITEV(t_) do { LAS unsigned char* Vs_ = lds + 2 * AT_KT + ((t_) & 1) * AT_VT; *(LAS u32x2*)(Vs_ + vdv * AT_VROW + vpart * 16) = (u32x2){rv.x, rv.y}; *(LAS u32x2*)(Vs_ + vdv * AT_VROW + vpart * 16 + 8) = (u32x2){rv.z, rv.w}; } while (0)
#define AT_QK(P0, P1, t_) do { const LAS unsigned char* Ks_ = lds + ((t_) & 1) * AT_KT + r32 * AT_KROW + 16 * hi; f32x16 c0_ = negm, c1_ = negm; \
        _Pragma("unroll") for (int s = 0; s < 6; ++s) { const bf16x8 k0_ = *(const LAS bf16x8*)(Ks_ + 32 * s), k1_ = *(const LAS bf16x8*)(Ks_ + 32 * AT_KROW + 32 * s); \
            c0_ = __builtin_amdgcn_mfma_f32_32x32x16_bf16(k0_, qf[s], c0_, 0, 0, 0); c1_ = __builtin_amdgcn_mfma_f32_32x32x16_bf16(k1_, qf[s], c1_, 0, 0, 0); } \
        P0 = c0_; P1 = c1_; } while (0)
#define AT_SM1(P0, P1, MOFF, t_, MASK) do { \
        { const float d_ = mref - MOFF; if (__any(d_ != 0.f)) { _Pragma("unroll") for (int r = 0; r < 16; ++r) { P0[r] -= d_; P1[r] -= d_; } } } \
        if (MASK && (t_) == wlim) { const int kbase_ = (t_) * 64 + 4 * hi; \
            _Pragma("unroll") for (int r = 0; r < 16; ++r) { const int kv_ = kbase_ + (r & 3) + 8 * (r >> 2); if (kv_ > qg) P0[r] = -1e30f; if (kv_ + 32 > qg) P1[r] = -1e30f; } } \
        const float mx_ = rowmax32(P0, P1); \
        if ((t_) == 0 || __any(mx_ > 8.f)) { const float dl_ = ((t_) == 0) ? mx_ : fmaxf(mx_, 0.f); mref += dl_; \
            _Pragma("unroll") for (int r = 0; r < 16; ++r) { P0[r] -= dl_; P1[r] -= dl_; } \
            const float al_ = __builtin_amdgcn_exp2f(-dl_); lrun *= al_; \
            _Pragma("unroll") for (int r = 0; r < 16; ++r) { o0[r] *= al_; o1[r] *= al_; negm[r] = -mref; } asm volatile("" : "+v"(negm)); } \
    } while (0)
#define AT_SM2(P0, P1, t_) do { \
        float ps_ = 0.f; \
        _Pragma("unroll") for (int r = 0; r < 16; ++r) { P0[r] = __builtin_amdgcn_exp2f(P0[r]); P1[r] = __builtin_amdgcn_exp2f(P1[r]); ps_ += P0[r] + P1[r]; } \
        lrun += ps_; \
        const LAS unsigned char* Vs_ = lds + 2 * AT_KT + ((t_) & 1) * AT_VT + r32 * AT_VROW + 8 * hi; \
        _Pragma("unroll") for (int ks = 0; ks < 4; ++ks) { u32x4 w_; \
            if (ks < 2) { w_.x = pk2(P0[8 * ks], P0[8 * ks + 1]); w_.y = pk2(P0[8 * ks + 2], P0[8 * ks + 3]); w_.z = pk2(P0[8 * ks + 4], P0[8 * ks + 5]); w_.w = pk2(P0[8 * ks + 6], P0[8 * ks + 7]); } \
            else { w_.x = pk2(P1[8 * ks - 16], P1[8 * ks - 15]); w_.y = pk2(P1[8 * ks - 14], P1[8 * ks - 13]); w_.z = pk2(P1[8 * ks - 12], P1[8 * ks - 11]); w_.w = pk2(P1[8 * ks - 10], P1[8 * ks - 9]); } \
            const bf16x8 pa_ = __builtin_bit_cast(bf16x8, w_); \
            const u32x2 a0_ = *(const LAS u32x2*)(Vs_ + 32 * ks), a1_ = *(const LAS u32x2*)(Vs_ + 32 * ks + 16); \
            const u32x2 b0_ = *(const LAS u32x2*)(Vs_ + 32 * AT_VROW + 32 * ks), b1_ = *(const LAS u32x2*)(Vs_ + 32 * AT_VROW + 32 * ks + 16); \
            o0 = __builtin_amdgcn_mfma_f32_32x32x16_bf16(__builtin_bit_cast(bf16x8, (u32x4){a0_.x, a0_.y, a1_.x, a1_.y}), pa_, o0, 0, 0, 0); \
            o1 = __builtin_amdgcn_mfma_f32_32x32x16_bf16(__builtin_bit_cast(bf16x8, (u32x4){b0_.x, b0_.y, b1_.x, b1_.y}), pa_, o1, 0, 0, 0); } \
    } while (0)
#define AT_STEPM(C0, C1, MC, N0, N1, MN, t_) do { \
        AT_WRITEK((t_) + 1); AT_WRITEV(t_); \
        __syncthreads(); \
        AT_LOADK((t_) + 2); AT_LOADV((t_) + 1); \
        AT_SM1(C0, C1, MC, t_, 0); MN = mref; AT_QK(N0, N1, (t_) + 1); AT_SM2(C0, C1, t_); \
    } while (0)
#define AT_STEPB(C0, C1, MC, N0, N1, MN, t_) do { \
        if ((t_) + 1 < NT) AT_WRITEK((t_) + 1); AT_WRITEV(t_); \
        __syncthreads(); \
        if ((t_) + 2 < NT) AT_LOADK((t_) + 2); if ((t_) + 1 < NT) AT_LOADV((t_) + 1); \
        if ((t_) + 1 <= wlim) { MN = mref; AT_QK(N0, N1, (t_) + 1); } \
        if ((t_) <= wlim) { AT_SM1(C0, C1, MC, t_, 1); AT_SM2(C0, C1, t_); } \
    } while (0)
    f32x16 pA0, pA1, pB0 = {}, pB1 = {}; float mA = 0.f, mB = 0.f;
    AT_LOADK(0); AT_WRITEK(0);
    __syncthreads();
    AT_LOADK(1); AT_LOADV(0);
    AT_QK(pA0, pA1, 0);
    int t = 0;
    for (; t < 4 * qb; t += 2) {
        AT_STEPM(pA0, pA1, mA, pB0, pB1, mB, t);
        AT_STEPM(pB0, pB1, mB, pA0, pA1, mA, t + 1);
    }
    for (; t < NT; t += 2) {
        AT_STEPB(pA0, pA1, mA, pB0, pB1, mB, t);
        AT_STEPB(pB0, pB1, mB, pA0, pA1, mA, t + 1);
    }
#undef AT_STEPM
#undef AT_STEPB
#undef AT_LOADK
#undef AT_LOADV
#undef AT_WRITEK
#undef AT_WRITEV
#undef AT_QK
#undef AT_SM1
#undef AT_SM2
    lrun += __shfl_xor(lrun, 32);
    const float inv = 1.f / lrun;
    bf16_t* op = MIX + (size_t)qg * 1024 + 512 + h * 64;
#pragma unroll
    for (int g = 0; g < 4; ++g) { const int dv = 8 * g + 4 * hi;
        u32x2 w; w.x = pk2(o0[4 * g] * inv, o0[4 * g + 1] * inv); w.y = pk2(o0[4 * g + 2] * inv, o0[4 * g + 3] * inv); *(u32x2*)(op + dv) = w;
        u32x2 w2; w2.x = pk2(o1[4 * g] * inv, o1[4 * g + 1] * inv); w2.y = pk2(o1[4 * g + 2] * inv, o1[4 * g + 3] * inv); *(u32x2*)(op + 32 + dv) = w2; }
    __syncthreads();
}
DI void phase_attn(int wv, const ArgP a, LAS unsigned char* lds) {
    unsigned char* ws = a.ws();
    const bf16_t* QB = (const bf16_t*)(ws + O_QB); const bf16_t* KB = (const bf16_t*)(ws + O_KB); const bf16_t* VT = (const bf16_t*)(ws + O_VT); bf16_t* MIX = (bf16_t*)(ws + O_MIX);
    for (int b = blockIdx.x; b < 256; b += gridDim.x) {
        const int v = (b & 7) * 32 + (b >> 3), h = v >> 5, s = v & 31;
        attn_unit(wv, h, 63 - s, QB, KB, VT, MIX, lds);
        attn_unit(wv, h, s, QB, KB, VT, MIX, lds);
    }
}

DI void phase_m_gates(int wv, const ArgP a, LAS unsigned char* lds) {
    unsigned char* ws = a.ws(); const int tid = ltid(wv), wave = tid >> 6, lane = tid & 63;
    const float* HF = a.out(); const float* rowss = (const float*)(ws + O_ROWSS) + 2 * S;
    const float* Wg = a.in(17); const float* gn = a.in(16);
    LAS float* wgs = (LAS float*)lds;
    LAS float* pre = (LAS float*)(lds + 32768);
    float* GB = (float*)(ws + O_GB); float* GE = (float*)(ws + O_GE); float* GPM = (float*)(ws + O_GPM);
    float* BL = (float*)(ws + O_BL); float* ML = (float*)(ws + O_ML);
    for (int e = tid; e < 8192; e += 512) { const int k = e >> 3, j = e & 7; wgs[e] = Wg[(size_t)k * 3080 + 3072 + j] * gn[k]; }
    __syncthreads();
    for (int c = blockIdx.x; c < 256; c += gridDim.x) {
#pragma unroll 4
        for (int i = 0; i < 8; ++i) { const int t = c * 64 + wave * 8 + i;
            float acc[8];
#pragma unroll
            for (int j = 0; j < 8; ++j) acc[j] = 0.f;
#pragma unroll
            for (int jj = 0; jj < 4; ++jj) { const int k0 = jj * 256 + lane * 4; const f32x4 hv = *(const f32x4*)(HF + (size_t)t * 1024 + k0);
#pragma unroll
                for (int kk = 0; kk < 4; ++kk) { const f32x4 w0 = *(const LAS f32x4*)(wgs + (k0 + kk) * 8), w1 = *(const LAS f32x4*)(wgs + (k0 + kk) * 8 + 4);
                    acc[0] += hv[kk] * w0[0]; acc[1] += hv[kk] * w0[1]; acc[2] += hv[kk] * w0[2]; acc[3] += hv[kk] * w0[3];
                    acc[4] += hv[kk] * w1[0]; acc[5] += hv[kk] * w1[1]; acc[6] += hv[kk] * w1[2]; acc[7] += hv[kk] * w1[3]; } }
            const float rs = rs_from_ss(rowss[t]);
#pragma unroll
            for (int j = 0; j < 8; ++j) { const float v = wave_sum(acc[j]) * rs; if (lane == j) pre[(wave * 8 + i) * 8 + j] = v; }
        }
        __syncthreads();
        if (wave < 4) { const int h = wave; const float bi = a.in(18)[h], bfg = a.in(19)[h];
            const float ig = 15.f * tanhf((pre[lane * 8 + h] + bi) * (1.f / 15.f));
            const float fg = 15.f * tanhf((pre[lane * 8 + 4 + h] + bfg) * (1.f / 15.f));
            float b = -log1pf(expf(-fg));
#pragma unroll
            for (int o = 1; o < 64; o <<= 1) { const float v = __shfl_up(b, o); if (lane >= o) b += v; }
            const float e = ig - b; float pm = e;
#pragma unroll
            for (int o = 1; o < 64; o <<= 1) { const float v = __shfl_up(pm, o); if (lane >= o) pm = fmaxf(pm, v); }
            const size_t o_ = (size_t)h * S + c * 64 + lane; GB[o_] = b; GE[o_] = e; GPM[o_] = pm;
            if (lane == 63) { BL[c * 4 + h] = b; ML[c * 4 + h] = b + pm; } }
        __syncthreads();
    }
}
DI void phase_m_dc(int wv, const ArgP a) {
    unsigned char* ws = a.ws(); const int tid = ltid(wv), lane = tid & 63, r32 = lane & 31, hi = lane >> 5; const int w = __builtin_amdgcn_readfirstlane(tid >> 6);
    const float* BL = (const float*)(ws + O_BL); const float* ML = (const float*)(ws + O_ML); float* NST = (float*)(ws + O_NST);
    const float* GE = (const float*)(ws + O_GE); const bf16_t* KVT = (const bf16_t*)(ws + O_KVT); bf16_t* CST = (bf16_t*)(ws + O_CST);
    for (int u = blockIdx.x; u < 1024; u += gridDim.x) {
        const int c = u >> 2, h = u & 3; const size_t t0 = (size_t)c * 64;
        const float emax = ML[c * 4 + h] - BL[c * 4 + h];
        bf16x8 bfr[4];
        { const bf16_t* vp = KVT + (size_t)(512 + h * 256 + 32 * w + r32) * S + t0 + 8 * hi; const float* gp = GE + (size_t)h * S + t0 + 8 * hi;
#pragma unroll
          for (int ks = 0; ks < 4; ++ks) { const u32x4 v = *(const u32x4*)(vp + 16 * ks); const f32x4 e0 = *(const f32x4*)(gp + 16 * ks), e1 = *(const f32x4*)(gp + 16 * ks + 4);
              u32x4 o; o.x = pk2(bflo(v.x) * fexp(e0[0] - emax), bfhi(v.x) * fexp(e0[1] - emax)); o.y = pk2(bflo(v.y) * fexp(e0[2] - emax), bfhi(v.y) * fexp(e0[3] - emax));
              o.z = pk2(bflo(v.z) * fexp(e1[0] - emax), bfhi(v.z) * fexp(e1[1] - emax)); o.w = pk2(bflo(v.w) * fexp(e1[2] - emax), bfhi(v.w) * fexp(e1[3] - emax));
              bfr[ks] = __builtin_bit_cast(bf16x8, o); } }
        const bf16_t* kp = KVT + (size_t)(h * 128 + r32) * S + t0 + 8 * hi;
        bf16_t* op = CST + ((size_t)(c * 4 + h) * 256 + 32 * w + r32) * 128 + 4 * hi;
#pragma unroll
        for (int rb = 0; rb < 4; ++rb) { f32x16 acc = {};
#pragma unroll
            for (int ks = 0; ks < 4; ++ks) { const bf16x8 ka = *(const bf16x8*)(kp + (size_t)(32 * rb) * S + 16 * ks); acc = __builtin_amdgcn_mfma_f32_32x32x16_bf16(ka, bfr[ks], acc, 0, 0, 0); }
#pragma unroll
            for (int g = 0; g < 4; ++g) { u32x2 o; o.x = pk2(acc[4 * g], acc[4 * g + 1]); o.y = pk2(acc[4 * g + 2], acc[4 * g + 3]); *(u32x2*)(op + 32 * rb + 8 * g) = o; } }
        if (tid < 128) { const bf16_t* kr = KVT + (size_t)(h * 128 + tid) * S + t0; const float* gp = GE + (size_t)h * S + t0; float s = 0.f;
#pragma unroll
            for (int p = 0; p < 8; ++p) { const u32x4 v = *(const u32x4*)(kr + 8 * p); const f32x4 e0 = *(const f32x4*)(gp + 8 * p), e1 = *(const f32x4*)(gp + 8 * p + 4);
                s += bflo(v.x) * fexp(e0[0] - emax) + bfhi(v.x) * fexp(e0[1] - emax) + bflo(v.y) * fexp(e0[2] - emax) + bfhi(v.y) * fexp(e0[3] - emax)
                   + bflo(v.z) * fexp(e1[0] - emax) + bfhi(v.z) * fexp(e1[1] - emax) + bflo(v.w) * fexp(e1[2] - emax) + bfhi(v.w) * fexp(e1[3] - emax); }
            NST[(size_t)(c * 4 + h) * 128 + tid] = s; }
    }
}
DI void phase_m_comb(int wv, const ArgP a, LAS unsigned char* lds, int dry) {
    unsigned char* ws = a.ws(); const int tid = ltid(wv);
    const float* BL = (const float*)(ws + O_BL); const float* ML = (const float*)(ws + O_ML); float* MST = (float*)(ws + O_MST); float* NST = (float*)(ws + O_NST);
    bf16_t* CST = (bf16_t*)(ws + O_CST);
    LAS float* bls = (LAS float*)lds; LAS float* mls = bls + 1024; LAS float* ga = mls + 1024; LAS float* gb = ga + 1024;
    for (int e = tid; e < 1024; e += 512) { bls[e] = BL[e]; mls[e] = ML[e]; }
    __syncthreads();
    if (tid < 256) { const int h = tid >> 6, l = tid & 63;
        float a_ = 0.f, b_ = -1e30f;
#pragma unroll
        for (int k = 0; k < 4; ++k) { const float bl = bls[(4 * l + k) * 4 + h], ml = mls[(4 * l + k) * 4 + h]; a_ += bl; b_ = fmaxf(b_ + bl, ml); }
        float pa = a_, pb = b_;
#pragma unroll
        for (int o = 1; o < 64; o <<= 1) { const float qa = __shfl_up(pa, o), qb = __shfl_up(pb, o); if (l >= o) { pb = fmaxf(qb + pa, pb); pa = qa + pa; } }
        float ea = __shfl_up(pa, 1), eb_ = __shfl_up(pb, 1); if (l == 0) { ea = 0.f; eb_ = -1e30f; }
        float m = fmaxf(0.f + ea, eb_);
#pragma unroll
        for (int k = 0; k < 4; ++k) { const int c = 4 * l + k; const float bl = bls[c * 4 + h], ml = mls[c * 4 + h]; const float mn = fmaxf(bl + m, ml);
            ga[c * 4 + h] = fexp(bl + m - mn); gb[c * 4 + h] = fexp(ml - mn);
            if (blockIdx.x == 0 && !dry) MST[c * 4 + h] = m;
            m = mn; } }
    __syncthreads();
    for (int eb = blockIdx.x; eb < 129; eb += gridDim.x) {
        if (eb < 128) { const int h = eb >> 5; unsigned* p = (unsigned*)(CST + (size_t)h * 32768 + (size_t)(eb & 31) * 1024 + 2 * tid); float C0 = 0.f, C1 = 0.f;
            for (int c = 0; c < 256; c += 64) { unsigned d[64];
#pragma unroll
                for (int k = 0; k < 64; ++k) d[k] = p[(size_t)(c + k) * 65536];
#pragma unroll
                for (int k = 0; k < 64; ++k) { if (!dry) p[(size_t)(c + k) * 65536] = pk2(C0, C1); const float a_ = ga[(c + k) * 4 + h], b_ = gb[(c + k) * 4 + h]; C0 = a_ * C0 + b_ * bflo(d[k]); C1 = a_ * C1 + b_ * bfhi(d[k]); } }
        } else { const int h = tid >> 7; float* p = NST + tid; float C = 0.f;
            for (int c = 0; c < 256; c += 8) { float d[8];
#pragma unroll
                for (int k = 0; k < 8; ++k) d[k] = p[(size_t)(c + k) * 512];
#pragma unroll
                for (int k = 0; k < 8; ++k) { if (!dry) p[(size_t)(c + k) * 512] = C; C = ga[(c + k) * 4 + h] * C + gb[(c + k) * 4 + h] * d[k]; } } }
    }
    __syncthreads();
}
constexpr int MC_QROW = 272, MC_SROW = 144;
constexpr int MC_QS = 0, MC_KS = 64 * MC_QROW, MC_SC = 2 * 64 * MC_QROW, MC_F = MC_SC + 64 * MC_SROW;
DI void phase_m_out(int wv, const ArgP a, LAS unsigned char* lds, int dry) {
    unsigned char* ws = a.ws(); const int tid = ltid(wv), lane = tid & 63, r32 = lane & 31, hi = lane >> 5; const int w = __builtin_amdgcn_readfirstlane(tid >> 6);
    bf16_t* QOK = (bf16_t*)(ws + O_QOK); const bf16_t* KVT = (const bf16_t*)(ws + O_KVT); const bf16_t* CST = (const bf16_t*)(ws + O_CST);
    const float* GB = (const float*)(ws + O_GB); const float* GE = (const float*)(ws + O_GE); const float* GPM = (const float*)(ws + O_GPM);
    const float* MST = (const float*)(ws + O_MST); const float* NST = (const float*)(ws + O_NST); const float* ong = a.in(20);
    LAS unsigned char* Qs = lds + MC_QS; LAS unsigned char* Ks = lds + MC_KS; LAS unsigned char* Sc = lds + MC_SC;
    LAS float* F = (LAS float*)(lds + MC_F);
    LAS float* f_b = F, *f_e = F + 64, *f_m = F + 128, *f_g = F + 192, *f_qn = F + 256, *f_ps = F + 320  , *f_n = F + 576  , *f_part = F + 704  ;
    for (int u = blockIdx.x; u < 1024; u += gridDim.x) {
        const int c = u >> 2, h = u & 3; const size_t t0 = (size_t)c * 64;
        for (int e = tid; e < 1024; e += 512) { const int r = e >> 4, p = e & 15;
            *(LAS u32x4*)(Qs + r * MC_QROW + p * 16) = *(const u32x4*)(QOK + (t0 + r) * 2048 + h * 128 + p * 8);
            *(LAS u32x4*)(Ks + r * MC_QROW + p * 16) = *(const u32x4*)(QOK + (t0 + r) * 2048 + 1536 + h * 128 + p * 8); }
        if (tid < 64) { const float mstv = MST[c * 4 + h]; const float b = GB[(size_t)h * S + t0 + tid], e = GE[(size_t)h * S + t0 + tid], pm = GPM[(size_t)h * S + t0 + tid];
            const float m = b + fmaxf(mstv, pm); f_b[tid] = b; f_e[tid] = e; f_m[tid] = m; f_g[tid] = fexp(b + mstv - m); }
        if (tid >= 64 && tid < 192) f_n[tid - 64] = NST[(size_t)(c * 4 + h) * 128 + tid - 64];
        __syncthreads();
        if (w < 4) {
            const int sb = w & 1, tb = w >> 1; const int tl = 32 * tb + r32;
            f32x16 x = {};
#pragma unroll
            for (int ks = 0; ks < 8; ++ks) {
                const bf16x8 ka = *(const LAS bf16x8*)(Ks + (32 * sb + r32) * MC_QROW + (16 * ks + 8 * hi) * 2);
                const bf16x8 qb = *(const LAS bf16x8*)(Qs + tl * MC_QROW + (16 * ks + 8 * hi) * 2);
                x = __builtin_amdgcn_mfma_f32_32x32x16_bf16(ka, qb, x, 0, 0, 0); }
            const float bt = f_b[tl], mt = f_m[tl]; float ps = 0.f;
#pragma unroll
            for (int g = 0; g < 4; ++g) { float v[4];
#pragma unroll
                for (int j = 0; j < 4; ++j) { const int sl = 32 * sb + 8 * g + 4 * hi + j; const float wgt = (sl <= tl) ? fexp(bt + f_e[sl] - mt) : 0.f; v[j] = x[4 * g + j] * wgt; ps += v[j]; }
                u32x2 o; o.x = pk2(v[0], v[1]); o.y = pk2(v[2], v[3]);
                *(LAS u32x2*)(Sc + tl * MC_SROW + (32 * sb + 8 * g + 4 * hi) * 2) = o; }
            f_ps[(sb * 2 + hi) * 64 + tl] = ps;
        } else {
            const int tl = 16 * (w - 4) + (lane >> 2), qq = lane & 3; float s = 0.f;
#pragma unroll
            for (int p = 0; p < 4; ++p) { const u32x4 v = *(const LAS u32x4*)(Qs + tl * MC_QROW + (32 * qq + 8 * p) * 2); LAS float* np = f_n + 32 * qq + 8 * p;
                s += bflo(v.x) * np[0] + bfhi(v.x) * np[1] + bflo(v.y) * np[2] + bfhi(v.y) * np[3] + bflo(v.z) * np[4] + bfhi(v.z) * np[5] + bflo(v.w) * np[6] + bfhi(v.w) * np[7]; }
            s += __shfl_xor(s, 1); s += __shfl_xor(s, 2);
            if (qq == 0) f_qn[tl] = s;
        }
        __syncthreads();
        f32x16 acc0 = {}, acc1 = {};
        { const bf16_t* cp = CST + ((size_t)(c * 4 + h) * 256 + 32 * w + r32) * 128 + 8 * hi;
#pragma unroll
          for (int ks = 0; ks < 8; ++ks) { const bf16x8 ca = *(const bf16x8*)(cp + 16 * ks);
              const bf16x8 q0 = *(const LAS bf16x8*)(Qs + r32 * MC_QROW + (16 * ks + 8 * hi) * 2), q1 = *(const LAS bf16x8*)(Qs + (32 + r32) * MC_QROW + (16 * ks + 8 * hi) * 2);
              acc0 = __builtin_amdgcn_mfma_f32_32x32x16_bf16(ca, q0, acc0, 0, 0, 0); acc1 = __builtin_amdgcn_mfma_f32_32x32x16_bf16(ca, q1, acc1, 0, 0, 0); } }
        const float g0 = f_g[r32], g1 = f_g[32 + r32];
#pragma unroll
        for (int r = 0; r < 16; ++r) { acc0[r] *= g0; acc1[r] *= g1; }
        { const bf16_t* vp = KVT + (size_t)(512 + h * 256 + 32 * w + r32) * S + t0 + 8 * hi;
#pragma unroll
          for (int ks = 0; ks < 4; ++ks) { const bf16x8 va = *(const bf16x8*)(vp + 16 * ks);
              const bf16x8 s0 = *(const LAS bf16x8*)(Sc + r32 * MC_SROW + (16 * ks + 8 * hi) * 2), s1 = *(const LAS bf16x8*)(Sc + (32 + r32) * MC_SROW + (16 * ks + 8 * hi) * 2);
              acc0 = __builtin_amdgcn_mfma_f32_32x32x16_bf16(va, s0, acc0, 0, 0, 0); acc1 = __builtin_amdgcn_mfma_f32_32x32x16_bf16(va, s1, acc1, 0, 0, 0); } }
        float inv[2];
#pragma unroll
        for (int tb = 0; tb < 2; ++tb) { const int tl = 32 * tb + r32;
            const float den = f_g[tl] * f_qn[tl] + f_ps[tl] + f_ps[64 + tl] + f_ps[128 + tl] + f_ps[192 + tl];
            inv[tb] = 1.f / fmaxf(fabsf(den), fexp(-f_m[tl])); }
        float ss0 = 0.f, ss1 = 0.f;
#pragma unroll
        for (int r = 0; r < 16; ++r) { acc0[r] *= inv[0]; acc1[r] *= inv[1]; ss0 += acc0[r] * acc0[r]; ss1 += acc1[r] * acc1[r]; }
        ss0 += __shfl_xor(ss0, 32); ss1 += __shfl_xor(ss1, 32);
        if (hi == 0) { f_part[w * 64 + r32] = ss0; f_part[w * 64 + 32 + r32] = ss1; }
        __syncthreads();
        float rn[2];
#pragma unroll
        for (int tb = 0; tb < 2; ++tb) { float s = 0.f;
#pragma unroll
            for (int ww = 0; ww < 8; ++ww) s += f_part[ww * 64 + 32 * tb + r32];
            rn[tb] = rsqrtf(s * (1.f / 256.f) + EPS); }
#pragma unroll
        for (int tb = 0; tb < 2; ++tb) { bf16_t* op = QOK + (t0 + 32 * tb + r32) * 2048 + 512 + h * 256 + 32 * w;
#pragma unroll
            for (int g = 0; g < 4; ++g) { const int dv = 8 * g + 4 * hi; const u32x2 ov = *(const u32x2*)(op + dv);
                const f32x4 gg = *(const f32x4*)(ong + h * 256 + 32 * w + dv);
                const float og[4] = {bflo(ov.x), bfhi(ov.x), bflo(ov.y), bfhi(ov.y)}; float y[4];
#pragma unroll
                for (int j = 0; j < 4; ++j) { const float hv = (tb ? acc1[4 * g + j] : acc0[4 * g + j]) * rn[tb]; y[j] = hv * gg[j] * sigmoidf_(og[j]); }
                u32x2 o; o.x = pk2(y[0], y[1]); o.y = pk2(y[2], y[3]); if (!dry) *(u32x2*)(op + dv) = o; } }
        __syncthreads();
    }
}

DI void phase_final(int wv, const ArgP a) {
    float* out = a.out(); const float* rowss = (const float*)(a.ws() + O_ROWSS) + 4 * S; const float* g = a.in(27);
    for (size_t e = (size_t)blockIdx.x * 512 + ltid(wv); e < (size_t)S * 256; e += (size_t)gridDim.x * 512) { const int t = (int)(e >> 8), c = (int)(e & 255) * 4;
        const float rs = rs_from_ss(rowss[t]); f32x4 v = *(f32x4*)(out + (size_t)t * 1024 + c); const f32x4 gg = *(const f32x4*)(g + c);
        v = v * rs * gg; *(f32x4*)(out + (size_t)t * 1024 + c) = v; }
}

#ifndef DIS
#define DIS 0u
#endif
#ifndef REP
#define REP 0u
#endif
#ifndef XSYNC
#define XSYNC 0
#endif

#define XB_TMO      128
#define XB_XCNT(j)  (256  + 64 * (j))
#define XB_XSUB(j)  (1280 + 64 * (j))
#define XB_XGEN(j)  (2304 + 64 * (j))
#define XB_TOP      3328
#define XB_TOPGEN   3392
#define XB_SPIN_CAP (1u << 18)
DI unsigned xb_ld(unsigned* p) { return __hip_atomic_load(p, __ATOMIC_RELAXED, __HIP_MEMORY_SCOPE_AGENT); }
DI unsigned xb_add(unsigned* p, unsigned v) { return __hip_atomic_fetch_add(p, v, __ATOMIC_RELAXED, __HIP_MEMORY_SCOPE_AGENT); }
DI unsigned xb_xcc_id() { return (unsigned)__builtin_amdgcn_s_getreg((3 << 11) | 20) & 0xFu; }
#define XB_SPIN(cond, bar) do { unsigned _sp = 0; while (cond) { __builtin_amdgcn_s_sleep(1); \
    if ((++_sp & 255u) == 0u) { if (xb_ld(&(bar)[XB_TMO])) break; if (_sp > XB_SPIN_CAP) { atomicAdd(&(bar)[XB_TMO], 1u); break; } } } } while (0)
DI void xcd_barrier_complete(unsigned* bar, unsigned x, unsigned& nloc, unsigned& nx) {
    const unsigned G = gridDim.x;
    unsigned sum, cnt, mine, sp = 0u;
    for (;;) {
        sum = 0u; cnt = 0u; mine = 0u;
#pragma unroll
        for (unsigned j = 0; j < 16; ++j) { const unsigned c = xb_ld(&bar[XB_XCNT(j)]); sum += c; cnt += (c > 0u) ? 1u : 0u; mine = (j == x) ? c : mine; }
        if (sum == G) break;
        __builtin_amdgcn_s_sleep(1);
        if ((++sp & 255u) == 0u) { if (xb_ld(&bar[XB_TMO])) break; if (sp > XB_SPIN_CAP) { atomicAdd(&bar[XB_TMO], 1u); break; } }
    }
    nloc = mine > 0u ? mine : 1u; nx = cnt > 0u ? cnt : 1u;
}
DI void xcd_barrier(int wv, unsigned* bar, volatile LAS unsigned* st) {
    asm volatile("s_waitcnt vmcnt(0)" ::: "memory");
    __syncthreads();
    if (ltid(wv) == 0) {
        const unsigned x = xb_xcc_id();
        __builtin_amdgcn_s_waitcnt(0);
        unsigned nloc = st[0], nx = st[1];
        if (nloc == 0u) { xcd_barrier_complete(bar, x, nloc, nx); st[0] = nloc; st[1] = nx; }
        const unsigned old = xb_add(&bar[XB_XSUB(x)], 1u);
        const unsigned gen = old / nloc;
        if (old + 1u == (gen + 1u) * nloc) {
            __builtin_amdgcn_fence(__ATOMIC_RELEASE, "agent");
            asm volatile("s_waitcnt vmcnt(0)" ::: "memory");
            const unsigned og = xb_add(&bar[XB_TOP], 1u);
            const unsigned tg = og / nx;
            if (og + 1u == (tg + 1u) * nx) xb_add(&bar[XB_TOPGEN], 1u);
            else XB_SPIN(xb_ld(&bar[XB_TOPGEN]) == tg, bar);
            __builtin_amdgcn_fence(__ATOMIC_ACQUIRE, "agent");
            xb_add(&bar[XB_XGEN(x)], 1u);
            asm volatile("s_waitcnt vmcnt(0)" ::: "memory");
        } else {
            XB_SPIN(xb_ld(&bar[XB_XGEN(x)]) == gen, bar);
            __builtin_amdgcn_fence(__ATOMIC_ACQUIRE, "agent");
            asm volatile("s_waitcnt vmcnt(0)" ::: "memory");
        }
    }
    __syncthreads();
}
DI ArgP getargs() { ArgP r; r.p = (const __attribute__((address_space(4))) Args*)__builtin_amdgcn_kernarg_segment_ptr(); asm volatile("" : "+s"(r.p)); return r; }
#define WSB (getargs().ws())
#define XBP ((bf16_t*)(getargs().ws() + O_XB) + 2 * 1024)
#define RSS ((float*)(getargs().ws() + O_ROWSS))
#define HFP (getargs().out())
__global__ void __launch_bounds__(512, 2) fwd_kernel(Args a_unused) {
    extern __shared__ __attribute__((aligned(16))) unsigned char shm[];
    LAS unsigned char* lds = (LAS unsigned char*)shm;
    const int wv = __builtin_amdgcn_readfirstlane(threadIdx.x >> 6);
#define BARW ((unsigned*)(getargs().ws() + O_BAR))
#define BARST ((volatile LAS unsigned*)(lds + 139264))
#define GSYNC() xcd_barrier(wv, BARW, BARST)
    { unsigned* barw0 = BARW; if (threadIdx.x == 0) { BARST[0] = 0u; BARST[1] = 0u; (void)xb_add(&barw0[XB_XCNT(xb_xcc_id())], 1u); } }
    if (getargs().p->pad == 0x7fffffff) cg::this_grid().sync();

#if !(DIS & (1u << 0))
    for (int rep_ = 0; rep_ < ((REP >> 0) & 1u) + 1; ++rep_) { const int dry_ = rep_ < (int)((REP >> 0) & 1u); (void)dry_;
    phase_prologue(wv, getargs(), lds, dry_ ? PROPART : 7);
    }
#endif
    GSYNC();
#if !(DIS & (1u << 1))
    for (int rep_ = 0; rep_ < ((REP >> 1) & 1u) + 1; ++rep_) { const int dry_ = rep_ < (int)((REP >> 1) & 1u); (void)dry_;
    { EpiRowBf16<1> E{(bf16_t*)(WSB + O_Z), 1536, RSS};
      pg8::gemm_phase<false>(wv, lds, XBP, 1024, (const bf16_t*)(WSB + O_W1T), 1024, 1024, 64, 6, E); }
    }
#endif
    GSYNC();
#if !(DIS & (1u << 2))
    for (int rep_ = 0; rep_ < ((REP >> 2) & 1u) + 1; ++rep_) { const int dry_ = rep_ < (int)((REP >> 2) & 1u); (void)dry_;
    phase_l0_prep(wv, getargs());
    }
#endif
    GSYNC();
#if !(DIS & (1u << 3))
    for (int rep_ = 0; rep_ < ((REP >> 3) & 1u) + 1; ++rep_) { const int dry_ = rep_ < (int)((REP >> 3) & 1u); (void)dry_;
    { EpiRowBf16<0> E{(bf16_t*)(WSB + O_RI), 1024, nullptr};
      pg8::gemm_phase<false>(wv, lds, (const bf16_t*)(WSB + O_XC), 512, (const bf16_t*)(WSB + O_WRIT), 512, 512, 64, 4, E); }
    }
#endif
#if !(DIS & (1u << 4))
    for (int rep_ = 0; rep_ < ((REP >> 4) & 1u) + 1; ++rep_) { const int dry_ = rep_ < (int)((REP >> 4) & 1u); (void)dry_;
    { EpiQ E{(bf16_t*)(WSB + O_QB), (const float*)(WSB + O_RSQ), (const float*)(WSB + O_CSTAB)};
      pg8::gemm_phase<false>(wv, lds, (const bf16_t*)(WSB + O_Z) + 1024, 1536, (const bf16_t*)(WSB + O_WQT), 256, 256, 64, 3, E); }
    }
#endif
#if !(DIS & (1u << 5))
    for (int rep_ = 0; rep_ < ((REP >> 5) & 1u) + 1; ++rep_) { const int dry_ = rep_ < (int)((REP >> 5) & 1u); (void)dry_;
    { EpiK E{(bf16_t*)(WSB + O_KB), (const float*)(WSB + O_RSKV)};
      pg8::gemm_phase<false>(wv, lds, (const bf16_t*)(WSB + O_Z) + 1280, 1536, (const bf16_t*)(WSB + O_WKT), 256, 256, 64, 2, E, 192); }
    }
#endif
#if !(DIS & (1u << 6))
    for (int rep_ = 0; rep_ < ((REP >> 6) & 1u) + 1; ++rep_) { const int dry_ = rep_ < (int)((REP >> 6) & 1u); (void)dry_;
    { EpiColBf16<2> E{(bf16_t*)(WSB + O_VT), S, (const float*)(WSB + O_RSKV)};
      pg8::gemm_phase<false>(wv, lds, (const bf16_t*)(WSB + O_WVT), 256, (const bf16_t*)(WSB + O_Z) + 1280, 1536, 256, 2, 64, E, 64); }
    }
#endif
    GSYNC();
#if !(DIS & (1u << 7))
    for (int rep_ = 0; rep_ < ((REP >> 7) & 1u) + 1; ++rep_) { const int dry_ = rep_ < (int)((REP >> 7) & 1u); (void)dry_;
    phase_lru_s1(wv, getargs());
    }
#endif
    GSYNC();
#if !(DIS & (1u << 8))
    for (int rep_ = 0; rep_ < ((REP >> 8) & 1u) + 1; ++rep_) { const int dry_ = rep_ < (int)((REP >> 8) & 1u); (void)dry_;
    phase_lru_s3(wv, getargs());
    }
#endif
#if !(DIS & (1u << 9))
    for (int rep_ = 0; rep_ < ((REP >> 9) & 1u) + 1; ++rep_) { const int dry_ = rep_ < (int)((REP >> 9) & 1u); (void)dry_;
    phase_attn(wv, getargs(), lds);
    }
#endif
    GSYNC();
#if !(DIS & (1u << 10))
    for (int rep_ = 0; rep_ < ((REP >> 10) & 1u) + 1; ++rep_) { const int dry_ = rep_ < (int)((REP >> 10) & 1u); (void)dry_;
    { EpiRes E{getargs().in(0), HFP, XBP, RSS + 1 * S, dry_};
      pg8::gemm_phase<false>(wv, lds, (const bf16_t*)(WSB + O_MIX), 1024, (const bf16_t*)(WSB + O_WO1T), 1024, 1024, 64, 4, E); }
    }
#endif
    GSYNC();
#if !(DIS & (1u << 11))
    for (int rep_ = 0; rep_ < ((REP >> 11) & 1u) + 1; ++rep_) { const int dry_ = rep_ < (int)((REP >> 11) & 1u); (void)dry_;
    { EpiUp E{(bf16_t*)(WSB + O_ACT), RSS + 1 * S, getargs().in(24), getargs().in(25), lds + 131072};
      pg8::gemm_phase<true>(wv, lds, XBP, 1024, (const bf16_t*)(WSB + O_WUPT), 1024, 1024, 67, 22, E); }
    }
#endif
    GSYNC();
#if !(DIS & (1u << 12))
    for (int rep_ = 0; rep_ < ((REP >> 12) & 1u) + 1; ++rep_) { const int dry_ = rep_ < (int)((REP >> 12) & 1u); (void)dry_;
    { EpiRes E{HFP, HFP, XBP, RSS + 2 * S, dry_};
      pg8::gemm_phase<false>(wv, lds, (const bf16_t*)(WSB + O_ACT), 2816, (const bf16_t*)(WSB + O_WDNT), 2816, 2816, 64, 4, E); }
    }
#endif
    GSYNC();
#if !(DIS & (1u << 13))
    for (int rep_ = 0; rep_ < ((REP >> 13) & 1u) + 1; ++rep_) { const int dry_ = rep_ < (int)((REP >> 13) & 1u); (void)dry_;
    { EpiRowBf16<1> E{(bf16_t*)(WSB + O_QOK), 2048, RSS + 2 * S};
      pg8::gemm_phase<false>(wv, lds, XBP, 1024, (const bf16_t*)(WSB + O_WOINT), 1024, 1024, 64, 8, E); }
    }
#endif
#if !(DIS & (1u << 14))
    for (int rep_ = 0; rep_ < ((REP >> 14) & 1u) + 1; ++rep_) { const int dry_ = rep_ < (int)((REP >> 14) & 1u); (void)dry_;
    { EpiColBf16<1> E{(bf16_t*)(WSB + O_KVT), S, RSS + 2 * S};
      pg8::gemm_phase<false>(wv, lds, (const bf16_t*)(WSB + O_WOINT) + (size_t)1536 * 1024, 1024, XBP, 1024, 1024, 6, 64, E); }
    }
#endif
#if !(DIS & (1u << 15))
    for (int rep_ = 0; rep_ < ((REP >> 15) & 1u) + 1; ++rep_) { const int dry_ = rep_ < (int)((REP >> 15) & 1u); (void)dry_;
    phase_m_gates(wv, getargs(), lds);
    }
#endif
    GSYNC();
#if !(DIS & (1u << 16))
    for (int rep_ = 0; rep_ < ((REP >> 16) & 1u) + 1; ++rep_) { const int dry_ = rep_ < (int)((REP >> 16) & 1u); (void)dry_;
    phase_m_dc(wv, getargs());
    }
#endif
    GSYNC();
#if !(DIS & (1u << 22))
    for (int rep_ = 0; rep_ < ((REP >> 22) & 1u) + 1; ++rep_) { const int dry_ = rep_ < (int)((REP >> 22) & 1u); (void)dry_;
    phase_m_comb(wv, getargs(), lds, dry_);
    }
#endif
    GSYNC();
#if !(DIS & (1u << 17))
    for (int rep_ = 0; rep_ < ((REP >> 17) & 1u) + 1; ++rep_) { const int dry_ = rep_ < (int)((REP >> 17) & 1u); (void)dry_;
    phase_m_out(wv, getargs(), lds, dry_);
    }
#endif
    GSYNC();
#if !(DIS & (1u << 18))
    for (int rep_ = 0; rep_ < ((REP >> 18) & 1u) + 1; ++rep_) { const int dry_ = rep_ < (int)((REP >> 18) & 1u); (void)dry_;
    { EpiRes E{HFP, HFP, XBP, RSS + 3 * S, dry_};
      pg8::gemm_phase<false>(wv, lds, (const bf16_t*)(WSB + O_QOK) + 512, 2048, (const bf16_t*)(WSB + O_WO2T), 1024, 1024, 64, 4, E); }
    }
#endif
    GSYNC();
#if !(DIS & (1u << 19))
    for (int rep_ = 0; rep_ < ((REP >> 19) & 1u) + 1; ++rep_) { const int dry_ = rep_ < (int)((REP >> 19) & 1u); (void)dry_;
    { EpiUp E{(bf16_t*)(WSB + O_ACT), RSS + 3 * S, getargs().in(24) + 3 * 5632, getargs().in(25) + 5632, lds + 131072};
      pg8::gemm_phase<true>(wv, lds, XBP, 1024, (const bf16_t*)(WSB + O_WUPT + SZ_WUPT), 1024, 1024, 67, 22, E); }
    }
#endif
    GSYNC();
#if !(DIS & (1u << 20))
    for (int rep_ = 0; rep_ < ((REP >> 20) & 1u) + 1; ++rep_) { const int dry_ = rep_ < (int)((REP >> 20) & 1u); (void)dry_;
    { EpiRes E{HFP, HFP, XBP, RSS + 4 * S, dry_};
      pg8::gemm_phase<false>(wv, lds, (const bf16_t*)(WSB + O_ACT), 2816, (const bf16_t*)(WSB + O_WDNT + SZ_WDNT), 2816, 2816, 64, 4, E); }
    }
#endif
    GSYNC();
#if !(DIS & (1u << 21))
    for (int rep_ = 0; rep_ < ((REP >> 21) & 1u) + 1; ++rep_) { const int dry_ = rep_ < (int)((REP >> 21) & 1u); (void)dry_;
    phase_final(wv, getargs());
    }
#endif
    for (int i = 0; i < XSYNC; ++i) GSYNC();
}

extern "C" void kernel_launch(void* const* d_in, const int* in_sizes, int n_in, void* d_out, int out_size, void* d_ws, size_t ws_size, hipStream_t stream) {
    static int grid = 0;
    if (grid == 0) {
        if (n_in != 28 || out_size != S * 1024 || ws_size < WS_NEED) { fprintf(stderr, "kernel_launch: unexpected shapes (n_in %d out %d ws %zu need %zu)\n", n_in, out_size, ws_size, (size_t)WS_NEED); grid = -1; return; }
        int dev = 0, cus = 0, per_cu = 0;
        (void)hipGetDevice(&dev);
        (void)hipDeviceGetAttribute(&cus, hipDeviceAttributeMultiprocessorCount, dev);
        if (hipFuncSetAttribute((const void*)fwd_kernel, hipFuncAttributeMaxDynamicSharedMemorySize, LDS_BYTES) != hipSuccess) { fprintf(stderr, "kernel_launch: hipFuncSetAttribute failed\n"); grid = -1; return; }
        if (hipOccupancyMaxActiveBlocksPerMultiprocessor(&per_cu, (const void*)fwd_kernel, 512, LDS_BYTES) != hipSuccess || per_cu < 1) { fprintf(stderr, "kernel_launch: occupancy query says %d\n", per_cu); per_cu = 1; }
        (void)hipGetLastError();
        grid = cus * 1;
        if (grid > 256) grid = 256;
    }
    if (grid < 0) return;
    Args a{};
    for (int i = 0; i < 28; ++i) a.in[i] = (const float*)d_in[i];
    a.out = (float*)d_out; a.ws = (unsigned char*)d_ws;
    if (hipMemsetAsync((char*)d_ws + O_BAR, 0, BAR_BYTES, stream) != hipSuccess) { fprintf(stderr, "kernel_launch: memset failed\n"); return; }
    void* args[] = {&a};
    hipError_t e = hipLaunchCooperativeKernel((void*)fwd_kernel, dim3(grid), dim3(512), args, LDS_BYTES, stream);
    if (e != hipSuccess) fprintf(stderr, "kernel_launch: cooperative launch failed: %s (grid %d)\n", hipGetErrorString(e), grid);
}
```

```cpp
#include <hip/hip_runtime.h>
#include <hip/hip_cooperative_groups.h>
#include <cstdio>
#include <cstdint>
namespace cg = cooperative_groups;

typedef unsigned short bf16_t;
typedef short bf16x8 __attribute__((ext_vector_type(8)));
typedef short s16x4 __attribute__((ext_vector_type(4)));
typedef float f32x2 __attribute__((ext_vector_type(2)));
typedef float f32x4 __attribute__((ext_vector_type(4)));
typedef float f32x16 __attribute__((ext_vector_type(16)));
typedef unsigned u32x2 __attribute__((ext_vector_type(2)));
typedef unsigned u32x4 __attribute__((ext_vector_type(4)));
typedef __bf16 bf16x2_t __attribute__((ext_vector_type(2)));
#define LAS __attribute__((address_space(3)))
#define DI __device__ __forceinline__

constexpr int S = 16384;
constexpr float EPS = 1e-6f;
constexpr float LOG2E = 1.4426950408889634f;

constexpr size_t SZ_WUPT = (size_t)5632 * 1024 * 2, SZ_WDNT = (size_t)1024 * 2816 * 2;
constexpr size_t O_WUPT1 = 0;
constexpr size_t O_WDNT1 = O_WUPT1 + SZ_WUPT;
constexpr size_t O_WOINT = O_WDNT1 + SZ_WDNT;
constexpr size_t O_WO2T = O_WOINT + (size_t)3072 * 1024 * 2;
constexpr size_t O_ROWSS = O_WO2T + (size_t)1024 * 1024 * 2;
constexpr size_t O_RSQ = O_ROWSS + (size_t)5 * S * 8;
constexpr size_t O_RSKV = O_RSQ + (size_t)S * 4;
constexpr size_t O_CSTAB = O_RSKV + (size_t)S * 4;
constexpr size_t O_CHA = O_CSTAB + (size_t)S * 32 * 4;
constexpr size_t O_CHH = O_CHA + (size_t)256 * 512 * 4;
constexpr size_t O_GB = O_CHH + (size_t)256 * 512 * 4;
constexpr size_t O_GE = O_GB + (size_t)4 * S * 4;
constexpr size_t O_GPM = O_GE + (size_t)4 * S * 4;
constexpr size_t O_BL = O_GPM + (size_t)4 * S * 4;
constexpr size_t O_ML = O_BL + 4096;
constexpr size_t O_MST = O_ML + 4096;
constexpr size_t O_NST = O_MST + 4096;
constexpr size_t O_BAR = O_NST + (size_t)256 * 4 * 128 * 4;
constexpr size_t BAR_BYTES = 16384;
constexpr size_t O_XB = O_BAR + BAR_BYTES;
constexpr size_t XB_ROWS = 16648;
constexpr size_t O_L0W = O_XB + XB_ROWS * 2048;
constexpr size_t O_W1T = O_L0W;
constexpr size_t O_WQT = O_W1T + (size_t)1536 * 1024 * 2;
constexpr size_t O_WKT = O_WQT + (size_t)768 * 256 * 2;
constexpr size_t O_WVT = O_WKT + (size_t)512 * 256 * 2;
constexpr size_t O_WRIT = O_WVT + (size_t)512 * 256 * 2;
constexpr size_t O_WO1T = O_WRIT + (size_t)1024 * 512 * 2;
constexpr size_t O_WUPT0 = O_WO1T + (size_t)1024 * 1024 * 2;
constexpr size_t O_WDNT0 = O_WUPT0 + SZ_WUPT;
constexpr size_t O_ARENA = O_WDNT0 + SZ_WDNT;
constexpr size_t O_Z = O_ARENA;
constexpr size_t O_XC = O_Z + (size_t)S * 1536 * 2;
constexpr size_t O_QB = O_XC + (size_t)S * 512 * 2;
constexpr size_t O_KB = O_QB + (size_t)8 * S * 96 * 2;
constexpr size_t O_VT = O_KB + (size_t)8 * S * 96 * 2;
constexpr size_t O_MIX = O_VT + (size_t)512 * S * 2;
constexpr size_t O_END0 = O_MIX + (size_t)S * 1024 * 2;
constexpr size_t O_ACT = O_ARENA;
constexpr size_t O_RI = O_XB;
constexpr size_t O_CST = O_L0W;
constexpr size_t O_QOK = O_CST + (size_t)256 * 4 * 256 * 128 * 2;
constexpr size_t O_KVT = O_QOK + (size_t)S * 2048 * 2;
constexpr size_t O_END1 = O_KVT + (size_t)1536 * S * 2;
constexpr size_t WS_NEED = (O_END0 > O_END1 ? O_END0 : O_END1);
static_assert(WS_NEED <= (size_t)268435456, "workspace");
static_assert(O_ACT + (size_t)(S + 240) * 2816 * 2 <= (size_t)268435456, "act");

constexpr int LDS_BYTES = 147456;

struct Args {
    const float* in[28];
    float* out;
    unsigned char* ws;
    int pad; int pad2;
};

struct ArgP { const __attribute__((address_space(4))) Args* p;
    DI const float* in(int i) const { return p->in[i]; } DI float* out() const { return p->out; } DI unsigned char* ws() const { return p->ws; } };
DI unsigned pk2(float lo, float hi) { f32x2 v = {lo, hi}; bf16x2_t b = __builtin_convertvector(v, bf16x2_t); return __builtin_bit_cast(unsigned, b); }
DI bf16_t f2bf(float f) { return (bf16_t)(pk2(f, 0.f) & 0xffffu); }
DI int ltid(int wv) { asm volatile("" : "+s"(wv)); int l = __builtin_amdgcn_mbcnt_hi(~0u, __builtin_amdgcn_mbcnt_lo(~0u, 0u)); asm volatile("" : "+v"(l)); return wv * 64 + l; }
DI int lbid() { int t = blockIdx.x; asm volatile("" : "+s"(t)); return t; }
DI float bf2f(bf16_t b) { return __uint_as_float(((unsigned)b) << 16); }
DI float bflo(unsigned u) { return __uint_as_float(u << 16); }
DI float bfhi(unsigned u) { return __uint_as_float(u & 0xffff0000u); }
DI float wave_sum(float v) {
#pragma unroll
    for (int o = 1; o < 64; o <<= 1) v += __shfl_xor(v, o);
    return v;
}
DI float fexp(float x) { return __builtin_amdgcn_exp2f(x * LOG2E); }
DI float sigmoidf_(float x) { return __builtin_amdgcn_rcpf(1.f + fexp(-x)); }
DI int crow(int r, int hi) { return (r & 3) + 8 * (r >> 2) + 4 * hi; }
typedef unsigned long long u64;
DI float rs_from_ss(u64 ssq) { return rsqrtf((float)ssq * (1.f / (1048576.f * 1024.f)) + EPS); }
DI u64 ss_to_fix(float ss) { return (u64)(ss * 1048576.f); }

namespace pg8 {
constexpr int BM = 256, BK = 64, HALF = 128, HTB = HALF * BK * 2, STAGE_BYTES = 8 * HTB, NXCD = 8, WGM = 8;
DI int lds_byte(int r, int c) { const int st = (r >> 4) * 2 + (c >> 5), rr = r & 15, cc = c & 31, ob = rr * 64 + cc * 2; return st * 1024 + (ob ^ (((ob >> 9) & 1) << 5)); }
DI void stage_rc(int b, int& R, int& C) { const int st = b / 1024, sb = b % 1024, swz = sb ^ (((sb >> 9) & 1) << 5); R = (st >> 1) * 16 + swz / 64; C = (st & 1) * 32 + (swz % 64) / 2; }
DI int perm32(int rho) { const int n = rho >> 4, i = rho & 15; return 8 * (i >> 2) + 4 * n + (i & 3); }
struct Unit { int pm, pn; };
struct StaticOrder {
    int nM, nN, nwg, G, c;
    DI void init(int nM_, int nN_, int G_, int c_) { nM = nM_; nN = nN_; nwg = nM * nN; G = G_; c = c_; }
    DI bool next(int i, Unit& u) const {
        const long L = (long)i * G + c; if (L >= nwg) return false;
        int wgid = (int)L; { const int q = nwg / NXCD, r = nwg % NXCD, xcd = wgid % NXCD, off = wgid / NXCD; wgid = (xcd < r ? xcd * (q + 1) : r * (q + 1) + (xcd - r) * q) + off; }
        const int nig = WGM * nN, gid = wgid / nig, fm = gid * WGM, gsz = (nM - fm) < WGM ? (nM - fm) : WGM;
        u.pm = fm + ((wgid % nig) % gsz); u.pn = (wgid % nig) / gsz; return true;
    }
};

template <bool AMAP, class Epi>
DI void gemm_phase(int wv, LAS unsigned char* lds, const bf16_t* A, int lda, const bf16_t* Bt, int ldb, int K_, int nM, int nN, const Epi& E, int rot = 0) {
    int K = K_; asm volatile("" : "+s"(K));
    const int tid = ltid(wv), wid = __builtin_amdgcn_readfirstlane(tid >> 6), lane = tid & 63, wr = wid >> 2, wc = wid & 3, fr = lane & 15, fq = lane >> 4;
    const int nt = K / BK;
    StaticOrder SO; { int c_ = lbid() - rot; if (c_ < 0) c_ += (int)gridDim.x; SO.init(nM, nN, (int)gridDim.x, c_); }
    unsigned voffA[2], voffB[2];
#pragma unroll
    for (int i = 0; i < 2; ++i) { int R, C; stage_rc(tid * 16 + i * 8192, R, C); const int Rb = (R & ~31) + perm32(R & 31);
        const int Ra = AMAP ? (62 * (R >> 6) + (R & 63) - 2) : R;
        voffA[i] = (unsigned)((Ra + (AMAP ? 2 : 0)) * lda + C) * 2u; voffB[i] = (unsigned)(Rb * ldb + C) * 2u; }
    const size_t kstep = (size_t)(BK * 2);
    const size_t hstepA = (size_t)(AMAP ? 124 : 128) * lda * 2, hstepB = (size_t)HALF * ldb * 2;
    const size_t tstepA = 2 * hstepA, tstepB = 2 * hstepB;
    const unsigned ldsw = (unsigned)wid * 1024u;
    const int aoff = lds_byte(wr * 64 + fr, fq * 8), boff = lds_byte(wc * 32 + fr, fq * 8);
#define PG8_SA(b, h) (((b) * 2 + (h)) * HTB)
#define PG8_SB(b, h) ((4 + (b) * 2 + (h)) * HTB)
#define PG8_STAGE(bufoff, gbase, voff) do { _Pragma("unroll") for (int _i = 0; _i < 2; ++_i) \
        __builtin_amdgcn_global_load_lds((const unsigned*)((const char*)(gbase) + (voff)[_i]), (LAS unsigned*)(lds + (bufoff) + ldsw + _i * 8192), 16, 0, 0); } while (0)
#define PG8_LDA(dst, b, h) do { _Pragma("unroll") for (int m = 0; m < 4; ++m) _Pragma("unroll") for (int k = 0; k < 2; ++k) dst[m][k] = *(const LAS bf16x8*)(lds + PG8_SA(b, h) + aoff + m * 2048 + k * 1024); } while (0)
#define PG8_LDB(dst, b, h) do { _Pragma("unroll") for (int n = 0; n < 2; ++n) _Pragma("unroll") for (int k = 0; k < 2; ++k) dst[n][k] = *(const LAS bf16x8*)(lds + PG8_SB(b, h) + boff + n * 2048 + k * 1024); } while (0)
#define PG8_MMA(ai, bj, At, Bt_) do { __builtin_amdgcn_s_setprio(1); _Pragma("unroll") for (int m = 0; m < 4; ++m) _Pragma("unroll") for (int n = 0; n < 2; ++n) _Pragma("unroll") for (int k = 0; k < 2; ++k) \
        acc[ai][bj][m][n] = __builtin_amdgcn_mfma_f32_16x16x32_bf16(Bt_[n][k], At[m][k], acc[ai][bj][m][n], 0, 0, 0); __builtin_amdgcn_s_setprio(0); } while (0)
#define PG8_WAIT_V(n) asm volatile("s_waitcnt vmcnt(" #n ")" ::: "memory")
#define PG8_WAIT_L(n) asm volatile("s_waitcnt lgkmcnt(" #n ")" ::: "memory")
#define PG8_BAR __builtin_amdgcn_s_barrier()
#define PG8_SCHED __builtin_amdgcn_sched_barrier(0)
    if (AMAP) A -= 2 * lda;
    Unit cur, nxt; int ui = 0;
    if (!SO.next(0, cur)) return;
    f32x4 acc[2][2][4][2];
#pragma unroll
    for (int a = 0; a < 2; ++a)
#pragma unroll
        for (int b = 0; b < 2; ++b)
#pragma unroll
            for (int m = 0; m < 4; ++m)
#pragma unroll
                for (int n = 0; n < 2; ++n) acc[a][b][m][n] = (f32x4){0.f, 0.f, 0.f, 0.f};
    bf16x8 At[4][2], B0[2][2], B1[2][2];
    const char* cA = (const char*)A + (size_t)cur.pm * tstepA; const char* cB = (const char*)Bt + (size_t)cur.pn * tstepB;
    PG8_STAGE(PG8_SB(0, 0), cB, voffB); PG8_STAGE(PG8_SA(0, 0), cA, voffA); PG8_STAGE(PG8_SB(0, 1), cB + hstepB, voffB); PG8_STAGE(PG8_SA(0, 1), cA + hstepA, voffA);
    if (wr == 1) PG8_BAR;
    PG8_WAIT_V(4); PG8_BAR;
    PG8_STAGE(PG8_SB(1, 0), cB + kstep, voffB); PG8_STAGE(PG8_SA(1, 0), cA + kstep, voffA); PG8_STAGE(PG8_SB(1, 1), cB + hstepB + kstep, voffB);
    PG8_WAIT_V(6); PG8_BAR;
    for (;;) {
        const bool has_next = SO.next(ui + 1, nxt);
        const char* nA = has_next ? (const char*)A + (size_t)nxt.pm * tstepA : cA; const char* nB = has_next ? (const char*)Bt + (size_t)nxt.pn * tstepB : cB;
        for (int t = 0; t < nt; t += 2) {
            const bool last = (t == nt - 2);
            const char* a1 = cA + (size_t)(t + 1) * kstep;
            const char* a2 = last ? nA : cA + (size_t)(t + 2) * kstep; const char* b2 = last ? nB : cB + (size_t)(t + 2) * kstep;
            const char* a3 = a2 + kstep; const char* b3 = b2 + kstep;
            PG8_LDB(B0, 0, 0); PG8_SCHED; PG8_LDA(At, 0, 0); PG8_STAGE(PG8_SA(1, 1), a1 + hstepA, voffA);
            PG8_WAIT_L(8); PG8_BAR; PG8_WAIT_L(0); PG8_MMA(0, 0, At, B0); PG8_BAR; PG8_SCHED;
            PG8_LDB(B1, 0, 1); PG8_STAGE(PG8_SB(0, 0), b2, voffB);
            PG8_BAR; PG8_WAIT_L(0); PG8_MMA(0, 1, At, B1); PG8_BAR;
            PG8_LDA(At, 0, 1); PG8_STAGE(PG8_SA(0, 0), a2, voffA);
            PG8_BAR; PG8_WAIT_L(0); PG8_MMA(1, 0, At, B0); PG8_BAR; PG8_SCHED;
            PG8_STAGE(PG8_SB(0, 1), b2 + hstepB, voffB);
            PG8_WAIT_V(6); PG8_BAR; PG8_MMA(1, 1, At, B1); PG8_BAR;
            PG8_LDB(B0, 1, 0); PG8_SCHED; PG8_LDA(At, 1, 0); PG8_STAGE(PG8_SA(0, 1), a2 + hstepA, voffA);
            PG8_WAIT_L(8); PG8_BAR; PG8_WAIT_L(0); PG8_MMA(0, 0, At, B0); PG8_BAR; PG8_SCHED;
            PG8_LDB(B1, 1, 1); PG8_STAGE(PG8_SB(1, 0), b3, voffB);
            PG8_BAR; PG8_WAIT_L(0); PG8_MMA(0, 1, At, B1); PG8_BAR;
            PG8_LDA(At, 1, 1); PG8_STAGE(PG8_SA(1, 0), a3, voffA);
            PG8_BAR; PG8_WAIT_L(0); PG8_MMA(1, 0, At, B0); PG8_BAR; PG8_SCHED;
            PG8_STAGE(PG8_SB(1, 1), b3 + hstepB, voffB);
            PG8_WAIT_V(6); PG8_BAR; PG8_MMA(1, 1, At, B1); PG8_BAR;
        }
        E(acc, cur, wr, wc, fr, fq);
        if (!has_next) break;
#pragma unroll
        for (int a = 0; a < 2; ++a)
#pragma unroll
            for (int b = 0; b < 2; ++b)
#pragma unroll
                for (int m = 0; m < 4; ++m)
#pragma unroll
                    for (int n = 0; n < 2; ++n) acc[a][b][m][n] = (f32x4){0.f, 0.f, 0.f, 0.f};
        cur = nxt; cA = nA; cB = nB; ++ui;
    }
    PG8_WAIT_V(0);
    if (wr == 0) PG8_BAR;
    PG8_BAR;
#undef PG8_SA
#undef PG8_SB
#undef PG8_STAGE
#undef PG8_LDA
#undef PG8_LDB
#undef PG8_MMA
#undef PG8_WAIT_V
#undef PG8_WAIT_L
#undef PG8_BAR
#undef PG8_SCHED
}
}
using pg8::Unit;
typedef f32x4 AccT[2][2][4][2];

template <int SMODE> struct EpiRowBf16 {
    bf16_t* O; int ldc; const void* sc;
    DI void operator()(const AccT& acc, const Unit& u, int wr, int wc, int fr, int fq) const {
        const int row0 = u.pm * 256 + wr * 64 + fr, col0 = u.pn * 256 + wc * 32 + 8 * fq;
#pragma unroll
        for (int ai = 0; ai < 2; ++ai)
#pragma unroll
            for (int m = 0; m < 4; ++m) { const int row = row0 + ai * 128 + m * 16;
                float s = 1.f; if (SMODE == 1) s = rs_from_ss(((const u64*)sc)[row]); if (SMODE == 2) s = ((const float*)sc)[row];
                bf16_t* rowp = O + (size_t)row * ldc + col0;
#pragma unroll
                for (int bj = 0; bj < 2; ++bj) { const f32x4 v0 = acc[ai][bj][m][0] * s, v1 = acc[ai][bj][m][1] * s;
                    u32x4 w; w.x = pk2(v0[0], v0[1]); w.y = pk2(v0[2], v0[3]); w.z = pk2(v1[0], v1[1]); w.w = pk2(v1[2], v1[3]);
                    *(u32x4*)(rowp + bj * 128) = w; } }
    }
};
template <int SMODE> struct EpiColBf16 {
    bf16_t* O; int ldc; const void* sc;
    DI void operator()(const AccT& acc, const Unit& u, int wr, int wc, int fr, int fq) const {
        const int row0 = u.pm * 256 + wr * 64 + fr, col0 = u.pn * 256 + wc * 32 + 8 * fq;
#pragma unroll
        for (int bj = 0; bj < 2; ++bj) { float s[8];
#pragma unroll
            for (int j = 0; j < 8; ++j) s[j] = (SMODE == 1) ? rs_from_ss(((const u64*)sc)[col0 + bj * 128 + j]) : ((const float*)sc)[col0 + bj * 128 + j];
#pragma unroll
            for (int ai = 0; ai < 2; ++ai)
#pragma unroll
                for (int m = 0; m < 4; ++m) { const int row = row0 + ai * 128 + m * 16; const f32x4 v0 = acc[ai][bj][m][0], v1 = acc[ai][bj][m][1];
                    u32x4 w; w.x = pk2(v0[0] * s[0], v0[1] * s[1]); w.y = pk2(v0[2] * s[2], v0[3] * s[3]); w.z = pk2(v1[0] * s[4], v1[1] * s[5]); w.w = pk2(v1[2] * s[6], v1[3] * s[7]);
                    *(u32x4*)(O + (size_t)row * ldc + col0 + bj * 128) = w; } }
    }
};
struct EpiQ {
    bf16_t* QB; const float* rsq; const float* cstab;
    DI void operator()(const AccT& acc, const Unit& u, int wr, int wc, int fr, int fq) const {
        const int row0 = u.pm * 256 + wr * 64 + fr, col0 = u.pn * 256 + wc * 32 + 8 * fq;
        const float QS = 0.10206207261596577f * LOG2E;
#pragma unroll
        for (int ai = 0; ai < 2; ++ai)
#pragma unroll
            for (int m = 0; m < 4; ++m) { const int t = row0 + ai * 128 + m * 16; const float s = rsq[t] * QS;
#pragma unroll
                for (int bj = 0; bj < 2; ++bj) { const int c = col0 + bj * 128, h = c / 96, d = c - h * 96;
                    f32x4 v0 = acc[ai][bj][m][0] * s, v1 = acc[ai][bj][m][1] * s;
                    if (d >= 64) { const int i0 = (d - 64) >> 1; const f32x4 cs0 = *(const f32x4*)(cstab + (size_t)t * 32 + 2 * i0), cs1 = *(const f32x4*)(cstab + (size_t)t * 32 + 2 * i0 + 4);
                        f32x4 a, b;
                        a[0] = v0[0] * cs0[0] - v0[1] * cs0[1]; a[1] = v0[1] * cs0[0] + v0[0] * cs0[1];
                        a[2] = v0[2] * cs0[2] - v0[3] * cs0[3]; a[3] = v0[3] * cs0[2] + v0[2] * cs0[3];
                        b[0] = v1[0] * cs1[0] - v1[1] * cs1[1]; b[1] = v1[1] * cs1[0] + v1[0] * cs1[1];
                        b[2] = v1[2] * cs1[2] - v1[3] * cs1[3]; b[3] = v1[3] * cs1[2] + v1[2] * cs1[3];
                        v0 = a; v1 = b; }
                    u32x4 w; w.x = pk2(v0[0], v0[1]); w.y = pk2(v0[2], v0[3]); w.z = pk2(v1[0], v1[1]); w.w = pk2(v1[2], v1[3]);
                    *(u32x4*)(QB + ((size_t)h * S + t) * 96 + d) = w; } }
    }
};
struct EpiK {
    bf16_t* KB; const float* rskv;
    DI void operator()(const AccT& acc, const Unit& u, int wr, int wc, int fr, int fq) const {
        const int row0 = u.pm * 256 + wr * 64 + fr, col0 = u.pn * 256 + wc * 32 + 8 * fq;
#pragma unroll
        for (int ai = 0; ai < 2; ++ai)
#pragma unroll
            for (int m = 0; m < 4; ++m) { const int t = row0 + ai * 128 + m * 16; const float s = rskv[t];
#pragma unroll
                for (int bj = 0; bj < 2; ++bj) { const int c = col0 + bj * 128, h = c >> 6, d = c & 63;
                    const f32x4 v0 = acc[ai][bj][m][0] * s, v1 = acc[ai][bj][m][1] * s;
                    u32x4 w; w.x = pk2(v0[0], v0[1]); w.y = pk2(v0[2], v0[3]); w.z = pk2(v1[0], v1[1]); w.w = pk2(v1[2], v1[3]);
                    *(u32x4*)(KB + ((size_t)h * S + t) * 96 + d) = w; } }
    }
};
template <bool RESBF> struct EpiRes {
    const float* res; bf16_t* XB; u64* rowss; int dry;
    DI void operator()(const AccT& acc, const Unit& u, int wr, int wc, int fr, int fq) const {
        const int row0 = u.pm * 256 + wr * 64 + fr, col0 = u.pn * 256 + wc * 32 + 8 * fq;
#pragma unroll
        for (int ai = 0; ai < 2; ++ai)
#pragma unroll
            for (int m = 0; m < 4; ++m) { const int t = row0 + ai * 128 + m * 16; float ss = 0.f;
#pragma unroll
                for (int bj = 0; bj < 2; ++bj) { const size_t o = (size_t)t * 1024 + col0 + bj * 128;
                    f32x4 r0, r1;
                    if (RESBF) { const u32x4 rb = *(const u32x4*)(XB + o); r0 = (f32x4){bflo(rb.x), bfhi(rb.x), bflo(rb.y), bfhi(rb.y)}; r1 = (f32x4){bflo(rb.z), bfhi(rb.z), bflo(rb.w), bfhi(rb.w)}; }
                    else { r0 = *(const f32x4*)(res + o); r1 = *(const f32x4*)(res + o + 4); }
                    const f32x4 v0 = acc[ai][bj][m][0] + r0, v1 = acc[ai][bj][m][1] + r1;
                    u32x4 w; w.x = pk2(v0[0], v0[1]); w.y = pk2(v0[2], v0[3]); w.z = pk2(v1[0], v1[1]); w.w = pk2(v1[2], v1[3]);
                    if (!dry) *(u32x4*)(XB + o) = w;
                    ss += v0[0] * v0[0] + v0[1] * v0[1] + v0[2] * v0[2] + v0[3] * v0[3] + v1[0] * v1[0] + v1[1] * v1[1] + v1[2] * v1[2] + v1[3] * v1[3]; }
                ss += __shfl_xor(ss, 16); ss += __shfl_xor(ss, 32);
                if (fq == 0 && !dry) atomicAdd(rowss + t, ss_to_fix(ss)); }
    }
};
DI float dpp_prev1(float cur, float prevm) {
    const int o = __builtin_amdgcn_update_dpp(0, __builtin_bit_cast(int, prevm), 0x121, 0xf, 0xf, false);
    return __builtin_bit_cast(float, __builtin_amdgcn_update_dpp(o, __builtin_bit_cast(int, cur), 0x111, 0xf, 0xf, false));
}
DI float dpp_prev2(float cur, float prevm) {
    const int o = __builtin_amdgcn_update_dpp(0, __builtin_bit_cast(int, prevm), 0x122, 0xf, 0xf, false);
    return __builtin_bit_cast(float, __builtin_amdgcn_update_dpp(o, __builtin_bit_cast(int, cur), 0x112, 0xf, 0xf, false));
}
struct EpiUp {
    bf16_t* ACT; const u64* rowss; const float* cw; const float* cb; LAS unsigned char* plds;
    DI void operator()(const AccT& acc, const Unit& u, int wr, int wc, int fr, int fq) const {
        const int cl = u.pn * 128 + wc * 32 + 8 * fq;
        LAS float* P = (LAS float*)(plds + (wr * 4 + wc) * 1024);
        { const int lane = fq * 16 + fr, kind = lane >> 3, c4 = 4 * (lane & 7), k3 = kind & 3;
          const float* src = (k3 == 0 ? cb : cw + (k3 - 1) * 5632) + (kind >= 4 ? 2816 : 0) + u.pn * 128 + wc * 32 + c4;
          *(LAS f32x4*)(P + kind * 32 + c4) = *(const f32x4*)src; }
#pragma unroll
        for (int ai = 0; ai < 2; ++ai) {
            const int tok0 = u.pm * 248 + 62 * (2 * ai + wr) - 2 + fr;
            float rs[4];
#pragma unroll
            for (int m = 0; m < 4; ++m) { const int t = tok0 + 16 * m; const int tc = t < 0 ? 0 : (t >= S ? S - 1 : t); const float r = rs_from_ss(rowss[tc]); rs[m] = t < 0 ? 0.f : r; }
            const int row0 = fr < 2 ? (S + 236 + fr) : tok0;
#pragma unroll
            for (int n = 0; n < 2; ++n) {
                const int lc = 8 * fq + 4 * n;
                unsigned wpk[4][2];
#pragma unroll
                for (int jp = 0; jp < 2; ++jp) {
                    const f32x2 bg = *(const LAS f32x2*)(P + lc + 2 * jp), g0 = *(const LAS f32x2*)(P + 32 + lc + 2 * jp), g1 = *(const LAS f32x2*)(P + 64 + lc + 2 * jp), g2 = *(const LAS f32x2*)(P + 96 + lc + 2 * jp);
                    const f32x2 bv = *(const LAS f32x2*)(P + 128 + lc + 2 * jp), v0 = *(const LAS f32x2*)(P + 160 + lc + 2 * jp), v1 = *(const LAS f32x2*)(P + 192 + lc + 2 * jp), v2 = *(const LAS f32x2*)(P + 224 + lc + 2 * jp);
                    f32x2 G[4], V[4];
#pragma unroll
                    for (int m = 0; m < 4; ++m) { G[m] = (f32x2){acc[ai][0][m][n][2 * jp], acc[ai][0][m][n][2 * jp + 1]} * rs[m]; V[m] = (f32x2){acc[ai][1][m][n][2 * jp], acc[ai][1][m][n][2 * jp + 1]} * rs[m]; }
#pragma unroll
                    for (int m = 0; m < 4; ++m) {
                        const f32x2 zz = {0.f, 0.f}; const f32x2 Gp = m ? G[m - 1] : zz, Vp = m ? V[m - 1] : zz;
                        const f32x2 gp1 = {dpp_prev1(G[m].x, Gp.x), dpp_prev1(G[m].y, Gp.y)}, gp2 = {dpp_prev2(G[m].x, Gp.x), dpp_prev2(G[m].y, Gp.y)};
                        const f32x2 vp1 = {dpp_prev1(V[m].x, Vp.x), dpp_prev1(V[m].y, Vp.y)}, vp2 = {dpp_prev2(V[m].x, Vp.x), dpp_prev2(V[m].y, Vp.y)};
                        const f32x2 gc = bg + g0 * gp2 + g1 * gp1 + g2 * G[m];
                        const f32x2 vc = bv + v0 * vp2 + v1 * vp1 + v2 * V[m];
                        const f32x2 xe = gc * (-LOG2E);
                        f32x2 dn = {__builtin_amdgcn_exp2f(xe.x), __builtin_amdgcn_exp2f(xe.y)}; dn = dn + 1.0f;
                        const f32x2 rc = {__builtin_amdgcn_rcpf(dn.x), __builtin_amdgcn_rcpf(dn.y)};
                        const f32x2 rr = gc * rc * vc;
                        wpk[m][jp] = pk2(rr.x, rr.y); }
                }
#pragma unroll
                for (int m = 0; m < 4; ++m) { const int row = m ? tok0 + 16 * m : row0;
                    *(u32x2*)(ACT + (size_t)row * 2816 + cl + 4 * n) = (u32x2){wpk[m][0], wpk[m][1]}; }
                __builtin_amdgcn_sched_barrier(0);
            }
        }
    }
};

template <class F> DI void tr_items(const F& f, int Kdst, int Nrows, bf16_t* WT, LAS float* scr, int gw, int NGW, int lane, int& cum) {
    const int nblk = Nrows / 32, nitems = (Kdst / 64) * nblk;
    int first = (gw - cum) % NGW; if (first < 0) first += NGW; cum = (cum + nitems) % NGW;
    for (int item = first; item < nitems; item += NGW) {
        const int kb = item / nblk, nb = item % nblk, k0 = 64 * kb, n0 = 32 * nb;
        float tv[32];
#pragma unroll
        for (int i = 0; i < 32; ++i) tv[i] = f(k0 + 2 * i + (lane >> 5), n0 + (lane & 31));
#pragma unroll
        for (int i = 0; i < 32; ++i) scr[(2 * i + (lane >> 5)) * 33 + (lane & 31)] = tv[i];
        asm volatile("s_waitcnt lgkmcnt(0)" ::: "memory");
        const int c = lane & 7;
#pragma unroll
        for (int j = 0; j < 4; ++j) { const int n = (lane >> 3) + 8 * j; const LAS float* s = scr + (8 * c) * 33 + n;
            u32x4 o; o.x = pk2(s[0 * 33], s[1 * 33]); o.y = pk2(s[2 * 33], s[3 * 33]); o.z = pk2(s[4 * 33], s[5 * 33]); o.w = pk2(s[6 * 33], s[7 * 33]);
            *(u32x4*)(WT + (size_t)(n0 + n) * Kdst + k0 + 8 * c) = o; }
        asm volatile("s_waitcnt lgkmcnt(0)" ::: "memory");
    }
}
struct FW1 { const float* W; const float* g; DI float operator()(int k, int n) const { return n < 1440 ? W[(size_t)k * 1440 + n] * g[k] : 0.f; } };
struct FWQ { const float* W; const float* g; DI float operator()(int k, int n) const { const int h = n / 96, d = n - h * 96; int c = d; if (d >= 64) { const int r = d - 64; c = 64 + (r >> 1) + 16 * (r & 1); } return W[(size_t)k * 768 + h * 96 + c] * g[k]; } };
struct FWKV { const float* W; const float* g; int off; DI float operator()(int k, int n) const { return k < 128 ? W[(size_t)k * 1024 + (n >> 6) * 128 + off + (n & 63)] * g[k] : 0.f; } };
struct FWRI { const float* Wa; const float* Wx; DI float operator()(int k, int n) const { const float* W = n < 512 ? Wa : Wx; const int ch = n & 511, g = ch >> 6, j = ch & 63; return (k >> 6) == g ? W[(size_t)k * 64 + j] : 0.f; } };
struct FWP { const float* W; int N; DI float operator()(int k, int n) const { return W[(size_t)k * N + n]; } };
struct FWUP { const float* W; const float* g; DI float operator()(int k, int n) const { const int pn = n >> 8, r = n & 255; const int c = r < 128 ? 128 * pn + r : 2816 + 128 * pn + r - 128; return W[(size_t)k * 5632 + c] * g[k]; } };
struct FWOIN { const float* W; const float* g; DI float operator()(int k, int n) const {
    int c; float s = 1.f; if (n < 512) { c = n; s = 0.08838834764831845f; } else if (n < 1536) c = 2048 + (n - 512); else if (n < 2048) c = 512 + (n - 1536); else c = 1024 + (n - 2048);
    return W[(size_t)k * 3080 + c] * g[k] * s; } };

#ifndef PROPART
#define PROPART 7
#endif
DI void phase_prologue(int wv, const ArgP a, LAS unsigned char* lds, int parts) {
    unsigned char* ws = a.ws();
    const int tid = ltid(wv), wave = tid >> 6, lane = tid & 63;
    LAS float* scr = (LAS float*)(lds + wave * 8448);
    const int gw = blockIdx.x * 8 + wave, NGW = gridDim.x * 8; int cum = 0;
    if (parts & 1) {
    { FW1 f{a.in(3), a.in(2)}; tr_items(f, 1024, 1536, (bf16_t*)(ws + O_W1T), scr, gw, NGW, lane, cum); }
    { FWQ f{a.in(12), a.in(11)}; tr_items(f, 256, 768, (bf16_t*)(ws + O_WQT), scr, gw, NGW, lane, cum); }
    { FWKV f{a.in(14), a.in(13), 0}; tr_items(f, 256, 512, (bf16_t*)(ws + O_WKT), scr, gw, NGW, lane, cum); }
    { FWKV f{a.in(14), a.in(13), 64}; tr_items(f, 256, 512, (bf16_t*)(ws + O_WVT), scr, gw, NGW, lane, cum); }
    { FWRI f{a.in(6), a.in(8)}; tr_items(f, 512, 1024, (bf16_t*)(ws + O_WRIT), scr, gw, NGW, lane, cum); }
    { FWP f{a.in(15), 1024}; tr_items(f, 1024, 1024, (bf16_t*)(ws + O_WO1T), scr, gw, NGW, lane, cum); }
    for (int l = 0; l < 2; ++l) {
        { FWUP f{a.in(23) + (size_t)l * 1024 * 5632, a.in(22) + l * 1024}; tr_items(f, 1024, 5632, (bf16_t*)(ws + (l ? O_WUPT1 : O_WUPT0)), scr, gw, NGW, lane, cum); }
        { FWP f{a.in(26) + (size_t)l * 2816 * 1024, 1024}; tr_items(f, 2816, 1024, (bf16_t*)(ws + (l ? O_WDNT1 : O_WDNT0)), scr, gw, NGW, lane, cum); }
    }
    { FWOIN f{a.in(17), a.in(16)}; tr_items(f, 1024, 3072, (bf16_t*)(ws + O_WOINT), scr, gw, NGW, lane, cum); }
    { FWP f{a.in(21), 1024}; tr_items(f, 1024, 1024, (bf16_t*)(ws + O_WO2T), scr, gw, NGW, lane, cum); }
    }
    if (parts & 2) {
    const float* x = a.in(0); bf16_t* XB = (bf16_t*)(ws + O_XB) + 2 * 1024; u64* rowss = (u64*)(ws + O_ROWSS);
#pragma unroll 4
    for (int t = gw; t < S; t += NGW) {
        float ss = 0.f;
#pragma unroll
        for (int j = 0; j < 4; ++j) { const f32x4 v = *(const f32x4*)(x + (size_t)t * 1024 + j * 256 + lane * 4);
            ss += v[0] * v[0] + v[1] * v[1] + v[2] * v[2] + v[3] * v[3];
            u32x2 w; w.x = pk2(v[0], v[1]); w.y = pk2(v[2], v[3]); *(u32x2*)(XB + (size_t)t * 1024 + j * 256 + lane * 4) = w; }
        ss = wave_sum(ss);
        if (lane == 0) rowss[t] = ss_to_fix(ss);
        if (lane >= 1 && lane < 5) rowss[(size_t)lane * S + t] = 0ull;
    }
    }
    if (parts & 4) {
    const int* pos = (const int*)a.in(1); float* cst = (float*)(ws + O_CSTAB);
    for (int e = blockIdx.x * 512 + tid; e < S * 16; e += gridDim.x * 512) { const int t = e >> 4, i = e & 15;
        const float invf = __builtin_amdgcn_exp2f(-(float)i * (13.287712379549449f / 16.f)); const float ang = (float)pos[t] * invf;
        const float k = rintf(ang * 0.15915494309189535f);
        float r = fmaf(-k, 6.28318548202514648f, ang); r = fmaf(-k, -1.7484555e-7f, r);
        const float rr = r * 0.15915494309189535f;
        cst[2 * e] = __builtin_amdgcn_cosf(rr); cst[2 * e + 1] = __builtin_amdgcn_sinf(rr); }
    }
}

DI void phase_l0_prep(int wv, const ArgP a) {
    unsigned char* ws = a.ws();
    const bf16_t* Z = (const bf16_t*)(ws + O_Z); bf16_t* XC = (bf16_t*)(ws + O_XC); bf16_t* KB = (bf16_t*)(ws + O_KB);
    float* rsq = (float*)(ws + O_RSQ); float* rskv = (float*)(ws + O_RSKV); const float* cst = (const float*)(ws + O_CSTAB);
    const float* cw = a.in(4); const float* cb = a.in(5);
    const int tid = ltid(wv), wave = tid >> 6, lane = tid & 63;
#pragma unroll 2
    for (int e = blockIdx.x * 512 + tid; e < S * 64; e += gridDim.x * 512) { const int t = e >> 6, c0 = (e & 63) * 8;
        float acc[8];
#pragma unroll
        for (int j = 0; j < 8; ++j) acc[j] = cb[c0 + j];
#pragma unroll
        for (int k = 0; k < 4; ++k) { const int tt = t - 3 + k; if (tt < 0) continue;
            const u32x4 v = *(const u32x4*)(Z + (size_t)tt * 1536 + c0);
            const f32x4 w0 = *(const f32x4*)(cw + k * 512 + c0), w1 = *(const f32x4*)(cw + k * 512 + c0 + 4);
            acc[0] += w0[0] * bflo(v.x); acc[1] += w0[1] * bfhi(v.x); acc[2] += w0[2] * bflo(v.y); acc[3] += w0[3] * bfhi(v.y);
            acc[4] += w1[0] * bflo(v.z); acc[5] += w1[1] * bfhi(v.z); acc[6] += w1[2] * bflo(v.w); acc[7] += w1[3] * bfhi(v.w); }
        u32x4 o; o.x = pk2(acc[0], acc[1]); o.y = pk2(acc[2], acc[3]); o.z = pk2(acc[4], acc[5]); o.w = pk2(acc[6], acc[7]);
        *(u32x4*)(XC + (size_t)t * 512 + c0) = o; }
#pragma unroll 4
    for (int t = blockIdx.x * 8 + wave; t < S; t += gridDim.x * 8) {
        const bf16_t* zr = Z + (size_t)t * 1536;
        float sq = 0.f, skv = 0.f;
        { const u32x2 v = *(const u32x2*)(zr + 1024 + lane * 4); const float p0 = bflo(v.x), p1 = bfhi(v.x), p2 = bflo(v.y), p3 = bfhi(v.y); sq = p0 * p0 + p1 * p1 + p2 * p2 + p3 * p3; }
        { const unsigned v = *(const unsigned*)(zr + 1280 + lane * 2); const float p0 = bflo(v), p1 = bfhi(v); skv = p0 * p0 + p1 * p1; }
        sq = wave_sum(sq); skv = wave_sum(skv);
        if (lane == 0) { rsq[t] = rsqrtf(sq * (1.f / 256.f) + EPS); rskv[t] = rsqrtf(skv * (1.f / 128.f) + EPS); }
        if (lane < 16) { const float x1 = bf2f(zr[1408 + lane]), x2 = bf2f(zr[1424 + lane]); const float c = cst[(size_t)t * 32 + 2 * lane], s = cst[(size_t)t * 32 + 2 * lane + 1];
            const unsigned w = pk2(x1 * c - x2 * s, x2 * c + x1 * s);
#pragma unroll
            for (int h = 0; h < 8; ++h) *(unsigned*)(KB + ((size_t)h * S + t) * 96 + 64 + 2 * lane) = w; }
    }
}

DI void lru_coeff(float rpre, float ipre, float xc, float sp8, float& av, float& uv) {
    const float r = sigmoidf_(rpre), ig = sigmoidf_(ipre);
    const float la = -sp8 * r;
    av = fexp(la);
    uv = __builtin_amdgcn_sqrtf(fmaxf(1.f - av * av, 0.f)) * (ig * xc);
}
DI void phase_lru_s1(int wv, const ArgP a) {
    unsigned char* ws = a.ws(); const int ch = ltid(wv);
    const bf16_t* RI = (const bf16_t*)(ws + O_RI); const bf16_t* XC = (const bf16_t*)(ws + O_XC);
    float* CHA = (float*)(ws + O_CHA); float* CHH = (float*)(ws + O_CHH);
    const float ba = a.in(7)[ch], bx = a.in(9)[ch]; const float lam = a.in(10)[ch];
    const float sp8 = 8.f * log1pf(expf(-lam));
    for (int c = blockIdx.x; c < 256; c += gridDim.x) {
        float A = 1.f, H = 0.f;
#pragma unroll 8
        for (int i = 0; i < 64; ++i) { const size_t t = (size_t)c * 64 + i;
            float av, uv; lru_coeff(bf2f(RI[t * 1024 + ch]) + ba, bf2f(RI[t * 1024 + 512 + ch]) + bx, bf2f(XC[t * 512 + ch]), sp8, av, uv);
            A *= av; H = av * H + uv; }
        CHA[c * 512 + ch] = A; CHH[c * 512 + ch] = H;
    }
}
DI void phase_lru_s3(int wv, const ArgP a) {
    unsigned char* ws = a.ws(); const int ch = ltid(wv);
    const bf16_t* RI = (const bf16_t*)(ws + O_RI); const bf16_t* XC = (const bf16_t*)(ws + O_XC); const bf16_t* Z = (const bf16_t*)(ws + O_Z);
    const float* CHA = (const float*)(ws + O_CHA); const float* CHH = (const float*)(ws + O_CHH); bf16_t* MIX = (bf16_t*)(ws + O_MIX);
    const float ba = a.in(7)[ch], bx = a.in(9)[ch]; const float lam = a.in(10)[ch];
    const float sp8 = 8.f * log1pf(expf(-lam));
    for (int c = blockIdx.x; c < 256; c += gridDim.x) {
        float H = 0.f;
#pragma unroll 16
        for (int cc = 0; cc < c; ++cc) H = CHA[cc * 512 + ch] * H + CHH[cc * 512 + ch];
#pragma unroll 4
        for (int i = 0; i < 64; ++i) { const size_t t = (size_t)c * 64 + i;
            float av, uv; lru_coeff(bf2f(RI[t * 1024 + ch]) + ba, bf2f(RI[t * 1024 + 512 + ch]) + bx, bf2f(XC[t * 512 + ch]), sp8, av, uv);
            H = av * H + uv;
            const float g = bf2f(Z[t * 1536 + 512 + ch]);
            const float y = 0.7978845608028654f * (g + 0.044715f * g * g * g);
            const float th = 1.f - 2.f * __builtin_amdgcn_rcpf(1.f + fexp(2.f * y));
            MIX[t * 1024 + ch] = f2bf(H * 0.5f * g * (1.f + th)); }
    }
}

constexpr int AT_KROW = 208, AT_VROW = 136, AT_KT = 64 * AT_KROW, AT_VT = 64 * AT_VROW;
DI float rowmax32(const f32x16& p0, const f32x16& p1) {
    float a = fmaxf(fmaxf(p0[0], p0[1]), p1[0]), b = fmaxf(fmaxf(p0[2], p0[3]), p1[1]); a = fmaxf(fmaxf(a, p1[2]), p1[3]);
#pragma unroll
    for (int r = 4; r < 16; r += 4) { a = fmaxf(fmaxf(a, p0[r]), p0[r + 1]); b = fmaxf(fmaxf(b, p0[r + 2]), p0[r + 3]); a = fmaxf(fmaxf(a, p1[r]), p1[r + 1]); b = fmaxf(fmaxf(b, p1[r + 2]), p1[r + 3]); }
    const float m = fmaxf(a, b);
    return fmaxf(m, __shfl_xor(m, 32));
}
DI void attn_unit(int wv, int h, int qb, const bf16_t* QB, const bf16_t* KB, const bf16_t* VT, bf16_t* MIX, LAS unsigned char* lds) {
    const int tid = ltid(wv), lane = tid & 63, r32 = lane & 31, hi = lane >> 5; const int wid = __builtin_amdgcn_readfirstlane(tid >> 6);
    const int qg = qb * 256 + wid * 32 + r32;
    const bf16_t* Kh = KB + (size_t)h * S * 96; const bf16_t* Vh = VT + (size_t)h * 64 * S;
    bf16x8 qf[6];
    { const bf16_t* qp = QB + ((size_t)h * S + qg) * 96 + 8 * hi;
#pragma unroll
      for (int s = 0; s < 6; ++s) qf[s] = *(const bf16x8*)(qp + 16 * s); }
    f32x16 o0 = {}, o1 = {}, negm = {};
    float mref = 0.f, lrun = 0.f;
    const int NT = 4 * qb + 4, wlim = 4 * qb + (wid >> 1);
    const int kc0 = tid, kkey0 = kc0 / 12, kpart0 = kc0 % 12;
    const int kc1 = tid + 512, kkey1 = kc1 / 12, kpart1 = kc1 % 12;
    const int vdv = tid >> 3, vpart = tid & 7;
    u32x4 rk0, rk1 = {}, rv;
#define AT_LOADK(t_) do { const size_t kb_ = (size_t)(t_) * 64; rk0 = *(const u32x4*)(Kh + (kb_ + kkey0) * 96 + kpart0 * 8); if (tid < 256) rk1 = *(const u32x4*)(Kh + (kb_ + kkey1) * 96 + kpart1 * 8); } while (0)
#define AT_LOADV(t_) do { rv = *(const u32x4*)(Vh + (size_t)vdv * S + (size_t)(t_) * 64 + vpart * 8); } while (0)
#define AT_WRITEK(t_) do { LAS unsigned char* Ks_ = lds + ((t_) & 1) * AT_KT; *(LAS u32x4*)(Ks_ + kkey0 * AT_KROW + kpart0 * 16) = rk0; if (tid < 256) *(LAS u32x4*)(Ks_ + kkey1 * AT_KROW + kpart1 * 16) = rk1; } while (0)
#define AT_WRITEV(t_) do { LAS unsigned char* Vs_ = lds + 2 * AT_KT + ((t_) & 1) * AT_VT; *(LAS u32x2*)(Vs_ + vdv * AT_VROW + vpart * 16) = (u32x2){rv.x, rv.y}; *(LAS u32x2*)(Vs_ + vdv * AT_VROW + vpart * 16 + 8) = (u32x2){rv.z, rv.w}; } while (0)
#define AT_QK(P0, P1, t_) do { const LAS unsigned char* Ks_ = lds + ((t_) & 1) * AT_KT + r32 * AT_KROW + 16 * hi; f32x16 c0_ = negm, c1_ = negm; \
        _Pragma("unroll") for (int s = 0; s < 6; ++s) { const bf16x8 k0_ = *(const LAS bf16x8*)(Ks_ + 32 * s), k1_ = *(const LAS bf16x8*)(Ks_ + 32 * AT_KROW + 32 * s); \
            c0_ = __builtin_amdgcn_mfma_f32_32x32x16_bf16(k0_, qf[s], c0_, 0, 0, 0); c1_ = __builtin_amdgcn_mfma_f32_32x32x16_bf16(k1_, qf[s], c1_, 0, 0, 0); } \
        P0 = c0_; P1 = c1_; } while (0)
#define AT_SM1(P0, P1, MOFF, t_, MASK) do { \
        { const float d_ = mref - MOFF; if (__any(d_ != 0.f)) { _Pragma("unroll") for (int r = 0; r < 16; ++r) { P0[r] -= d_; P1[r] -= d_; } } } \
        if (MASK && (t_) == wlim) { const int kbase_ = (t_) * 64 + 4 * hi; \
            _Pragma("unroll") for (int r = 0; r < 16; ++r) { const int kv_ = kbase_ + (r & 3) + 8 * (r >> 2); if (kv_ > qg) P0[r] = -1e30f; if (kv_ + 32 > qg) P1[r] = -1e30f; } } \
        const float mx_ = rowmax32(P0, P1); \
        if ((t_) == 0 || __any(mx_ > 8.f)) { const float dl_ = ((t_) == 0) ? mx_ : fmaxf(mx_, 0.f); mref += dl_; \
            _Pragma("unroll") for (int r = 0; r < 16; ++r) { P0[r] -= dl_; P1[r] -= dl_; } \
            const float al_ = __builtin_amdgcn_exp2f(-dl_); lrun *= al_; \
            _Pragma("unroll") for (int r = 0; r < 16; ++r) { o0[r] *= al_; o1[r] *= al_; negm[r] = -mref; } asm volatile("" : "+v"(negm)); } \
    } while (0)
#define AT_SM2(P0, P1, t_) do { \
        float ps_ = 0.f; \
        _Pragma("unroll") for (int r = 0; r < 16; ++r) { P0[r] = __builtin_amdgcn_exp2f(P0[r]); P1[r] = __builtin_amdgcn_exp2f(P1[r]); ps_ += P0[r] + P1[r]; } \
        lrun += ps_; \
        const LAS unsigned char* Vs_ = lds + 2 * AT_KT + ((t_) & 1) * AT_VT + r32 * AT_VROW + 8 * hi; \
        _Pragma("unroll") for (int ks = 0; ks < 4; ++ks) { u32x4 w_; \
            if (ks < 2) { w_.x = pk2(P0[8 * ks], P0[8 * ks + 1]); w_.y = pk2(P0[8 * ks + 2], P0[8 * ks + 3]); w_.z = pk2(P0[8 * ks + 4], P0[8 * ks + 5]); w_.w = pk2(P0[8 * ks + 6], P0[8 * ks + 7]); } \
            else { w_.x = pk2(P1[8 * ks - 16], P1[8 * ks - 15]); w_.y = pk2(P1[8 * ks - 14], P1[8 * ks - 13]); w_.z = pk2(P1[8 * ks - 12], P1[8 * ks - 11]); w_.w = pk2(P1[8 * ks - 10], P1[8 * ks - 9]); } \
            const bf16x8 pa_ = __builtin_bit_cast(bf16x8, w_); \
            const u32x2 a0_ = *(const LAS u32x2*)(Vs_ + 32 * ks), a1_ = *(const LAS u32x2*)(Vs_ + 32 * ks + 16); \
            const u32x2 b0_ = *(const LAS u32x2*)(Vs_ + 32 * AT_VROW + 32 * ks), b1_ = *(const LAS u32x2*)(Vs_ + 32 * AT_VROW + 32 * ks + 16); \
            o0 = __builtin_amdgcn_mfma_f32_32x32x16_bf16(__builtin_bit_cast(bf16x8, (u32x4){a0_.x, a0_.y, a1_.x, a1_.y}), pa_, o0, 0, 0, 0); \
            o1 = __builtin_amdgcn_mfma_f32_32x32x16_bf16(__builtin_bit_cast(bf16x8, (u32x4){b0_.x, b0_.y, b1_.x, b1_.y}), pa_, o1, 0, 0, 0); } \
    } while (0)
#define AT_STEPM(C0, C1, MC, N0, N1, MN, t_) do { \
        AT_WRITEK((t_) + 1); AT_WRITEV(t_); \
        __syncthreads(); \
        AT_LOADK((t_) + 2); AT_LOADV((t_) + 1); \
        AT_SM1(C0, C1, MC, t_, 0); MN = mref; AT_QK(N0, N1, (t_) + 1); AT_SM2(C0, C1, t_); \
    } while (0)
#define AT_STEPB(C0, C1, MC, N0, N1, MN, t_) do { \
        if ((t_) + 1 < NT) AT_WRITEK((t_) + 1); AT_WRITEV(t_); \
        __syncthreads(); \
        if ((t_) + 2 < NT) AT_LOADK((t_) + 2); if ((t_) + 1 < NT) AT_LOADV((t_) + 1); \
        if ((t_) + 1 <= wlim) { MN = mref; AT_QK(N0, N1, (t_) + 1); } \
        if ((t_) <= wlim) { AT_SM1(C0, C1, MC, t_, 1); AT_SM2(C0, C1, t_); } \
    } while (0)
    f32x16 pA0, pA1, pB0 = {}, pB1 = {}; float mA = 0.f, mB = 0.f;
    AT_LOADK(0); AT_WRITEK(0);
    __syncthreads();
    AT_LOADK(1); AT_LOADV(0);
    AT_QK(pA0, pA1, 0);
    int t = 0;
    for (; t < 4 * qb; t += 2) {
        AT_STEPM(pA0, pA1, mA, pB0, pB1, mB, t);
        AT_STEPM(pB0, pB1, mB, pA0, pA1, mA, t + 1);
    }
    for (; t < NT; t += 2) {
        AT_STEPB(pA0, pA1, mA, pB0, pB1, mB, t);
        AT_STEPB(pB0, pB1, mB, pA0, pA1, mA, t + 1);
    }
#undef AT_STEPM
#undef AT_STEPB
#undef AT_LOADK
#undef AT_LOADV
#undef AT_WRITEK
#undef AT_WRITEV
#undef AT_QK
#undef AT_SM1
#undef AT_SM2
    lrun += __shfl_xor(lrun, 32);
    const float inv = 1.f / lrun;
    bf16_t* op = MIX + (size_t)qg * 1024 + 512 + h * 64;
#pragma unroll
    for (int g = 0; g < 4; ++g) { const int dv = 8 * g + 4 * hi;
        u32x2 w; w.x = pk2(o0[4 * g] * inv, o0[4 * g + 1] * inv); w.y = pk2(o0[4 * g + 2] * inv, o0[4 * g + 3] * inv); *(u32x2*)(op + dv) = w;
        u32x2 w2; w2.x = pk2(o1[4 * g] * inv, o1[4 * g + 1] * inv); w2.y = pk2(o1[4 * g + 2] * inv, o1[4 * g + 3] * inv); *(u32x2*)(op + 32 + dv) = w2; }
    __syncthreads();
}
DI void phase_attn(int wv, const ArgP a, LAS unsigned char* lds) {
    unsigned char* ws = a.ws();
    const bf16_t* QB = (const bf16_t*)(ws + O_QB); const bf16_t* KB = (const bf16_t*)(ws + O_KB); const bf16_t* VT = (const bf16_t*)(ws + O_VT); bf16_t* MIX = (bf16_t*)(ws + O_MIX);
    for (int b = blockIdx.x; b < 256; b += gridDim.x) {
        const int v = (b & 7) * 32 + (b >> 3), h = v >> 5, s = v & 31;
        attn_unit(wv, h, 63 - s, QB, KB, VT, MIX, lds);
        attn_unit(wv, h, s, QB, KB, VT, MIX, lds);
    }
}

DI void phase_m_gates(int wv, const ArgP a, LAS unsigned char* lds) {
    unsigned char* ws = a.ws(); const int tid = ltid(wv), wave = tid >> 6, lane = tid & 63;
    const bf16_t* XBr = (const bf16_t*)(ws + O_XB) + 2 * 1024; const u64* rowss = (const u64*)(ws + O_ROWSS) + 2 * S;
    const float* Wg = a.in(17); const float* gn = a.in(16);
    LAS float* wgs = (LAS float*)lds;
    LAS float* pre = (LAS float*)(lds + 32768);
    float* GB = (float*)(ws + O_GB); float* GE = (float*)(ws + O_GE); float* GPM = (float*)(ws + O_GPM);
    float* BL = (float*)(ws + O_BL); float* ML = (float*)(ws + O_ML);
    for (int e = tid; e < 8192; e += 512) { const int k = e >> 3, j = e & 7; wgs[e] = Wg[(size_t)k * 3080 + 3072 + j] * gn[k]; }
    __syncthreads();
    for (int c = blockIdx.x; c < 256; c += gridDim.x) {
#pragma unroll 4
        for (int i = 0; i < 8; ++i) { const int t = c * 64 + wave * 8 + i;
            float acc[8];
#pragma unroll
            for (int j = 0; j < 8; ++j) acc[j] = 0.f;
#pragma unroll
            for (int jj = 0; jj < 4; ++jj) { const int k0 = jj * 256 + lane * 4; const u32x2 hb = *(const u32x2*)(XBr + (size_t)t * 1024 + k0); const f32x4 hv = {bflo(hb.x), bfhi(hb.x), bflo(hb.y), bfhi(hb.y)};
#pragma unroll
                for (int kk = 0; kk < 4; ++kk) { const f32x4 w0 = *(const LAS f32x4*)(wgs + (k0 + kk) * 8), w1 = *(const LAS f32x4*)(wgs + (k0 + kk) * 8 + 4);
                    acc[0] += hv[kk] * w0[0]; acc[1] += hv[kk] * w0[1]; acc[2] += hv[kk] * w0[2]; acc[3] += hv[kk] * w0[3];
                    acc[4] += hv[kk] * w1[0]; acc[5] += hv[kk] * w1[1]; acc[6] += hv[kk] * w1[2]; acc[7] += hv[kk] * w1[3]; } }
            const float rs = rs_from_ss(rowss[t]);
            { const bool b5 = lane & 32, b4 = lane & 16, b3 = lane & 8;
#pragma unroll
              for (int j = 0; j < 4; ++j) { const float snd = b5 ? acc[j] : acc[j + 4], kp = b5 ? acc[j + 4] : acc[j]; acc[j] = kp + __shfl_xor(snd, 32); }
#pragma unroll
              for (int j = 0; j < 2; ++j) { const float snd = b4 ? acc[j] : acc[j + 2], kp = b4 ? acc[j + 2] : acc[j]; acc[j] = kp + __shfl_xor(snd, 16); }
              { const float snd = b3 ? acc[0] : acc[1], kp = b3 ? acc[1] : acc[0]; acc[0] = kp + __shfl_xor(snd, 8); }
              acc[0] += __shfl_xor(acc[0], 4); acc[0] += __shfl_xor(acc[0], 2); acc[0] += __shfl_xor(acc[0], 1);
              if ((lane & 7) == 0) pre[(wave * 8 + i) * 8 + (b5 ? 4 : 0) + (b4 ? 2 : 0) + (b3 ? 1 : 0)] = acc[0] * rs; }
        }
        __syncthreads();
        if (wave < 4) { const int h = wave; const float bi = a.in(18)[h], bfg = a.in(19)[h];
            const float ig = 15.f * tanhf((pre[lane * 8 + h] + bi) * (1.f / 15.f));
            const float fg = 15.f * tanhf((pre[lane * 8 + 4 + h] + bfg) * (1.f / 15.f));
            float b = -log1pf(expf(-fg));
#pragma unroll
            for (int o = 1; o < 64; o <<= 1) { const float v = __shfl_up(b, o); if (lane >= o) b += v; }
            const float e = ig - b; float pm = e;
#pragma unroll
            for (int o = 1; o < 64; o <<= 1) { const float v = __shfl_up(pm, o); if (lane >= o) pm = fmaxf(pm, v); }
            const size_t o_ = (size_t)h * S + c * 64 + lane; GB[o_] = b; GE[o_] = e; GPM[o_] = pm;
            if (lane == 63) { BL[c * 4 + h] = b; ML[c * 4 + h] = b + pm; } }
        __syncthreads();
    }
}
DI void phase_m_dc(int wv, const ArgP a) {
    unsigned char* ws = a.ws(); const int tid = ltid(wv), lane = tid & 63, r32 = lane & 31, hi = lane >> 5; const int w = __builtin_amdgcn_readfirstlane(tid >> 6);
    const float* BL = (const float*)(ws + O_BL); const float* ML = (const float*)(ws + O_ML); float* NST = (float*)(ws + O_NST);
    const float* GE = (const float*)(ws + O_GE); const bf16_t* KVT = (const bf16_t*)(ws + O_KVT); bf16_t* CST = (bf16_t*)(ws + O_CST);
    for (int u = blockIdx.x; u < 1024; u += gridDim.x) {
        const int c = u >> 2, h = u & 3; const size_t t0 = (size_t)c * 64;
        const float emax = ML[c * 4 + h] - BL[c * 4 + h];
        bf16x8 bfr[4];
        { const bf16_t* vp = KVT + (size_t)(512 + h * 256 + 32 * w + r32) * S + t0 + 8 * hi; const float* gp = GE + (size_t)h * S + t0 + 8 * hi;
#pragma unroll
          for (int ks = 0; ks < 4; ++ks) { const u32x4 v = *(const u32x4*)(vp + 16 * ks); const f32x4 e0 = *(const f32x4*)(gp + 16 * ks), e1 = *(const f32x4*)(gp + 16 * ks + 4);
              u32x4 o; o.x = pk2(bflo(v.x) * fexp(e0[0] - emax), bfhi(v.x) * fexp(e0[1] - emax)); o.y = pk2(bflo(v.y) * fexp(e0[2] - emax), bfhi(v.y) * fexp(e0[3] - emax));
              o.z = pk2(bflo(v.z) * fexp(e1[0] - emax), bfhi(v.z) * fexp(e1[1] - emax)); o.w = pk2(bflo(v.w) * fexp(e1[2] - emax), bfhi(v.w) * fexp(e1[3] - emax));
              bfr[ks] = __builtin_bit_cast(bf16x8, o); } }
        const bf16_t* kp = KVT + (size_t)(h * 128 + r32) * S + t0 + 8 * hi;
        bf16_t* op = CST + ((size_t)(c * 4 + h) * 256 + 32 * w + r32) * 128 + 4 * hi;
#pragma unroll
        for (int rb = 0; rb < 4; ++rb) { f32x16 acc = {};
#pragma unroll
            for (int ks = 0; ks < 4; ++ks) { const bf16x8 ka = *(const bf16x8*)(kp + (size_t)(32 * rb) * S + 16 * ks); acc = __builtin_amdgcn_mfma_f32_32x32x16_bf16(ka, bfr[ks], acc, 0, 0, 0); }
#pragma unroll
            for (int g = 0; g < 4; ++g) { u32x2 o; o.x = pk2(acc[4 * g], acc[4 * g + 1]); o.y = pk2(acc[4 * g + 2], acc[4 * g + 3]); *(u32x2*)(op + 32 * rb + 8 * g) = o; } }
        if (tid < 128) { const bf16_t* kr = KVT + (size_t)(h * 128 + tid) * S + t0; const float* gp = GE + (size_t)h * S + t0; float s = 0.f;
#pragma unroll
            for (int p = 0; p < 8; ++p) { const u32x4 v = *(const u32x4*)(kr + 8 * p); const f32x4 e0 = *(const f32x4*)(gp + 8 * p), e1 = *(const f32x4*)(gp + 8 * p + 4);
                s += bflo(v.x) * fexp(e0[0] - emax) + bfhi(v.x) * fexp(e0[1] - emax) + bflo(v.y) * fexp(e0[2] - emax) + bfhi(v.y) * fexp(e0[3] - emax)
                   + bflo(v.z) * fexp(e1[0] - emax) + bfhi(v.z) * fexp(e1[1] - emax) + bflo(v.w) * fexp(e1[2] - emax) + bfhi(v.w) * fexp(e1[3] - emax); }
            NST[(size_t)(c * 4 + h) * 128 + tid] = s; }
    }
}
DI void phase_m_comb(int wv, const ArgP a, LAS unsigned char* lds, int dry) {
    unsigned char* ws = a.ws(); const int tid = ltid(wv);
    const float* BL = (const float*)(ws + O_BL); const float* ML = (const float*)(ws + O_ML); float* MST = (float*)(ws + O_MST); float* NST = (float*)(ws + O_NST);
    bf16_t* CST = (bf16_t*)(ws + O_CST);
    LAS float* bls = (LAS float*)lds; LAS float* mls = bls + 1024; LAS float* ga = mls + 1024; LAS float* gb = ga + 1024;
    for (int e = tid; e < 1024; e += 512) { bls[e] = BL[e]; mls[e] = ML[e]; }
    __syncthreads();
    if (tid < 256) { const int h = tid >> 6, l = tid & 63;
        float a_ = 0.f, b_ = -1e30f;
#pragma unroll
        for (int k = 0; k < 4; ++k) { const float bl = bls[(4 * l + k) * 4 + h], ml = mls[(4 * l + k) * 4 + h]; a_ += bl; b_ = fmaxf(b_ + bl, ml); }
        float pa = a_, pb = b_;
#pragma unroll
        for (int o = 1; o < 64; o <<= 1) { const float qa = __shfl_up(pa, o), qb = __shfl_up(pb, o); if (l >= o) { pb = fmaxf(qb + pa, pb); pa = qa + pa; } }
        float ea = __shfl_up(pa, 1), eb_ = __shfl_up(pb, 1); if (l == 0) { ea = 0.f; eb_ = -1e30f; }
        float m = fmaxf(0.f + ea, eb_);
#pragma unroll
        for (int k = 0; k < 4; ++k) { const int c = 4 * l + k; const float bl = bls[c * 4 + h], ml = mls[c * 4 + h]; const float mn = fmaxf(bl + m, ml);
            ga[c * 4 + h] = fexp(bl + m - mn); gb[c * 4 + h] = fexp(ml - mn);
            if (blockIdx.x == 0 && !dry) MST[c * 4 + h] = m;
            m = mn; } }
    __syncthreads();
    for (int eb = blockIdx.x; eb < 129; eb += gridDim.x) {
        if (eb < 128) { const int h = eb >> 5; unsigned* p = (unsigned*)(CST + (size_t)h * 32768 + (size_t)(eb & 31) * 1024 + 2 * tid); float C0 = 0.f, C1 = 0.f;
            for (int c = 0; c < 256; c += 64) { unsigned d[64];
#pragma unroll
                for (int k = 0; k < 64; ++k) d[k] = p[(size_t)(c + k) * 65536];
#pragma unroll
                for (int k = 0; k < 64; ++k) { if (!dry) p[(size_t)(c + k) * 65536] = pk2(C0, C1); const float a_ = ga[(c + k) * 4 + h], b_ = gb[(c + k) * 4 + h]; C0 = a_ * C0 + b_ * bflo(d[k]); C1 = a_ * C1 + b_ * bfhi(d[k]); } }
        } else { const int h = tid >> 7; float* p = NST + tid; float C = 0.f;
            for (int c = 0; c < 256; c += 8) { float d[8];
#pragma unroll
                for (int k = 0; k < 8; ++k) d[k] = p[(size_t)(c + k) * 512];
#pragma unroll
                for (int k = 0; k < 8; ++k) { if (!dry) p[(size_t)(c + k) * 512] = C; C = ga[(c + k) * 4 + h] * C + gb[(c + k) * 4 + h] * d[k]; } } }
    }
    __syncthreads();
}
constexpr int MC_QROW = 272, MC_SROW = 144;
constexpr int MC_QS = 0, MC_KS = 64 * MC_QROW, MC_SC = 2 * 64 * MC_QROW, MC_F = MC_SC + 64 * MC_SROW;
DI void phase_m_out(int wv, const ArgP a, LAS unsigned char* lds, int dry) {
    unsigned char* ws = a.ws(); const int tid = ltid(wv), lane = tid & 63, r32 = lane & 31, hi = lane >> 5; const int w = __builtin_amdgcn_readfirstlane(tid >> 6);
    bf16_t* QOK = (bf16_t*)(ws + O_QOK); const bf16_t* KVT = (const bf16_t*)(ws + O_KVT); const bf16_t* CST = (const bf16_t*)(ws + O_CST);
    const float* GB = (const float*)(ws + O_GB); const float* GE = (const float*)(ws + O_GE); const float* GPM = (const float*)(ws + O_GPM);
    const float* MST = (const float*)(ws + O_MST); const float* NST = (const float*)(ws + O_NST); const float* ong = a.in(20);
    LAS unsigned char* Qs = lds + MC_QS; LAS unsigned char* Ks = lds + MC_KS; LAS unsigned char* Sc = lds + MC_SC;
    LAS float* F = (LAS float*)(lds + MC_F);
    LAS float* f_b = F, *f_e = F + 64, *f_m = F + 128, *f_g = F + 192, *f_qn = F + 256, *f_ps = F + 320  , *f_n = F + 576  , *f_part = F + 704  ;
    for (int u = blockIdx.x; u < 1024; u += gridDim.x) {
        const int c = u >> 2, h = u & 3; const size_t t0 = (size_t)c * 64;
        for (int e = tid; e < 1024; e += 512) { const int r = e >> 4, p = e & 15;
            *(LAS u32x4*)(Qs + r * MC_QROW + p * 16) = *(const u32x4*)(QOK + (t0 + r) * 2048 + h * 128 + p * 8);
            *(LAS u32x4*)(Ks + r * MC_QROW + p * 16) = *(const u32x4*)(QOK + (t0 + r) * 2048 + 1536 + h * 128 + p * 8); }
        if (tid < 64) { const float mstv = MST[c * 4 + h]; const float b = GB[(size_t)h * S + t0 + tid], e = GE[(size_t)h * S + t0 + tid], pm = GPM[(size_t)h * S + t0 + tid];
            const float m = b + fmaxf(mstv, pm); f_b[tid] = b; f_e[tid] = e; f_m[tid] = m; f_g[tid] = fexp(b + mstv - m); }
        if (tid >= 64 && tid < 192) f_n[tid - 64] = NST[(size_t)(c * 4 + h) * 128 + tid - 64];
        __syncthreads();
        if (w < 4) {
            const int sb = w & 1, tb = w >> 1; const int tl = 32 * tb + r32;
            f32x16 x = {};
#pragma unroll
            for (int ks = 0; ks < 8; ++ks) {
                const bf16x8 ka = *(const LAS bf16x8*)(Ks + (32 * sb + r32) * MC_QROW + (16 * ks + 8 * hi) * 2);
                const bf16x8 qb = *(const LAS bf16x8*)(Qs + tl * MC_QROW + (16 * ks + 8 * hi) * 2);
                x = __builtin_amdgcn_mfma_f32_32x32x16_bf16(ka, qb, x, 0, 0, 0); }
            const float bt = f_b[tl], mt = f_m[tl]; float ps = 0.f;
#pragma unroll
            for (int g = 0; g < 4; ++g) { float v[4];
#pragma unroll
                for (int j = 0; j < 4; ++j) { const int sl = 32 * sb + 8 * g + 4 * hi + j; const float wgt = (sl <= tl) ? fexp(bt + f_e[sl] - mt) : 0.f; v[j] = x[4 * g + j] * wgt; ps += v[j]; }
                u32x2 o; o.x = pk2(v[0], v[1]); o.y = pk2(v[2], v[3]);
                *(LAS u32x2*)(Sc + tl * MC_SROW + (32 * sb + 8 * g + 4 * hi) * 2) = o; }
            f_ps[(sb * 2 + hi) * 64 + tl] = ps;
        } else {
            const int tl = 16 * (w - 4) + (lane >> 2), qq = lane & 3; float s = 0.f;
#pragma unroll
            for (int p = 0; p < 4; ++p) { const u32x4 v = *(const LAS u32x4*)(Qs + tl * MC_QROW + (32 * qq + 8 * p) * 2); LAS float* np = f_n + 32 * qq + 8 * p;
                s += bflo(v.x) * np[0] + bfhi(v.x) * np[1] + bflo(v.y) * np[2] + bfhi(v.y) * np[3] + bflo(v.z) * np[4] + bfhi(v.z) * np[5] + bflo(v.w) * np[6] + bfhi(v.w) * np[7]; }
            s += __shfl_xor(s, 1); s += __shfl_xor(s, 2);
            if (qq == 0) f_qn[tl] = s;
        }
        __syncthreads();
        f32x16 acc0 = {}, acc1 = {};
        { const bf16_t* cp = CST + ((size_t)(c * 4 + h) * 256 + 32 * w + r32) * 128 + 8 * hi;
#pragma unroll
          for (int ks = 0; ks < 8; ++ks) { const bf16x8 ca = *(const bf16x8*)(cp + 16 * ks);
              const bf16x8 q0 = *(const LAS bf16x8*)(Qs + r32 * MC_QROW + (16 * ks + 8 * hi) * 2), q1 = *(const LAS bf16x8*)(Qs + (32 + r32) * MC_QROW + (16 * ks + 8 * hi) * 2);
              acc0 = __builtin_amdgcn_mfma_f32_32x32x16_bf16(ca, q0, acc0, 0, 0, 0); acc1 = __builtin_amdgcn_mfma_f32_32x32x16_bf16(ca, q1, acc1, 0, 0, 0); } }
        const float g0 = f_g[r32], g1 = f_g[32 + r32];
#pragma unroll
        for (int r = 0; r < 16; ++r) { acc0[r] *= g0; acc1[r] *= g1; }
        { const bf16_t* vp = KVT + (size_t)(512 + h * 256 + 32 * w + r32) * S + t0 + 8 * hi;
#pragma unroll
          for (int ks = 0; ks < 4; ++ks) { const bf16x8 va = *(const bf16x8*)(vp + 16 * ks);
              const bf16x8 s0 = *(const LAS bf16x8*)(Sc + r32 * MC_SROW + (16 * ks + 8 * hi) * 2), s1 = *(const LAS bf16x8*)(Sc + (32 + r32) * MC_SROW + (16 * ks + 8 * hi) * 2);
              acc0 = __builtin_amdgcn_mfma_f32_32x32x16_bf16(va, s0, acc0, 0, 0, 0); acc1 = __builtin_amdgcn_mfma_f32_32x32x16_bf16(va, s1, acc1, 0, 0, 0); } }
        float inv[2];
#pragma unroll
        for (int tb = 0; tb < 2; ++tb) { const int tl = 32 * tb + r32;
            const float den = f_g[tl] * f_qn[tl] + f_ps[tl] + f_ps[64 + tl] + f_ps[128 + tl] + f_ps[192 + tl];
            inv[tb] = 1.f / fmaxf(fabsf(den), fexp(-f_m[tl])); }
        float ss0 = 0.f, ss1 = 0.f;
#pragma unroll
        for (int r = 0; r < 16; ++r) { acc0[r] *= inv[0]; acc1[r] *= inv[1]; ss0 += acc0[r] * acc0[r]; ss1 += acc1[r] * acc1[r]; }
        ss0 += __shfl_xor(ss0, 32); ss1 += __shfl_xor(ss1, 32);
        if (hi == 0) { f_part[w * 64 + r32] = ss0; f_part[w * 64 + 32 + r32] = ss1; }
        __syncthreads();
        float rn[2];
#pragma unroll
        for (int tb = 0; tb < 2; ++tb) { float s = 0.f;
#pragma unroll
            for (int ww = 0; ww < 8; ++ww) s += f_part[ww * 64 + 32 * tb + r32];
            rn[tb] = rsqrtf(s * (1.f / 256.f) + EPS); }
#pragma unroll
        for (int tb = 0; tb < 2; ++tb) { bf16_t* op = QOK + (t0 + 32 * tb + r32) * 2048 + 512 + h * 256 + 32 * w;
#pragma unroll
            for (int g = 0; g < 4; ++g) { const int dv = 8 * g + 4 * hi; const u32x2 ov = *(const u32x2*)(op + dv);
                const f32x4 gg = *(const f32x4*)(ong + h * 256 + 32 * w + dv);
                const float og[4] = {bflo(ov.x), bfhi(ov.x), bflo(ov.y), bfhi(ov.y)}; float y[4];
#pragma unroll
                for (int j = 0; j < 4; ++j) { const float hv = (tb ? acc1[4 * g + j] : acc0[4 * g + j]) * rn[tb]; y[j] = hv * gg[j] * sigmoidf_(og[j]); }
                u32x2 o; o.x = pk2(y[0], y[1]); o.y = pk2(y[2], y[3]); if (!dry) *(u32x2*)(op + dv) = o; } }
        __syncthreads();
    }
}

DI void phase_final(int wv, const ArgP a) {
    float* out = a.out(); const u64* rowss = (const u64*)(a.ws() + O_ROWSS) + 4 * S; const float* g = a.in(27); const bf16_t* XBr = (const bf16_t*)(a.ws() + O_XB) + 2 * 1024;
    for (size_t e = (size_t)blockIdx.x * 512 + ltid(wv); e < (size_t)S * 128; e += (size_t)gridDim.x * 512) { const int t = (int)(e >> 7), c = (int)(e & 127) * 8;
        const float rs = rs_from_ss(rowss[t]); const u32x4 hb = *(const u32x4*)(XBr + (size_t)t * 1024 + c); const f32x4 g0 = *(const f32x4*)(g + c), g1 = *(const f32x4*)(g + c + 4);
        const f32x4 v0 = (f32x4){bflo(hb.x), bfhi(hb.x), bflo(hb.y), bfhi(hb.y)} * rs * g0, v1 = (f32x4){bflo(hb.z), bfhi(hb.z), bflo(hb.w), bfhi(hb.w)} * rs * g1;
        *(f32x4*)(out + (size_t)t * 1024 + c) = v0; *(f32x4*)(out + (size_t)t * 1024 + c + 4) = v1; }
}

#ifndef DIS
#define DIS 0u
#endif
#ifndef REP
#define REP 0u
#endif
#ifndef XSYNC
#define XSYNC 0
#endif

#define XB_TMO      128
#define XB_XCNT(j)  (256  + 64 * (j))
#define XB_XSUB(j)  (1280 + 64 * (j))
#define XB_XGEN(j)  (2304 + 64 * (j))
#define XB_TOP      3328
#define XB_TOPGEN   3392
#define XB_SPIN_CAP (1u << 18)
DI unsigned xb_ld(unsigned* p) { return __hip_atomic_load(p, __ATOMIC_RELAXED, __HIP_MEMORY_SCOPE_AGENT); }
DI unsigned xb_add(unsigned* p, unsigned v) { return __hip_atomic_fetch_add(p, v, __ATOMIC_RELAXED, __HIP_MEMORY_SCOPE_AGENT); }
DI unsigned xb_xcc_id() { return (unsigned)__builtin_amdgcn_s_getreg((3 << 11) | 20) & 0xFu; }
#define XB_SPIN(cond, bar) do { unsigned _sp = 0; while (cond) { __builtin_amdgcn_s_sleep(1); \
    if ((++_sp & 255u) == 0u) { if (xb_ld(&(bar)[XB_TMO])) break; if (_sp > XB_SPIN_CAP) { atomicAdd(&(bar)[XB_TMO], 1u); break; } } } } while (0)
DI void xcd_barrier_complete(unsigned* bar, unsigned x, unsigned& nloc, unsigned& nx) {
    const unsigned G = gridDim.x;
    unsigned sum, cnt, mine, sp = 0u;
    for (;;) {
        sum = 0u; cnt = 0u; mine = 0u;
#pragma unroll
        for (unsigned j = 0; j < 16; ++j) { const unsigned c = xb_ld(&bar[XB_XCNT(j)]); sum += c; cnt += (c > 0u) ? 1u : 0u; mine = (j == x) ? c : mine; }
        if (sum == G) break;
        __builtin_amdgcn_s_sleep(1);
        if ((++sp & 255u) == 0u) { if (xb_ld(&bar[XB_TMO])) break; if (sp > XB_SPIN_CAP) { atomicAdd(&bar[XB_TMO], 1u); break; } }
    }
    nloc = mine > 0u ? mine : 1u; nx = cnt > 0u ? cnt : 1u;
}
DI void xcd_barrier(int wv, unsigned* bar, volatile LAS unsigned* st) {
    asm volatile("s_waitcnt vmcnt(0)" ::: "memory");
    __syncthreads();
    if (ltid(wv) == 0) {
        const unsigned x = xb_xcc_id();
        __builtin_amdgcn_s_waitcnt(0);
        unsigned nloc = st[0], nx = st[1];
        if (nloc == 0u) { xcd_barrier_complete(bar, x, nloc, nx); st[0] = nloc; st[1] = nx; }
        const unsigned old = xb_add(&bar[XB_XSUB(x)], 1u);
        const unsigned gen = old / nloc;
        if (old + 1u == (gen + 1u) * nloc) {
            __builtin_amdgcn_fence(__ATOMIC_RELEASE, "agent");
            asm volatile("s_waitcnt vmcnt(0)" ::: "memory");
            const unsigned og = xb_add(&bar[XB_TOP], 1u);
            const unsigned tg = og / nx;
            if (og + 1u == (tg + 1u) * nx) xb_add(&bar[XB_TOPGEN], 1u);
            else XB_SPIN(xb_ld(&bar[XB_TOPGEN]) == tg, bar);
            __builtin_amdgcn_fence(__ATOMIC_ACQUIRE, "agent");
            xb_add(&bar[XB_XGEN(x)], 1u);
            asm volatile("s_waitcnt vmcnt(0)" ::: "memory");
        } else {
            XB_SPIN(xb_ld(&bar[XB_XGEN(x)]) == gen, bar);
            __builtin_amdgcn_fence(__ATOMIC_ACQUIRE, "agent");
            asm volatile("s_waitcnt vmcnt(0)" ::: "memory");
        }
    }
    __syncthreads();
}
DI ArgP getargs() { ArgP r; r.p = (const __attribute__((address_space(4))) Args*)__builtin_amdgcn_kernarg_segment_ptr(); asm volatile("" : "+s"(r.p)); return r; }
#define WSB (getargs().ws())
#define XBP ((bf16_t*)(getargs().ws() + O_XB) + 2 * 1024)
#define RSS ((u64*)(getargs().ws() + O_ROWSS))
#define HFP (getargs().out())
__global__ void __launch_bounds__(512, 2) fwd_kernel(Args a_unused) {
    extern __shared__ __attribute__((aligned(16))) unsigned char shm[];
    LAS unsigned char* lds = (LAS unsigned char*)shm;
    const int wv = __builtin_amdgcn_readfirstlane(threadIdx.x >> 6);
#define BARW ((unsigned*)(getargs().ws() + O_BAR))
#define BARST ((volatile LAS unsigned*)(lds + 139264))
#define GSYNC() xcd_barrier(wv, BARW, BARST)
    { unsigned* barw0 = BARW; if (threadIdx.x == 0) { BARST[0] = 0u; BARST[1] = 0u; (void)xb_add(&barw0[XB_XCNT(xb_xcc_id())], 1u); } }
    if (getargs().p->pad == 0x7fffffff) cg::this_grid().sync();

#if !(DIS & (1u << 0))
    for (int rep_ = 0; rep_ < ((REP >> 0) & 1u) + 1; ++rep_) { const int dry_ = rep_ < (int)((REP >> 0) & 1u); (void)dry_;
    phase_prologue(wv, getargs(), lds, dry_ ? PROPART : 7);
    }
#endif
    GSYNC();
#if !(DIS & (1u << 1))
    for (int rep_ = 0; rep_ < ((REP >> 1) & 1u) + 1; ++rep_) { const int dry_ = rep_ < (int)((REP >> 1) & 1u); (void)dry_;
    { EpiRowBf16<1> E{(bf16_t*)(WSB + O_Z), 1536, RSS};
      pg8::gemm_phase<false>(wv, lds, XBP, 1024, (const bf16_t*)(WSB + O_W1T), 1024, 1024, 64, 6, E); }
    }
#endif
    GSYNC();
#if !(DIS & (1u << 2))
    for (int rep_ = 0; rep_ < ((REP >> 2) & 1u) + 1; ++rep_) { const int dry_ = rep_ < (int)((REP >> 2) & 1u); (void)dry_;
    phase_l0_prep(wv, getargs());
    }
#endif
    GSYNC();
#if !(DIS & (1u << 3))
    for (int rep_ = 0; rep_ < ((REP >> 3) & 1u) + 1; ++rep_) { const int dry_ = rep_ < (int)((REP >> 3) & 1u); (void)dry_;
    { EpiRowBf16<0> E{(bf16_t*)(WSB + O_RI), 1024, nullptr};
      pg8::gemm_phase<false>(wv, lds, (const bf16_t*)(WSB + O_XC), 512, (const bf16_t*)(WSB + O_WRIT), 512, 512, 64, 4, E); }
    }
#endif
#if !(DIS & (1u << 4))
    for (int rep_ = 0; rep_ < ((REP >> 4) & 1u) + 1; ++rep_) { const int dry_ = rep_ < (int)((REP >> 4) & 1u); (void)dry_;
    { EpiQ E{(bf16_t*)(WSB + O_QB), (const float*)(WSB + O_RSQ), (const float*)(WSB + O_CSTAB)};
      pg8::gemm_phase<false>(wv, lds, (const bf16_t*)(WSB + O_Z) + 1024, 1536, (const bf16_t*)(WSB + O_WQT), 256, 256, 64, 3, E); }
    }
#endif
#if !(DIS & (1u << 5))
    for (int rep_ = 0; rep_ < ((REP >> 5) & 1u) + 1; ++rep_) { const int dry_ = rep_ < (int)((REP >> 5) & 1u); (void)dry_;
    { EpiK E{(bf16_t*)(WSB + O_KB), (const float*)(WSB + O_RSKV)};
      pg8::gemm_phase<false>(wv, lds, (const bf16_t*)(WSB + O_Z) + 1280, 1536, (const bf16_t*)(WSB + O_WKT), 256, 256, 64, 2, E, 192); }
    }
#endif
#if !(DIS & (1u << 6))
    for (int rep_ = 0; rep_ < ((REP >> 6) & 1u) + 1; ++rep_) { const int dry_ = rep_ < (int)((REP >> 6) & 1u); (void)dry_;
    { EpiColBf16<2> E{(bf16_t*)(WSB + O_VT), S, (const float*)(WSB + O_RSKV)};
      pg8::gemm_phase<false>(wv, lds, (const bf16_t*)(WSB + O_WVT), 256, (const bf16_t*)(WSB + O_Z) + 1280, 1536, 256, 2, 64, E, 64); }
    }
#endif
    GSYNC();
#if !(DIS & (1u << 7))
    for (int rep_ = 0; rep_ < ((REP >> 7) & 1u) + 1; ++rep_) { const int dry_ = rep_ < (int)((REP >> 7) & 1u); (void)dry_;
    phase_lru_s1(wv, getargs());
    }
#endif
    GSYNC();
#if !(DIS & (1u << 8))
    for (int rep_ = 0; rep_ < ((REP >> 8) & 1u) + 1; ++rep_) { const int dry_ = rep_ < (int)((REP >> 8) & 1u); (void)dry_;
    phase_lru_s3(wv, getargs());
    }
#endif
#if !(DIS & (1u << 9))
    for (int rep_ = 0; rep_ < ((REP >> 9) & 1u) + 1; ++rep_) { const int dry_ = rep_ < (int)((REP >> 9) & 1u); (void)dry_;
    phase_attn(wv, getargs(), lds);
    }
#endif
    GSYNC();
#if !(DIS & (1u << 10))
    for (int rep_ = 0; rep_ < ((REP >> 10) & 1u) + 1; ++rep_) { const int dry_ = rep_ < (int)((REP >> 10) & 1u); (void)dry_;
    { EpiRes<false> E{getargs().in(0), XBP, RSS + 1 * S, dry_};
      pg8::gemm_phase<false>(wv, lds, (const bf16_t*)(WSB + O_MIX), 1024, (const bf16_t*)(WSB + O_WO1T), 1024, 1024, 64, 4, E); }
    }
#endif
    GSYNC();
#if !(DIS & (1u << 11))
    for (int rep_ = 0; rep_ < ((REP >> 11) & 1u) + 1; ++rep_) { const int dry_ = rep_ < (int)((REP >> 11) & 1u); (void)dry_;
    { EpiUp E{(bf16_t*)(WSB + O_ACT), RSS + 1 * S, getargs().in(24), getargs().in(25), lds + 131072};
      pg8::gemm_phase<true>(wv, lds, XBP, 1024, (const bf16_t*)(WSB + O_WUPT0), 1024, 1024, 67, 22, E); }
    }
#endif
    GSYNC();
#if !(DIS & (1u << 12))
    for (int rep_ = 0; rep_ < ((REP >> 12) & 1u) + 1; ++rep_) { const int dry_ = rep_ < (int)((REP >> 12) & 1u); (void)dry_;
    { EpiRes<true> E{nullptr, XBP, RSS + 2 * S, dry_};
      pg8::gemm_phase<false>(wv, lds, (const bf16_t*)(WSB + O_ACT), 2816, (const bf16_t*)(WSB + O_WDNT0), 2816, 2816, 64, 4, E); }
    }
#endif
    GSYNC();
#if !(DIS & (1u << 13))
    for (int rep_ = 0; rep_ < ((REP >> 13) & 1u) + 1; ++rep_) { const int dry_ = rep_ < (int)((REP >> 13) & 1u); (void)dry_;
    { EpiRowBf16<1> E{(bf16_t*)(WSB + O_QOK), 2048, RSS + 2 * S};
      pg8::gemm_phase<false>(wv, lds, XBP, 1024, (const bf16_t*)(WSB + O_WOINT), 1024, 1024, 64, 8, E); }
    }
#endif
#if !(DIS & (1u << 14))
    for (int rep_ = 0; rep_ < ((REP >> 14) & 1u) + 1; ++rep_) { const int dry_ = rep_ < (int)((REP >> 14) & 1u); (void)dry_;
    { EpiColBf16<1> E{(bf16_t*)(WSB + O_KVT), S, RSS + 2 * S};
      pg8::gemm_phase<false>(wv, lds, (const bf16_t*)(WSB + O_WOINT) + (size_t)1536 * 1024, 1024, XBP, 1024, 1024, 6, 64, E); }
    }
#endif
#if !(DIS & (1u << 15))
    for (int rep_ = 0; rep_ < ((REP >> 15) & 1u) + 1; ++rep_) { const int dry_ = rep_ < (int)((REP >> 15) & 1u); (void)dry_;
    phase_m_gates(wv, getargs(), lds);
    }
#endif
    GSYNC();
#if !(DIS & (1u << 16))
    for (int rep_ = 0; rep_ < ((REP >> 16) & 1u) + 1; ++rep_) { const int dry_ = rep_ < (int)((REP >> 16) & 1u); (void)dry_;
    phase_m_dc(wv, getargs());
    }
#endif
    GSYNC();
#if !(DIS & (1u << 22))
    for (int rep_ = 0; rep_ < ((REP >> 22) & 1u) + 1; ++rep_) { const int dry_ = rep_ < (int)((REP >> 22) & 1u); (void)dry_;
    phase_m_comb(wv, getargs(), lds, dry_);
    }
#endif
    GSYNC();
#if !(DIS & (1u << 17))
    for (int rep_ = 0; rep_ < ((REP >> 17) & 1u) + 1; ++rep_) { const int dry_ = rep_ < (int)((REP >> 17) & 1u); (void)dry_;
    phase_m_out(wv, getargs(), lds, dry_);
    }
#endif
    GSYNC();
#if !(DIS & (1u << 18))
    for (int rep_ = 0; rep_ < ((REP >> 18) & 1u) + 1; ++rep_) { const int dry_ = rep_ < (int)((REP >> 18) & 1u); (void)dry_;
    { EpiRes<true> E{nullptr, XBP, RSS + 3 * S, dry_};
      pg8::gemm_phase<false>(wv, lds, (const bf16_t*)(WSB + O_QOK) + 512, 2048, (const bf16_t*)(WSB + O_WO2T), 1024, 1024, 64, 4, E); }
    }
#endif
    GSYNC();
#if !(DIS & (1u << 19))
    for (int rep_ = 0; rep_ < ((REP >> 19) & 1u) + 1; ++rep_) { const int dry_ = rep_ < (int)((REP >> 19) & 1u); (void)dry_;
    { EpiUp E{(bf16_t*)(WSB + O_ACT), RSS + 3 * S, getargs().in(24) + 3 * 5632, getargs().in(25) + 5632, lds + 131072};
      pg8::gemm_phase<true>(wv, lds, XBP, 1024, (const bf16_t*)(WSB + O_WUPT1), 1024, 1024, 67, 22, E); }
    }
#endif
    GSYNC();
#if !(DIS & (1u << 20))
    for (int rep_ = 0; rep_ < ((REP >> 20) & 1u) + 1; ++rep_) { const int dry_ = rep_ < (int)((REP >> 20) & 1u); (void)dry_;
    { EpiRes<true> E{nullptr, XBP, RSS + 4 * S, dry_};
      pg8::gemm_phase<false>(wv, lds, (const bf16_t*)(WSB + O_ACT), 2816, (const bf16_t*)(WSB + O_WDNT1), 2816, 2816, 64, 4, E); }
    }
#endif
    GSYNC();
#if !(DIS & (1u << 21))
    for (int rep_ = 0; rep_ < ((REP >> 21) & 1u) + 1; ++rep_) { const int dry_ = rep_ < (int)((REP >> 21) & 1u); (void)dry_;
    phase_final(wv, getargs());
    }
#endif
    for (int i = 0; i < XSYNC; ++i) GSYNC();
}

extern "C" void kernel_launch(void* const* d_in, const int* in_sizes, int n_in, void* d_out, int out_size, void* d_ws, size_t ws_size, hipStream_t stream) {
    static int grid = 0;
    if (grid == 0) {
        if (n_in != 28 || out_size != S * 1024 || ws_size < WS_NEED) { fprintf(stderr, "kernel_launch: unexpected shapes (n_in %d out %d ws %zu need %zu)\n", n_in, out_size, ws_size, (size_t)WS_NEED); grid = -1; return; }
        int dev = 0, cus = 0, per_cu = 0;
        (void)hipGetDevice(&dev);
        (void)hipDeviceGetAttribute(&cus, hipDeviceAttributeMultiprocessorCount, dev);
        if (hipFuncSetAttribute((const void*)fwd_kernel, hipFuncAttributeMaxDynamicSharedMemorySize, LDS_BYTES) != hipSuccess) { fprintf(stderr, "kernel_launch: hipFuncSetAttribute failed\n"); grid = -1; return; }
        if (hipOccupancyMaxActiveBlocksPerMultiprocessor(&per_cu, (const void*)fwd_kernel, 512, LDS_BYTES) != hipSuccess || per_cu < 1) { fprintf(stderr, "kernel_launch: occupancy query says %d\n", per_cu); per_cu = 1; }
        (void)hipGetLastError();
        grid = cus * 1;
        if (grid > 256) grid = 256;
    }
    if (grid < 0) return;
    Args a{};
    for (int i = 0; i < 28; ++i) a.in[i] = (const float*)d_in[i];
    a.out = (float*)d_out; a.ws = (unsigned char*)d_ws;
    if (hipMemsetAsync((char*)d_ws + O_BAR, 0, BAR_BYTES, stream) != hipSuccess) { fprintf(stderr, "kernel_launch: memset failed\n"); return; }
    void* args[] = {&a};
    hipError_t e = hipLaunchCooperativeKernel((void*)fwd_kernel, dim3(grid), dim3(512), args, LDS_BYTES, stream);
    if (e != hipSuccess) fprintf(stderr, "kernel_launch: cooperative launch failed: %s (grid %d)\n", hipGetErrorString(e), grid);
}
```

```cpp
#include <hip/hip_runtime.h>
#include <hip/hip_cooperative_groups.h>
#include <cstdio>
#include <cstdint>
namespace cg = cooperative_groups;

typedef unsigned short bf16_t;
typedef short bf16x8 __attribute__((ext_vector_type(8)));
typedef short s16x4 __attribute__((ext_vector_type(4)));
typedef float f32x2 __attribute__((ext_vector_type(2)));
typedef float f32x4 __attribute__((ext_vector_type(4)));
typedef float f32x16 __attribute__((ext_vector_type(16)));
typedef unsigned u32x2 __attribute__((ext_vector_type(2)));
typedef unsigned u32x4 __attribute__((ext_vector_type(4)));
typedef __bf16 bf16x2_t __attribute__((ext_vector_type(2)));
#define LAS __attribute__((address_space(3)))
#define DI __device__ __forceinline__

constexpr int S = 16384;
constexpr float EPS = 1e-6f;
constexpr float LOG2E = 1.4426950408889634f;

constexpr size_t SZ_WUPT = (size_t)5632 * 1024 * 2, SZ_WDNT = (size_t)1024 * 2816 * 2;
constexpr size_t O_WUPT1 = 0;
constexpr size_t O_WDNT1 = O_WUPT1 + SZ_WUPT;
constexpr size_t O_WOINT = O_WDNT1 + SZ_WDNT;
constexpr size_t O_WO2T = O_WOINT + (size_t)3072 * 1024 * 2;
constexpr size_t O_ROWSS = O_WO2T + (size_t)1024 * 1024 * 2;
constexpr size_t O_RSQ = O_ROWSS + (size_t)5 * S * 8;
constexpr size_t O_RSKV = O_RSQ + (size_t)S * 4;
constexpr size_t O_CSTAB = O_RSKV + (size_t)S * 4;
constexpr size_t O_CHA = O_CSTAB + (size_t)S * 32 * 4;
constexpr size_t O_CHH = O_CHA + (size_t)256 * 512 * 4;
constexpr size_t O_GB = O_CHH + (size_t)256 * 512 * 4;
constexpr size_t O_GE = O_GB + (size_t)4 * S * 4;
constexpr size_t O_GPM = O_GE + (size_t)4 * S * 4;
constexpr size_t O_BL = O_GPM + (size_t)4 * S * 4;
constexpr size_t O_ML = O_BL + 4096;
constexpr size_t O_MST = O_ML + 4096;
constexpr size_t O_NST = O_MST + 4096;
constexpr size_t O_BAR = O_NST + (size_t)256 * 4 * 128 * 4;
constexpr size_t BAR_BYTES = 16384;
constexpr size_t O_XB = O_BAR + BAR_BYTES;
constexpr size_t XB_ROWS = 16648;
constexpr size_t O_L0W = O_XB + XB_ROWS * 2048;
constexpr size_t O_W1T = O_L0W;
constexpr size_t O_WQT = O_W1T + (size_t)1536 * 1024 * 2;
constexpr size_t O_WKT = O_WQT + (size_t)768 * 256 * 2;
constexpr size_t O_WVT = O_WKT + (size_t)512 * 256 * 2;
constexpr size_t O_WRIT = O_WVT + (size_t)512 * 256 * 2;
constexpr size_t O_WO1T = O_WRIT + (size_t)1024 * 512 * 2;
constexpr size_t O_WUPT0 = O_WO1T + (size_t)1024 * 1024 * 2;
constexpr size_t O_WDNT0 = O_WUPT0 + SZ_WUPT;
constexpr size_t O_ARENA = O_WDNT0 + SZ_WDNT;
constexpr size_t O_Z = O_ARENA;
constexpr size_t O_XC = O_Z + (size_t)S * 1536 * 2;
constexpr size_t O_QB = O_XC + (size_t)S * 512 * 2;
constexpr size_t O_KB = O_QB + (size_t)8 * S * 96 * 2;
constexpr size_t O_VT = O_KB + (size_t)8 * S * 96 * 2;
constexpr size_t O_MIX = O_VT + (size_t)512 * S * 2;
constexpr size_t O_END0 = O_MIX + (size_t)S * 1024 * 2;
constexpr size_t O_ACT = O_ARENA;
constexpr size_t O_RI = O_XB;
constexpr size_t O_CST = O_L0W;
constexpr size_t O_QOK = O_CST + (size_t)256 * 4 * 256 * 128 * 2;
constexpr size_t O_KVT = O_QOK + (size_t)S * 2048 * 2;
constexpr size_t O_END1 = O_KVT + (size_t)1536 * S * 2;
constexpr size_t WS_NEED = (O_END0 > O_END1 ? O_END0 : O_END1);
static_assert(WS_NEED <= (size_t)268435456, "workspace");
static_assert(O_ACT + (size_t)(S + 240) * 2816 * 2 <= (size_t)268435456, "act");

constexpr int LDS_BYTES = 147456;

struct Args {
    const float* in[28];
    float* out;
    unsigned char* ws;
    int pad; int pad2;
};

struct ArgP { const __attribute__((address_space(4))) Args* p;
    DI const float* in(int i) const { return p->in[i]; } DI float* out() const { return p->out; } DI unsigned char* ws() const { return p->ws; } };
DI unsigned pk2(float lo, float hi) { f32x2 v = {lo, hi}; bf16x2_t b = __builtin_convertvector(v, bf16x2_t); return __builtin_bit_cast(unsigned, b); }
DI bf16_t f2bf(float f) { return (bf16_t)(pk2(f, 0.f) & 0xffffu); }
DI int ltid(int wv) { asm volatile("" : "+s"(wv)); int l = __builtin_amdgcn_mbcnt_hi(~0u, __builtin_amdgcn_mbcnt_lo(~0u, 0u)); asm volatile("" : "+v"(l)); return wv * 64 + l; }
DI int lbid() { int t = blockIdx.x; asm volatile("" : "+s"(t)); return t; }
DI float bf2f(bf16_t b) { return __uint_as_float(((unsigned)b) << 16); }
DI float bflo(unsigned u) { return __uint_as_float(u << 16); }
DI float bfhi(unsigned u) { return __uint_as_float(u & 0xffff0000u); }
DI float wave_sum(float v) {
#pragma unroll
    for (int o = 1; o < 64; o <<= 1) v += __shfl_xor(v, o);
    return v;
}
DI float fexp(float x) { return __builtin_amdgcn_exp2f(x * LOG2E); }
DI float sigmoidf_(float x) { return __builtin_amdgcn_rcpf(1.f + fexp(-x)); }
DI int crow(int r, int hi) { return (r & 3) + 8 * (r >> 2) + 4 * hi; }
typedef unsigned long long u64;
DI float rs_from_ss(u64 ssq) { return rsqrtf((float)ssq * (1.f / (1048576.f * 1024.f)) + EPS); }
DI u64 ss_to_fix(float ss) { return (u64)(ss * 1048576.f); }

namespace pg8 {
constexpr int BM = 256, BK = 64, HALF = 128, HTB = HALF * BK * 2, STAGE_BYTES = 8 * HTB, NXCD = 8, WGM = 8;
DI int lds_byte(int r, int c) { const int st = (r >> 4) * 2 + (c >> 5), rr = r & 15, cc = c & 31, ob = rr * 64 + cc * 2; return st * 1024 + (ob ^ (((ob >> 9) & 1) << 5)); }
DI void stage_rc(int b, int& R, int& C) { const int st = b / 1024, sb = b % 1024, swz = sb ^ (((sb >> 9) & 1) << 5); R = (st >> 1) * 16 + swz / 64; C = (st & 1) * 32 + (swz % 64) / 2; }
DI int perm32(int rho) { const int n = rho >> 4, i = rho & 15; return 8 * (i >> 2) + 4 * n + (i & 3); }
struct Unit { int pm, pn; };
struct StaticOrder {
    int nM, nN, nwg, G, c;
    DI void init(int nM_, int nN_, int G_, int c_) { nM = nM_; nN = nN_; nwg = nM * nN; G = G_; c = c_; }
    DI bool next(int i, Unit& u) const {
        const long L = (long)i * G + c; if (L >= nwg) return false;
        int wgid = (int)L; { const int q = nwg / NXCD, r = nwg % NXCD, xcd = wgid % NXCD, off = wgid / NXCD; wgid = (xcd < r ? xcd * (q + 1) : r * (q + 1) + (xcd - r) * q) + off; }
        const int nig = WGM * nN, gid = wgid / nig, fm = gid * WGM, gsz = (nM - fm) < WGM ? (nM - fm) : WGM;
        u.pm = fm + ((wgid % nig) % gsz); u.pn = (wgid % nig) / gsz; return true;
    }
};

template <bool AMAP, class Epi>
DI void gemm_phase(int wv, LAS unsigned char* lds, const bf16_t* A, int lda, const bf16_t* Bt, int ldb, int K_, int nM, int nN, const Epi& E, int rot = 0) {
    int K = K_; asm volatile("" : "+s"(K));
    const int tid = ltid(wv), wid = __builtin_amdgcn_readfirstlane(tid >> 6), lane = tid & 63, wr = wid >> 2, wc = wid & 3, fr = lane & 15, fq = lane >> 4;
    const int nt = K / BK;
    StaticOrder SO; { int c_ = lbid() - rot; if (c_ < 0) c_ += (int)gridDim.x; SO.init(nM, nN, (int)gridDim.x, c_); }
    unsigned voffA[2], voffB[2];
#pragma unroll
    for (int i = 0; i < 2; ++i) { int R, C; stage_rc(tid * 16 + i * 8192, R, C); const int Rb = (R & ~31) + perm32(R & 31);
        const int Ra = AMAP ? (62 * (R >> 6) + (R & 63) - 2) : R;
        voffA[i] = (unsigned)((Ra + (AMAP ? 2 : 0)) * lda + C) * 2u; voffB[i] = (unsigned)(Rb * ldb + C) * 2u; }
    const size_t kstep = (size_t)(BK * 2);
    const size_t hstepA = (size_t)(AMAP ? 124 : 128) * lda * 2, hstepB = (size_t)HALF * ldb * 2;
    const size_t tstepA = 2 * hstepA, tstepB = 2 * hstepB;
    const unsigned ldsw = (unsigned)wid * 1024u;
    const int aoff = lds_byte(wr * 64 + fr, fq * 8), boff = lds_byte(wc * 32 + fr, fq * 8);
#define PG8_SA(b, h) (((b) * 2 + (h)) * HTB)
#define PG8_SB(b, h) ((4 + (b) * 2 + (h)) * HTB)
#define PG8_STAGE(bufoff, gbase, voff) do { _Pragma("unroll") for (int _i = 0; _i < 2; ++_i) \
        __builtin_amdgcn_global_load_lds((const unsigned*)((const char*)(gbase) + (voff)[_i]), (LAS unsigned*)(lds + (bufoff) + ldsw + _i * 8192), 16, 0, 0); } while (0)
#define PG8_LDA(dst, b, h) do { _Pragma("unroll") for (int m = 0; m < 4; ++m) _Pragma("unroll") for (int k = 0; k < 2; ++k) dst[m][k] = *(const LAS bf16x8*)(lds + PG8_SA(b, h) + aoff + m * 2048 + k * 1024); } while (0)
#define PG8_LDB(dst, b, h) do { _Pragma("unroll") for (int n = 0; n < 2; ++n) _Pragma("unroll") for (int k = 0; k < 2; ++k) dst[n][k] = *(const LAS bf16x8*)(lds + PG8_SB(b, h) + boff + n * 2048 + k * 1024); } while (0)
#define PG8_MMA(ai, bj, At, Bt_) do { __builtin_amdgcn_s_setprio(1); _Pragma("unroll") for (int m = 0; m < 4; ++m) _Pragma("unroll") for (int n = 0; n < 2; ++n) _Pragma("unroll") for (int k = 0; k < 2; ++k) \
        acc[ai][bj][m][n] = __builtin_amdgcn_mfma_f32_16x16x32_bf16(Bt_[n][k], At[m][k], acc[ai][bj][m][n], 0, 0, 0); __builtin_amdgcn_s_setprio(0); } while (0)
#define PG8_WAIT_V(n) asm volatile("s_waitcnt vmcnt(" #n ")" ::: "memory")
#define PG8_WAIT_L(n) asm volatile("s_waitcnt lgkmcnt(" #n ")" ::: "memory")
#define PG8_BAR __builtin_amdgcn_s_barrier()
#define PG8_SCHED __builtin_amdgcn_sched_barrier(0)
    if (AMAP) A -= 2 * lda;
    Unit cur, nxt; int ui = 0;
    if (!SO.next(0, cur)) return;
    f32x4 acc[2][2][4][2];
#pragma unroll
    for (int a = 0; a < 2; ++a)
#pragma unroll
        for (int b = 0; b < 2; ++b)
#pragma unroll
            for (int m = 0; m < 4; ++m)
#pragma unroll
                for (int n = 0; n < 2; ++n) acc[a][b][m][n] = (f32x4){0.f, 0.f, 0.f, 0.f};
    bf16x8 At[4][2], B0[2][2], B1[2][2];
    const char* cA = (const char*)A + (size_t)cur.pm * tstepA; const char* cB = (const char*)Bt + (size_t)cur.pn * tstepB;
    PG8_STAGE(PG8_SB(0, 0), cB, voffB); PG8_STAGE(PG8_SA(0, 0), cA, voffA); PG8_STAGE(PG8_SB(0, 1), cB + hstepB, voffB); PG8_STAGE(PG8_SA(0, 1), cA + hstepA, voffA);
    if (wr == 1) PG8_BAR;
    PG8_WAIT_V(4); PG8_BAR;
    PG8_STAGE(PG8_SB(1, 0), cB + kstep, voffB); PG8_STAGE(PG8_SA(1, 0), cA + kstep, voffA); PG8_STAGE(PG8_SB(1, 1), cB + hstepB + kstep, voffB);
    PG8_WAIT_V(6); PG8_BAR;
    for (;;) {
        const bool has_next = SO.next(ui + 1, nxt);
        const char* nA = has_next ? (const char*)A + (size_t)nxt.pm * tstepA : cA; const char* nB = has_next ? (const char*)Bt + (size_t)nxt.pn * tstepB : cB;
        for (int t = 0; t < nt; t += 2) {
            const bool last = (t == nt - 2);
            const char* a1 = cA + (size_t)(t + 1) * kstep;
            const char* a2 = last ? nA : cA + (size_t)(t + 2) * kstep; const char* b2 = last ? nB : cB + (size_t)(t + 2) * kstep;
            const char* a3 = a2 + kstep; const char* b3 = b2 + kstep;
            PG8_LDB(B0, 0, 0); PG8_SCHED; PG8_LDA(At, 0, 0); PG8_STAGE(PG8_SA(1, 1), a1 + hstepA, voffA);
            PG8_WAIT_L(8); PG8_BAR; PG8_WAIT_L(0); PG8_MMA(0, 0, At, B0); PG8_BAR; PG8_SCHED;
            PG8_LDB(B1, 0, 1); PG8_STAGE(PG8_SB(0, 0), b2, voffB);
            PG8_BAR; PG8_WAIT_L(0); PG8_MMA(0, 1, At, B1); PG8_BAR;
            PG8_LDA(At, 0, 1); PG8_STAGE(PG8_SA(0, 0), a2, voffA);
            PG8_BAR; PG8_WAIT_L(0); PG8_MMA(1, 0, At, B0); PG8_BAR; PG8_SCHED;
            PG8_STAGE(PG8_SB(0, 1), b2 + hstepB, voffB);
            PG8_WAIT_V(6); PG8_BAR; PG8_MMA(1, 1, At, B1); PG8_BAR;
            PG8_LDB(B0, 1, 0); PG8_SCHED; PG8_LDA(At, 1, 0); PG8_STAGE(PG8_SA(0, 1), a2 + hstepA, voffA);
            PG8_WAIT_L(8); PG8_BAR; PG8_WAIT_L(0); PG8_MMA(0, 0, At, B0); PG8_BAR; PG8_SCHED;
            PG8_LDB(B1, 1, 1); PG8_STAGE(PG8_SB(1, 0), b3, voffB);
            PG8_BAR; PG8_WAIT_L(0); PG8_MMA(0, 1, At, B1); PG8_BAR;
            PG8_LDA(At, 1, 1); PG8_STAGE(PG8_SA(1, 0), a3, voffA);
            PG8_BAR; PG8_WAIT_L(0); PG8_MMA(1, 0, At, B0); PG8_BAR; PG8_SCHED;
            PG8_STAGE(PG8_SB(1, 1), b3 + hstepB, voffB);
            PG8_WAIT_V(6); PG8_BAR; PG8_MMA(1, 1, At, B1); PG8_BAR;
        }
        if (wr == 0) PG8_BAR;
        E(acc, cur, wr, wc, fr, fq);
        if (!has_next) break;
#pragma unroll
        for (int a = 0; a < 2; ++a)
#pragma unroll
            for (int b = 0; b < 2; ++b)
#pragma unroll
                for (int m = 0; m < 4; ++m)
#pragma unroll
                    for (int n = 0; n < 2; ++n) acc[a][b][m][n] = (f32x4){0.f, 0.f, 0.f, 0.f};
        cur = nxt; cA = nA; cB = nB; ++ui;
        if (wr == 1) PG8_BAR;
    }
    PG8_WAIT_V(0);
    PG8_BAR;
#undef PG8_SA
#undef PG8_SB
#undef PG8_STAGE
#undef PG8_LDA
#undef PG8_LDB
#undef PG8_MMA
#undef PG8_WAIT_V
#undef PG8_WAIT_L
#undef PG8_BAR
#undef PG8_SCHED
}
}
using pg8::Unit;
typedef f32x4 AccT[2][2][4][2];

template <int SMODE> struct EpiRowBf16 {
    bf16_t* O; int ldc; const void* sc;
    DI void operator()(const AccT& acc, const Unit& u, int wr, int wc, int fr, int fq) const {
        const int row0 = u.pm * 256 + wr * 64 + fr, col0 = u.pn * 256 + wc * 32 + 8 * fq;
#pragma unroll
        for (int ai = 0; ai < 2; ++ai)
#pragma unroll
            for (int m = 0; m < 4; ++m) { const int row = row0 + ai * 128 + m * 16;
                float s = 1.f; if (SMODE == 1) s = rs_from_ss(((const u64*)sc)[row]); if (SMODE == 2) s = ((const float*)sc)[row];
                bf16_t* rowp = O + (size_t)row * ldc + col0;
#pragma unroll
                for (int bj = 0; bj < 2; ++bj) { const f32x4 v0 = acc[ai][bj][m][0] * s, v1 = acc[ai][bj][m][1] * s;
                    u32x4 w; w.x = pk2(v0[0], v0[1]); w.y = pk2(v0[2], v0[3]); w.z = pk2(v1[0], v1[1]); w.w = pk2(v1[2], v1[3]);
                    *(u32x4*)(rowp + bj * 128) = w; } }
    }
};
template <int SMODE> struct EpiColBf16 {
    bf16_t* O; int ldc; const void* sc;
    DI void operator()(const AccT& acc, const Unit& u, int wr, int wc, int fr, int fq) const {
        const int row0 = u.pm * 256 + wr * 64 + fr, col0 = u.pn * 256 + wc * 32 + 8 * fq;
#pragma unroll
        for (int bj = 0; bj < 2; ++bj) { float s[8];
#pragma unroll
            for (int j = 0; j < 8; ++j) s[j] = (SMODE == 1) ? rs_from_ss(((const u64*)sc)[col0 + bj * 128 + j]) : ((const float*)sc)[col0 + bj * 128 + j];
#pragma unroll
            for (int ai = 0; ai < 2; ++ai)
#pragma unroll
                for (int m = 0; m < 4; ++m) { const int row = row0 + ai * 128 + m * 16; const f32x4 v0 = acc[ai][bj][m][0], v1 = acc[ai][bj][m][1];
                    u32x4 w; w.x = pk2(v0[0] * s[0], v0[1] * s[1]); w.y = pk2(v0[2] * s[2], v0[3] * s[3]); w.z = pk2(v1[0] * s[4], v1[1] * s[5]); w.w = pk2(v1[2] * s[6], v1[3] * s[7]);
                    *(u32x4*)(O + (size_t)row * ldc + col0 + bj * 128) = w; } }
    }
};
struct EpiQ {
    bf16_t* QB; const float* rsq; const float* cstab;
    DI void operator()(const AccT& acc, const Unit& u, int wr, int wc, int fr, int fq) const {
        const int row0 = u.pm * 256 + wr * 64 + fr, col0 = u.pn * 256 + wc * 32 + 8 * fq;
        const float QS = 0.10206207261596577f * LOG2E;
#pragma unroll
        for (int ai = 0; ai < 2; ++ai)
#pragma unroll
            for (int m = 0; m < 4; ++m) { const int t = row0 + ai * 128 + m * 16; const float s = rsq[t] * QS;
#pragma unroll
                for (int bj = 0; bj < 2; ++bj) { const int c = col0 + bj * 128, h = c / 96, d = c - h * 96;
                    f32x4 v0 = acc[ai][bj][m][0] * s, v1 = acc[ai][bj][m][1] * s;
                    if (d >= 64) { const int i0 = (d - 64) >> 1; const f32x4 cs0 = *(const f32x4*)(cstab + (size_t)t * 32 + 2 * i0), cs1 = *(const f32x4*)(cstab + (size_t)t * 32 + 2 * i0 + 4);
                        f32x4 a, b;
                        a[0] = v0[0] * cs0[0] - v0[1] * cs0[1]; a[1] = v0[1] * cs0[0] + v0[0] * cs0[1];
                        a[2] = v0[2] * cs0[2] - v0[3] * cs0[3]; a[3] = v0[3] * cs0[2] + v0[2] * cs0[3];
                        b[0] = v1[0] * cs1[0] - v1[1] * cs1[1]; b[1] = v1[1] * cs1[0] + v1[0] * cs1[1];
                        b[2] = v1[2] * cs1[2] - v1[3] * cs1[3]; b[3] = v1[3] * cs1[2] + v1[2] * cs1[3];
                        v0 = a; v1 = b; }
                    u32x4 w; w.x = pk2(v0[0], v0[1]); w.y = pk2(v0[2], v0[3]); w.z = pk2(v1[0], v1[1]); w.w = pk2(v1[2], v1[3]);
                    *(u32x4*)(QB + ((size_t)h * S + t) * 96 + d) = w; } }
    }
};
struct EpiK {
    bf16_t* KB; const float* rskv;
    DI void operator()(const AccT& acc, const Unit& u, int wr, int wc, int fr, int fq) const {
        const int row0 = u.pm * 256 + wr * 64 + fr, col0 = u.pn * 256 + wc * 32 + 8 * fq;
#pragma unroll
        for (int ai = 0; ai < 2; ++ai)
#pragma unroll
            for (int m = 0; m < 4; ++m) { const int t = row0 + ai * 128 + m * 16; const float s = rskv[t];
#pragma unroll
                for (int bj = 0; bj < 2; ++bj) { const int c = col0 + bj * 128, h = c >> 6, d = c & 63;
                    const f32x4 v0 = acc[ai][bj][m][0] * s, v1 = acc[ai][bj][m][1] * s;
                    u32x4 w; w.x = pk2(v0[0], v0[1]); w.y = pk2(v0[2], v0[3]); w.z = pk2(v1[0], v1[1]); w.w = pk2(v1[2], v1[3]);
                    *(u32x4*)(KB + ((size_t)h * S + t) * 96 + d) = w; } }
    }
};
template <bool RESBF> struct EpiRes {
    const float* res; bf16_t* XB; u64* rowss; int dry;
    DI void operator()(const AccT& acc, const Unit& u, int wr, int wc, int fr, int fq) const {
        const int row0 = u.pm * 256 + wr * 64 + fr, col0 = u.pn * 256 + wc * 32 + 8 * fq;
#pragma unroll
        for (int ai = 0; ai < 2; ++ai)
#pragma unroll
            for (int m = 0; m < 4; ++m) { const int t = row0 + ai * 128 + m * 16; float ss = 0.f;
#pragma unroll
                for (int bj = 0; bj < 2; ++bj) { const size_t o = (size_t)t * 1024 + col0 + bj * 128;
                    f32x4 r0, r1;
                    if (RESBF) { const u32x4 rb = *(const u32x4*)(XB + o); r0 = (f32x4){bflo(rb.x), bfhi(rb.x), bflo(rb.y), bfhi(rb.y)}; r1 = (f32x4){bflo(rb.z), bfhi(rb.z), bflo(rb.w), bfhi(rb.w)}; }
                    else { r0 = *(const f32x4*)(res + o); r1 = *(const f32x4*)(res + o + 4); }
                    const f32x4 v0 = acc[ai][bj][m][0] + r0, v1 = acc[ai][bj][m][1] + r1;
                    u32x4 w; w.x = pk2(v0[0], v0[1]); w.y = pk2(v0[2], v0[3]); w.z = pk2(v1[0], v1[1]); w.w = pk2(v1[2], v1[3]);
                    if (!dry) *(u32x4*)(XB + o) = w;
                    ss += v0[0] * v0[0] + v0[1] * v0[1] + v0[2] * v0[2] + v0[3] * v0[3] + v1[0] * v1[0] + v1[1] * v1[1] + v1[2] * v1[2] + v1[3] * v1[3]; }
                ss += __shfl_xor(ss, 16); ss += __shfl_xor(ss, 32);
                if (fq == 0 && !dry) atomicAdd(rowss + t, ss_to_fix(ss)); }
    }
};
DI float dpp_prev1(float cur, float prevm) {
    const int o = __builtin_amdgcn_update_dpp(0, __builtin_bit_cast(int, prevm), 0x121, 0xf, 0xf, false);
    return __builtin_bit_cast(float, __builtin_amdgcn_update_dpp(o, __builtin_bit_cast(int, cur), 0x111, 0xf, 0xf, false));
}
DI float dpp_prev2(float cur, float prevm) {
    const int o = __builtin_amdgcn_update_dpp(0, __builtin_bit_cast(int, prevm), 0x122, 0xf, 0xf, false);
    return __builtin_bit_cast(float, __builtin_amdgcn_update_dpp(o, __builtin_bit_cast(int, cur), 0x112, 0xf, 0xf, false));
}
struct EpiUp {
    bf16_t* ACT; const u64* rowss; const float* cw; const float* cb; LAS unsigned char* plds;
    DI void operator()(const AccT& acc, const Unit& u, int wr, int wc, int fr, int fq) const {
        const int cl = u.pn * 128 + wc * 32 + 8 * fq;
        LAS float* P = (LAS float*)(plds + (wr * 4 + wc) * 1024);
        { const int lane = fq * 16 + fr, kind = lane >> 3, c4 = 4 * (lane & 7), k3 = kind & 3;
          const float* src = (k3 == 0 ? cb : cw + (k3 - 1) * 5632) + (kind >= 4 ? 2816 : 0) + u.pn * 128 + wc * 32 + c4;
          *(LAS f32x4*)(P + kind * 32 + c4) = *(const f32x4*)src; }
#pragma unroll
        for (int ai = 0; ai < 2; ++ai) {
            const int tok0 = u.pm * 248 + 62 * (2 * ai + wr) - 2 + fr;
            float rs[4];
#pragma unroll
            for (int m = 0; m < 4; ++m) { const int t = tok0 + 16 * m; const int tc = t < 0 ? 0 : (t >= S ? S - 1 : t); const float r = rs_from_ss(rowss[tc]); rs[m] = t < 0 ? 0.f : r; }
            const int row0 = fr < 2 ? (S + 236 + fr) : tok0;
#pragma unroll
            for (int n = 0; n < 2; ++n) {
                const int lc = 8 * fq + 4 * n;
                unsigned wpk[4][2];
#pragma unroll
                for (int jp = 0; jp < 2; ++jp) {
                    const f32x2 bg = *(const LAS f32x2*)(P + lc + 2 * jp), g0 = *(const LAS f32x2*)(P + 32 + lc + 2 * jp), g1 = *(const LAS f32x2*)(P + 64 + lc + 2 * jp), g2 = *(const LAS f32x2*)(P + 96 + lc + 2 * jp);
                    const f32x2 bv = *(const LAS f32x2*)(P + 128 + lc + 2 * jp), v0 = *(const LAS f32x2*)(P + 160 + lc + 2 * jp), v1 = *(const LAS f32x2*)(P + 192 + lc + 2 * jp), v2 = *(const LAS f32x2*)(P + 224 + lc + 2 * jp);
                    f32x2 G[4], V[4];
#pragma unroll
                    for (int m = 0; m < 4; ++m) { G[m] = (f32x2){acc[ai][0][m][n][2 * jp], acc[ai][0][m][n][2 * jp + 1]} * rs[m]; V[m] = (f32x2){acc[ai][1][m][n][2 * jp], acc[ai][1][m][n][2 * jp + 1]} * rs[m]; }
#pragma unroll
                    for (int m = 0; m < 4; ++m) {
                        const f32x2 zz = {0.f, 0.f}; const f32x2 Gp = m ? G[m - 1] : zz, Vp = m ? V[m - 1] : zz;
                        const f32x2 gp1 = {dpp_prev1(G[m].x, Gp.x), dpp_prev1(G[m].y, Gp.y)}, gp2 = {dpp_prev2(G[m].x, Gp.x), dpp_prev2(G[m].y, Gp.y)};
                        const f32x2 vp1 = {dpp_prev1(V[m].x, Vp.x), dpp_prev1(V[m].y, Vp.y)}, vp2 = {dpp_prev2(V[m].x, Vp.x), dpp_prev2(V[m].y, Vp.y)};
                        const f32x2 gc = bg + g0 * gp2 + g1 * gp1 + g2 * G[m];
                        const f32x2 vc = bv + v0 * vp2 + v1 * vp1 + v2 * V[m];
                        const f32x2 xe = gc * (-LOG2E);
                        f32x2 dn = {__builtin_amdgcn_exp2f(xe.x), __builtin_amdgcn_exp2f(xe.y)}; dn = dn + 1.0f;
                        const f32x2 rc = {__builtin_amdgcn_rcpf(dn.x), __builtin_amdgcn_rcpf(dn.y)};
                        const f32x2 rr = gc * rc * vc;
                        wpk[m][jp] = pk2(rr.x, rr.y); }
                }
#pragma unroll
                for (int m = 0; m < 4; ++m) { const int row = m ? tok0 + 16 * m : row0;
                    *(u32x2*)(ACT + (size_t)row * 2816 + cl + 4 * n) = (u32x2){wpk[m][0], wpk[m][1]}; }
                __builtin_amdgcn_sched_barrier(0);
            }
        }
    }
};

template <class F> DI void tr_items(const F& f, int Kdst, int Nrows, bf16_t* WT, LAS float* scr, int gw, int NGW, int lane, int& cum) {
    const int nblk = Nrows / 32, nitems = (Kdst / 64) * nblk;
    int first = (gw - cum) % NGW; if (first < 0) first += NGW; cum = (cum + nitems) % NGW;
    for (int item = first; item < nitems; item += NGW) {
        const int kb = item / nblk, nb = item % nblk, k0 = 64 * kb, n0 = 32 * nb;
        float tv[32];
#pragma unroll
        for (int i = 0; i < 32; ++i) tv[i] = f(k0 + 2 * i + (lane >> 5), n0 + (lane & 31));
#pragma unroll
        for (int i = 0; i < 32; ++i) scr[(2 * i + (lane >> 5)) * 33 + (lane & 31)] = tv[i];
        asm volatile("s_waitcnt lgkmcnt(0)" ::: "memory");
        const int c = lane & 7;
#pragma unroll
        for (int j = 0; j < 4; ++j) { const int n = (lane >> 3) + 8 * j; const LAS float* s = scr + (8 * c) * 33 + n;
            u32x4 o; o.x = pk2(s[0 * 33], s[1 * 33]); o.y = pk2(s[2 * 33], s[3 * 33]); o.z = pk2(s[4 * 33], s[5 * 33]); o.w = pk2(s[6 * 33], s[7 * 33]);
            *(u32x4*)(WT + (size_t)(n0 + n) * Kdst + k0 + 8 * c) = o; }
        asm volatile("s_waitcnt lgkmcnt(0)" ::: "memory");
    }
}
struct FW1 { const float* W; const float* g; DI float operator()(int k, int n) const { return n < 1440 ? W[(size_t)k * 1440 + n] * g[k] : 0.f; } };
struct FWQ { const float* W; const float* g; DI float operator()(int k, int n) const { const int h = n / 96, d = n - h * 96; int c = d; if (d >= 64) { const int r = d - 64; c = 64 + (r >> 1) + 16 * (r & 1); } return W[(size_t)k * 768 + h * 96 + c] * g[k]; } };
struct FWKV { const float* W; const float* g; int off; DI float operator()(int k, int n) const { return k < 128 ? W[(size_t)k * 1024 + (n >> 6) * 128 + off + (n & 63)] * g[k] : 0.f; } };
struct FWRI { const float* Wa; const float* Wx; DI float operator()(int k, int n) const { const float* W = n < 512 ? Wa : Wx; const int ch = n & 511, g = ch >> 6, j = ch & 63; return (k >> 6) == g ? W[(size_t)k * 64 + j] : 0.f; } };
struct FWP { const float* W; int N; DI float operator()(int k, int n) const { return W[(size_t)k * N + n]; } };
struct FWUP { const float* W; const float* g; DI float operator()(int k, int n) const { const int pn = n >> 8, r = n & 255; const int c = r < 128 ? 128 * pn + r : 2816 + 128 * pn + r - 128; return W[(size_t)k * 5632 + c] * g[k]; } };
struct FWOIN { const float* W; const float* g; DI float operator()(int k, int n) const {
    int c; float s = 1.f; if (n < 512) { c = n; s = 0.08838834764831845f; } else if (n < 1536) c = 2048 + (n - 512); else if (n < 2048) c = 512 + (n - 1536); else c = 1024 + (n - 2048);
    return W[(size_t)k * 3080 + c] * g[k] * s; } };

#ifndef PROPART
#define PROPART 7
#endif
DI void phase_prologue(int wv, const ArgP a, LAS unsigned char* lds, int parts) {
    unsigned char* ws = a.ws();
    const int tid = ltid(wv), wave = tid >> 6, lane = tid & 63;
    LAS float* scr = (LAS float*)(lds + wave * 8448);
    const int gw = blockIdx.x * 8 + wave, NGW = gridDim.x * 8; int cum = 0;
    if (parts & 1) {
    { FW1 f{a.in(3), a.in(2)}; tr_items(f, 1024, 1536, (bf16_t*)(ws + O_W1T), scr, gw, NGW, lane, cum); }
    { FWQ f{a.in(12), a.in(11)}; tr_items(f, 256, 768, (bf16_t*)(ws + O_WQT), scr, gw, NGW, lane, cum); }
    { FWKV f{a.in(14), a.in(13), 0}; tr_items(f, 256, 512, (bf16_t*)(ws + O_WKT), scr, gw, NGW, lane, cum); }
    { FWKV f{a.in(14), a.in(13), 64}; tr_items(f, 256, 512, (bf16_t*)(ws + O_WVT), scr, gw, NGW, lane, cum); }
    { FWRI f{a.in(6), a.in(8)}; tr_items(f, 512, 1024, (bf16_t*)(ws + O_WRIT), scr, gw, NGW, lane, cum); }
    { FWP f{a.in(15), 1024}; tr_items(f, 1024, 1024, (bf16_t*)(ws + O_WO1T), scr, gw, NGW, lane, cum); }
    for (int l = 0; l < 2; ++l) {
        { FWUP f{a.in(23) + (size_t)l * 1024 * 5632, a.in(22) + l * 1024}; tr_items(f, 1024, 5632, (bf16_t*)(ws + (l ? O_WUPT1 : O_WUPT0)), scr, gw, NGW, lane, cum); }
        { FWP f{a.in(26) + (size_t)l * 2816 * 1024, 1024}; tr_items(f, 2816, 1024, (bf16_t*)(ws + (l ? O_WDNT1 : O_WDNT0)), scr, gw, NGW, lane, cum); }
    }
    { FWOIN f{a.in(17), a.in(16)}; tr_items(f, 1024, 3072, (bf16_t*)(ws + O_WOINT), scr, gw, NGW, lane, cum); }
    { FWP f{a.in(21), 1024}; tr_items(f, 1024, 1024, (bf16_t*)(ws + O_WO2T), scr, gw, NGW, lane, cum); }
    }
    if (parts & 2) {
    const float* x = a.in(0); bf16_t* XB = (bf16_t*)(ws + O_XB) + 2 * 1024; u64* rowss = (u64*)(ws + O_ROWSS);
#pragma unroll 4
    for (int t = gw; t < S; t += NGW) {
        float ss = 0.f;
#pragma unroll
        for (int j = 0; j < 4; ++j) { const f32x4 v = *(const f32x4*)(x + (size_t)t * 1024 + j * 256 + lane * 4);
            ss += v[0] * v[0] + v[1] * v[1] + v[2] * v[2] + v[3] * v[3];
            u32x2 w; w.x = pk2(v[0], v[1]); w.y = pk2(v[2], v[3]); *(u32x2*)(XB + (size_t)t * 1024 + j * 256 + lane * 4) = w; }
        ss = wave_sum(ss);
        if (lane == 0) rowss[t] = ss_to_fix(ss);
        if (lane >= 1 && lane < 5) rowss[(size_t)lane * S + t] = 0ull;
    }
    }
    if (parts & 4) {
    const int* pos = (const int*)a.in(1); float* cst = (float*)(ws + O_CSTAB);
    for (int e = blockIdx.x * 512 + tid; e < S * 16; e += gridDim.x * 512) { const int t = e >> 4, i = e & 15;
        const float invf = __builtin_amdgcn_exp2f(-(float)i * (13.287712379549449f / 16.f)); const float ang = (float)pos[t] * invf;
        const float k = rintf(ang * 0.15915494309189535f);
        float r = fmaf(-k, 6.28318548202514648f, ang); r = fmaf(-k, -1.7484555e-7f, r);
        const float rr = r * 0.15915494309189535f;
        cst[2 * e] = __builtin_amdgcn_cosf(rr); cst[2 * e + 1] = __builtin_amdgcn_sinf(rr); }
    }
}

DI void phase_l0_prep(int wv, const ArgP a) {
    unsigned char* ws = a.ws();
    const bf16_t* Z = (const bf16_t*)(ws + O_Z); bf16_t* XC = (bf16_t*)(ws + O_XC); bf16_t* KB = (bf16_t*)(ws + O_KB);
    float* rsq = (float*)(ws + O_RSQ); float* rskv = (float*)(ws + O_RSKV); const float* cst = (const float*)(ws + O_CSTAB);
    const float* cw = a.in(4); const float* cb = a.in(5);
    const int tid = ltid(wv), wave = tid >> 6, lane = tid & 63;
#pragma unroll 2
    for (int e = blockIdx.x * 512 + tid; e < S * 64; e += gridDim.x * 512) { const int t = e >> 6, c0 = (e & 63) * 8;
        float acc[8];
#pragma unroll
        for (int j = 0; j < 8; ++j) acc[j] = cb[c0 + j];
#pragma unroll
        for (int k = 0; k < 4; ++k) { const int tt = t - 3 + k; if (tt < 0) continue;
            const u32x4 v = *(const u32x4*)(Z + (size_t)tt * 1536 + c0);
            const f32x4 w0 = *(const f32x4*)(cw + k * 512 + c0), w1 = *(const f32x4*)(cw + k * 512 + c0 + 4);
            acc[0] += w0[0] * bflo(v.x); acc[1] += w0[1] * bfhi(v.x); acc[2] += w0[2] * bflo(v.y); acc[3] += w0[3] * bfhi(v.y);
            acc[4] += w1[0] * bflo(v.z); acc[5] += w1[1] * bfhi(v.z); acc[6] += w1[2] * bflo(v.w); acc[7] += w1[3] * bfhi(v.w); }
        u32x4 o; o.x = pk2(acc[0], acc[1]); o.y = pk2(acc[2], acc[3]); o.z = pk2(acc[4], acc[5]); o.w = pk2(acc[6], acc[7]);
        *(u32x4*)(XC + (size_t)t * 512 + c0) = o; }
#pragma unroll 4
    for (int t = blockIdx.x * 8 + wave; t < S; t += gridDim.x * 8) {
        const bf16_t* zr = Z + (size_t)t * 1536;
        float sq = 0.f, skv = 0.f;
        { const u32x2 v = *(const u32x2*)(zr + 1024 + lane * 4); const float p0 = bflo(v.x), p1 = bfhi(v.x), p2 = bflo(v.y), p3 = bfhi(v.y); sq = p0 * p0 + p1 * p1 + p2 * p2 + p3 * p3; }
        { const unsigned v = *(const unsigned*)(zr + 1280 + lane * 2); const float p0 = bflo(v), p1 = bfhi(v); skv = p0 * p0 + p1 * p1; }
        sq = wave_sum(sq); skv = wave_sum(skv);
        if (lane == 0) { rsq[t] = rsqrtf(sq * (1.f / 256.f) + EPS); rskv[t] = rsqrtf(skv * (1.f / 128.f) + EPS); }
        if (lane < 16) { const float x1 = bf2f(zr[1408 + lane]), x2 = bf2f(zr[1424 + lane]); const float c = cst[(size_t)t * 32 + 2 * lane], s = cst[(size_t)t * 32 + 2 * lane + 1];
            const unsigned w = pk2(x1 * c - x2 * s, x2 * c + x1 * s);
#pragma unroll
            for (int h = 0; h < 8; ++h) *(unsigned*)(KB + ((size_t)h * S + t) * 96 + 64 + 2 * lane) = w; }
    }
}

DI void lru_coeff(float rpre, float ipre, float xc, float sp8, float& av, float& uv) {
    const float r = sigmoidf_(rpre), ig = sigmoidf_(ipre);
    const float la = -sp8 * r;
    av = fexp(la);
    uv = __builtin_amdgcn_sqrtf(fmaxf(1.f - av * av, 0.f)) * (ig * xc);
}
DI void phase_lru_s1(int wv, const ArgP a) {
    unsigned char* ws = a.ws(); const int ch = ltid(wv);
    const bf16_t* RI = (const bf16_t*)(ws + O_RI); const bf16_t* XC = (const bf16_t*)(ws + O_XC);
    float* CHA = (float*)(ws + O_CHA); float* CHH = (float*)(ws + O_CHH);
    const float ba = a.in(7)[ch], bx = a.in(9)[ch]; const float lam = a.in(10)[ch];
    const float sp8 = 8.f * log1pf(expf(-lam));
    for (int c = blockIdx.x; c < 256; c += gridDim.x) {
        float A = 1.f, H = 0.f;
#pragma unroll 8
        for (int i = 0; i < 64; ++i) { const size_t t = (size_t)c * 64 + i;
            float av, uv; lru_coeff(bf2f(RI[t * 1024 + ch]) + ba, bf2f(RI[t * 1024 + 512 + ch]) + bx, bf2f(XC[t * 512 + ch]), sp8, av, uv);
            A *= av; H = av * H + uv; }
        CHA[c * 512 + ch] = A; CHH[c * 512 + ch] = H;
    }
}
DI void phase_lru_s3(int wv, const ArgP a) {
    unsigned char* ws = a.ws(); const int ch = ltid(wv);
    const bf16_t* RI = (const bf16_t*)(ws + O_RI); const bf16_t* XC = (const bf16_t*)(ws + O_XC); const bf16_t* Z = (const bf16_t*)(ws + O_Z);
    const float* CHA = (const float*)(ws + O_CHA); const float* CHH = (const float*)(ws + O_CHH); bf16_t* MIX = (bf16_t*)(ws + O_MIX);
    const float ba = a.in(7)[ch], bx = a.in(9)[ch]; const float lam = a.in(10)[ch];
    const float sp8 = 8.f * log1pf(expf(-lam));
    for (int c = blockIdx.x; c < 256; c += gridDim.x) {
        float H = 0.f;
#pragma unroll 16
        for (int cc = 0; cc < c; ++cc) H = CHA[cc * 512 + ch] * H + CHH[cc * 512 + ch];
#pragma unroll 4
        for (int i = 0; i < 64; ++i) { const size_t t = (size_t)c * 64 + i;
            float av, uv; lru_coeff(bf2f(RI[t * 1024 + ch]) + ba, bf2f(RI[t * 1024 + 512 + ch]) + bx, bf2f(XC[t * 512 + ch]), sp8, av, uv);
            H = av * H + uv;
            const float g = bf2f(Z[t * 1536 + 512 + ch]);
            const float y = 0.7978845608028654f * (g + 0.044715f * g * g * g);
            const float th = 1.f - 2.f * __builtin_amdgcn_rcpf(1.f + fexp(2.f * y));
            MIX[t * 1024 + ch] = f2bf(H * 0.5f * g * (1.f + th)); }
    }
}

constexpr int AT_KROW = 208, AT_VROW = 136, AT_KT = 64 * AT_KROW, AT_VT = 64 * AT_VROW;
DI float rowmax32(const f32x16& p0, const f32x16& p1) {
    float a = fmaxf(fmaxf(p0[0], p0[1]), p1[0]), b = fmaxf(fmaxf(p0[2], p0[3]), p1[1]); a = fmaxf(fmaxf(a, p1[2]), p1[3]);
#pragma unroll
    for (int r = 4; r < 16; r += 4) { a = fmaxf(fmaxf(a, p0[r]), p0[r + 1]); b = fmaxf(fmaxf(b, p0[r + 2]), p0[r + 3]); a = fmaxf(fmaxf(a, p1[r]), p1[r + 1]); b = fmaxf(fmaxf(b, p1[r + 2]), p1[r + 3]); }
    const float m = fmaxf(a, b);
    return fmaxf(m, __shfl_xor(m, 32));
}
DI void attn_unit(int wv, int h, int qb, const bf16_t* QB, const bf16_t* KB, const bf16_t* VT, bf16_t* MIX, LAS unsigned char* lds) {
    const int tid = ltid(wv), lane = tid & 63, r32 = lane & 31, hi = lane >> 5; const int wid = __builtin_amdgcn_readfirstlane(tid >> 6);
    const int qg = qb * 256 + wid * 32 + r32;
    const bf16_t* Kh = KB + (size_t)h * S * 96; const bf16_t* Vh = VT + (size_t)h * 64 * S;
    bf16x8 qf[6];
    { const bf16_t* qp = QB + ((size_t)h * S + qg) * 96 + 8 * hi;
#pragma unroll
      for (int s = 0; s < 6; ++s) qf[s] = *(const bf16x8*)(qp + 16 * s); }
    f32x16 o0 = {}, o1 = {}, negm = {};
    float mref = 0.f, lrun = 0.f;
    const int NT = 4 * qb + 4, wlim = 4 * qb + (wid >> 1);
    const int kc0 = tid, kkey0 = kc0 / 12, kpart0 = kc0 % 12;
    const int kc1 = tid + 512, kkey1 = kc1 / 12, kpart1 = kc1 % 12;
    const int vdv = tid >> 3, vpart = tid & 7;
    u32x4 rk0, rk1 = {}, rv;
#define AT_LOADK(t_) do { const size_t kb_ = (size_t)(t_) * 64; rk0 = *(const u32x4*)(Kh + (kb_ + kkey0) * 96 + kpart0 * 8); if (tid < 256) rk1 = *(const u32x4*)(Kh + (kb_ + kkey1) * 96 + kpart1 * 8); } while (0)
#define AT_LOADV(t_) do { rv = *(const u32x4*)(Vh + (size_t)vdv * S + (size_t)(t_) * 64 + vpart * 8); } while (0)
#define AT_WRITEK(t_) do { LAS unsigned char* Ks_ = lds + ((t_) & 1) * AT_KT; *(LAS u32x4*)(Ks_ + kkey0 * AT_KROW + kpart0 * 16) = rk0; if (tid < 256) *(LAS u32x4*)(Ks_ + kkey1 * AT_KROW + kpart1 * 16) = rk1; } while (0)
#define AT_WRITEV(t_) do { LAS unsigned char* Vs_ = lds + 2 * AT_KT + ((t_) & 1) * AT_VT; *(LAS u32x2*)(Vs_ + vdv * AT_VROW + vpart * 16) = (u32x2){rv.x, rv.y}; *(LAS u32x2*)(Vs_ + vdv * AT_VROW + vpart * 16 + 8) = (u32x2){rv.z, rv.w}; } while (0)
#define AT_QK(P0, P1, t_) do { const LAS unsigned char* Ks_ = lds + ((t_) & 1) * AT_KT + r32 * AT_KROW + 16 * hi; f32x16 c0_ = negm, c1_ = negm; \
        _Pragma("unroll") for (int s = 0; s < 6; ++s) { const bf16x8 k0_ = *(const LAS bf16x8*)(Ks_ + 32 * s), k1_ = *(const LAS bf16x8*)(Ks_ + 32 * AT_KROW + 32 * s); \
            c0_ = __builtin_amdgcn_mfma_f32_32x32x16_bf16(k0_, qf[s], c0_, 0, 0, 0); c1_ = __builtin_amdgcn_mfma_f32_32x32x16_bf16(k1_, qf[s], c1_, 0, 0, 0); } \
        P0 = c0_; P1 = c1_; } while (0)
#define AT_SM1(P0, P1, MOFF, t_, MASK) do { \
        { const float d_ = mref - MOFF; if (__any(d_ != 0.f)) { _Pragma("unroll") for (int r = 0; r < 16; ++r) { P0[r] -= d_; P1[r] -= d_; } } } \
        if (MASK && (t_) == wlim) { const int kbase_ = (t_) * 64 + 4 * hi; \
            _Pragma("unroll") for (int r = 0; r < 16; ++r) { const int kv_ = kbase_ + (r & 3) + 8 * (r >> 2); if (kv_ > qg) P0[r] = -1e30f; if (kv_ + 32 > qg) P1[r] = -1e30f; } } \
        const float mx_ = rowmax32(P0, P1); \
        if ((t_) == 0 || __any(mx_ > 8.f)) { const float dl_ = ((t_) == 0) ? mx_ : fmaxf(mx_, 0.f); mref += dl_; \
            _Pragma("unroll") for (int r = 0; r < 16; ++r) { P0[r] -= dl_; P1[r] -= dl_; } \
            const float al_ = __builtin_amdgcn_exp2f(-dl_); lrun *= al_; \
            _Pragma("unroll") for (int r = 0; r < 16; ++r) { o0[r] *= al_; o1[r] *= al_; negm[r] = -mref; } asm volatile("" : "+v"(negm)); } \
    } while (0)
#define AT_SM2(P0, P1, t_) do { \
        float ps_ = 0.f; \
        _Pragma("unroll") for (int r = 0; r < 16; ++r) { P0[r] = __builtin_amdgcn_exp2f(P0[r]); P1[r] = __builtin_amdgcn_exp2f(P1[r]); ps_ += P0[r] + P1[r]; } \
        lrun += ps_; \
        const LAS unsigned char* Vs_ = lds + 2 * AT_KT + ((t_) & 1) * AT_VT + r32 * AT_VROW + 8 * hi; \
        _Pragma("unroll") for (int ks = 0; ks < 4; ++ks) { u32x4 w_; \
            if (ks < 2) { w_.x = pk2(P0[8 * ks], P0[8 * ks + 1]); w_.y = pk2(P0[8 * ks + 2], P0[8 * ks + 3]); w_.z = pk2(P0[8 * ks + 4], P0[8 * ks + 5]); w_.w = pk2(P0[8 * ks + 6], P0[8 * ks + 7]); } \
            else { w_.x = pk2(P1[8 * ks - 16], P1[8 * ks - 15]); w_.y = pk2(P1[8 * ks - 14], P1[8 * ks - 13]); w_.z = pk2(P1[8 * ks - 12], P1[8 * ks - 11]); w_.w = pk2(P1[8 * ks - 10], P1[8 * ks - 9]); } \
            const bf16x8 pa_ = __builtin_bit_cast(bf16x8, w_); \
            const u32x2 a0_ = *(const LAS u32x2*)(Vs_ + 32 * ks), a1_ = *(const LAS u32x2*)(Vs_ + 32 * ks + 16); \
            const u32x2 b0_ = *(const LAS u32x2*)(Vs_ + 32 * AT_VROW + 32 * ks), b1_ = *(const LAS u32x2*)(Vs_ + 32 * AT_VROW + 32 * ks + 16); \
            o0 = __builtin_amdgcn_mfma_f32_32x32x16_bf16(__builtin_bit_cast(bf16x8, (u32x4){a0_.x, a0_.y, a1_.x, a1_.y}), pa_, o0, 0, 0, 0); \
            o1 = __builtin_amdgcn_mfma_f32_32x32x16_bf16(__builtin_bit_cast(bf16x8, (u32x4){b0_.x, b0_.y, b1_.x, b1_.y}), pa_, o1, 0, 0, 0); } \
    } while (0)
#define AT_STEPM(C0, C1, MC, N0, N1, MN, t_) do { \
        AT_WRITEK((t_) + 1); AT_WRITEV(t_); \
        __syncthreads(); \
        AT_LOADK((t_) + 2); AT_LOADV((t_) + 1); \
        AT_SM1(C0, C1, MC, t_, 0); MN = mref; AT_QK(N0, N1, (t_) + 1); AT_SM2(C0, C1, t_); \
    } while (0)
#define AT_STEPB(C0, C1, MC, N0, N1, MN, t_) do { \
        if ((t_) + 1 < NT) AT_WRITEK((t_) + 1); AT_WRITEV(t_); \
        __syncthreads(); \
        if ((t_) + 2 < NT) AT_LOADK((t_) + 2); if ((t_) + 1 < NT) AT_LOADV((t_) + 1); \
        if ((t_) + 1 <= wlim) { MN = mref; AT_QK(N0, N1, (t_) + 1); } \
        if ((t_) <= wlim) { AT_SM1(C0, C1, MC, t_, 1); AT_SM2(C0, C1, t_); } \
    } while (0)
    f32x16 pA0, pA1, pB0 = {}, pB1 = {}; float mA = 0.f, mB = 0.f;
    AT_LOADK(0); AT_WRITEK(0);
    __syncthreads();
    AT_LOADK(1); AT_LOADV(0);
    AT_QK(pA0, pA1, 0);
    int t = 0;
    for (; t < 4 * qb; t += 2) {
        AT_STEPM(pA0, pA1, mA, pB0, pB1, mB, t);
        AT_STEPM(pB0, pB1, mB, pA0, pA1, mA, t + 1);
    }
    for (; t < NT; t += 2) {
        AT_STEPB(pA0, pA1, mA, pB0, pB1, mB, t);
        AT_STEPB(pB0, pB1, mB, pA0, pA1, mA, t + 1);
    }
#undef AT_STEPM
#undef AT_STEPB
#undef AT_LOADK
#undef AT_LOADV
#undef AT_WRITEK
#undef AT_WRITEV
#undef AT_QK
#undef AT_SM1
#undef AT_SM2
    lrun += __shfl_xor(lrun, 32);
    const float inv = 1.f / lrun;
    bf16_t* op = MIX + (size_t)qg * 1024 + 512 + h * 64;
#pragma unroll
    for (int g = 0; g < 4; ++g) { const int dv = 8 * g + 4 * hi;
        u32x2 w; w.x = pk2(o0[4 * g] * inv, o0[4 * g + 1] * inv); w.y = pk2(o0[4 * g + 2] * inv, o0[4 * g + 3] * inv); *(u32x2*)(op + dv) = w;
        u32x2 w2; w2.x = pk2(o1[4 * g] * inv, o1[4 * g + 1] * inv); w2.y = pk2(o1[4 * g + 2] * inv, o1[4 * g + 3] * inv); *(u32x2*)(op + 32 + dv) = w2; }
    __syncthreads();
}
DI void phase_attn(int wv, const ArgP a, LAS unsigned char* lds) {
    unsigned char* ws = a.ws();
    const bf16_t* QB = (const bf16_t*)(ws + O_QB); const bf16_t* KB = (const bf16_t*)(ws + O_KB); const bf16_t* VT = (const bf16_t*)(ws + O_VT); bf16_t* MIX = (bf16_t*)(ws + O_MIX);
    for (int b = blockIdx.x; b < 256; b += gridDim.x) {
        const int v = (b & 7) * 32 + (b >> 3), h = v >> 5, s = v & 31;
        attn_unit(wv, h, 63 - s, QB, KB, VT, MIX, lds);
        attn_unit(wv, h, s, QB, KB, VT, MIX, lds);
    }
}

DI void phase_m_gates(int wv, const ArgP a, LAS unsigned char* lds) {
    unsigned char* ws = a.ws(); const int tid = ltid(wv), wave = tid >> 6, lane = tid & 63;
    const bf16_t* XBr = (const bf16_t*)(ws + O_XB) + 2 * 1024; const u64* rowss = (const u64*)(ws + O_ROWSS) + 2 * S;
    const float* Wg = a.in(17); const float* gn = a.in(16);
    LAS float* wgs = (LAS float*)lds;
    LAS float* pre = (LAS float*)(lds + 32768);
    float* GB = (float*)(ws + O_GB); float* GE = (float*)(ws + O_GE); float* GPM = (float*)(ws + O_GPM);
    float* BL = (float*)(ws + O_BL); float* ML = (float*)(ws + O_ML);
    for (int e = tid; e < 8192; e += 512) { const int k = e >> 3, j = e & 7; wgs[e] = Wg[(size_t)k * 3080 + 3072 + j] * gn[k]; }
    __syncthreads();
    for (int c = blockIdx.x; c < 256; c += gridDim.x) {
#pragma unroll 4
        for (int i = 0; i < 8; ++i) { const int t = c * 64 + wave * 8 + i;
            float acc[8];
#pragma unroll
            for (int j = 0; j < 8; ++j) acc[j] = 0.f;
#pragma unroll
            for (int jj = 0; jj < 4; ++jj) { const int k0 = jj * 256 + lane * 4; const u32x2 hb = *(const u32x2*)(XBr + (size_t)t * 1024 + k0); const f32x4 hv = {bflo(hb.x), bfhi(hb.x), bflo(hb.y), bfhi(hb.y)};
#pragma unroll
                for (int kk = 0; kk < 4; ++kk) { const f32x4 w0 = *(const LAS f32x4*)(wgs + (k0 + kk) * 8), w1 = *(const LAS f32x4*)(wgs + (k0 + kk) * 8 + 4);
                    acc[0] += hv[kk] * w0[0]; acc[1] += hv[kk] * w0[1]; acc[2] += hv[kk] * w0[2]; acc[3] += hv[kk] * w0[3];
                    acc[4] += hv[kk] * w1[0]; acc[5] += hv[kk] * w1[1]; acc[6] += hv[kk] * w1[2]; acc[7] += hv[kk] * w1[3]; } }
            const float rs = rs_from_ss(rowss[t]);
            { const bool b5 = lane & 32, b4 = lane & 16, b3 = lane & 8;
#pragma unroll
              for (int j = 0; j < 4; ++j) { const float snd = b5 ? acc[j] : acc[j + 4], kp = b5 ? acc[j + 4] : acc[j]; acc[j] = kp + __shfl_xor(snd, 32); }
#pragma unroll
              for (int j = 0; j < 2; ++j) { const float snd = b4 ? acc[j] : acc[j + 2], kp = b4 ? acc[j + 2] : acc[j]; acc[j] = kp + __shfl_xor(snd, 16); }
              { const float snd = b3 ? acc[0] : acc[1], kp = b3 ? acc[1] : acc[0]; acc[0] = kp + __shfl_xor(snd, 8); }
              acc[0] += __shfl_xor(acc[0], 4); acc[0] += __shfl_xor(acc[0], 2); acc[0] += __shfl_xor(acc[0], 1);
              if ((lane & 7) == 0) pre[(wave * 8 + i) * 8 + (b5 ? 4 : 0) + (b4 ? 2 : 0) + (b3 ? 1 : 0)] = acc[0] * rs; }
        }
        __syncthreads();
        if (wave < 4) { const int h = wave; const float bi = a.in(18)[h], bfg = a.in(19)[h];
            const float ig = 15.f * tanhf((pre[lane * 8 + h] + bi) * (1.f / 15.f));
            const float fg = 15.f * tanhf((pre[lane * 8 + 4 + h] + bfg) * (1.f / 15.f));
            float b = -log1pf(expf(-fg));
#pragma unroll
            for (int o = 1; o < 64; o <<= 1) { const float v = __shfl_up(b, o); if (lane >= o) b += v; }
            const float e = ig - b; float pm = e;
#pragma unroll
            for (int o = 1; o < 64; o <<= 1) { const float v = __shfl_up(pm, o); if (lane >= o) pm = fmaxf(pm, v); }
            const size_t o_ = (size_t)h * S + c * 64 + lane; GB[o_] = b; GE[o_] = e; GPM[o_] = pm;
            if (lane == 63) { BL[c * 4 + h] = b; ML[c * 4 + h] = b + pm; } }
        __syncthreads();
    }
}
DI void phase_m_dc(int wv, const ArgP a) {
    unsigned char* ws = a.ws(); const int tid = ltid(wv), lane = tid & 63, r32 = lane & 31, hi = lane >> 5; const int w = __builtin_amdgcn_readfirstlane(tid >> 6);
    const float* BL = (const float*)(ws + O_BL); const float* ML = (const float*)(ws + O_ML); float* NST = (float*)(ws + O_NST);
    const float* GE = (const float*)(ws + O_GE); const bf16_t* KVT = (const bf16_t*)(ws + O_KVT); bf16_t* CST = (bf16_t*)(ws + O_CST);
    for (int u = blockIdx.x; u < 1024; u += gridDim.x) {
        const int c = u >> 2, h = u & 3; const size_t t0 = (size_t)c * 64;
        const float emax = ML[c * 4 + h] - BL[c * 4 + h];
        bf16x8 bfr[4];
        { const bf16_t* vp = KVT + (size_t)(512 + h * 256 + 32 * w + r32) * S + t0 + 8 * hi; const float* gp = GE + (size_t)h * S + t0 + 8 * hi;
#pragma unroll
          for (int ks = 0; ks < 4; ++ks) { const u32x4 v = *(const u32x4*)(vp + 16 * ks); const f32x4 e0 = *(const f32x4*)(gp + 16 * ks), e1 = *(const f32x4*)(gp + 16 * ks + 4);
              u32x4 o; o.x = pk2(bflo(v.x) * fexp(e0[0] - emax), bfhi(v.x) * fexp(e0[1] - emax)); o.y = pk2(bflo(v.y) * fexp(e0[2] - emax), bfhi(v.y) * fexp(e0[3] - emax));
              o.z = pk2(bflo(v.z) * fexp(e1[0] - emax), bfhi(v.z) * fexp(e1[1] - emax)); o.w = pk2(bflo(v.w) * fexp(e1[2] - emax), bfhi(v.w) * fexp(e1[3] - emax));
              bfr[ks] = __builtin_bit_cast(bf16x8, o); } }
        const bf16_t* kp = KVT + (size_t)(h * 128 + r32) * S + t0 + 8 * hi;
        bf16_t* op = CST + ((size_t)(c * 4 + h) * 256 + 32 * w + r32) * 128 + 4 * hi;
#pragma unroll
        for (int rb = 0; rb < 4; ++rb) { f32x16 acc = {};
#pragma unroll
            for (int ks = 0; ks < 4; ++ks) { const bf16x8 ka = *(const bf16x8*)(kp + (size_t)(32 * rb) * S + 16 * ks); acc = __builtin_amdgcn_mfma_f32_32x32x16_bf16(ka, bfr[ks], acc, 0, 0, 0); }
#pragma unroll
            for (int g = 0; g < 4; ++g) { u32x2 o; o.x = pk2(acc[4 * g], acc[4 * g + 1]); o.y = pk2(acc[4 * g + 2], acc[4 * g + 3]); *(u32x2*)(op + 32 * rb + 8 * g) = o; } }
        if (tid < 128) { const bf16_t* kr = KVT + (size_t)(h * 128 + tid) * S + t0; const float* gp = GE + (size_t)h * S + t0; float s = 0.f;
#pragma unroll
            for (int p = 0; p < 8; ++p) { const u32x4 v = *(const u32x4*)(kr + 8 * p); const f32x4 e0 = *(const f32x4*)(gp + 8 * p), e1 = *(const f32x4*)(gp + 8 * p + 4);
                s += bflo(v.x) * fexp(e0[0] - emax) + bfhi(v.x) * fexp(e0[1] - emax) + bflo(v.y) * fexp(e0[2] - emax) + bfhi(v.y) * fexp(e0[3] - emax)
                   + bflo(v.z) * fexp(e1[0] - emax) + bfhi(v.z) * fexp(e1[1] - emax) + bflo(v.w) * fexp(e1[2] - emax) + bfhi(v.w) * fexp(e1[3] - emax); }
            NST[(size_t)(c * 4 + h) * 128 + tid] = s; }
    }
}
DI void phase_m_comb(int wv, const ArgP a, LAS unsigned char* lds, int dry) {
    unsigned char* ws = a.ws(); const int tid = ltid(wv);
    const float* BL = (const float*)(ws + O_BL); const float* ML = (const float*)(ws + O_ML); float* MST = (float*)(ws + O_MST); float* NST = (float*)(ws + O_NST);
    bf16_t* CST = (bf16_t*)(ws + O_CST);
    LAS float* bls = (LAS float*)lds; LAS float* mls = bls + 1024; LAS float* ga = mls + 1024; LAS float* gb = ga + 1024;
    for (int e = tid; e < 1024; e += 512) { bls[e] = BL[e]; mls[e] = ML[e]; }
    __syncthreads();
    if (tid < 256) { const int h = tid >> 6, l = tid & 63;
        float a_ = 0.f, b_ = -1e30f;
#pragma unroll
        for (int k = 0; k < 4; ++k) { const float bl = bls[(4 * l + k) * 4 + h], ml = mls[(4 * l + k) * 4 + h]; a_ += bl; b_ = fmaxf(b_ + bl, ml); }
        float pa = a_, pb = b_;
#pragma unroll
        for (int o = 1; o < 64; o <<= 1) { const float qa = __shfl_up(pa, o), qb = __shfl_up(pb, o); if (l >= o) { pb = fmaxf(qb + pa, pb); pa = qa + pa; } }
        float ea = __shfl_up(pa, 1), eb_ = __shfl_up(pb, 1); if (l == 0) { ea = 0.f; eb_ = -1e30f; }
        float m = fmaxf(0.f + ea, eb_);
#pragma unroll
        for (int k = 0; k < 4; ++k) { const int c = 4 * l + k; const float bl = bls[c * 4 + h], ml = mls[c * 4 + h]; const float mn = fmaxf(bl + m, ml);
            ga[c * 4 + h] = fexp(bl + m - mn); gb[c * 4 + h] = fexp(ml - mn);
            if (blockIdx.x == 0 && !dry) MST[c * 4 + h] = m;
            m = mn; } }
    __syncthreads();
    for (int eb = blockIdx.x; eb < 129; eb += gridDim.x) {
        if (eb < 128) { const int h = eb >> 5; unsigned* p = (unsigned*)(CST + (size_t)h * 32768 + (size_t)(eb & 31) * 1024 + 2 * tid); float C0 = 0.f, C1 = 0.f;
            for (int c = 0; c < 256; c += 64) { unsigned d[64];
#pragma unroll
                for (int k = 0; k < 64; ++k) d[k] = p[(size_t)(c + k) * 65536];
#pragma unroll
                for (int k = 0; k < 64; ++k) { if (!dry) p[(size_t)(c + k) * 65536] = pk2(C0, C1); const float a_ = ga[(c + k) * 4 + h], b_ = gb[(c + k) * 4 + h]; C0 = a_ * C0 + b_ * bflo(d[k]); C1 = a_ * C1 + b_ * bfhi(d[k]); } }
        } else { const int h = tid >> 7; float* p = NST + tid; float C = 0.f;
            for (int c = 0; c < 256; c += 8) { float d[8];
#pragma unroll
                for (int k = 0; k < 8; ++k) d[k] = p[(size_t)(c + k) * 512];
#pragma unroll
                for (int k = 0; k < 8; ++k) { if (!dry) p[(size_t)(c + k) * 512] = C; C = ga[(c + k) * 4 + h] * C + gb[(c + k) * 4 + h] * d[k]; } } }
    }
    __syncthreads();
}
constexpr int MC_QROW = 272, MC_SROW = 144;
constexpr int MC_QS = 0, MC_KS = 64 * MC_QROW, MC_SC = 2 * 64 * MC_QROW, MC_F = MC_SC + 64 * MC_SROW;
DI void phase_m_out(int wv, const ArgP a, LAS unsigned char* lds, int dry) {
    unsigned char* ws = a.ws(); const int tid = ltid(wv), lane = tid & 63, r32 = lane & 31, hi = lane >> 5; const int w = __builtin_amdgcn_readfirstlane(tid >> 6);
    bf16_t* QOK = (bf16_t*)(ws + O_QOK); const bf16_t* KVT = (const bf16_t*)(ws + O_KVT); const bf16_t* CST = (const bf16_t*)(ws + O_CST);
    const float* GB = (const float*)(ws + O_GB); const float* GE = (const float*)(ws + O_GE); const float* GPM = (const float*)(ws + O_GPM);
    const float* MST = (const float*)(ws + O_MST); const float* NST = (const float*)(ws + O_NST); const float* ong = a.in(20);
    LAS unsigned char* Qs = lds + MC_QS; LAS unsigned char* Ks = lds + MC_KS; LAS unsigned char* Sc = lds + MC_SC;
    LAS float* F = (LAS float*)(lds + MC_F);
    LAS float* f_b = F, *f_e = F + 64, *f_m = F + 128, *f_g = F + 192, *f_qn = F + 256, *f_ps = F + 320  , *f_n = F + 576  , *f_part = F + 704  ;
    for (int u = blockIdx.x; u < 1024; u += gridDim.x) {
        const int c = u >> 2, h = u & 3; const size_t t0 = (size_t)c * 64;
        for (int e = tid; e < 1024; e += 512) { const int r = e >> 4, p = e & 15;
            *(LAS u32x4*)(Qs + r * MC_QROW + p * 16) = *(const u32x4*)(QOK + (t0 + r) * 2048 + h * 128 + p * 8);
            *(LAS u32x4*)(Ks + r * MC_QROW + p * 16) = *(const u32x4*)(QOK + (t0 + r) * 2048 + 1536 + h * 128 + p * 8); }
        if (tid < 64) { const float mstv = MST[c * 4 + h]; const float b = GB[(size_t)h * S + t0 + tid], e = GE[(size_t)h * S + t0 + tid], pm = GPM[(size_t)h * S + t0 + tid];
            const float m = b + fmaxf(mstv, pm); f_b[tid] = b; f_e[tid] = e; f_m[tid] = m; f_g[tid] = fexp(b + mstv - m); }
        if (tid >= 64 && tid < 192) f_n[tid - 64] = NST[(size_t)(c * 4 + h) * 128 + tid - 64];
        __syncthreads();
        if (w < 4) {
            const int sb = w & 1, tb = w >> 1; const int tl = 32 * tb + r32;
            f32x16 x = {};
#pragma unroll
            for (int ks = 0; ks < 8; ++ks) {
                const bf16x8 ka = *(const LAS bf16x8*)(Ks + (32 * sb + r32) * MC_QROW + (16 * ks + 8 * hi) * 2);
                const bf16x8 qb = *(const LAS bf16x8*)(Qs + tl * MC_QROW + (16 * ks + 8 * hi) * 2);
                x = __builtin_amdgcn_mfma_f32_32x32x16_bf16(ka, qb, x, 0, 0, 0); }
            const float bt = f_b[tl], mt = f_m[tl]; float ps = 0.f;
#pragma unroll
            for (int g = 0; g < 4; ++g) { float v[4];
#pragma unroll
                for (int j = 0; j < 4; ++j) { const int sl = 32 * sb + 8 * g + 4 * hi + j; const float wgt = (sl <= tl) ? fexp(bt + f_e[sl] - mt) : 0.f; v[j] = x[4 * g + j] * wgt; ps += v[j]; }
                u32x2 o; o.x = pk2(v[0], v[1]); o.y = pk2(v[2], v[3]);
                *(LAS u32x2*)(Sc + tl * MC_SROW + (32 * sb + 8 * g + 4 * hi) * 2) = o; }
            f_ps[(sb * 2 + hi) * 64 + tl] = ps;
        } else {
            const int tl = 16 * (w - 4) + (lane >> 2), qq = lane & 3; float s = 0.f;
#pragma unroll
            for (int p = 0; p < 4; ++p) { const u32x4 v = *(const LAS u32x4*)(Qs + tl * MC_QROW + (32 * qq + 8 * p) * 2); LAS float* np = f_n + 32 * qq + 8 * p;
                s += bflo(v.x) * np[0] + bfhi(v.x) * np[1] + bflo(v.y) * np[2] + bfhi(v.y) * np[3] + bflo(v.z) * np[4] + bfhi(v.z) * np[5] + bflo(v.w) * np[6] + bfhi(v.w) * np[7]; }
            s += __shfl_xor(s, 1); s += __shfl_xor(s, 2);
            if (qq == 0) f_qn[tl] = s;
        }
        __syncthreads();
        f32x16 acc0 = {}, acc1 = {};
        { const bf16_t* cp = CST + ((size_t)(c * 4 + h) * 256 + 32 * w + r32) * 128 + 8 * hi;
#pragma unroll
          for (int ks = 0; ks < 8; ++ks) { const bf16x8 ca = *(const bf16x8*)(cp + 16 * ks);
              const bf16x8 q0 = *(const LAS bf16x8*)(Qs + r32 * MC_QROW + (16 * ks + 8 * hi) * 2), q1 = *(const LAS bf16x8*)(Qs + (32 + r32) * MC_QROW + (16 * ks + 8 * hi) * 2);
              acc0 = __builtin_amdgcn_mfma_f32_32x32x16_bf16(ca, q0, acc0, 0, 0, 0); acc1 = __builtin_amdgcn_mfma_f32_32x32x16_bf16(ca, q1, acc1, 0, 0, 0); } }
        const float g0 = f_g[r32], g1 = f_g[32 + r32];
#pragma unroll
        for (int r = 0; r < 16; ++r) { acc0[r] *= g0; acc1[r] *= g1; }
        { const bf16_t* vp = KVT + (size_t)(512 + h * 256 + 32 * w + r32) * S + t0 + 8 * hi;
#pragma unroll
          for (int ks = 0; ks < 4; ++ks) { const bf16x8 va = *(const bf16x8*)(vp + 16 * ks);
              const bf16x8 s0 = *(const LAS bf16x8*)(Sc + r32 * MC_SROW + (16 * ks + 8 * hi) * 2), s1 = *(const LAS bf16x8*)(Sc + (32 + r32) * MC_SROW + (16 * ks + 8 * hi) * 2);
              acc0 = __builtin_amdgcn_mfma_f32_32x32x16_bf16(va, s0, acc0, 0, 0, 0); acc1 = __builtin_amdgcn_mfma_f32_32x32x16_bf16(va, s1, acc1, 0, 0, 0); } }
        float inv[2];
#pragma unroll
        for (int tb = 0; tb < 2; ++tb) { const int tl = 32 * tb + r32;
            const float den = f_g[tl] * f_qn[tl] + f_ps[tl] + f_ps[64 + tl] + f_ps[128 + tl] + f_ps[192 + tl];
            inv[tb] = 1.f / fmaxf(fabsf(den), fexp(-f_m[tl])); }
        float ss0 = 0.f, ss1 = 0.f;
#pragma unroll
        for (int r = 0; r < 16; ++r) { acc0[r] *= inv[0]; acc1[r] *= inv[1]; ss0 += acc0[r] * acc0[r]; ss1 += acc1[r] * acc1[r]; }
        ss0 += __shfl_xor(ss0, 32); ss1 += __shfl_xor(ss1, 32);
        if (hi == 0) { f_part[w * 64 + r32] = ss0; f_part[w * 64 + 32 + r32] = ss1; }
        __syncthreads();
        float rn[2];
#pragma unroll
        for (int tb = 0; tb < 2; ++tb) { float s = 0.f;
#pragma unroll
            for (int ww = 0; ww < 8; ++ww) s += f_part[ww * 64 + 32 * tb + r32];
            rn[tb] = rsqrtf(s * (1.f / 256.f) + EPS); }
#pragma unroll
        for (int tb = 0; tb < 2; ++tb) { bf16_t* op = QOK + (t0 + 32 * tb + r32) * 2048 + 512 + h * 256 + 32 * w;
#pragma unroll
            for (int g = 0; g < 4; ++g) { const int dv = 8 * g + 4 * hi; const u32x2 ov = *(const u32x2*)(op + dv);
                const f32x4 gg = *(const f32x4*)(ong + h * 256 + 32 * w + dv);
                const float og[4] = {bflo(ov.x), bfhi(ov.x), bflo(ov.y), bfhi(ov.y)}; float y[4];
#pragma unroll
                for (int j = 0; j < 4; ++j) { const float hv = (tb ? acc1[4 * g + j] : acc0[4 * g + j]) * rn[tb]; y[j] = hv * gg[j] * sigmoidf_(og[j]); }
                u32x2 o; o.x = pk2(y[0], y[1]); o.y = pk2(y[2], y[3]); if (!dry) *(u32x2*)(op + dv) = o; } }
        __syncthreads();
    }
}

DI void phase_final(int wv, const ArgP a) {
    float* out = a.out(); const u64* rowss = (const u64*)(a.ws() + O_ROWSS) + 4 * S; const float* g = a.in(27); const bf16_t* XBr = (const bf16_t*)(a.ws() + O_XB) + 2 * 1024;
    for (size_t e = (size_t)blockIdx.x * 512 + ltid(wv); e < (size_t)S * 128; e += (size_t)gridDim.x * 512) { const int t = (int)(e >> 7), c = (int)(e & 127) * 8;
        const float rs = rs_from_ss(rowss[t]); const u32x4 hb = *(const u32x4*)(XBr + (size_t)t * 1024 + c); const f32x4 g0 = *(const f32x4*)(g + c), g1 = *(const f32x4*)(g + c + 4);
        const f32x4 v0 = (f32x4){bflo(hb.x), bfhi(hb.x), bflo(hb.y), bfhi(hb.y)} * rs * g0, v1 = (f32x4){bflo(hb.z), bfhi(hb.z), bflo(hb.w), bfhi(hb.w)} * rs * g1;
        *(f32x4*)(out + (size_t)t * 1024 + c) = v0; *(f32x4*)(out + (size_t)t * 1024 + c + 4) = v1; }
}

#ifndef DIS
#define DIS 0u
#endif
#ifndef REP
#define REP 0u
#endif
#ifndef XSYNC
#define XSYNC 0
#endif

#define XB_TMO      128
#define XB_XCNT(j)  (256  + 64 * (j))
#define XB_XSUB(j)  (1280 + 64 * (j))
#define XB_XGEN(j)  (2304 + 64 * (j))
#define XB_TOP      3328
#define XB_TOPGEN   3392
#define XB_SPIN_CAP (1u << 18)
DI unsigned xb_ld(unsigned* p) { return __hip_atomic_load(p, __ATOMIC_RELAXED, __HIP_MEMORY_SCOPE_AGENT); }
DI unsigned xb_add(unsigned* p, unsigned v) { return __hip_atomic_fetch_add(p, v, __ATOMIC_RELAXED, __HIP_MEMORY_SCOPE_AGENT); }
DI unsigned xb_xcc_id() { return (unsigned)__builtin_amdgcn_s_getreg((3 << 11) | 20) & 0xFu; }
#define XB_SPIN(cond, bar) do { unsigned _sp = 0; while (cond) { __builtin_amdgcn_s_sleep(1); \
    if ((++_sp & 255u) == 0u) { if (xb_ld(&(bar)[XB_TMO])) break; if (_sp > XB_SPIN_CAP) { atomicAdd(&(bar)[XB_TMO], 1u); break; } } } } while (0)
DI void xcd_barrier_complete(unsigned* bar, unsigned x, unsigned& nloc, unsigned& nx) {
    const unsigned G = gridDim.x;
    unsigned sum, cnt, mine, sp = 0u;
    for (;;) {
        sum = 0u; cnt = 0u; mine = 0u;
#pragma unroll
        for (unsigned j = 0; j < 16; ++j) { const unsigned c = xb_ld(&bar[XB_XCNT(j)]); sum += c; cnt += (c > 0u) ? 1u : 0u; mine = (j == x) ? c : mine; }
        if (sum == G) break;
        __builtin_amdgcn_s_sleep(1);
        if ((++sp & 255u) == 0u) { if (xb_ld(&bar[XB_TMO])) break; if (sp > XB_SPIN_CAP) { atomicAdd(&bar[XB_TMO], 1u); break; } }
    }
    nloc = mine > 0u ? mine : 1u; nx = cnt > 0u ? cnt : 1u;
}
DI void xcd_barrier(int wv, unsigned* bar, volatile LAS unsigned* st) {
    asm volatile("s_waitcnt vmcnt(0)" ::: "memory");
    __syncthreads();
    if (ltid(wv) == 0) {
        const unsigned x = xb_xcc_id();
        __builtin_amdgcn_s_waitcnt(0);
        unsigned nloc = st[0], nx = st[1];
        if (nloc == 0u) { xcd_barrier_complete(bar, x, nloc, nx); st[0] = nloc; st[1] = nx; }
        const unsigned old = xb_add(&bar[XB_XSUB(x)], 1u);
        const unsigned gen = old / nloc;
        if (old + 1u == (gen + 1u) * nloc) {
            __builtin_amdgcn_fence(__ATOMIC_RELEASE, "agent");
            asm volatile("s_waitcnt vmcnt(0)" ::: "memory");
            const unsigned og = xb_add(&bar[XB_TOP], 1u);
            const unsigned tg = og / nx;
            if (og + 1u == (tg + 1u) * nx) xb_add(&bar[XB_TOPGEN], 1u);
            else XB_SPIN(xb_ld(&bar[XB_TOPGEN]) == tg, bar);
            __builtin_amdgcn_fence(__ATOMIC_ACQUIRE, "agent");
            xb_add(&bar[XB_XGEN(x)], 1u);
            asm volatile("s_waitcnt vmcnt(0)" ::: "memory");
        } else {
            XB_SPIN(xb_ld(&bar[XB_XGEN(x)]) == gen, bar);
            __builtin_amdgcn_fence(__ATOMIC_ACQUIRE, "agent");
            asm volatile("s_waitcnt vmcnt(0)" ::: "memory");
        }
    }
    __syncthreads();
}
DI ArgP getargs() { ArgP r; r.p = (const __attribute__((address_space(4))) Args*)__builtin_amdgcn_kernarg_segment_ptr(); asm volatile("" : "+s"(r.p)); return r; }
#define WSB (getargs().ws())
#define XBP ((bf16_t*)(getargs().ws() + O_XB) + 2 * 1024)
#define RSS ((u64*)(getargs().ws() + O_ROWSS))
#define HFP (getargs().out())
__global__ void __launch_bounds__(512, 2) fwd_kernel(Args a_unused) {
    extern __shared__ __attribute__((aligned(16))) unsigned char shm[];
    LAS unsigned char* lds = (LAS unsigned char*)shm;
    const int wv = __builtin_amdgcn_readfirstlane(threadIdx.x >> 6);
#define BARW ((unsigned*)(getargs().ws() + O_BAR))
#define BARST ((volatile LAS unsigned*)(lds + 139264))
#define GSYNC() xcd_barrier(wv, BARW, BARST)
    { unsigned* barw0 = BARW; if (threadIdx.x == 0) { BARST[0] = 0u; BARST[1] = 0u; (void)xb_add(&barw0[XB_XCNT(xb_xcc_id())], 1u); } }
    if (getargs().p->pad == 0x7fffffff) cg::this_grid().sync();

#if !(DIS & (1u << 0))
    for (int rep_ = 0; rep_ < ((REP >> 0) & 1u) + 1; ++rep_) { const int dry_ = rep_ < (int)((REP >> 0) & 1u); (void)dry_;
    phase_prologue(wv, getargs(), lds, dry_ ? PROPART : 7);
    }
#endif
    GSYNC();
#if !(DIS & (1u << 1))
    for (int rep_ = 0; rep_ < ((REP >> 1) & 1u) + 1; ++rep_) { const int dry_ = rep_ < (int)((REP >> 1) & 1u); (void)dry_;
    { EpiRowBf16<1> E{(bf16_t*)(WSB + O_Z), 1536, RSS};
      pg8::gemm_phase<false>(wv, lds, XBP, 1024, (const bf16_t*)(WSB + O_W1T), 1024, 1024, 64, 6, E); }
    }
#endif
    GSYNC();
#if !(DIS & (1u << 2))
    for (int rep_ = 0; rep_ < ((REP >> 2) & 1u) + 1; ++rep_) { const int dry_ = rep_ < (int)((REP >> 2) & 1u); (void)dry_;
    phase_l0_prep(wv, getargs());
    }
#endif
    GSYNC();
#if !(DIS & (1u << 3))
    for (int rep_ = 0; rep_ < ((REP >> 3) & 1u) + 1; ++rep_) { const int dry_ = rep_ < (int)((REP >> 3) & 1u); (void)dry_;
    { EpiRowBf16<0> E{(bf16_t*)(WSB + O_RI), 1024, nullptr};
      pg8::gemm_phase<false>(wv, lds, (const bf16_t*)(WSB + O_XC), 512, (const bf16_t*)(WSB + O_WRIT), 512, 512, 64, 4, E); }
    }
#endif
#if !(DIS & (1u << 4))
    for (int rep_ = 0; rep_ < ((REP >> 4) & 1u) + 1; ++rep_) { const int dry_ = rep_ < (int)((REP >> 4) & 1u); (void)dry_;
    { EpiQ E{(bf16_t*)(WSB + O_QB), (const float*)(WSB + O_RSQ), (const float*)(WSB + O_CSTAB)};
      pg8::gemm_phase<false>(wv, lds, (const bf16_t*)(WSB + O_Z) + 1024, 1536, (const bf16_t*)(WSB + O_WQT), 256, 256, 64, 3, E); }
    }
#endif
#if !(DIS & (1u << 5))
    for (int rep_ = 0; rep_ < ((REP >> 5) & 1u) + 1; ++rep_) { const int dry_ = rep_ < (int)((REP >> 5) & 1u); (void)dry_;
    { EpiK E{(bf16_t*)(WSB + O_KB), (const float*)(WSB + O_RSKV)};
      pg8::gemm_phase<false>(wv, lds, (const bf16_t*)(WSB + O_Z) + 1280, 1536, (const bf16_t*)(WSB + O_WKT), 256, 256, 64, 2, E, 192); }
    }
#endif
#if !(DIS & (1u << 6))
    for (int rep_ = 0; rep_ < ((REP >> 6) & 1u) + 1; ++rep_) { const int dry_ = rep_ < (int)((REP >> 6) & 1u); (void)dry_;
    { EpiColBf16<2> E{(bf16_t*)(WSB + O_VT), S, (const float*)(WSB + O_RSKV)};
      pg8::gemm_phase<false>(wv, lds, (const bf16_t*)(WSB + O_WVT), 256, (const bf16_t*)(WSB + O_Z) + 1280, 1536, 256, 2, 64, E, 64); }
    }
#endif
    GSYNC();
#if !(DIS & (1u << 7))
    for (int rep_ = 0; rep_ < ((REP >> 7) & 1u) + 1; ++rep_) { const int dry_ = rep_ < (int)((REP >> 7) & 1u); (void)dry_;
    phase_lru_s1(wv, getargs());
    }
#endif
    GSYNC();
#if !(DIS & (1u << 8))
    for (int rep_ = 0; rep_ < ((REP >> 8) & 1u) + 1; ++rep_) { const int dry_ = rep_ < (int)((REP >> 8) & 1u); (void)dry_;
    phase_lru_s3(wv, getargs());
    }
#endif
#if !(DIS & (1u << 9))
    for (int rep_ = 0; rep_ < ((REP >> 9) & 1u) + 1; ++rep_) { const int dry_ = rep_ < (int)((REP >> 9) & 1u); (void)dry_;
    phase_attn(wv, getargs(), lds);
    }
#endif
    GSYNC();
#if !(DIS & (1u << 10))
    for (int rep_ = 0; rep_ < ((REP >> 10) & 1u) + 1; ++rep_) { const int dry_ = rep_ < (int)((REP >> 10) & 1u); (void)dry_;
    { EpiRes<false> E{getargs().in(0), XBP, RSS + 1 * S, dry_};
      pg8::gemm_phase<false>(wv, lds, (const bf16_t*)(WSB + O_MIX), 1024, (const bf16_t*)(WSB + O_WO1T), 1024, 1024, 64, 4, E); }
    }
#endif
    GSYNC();
#if !(DIS & (1u << 11))
    for (int rep_ = 0; rep_ < ((REP >> 11) & 1u) + 1; ++rep_) { const int dry_ = rep_ < (int)((REP >> 11) & 1u); (void)dry_;
    { EpiUp E{(bf16_t*)(WSB + O_ACT), RSS + 1 * S, getargs().in(24), getargs().in(25), lds + 131072};
      pg8::gemm_phase<true>(wv, lds, XBP, 1024, (const bf16_t*)(WSB + O_WUPT0), 1024, 1024, 67, 22, E); }
    }
#endif
    GSYNC();
#if !(DIS & (1u << 12))
    for (int rep_ = 0; rep_ < ((REP >> 12) & 1u) + 1; ++rep_) { const int dry_ = rep_ < (int)((REP >> 12) & 1u); (void)dry_;
    { EpiRes<true> E{nullptr, XBP, RSS + 2 * S, dry_};
      pg8::gemm_phase<false>(wv, lds, (const bf16_t*)(WSB + O_ACT), 2816, (const bf16_t*)(WSB + O_WDNT0), 2816, 2816, 64, 4, E); }
    }
#endif
    GSYNC();
#if !(DIS & (1u << 13))
    for (int rep_ = 0; rep_ < ((REP >> 13) & 1u) + 1; ++rep_) { const int dry_ = rep_ < (int)((REP >> 13) & 1u); (void)dry_;
    { EpiRowBf16<1> E{(bf16_t*)(WSB + O_QOK), 2048, RSS + 2 * S};
      pg8::gemm_phase<false>(wv, lds, XBP, 1024, (const bf16_t*)(WSB + O_WOINT), 1024, 1024, 64, 8, E); }
    }
#endif
#if !(DIS & (1u << 14))
    for (int rep_ = 0; rep_ < ((REP >> 14) & 1u) + 1; ++rep_) { const int dry_ = rep_ < (int)((REP >> 14) & 1u); (void)dry_;
    { EpiColBf16<1> E{(bf16_t*)(WSB + O_KVT), S, RSS + 2 * S};
      pg8::gemm_phase<false>(wv, lds, (const bf16_t*)(WSB + O_WOINT) + (size_t)1536 * 1024, 1024, XBP, 1024, 1024, 6, 64, E); }
    }
#endif
#if !(DIS & (1u << 15))
    for (int rep_ = 0; rep_ < ((REP >> 15) & 1u) + 1; ++rep_) { const int dry_ = rep_ < (int)((REP >> 15) & 1u); (void)dry_;
    phase_m_gates(wv, getargs(), lds);
    }
#endif
    GSYNC();
#if !(DIS & (1u << 16))
    for (int rep_ = 0; rep_ < ((REP >> 16) & 1u) + 1; ++rep_) { const int dry_ = rep_ < (int)((REP >> 16) & 1u); (void)dry_;
    phase_m_dc(wv, getargs());
    }
#endif
    GSYNC();
#if !(DIS & (1u << 22))
    for (int rep_ = 0; rep_ < ((REP >> 22) & 1u) + 1; ++rep_) { const int dry_ = rep_ < (int)((REP >> 22) & 1u); (void)dry_;
    phase_m_comb(wv, getargs(), lds, dry_);
    }
#endif
    GSYNC();
#if !(DIS & (1u << 17))
    for (int rep_ = 0; rep_ < ((REP >> 17) & 1u) + 1; ++rep_) { const int dry_ = rep_ < (int)((REP >> 17) & 1u); (void)dry_;
    phase_m_out(wv, getargs(), lds, dry_);
    }
#endif
    GSYNC();
#if !(DIS & (1u << 18))
    for (int rep_ = 0; rep_ < ((REP >> 18) & 1u) + 1; ++rep_) { const int dry_ = rep_ < (int)((REP >> 18) & 1u); (void)dry_;
    { EpiRes<true> E{nullptr, XBP, RSS + 3 * S, dry_};
      pg8::gemm_phase<false>(wv, lds, (const bf16_t*)(WSB + O_QOK) + 512, 2048, (const bf16_t*)(WSB + O_WO2T), 1024, 1024, 64, 4, E); }
    }
#endif
    GSYNC();
#if !(DIS & (1u << 19))
    for (int rep_ = 0; rep_ < ((REP >> 19) & 1u) + 1; ++rep_) { const int dry_ = rep_ < (int)((REP >> 19) & 1u); (void)dry_;
    { EpiUp E{(bf16_t*)(WSB + O_ACT), RSS + 3 * S, getargs().in(24) + 3 * 5632, getargs().in(25) + 5632, lds + 131072};
      pg8::gemm_phase<true>(wv, lds, XBP, 1024, (const bf16_t*)(WSB + O_WUPT1), 1024, 1024, 67, 22, E); }
    }
#endif
    GSYNC();
#if !(DIS & (1u << 20))
    for (int rep_ = 0; rep_ < ((REP >> 20) & 1u) + 1; ++rep_) { const int dry_ = rep_ < (int)((REP >> 20) & 1u); (void)dry_;
    { EpiRes<true> E{nullptr, XBP, RSS + 4 * S, dry_};
      pg8::gemm_phase<false>(wv, lds, (const bf16_t*)(WSB + O_ACT), 2816, (const bf16_t*)(WSB + O_WDNT1), 2816, 2816, 64, 4, E); }
    }
#endif
    GSYNC();
#if !(DIS & (1u << 21))
    for (int rep_ = 0; rep_ < ((REP >> 21) & 1u) + 1; ++rep_) { const int dry_ = rep_ < (int)((REP >> 21) & 1u); (void)dry_;
    phase_final(wv, getargs());
    }
#endif
    for (int i = 0; i < XSYNC; ++i) GSYNC();
}

extern "C" void kernel_launch(void* const* d_in, const int* in_sizes, int n_in, void* d_out, int out_size, void* d_ws, size_t ws_size, hipStream_t stream) {
    static int grid = 0;
    if (grid == 0) {
        if (n_in != 28 || out_size != S * 1024 || ws_size < WS_NEED) { fprintf(stderr, "kernel_launch: unexpected shapes (n_in %d out %d ws %zu need %zu)\n", n_in, out_size, ws_size, (size_t)WS_NEED); grid = -1; return; }
        int dev = 0, cus = 0, per_cu = 0;
        (void)hipGetDevice(&dev);
        (void)hipDeviceGetAttribute(&cus, hipDeviceAttributeMultiprocessorCount, dev);
        if (hipFuncSetAttribute((const void*)fwd_kernel, hipFuncAttributeMaxDynamicSharedMemorySize, LDS_BYTES) != hipSuccess) { fprintf(stderr, "kernel_launch: hipFuncSetAttribute failed\n"); grid = -1; return; }
        if (hipOccupancyMaxActiveBlocksPerMultiprocessor(&per_cu, (const void*)fwd_kernel, 512, LDS_BYTES) != hipSuccess || per_cu < 1) { fprintf(stderr, "kernel_launch: occupancy query says %d\n", per_cu); per_cu = 1; }
        (void)hipGetLastError();
        grid = cus * 1;
        if (grid > 256) grid = 256;
    }
    if (grid < 0) return;
    Args a{};
    for (int i = 0; i < 28; ++i) a.in[i] = (const float*)d_in[i];
    a.out = (float*)d_out; a.ws = (unsigned char*)d_ws;
    if (hipMemsetAsync((char*)d_ws + O_BAR, 0, BAR_BYTES, stream) != hipSuccess) { fprintf(stderr, "kernel_launch: memset failed\n"); return; }
    void* args[] = {&a};
    hipError_t e = hipLaunchCooperativeKernel((void*)fwd_kernel, dim3(grid), dim3(512), args, LDS_BYTES, stream);
    if (e != hipSuccess) fprintf(stderr, "kernel_launch: cooperative launch failed: %s (grid %d)\n", hipGetErrorString(e), grid);
}
```

```cpp
#include <hip/hip_runtime.h>
#include <hip/hip_cooperative_groups.h>
#include <cstdio>
#include <cstdint>
namespace cg = cooperative_groups;

typedef unsigned short bf16_t;
typedef short bf16x8 __attribute__((ext_vector_type(8)));
typedef short s16x4 __attribute__((ext_vector_type(4)));
typedef float f32x2 __attribute__((ext_vector_type(2)));
typedef float f32x4 __attribute__((ext_vector_type(4)));
typedef float f32x16 __attribute__((ext_vector_type(16)));
typedef unsigned u32x2 __attribute__((ext_vector_type(2)));
typedef unsigned u32x4 __attribute__((ext_vector_type(4)));
typedef __bf16 bf16x2_t __attribute__((ext_vector_type(2)));
#define LAS __attribute__((address_space(3)))
#define DI __device__ __forceinline__

constexpr int S = 16384;
constexpr float EPS = 1e-6f;
constexpr float LOG2E = 1.4426950408889634f;

constexpr size_t SZ_WUPT = (size_t)5632 * 1024 * 2, SZ_WDNT = (size_t)1024 * 2816 * 2;
constexpr size_t O_WUPT1 = 0;
constexpr size_t O_WDNT1 = O_WUPT1 + SZ_WUPT;
constexpr size_t O_WOINT = O_WDNT1 + SZ_WDNT;
constexpr size_t O_WO2T = O_WOINT + (size_t)3072 * 1024 * 2;
constexpr size_t O_ROWSS = O_WO2T + (size_t)1024 * 1024 * 2;
constexpr size_t O_RSQ = O_ROWSS + (size_t)5 * S * 8;
constexpr size_t O_RSKV = O_RSQ + (size_t)S * 4;
constexpr size_t O_CSTAB = O_RSKV + (size_t)S * 4;
constexpr size_t O_CHA = O_CSTAB + (size_t)S * 32 * 4;
constexpr size_t O_CHH = O_CHA + (size_t)256 * 512 * 4;
constexpr size_t O_GB = O_CHH + (size_t)256 * 512 * 4;
constexpr size_t O_GE = O_GB + (size_t)4 * S * 4;
constexpr size_t O_GPM = O_GE + (size_t)4 * S * 4;
constexpr size_t O_BL = O_GPM + (size_t)4 * S * 4;
constexpr size_t O_ML = O_BL + 4096;
constexpr size_t O_MST = O_ML + 4096;
constexpr size_t O_NST = O_MST + 4096;
constexpr size_t O_BAR = O_NST + (size_t)256 * 4 * 128 * 4;
constexpr size_t BAR_BYTES = 16384;
constexpr size_t O_XB = O_BAR + BAR_BYTES;
constexpr size_t XB_ROWS = 16648;
constexpr size_t O_L0W = O_XB + XB_ROWS * 2048;
constexpr size_t O_W1T = O_L0W;
constexpr size_t O_WQT = O_W1T + (size_t)1536 * 1024 * 2;
constexpr size_t O_WKT = O_WQT + (size_t)768 * 256 * 2;
constexpr size_t O_WVT = O_WKT + (size_t)512 * 256 * 2;
constexpr size_t O_WRIT = O_WVT + (size_t)512 * 256 * 2;
constexpr size_t O_WO1T = O_WRIT + (size_t)1024 * 512 * 2;
constexpr size_t O_WUPT0 = O_WO1T + (size_t)1024 * 1024 * 2;
constexpr size_t O_WDNT0 = O_WUPT0 + SZ_WUPT;
constexpr size_t O_ARENA = O_WDNT0 + SZ_WDNT;
constexpr size_t O_Z = O_ARENA;
constexpr size_t O_XC = O_Z + (size_t)S * 1536 * 2;
constexpr size_t O_QB = O_XC + (size_t)S * 512 * 2;
constexpr size_t O_KB = O_QB + (size_t)8 * S * 96 * 2;
constexpr size_t O_VT = O_KB + (size_t)8 * S * 96 * 2;
constexpr size_t O_MIX = O_VT + (size_t)512 * S * 2;
constexpr size_t O_END0 = O_MIX + (size_t)S * 1024 * 2;
constexpr size_t O_ACT = O_ARENA;
constexpr size_t O_RI = O_XB;
constexpr size_t O_CST = O_L0W;
constexpr size_t O_QOK = O_CST + (size_t)256 * 4 * 256 * 128 * 2;
constexpr size_t O_KVT = O_QOK + (size_t)S * 2048 * 2;
constexpr size_t O_END1 = O_KVT + (size_t)1536 * S * 2;
constexpr size_t WS_NEED = (O_END0 > O_END1 ? O_END0 : O_END1);
static_assert(WS_NEED <= (size_t)268435456, "workspace");
static_assert(O_ACT + (size_t)(S + 240) * 2816 * 2 <= (size_t)268435456, "act");

constexpr int LDS_BYTES = 147456;

struct Args {
    const float* in[28];
    float* out;
    unsigned char* ws;
    int pad; int pad2;
};

struct ArgP { const __attribute__((address_space(4))) Args* p;
    DI const float* in(int i) const { return p->in[i]; } DI float* out() const { return p->out; } DI unsigned char* ws() const { return p->ws; } };
DI unsigned pk2(float lo, float hi) { f32x2 v = {lo, hi}; bf16x2_t b = __builtin_convertvector(v, bf16x2_t); return __builtin_bit_cast(unsigned, b); }
DI bf16_t f2bf(float f) { return (bf16_t)(pk2(f, 0.f) & 0xffffu); }
DI int ltid(int wv) { asm volatile("" : "+s"(wv)); int l = __builtin_amdgcn_mbcnt_hi(~0u, __builtin_amdgcn_mbcnt_lo(~0u, 0u)); asm volatile("" : "+v"(l)); return wv * 64 + l; }
DI int lbid() { int t = blockIdx.x; asm volatile("" : "+s"(t)); return t; }
DI float bf2f(bf16_t b) { return __uint_as_float(((unsigned)b) << 16); }
DI float bflo(unsigned u) { return __uint_as_float(u << 16); }
DI float bfhi(unsigned u) { return __uint_as_float(u & 0xffff0000u); }
DI float wave_sum(float v) {
#pragma unroll
    for (int o = 1; o < 64; o <<= 1) v += __shfl_xor(v, o);
    return v;
}
DI float fexp(float x) { return __builtin_amdgcn_exp2f(x * LOG2E); }
DI float sigmoidf_(float x) { return __builtin_amdgcn_rcpf(1.f + fexp(-x)); }
DI int crow(int r, int hi) { return (r & 3) + 8 * (r >> 2) + 4 * hi; }
typedef unsigned long long u64;
DI float rs_from_ss(u64 ssq) { return rsqrtf((float)ssq * (1.f / (1048576.f * 1024.f)) + EPS); }
DI u64 ss_to_fix(float ss) { return (u64)(ss * 1048576.f); }

namespace pg8 {
constexpr int BM = 256, BK = 64, HALF = 128, HTB = HALF * BK * 2, STAGE_BYTES = 8 * HTB, NXCD = 8, WGM = 8;
DI int lds_byte(int r, int c) { const int st = (r >> 4) * 2 + (c >> 5), rr = r & 15, cc = c & 31, ob = rr * 64 + cc * 2; return st * 1024 + (ob ^ (((ob >> 9) & 1) << 5)); }
DI void stage_rc(int b, int& R, int& C) { const int st = b / 1024, sb = b % 1024, swz = sb ^ (((sb >> 9) & 1) << 5); R = (st >> 1) * 16 + swz / 64; C = (st & 1) * 32 + (swz % 64) / 2; }
DI int perm32(int rho) { const int n = rho >> 4, i = rho & 15; return 8 * (i >> 2) + 4 * n + (i & 3); }
struct Unit { int pm, pn; };
struct StaticOrder {
    int nM, nN, nwg, G, c;
    DI void init(int nM_, int nN_, int G_, int c_) { nM = nM_; nN = nN_; nwg = nM * nN; G = G_; c = c_; }
    DI bool next(int i, Unit& u) const {
        const long L = (long)i * G + c; if (L >= nwg) return false;
        int wgid = (int)L; { const int q = nwg / NXCD, r = nwg % NXCD, xcd = wgid % NXCD, off = wgid / NXCD; wgid = (xcd < r ? xcd * (q + 1) : r * (q + 1) + (xcd - r) * q) + off; }
        const int nig = WGM * nN, gid = wgid / nig, fm = gid * WGM, gsz = (nM - fm) < WGM ? (nM - fm) : WGM;
        u.pm = fm + ((wgid % nig) % gsz); u.pn = (wgid % nig) / gsz; return true;
    }
};

template <bool AMAP, class Epi>
DI void gemm_phase(int wv, LAS unsigned char* lds, const bf16_t* A, int lda, const bf16_t* Bt, int ldb, int K_, int nM, int nN, const Epi& E, int rot = 0) {
    int K = K_; asm volatile("" : "+s"(K));
    const int tid = ltid(wv), wid = __builtin_amdgcn_readfirstlane(tid >> 6), lane = tid & 63, wr = wid >> 2, wc = wid & 3, fr = lane & 15, fq = lane >> 4;
    const int nt = K / BK;
    StaticOrder SO; { int c_ = lbid() - rot; if (c_ < 0) c_ += (int)gridDim.x; SO.init(nM, nN, (int)gridDim.x, c_); }
    unsigned voffA[2], voffB[2];
#pragma unroll
    for (int i = 0; i < 2; ++i) { int R, C; stage_rc(tid * 16 + i * 8192, R, C); const int Rb = (R & ~31) + perm32(R & 31);
        const int Ra = AMAP ? (62 * (R >> 6) + (R & 63) - 2) : R;
        voffA[i] = (unsigned)((Ra + (AMAP ? 2 : 0)) * lda + C) * 2u; voffB[i] = (unsigned)(Rb * ldb + C) * 2u; }
    const size_t kstep = (size_t)(BK * 2);
    const size_t hstepA = (size_t)(AMAP ? 124 : 128) * lda * 2, hstepB = (size_t)HALF * ldb * 2;
    const size_t tstepA = 2 * hstepA, tstepB = 2 * hstepB;
    const unsigned ldsw = (unsigned)wid * 1024u;
    const int aoff = lds_byte(wr * 64 + fr, fq * 8), boff = lds_byte(wc * 32 + fr, fq * 8);
#define PG8_SA(b, h) (((b) * 2 + (h)) * HTB)
#define PG8_SB(b, h) ((4 + (b) * 2 + (h)) * HTB)
#define PG8_STAGE(bufoff, gbase, voff) do { _Pragma("unroll") for (int _i = 0; _i < 2; ++_i) \
        __builtin_amdgcn_global_load_lds((const unsigned*)((const char*)(gbase) + (voff)[_i]), (LAS unsigned*)(lds + (bufoff) + ldsw + _i * 8192), 16, 0, 0); } while (0)
#define PG8_LDA(dst, b, h) do { _Pragma("unroll") for (int m = 0; m < 4; ++m) _Pragma("unroll") for (int k = 0; k < 2; ++k) dst[m][k] = *(const LAS bf16x8*)(lds + PG8_SA(b, h) + aoff + m * 2048 + k * 1024); } while (0)
#define PG8_LDB(dst, b, h) do { _Pragma("unroll") for (int n = 0; n < 2; ++n) _Pragma("unroll") for (int k = 0; k < 2; ++k) dst[n][k] = *(const LAS bf16x8*)(lds + PG8_SB(b, h) + boff + n * 2048 + k * 1024); } while (0)
#define PG8_MMA(ai, bj, At, Bt_) do { __builtin_amdgcn_s_setprio(1); _Pragma("unroll") for (int m = 0; m < 4; ++m) _Pragma("unroll") for (int n = 0; n < 2; ++n) _Pragma("unroll") for (int k = 0; k < 2; ++k) \
        acc[ai][bj][m][n] = __builtin_amdgcn_mfma_f32_16x16x32_bf16(Bt_[n][k], At[m][k], acc[ai][bj][m][n], 0, 0, 0); __builtin_amdgcn_s_setprio(0); } while (0)
#define PG8_WAIT_V(n) asm volatile("s_waitcnt vmcnt(" #n ")" ::: "memory")
#define PG8_WAIT_L(n) asm volatile("s_waitcnt lgkmcnt(" #n ")" ::: "memory")
#define PG8_BAR __builtin_amdgcn_s_barrier()
#define PG8_SCHED __builtin_amdgcn_sched_barrier(0)
    if (AMAP) A -= 2 * lda;
    Unit cur, nxt; int ui = 0;
    if (!SO.next(0, cur)) return;
    f32x4 acc[2][2][4][2];
#pragma unroll
    for (int a = 0; a < 2; ++a)
#pragma unroll
        for (int b = 0; b < 2; ++b)
#pragma unroll
            for (int m = 0; m < 4; ++m)
#pragma unroll
                for (int n = 0; n < 2; ++n) acc[a][b][m][n] = (f32x4){0.f, 0.f, 0.f, 0.f};
    bf16x8 At[4][2], B0[2][2], B1[2][2];
    const char* cA = (const char*)A + (size_t)cur.pm * tstepA; const char* cB = (const char*)Bt + (size_t)cur.pn * tstepB;
    PG8_STAGE(PG8_SB(0, 0), cB, voffB); PG8_STAGE(PG8_SB(0, 1), cB + hstepB, voffB); PG8_STAGE(PG8_SA(0, 0), cA, voffA); PG8_STAGE(PG8_SA(0, 1), cA + hstepA, voffA);
    if (wr == 1) PG8_BAR;
    PG8_WAIT_V(2); PG8_BAR;
    PG8_STAGE(PG8_SB(1, 0), cB + kstep, voffB); PG8_STAGE(PG8_SA(1, 0), cA + kstep, voffA); PG8_STAGE(PG8_SB(1, 1), cB + hstepB + kstep, voffB);
    PG8_WAIT_V(6); PG8_BAR;
    for (;;) {
        const bool has_next = SO.next(ui + 1, nxt);
        const char* nA = has_next ? (const char*)A + (size_t)nxt.pm * tstepA : cA; const char* nB = has_next ? (const char*)Bt + (size_t)nxt.pn * tstepB : cB;
        for (int t = 0; t < nt; t += 2) {
            const bool last = (t == nt - 2);
            const char* a1 = cA + (size_t)(t + 1) * kstep;
            const char* a2 = last ? nA : cA + (size_t)(t + 2) * kstep; const char* b2 = last ? nB : cB + (size_t)(t + 2) * kstep;
            const char* a3 = a2 + kstep; const char* b3 = b2 + kstep;
            PG8_LDB(B0, 0, 0); PG8_LDB(B1, 0, 1); PG8_SCHED; PG8_LDA(At, 0, 0); PG8_STAGE(PG8_SA(1, 1), a1 + hstepA, voffA);
            PG8_WAIT_V(8); PG8_WAIT_L(0); PG8_BAR; PG8_MMA(0, 0, At, B0); PG8_MMA(0, 1, At, B1); PG8_BAR; PG8_SCHED;
            PG8_LDA(At, 0, 1); PG8_STAGE(PG8_SB(0, 0), b2, voffB); PG8_STAGE(PG8_SB(0, 1), b2 + hstepB, voffB); PG8_STAGE(PG8_SA(0, 0), a2, voffA);
            PG8_WAIT_V(8); PG8_WAIT_L(0); PG8_BAR; PG8_MMA(1, 0, At, B0); PG8_MMA(1, 1, At, B1); PG8_BAR; PG8_SCHED;
            PG8_LDB(B0, 1, 0); PG8_LDB(B1, 1, 1); PG8_SCHED; PG8_LDA(At, 1, 0); PG8_STAGE(PG8_SA(0, 1), a2 + hstepA, voffA);
            PG8_WAIT_V(8); PG8_WAIT_L(0); PG8_BAR; PG8_MMA(0, 0, At, B0); PG8_MMA(0, 1, At, B1); PG8_BAR; PG8_SCHED;
            PG8_LDA(At, 1, 1); PG8_STAGE(PG8_SB(1, 0), b3, voffB); PG8_STAGE(PG8_SB(1, 1), b3 + hstepB, voffB); PG8_STAGE(PG8_SA(1, 0), a3, voffA);
            PG8_WAIT_V(8); PG8_WAIT_L(0); PG8_BAR; PG8_MMA(1, 0, At, B0); PG8_MMA(1, 1, At, B1); PG8_BAR; PG8_SCHED;
        }
        if (wr == 0) PG8_BAR;
        E(acc, cur, wr, wc, fr, fq);
        if (!has_next) break;
#pragma unroll
        for (int a = 0; a < 2; ++a)
#pragma unroll
            for (int b = 0; b < 2; ++b)
#pragma unroll
                for (int m = 0; m < 4; ++m)
#pragma unroll
                    for (int n = 0; n < 2; ++n) acc[a][b][m][n] = (f32x4){0.f, 0.f, 0.f, 0.f};
        cur = nxt; cA = nA; cB = nB; ++ui;
        if (wr == 1) PG8_BAR;
    }
    PG8_WAIT_V(0);
    PG8_BAR;
#undef PG8_SA
#undef PG8_SB
#undef PG8_STAGE
#undef PG8_LDA
#undef PG8_LDB
#undef PG8_MMA
#undef PG8_WAIT_V
#undef PG8_WAIT_L
#undef PG8_BAR
#undef PG8_SCHED
}
}
using pg8::Unit;
typedef f32x4 AccT[2][2][4][2];

template <int SMODE> struct EpiRowBf16 {
    bf16_t* O; int ldc; const void* sc;
    DI void operator()(const AccT& acc, const Unit& u, int wr, int wc, int fr, int fq) const {
        const int row0 = u.pm * 256 + wr * 64 + fr, col0 = u.pn * 256 + wc * 32 + 8 * fq;
#pragma unroll
        for (int ai = 0; ai < 2; ++ai)
#pragma unroll
            for (int m = 0; m < 4; ++m) { const int row = row0 + ai * 128 + m * 16;
                float s = 1.f; if (SMODE == 1) s = rs_from_ss(((const u64*)sc)[row]); if (SMODE == 2) s = ((const float*)sc)[row];
                bf16_t* rowp = O + (size_t)row * ldc + col0;
#pragma unroll
                for (int bj = 0; bj < 2; ++bj) { const f32x4 v0 = acc[ai][bj][m][0] * s, v1 = acc[ai][bj][m][1] * s;
                    u32x4 w; w.x = pk2(v0[0], v0[1]); w.y = pk2(v0[2], v0[3]); w.z = pk2(v1[0], v1[1]); w.w = pk2(v1[2], v1[3]);
                    *(u32x4*)(rowp + bj * 128) = w; } }
    }
};
template <int SMODE> struct EpiColBf16 {
    bf16_t* O; int ldc; const void* sc;
    DI void operator()(const AccT& acc, const Unit& u, int wr, int wc, int fr, int fq) const {
        const int row0 = u.pm * 256 + wr * 64 + fr, col0 = u.pn * 256 + wc * 32 + 8 * fq;
#pragma unroll
        for (int bj = 0; bj < 2; ++bj) { float s[8];
#pragma unroll
            for (int j = 0; j < 8; ++j) s[j] = (SMODE == 1) ? rs_from_ss(((const u64*)sc)[col0 + bj * 128 + j]) : ((const float*)sc)[col0 + bj * 128 + j];
#pragma unroll
            for (int ai = 0; ai < 2; ++ai)
#pragma unroll
                for (int m = 0; m < 4; ++m) { const int row = row0 + ai * 128 + m * 16; const f32x4 v0 = acc[ai][bj][m][0], v1 = acc[ai][bj][m][1];
                    u32x4 w; w.x = pk2(v0[0] * s[0], v0[1] * s[1]); w.y = pk2(v0[2] * s[2], v0[3] * s[3]); w.z = pk2(v1[0] * s[4], v1[1] * s[5]); w.w = pk2(v1[2] * s[6], v1[3] * s[7]);
                    *(u32x4*)(O + (size_t)row * ldc + col0 + bj * 128) = w; } }
    }
};
struct EpiQ {
    bf16_t* QB; const float* rsq; const float* cstab;
    DI void operator()(const AccT& acc, const Unit& u, int wr, int wc, int fr, int fq) const {
        const int row0 = u.pm * 256 + wr * 64 + fr, col0 = u.pn * 256 + wc * 32 + 8 * fq;
        const float QS = 0.10206207261596577f * LOG2E;
#pragma unroll
        for (int ai = 0; ai < 2; ++ai)
#pragma unroll
            for (int m = 0; m < 4; ++m) { const int t = row0 + ai * 128 + m * 16; const float s = rsq[t] * QS;
#pragma unroll
                for (int bj = 0; bj < 2; ++bj) { const int c = col0 + bj * 128, h = c / 96, d = c - h * 96;
                    f32x4 v0 = acc[ai][bj][m][0] * s, v1 = acc[ai][bj][m][1] * s;
                    if (d >= 64) { const int i0 = (d - 64) >> 1; const f32x4 cs0 = *(const f32x4*)(cstab + (size_t)t * 32 + 2 * i0), cs1 = *(const f32x4*)(cstab + (size_t)t * 32 + 2 * i0 + 4);
                        f32x4 a, b;
                        a[0] = v0[0] * cs0[0] - v0[1] * cs0[1]; a[1] = v0[1] * cs0[0] + v0[0] * cs0[1];
                        a[2] = v0[2] * cs0[2] - v0[3] * cs0[3]; a[3] = v0[3] * cs0[2] + v0[2] * cs0[3];
                        b[0] = v1[0] * cs1[0] - v1[1] * cs1[1]; b[1] = v1[1] * cs1[0] + v1[0] * cs1[1];
                        b[2] = v1[2] * cs1[2] - v1[3] * cs1[3]; b[3] = v1[3] * cs1[2] + v1[2] * cs1[3];
                        v0 = a; v1 = b; }
                    u32x4 w; w.x = pk2(v0[0], v0[1]); w.y = pk2(v0[2], v0[3]); w.z = pk2(v1[0], v1[1]); w.w = pk2(v1[2], v1[3]);
                    *(u32x4*)(QB + ((size_t)h * S + t) * 96 + d) = w; } }
    }
};
struct EpiK {
    bf16_t* KB; const float* rskv;
    DI void operator()(const AccT& acc, const Unit& u, int wr, int wc, int fr, int fq) const {
        const int row0 = u.pm * 256 + wr * 64 + fr, col0 = u.pn * 256 + wc * 32 + 8 * fq;
#pragma unroll
        for (int ai = 0; ai < 2; ++ai)
#pragma unroll
            for (int m = 0; m < 4; ++m) { const int t = row0 + ai * 128 + m * 16; const float s = rskv[t];
#pragma unroll
                for (int bj = 0; bj < 2; ++bj) { const int c = col0 + bj * 128, h = c >> 6, d = c & 63;
                    const f32x4 v0 = acc[ai][bj][m][0] * s, v1 = acc[ai][bj][m][1] * s;
                    u32x4 w; w.x = pk2(v0[0], v0[1]); w.y = pk2(v0[2], v0[3]); w.z = pk2(v1[0], v1[1]); w.w = pk2(v1[2], v1[3]);
                    *(u32x4*)(KB + ((size_t)h * S + t) * 96 + d) = w; } }
    }
};
template <bool RESBF> struct EpiRes {
    const float* res; bf16_t* XB; u64* rowss; int dry;
    DI void operator()(const AccT& acc, const Unit& u, int wr, int wc, int fr, int fq) const {
        const int row0 = u.pm * 256 + wr * 64 + fr, col0 = u.pn * 256 + wc * 32 + 8 * fq;
#pragma unroll
        for (int ai = 0; ai < 2; ++ai)
#pragma unroll
            for (int m = 0; m < 4; ++m) { const int t = row0 + ai * 128 + m * 16; float ss = 0.f;
#pragma unroll
                for (int bj = 0; bj < 2; ++bj) { const size_t o = (size_t)t * 1024 + col0 + bj * 128;
                    f32x4 r0, r1;
                    if (RESBF) { const u32x4 rb = *(const u32x4*)(XB + o); r0 = (f32x4){bflo(rb.x), bfhi(rb.x), bflo(rb.y), bfhi(rb.y)}; r1 = (f32x4){bflo(rb.z), bfhi(rb.z), bflo(rb.w), bfhi(rb.w)}; }
                    else { r0 = *(const f32x4*)(res + o); r1 = *(const f32x4*)(res + o + 4); }
                    const f32x4 v0 = acc[ai][bj][m][0] + r0, v1 = acc[ai][bj][m][1] + r1;
                    u32x4 w; w.x = pk2(v0[0], v0[1]); w.y = pk2(v0[2], v0[3]); w.z = pk2(v1[0], v1[1]); w.w = pk2(v1[2], v1[3]);
                    if (!dry) *(u32x4*)(XB + o) = w;
                    ss += v0[0] * v0[0] + v0[1] * v0[1] + v0[2] * v0[2] + v0[3] * v0[3] + v1[0] * v1[0] + v1[1] * v1[1] + v1[2] * v1[2] + v1[3] * v1[3]; }
                ss += __shfl_xor(ss, 16); ss += __shfl_xor(ss, 32);
                if (fq == 0 && !dry) atomicAdd(rowss + t, ss_to_fix(ss)); }
    }
};
DI float dpp_prev1(float cur, float prevm) {
    const int o = __builtin_amdgcn_update_dpp(0, __builtin_bit_cast(int, prevm), 0x121, 0xf, 0xf, false);
    return __builtin_bit_cast(float, __builtin_amdgcn_update_dpp(o, __builtin_bit_cast(int, cur), 0x111, 0xf, 0xf, false));
}
DI float dpp_prev2(float cur, float prevm) {
    const int o = __builtin_amdgcn_update_dpp(0, __builtin_bit_cast(int, prevm), 0x122, 0xf, 0xf, false);
    return __builtin_bit_cast(float, __builtin_amdgcn_update_dpp(o, __builtin_bit_cast(int, cur), 0x112, 0xf, 0xf, false));
}
struct EpiUp {
    bf16_t* ACT; const u64* rowss; const float* cw; const float* cb; LAS unsigned char* plds;
    DI void operator()(const AccT& acc, const Unit& u, int wr, int wc, int fr, int fq) const {
        const int cl = u.pn * 128 + wc * 32 + 8 * fq;
        LAS float* P = (LAS float*)(plds + (wr * 4 + wc) * 1024);
        { const int lane = fq * 16 + fr, kind = lane >> 3, c4 = 4 * (lane & 7), k3 = kind & 3;
          const float* src = (k3 == 0 ? cb : cw + (k3 - 1) * 5632) + (kind >= 4 ? 2816 : 0) + u.pn * 128 + wc * 32 + c4;
          *(LAS f32x4*)(P + kind * 32 + c4) = *(const f32x4*)src; }
#pragma unroll
        for (int ai = 0; ai < 2; ++ai) {
            const int tok0 = u.pm * 248 + 62 * (2 * ai + wr) - 2 + fr;
            float rs[4];
#pragma unroll
            for (int m = 0; m < 4; ++m) { const int t = tok0 + 16 * m; const int tc = t < 0 ? 0 : (t >= S ? S - 1 : t); const float r = rs_from_ss(rowss[tc]); rs[m] = t < 0 ? 0.f : r; }
            const int row0 = fr < 2 ? (S + 236 + fr) : tok0;
#pragma unroll
            for (int n = 0; n < 2; ++n) {
                const int lc = 8 * fq + 4 * n;
                unsigned wpk[4][2];
#pragma unroll
                for (int jp = 0; jp < 2; ++jp) {
                    const f32x2 bg = *(const LAS f32x2*)(P + lc + 2 * jp), g0 = *(const LAS f32x2*)(P + 32 + lc + 2 * jp), g1 = *(const LAS f32x2*)(P + 64 + lc + 2 * jp), g2 = *(const LAS f32x2*)(P + 96 + lc + 2 * jp);
                    const f32x2 bv = *(const LAS f32x2*)(P + 128 + lc + 2 * jp), v0 = *(const LAS f32x2*)(P + 160 + lc + 2 * jp), v1 = *(const LAS f32x2*)(P + 192 + lc + 2 * jp), v2 = *(const LAS f32x2*)(P + 224 + lc + 2 * jp);
                    f32x2 G[4], V[4];
#pragma unroll
                    for (int m = 0; m < 4; ++m) { G[m] = (f32x2){acc[ai][0][m][n][2 * jp], acc[ai][0][m][n][2 * jp + 1]} * rs[m]; V[m] = (f32x2){acc[ai][1][m][n][2 * jp], acc[ai][1][m][n][2 * jp + 1]} * rs[m]; }
#pragma unroll
                    for (int m = 0; m < 4; ++m) {
                        const f32x2 zz = {0.f, 0.f}; const f32x2 Gp = m ? G[m - 1] : zz, Vp = m ? V[m - 1] : zz;
                        const f32x2 gp1 = {dpp_prev1(G[m].x, Gp.x), dpp_prev1(G[m].y, Gp.y)}, gp2 = {dpp_prev2(G[m].x, Gp.x), dpp_prev2(G[m].y, Gp.y)};
                        const f32x2 vp1 = {dpp_prev1(V[m].x, Vp.x), dpp_prev1(V[m].y, Vp.y)}, vp2 = {dpp_prev2(V[m].x, Vp.x), dpp_prev2(V[m].y, Vp.y)};
                        const f32x2 gc = bg + g0 * gp2 + g1 * gp1 + g2 * G[m];
                        const f32x2 vc = bv + v0 * vp2 + v1 * vp1 + v2 * V[m];
                        const f32x2 xe = gc * (-LOG2E);
                        f32x2 dn = {__builtin_amdgcn_exp2f(xe.x), __builtin_amdgcn_exp2f(xe.y)}; dn = dn + 1.0f;
                        const f32x2 rc = {__builtin_amdgcn_rcpf(dn.x), __builtin_amdgcn_rcpf(dn.y)};
                        const f32x2 rr = gc * rc * vc;
                        wpk[m][jp] = pk2(rr.x, rr.y); }
                }
#pragma unroll
                for (int m = 0; m < 4; ++m) { const int row = m ? tok0 + 16 * m : row0;
                    *(u32x2*)(ACT + (size_t)row * 2816 + cl + 4 * n) = (u32x2){wpk[m][0], wpk[m][1]}; }
                __builtin_amdgcn_sched_barrier(0);
            }
        }
    }
};

template <class F> DI void tr_items(const F& f, int Kdst, int Nrows, bf16_t* WT, LAS float* scr, int gw, int NGW, int lane, int& cum) {
    const int nblk = Nrows / 32, nitems = (Kdst / 64) * nblk;
    int first = (gw - cum) % NGW; if (first < 0) first += NGW; cum = (cum + nitems) % NGW;
    for (int item = first; item < nitems; item += NGW) {
        const int kb = item / nblk, nb = item % nblk, k0 = 64 * kb, n0 = 32 * nb;
        float tv[32];
#pragma unroll
        for (int i = 0; i < 32; ++i) tv[i] = f(k0 + 2 * i + (lane >> 5), n0 + (lane & 31));
#pragma unroll
        for (int i = 0; i < 32; ++i) scr[(2 * i + (lane >> 5)) * 33 + (lane & 31)] = tv[i];
        asm volatile("s_waitcnt lgkmcnt(0)" ::: "memory");
        const int c = lane & 7;
#pragma unroll
        for (int j = 0; j < 4; ++j) { const int n = (lane >> 3) + 8 * j; const LAS float* s = scr + (8 * c) * 33 + n;
            u32x4 o; o.x = pk2(s[0 * 33], s[1 * 33]); o.y = pk2(s[2 * 33], s[3 * 33]); o.z = pk2(s[4 * 33], s[5 * 33]); o.w = pk2(s[6 * 33], s[7 * 33]);
            *(u32x4*)(WT + (size_t)(n0 + n) * Kdst + k0 + 8 * c) = o; }
        asm volatile("s_waitcnt lgkmcnt(0)" ::: "memory");
    }
}
struct FW1 { const float* W; const float* g; DI float operator()(int k, int n) const { return n < 1440 ? W[(size_t)k * 1440 + n] * g[k] : 0.f; } };
struct FWQ { const float* W; const float* g; DI float operator()(int k, int n) const { const int h = n / 96, d = n - h * 96; int c = d; if (d >= 64) { const int r = d - 64; c = 64 + (r >> 1) + 16 * (r & 1); } return W[(size_t)k * 768 + h * 96 + c] * g[k]; } };
struct FWKV { const float* W; const float* g; int off; DI float operator()(int k, int n) const { return k < 128 ? W[(size_t)k * 1024 + (n >> 6) * 128 + off + (n & 63)] * g[k] : 0.f; } };
struct FWRI { const float* Wa; const float* Wx; DI float operator()(int k, int n) const { const float* W = n < 512 ? Wa : Wx; const int ch = n & 511, g = ch >> 6, j = ch & 63; return (k >> 6) == g ? W[(size_t)k * 64 + j] : 0.f; } };
struct FWP { const float* W; int N; DI float operator()(int k, int n) const { return W[(size_t)k * N + n]; } };
struct FWUP { const float* W; const float* g; DI float operator()(int k, int n) const { const int pn = n >> 8, r = n & 255; const int c = r < 128 ? 128 * pn + r : 2816 + 128 * pn + r - 128; return W[(size_t)k * 5632 + c] * g[k]; } };
struct FWOIN { const float* W; const float* g; DI float operator()(int k, int n) const {
    int c; float s = 1.f; if (n < 512) { c = n; s = 0.08838834764831845f; } else if (n < 1536) c = 2048 + (n - 512); else if (n < 2048) c = 512 + (n - 1536); else c = 1024 + (n - 2048);
    return W[(size_t)k * 3080 + c] * g[k] * s; } };

#ifndef PROPART
#define PROPART 7
#endif
DI void phase_prologue(int wv, const ArgP a, LAS unsigned char* lds, int parts) {
    unsigned char* ws = a.ws();
    const int tid = ltid(wv), wave = tid >> 6, lane = tid & 63;
    LAS float* scr = (LAS float*)(lds + wave * 8448);
    const int gw = blockIdx.x * 8 + wave, NGW = gridDim.x * 8; int cum = 0;
    if (parts & 1) {
    { FW1 f{a.in(3), a.in(2)}; tr_items(f, 1024, 1536, (bf16_t*)(ws + O_W1T), scr, gw, NGW, lane, cum); }
    { FWQ f{a.in(12), a.in(11)}; tr_items(f, 256, 768, (bf16_t*)(ws + O_WQT), scr, gw, NGW, lane, cum); }
    { FWKV f{a.in(14), a.in(13), 0}; tr_items(f, 256, 512, (bf16_t*)(ws + O_WKT), scr, gw, NGW, lane, cum); }
    { FWKV f{a.in(14), a.in(13), 64}; tr_items(f, 256, 512, (bf16_t*)(ws + O_WVT), scr, gw, NGW, lane, cum); }
    { FWRI f{a.in(6), a.in(8)}; tr_items(f, 512, 1024, (bf16_t*)(ws + O_WRIT), scr, gw, NGW, lane, cum); }
    { FWP f{a.in(15), 1024}; tr_items(f, 1024, 1024, (bf16_t*)(ws + O_WO1T), scr, gw, NGW, lane, cum); }
    for (int l = 0; l < 2; ++l) {
        { FWUP f{a.in(23) + (size_t)l * 1024 * 5632, a.in(22) + l * 1024}; tr_items(f, 1024, 5632, (bf16_t*)(ws + (l ? O_WUPT1 : O_WUPT0)), scr, gw, NGW, lane, cum); }
        { FWP f{a.in(26) + (size_t)l * 2816 * 1024, 1024}; tr_items(f, 2816, 1024, (bf16_t*)(ws + (l ? O_WDNT1 : O_WDNT0)), scr, gw, NGW, lane, cum); }
    }
    { FWOIN f{a.in(17), a.in(16)}; tr_items(f, 1024, 3072, (bf16_t*)(ws + O_WOINT), scr, gw, NGW, lane, cum); }
    { FWP f{a.in(21), 1024}; tr_items(f, 1024, 1024, (bf16_t*)(ws + O_WO2T), scr, gw, NGW, lane, cum); }
    }
    if (parts & 2) {
    const float* x = a.in(0); bf16_t* XB = (bf16_t*)(ws + O_XB) + 2 * 1024; u64* rowss = (u64*)(ws + O_ROWSS);
#pragma unroll 4
    for (int t = gw; t < S; t += NGW) {
        float ss = 0.f;
#pragma unroll
        for (int j = 0; j < 4; ++j) { const f32x4 v = *(const f32x4*)(x + (size_t)t * 1024 + j * 256 + lane * 4);
            ss += v[0] * v[0] + v[1] * v[1] + v[2] * v[2] + v[3] * v[3];
            u32x2 w; w.x = pk2(v[0], v[1]); w.y = pk2(v[2], v[3]); *(u32x2*)(XB + (size_t)t * 1024 + j * 256 + lane * 4) = w; }
        ss = wave_sum(ss);
        if (lane == 0) rowss[t] = ss_to_fix(ss);
        if (lane >= 1 && lane < 5) rowss[(size_t)lane * S + t] = 0ull;
    }
    }
    if (parts & 4) {
    const int* pos = (const int*)a.in(1); float* cst = (float*)(ws + O_CSTAB);
    for (int e = blockIdx.x * 512 + tid; e < S * 16; e += gridDim.x * 512) { const int t = e >> 4, i = e & 15;
        const float invf = __builtin_amdgcn_exp2f(-(float)i * (13.287712379549449f / 16.f)); const float ang = (float)pos[t] * invf;
        const float k = rintf(ang * 0.15915494309189535f);
        float r = fmaf(-k, 6.28318548202514648f, ang); r = fmaf(-k, -1.7484555e-7f, r);
        const float rr = r * 0.15915494309189535f;
        cst[2 * e] = __builtin_amdgcn_cosf(rr); cst[2 * e + 1] = __builtin_amdgcn_sinf(rr); }
    }
}

DI void phase_l0_prep(int wv, const ArgP a) {
    unsigned char* ws = a.ws();
    const bf16_t* Z = (const bf16_t*)(ws + O_Z); bf16_t* XC = (bf16_t*)(ws + O_XC); bf16_t* KB = (bf16_t*)(ws + O_KB);
    float* rsq = (float*)(ws + O_RSQ); float* rskv = (float*)(ws + O_RSKV); const float* cst = (const float*)(ws + O_CSTAB);
    const float* cw = a.in(4); const float* cb = a.in(5);
    const int tid = ltid(wv), wave = tid >> 6, lane = tid & 63;
#pragma unroll 2
    for (int e = blockIdx.x * 512 + tid; e < S * 64; e += gridDim.x * 512) { const int t = e >> 6, c0 = (e & 63) * 8;
        float acc[8];
#pragma unroll
        for (int j = 0; j < 8; ++j) acc[j] = cb[c0 + j];
#pragma unroll
        for (int k = 0; k < 4; ++k) { const int tt = t - 3 + k; if (tt < 0) continue;
            const u32x4 v = *(const u32x4*)(Z + (size_t)tt * 1536 + c0);
            const f32x4 w0 = *(const f32x4*)(cw + k * 512 + c0), w1 = *(const f32x4*)(cw + k * 512 + c0 + 4);
            acc[0] += w0[0] * bflo(v.x); acc[1] += w0[1] * bfhi(v.x); acc[2] += w0[2] * bflo(v.y); acc[3] += w0[3] * bfhi(v.y);
            acc[4] += w1[0] * bflo(v.z); acc[5] += w1[1] * bfhi(v.z); acc[6] += w1[2] * bflo(v.w); acc[7] += w1[3] * bfhi(v.w); }
        u32x4 o; o.x = pk2(acc[0], acc[1]); o.y = pk2(acc[2], acc[3]); o.z = pk2(acc[4], acc[5]); o.w = pk2(acc[6], acc[7]);
        *(u32x4*)(XC + (size_t)t * 512 + c0) = o; }
#pragma unroll 4
    for (int t = blockIdx.x * 8 + wave; t < S; t += gridDim.x * 8) {
        const bf16_t* zr = Z + (size_t)t * 1536;
        float sq = 0.f, skv = 0.f;
        { const u32x2 v = *(const u32x2*)(zr + 1024 + lane * 4); const float p0 = bflo(v.x), p1 = bfhi(v.x), p2 = bflo(v.y), p3 = bfhi(v.y); sq = p0 * p0 + p1 * p1 + p2 * p2 + p3 * p3; }
        { const unsigned v = *(const unsigned*)(zr + 1280 + lane * 2); const float p0 = bflo(v), p1 = bfhi(v); skv = p0 * p0 + p1 * p1; }
        sq = wave_sum(sq); skv = wave_sum(skv);
        if (lane == 0) { rsq[t] = rsqrtf(sq * (1.f / 256.f) + EPS); rskv[t] = rsqrtf(skv * (1.f / 128.f) + EPS); }
        if (lane < 16) { const float x1 = bf2f(zr[1408 + lane]), x2 = bf2f(zr[1424 + lane]); const float c = cst[(size_t)t * 32 + 2 * lane], s = cst[(size_t)t * 32 + 2 * lane + 1];
            const unsigned w = pk2(x1 * c - x2 * s, x2 * c + x1 * s);
#pragma unroll
            for (int h = 0; h < 8; ++h) *(unsigned*)(KB + ((size_t)h * S + t) * 96 + 64 + 2 * lane) = w; }
    }
}

DI void lru_coeff(float rpre, float ipre, float xc, float sp8, float& av, float& uv) {
    const float r = sigmoidf_(rpre), ig = sigmoidf_(ipre);
    const float la = -sp8 * r;
    av = fexp(la);
    uv = __builtin_amdgcn_sqrtf(fmaxf(1.f - av * av, 0.f)) * (ig * xc);
}
DI void phase_lru_s1(int wv, const ArgP a) {
    unsigned char* ws = a.ws(); const int ch = ltid(wv);
    const bf16_t* RI = (const bf16_t*)(ws + O_RI); const bf16_t* XC = (const bf16_t*)(ws + O_XC);
    float* CHA = (float*)(ws + O_CHA); float* CHH = (float*)(ws + O_CHH);
    const float ba = a.in(7)[ch], bx = a.in(9)[ch]; const float lam = a.in(10)[ch];
    const float sp8 = 8.f * log1pf(expf(-lam));
    for (int c = blockIdx.x; c < 256; c += gridDim.x) {
        float A = 1.f, H = 0.f;
#pragma unroll 8
        for (int i = 0; i < 64; ++i) { const size_t t = (size_t)c * 64 + i;
            float av, uv; lru_coeff(bf2f(RI[t * 1024 + ch]) + ba, bf2f(RI[t * 1024 + 512 + ch]) + bx, bf2f(XC[t * 512 + ch]), sp8, av, uv);
            A *= av; H = av * H + uv; }
        CHA[c * 512 + ch] = A; CHH[c * 512 + ch] = H;
    }
}
DI void phase_lru_s3(int wv, const ArgP a) {
    unsigned char* ws = a.ws(); const int ch = ltid(wv);
    const bf16_t* RI = (const bf16_t*)(ws + O_RI); const bf16_t* XC = (const bf16_t*)(ws + O_XC); const bf16_t* Z = (const bf16_t*)(ws + O_Z);
    const float* CHA = (const float*)(ws + O_CHA); const float* CHH = (const float*)(ws + O_CHH); bf16_t* MIX = (bf16_t*)(ws + O_MIX);
    const float ba = a.in(7)[ch], bx = a.in(9)[ch]; const float lam = a.in(10)[ch];
    const float sp8 = 8.f * log1pf(expf(-lam));
    for (int c = blockIdx.x; c < 256; c += gridDim.x) {
        float H = 0.f;
#pragma unroll 16
        for (int cc = 0; cc < c; ++cc) H = CHA[cc * 512 + ch] * H + CHH[cc * 512 + ch];
#pragma unroll 4
        for (int i = 0; i < 64; ++i) { const size_t t = (size_t)c * 64 + i;
            float av, uv; lru_coeff(bf2f(RI[t * 1024 + ch]) + ba, bf2f(RI[t * 1024 + 512 + ch]) + bx, bf2f(XC[t * 512 + ch]), sp8, av, uv);
            H = av * H + uv;
            const float g = bf2f(Z[t * 1536 + 512 + ch]);
            const float y = 0.7978845608028654f * (g + 0.044715f * g * g * g);
            const float th = 1.f - 2.f * __builtin_amdgcn_rcpf(1.f + fexp(2.f * y));
            MIX[t * 1024 + ch] = f2bf(H * 0.5f * g * (1.f + th)); }
    }
}

constexpr int AT_KROW = 208, AT_VROW = 136, AT_KT = 64 * AT_KROW, AT_VT = 64 * AT_VROW;
DI float rowmax32(const f32x16& p0, const f32x16& p1) {
    float a = fmaxf(fmaxf(p0[0], p0[1]), p1[0]), b = fmaxf(fmaxf(p0[2], p0[3]), p1[1]); a = fmaxf(fmaxf(a, p1[2]), p1[3]);
#pragma unroll
    for (int r = 4; r < 16; r += 4) { a = fmaxf(fmaxf(a, p0[r]), p0[r + 1]); b = fmaxf(fmaxf(b, p0[r + 2]), p0[r + 3]); a = fmaxf(fmaxf(a, p1[r]), p1[r + 1]); b = fmaxf(fmaxf(b, p1[r + 2]), p1[r + 3]); }
    const float m = fmaxf(a, b);
    return fmaxf(m, __shfl_xor(m, 32));
}
DI void attn_unit(int wv, int h, int qb, const bf16_t* QB, const bf16_t* KB, const bf16_t* VT, bf16_t* MIX, LAS unsigned char* lds) {
    const int tid = ltid(wv), lane = tid & 63, r32 = lane & 31, hi = lane >> 5; const int wid = __builtin_amdgcn_readfirstlane(tid >> 6);
    const int qg = qb * 256 + wid * 32 + r32;
    const bf16_t* Kh = KB + (size_t)h * S * 96; const bf16_t* Vh = VT + (size_t)h * 64 * S;
    bf16x8 qf[6];
    { const bf16_t* qp = QB + ((size_t)h * S + qg) * 96 + 8 * hi;
#pragma unroll
      for (int s = 0; s < 6; ++s) qf[s] = *(const bf16x8*)(qp + 16 * s); }
    f32x16 o0 = {}, o1 = {}, negm = {};
    float mref = 0.f, lrun = 0.f;
    const int NT = 4 * qb + 4, wlim = 4 * qb + (wid >> 1);
    const int kc0 = tid, kkey0 = kc0 / 12, kpart0 = kc0 % 12;
    const int kc1 = tid + 512, kkey1 = kc1 / 12, kpart1 = kc1 % 12;
    const int vdv = tid >> 3, vpart = tid & 7;
    u32x4 rk0, rk1 = {}, rv;
#define AT_LOADK(t_) do { const size_t kb_ = (size_t)(t_) * 64; rk0 = *(const u32x4*)(Kh + (kb_ + kkey0) * 96 + kpart0 * 8); if (tid < 256) rk1 = *(const u32x4*)(Kh + (kb_ + kkey1) * 96 + kpart1 * 8); } while (0)
#define AT_LOADV(t_) do { rv = *(const u32x4*)(Vh + (size_t)vdv * S + (size_t)(t_) * 64 + vpart * 8); } while (0)
#define AT_WRITEK(t_) do { LAS unsigned char* Ks_ = lds + ((t_) & 1) * AT_KT; *(LAS u32x4*)(Ks_ + kkey0 * AT_KROW + kpart0 * 16) = rk0; if (tid < 256) *(LAS u32x4*)(Ks_ + kkey1 * AT_KROW + kpart1 * 16) = rk1; } while (0)
#define AT_WRITEV(t_) do { LAS unsigned char* Vs_ = lds + 2 * AT_KT + ((t_) & 1) * AT_VT; *(LAS u32x2*)(Vs_ + vdv * AT_VROW + vpart * 16) = (u32x2){rv.x, rv.y}; *(LAS u32x2*)(Vs_ + vdv * AT_VROW + vpart * 16 + 8) = (u32x2){rv.z, rv.w}; } while (0)
#define AT_QK(P0, P1, t_) do { const LAS unsigned char* Ks_ = lds + ((t_) & 1) * AT_KT + r32 * AT_KROW + 16 * hi; f32x16 c0_ = negm, c1_ = negm; \
        _Pragma("unroll") for (int s = 0; s < 6; ++s) { const bf16x8 k0_ = *(const LAS bf16x8*)(Ks_ + 32 * s), k1_ = *(const LAS bf16x8*)(Ks_ + 32 * AT_KROW + 32 * s); \
            c0_ = __builtin_amdgcn_mfma_f32_32x32x16_bf16(k0_, qf[s], c0_, 0, 0, 0); c1_ = __builtin_amdgcn_mfma_f32_32x32x16_bf16(k1_, qf[s], c1_, 0, 0, 0); } \
        P0 = c0_; P1 = c1_; } while (0)
#define AT_SM1(P0, P1, MOFF, t_, MASK) do { \
        { const float d_ = mref - MOFF; if (__any(d_ != 0.f)) { _Pragma("unroll") for (int r = 0; r < 16; ++r) { P0[r] -= d_; P1[r] -= d_; } } } \
        if (MASK && (t_) == wlim) { const int kbase_ = (t_) * 64 + 4 * hi; \
            _Pragma("unroll") for (int r = 0; r < 16; ++r) { const int kv_ = kbase_ + (r & 3) + 8 * (r >> 2); if (kv_ > qg) P0[r] = -1e30f; if (kv_ + 32 > qg) P1[r] = -1e30f; } } \
        const float mx_ = rowmax32(P0, P1); \
        if ((t_) == 0 || __any(mx_ > 8.f)) { const float dl_ = ((t_) == 0) ? mx_ : fmaxf(mx_, 0.f); mref += dl_; \
            _Pragma("unroll") for (int r = 0; r < 16; ++r) { P0[r] -= dl_; P1[r] -= dl_; } \
            const float al_ = __builtin_amdgcn_exp2f(-dl_); lrun *= al_; \
            _Pragma("unroll") for (int r = 0; r < 16; ++r) { o0[r] *= al_; o1[r] *= al_; negm[r] = -mref; } asm volatile("" : "+v"(negm)); } \
    } while (0)
#define AT_SM2(P0, P1, t_) do { \
        float ps_ = 0.f; \
        _Pragma("unroll") for (int r = 0; r < 16; ++r) { P0[r] = __builtin_amdgcn_exp2f(P0[r]); P1[r] = __builtin_amdgcn_exp2f(P1[r]); ps_ += P0[r] + P1[r]; } \
        lrun += ps_; \
        const LAS unsigned char* Vs_ = lds + 2 * AT_KT + ((t_) & 1) * AT_VT + r32 * AT_VROW + 8 * hi; \
        _Pragma("unroll") for (int ks = 0; ks < 4; ++ks) { u32x4 w_; \
            if (ks < 2) { w_.x = pk2(P0[8 * ks], P0[8 * ks + 1]); w_.y = pk2(P0[8 * ks + 2], P0[8 * ks + 3]); w_.z = pk2(P0[8 * ks + 4], P0[8 * ks + 5]); w_.w = pk2(P0[8 * ks + 6], P0[8 * ks + 7]); } \
            else { w_.x = pk2(P1[8 * ks - 16], P1[8 * ks - 15]); w_.y = pk2(P1[8 * ks - 14], P1[8 * ks - 13]); w_.z = pk2(P1[8 * ks - 12], P1[8 * ks - 11]); w_.w = pk2(P1[8 * ks - 10], P1[8 * ks - 9]); } \
            const bf16x8 pa_ = __builtin_bit_cast(bf16x8, w_); \
            const u32x2 a0_ = *(const LAS u32x2*)(Vs_ + 32 * ks), a1_ = *(const LAS u32x2*)(Vs_ + 32 * ks + 16); \
            const u32x2 b0_ = *(const LAS u32x2*)(Vs_ + 32 * AT_VROW + 32 * ks), b1_ = *(const LAS u32x2*)(Vs_ + 32 * AT_VROW + 32 * ks + 16); \
            o0 = __builtin_amdgcn_mfma_f32_32x32x16_bf16(__builtin_bit_cast(bf16x8, (u32x4){a0_.x, a0_.y, a1_.x, a1_.y}), pa_, o0, 0, 0, 0); \
            o1 = __builtin_amdgcn_mfma_f32_32x32x16_bf16(__builtin_bit_cast(bf16x8, (u32x4){b0_.x, b0_.y, b1_.x, b1_.y}), pa_, o1, 0, 0, 0); } \
    } while (0)
#define AT_STEPM(C0, C1, MC, N0, N1, MN, t_) do { \
        AT_WRITEK((t_) + 1); AT_WRITEV(t_); \
        __syncthreads(); \
        AT_LOADK((t_) + 2); AT_LOADV((t_) + 1); \
        AT_SM1(C0, C1, MC, t_, 0); MN = mref; AT_QK(N0, N1, (t_) + 1); AT_SM2(C0, C1, t_); \
    } while (0)
#define AT_STEPB(C0, C1, MC, N0, N1, MN, t_) do { \
        if ((t_) + 1 < NT) AT_WRITEK((t_) + 1); AT_WRITEV(t_); \
        __syncthreads(); \
        if ((t_) + 2 < NT) AT_LOADK((t_) + 2); if ((t_) + 1 < NT) AT_LOADV((t_) + 1); \
        if ((t_) + 1 <= wlim) { MN = mref; AT_QK(N0, N1, (t_) + 1); } \
        if ((t_) <= wlim) { AT_SM1(C0, C1, MC, t_, 1); AT_SM2(C0, C1, t_); } \
    } while (0)
    f32x16 pA0, pA1, pB0 = {}, pB1 = {}; float mA = 0.f, mB = 0.f;
    AT_LOADK(0); AT_WRITEK(0);
    __syncthreads();
    AT_LOADK(1); AT_LOADV(0);
    AT_QK(pA0, pA1, 0);
    int t = 0;
    for (; t < 4 * qb; t += 2) {
        AT_STEPM(pA0, pA1, mA, pB0, pB1, mB, t);
        AT_STEPM(pB0, pB1, mB, pA0, pA1, mA, t + 1);
    }
    for (; t < NT; t += 2) {
        AT_STEPB(pA0, pA1, mA, pB0, pB1, mB, t);
        AT_STEPB(pB0, pB1, mB, pA0, pA1, mA, t + 1);
    }
#undef AT_STEPM
#undef AT_STEPB
#undef AT_LOADK
#undef AT_LOADV
#undef AT_WRITEK
#undef AT_WRITEV
#undef AT_QK
#undef AT_SM1
#undef AT_SM2
    lrun += __shfl_xor(lrun, 32);
    const float inv = 1.f / lrun;
    bf16_t* op = MIX + (size_t)qg * 1024 + 512 + h * 64;
#pragma unroll
    for (int g = 0; g < 4; ++g) { const int dv = 8 * g + 4 * hi;
        u32x2 w; w.x = pk2(o0[4 * g] * inv, o0[4 * g + 1] * inv); w.y = pk2(o0[4 * g + 2] * inv, o0[4 * g + 3] * inv); *(u32x2*)(op + dv) = w;
        u32x2 w2; w2.x = pk2(o1[4 * g] * inv, o1[4 * g + 1] * inv); w2.y = pk2(o1[4 * g + 2] * inv, o1[4 * g + 3] * inv); *(u32x2*)(op + 32 + dv) = w2; }
    __syncthreads();
}
DI void phase_attn(int wv, const ArgP a, LAS unsigned char* lds) {
    unsigned char* ws = a.ws();
    const bf16_t* QB = (const bf16_t*)(ws + O_QB); const bf16_t* KB = (const bf16_t*)(ws + O_KB); const bf16_t* VT = (const bf16_t*)(ws + O_VT); bf16_t* MIX = (bf16_t*)(ws + O_MIX);
    for (int b = blockIdx.x; b < 256; b += gridDim.x) {
        const int v = (b & 7) * 32 + (b >> 3), h = v >> 5, s = v & 31;
        attn_unit(wv, h, 63 - s, QB, KB, VT, MIX, lds);
        attn_unit(wv, h, s, QB, KB, VT, MIX, lds);
    }
}

DI void phase_m_gates(int wv, const ArgP a, LAS unsigned char* lds) {
    unsigned char* ws = a.ws(); const int tid = ltid(wv), wave = tid >> 6, lane = tid & 63;
    const bf16_t* XBr = (const bf16_t*)(ws + O_XB) + 2 * 1024; const u64* rowss = (const u64*)(ws + O_ROWSS) + 2 * S;
    const float* Wg = a.in(17); const float* gn = a.in(16);
    LAS float* wgs = (LAS float*)lds;
    LAS float* pre = (LAS float*)(lds + 32768);
    float* GB = (float*)(ws + O_GB); float* GE = (float*)(ws + O_GE); float* GPM = (float*)(ws + O_GPM);
    float* BL = (float*)(ws + O_BL); float* ML = (float*)(ws + O_ML);
    for (int e = tid; e < 8192; e += 512) { const int k = e >> 3, j = e & 7; wgs[e] = Wg[(size_t)k * 3080 + 3072 + j] * gn[k]; }
    __syncthreads();
    for (int c = blockIdx.x; c < 256; c += gridDim.x) {
#pragma unroll 4
        for (int i = 0; i < 8; ++i) { const int t = c * 64 + wave * 8 + i;
            float acc[8];
#pragma unroll
            for (int j = 0; j < 8; ++j) acc[j] = 0.f;
#pragma unroll
            for (int jj = 0; jj < 4; ++jj) { const int k0 = jj * 256 + lane * 4; const u32x2 hb = *(const u32x2*)(XBr + (size_t)t * 1024 + k0); const f32x4 hv = {bflo(hb.x), bfhi(hb.x), bflo(hb.y), bfhi(hb.y)};
#pragma unroll
                for (int kk = 0; kk < 4; ++kk) { const f32x4 w0 = *(const LAS f32x4*)(wgs + (k0 + kk) * 8), w1 = *(const LAS f32x4*)(wgs + (k0 + kk) * 8 + 4);
                    acc[0] += hv[kk] * w0[0]; acc[1] += hv[kk] * w0[1]; acc[2] += hv[kk] * w0[2]; acc[3] += hv[kk] * w0[3];
                    acc[4] += hv[kk] * w1[0]; acc[5] += hv[kk] * w1[1]; acc[6] += hv[kk] * w1[2]; acc[7] += hv[kk] * w1[3]; } }
            const float rs = rs_from_ss(rowss[t]);
            { const bool b5 = lane & 32, b4 = lane & 16, b3 = lane & 8;
#pragma unroll
              for (int j = 0; j < 4; ++j) { const float snd = b5 ? acc[j] : acc[j + 4], kp = b5 ? acc[j + 4] : acc[j]; acc[j] = kp + __shfl_xor(snd, 32); }
#pragma unroll
              for (int j = 0; j < 2; ++j) { const float snd = b4 ? acc[j] : acc[j + 2], kp = b4 ? acc[j + 2] : acc[j]; acc[j] = kp + __shfl_xor(snd, 16); }
              { const float snd = b3 ? acc[0] : acc[1], kp = b3 ? acc[1] : acc[0]; acc[0] = kp + __shfl_xor(snd, 8); }
              acc[0] += __shfl_xor(acc[0], 4); acc[0] += __shfl_xor(acc[0], 2); acc[0] += __shfl_xor(acc[0], 1);
              if ((lane & 7) == 0) pre[(wave * 8 + i) * 8 + (b5 ? 4 : 0) + (b4 ? 2 : 0) + (b3 ? 1 : 0)] = acc[0] * rs; }
        }
        __syncthreads();
        if (wave < 4) { const int h = wave; const float bi = a.in(18)[h], bfg = a.in(19)[h];
            const float ig = 15.f * tanhf((pre[lane * 8 + h] + bi) * (1.f / 15.f));
            const float fg = 15.f * tanhf((pre[lane * 8 + 4 + h] + bfg) * (1.f / 15.f));
            float b = -log1pf(expf(-fg));
#pragma unroll
            for (int o = 1; o < 64; o <<= 1) { const float v = __shfl_up(b, o); if (lane >= o) b += v; }
            const float e = ig - b; float pm = e;
#pragma unroll
            for (int o = 1; o < 64; o <<= 1) { const float v = __shfl_up(pm, o); if (lane >= o) pm = fmaxf(pm, v); }
            const size_t o_ = (size_t)h * S + c * 64 + lane; GB[o_] = b; GE[o_] = e; GPM[o_] = pm;
            if (lane == 63) { BL[c * 4 + h] = b; ML[c * 4 + h] = b + pm; } }
        __syncthreads();
    }
}
DI void phase_m_dc(int wv, const ArgP a) {
    unsigned char* ws = a.ws(); const int tid = ltid(wv), lane = tid & 63, r32 = lane & 31, hi = lane >> 5; const int w = __builtin_amdgcn_readfirstlane(tid >> 6);
    const float* BL = (const float*)(ws + O_BL); const float* ML = (const float*)(ws + O_ML); float* NST = (float*)(ws + O_NST);
    const float* GE = (const float*)(ws + O_GE); const bf16_t* KVT = (const bf16_t*)(ws + O_KVT); bf16_t* CST = (bf16_t*)(ws + O_CST);
    for (int u = blockIdx.x; u < 1024; u += gridDim.x) {
        const int c = u >> 2, h = u & 3; const size_t t0 = (size_t)c * 64;
        const float emax = ML[c * 4 + h] - BL[c * 4 + h];
        bf16x8 bfr[4];
        { const bf16_t* vp = KVT + (size_t)(512 + h * 256 + 32 * w + r32) * S + t0 + 8 * hi; const float* gp = GE + (size_t)h * S + t0 + 8 * hi;
#pragma unroll
          for (int ks = 0; ks < 4; ++ks) { const u32x4 v = *(const u32x4*)(vp + 16 * ks); const f32x4 e0 = *(const f32x4*)(gp + 16 * ks), e1 = *(const f32x4*)(gp + 16 * ks + 4);
              u32x4 o; o.x = pk2(bflo(v.x) * fexp(e0[0] - emax), bfhi(v.x) * fexp(e0[1] - emax)); o.y = pk2(bflo(v.y) * fexp(e0[2] - emax), bfhi(v.y) * fexp(e0[3] - emax));
              o.z = pk2(bflo(v.z) * fexp(e1[0] - emax), bfhi(v.z) * fexp(e1[1] - emax)); o.w = pk2(bflo(v.w) * fexp(e1[2] - emax), bfhi(v.w) * fexp(e1[3] - emax));
              bfr[ks] = __builtin_bit_cast(bf16x8, o); } }
        const bf16_t* kp = KVT + (size_t)(h * 128 + r32) * S + t0 + 8 * hi;
        bf16_t* op = CST + ((size_t)(c * 4 + h) * 256 + 32 * w + r32) * 128 + 4 * hi;
#pragma unroll
        for (int rb = 0; rb < 4; ++rb) { f32x16 acc = {};
#pragma unroll
            for (int ks = 0; ks < 4; ++ks) { const bf16x8 ka = *(const bf16x8*)(kp + (size_t)(32 * rb) * S + 16 * ks); acc = __builtin_amdgcn_mfma_f32_32x32x16_bf16(ka, bfr[ks], acc, 0, 0, 0); }
#pragma unroll
            for (int g = 0; g < 4; ++g) { u32x2 o; o.x = pk2(acc[4 * g], acc[4 * g + 1]); o.y = pk2(acc[4 * g + 2], acc[4 * g + 3]); *(u32x2*)(op + 32 * rb + 8 * g) = o; } }
        if (tid < 128) { const bf16_t* kr = KVT + (size_t)(h * 128 + tid) * S + t0; const float* gp = GE + (size_t)h * S + t0; float s = 0.f;
#pragma unroll
            for (int p = 0; p < 8; ++p) { const u32x4 v = *(const u32x4*)(kr + 8 * p); const f32x4 e0 = *(const f32x4*)(gp + 8 * p), e1 = *(const f32x4*)(gp + 8 * p + 4);
                s += bflo(v.x) * fexp(e0[0] - emax) + bfhi(v.x) * fexp(e0[1] - emax) + bflo(v.y) * fexp(e0[2] - emax) + bfhi(v.y) * fexp(e0[3] - emax)
                   + bflo(v.z) * fexp(e1[0] - emax) + bfhi(v.z) * fexp(e1[1] - emax) + bflo(v.w) * fexp(e1[2] - emax) + bfhi(v.w) * fexp(e1[3] - emax); }
            NST[(size_t)(c * 4 + h) * 128 + tid] = s; }
    }
}
DI void phase_m_comb(int wv, const ArgP a, LAS unsigned char* lds, int dry) {
    unsigned char* ws = a.ws(); const int tid = ltid(wv);
    const float* BL = (const float*)(ws + O_BL); const float* ML = (const float*)(ws + O_ML); float* MST = (float*)(ws + O_MST); float* NST = (float*)(ws + O_NST);
    bf16_t* CST = (bf16_t*)(ws + O_CST);
    LAS float* bls = (LAS float*)lds; LAS float* mls = bls + 1024; LAS float* ga = mls + 1024; LAS float* gb = ga + 1024;
    for (int e = tid; e < 1024; e += 512) { bls[e] = BL[e]; mls[e] = ML[e]; }
    __syncthreads();
    if (tid < 256) { const int h = tid >> 6, l = tid & 63;
        float a_ = 0.f, b_ = -1e30f;
#pragma unroll
        for (int k = 0; k < 4; ++k) { const float bl = bls[(4 * l + k) * 4 + h], ml = mls[(4 * l + k) * 4 + h]; a_ += bl; b_ = fmaxf(b_ + bl, ml); }
        float pa = a_, pb = b_;
#pragma unroll
        for (int o = 1; o < 64; o <<= 1) { const float qa = __shfl_up(pa, o), qb = __shfl_up(pb, o); if (l >= o) { pb = fmaxf(qb + pa, pb); pa = qa + pa; } }
        float ea = __shfl_up(pa, 1), eb_ = __shfl_up(pb, 1); if (l == 0) { ea = 0.f; eb_ = -1e30f; }
        float m = fmaxf(0.f + ea, eb_);
#pragma unroll
        for (int k = 0; k < 4; ++k) { const int c = 4 * l + k; const float bl = bls[c * 4 + h], ml = mls[c * 4 + h]; const float mn = fmaxf(bl + m, ml);
            ga[c * 4 + h] = fexp(bl + m - mn); gb[c * 4 + h] = fexp(ml - mn);
            if (blockIdx.x == 0 && !dry) MST[c * 4 + h] = m;
            m = mn; } }
    __syncthreads();
    for (int eb = blockIdx.x; eb < 129; eb += gridDim.x) {
        if (eb < 128) { const int h = eb >> 5; unsigned* p = (unsigned*)(CST + (size_t)h * 32768 + (size_t)(eb & 31) * 1024 + 2 * tid); float C0 = 0.f, C1 = 0.f;
            for (int c = 0; c < 256; c += 64) { unsigned d[64];
#pragma unroll
                for (int k = 0; k < 64; ++k) d[k] = p[(size_t)(c + k) * 65536];
#pragma unroll
                for (int k = 0; k < 64; ++k) { if (!dry) p[(size_t)(c + k) * 65536] = pk2(C0, C1); const float a_ = ga[(c + k) * 4 + h], b_ = gb[(c + k) * 4 + h]; C0 = a_ * C0 + b_ * bflo(d[k]); C1 = a_ * C1 + b_ * bfhi(d[k]); } }
        } else { const int h = tid >> 7; float* p = NST + tid; float C = 0.f;
            for (int c = 0; c < 256; c += 8) { float d[8];
#pragma unroll
                for (int k = 0; k < 8; ++k) d[k] = p[(size_t)(c + k) * 512];
#pragma unroll
                for (int k = 0; k < 8; ++k) { if (!dry) p[(size_t)(c + k) * 512] = C; C = ga[(c + k) * 4 + h] * C + gb[(c + k) * 4 + h] * d[k]; } } }
    }
    __syncthreads();
}
constexpr int MC_QROW = 272, MC_SROW = 144;
constexpr int MC_QS = 0, MC_KS = 64 * MC_QROW, MC_SC = 2 * 64 * MC_QROW, MC_F = MC_SC + 64 * MC_SROW;
DI void phase_m_out(int wv, const ArgP a, LAS unsigned char* lds, int dry) {
    unsigned char* ws = a.ws(); const int tid = ltid(wv), lane = tid & 63, r32 = lane & 31, hi = lane >> 5; const int w = __builtin_amdgcn_readfirstlane(tid >> 6);
    bf16_t* QOK = (bf16_t*)(ws + O_QOK); const bf16_t* KVT = (const bf16_t*)(ws + O_KVT); const bf16_t* CST = (const bf16_t*)(ws + O_CST);
    const float* GB = (const float*)(ws + O_GB); const float* GE = (const float*)(ws + O_GE); const float* GPM = (const float*)(ws + O_GPM);
    const float* MST = (const float*)(ws + O_MST); const float* NST = (const float*)(ws + O_NST); const float* ong = a.in(20);
    LAS unsigned char* Qs = lds + MC_QS; LAS unsigned char* Ks = lds + MC_KS; LAS unsigned char* Sc = lds + MC_SC;
    LAS float* F = (LAS float*)(lds + MC_F);
    LAS float* f_b = F, *f_e = F + 64, *f_m = F + 128, *f_g = F + 192, *f_qn = F + 256, *f_ps = F + 320  , *f_n = F + 576  , *f_part = F + 704  ;
    for (int u = blockIdx.x; u < 1024; u += gridDim.x) {
        const int c = u >> 2, h = u & 3; const size_t t0 = (size_t)c * 64;
        for (int e = tid; e < 1024; e += 512) { const int r = e >> 4, p = e & 15;
            *(LAS u32x4*)(Qs + r * MC_QROW + p * 16) = *(const u32x4*)(QOK + (t0 + r) * 2048 + h * 128 + p * 8);
            *(LAS u32x4*)(Ks + r * MC_QROW + p * 16) = *(const u32x4*)(QOK + (t0 + r) * 2048 + 1536 + h * 128 + p * 8); }
        if (tid < 64) { const float mstv = MST[c * 4 + h]; const float b = GB[(size_t)h * S + t0 + tid], e = GE[(size_t)h * S + t0 + tid], pm = GPM[(size_t)h * S + t0 + tid];
            const float m = b + fmaxf(mstv, pm); f_b[tid] = b; f_e[tid] = e; f_m[tid] = m; f_g[tid] = fexp(b + mstv - m); }
        if (tid >= 64 && tid < 192) f_n[tid - 64] = NST[(size_t)(c * 4 + h) * 128 + tid - 64];
        __syncthreads();
        if (w < 4) {
            const int sb = w & 1, tb = w >> 1; const int tl = 32 * tb + r32;
            f32x16 x = {};
#pragma unroll
            for (int ks = 0; ks < 8; ++ks) {
                const bf16x8 ka = *(const LAS bf16x8*)(Ks + (32 * sb + r32) * MC_QROW + (16 * ks + 8 * hi) * 2);
                const bf16x8 qb = *(const LAS bf16x8*)(Qs + tl * MC_QROW + (16 * ks + 8 * hi) * 2);
                x = __builtin_amdgcn_mfma_f32_32x32x16_bf16(ka, qb, x, 0, 0, 0); }
            const float bt = f_b[tl], mt = f_m[tl]; float ps = 0.f;
#pragma unroll
            for (int g = 0; g < 4; ++g) { float v[4];
#pragma unroll
                for (int j = 0; j < 4; ++j) { const int sl = 32 * sb + 8 * g + 4 * hi + j; const float wgt = (sl <= tl) ? fexp(bt + f_e[sl] - mt) : 0.f; v[j] = x[4 * g + j] * wgt; ps += v[j]; }
                u32x2 o; o.x = pk2(v[0], v[1]); o.y = pk2(v[2], v[3]);
                *(LAS u32x2*)(Sc + tl * MC_SROW + (32 * sb + 8 * g + 4 * hi) * 2) = o; }
            f_ps[(sb * 2 + hi) * 64 + tl] = ps;
        } else {
            const int tl = 16 * (w - 4) + (lane >> 2), qq = lane & 3; float s = 0.f;
#pragma unroll
            for (int p = 0; p < 4; ++p) { const u32x4 v = *(const LAS u32x4*)(Qs + tl * MC_QROW + (32 * qq + 8 * p) * 2); LAS float* np = f_n + 32 * qq + 8 * p;
                s += bflo(v.x) * np[0] + bfhi(v.x) * np[1] + bflo(v.y) * np[2] + bfhi(v.y) * np[3] + bflo(v.z) * np[4] + bfhi(v.z) * np[5] + bflo(v.w) * np[6] + bfhi(v.w) * np[7]; }
            s += __shfl_xor(s, 1); s += __shfl_xor(s, 2);
            if (qq == 0) f_qn[tl] = s;
        }
        __syncthreads();
        f32x16 acc0 = {}, acc1 = {};
        { const bf16_t* cp = CST + ((size_t)(c * 4 + h) * 256 + 32 * w + r32) * 128 + 8 * hi;
#pragma unroll
          for (int ks = 0; ks < 8; ++ks) { const bf16x8 ca = *(const bf16x8*)(cp + 16 * ks);
              const bf16x8 q0 = *(const LAS bf16x8*)(Qs + r32 * MC_QROW + (16 * ks + 8 * hi) * 2), q1 = *(const LAS bf16x8*)(Qs + (32 + r32) * MC_QROW + (16 * ks + 8 * hi) * 2);
              acc0 = __builtin_amdgcn_mfma_f32_32x32x16_bf16(ca, q0, acc0, 0, 0, 0); acc1 = __builtin_amdgcn_mfma_f32_32x32x16_bf16(ca, q1, acc1, 0, 0, 0); } }
        const float g0 = f_g[r32], g1 = f_g[32 + r32];
#pragma unroll
        for (int r = 0; r < 16; ++r) { acc0[r] *= g0; acc1[r] *= g1; }
        { const bf16_t* vp = KVT + (size_t)(512 + h * 256 + 32 * w + r32) * S + t0 + 8 * hi;
#pragma unroll
          for (int ks = 0; ks < 4; ++ks) { const bf16x8 va = *(const bf16x8*)(vp + 16 * ks);
              const bf16x8 s0 = *(const LAS bf16x8*)(Sc + r32 * MC_SROW + (16 * ks + 8 * hi) * 2), s1 = *(const LAS bf16x8*)(Sc + (32 + r32) * MC_SROW + (16 * ks + 8 * hi) * 2);
              acc0 = __builtin_amdgcn_mfma_f32_32x32x16_bf16(va, s0, acc0, 0, 0, 0); acc1 = __builtin_amdgcn_mfma_f32_32x32x16_bf16(va, s1, acc1, 0, 0, 0); } }
        float inv[2];
#pragma unroll
        for (int tb = 0; tb < 2; ++tb) { const int tl = 32 * tb + r32;
            const float den = f_g[tl] * f_qn[tl] + f_ps[tl] + f_ps[64 + tl] + f_ps[128 + tl] + f_ps[192 + tl];
            inv[tb] = 1.f / fmaxf(fabsf(den), fexp(-f_m[tl])); }
        float ss0 = 0.f, ss1 = 0.f;
#pragma unroll
        for (int r = 0; r < 16; ++r) { acc0[r] *= inv[0]; acc1[r] *= inv[1]; ss0 += acc0[r] * acc0[r]; ss1 += acc1[r] * acc1[r]; }
        ss0 += __shfl_xor(ss0, 32); ss1 += __shfl_xor(ss1, 32);
        if (hi == 0) { f_part[w * 64 + r32] = ss0; f_part[w * 64 + 32 + r32] = ss1; }
        __syncthreads();
        float rn[2];
#pragma unroll
        for (int tb = 0; tb < 2; ++tb) { float s = 0.f;
#pragma unroll
            for (int ww = 0; ww < 8; ++ww) s += f_part[ww * 64 + 32 * tb + r32];
            rn[tb] = rsqrtf(s * (1.f / 256.f) + EPS); }
#pragma unroll
        for (int tb = 0; tb < 2; ++tb) { bf16_t* op = QOK + (t0 + 32 * tb + r32) * 2048 + 512 + h * 256 + 32 * w;
#pragma unroll
            for (int g = 0; g < 4; ++g) { const int dv = 8 * g + 4 * hi; const u32x2 ov = *(const u32x2*)(op + dv);
                const f32x4 gg = *(const f32x4*)(ong + h * 256 + 32 * w + dv);
                const float og[4] = {bflo(ov.x), bfhi(ov.x), bflo(ov.y), bfhi(ov.y)}; float y[4];
#pragma unroll
                for (int j = 0; j < 4; ++j) { const float hv = (tb ? acc1[4 * g + j] : acc0[4 * g + j]) * rn[tb]; y[j] = hv * gg[j] * sigmoidf_(og[j]); }
                u32x2 o; o.x = pk2(y[0], y[1]); o.y = pk2(y[2], y[3]); if (!dry) *(u32x2*)(op + dv) = o; } }
        __syncthreads();
    }
}

DI void phase_final(int wv, const ArgP a) {
    float* out = a.out(); const u64* rowss = (const u64*)(a.ws() + O_ROWSS) + 4 * S; const float* g = a.in(27); const bf16_t* XBr = (const bf16_t*)(a.ws() + O_XB) + 2 * 1024;
    for (size_t e = (size_t)blockIdx.x * 512 + ltid(wv); e < (size_t)S * 128; e += (size_t)gridDim.x * 512) { const int t = (int)(e >> 7), c = (int)(e & 127) * 8;
        const float rs = rs_from_ss(rowss[t]); const u32x4 hb = *(const u32x4*)(XBr + (size_t)t * 1024 + c); const f32x4 g0 = *(const f32x4*)(g + c), g1 = *(const f32x4*)(g + c + 4);
        const f32x4 v0 = (f32x4){bflo(hb.x), bfhi(hb.x), bflo(hb.y), bfhi(hb.y)} * rs * g0, v1 = (f32x4){bflo(hb.z), bfhi(hb.z), bflo(hb.w), bfhi(hb.w)} * rs * g1;
        *(f32x4*)(out + (size_t)t * 1024 + c) = v0; *(f32x4*)(out + (size_t)t * 1024 + c + 4) = v1; }
}

#ifndef DIS
#define DIS 0u
#endif
#ifndef REP
#define REP 0u
#endif
#ifndef XSYNC
#define XSYNC 0
#endif

#define XB_TMO      128
#define XB_XCNT(j)  (256  + 64 * (j))
#define XB_XSUB(j)  (1280 + 64 * (j))
#define XB_XGEN(j)  (2304 + 64 * (j))
#define XB_TOP      3328
#define XB_TOPGEN   3392
#define XB_SPIN_CAP (1u << 18)
DI unsigned xb_ld(unsigned* p) { return __hip_atomic_load(p, __ATOMIC_RELAXED, __HIP_MEMORY_SCOPE_AGENT); }
DI unsigned xb_add(unsigned* p, unsigned v) { return __hip_atomic_fetch_add(p, v, __ATOMIC_RELAXED, __HIP_MEMORY_SCOPE_AGENT); }
DI unsigned xb_xcc_id() { return (unsigned)__builtin_amdgcn_s_getreg((3 << 11) | 20) & 0xFu; }
#define XB_SPIN(cond, bar) do { unsigned _sp = 0; while (cond) { __builtin_amdgcn_s_sleep(1); \
    if ((++_sp & 255u) == 0u) { if (xb_ld(&(bar)[XB_TMO])) break; if (_sp > XB_SPIN_CAP) { atomicAdd(&(bar)[XB_TMO], 1u); break; } } } } while (0)
DI void xcd_barrier_complete(unsigned* bar, unsigned x, unsigned& nloc, unsigned& nx) {
    const unsigned G = gridDim.x;
    unsigned sum, cnt, mine, sp = 0u;
    for (;;) {
        sum = 0u; cnt = 0u; mine = 0u;
#pragma unroll
        for (unsigned j = 0; j < 16; ++j) { const unsigned c = xb_ld(&bar[XB_XCNT(j)]); sum += c; cnt += (c > 0u) ? 1u : 0u; mine = (j == x) ? c : mine; }
        if (sum == G) break;
        __builtin_amdgcn_s_sleep(1);
        if ((++sp & 255u) == 0u) { if (xb_ld(&bar[XB_TMO])) break; if (sp > XB_SPIN_CAP) { atomicAdd(&bar[XB_TMO], 1u); break; } }
    }
    nloc = mine > 0u ? mine : 1u; nx = cnt > 0u ? cnt : 1u;
}
DI void xcd_barrier(int wv, unsigned* bar, volatile LAS unsigned* st) {
    asm volatile("s_waitcnt vmcnt(0)" ::: "memory");
    __syncthreads();
    if (ltid(wv) == 0) {
        const unsigned x = xb_xcc_id();
        __builtin_amdgcn_s_waitcnt(0);
        unsigned nloc = st[0], nx = st[1];
        if (nloc == 0u) { xcd_barrier_complete(bar, x, nloc, nx); st[0] = nloc; st[1] = nx; }
        const unsigned old = xb_add(&bar[XB_XSUB(x)], 1u);
        const unsigned gen = old / nloc;
        if (old + 1u == (gen + 1u) * nloc) {
            __builtin_amdgcn_fence(__ATOMIC_RELEASE, "agent");
            asm volatile("s_waitcnt vmcnt(0)" ::: "memory");
            const unsigned og = xb_add(&bar[XB_TOP], 1u);
            const unsigned tg = og / nx;
            if (og + 1u == (tg + 1u) * nx) xb_add(&bar[XB_TOPGEN], 1u);
            else XB_SPIN(xb_ld(&bar[XB_TOPGEN]) == tg, bar);
            __builtin_amdgcn_fence(__ATOMIC_ACQUIRE, "agent");
            xb_add(&bar[XB_XGEN(x)], 1u);
            asm volatile("s_waitcnt vmcnt(0)" ::: "memory");
        } else {
            XB_SPIN(xb_ld(&bar[XB_XGEN(x)]) == gen, bar);
            __builtin_amdgcn_fence(__ATOMIC_ACQUIRE, "agent");
            asm volatile("s_waitcnt vmcnt(0)" ::: "memory");
        }
    }
    __syncthreads();
}
DI ArgP getargs() { ArgP r; r.p = (const __attribute__((address_space(4))) Args*)__builtin_amdgcn_kernarg_segment_ptr(); asm volatile("" : "+s"(r.p)); return r; }
#define WSB (getargs().ws())
#define XBP ((bf16_t*)(getargs().ws() + O_XB) + 2 * 1024)
#define RSS ((u64*)(getargs().ws() + O_ROWSS))
#define HFP (getargs().out())
__global__ void __launch_bounds__(512, 2) fwd_kernel(Args a_unused) {
    extern __shared__ __attribute__((aligned(16))) unsigned char shm[];
    LAS unsigned char* lds = (LAS unsigned char*)shm;
    const int wv = __builtin_amdgcn_readfirstlane(threadIdx.x >> 6);
#define BARW ((unsigned*)(getargs().ws() + O_BAR))
#define BARST ((volatile LAS unsigned*)(lds + 139264))
#define GSYNC() xcd_barrier(wv, BARW, BARST)
    { unsigned* barw0 = BARW; if (threadIdx.x == 0) { BARST[0] = 0u; BARST[1] = 0u; (void)xb_add(&barw0[XB_XCNT(xb_xcc_id())], 1u); } }
    if (getargs().p->pad == 0x7fffffff) cg::this_grid().sync();

#if !(DIS & (1u << 0))
    for (int rep_ = 0; rep_ < ((REP >> 0) & 1u) + 1; ++rep_) { const int dry_ = rep_ < (int)((REP >> 0) & 1u); (void)dry_;
    phase_prologue(wv, getargs(), lds, dry_ ? PROPART : 7);
    }
#endif
    GSYNC();
#if !(DIS & (1u << 1))
    for (int rep_ = 0; rep_ < ((REP >> 1) & 1u) + 1; ++rep_) { const int dry_ = rep_ < (int)((REP >> 1) & 1u); (void)dry_;
    { EpiRowBf16<1> E{(bf16_t*)(WSB + O_Z), 1536, RSS};
      pg8::gemm_phase<false>(wv, lds, XBP, 1024, (const bf16_t*)(WSB + O_W1T), 1024, 1024, 64, 6, E); }
    }
#endif
    GSYNC();
#if !(DIS & (1u << 2))
    for (int rep_ = 0; rep_ < ((REP >> 2) & 1u) + 1; ++rep_) { const int dry_ = rep_ < (int)((REP >> 2) & 1u); (void)dry_;
    phase_l0_prep(wv, getargs());
    }
#endif
    GSYNC();
#if !(DIS & (1u << 3))
    for (int rep_ = 0; rep_ < ((REP >> 3) & 1u) + 1; ++rep_) { const int dry_ = rep_ < (int)((REP >> 3) & 1u); (void)dry_;
    { EpiRowBf16<0> E{(bf16_t*)(WSB + O_RI), 1024, nullptr};
      pg8::gemm_phase<false>(wv, lds, (const bf16_t*)(WSB + O_XC), 512, (const bf16_t*)(WSB + O_WRIT), 512, 512, 64, 4, E); }
    }
#endif
#if !(DIS & (1u << 4))
    for (int rep_ = 0; rep_ < ((REP >> 4) & 1u) + 1; ++rep_) { const int dry_ = rep_ < (int)((REP >> 4) & 1u); (void)dry_;
    { EpiQ E{(bf16_t*)(WSB + O_QB), (const float*)(WSB + O_RSQ), (const float*)(WSB + O_CSTAB)};
      pg8::gemm_phase<false>(wv, lds, (const bf16_t*)(WSB + O_Z) + 1024, 1536, (const bf16_t*)(WSB + O_WQT), 256, 256, 64, 3, E); }
    }
#endif
#if !(DIS & (1u << 5))
    for (int rep_ = 0; rep_ < ((REP >> 5) & 1u) + 1; ++rep_) { const int dry_ = rep_ < (int)((REP >> 5) & 1u); (void)dry_;
    { EpiK E{(bf16_t*)(WSB + O_KB), (const float*)(WSB + O_RSKV)};
      pg8::gemm_phase<false>(wv, lds, (const bf16_t*)(WSB + O_Z) + 1280, 1536, (const bf16_t*)(WSB + O_WKT), 256, 256, 64, 2, E, 192); }
    }
#endif
#if !(DIS & (1u << 6))
    for (int rep_ = 0; rep_ < ((REP >> 6) & 1u) + 1; ++rep_) { const int dry_ = rep_ < (int)((REP >> 6) & 1u); (void)dry_;
    { EpiColBf16<2> E{(bf16_t*)(WSB + O_VT), S, (const float*)(WSB + O_RSKV)};
      pg8::gemm_phase<false>(wv, lds, (const bf16_t*)(WSB + O_WVT), 256, (const bf16_t*)(WSB + O_Z) + 1280, 1536, 256, 2, 64, E, 64); }
    }
#endif
    GSYNC();
#if !(DIS & (1u << 7))
    for (int rep_ = 0; rep_ < ((REP >> 7) & 1u) + 1; ++rep_) { const int dry_ = rep_ < (int)((REP >> 7) & 1u); (void)dry_;
    phase_lru_s1(wv, getargs());
    }
#endif
    GSYNC();
#if !(DIS & (1u << 8))
    for (int rep_ = 0; rep_ < ((REP >> 8) & 1u) + 1; ++rep_) { const int dry_ = rep_ < (int)((REP >> 8) & 1u); (void)dry_;
    phase_lru_s3(wv, getargs());
    }
#endif
#if !(DIS & (1u << 9))
    for (int rep_ = 0; rep_ < ((REP >> 9) & 1u) + 1; ++rep_) { const int dry_ = rep_ < (int)((REP >> 9) & 1u); (void)dry_;
    phase_attn(wv, getargs(), lds);
    }
#endif
    GSYNC();
#if !(DIS & (1u << 10))
    for (int rep_ = 0; rep_ < ((REP >> 10) & 1u) + 1; ++rep_) { const int dry_ = rep_ < (int)((REP >> 10) & 1u); (void)dry_;
    { EpiRes<false> E{getargs().in(0), XBP, RSS + 1 * S, dry_};
      pg8::gemm_phase<false>(wv, lds, (const bf16_t*)(WSB + O_MIX), 1024, (const bf16_t*)(WSB + O_WO1T), 1024, 1024, 64, 4, E); }
    }
#endif
    GSYNC();
#if !(DIS & (1u << 11))
    for (int rep_ = 0; rep_ < ((REP >> 11) & 1u) + 1; ++rep_) { const int dry_ = rep_ < (int)((REP >> 11) & 1u); (void)dry_;
    { EpiUp E{(bf16_t*)(WSB + O_ACT), RSS + 1 * S, getargs().in(24), getargs().in(25), lds + 131072};
      pg8::gemm_phase<true>(wv, lds, XBP, 1024, (const bf16_t*)(WSB + O_WUPT0), 1024, 1024, 67, 22, E); }
    }
#endif
    GSYNC();
#if !(DIS & (1u << 12))
    for (int rep_ = 0; rep_ < ((REP >> 12) & 1u) + 1; ++rep_) { const int dry_ = rep_ < (int)((REP >> 12) & 1u); (void)dry_;
    { EpiRes<true> E{nullptr, XBP, RSS + 2 * S, dry_};
      pg8::gemm_phase<false>(wv, lds, (const bf16_t*)(WSB + O_ACT), 2816, (const bf16_t*)(WSB + O_WDNT0), 2816, 2816, 64, 4, E); }
    }
#endif
    GSYNC();
#if !(DIS & (1u << 13))
    for (int rep_ = 0; rep_ < ((REP >> 13) & 1u) + 1; ++rep_) { const int dry_ = rep_ < (int)((REP >> 13) & 1u); (void)dry_;
    { EpiRowBf16<1> E{(bf16_t*)(WSB + O_QOK), 2048, RSS + 2 * S};
      pg8::gemm_phase<false>(wv, lds, XBP, 1024, (const bf16_t*)(WSB + O_WOINT), 1024, 1024, 64, 8, E); }
    }
#endif
#if !(DIS & (1u << 14))
    for (int rep_ = 0; rep_ < ((REP >> 14) & 1u) + 1; ++rep_) { const int dry_ = rep_ < (int)((REP >> 14) & 1u); (void)dry_;
    { EpiColBf16<1> E{(bf16_t*)(WSB + O_KVT), S, RSS + 2 * S};
      pg8::gemm_phase<false>(wv, lds, (const bf16_t*)(WSB + O_WOINT) + (size_t)1536 * 1024, 1024, XBP, 1024, 1024, 6, 64, E); }
    }
#endif
#if !(DIS & (1u << 15))
    for (int rep_ = 0; rep_ < ((REP >> 15) & 1u) + 1; ++rep_) { const int dry_ = rep_ < (int)((REP >> 15) & 1u); (void)dry_;
    phase_m_gates(wv, getargs(), lds);
    }
#endif
    GSYNC();
#if !(DIS & (1u << 16))
    for (int rep_ = 0; rep_ < ((REP >> 16) & 1u) + 1; ++rep_) { const int dry_ = rep_ < (int)((REP >> 16) & 1u); (void)dry_;
    phase_m_dc(wv, getargs());
    }
#endif
    GSYNC();
#if !(DIS & (1u << 22))
    for (int rep_ = 0; rep_ < ((REP >> 22) & 1u) + 1; ++rep_) { const int dry_ = rep_ < (int)((REP >> 22) & 1u); (void)dry_;
    phase_m_comb(wv, getargs(), lds, dry_);
    }
#endif
    GSYNC();
#if !(DIS & (1u << 17))
    for (int rep_ = 0; rep_ < ((REP >> 17) & 1u) + 1; ++rep_) { const int dry_ = rep_ < (int)((REP >> 17) & 1u); (void)dry_;
    phase_m_out(wv, getargs(), lds, dry_);
    }
#endif
    GSYNC();
#if !(DIS & (1u << 18))
    for (int rep_ = 0; rep_ < ((REP >> 18) & 1u) + 1; ++rep_) { const int dry_ = rep_ < (int)((REP >> 18) & 1u); (void)dry_;
    { EpiRes<true> E{nullptr, XBP, RSS + 3 * S, dry_};
      pg8::gemm_phase<false>(wv, lds, (const bf16_t*)(WSB + O_QOK) + 512, 2048, (const bf16_t*)(WSB + O_WO2T), 1024, 1024, 64, 4, E); }
    }
#endif
    GSYNC();
#if !(DIS & (1u << 19))
    for (int rep_ = 0; rep_ < ((REP >> 19) & 1u) + 1; ++rep_) { const int dry_ = rep_ < (int)((REP >> 19) & 1u); (void)dry_;
    { EpiUp E{(bf16_t*)(WSB + O_ACT), RSS + 3 * S, getargs().in(24) + 3 * 5632, getargs().in(25) + 5632, lds + 131072};
      pg8::gemm_phase<true>(wv, lds, XBP, 1024, (const bf16_t*)(WSB + O_WUPT1), 1024, 1024, 67, 22, E); }
    }
#endif
    GSYNC();
#if !(DIS & (1u << 20))
    for (int rep_ = 0; rep_ < ((REP >> 20) & 1u) + 1; ++rep_) { const int dry_ = rep_ < (int)((REP >> 20) & 1u); (void)dry_;
    { EpiRes<true> E{nullptr, XBP, RSS + 4 * S, dry_};
      pg8::gemm_phase<false>(wv, lds, (const bf16_t*)(WSB + O_ACT), 2816, (const bf16_t*)(WSB + O_WDNT1), 2816, 2816, 64, 4, E); }
    }
#endif
    GSYNC();
#if !(DIS & (1u << 21))
    for (int rep_ = 0; rep_ < ((REP >> 21) & 1u) + 1; ++rep_) { const int dry_ = rep_ < (int)((REP >> 21) & 1u); (void)dry_;
    phase_final(wv, getargs());
    }
#endif
    for (int i = 0; i < XSYNC; ++i) GSYNC();
}

extern "C" void kernel_launch(void* const* d_in, const int* in_sizes, int n_in, void* d_out, int out_size, void* d_ws, size_t ws_size, hipStream_t stream) {
    static int grid = 0;
    if (grid == 0) {
        if (n_in != 28 || out_size != S * 1024 || ws_size < WS_NEED) { fprintf(stderr, "kernel_launch: unexpected shapes (n_in %d out %d ws %zu need %zu)\n", n_in, out_size, ws_size, (size_t)WS_NEED); grid = -1; return; }
        int dev = 0, cus = 0, per_cu = 0;
        (void)hipGetDevice(&dev);
        (void)hipDeviceGetAttribute(&cus, hipDeviceAttributeMultiprocessorCount, dev);
        if (hipFuncSetAttribute((const void*)fwd_kernel, hipFuncAttributeMaxDynamicSharedMemorySize, LDS_BYTES) != hipSuccess) { fprintf(stderr, "kernel_launch: hipFuncSetAttribute failed\n"); grid = -1; return; }
        if (hipOccupancyMaxActiveBlocksPerMultiprocessor(&per_cu, (const void*)fwd_kernel, 512, LDS_BYTES) != hipSuccess || per_cu < 1) { fprintf(stderr, "kernel_launch: occupancy query says %d\n", per_cu); per_cu = 1; }
        (void)hipGetLastError();
        grid = cus * 1;
        if (grid > 256) grid = 256;
    }
    if (grid < 0) return;
    Args a{};
    for (int i = 0; i < 28; ++i) a.in[i] = (const float*)d_in[i];
    a.out = (float*)d_out; a.ws = (unsigned char*)d_ws;
    if (hipMemsetAsync((char*)d_ws + O_BAR, 0, BAR_BYTES, stream) != hipSuccess) { fprintf(stderr, "kernel_launch: memset failed\n"); return; }
    void* args[] = {&a};
    hipError_t e = hipLaunchCooperativeKernel((void*)fwd_kernel, dim3(grid), dim3(512), args, LDS_BYTES, stream);
    if (e != hipSuccess) fprintf(stderr, "kernel_launch: cooperative launch failed: %s (grid %d)\n", hipGetErrorString(e), grid);
}
```

```cpp
#include <hip/hip_runtime.h>
#include <hip/hip_cooperative_groups.h>
#include <cstdio>
#include <cstdint>
namespace cg = cooperative_groups;

typedef unsigned short bf16_t;
typedef short bf16x8 __attribute__((ext_vector_type(8)));
typedef short s16x4 __attribute__((ext_vector_type(4)));
typedef float f32x2 __attribute__((ext_vector_type(2)));
typedef float f32x4 __attribute__((ext_vector_type(4)));
typedef float f32x16 __attribute__((ext_vector_type(16)));
typedef unsigned u32x2 __attribute__((ext_vector_type(2)));
typedef unsigned u32x4 __attribute__((ext_vector_type(4)));
typedef __bf16 bf16x2_t __attribute__((ext_vector_type(2)));
#define LAS __attribute__((address_space(3)))
#define DI __device__ __forceinline__

constexpr int S = 16384;
constexpr float EPS = 1e-6f;
constexpr float LOG2E = 1.4426950408889634f;

constexpr size_t SZ_WUPT = (size_t)5632 * 1024 * 2, SZ_WDNT = (size_t)1024 * 2816 * 2;
constexpr size_t O_WUPT1 = 0;
constexpr size_t O_WDNT1 = O_WUPT1 + SZ_WUPT;
constexpr size_t O_WOINT = O_WDNT1 + SZ_WDNT;
constexpr size_t O_WO2T = O_WOINT + (size_t)3072 * 1024 * 2;
constexpr size_t O_ROWSS = O_WO2T + (size_t)1024 * 1024 * 2;
constexpr size_t O_RSQ = O_ROWSS + (size_t)5 * S * 8;
constexpr size_t O_RSKV = O_RSQ + (size_t)S * 4;
constexpr size_t O_CSTAB = O_RSKV + (size_t)S * 4;
constexpr size_t O_CHA = O_CSTAB + (size_t)S * 32 * 4;
constexpr size_t O_CHH = O_CHA + (size_t)256 * 512 * 4;
constexpr size_t O_GB = O_CHH + (size_t)256 * 512 * 4;
constexpr size_t O_GE = O_GB + (size_t)4 * S * 4;
constexpr size_t O_GPM = O_GE + (size_t)4 * S * 4;
constexpr size_t O_BL = O_GPM + (size_t)4 * S * 4;
constexpr size_t O_ML = O_BL + 4096;
constexpr size_t O_MST = O_ML + 4096;
constexpr size_t O_NST = O_MST + 4096;
constexpr size_t O_BAR = O_NST + (size_t)256 * 4 * 128 * 4;
constexpr size_t BAR_BYTES = 16384;
constexpr size_t O_XB = O_BAR + BAR_BYTES;
constexpr size_t XB_ROWS = 16648;
constexpr size_t O_L0W = O_XB + XB_ROWS * 2048;
constexpr size_t O_W1T = O_L0W;
constexpr size_t O_WQT = O_W1T + (size_t)1536 * 1024 * 2;
constexpr size_t O_WKT = O_WQT + (size_t)768 * 256 * 2;
constexpr size_t O_WVT = O_WKT + (size_t)512 * 256 * 2;
constexpr size_t O_WRIT = O_WVT + (size_t)512 * 256 * 2;
constexpr size_t O_WO1T = O_WRIT + (size_t)1024 * 512 * 2;
constexpr size_t O_WUPT0 = O_WO1T + (size_t)1024 * 1024 * 2;
constexpr size_t O_WDNT0 = O_WUPT0 + SZ_WUPT;
constexpr size_t O_ARENA = O_WDNT0 + SZ_WDNT;
constexpr size_t O_Z = O_ARENA;
constexpr size_t O_XC = O_Z + (size_t)S * 1536 * 2;
constexpr size_t O_QB = O_XC + (size_t)S * 512 * 2;
constexpr size_t O_KB = O_QB + (size_t)8 * S * 96 * 2;
constexpr size_t O_VT = O_KB + (size_t)8 * S * 96 * 2;
constexpr size_t O_MIX = O_VT + (size_t)512 * S * 2;
constexpr size_t O_END0 = O_MIX + (size_t)S * 1024 * 2;
constexpr size_t O_ACT = O_ARENA;
constexpr size_t O_RI = O_XB;
constexpr size_t O_CST = O_L0W;
constexpr size_t O_QOK = O_CST + (size_t)256 * 4 * 256 * 128 * 2;
constexpr size_t O_KVT = O_QOK + (size_t)S * 2048 * 2;
constexpr size_t O_END1 = O_KVT + (size_t)1536 * S * 2;
constexpr size_t WS_NEED = (O_END0 > O_END1 ? O_END0 : O_END1);
static_assert(WS_NEED <= (size_t)268435456, "workspace");
static_assert(O_ACT + (size_t)(S + 240) * 2816 * 2 <= (size_t)268435456, "act");

constexpr int LDS_BYTES = 147456;

struct Args {
    const float* in[28];
    float* out;
    unsigned char* ws;
    int pad; int pad2;
};

struct ArgP { const __attribute__((address_space(4))) Args* p;
    DI const float* in(int i) const { return p->in[i]; } DI float* out() const { return p->out; } DI unsigned char* ws() const { return p->ws; } };
DI unsigned pk2(float lo, float hi) { f32x2 v = {lo, hi}; bf16x2_t b = __builtin_convertvector(v, bf16x2_t); return __builtin_bit_cast(unsigned, b); }
DI bf16_t f2bf(float f) { return (bf16_t)(pk2(f, 0.f) & 0xffffu); }
DI int ltid(int wv) { asm volatile("" : "+s"(wv)); int l = __builtin_amdgcn_mbcnt_hi(~0u, __builtin_amdgcn_mbcnt_lo(~0u, 0u)); asm volatile("" : "+v"(l)); return wv * 64 + l; }
DI int lbid() { int t = blockIdx.x; asm volatile("" : "+s"(t)); return t; }
DI float bf2f(bf16_t b) { return __uint_as_float(((unsigned)b) << 16); }
DI float bflo(unsigned u) { return __uint_as_float(u << 16); }
DI float bfhi(unsigned u) { return __uint_as_float(u & 0xffff0000u); }
DI float wave_sum(float v) {
#pragma unroll
    for (int o = 1; o < 64; o <<= 1) v += __shfl_xor(v, o);
    return v;
}
DI float fexp(float x) { return __builtin_amdgcn_exp2f(x * LOG2E); }
DI float sigmoidf_(float x) { return __builtin_amdgcn_rcpf(1.f + fexp(-x)); }
DI int crow(int r, int hi) { return (r & 3) + 8 * (r >> 2) + 4 * hi; }
typedef unsigned long long u64;
DI float rs_from_ss(u64 ssq) { return rsqrtf((float)ssq * (1.f / (1048576.f * 1024.f)) + EPS); }
DI u64 ss_to_fix(float ss) { return (u64)(ss * 1048576.f); }

namespace pg8 {
constexpr int BM = 256, BK = 64, HALF = 128, HTB = HALF * BK * 2, STAGE_BYTES = 8 * HTB, NXCD = 8, WGM = 8;
DI int lds_byte(int r, int c) { const int st = (r >> 4) * 2 + (c >> 5), rr = r & 15, cc = c & 31, ob = rr * 64 + cc * 2; return st * 1024 + (ob ^ (((ob >> 9) & 1) << 5)); }
DI void stage_rc(int b, int& R, int& C) { const int st = b / 1024, sb = b % 1024, swz = sb ^ (((sb >> 9) & 1) << 5); R = (st >> 1) * 16 + swz / 64; C = (st & 1) * 32 + (swz % 64) / 2; }
DI int perm32(int rho) { const int n = rho >> 4, i = rho & 15; return 8 * (i >> 2) + 4 * n + (i & 3); }
struct Unit { int pm, pn; };
struct StaticOrder {
    int nM, nN, nwg, G, c;
    DI void init(int nM_, int nN_, int G_, int c_) { nM = nM_; nN = nN_; nwg = nM * nN; G = G_; c = c_; }
    DI bool next(int i, Unit& u) const {
        const long L = (long)i * G + c; if (L >= nwg) return false;
        int wgid = (int)L; { const int q = nwg / NXCD, r = nwg % NXCD, xcd = wgid % NXCD, off = wgid / NXCD; wgid = (xcd < r ? xcd * (q + 1) : r * (q + 1) + (xcd - r) * q) + off; }
        const int nig = WGM * nN, gid = wgid / nig, fm = gid * WGM, gsz = (nM - fm) < WGM ? (nM - fm) : WGM;
        u.pm = fm + ((wgid % nig) % gsz); u.pn = (wgid % nig) / gsz; return true;
    }
};

template <bool AMAP, class Epi>
DI void gemm_phase(int wv, LAS unsigned char* lds, const bf16_t* A, int lda, const bf16_t* Bt, int ldb, int K_, int nM, int nN, const Epi& E, int rot = 0) {
    int K = K_; asm volatile("" : "+s"(K));
    const int tid = ltid(wv), wid = __builtin_amdgcn_readfirstlane(tid >> 6), lane = tid & 63, wr = wid >> 2, wc = wid & 3, fr = lane & 15, fq = lane >> 4;
    const int nt = K / BK;
    StaticOrder SO; { int c_ = lbid() - rot; if (c_ < 0) c_ += (int)gridDim.x; SO.init(nM, nN, (int)gridDim.x, c_); }
    unsigned voffA[2], voffB[2];
#pragma unroll
    for (int i = 0; i < 2; ++i) { int R, C; stage_rc(tid * 16 + i * 8192, R, C); const int Rb = (R & ~31) + perm32(R & 31);
        const int Ra = AMAP ? (62 * (R >> 6) + (R & 63) - 2) : R;
        voffA[i] = (unsigned)((Ra + (AMAP ? 2 : 0)) * lda + C) * 2u; voffB[i] = (unsigned)(Rb * ldb + C) * 2u; }
    const size_t kstep = (size_t)(BK * 2);
    const size_t hstepA = (size_t)(AMAP ? 124 : 128) * lda * 2, hstepB = (size_t)HALF * ldb * 2;
    const size_t tstepA = 2 * hstepA, tstepB = 2 * hstepB;
    const unsigned ldsw = (unsigned)wid * 1024u;
    const int aoff = lds_byte(wr * 64 + fr, fq * 8), boff = lds_byte(wc * 32 + fr, fq * 8);
#define PG8_SA(b, h) (((b) * 2 + (h)) * HTB)
#define PG8_SB(b, h) ((4 + (b) * 2 + (h)) * HTB)
#define PG8_STAGE(bufoff, gbase, voff) do { _Pragma("unroll") for (int _i = 0; _i < 2; ++_i) \
        __builtin_amdgcn_global_load_lds((const unsigned*)((const char*)(gbase) + (voff)[_i]), (LAS unsigned*)(lds + (bufoff) + ldsw + _i * 8192), 16, 0, 0); } while (0)
#define PG8_LDA(dst, b, h) do { _Pragma("unroll") for (int m = 0; m < 4; ++m) _Pragma("unroll") for (int k = 0; k < 2; ++k) dst[m][k] = *(const LAS bf16x8*)(lds + PG8_SA(b, h) + aoff + m * 2048 + k * 1024); } while (0)
#define PG8_LDB(dst, b, h) do { _Pragma("unroll") for (int n = 0; n < 2; ++n) _Pragma("unroll") for (int k = 0; k < 2; ++k) dst[n][k] = *(const LAS bf16x8*)(lds + PG8_SB(b, h) + boff + n * 2048 + k * 1024); } while (0)
#define PG8_MMA(ai, bj, At, Bt_) do { __builtin_amdgcn_s_setprio(1); _Pragma("unroll") for (int m = 0; m < 4; ++m) _Pragma("unroll") for (int n = 0; n < 2; ++n) _Pragma("unroll") for (int k = 0; k < 2; ++k) \
        acc[ai][bj][m][n] = __builtin_amdgcn_mfma_f32_16x16x32_bf16(Bt_[n][k], At[m][k], acc[ai][bj][m][n], 0, 0, 0); __builtin_amdgcn_s_setprio(0); } while (0)
#define PG8_WAIT_V(n) asm volatile("s_waitcnt vmcnt(" #n ")" ::: "memory")
#define PG8_WAIT_L(n) asm volatile("s_waitcnt lgkmcnt(" #n ")" ::: "memory")
#define PG8_BAR __builtin_amdgcn_s_barrier()
#define PG8_SCHED __builtin_amdgcn_sched_barrier(0)
    if (AMAP) A -= 2 * lda;
    Unit cur, nxt; int ui = 0;
    if (!SO.next(0, cur)) return;
    f32x4 acc[2][2][4][2];
#pragma unroll
    for (int a = 0; a < 2; ++a)
#pragma unroll
        for (int b = 0; b < 2; ++b)
#pragma unroll
            for (int m = 0; m < 4; ++m)
#pragma unroll
                for (int n = 0; n < 2; ++n) acc[a][b][m][n] = (f32x4){0.f, 0.f, 0.f, 0.f};
    bf16x8 At[4][2], B0[2][2], B1[2][2];
    const char* cA = (const char*)A + (size_t)cur.pm * tstepA; const char* cB = (const char*)Bt + (size_t)cur.pn * tstepB;
    PG8_STAGE(PG8_SB(0, 0), cB, voffB); PG8_STAGE(PG8_SB(0, 1), cB + hstepB, voffB); PG8_STAGE(PG8_SA(0, 0), cA, voffA); PG8_STAGE(PG8_SA(0, 1), cA + hstepA, voffA);
    if (wr == 1) PG8_BAR;
    PG8_WAIT_V(2); PG8_BAR;
    PG8_STAGE(PG8_SB(1, 0), cB + kstep, voffB); PG8_STAGE(PG8_SA(1, 0), cA + kstep, voffA); PG8_STAGE(PG8_SB(1, 1), cB + hstepB + kstep, voffB);
    PG8_WAIT_V(6); PG8_BAR;
    for (;;) {
        const bool has_next = SO.next(ui + 1, nxt);
        const char* nA = has_next ? (const char*)A + (size_t)nxt.pm * tstepA : cA; const char* nB = has_next ? (const char*)Bt + (size_t)nxt.pn * tstepB : cB;
        for (int t = 0; t < nt; t += 2) {
            const bool last = (t == nt - 2);
            const char* a1 = cA + (size_t)(t + 1) * kstep;
            const char* a2 = last ? nA : cA + (size_t)(t + 2) * kstep; const char* b2 = last ? nB : cB + (size_t)(t + 2) * kstep;
            const char* a3 = a2 + kstep; const char* b3 = b2 + kstep;
            PG8_LDB(B0, 0, 0); PG8_LDB(B1, 0, 1); PG8_SCHED; PG8_LDA(At, 0, 0); PG8_STAGE(PG8_SA(1, 1), a1 + hstepA, voffA);
            PG8_WAIT_V(8); PG8_WAIT_L(0); PG8_BAR; PG8_MMA(0, 0, At, B0); PG8_MMA(0, 1, At, B1); PG8_BAR; PG8_SCHED;
            PG8_LDA(At, 0, 1); PG8_STAGE(PG8_SB(0, 0), b2, voffB); PG8_STAGE(PG8_SB(0, 1), b2 + hstepB, voffB); PG8_STAGE(PG8_SA(0, 0), a2, voffA);
            PG8_WAIT_V(8); PG8_WAIT_L(0); PG8_BAR; PG8_MMA(1, 0, At, B0); PG8_MMA(1, 1, At, B1); PG8_BAR; PG8_SCHED;
            PG8_LDB(B0, 1, 0); PG8_LDB(B1, 1, 1); PG8_SCHED; PG8_LDA(At, 1, 0); PG8_STAGE(PG8_SA(0, 1), a2 + hstepA, voffA);
            PG8_WAIT_V(8); PG8_WAIT_L(0); PG8_BAR; PG8_MMA(0, 0, At, B0); PG8_MMA(0, 1, At, B1); PG8_BAR; PG8_SCHED;
            PG8_LDA(At, 1, 1); PG8_STAGE(PG8_SB(1, 0), b3, voffB); PG8_STAGE(PG8_SB(1, 1), b3 + hstepB, voffB); PG8_STAGE(PG8_SA(1, 0), a3, voffA);
            PG8_WAIT_V(8); PG8_WAIT_L(0); PG8_BAR; PG8_MMA(1, 0, At, B0); PG8_MMA(1, 1, At, B1); PG8_BAR; PG8_SCHED;
        }
        if (wr == 0) PG8_BAR;
        E(acc, cur, wr, wc, fr, fq);
        if (!has_next) break;
#pragma unroll
        for (int a = 0; a < 2; ++a)
#pragma unroll
            for (int b = 0; b < 2; ++b)
#pragma unroll
                for (int m = 0; m < 4; ++m)
#pragma unroll
                    for (int n = 0; n < 2; ++n) acc[a][b][m][n] = (f32x4){0.f, 0.f, 0.f, 0.f};
        cur = nxt; cA = nA; cB = nB; ++ui;
        if (wr == 1) PG8_BAR;
    }
    PG8_WAIT_V(0);
    PG8_BAR;
#undef PG8_SA
#undef PG8_SB
#undef PG8_STAGE
#undef PG8_LDA
#undef PG8_LDB
#undef PG8_MMA
#undef PG8_WAIT_V
#undef PG8_WAIT_L
#undef PG8_BAR
#undef PG8_SCHED
}
}
using pg8::Unit;
typedef f32x4 AccT[2][2][4][2];

template <int SMODE> struct EpiRowBf16 {
    bf16_t* O; int ldc; const void* sc;
    DI void operator()(const AccT& acc, const Unit& u, int wr, int wc, int fr, int fq) const {
        const int row0 = u.pm * 256 + wr * 64 + fr, col0 = u.pn * 256 + wc * 32 + 8 * fq;
#pragma unroll
        for (int ai = 0; ai < 2; ++ai)
#pragma unroll
            for (int m = 0; m < 4; ++m) { const int row = row0 + ai * 128 + m * 16;
                float s = 1.f; if (SMODE == 1) s = rs_from_ss(((const u64*)sc)[row]); if (SMODE == 2) s = ((const float*)sc)[row];
                bf16_t* rowp = O + (size_t)row * ldc + col0;
#pragma unroll
                for (int bj = 0; bj < 2; ++bj) { const f32x4 v0 = acc[ai][bj][m][0] * s, v1 = acc[ai][bj][m][1] * s;
                    u32x4 w; w.x = pk2(v0[0], v0[1]); w.y = pk2(v0[2], v0[3]); w.z = pk2(v1[0], v1[1]); w.w = pk2(v1[2], v1[3]);
                    *(u32x4*)(rowp + bj * 128) = w; } }
    }
};
template <int SMODE> struct EpiColBf16 {
    bf16_t* O; int ldc; const void* sc;
    DI void operator()(const AccT& acc, const Unit& u, int wr, int wc, int fr, int fq) const {
        const int row0 = u.pm * 256 + wr * 64 + fr, col0 = u.pn * 256 + wc * 32 + 8 * fq;
#pragma unroll
        for (int bj = 0; bj < 2; ++bj) { float s[8];
#pragma unroll
            for (int j = 0; j < 8; ++j) s[j] = (SMODE == 1) ? rs_from_ss(((const u64*)sc)[col0 + bj * 128 + j]) : ((const float*)sc)[col0 + bj * 128 + j];
#pragma unroll
            for (int ai = 0; ai < 2; ++ai)
#pragma unroll
                for (int m = 0; m < 4; ++m) { const int row = row0 + ai * 128 + m * 16; const f32x4 v0 = acc[ai][bj][m][0], v1 = acc[ai][bj][m][1];
                    u32x4 w; w.x = pk2(v0[0] * s[0], v0[1] * s[1]); w.y = pk2(v0[2] * s[2], v0[3] * s[3]); w.z = pk2(v1[0] * s[4], v1[1] * s[5]); w.w = pk2(v1[2] * s[6], v1[3] * s[7]);
                    *(u32x4*)(O + (size_t)row * ldc + col0 + bj * 128) = w; } }
    }
};
struct EpiQ {
    bf16_t* QB; const float* rsq; const float* cstab;
    DI void operator()(const AccT& acc, const Unit& u, int wr, int wc, int fr, int fq) const {
        const int row0 = u.pm * 256 + wr * 64 + fr, col0 = u.pn * 256 + wc * 32 + 8 * fq;
        const float QS = 0.10206207261596577f * LOG2E;
#pragma unroll
        for (int ai = 0; ai < 2; ++ai)
#pragma unroll
            for (int m = 0; m < 4; ++m) { const int t = row0 + ai * 128 + m * 16; const float s = rsq[t] * QS;
#pragma unroll
                for (int bj = 0; bj < 2; ++bj) { const int c = col0 + bj * 128, h = c / 96, d = c - h * 96;
                    f32x4 v0 = acc[ai][bj][m][0] * s, v1 = acc[ai][bj][m][1] * s;
                    if (d >= 64) { const int i0 = (d - 64) >> 1; const f32x4 cs0 = *(const f32x4*)(cstab + (size_t)t * 32 + 2 * i0), cs1 = *(const f32x4*)(cstab + (size_t)t * 32 + 2 * i0 + 4);
                        f32x4 a, b;
                        a[0] = v0[0] * cs0[0] - v0[1] * cs0[1]; a[1] = v0[1] * cs0[0] + v0[0] * cs0[1];
                        a[2] = v0[2] * cs0[2] - v0[3] * cs0[3]; a[3] = v0[3] * cs0[2] + v0[2] * cs0[3];
                        b[0] = v1[0] * cs1[0] - v1[1] * cs1[1]; b[1] = v1[1] * cs1[0] + v1[0] * cs1[1];
                        b[2] = v1[2] * cs1[2] - v1[3] * cs1[3]; b[3] = v1[3] * cs1[2] + v1[2] * cs1[3];
                        v0 = a; v1 = b; }
                    u32x4 w; w.x = pk2(v0[0], v0[1]); w.y = pk2(v0[2], v0[3]); w.z = pk2(v1[0], v1[1]); w.w = pk2(v1[2], v1[3]);
                    *(u32x4*)(QB + ((size_t)h * S + t) * 96 + d) = w; } }
    }
};
struct EpiK {
    bf16_t* KB; const float* rskv;
    DI void operator()(const AccT& acc, const Unit& u, int wr, int wc, int fr, int fq) const {
        const int row0 = u.pm * 256 + wr * 64 + fr, col0 = u.pn * 256 + wc * 32 + 8 * fq;
#pragma unroll
        for (int ai = 0; ai < 2; ++ai)
#pragma unroll
            for (int m = 0; m < 4; ++m) { const int t = row0 + ai * 128 + m * 16; const float s = rskv[t];
#pragma unroll
                for (int bj = 0; bj < 2; ++bj) { const int c = col0 + bj * 128, h = c >> 6, d = c & 63;
                    const f32x4 v0 = acc[ai][bj][m][0] * s, v1 = acc[ai][bj][m][1] * s;
                    u32x4 w; w.x = pk2(v0[0], v0[1]); w.y = pk2(v0[2], v0[3]); w.z = pk2(v1[0], v1[1]); w.w = pk2(v1[2], v1[3]);
                    *(u32x4*)(KB + ((size_t)h * S + t) * 96 + d) = w; } }
    }
};
template <bool RESBF> struct EpiRes {
    const float* res; bf16_t* XB; u64* rowss; int dry;
    DI void operator()(const AccT& acc, const Unit& u, int wr, int wc, int fr, int fq) const {
        const int row0 = u.pm * 256 + wr * 64 + fr, col0 = u.pn * 256 + wc * 32 + 8 * fq;
#pragma unroll
        for (int ai = 0; ai < 2; ++ai)
#pragma unroll
            for (int m = 0; m < 4; ++m) { const int t = row0 + ai * 128 + m * 16; float ss = 0.f;
#pragma unroll
                for (int bj = 0; bj < 2; ++bj) { const size_t o = (size_t)t * 1024 + col0 + bj * 128;
                    f32x4 r0, r1;
                    if (RESBF) { const u32x4 rb = *(const u32x4*)(XB + o); r0 = (f32x4){bflo(rb.x), bfhi(rb.x), bflo(rb.y), bfhi(rb.y)}; r1 = (f32x4){bflo(rb.z), bfhi(rb.z), bflo(rb.w), bfhi(rb.w)}; }
                    else { r0 = *(const f32x4*)(res + o); r1 = *(const f32x4*)(res + o + 4); }
                    const f32x4 v0 = acc[ai][bj][m][0] + r0, v1 = acc[ai][bj][m][1] + r1;
                    u32x4 w; w.x = pk2(v0[0], v0[1]); w.y = pk2(v0[2], v0[3]); w.z = pk2(v1[0], v1[1]); w.w = pk2(v1[2], v1[3]);
                    if (!dry) *(u32x4*)(XB + o) = w;
                    ss += v0[0] * v0[0] + v0[1] * v0[1] + v0[2] * v0[2] + v0[3] * v0[3] + v1[0] * v1[0] + v1[1] * v1[1] + v1[2] * v1[2] + v1[3] * v1[3]; }
                ss += __shfl_xor(ss, 16); ss += __shfl_xor(ss, 32);
                if (fq == 0 && !dry) atomicAdd(rowss + t, ss_to_fix(ss)); }
    }
};
DI float dpp_prev1(float cur, float prevm) {
    const int o = __builtin_amdgcn_update_dpp(0, __builtin_bit_cast(int, prevm), 0x121, 0xf, 0xf, false);
    return __builtin_bit_cast(float, __builtin_amdgcn_update_dpp(o, __builtin_bit_cast(int, cur), 0x111, 0xf, 0xf, false));
}
DI float dpp_prev2(float cur, float prevm) {
    const int o = __builtin_amdgcn_update_dpp(0, __builtin_bit_cast(int, prevm), 0x122, 0xf, 0xf, false);
    return __builtin_bit_cast(float, __builtin_amdgcn_update_dpp(o, __builtin_bit_cast(int, cur), 0x112, 0xf, 0xf, false));
}
struct EpiUp {
    bf16_t* ACT; const u64* rowss; const float* cw; const float* cb; LAS unsigned char* plds;
    DI void operator()(const AccT& acc, const Unit& u, int wr, int wc, int fr, int fq) const {
        const int cl = u.pn * 128 + wc * 32 + 8 * fq;
        LAS float* P = (LAS float*)(plds + (wr * 4 + wc) * 1024);
        { const int lane = fq * 16 + fr, kind = lane >> 3, c4 = 4 * (lane & 7), k3 = kind & 3;
          const float* src = (k3 == 0 ? cb : cw + (k3 - 1) * 5632) + (kind >= 4 ? 2816 : 0) + u.pn * 128 + wc * 32 + c4;
          *(LAS f32x4*)(P + kind * 32 + c4) = *(const f32x4*)src; }
#pragma unroll
        for (int ai = 0; ai < 2; ++ai) {
            const int tok0 = u.pm * 248 + 62 * (2 * ai + wr) - 2 + fr;
            float rs[4];
#pragma unroll
            for (int m = 0; m < 4; ++m) { const int t = tok0 + 16 * m; const int tc = t < 0 ? 0 : (t >= S ? S - 1 : t); const float r = rs_from_ss(rowss[tc]); rs[m] = t < 0 ? 0.f : r; }
            const int row0 = fr < 2 ? (S + 236 + fr) : tok0;
#pragma unroll
            for (int n = 0; n < 2; ++n) {
                const int lc = 8 * fq + 4 * n;
                unsigned wpk[4][2];
#pragma unroll
                for (int jp = 0; jp < 2; ++jp) {
                    const f32x2 bg = *(const LAS f32x2*)(P + lc + 2 * jp), g0 = *(const LAS f32x2*)(P + 32 + lc + 2 * jp), g1 = *(const LAS f32x2*)(P + 64 + lc + 2 * jp), g2 = *(const LAS f32x2*)(P + 96 + lc + 2 * jp);
                    const f32x2 bv = *(const LAS f32x2*)(P + 128 + lc + 2 * jp), v0 = *(const LAS f32x2*)(P + 160 + lc + 2 * jp), v1 = *(const LAS f32x2*)(P + 192 + lc + 2 * jp), v2 = *(const LAS f32x2*)(P + 224 + lc + 2 * jp);
                    f32x2 G[4], V[4];
#pragma unroll
                    for (int m = 0; m < 4; ++m) { G[m] = (f32x2){acc[ai][0][m][n][2 * jp], acc[ai][0][m][n][2 * jp + 1]} * rs[m]; V[m] = (f32x2){acc[ai][1][m][n][2 * jp], acc[ai][1][m][n][2 * jp + 1]} * rs[m]; }
#pragma unroll
                    for (int m = 0; m < 4; ++m) {
                        const f32x2 zz = {0.f, 0.f}; const f32x2 Gp = m ? G[m - 1] : zz, Vp = m ? V[m - 1] : zz;
                        const f32x2 gp1 = {dpp_prev1(G[m].x, Gp.x), dpp_prev1(G[m].y, Gp.y)}, gp2 = {dpp_prev2(G[m].x, Gp.x), dpp_prev2(G[m].y, Gp.y)};
                        const f32x2 vp1 = {dpp_prev1(V[m].x, Vp.x), dpp_prev1(V[m].y, Vp.y)}, vp2 = {dpp_prev2(V[m].x, Vp.x), dpp_prev2(V[m].y, Vp.y)};
                        const f32x2 gc = bg + g0 * gp2 + g1 * gp1 + g2 * G[m];
                        const f32x2 vc = bv + v0 * vp2 + v1 * vp1 + v2 * V[m];
                        const f32x2 xe = gc * (-LOG2E);
                        f32x2 dn = {__builtin_amdgcn_exp2f(xe.x), __builtin_amdgcn_exp2f(xe.y)}; dn = dn + 1.0f;
                        const f32x2 rc = {__builtin_amdgcn_rcpf(dn.x), __builtin_amdgcn_rcpf(dn.y)};
                        const f32x2 rr = gc * rc * vc;
                        wpk[m][jp] = pk2(rr.x, rr.y); }
                }
#pragma unroll
                for (int m = 0; m < 4; ++m) { const int row = m ? tok0 + 16 * m : row0;
                    *(u32x2*)(ACT + (size_t)row * 2816 + cl + 4 * n) = (u32x2){wpk[m][0], wpk[m][1]}; }
                __builtin_amdgcn_sched_barrier(0);
            }
        }
    }
};

template <class F> DI void tr_items(const F& f, int Kdst, int Nrows, bf16_t* WT, LAS float* scr, int gw, int NGW, int lane, int& cum) {
    const int nblk = Nrows / 32, nitems = (Kdst / 64) * nblk;
    int first = (gw - cum) % NGW; if (first < 0) first += NGW; cum = (cum + nitems) % NGW;
    for (int item = first; item < nitems; item += NGW) {
        const int kb = item / nblk, nb = item % nblk, k0 = 64 * kb, n0 = 32 * nb;
        float tv[32];
#pragma unroll
        for (int i = 0; i < 32; ++i) tv[i] = f(k0 + 2 * i + (lane >> 5), n0 + (lane & 31));
#pragma unroll
        for (int i = 0; i < 32; ++i) scr[(2 * i + (lane >> 5)) * 33 + (lane & 31)] = tv[i];
        asm volatile("s_waitcnt lgkmcnt(0)" ::: "memory");
        const int c = lane & 7;
#pragma unroll
        for (int j = 0; j < 4; ++j) { const int n = (lane >> 3) + 8 * j; const LAS float* s = scr + (8 * c) * 33 + n;
            u32x4 o; o.x = pk2(s[0 * 33], s[1 * 33]); o.y = pk2(s[2 * 33], s[3 * 33]); o.z = pk2(s[4 * 33], s[5 * 33]); o.w = pk2(s[6 * 33], s[7 * 33]);
            *(u32x4*)(WT + (size_t)(n0 + n) * Kdst + k0 + 8 * c) = o; }
        asm volatile("s_waitcnt lgkmcnt(0)" ::: "memory");
    }
}
struct FW1 { const float* W; const float* g; DI float operator()(int k, int n) const { return n < 1440 ? W[(size_t)k * 1440 + n] * g[k] : 0.f; } };
struct FWQ { const float* W; const float* g; DI float operator()(int k, int n) const { const int h = n / 96, d = n - h * 96; int c = d; if (d >= 64) { const int r = d - 64; c = 64 + (r >> 1) + 16 * (r & 1); } return W[(size_t)k * 768 + h * 96 + c] * g[k]; } };
struct FWKV { const float* W; const float* g; int off; DI float operator()(int k, int n) const { return k < 128 ? W[(size_t)k * 1024 + (n >> 6) * 128 + off + (n & 63)] * g[k] : 0.f; } };
struct FWRI { const float* Wa; const float* Wx; DI float operator()(int k, int n) const { const float* W = n < 512 ? Wa : Wx; const int ch = n & 511, g = ch >> 6, j = ch & 63; return (k >> 6) == g ? W[(size_t)k * 64 + j] : 0.f; } };
struct FWP { const float* W; int N; DI float operator()(int k, int n) const { return W[(size_t)k * N + n]; } };
struct FWUP { const float* W; const float* g; DI float operator()(int k, int n) const { const int pn = n >> 8, r = n & 255; const int c = r < 128 ? 128 * pn + r : 2816 + 128 * pn + r - 128; return W[(size_t)k * 5632 + c] * g[k]; } };
struct FWOIN { const float* W; const float* g; DI float operator()(int k, int n) const {
    int c; float s = 1.f; if (n < 512) { c = n; s = 0.08838834764831845f; } else if (n < 1536) c = 2048 + (n - 512); else if (n < 2048) c = 512 + (n - 1536); else c = 1024 + (n - 2048);
    return W[(size_t)k * 3080 + c] * g[k] * s; } };

#ifndef PROPART
#define PROPART 7
#endif
DI void phase_prologue(int wv, const ArgP a, LAS unsigned char* lds, int parts) {
    unsigned char* ws = a.ws();
    const int tid = ltid(wv), wave = tid >> 6, lane = tid & 63;
    LAS float* scr = (LAS float*)(lds + wave * 8448);
    const int gw = blockIdx.x * 8 + wave, NGW = gridDim.x * 8; int cum = 0;
    if (parts & 1) {
    { FW1 f{a.in(3), a.in(2)}; tr_items(f, 1024, 1536, (bf16_t*)(ws + O_W1T), scr, gw, NGW, lane, cum); }
    { FWQ f{a.in(12), a.in(11)}; tr_items(f, 256, 768, (bf16_t*)(ws + O_WQT), scr, gw, NGW, lane, cum); }
    { FWKV f{a.in(14), a.in(13), 0}; tr_items(f, 256, 512, (bf16_t*)(ws + O_WKT), scr, gw, NGW, lane, cum); }
    { FWKV f{a.in(14), a.in(13), 64}; tr_items(f, 256, 512, (bf16_t*)(ws + O_WVT), scr, gw, NGW, lane, cum); }
    { FWRI f{a.in(6), a.in(8)}; tr_items(f, 512, 1024, (bf16_t*)(ws + O_WRIT), scr, gw, NGW, lane, cum); }
    { FWP f{a.in(15), 1024}; tr_items(f, 1024, 1024, (bf16_t*)(ws + O_WO1T), scr, gw, NGW, lane, cum); }
    for (int l = 0; l < 2; ++l) {
        { FWUP f{a.in(23) + (size_t)l * 1024 * 5632, a.in(22) + l * 1024}; tr_items(f, 1024, 5632, (bf16_t*)(ws + (l ? O_WUPT1 : O_WUPT0)), scr, gw, NGW, lane, cum); }
        { FWP f{a.in(26) + (size_t)l * 2816 * 1024, 1024}; tr_items(f, 2816, 1024, (bf16_t*)(ws + (l ? O_WDNT1 : O_WDNT0)), scr, gw, NGW, lane, cum); }
    }
    { FWOIN f{a.in(17), a.in(16)}; tr_items(f, 1024, 3072, (bf16_t*)(ws + O_WOINT), scr, gw, NGW, lane, cum); }
    { FWP f{a.in(21), 1024}; tr_items(f, 1024, 1024, (bf16_t*)(ws + O_WO2T), scr, gw, NGW, lane, cum); }
    }
    if (parts & 2) {
    const float* x = a.in(0); bf16_t* XB = (bf16_t*)(ws + O_XB) + 2 * 1024; u64* rowss = (u64*)(ws + O_ROWSS);
#pragma unroll 4
    for (int t = gw; t < S; t += NGW) {
        float ss = 0.f;
#pragma unroll
        for (int j = 0; j < 4; ++j) { const f32x4 v = *(const f32x4*)(x + (size_t)t * 1024 + j * 256 + lane * 4);
            ss += v[0] * v[0] + v[1] * v[1] + v[2] * v[2] + v[3] * v[3];
            u32x2 w; w.x = pk2(v[0], v[1]); w.y = pk2(v[2], v[3]); *(u32x2*)(XB + (size_t)t * 1024 + j * 256 + lane * 4) = w; }
        ss = wave_sum(ss);
        if (lane == 0) rowss[t] = ss_to_fix(ss);
        if (lane >= 1 && lane < 5) rowss[(size_t)lane * S + t] = 0ull;
    }
    }
    if (parts & 4) {
    const int* pos = (const int*)a.in(1); float* cst = (float*)(ws + O_CSTAB);
    for (int e = blockIdx.x * 512 + tid; e < S * 16; e += gridDim.x * 512) { const int t = e >> 4, i = e & 15;
        const float invf = __builtin_amdgcn_exp2f(-(float)i * (13.287712379549449f / 16.f)); const float ang = (float)pos[t] * invf;
        const float k = rintf(ang * 0.15915494309189535f);
        float r = fmaf(-k, 6.28318548202514648f, ang); r = fmaf(-k, -1.7484555e-7f, r);
        const float rr = r * 0.15915494309189535f;
        cst[2 * e] = __builtin_amdgcn_cosf(rr); cst[2 * e + 1] = __builtin_amdgcn_sinf(rr); }
    }
}

DI void phase_l0_prep(int wv, const ArgP a) {
    unsigned char* ws = a.ws();
    const bf16_t* Z = (const bf16_t*)(ws + O_Z); bf16_t* XC = (bf16_t*)(ws + O_XC); bf16_t* KB = (bf16_t*)(ws + O_KB);
    float* rsq = (float*)(ws + O_RSQ); float* rskv = (float*)(ws + O_RSKV); const float* cst = (const float*)(ws + O_CSTAB);
    const float* cw = a.in(4); const float* cb = a.in(5);
    const int tid = ltid(wv), wave = tid >> 6, lane = tid & 63;
#pragma unroll 2
    for (int e = blockIdx.x * 512 + tid; e < S * 64; e += gridDim.x * 512) { const int t = e >> 6, c0 = (e & 63) * 8;
        float acc[8];
#pragma unroll
        for (int j = 0; j < 8; ++j) acc[j] = cb[c0 + j];
#pragma unroll
        for (int k = 0; k < 4; ++k) { const int tt = t - 3 + k; if (tt < 0) continue;
            const u32x4 v = *(const u32x4*)(Z + (size_t)tt * 1536 + c0);
            const f32x4 w0 = *(const f32x4*)(cw + k * 512 + c0), w1 = *(const f32x4*)(cw + k * 512 + c0 + 4);
            acc[0] += w0[0] * bflo(v.x); acc[1] += w0[1] * bfhi(v.x); acc[2] += w0[2] * bflo(v.y); acc[3] += w0[3] * bfhi(v.y);
            acc[4] += w1[0] * bflo(v.z); acc[5] += w1[1] * bfhi(v.z); acc[6] += w1[2] * bflo(v.w); acc[7] += w1[3] * bfhi(v.w); }
        u32x4 o; o.x = pk2(acc[0], acc[1]); o.y = pk2(acc[2], acc[3]); o.z = pk2(acc[4], acc[5]); o.w = pk2(acc[6], acc[7]);
        *(u32x4*)(XC + (size_t)t * 512 + c0) = o; }
#pragma unroll 4
    for (int t = blockIdx.x * 8 + wave; t < S; t += gridDim.x * 8) {
        const bf16_t* zr = Z + (size_t)t * 1536;
        float sq = 0.f, skv = 0.f;
        { const u32x2 v = *(const u32x2*)(zr + 1024 + lane * 4); const float p0 = bflo(v.x), p1 = bfhi(v.x), p2 = bflo(v.y), p3 = bfhi(v.y); sq = p0 * p0 + p1 * p1 + p2 * p2 + p3 * p3; }
        { const unsigned v = *(const unsigned*)(zr + 1280 + lane * 2); const float p0 = bflo(v), p1 = bfhi(v); skv = p0 * p0 + p1 * p1; }
        sq = wave_sum(sq); skv = wave_sum(skv);
        if (lane == 0) { rsq[t] = rsqrtf(sq * (1.f / 256.f) + EPS); rskv[t] = rsqrtf(skv * (1.f / 128.f) + EPS); }
        if (lane < 16) { const float x1 = bf2f(zr[1408 + lane]), x2 = bf2f(zr[1424 + lane]); const float c = cst[(size_t)t * 32 + 2 * lane], s = cst[(size_t)t * 32 + 2 * lane + 1];
            const unsigned w = pk2(x1 * c - x2 * s, x2 * c + x1 * s);
#pragma unroll
            for (int h = 0; h < 8; ++h) *(unsigned*)(KB + ((size_t)h * S + t) * 96 + 64 + 2 * lane) = w; }
    }
}

DI void lru_coeff(float rpre, float ipre, float xc, float sp8, float& av, float& uv) {
    const float r = sigmoidf_(rpre), ig = sigmoidf_(ipre);
    const float la = -sp8 * r;
    av = fexp(la);
    uv = __builtin_amdgcn_sqrtf(fmaxf(1.f - av * av, 0.f)) * (ig * xc);
}
DI void phase_lru_s1(int wv, const ArgP a) {
    unsigned char* ws = a.ws(); const int ch = ltid(wv);
    const bf16_t* RI = (const bf16_t*)(ws + O_RI); const bf16_t* XC = (const bf16_t*)(ws + O_XC);
    float* CHA = (float*)(ws + O_CHA); float* CHH = (float*)(ws + O_CHH);
    const float ba = a.in(7)[ch], bx = a.in(9)[ch]; const float lam = a.in(10)[ch];
    const float sp8 = 8.f * log1pf(expf(-lam));
    for (int c = blockIdx.x; c < 256; c += gridDim.x) {
        float A = 1.f, H = 0.f;
#pragma unroll 8
        for (int i = 0; i < 64; ++i) { const size_t t = (size_t)c * 64 + i;
            float av, uv; lru_coeff(bf2f(RI[t * 1024 + ch]) + ba, bf2f(RI[t * 1024 + 512 + ch]) + bx, bf2f(XC[t * 512 + ch]), sp8, av, uv);
            A *= av; H = av * H + uv; }
        CHA[c * 512 + ch] = A; CHH[c * 512 + ch] = H;
    }
}
DI void phase_lru_s3(int wv, const ArgP a) {
    unsigned char* ws = a.ws(); const int ch = ltid(wv);
    const bf16_t* RI = (const bf16_t*)(ws + O_RI); const bf16_t* XC = (const bf16_t*)(ws + O_XC); const bf16_t* Z = (const bf16_t*)(ws + O_Z);
    const float* CHA = (const float*)(ws + O_CHA); const float* CHH = (const float*)(ws + O_CHH); bf16_t* MIX = (bf16_t*)(ws + O_MIX);
    const float ba = a.in(7)[ch], bx = a.in(9)[ch]; const float lam = a.in(10)[ch];
    const float sp8 = 8.f * log1pf(expf(-lam));
    for (int c = blockIdx.x; c < 256; c += gridDim.x) {
        float H = 0.f;
#pragma unroll 16
        for (int cc = 0; cc < c; ++cc) H = CHA[cc * 512 + ch] * H + CHH[cc * 512 + ch];
#pragma unroll 4
        for (int i = 0; i < 64; ++i) { const size_t t = (size_t)c * 64 + i;
            float av, uv; lru_coeff(bf2f(RI[t * 1024 + ch]) + ba, bf2f(RI[t * 1024 + 512 + ch]) + bx, bf2f(XC[t * 512 + ch]), sp8, av, uv);
            H = av * H + uv;
            const float g = bf2f(Z[t * 1536 + 512 + ch]);
            const float y = 0.7978845608028654f * (g + 0.044715f * g * g * g);
            const float th = 1.f - 2.f * __builtin_amdgcn_rcpf(1.f + fexp(2.f * y));
            MIX[t * 1024 + ch] = f2bf(H * 0.5f * g * (1.f + th)); }
    }
}

constexpr int AT_KROW = 208, AT_VROW = 136, AT_KT = 64 * AT_KROW, AT_VT = 64 * AT_VROW;
DI float rowmax32(const f32x16& p0, const f32x16& p1) {
    float a = fmaxf(fmaxf(p0[0], p0[1]), p1[0]), b = fmaxf(fmaxf(p0[2], p0[3]), p1[1]); a = fmaxf(fmaxf(a, p1[2]), p1[3]);
#pragma unroll
    for (int r = 4; r < 16; r += 4) { a = fmaxf(fmaxf(a, p0[r]), p0[r + 1]); b = fmaxf(fmaxf(b, p0[r + 2]), p0[r + 3]); a = fmaxf(fmaxf(a, p1[r]), p1[r + 1]); b = fmaxf(fmaxf(b, p1[r + 2]), p1[r + 3]); }
    const float m = fmaxf(a, b);
    const auto rr = __builtin_amdgcn_permlane32_swap(__float_as_uint(m), __float_as_uint(m), false, false);
    return fmaxf(__uint_as_float(rr[0]), __uint_as_float(rr[1]));
}
DI void attn_unit(int wv, int h, int qb, const bf16_t* QB, const bf16_t* KB, const bf16_t* VT, bf16_t* MIX, LAS unsigned char* lds) {
    const int tid = ltid(wv), lane = tid & 63, r32 = lane & 31, hi = lane >> 5; const int wid = __builtin_amdgcn_readfirstlane(tid >> 6);
    const int qg = qb * 256 + wid * 32 + r32;
    const bf16_t* Kh = KB + (size_t)h * S * 96; const bf16_t* Vh = VT + (size_t)h * 64 * S;
    bf16x8 qf[6];
    { const bf16_t* qp = QB + ((size_t)h * S + qg) * 96 + 8 * hi;
#pragma unroll
      for (int s = 0; s < 6; ++s) qf[s] = *(const bf16x8*)(qp + 16 * s); }
    f32x16 o0 = {}, o1 = {}, negm = {};
    float mref = 0.f, lrun = 0.f;
    const int NT = 4 * qb + 4, wlim = 4 * qb + (wid >> 1);
    const int kc0 = tid, kkey0 = kc0 / 12, kpart0 = kc0 % 12;
    const int kc1 = tid + 512, kkey1 = kc1 / 12, kpart1 = kc1 % 12;
    const int vdv = tid >> 3, vpart = tid & 7;
    u32x4 rk0, rk1 = {}, rv;
#define AT_LOADK(t_) do { const size_t kb_ = (size_t)(t_) * 64; rk0 = *(const u32x4*)(Kh + (kb_ + kkey0) * 96 + kpart0 * 8); if (tid < 256) rk1 = *(const u32x4*)(Kh + (kb_ + kkey1) * 96 + kpart1 * 8); } while (0)
#define AT_LOADV(t_) do { rv = *(const u32x4*)(Vh + (size_t)vdv * S + (size_t)(t_) * 64 + vpart * 8); } while (0)
#define AT_WRITEK(t_) do { LAS unsigned char* Ks_ = lds + ((t_) & 1) * AT_KT; *(LAS u32x4*)(Ks_ + kkey0 * AT_KROW + kpart0 * 16) = rk0; if (tid < 256) *(LAS u32x4*)(Ks_ + kkey1 * AT_KROW + kpart1 * 16) = rk1; } while (0)
#define AT_WRITEV(t_) do { LAS unsigned char* Vs_ = lds + 2 * AT_KT + ((t_) & 1) * AT_VT; *(LAS u32x2*)(Vs_ + vdv * AT_VROW + vpart * 16) = (u32x2){rv.x, rv.y}; *(LAS u32x2*)(Vs_ + vdv * AT_VROW + vpart * 16 + 8) = (u32x2){rv.z, rv.w}; } while (0)
#define AT_QK(P0, P1, t_) do { const LAS unsigned char* Ks_ = lds + ((t_) & 1) * AT_KT + r32 * AT_KROW + 16 * hi; f32x16 c0_ = negm, c1_ = negm; \
        _Pragma("unroll") for (int s = 0; s < 6; ++s) { const bf16x8 k0_ = *(const LAS bf16x8*)(Ks_ + 32 * s), k1_ = *(const LAS bf16x8*)(Ks_ + 32 * AT_KROW + 32 * s); \
            c0_ = __builtin_amdgcn_mfma_f32_32x32x16_bf16(k0_, qf[s], c0_, 0, 0, 0); c1_ = __builtin_amdgcn_mfma_f32_32x32x16_bf16(k1_, qf[s], c1_, 0, 0, 0); } \
        P0 = c0_; P1 = c1_; } while (0)
#define AT_SM1(P0, P1, MOFF, t_, MASK) do { \
        if (MASK && (t_) == wlim) { const int kbase_ = (t_) * 64 + 4 * hi; \
            _Pragma("unroll") for (int r = 0; r < 16; ++r) { const int kv_ = kbase_ + (r & 3) + 8 * (r >> 2); if (kv_ > qg) P0[r] = -1e30f; if (kv_ + 32 > qg) P1[r] = -1e30f; } } \
        const float d_ = mref - MOFF;                         \
        const float mx_ = rowmax32(P0, P1) - d_;              \
        if ((t_) == 0 || __any(mx_ > 8.f || d_ != 0.f)) { const float dl_ = ((t_) == 0) ? mx_ : fmaxf(mx_, 0.f); mref += dl_; \
            const float sh_ = d_ + dl_; \
            _Pragma("unroll") for (int r = 0; r < 16; ++r) { P0[r] -= sh_; P1[r] -= sh_; } \
            const float al_ = ((t_) == 0) ? 1.f : __builtin_amdgcn_exp2f(-dl_); lrun *= al_;     \
            _Pragma("unroll") for (int r = 0; r < 16; ++r) { o0[r] *= al_; o1[r] *= al_; negm[r] = -mref; } asm volatile("" : "+v"(negm)); } \
    } while (0)
#define AT_SM2(P0, P1, t_) do { \
        float ps_ = 0.f; \
        _Pragma("unroll") for (int r = 0; r < 16; ++r) { P0[r] = __builtin_amdgcn_exp2f(P0[r]); P1[r] = __builtin_amdgcn_exp2f(P1[r]); ps_ += P0[r] + P1[r]; } \
        lrun += ps_; \
        const LAS unsigned char* Vs_ = lds + 2 * AT_KT + ((t_) & 1) * AT_VT + r32 * AT_VROW + 8 * hi; \
        _Pragma("unroll") for (int ks = 0; ks < 4; ++ks) { u32x4 w_; \
            if (ks < 2) { w_.x = pk2(P0[8 * ks], P0[8 * ks + 1]); w_.y = pk2(P0[8 * ks + 2], P0[8 * ks + 3]); w_.z = pk2(P0[8 * ks + 4], P0[8 * ks + 5]); w_.w = pk2(P0[8 * ks + 6], P0[8 * ks + 7]); } \
            else { w_.x = pk2(P1[8 * ks - 16], P1[8 * ks - 15]); w_.y = pk2(P1[8 * ks - 14], P1[8 * ks - 13]); w_.z = pk2(P1[8 * ks - 12], P1[8 * ks - 11]); w_.w = pk2(P1[8 * ks - 10], P1[8 * ks - 9]); } \
            const bf16x8 pa_ = __builtin_bit_cast(bf16x8, w_); \
            const u32x2 a0_ = *(const LAS u32x2*)(Vs_ + 32 * ks), a1_ = *(const LAS u32x2*)(Vs_ + 32 * ks + 16); \
            const u32x2 b0_ = *(const LAS u32x2*)(Vs_ + 32 * AT_VROW + 32 * ks), b1_ = *(const LAS u32x2*)(Vs_ + 32 * AT_VROW + 32 * ks + 16); \
            o0 = __builtin_amdgcn_mfma_f32_32x32x16_bf16(__builtin_bit_cast(bf16x8, (u32x4){a0_.x, a0_.y, a1_.x, a1_.y}), pa_, o0, 0, 0, 0); \
            o1 = __builtin_amdgcn_mfma_f32_32x32x16_bf16(__builtin_bit_cast(bf16x8, (u32x4){b0_.x, b0_.y, b1_.x, b1_.y}), pa_, o1, 0, 0, 0); } \
    } while (0)
#define AT_STEPM(C0, C1, MC, N0, N1, MN, t_) do { \
        AT_WRITEK((t_) + 1); AT_WRITEV(t_); \
        __syncthreads(); \
        AT_LOADK((t_) + 2); AT_LOADV((t_) + 1); \
        AT_SM1(C0, C1, MC, t_, 0); MN = mref; AT_QK(N0, N1, (t_) + 1); AT_SM2(C0, C1, t_); \
    } while (0)
#define AT_STEPB(C0, C1, MC, N0, N1, MN, t_) do { \
        if ((t_) + 1 < NT) AT_WRITEK((t_) + 1); AT_WRITEV(t_); \
        __syncthreads(); \
        if ((t_) + 2 < NT) AT_LOADK((t_) + 2); if ((t_) + 1 < NT) AT_LOADV((t_) + 1); \
        if ((t_) + 1 <= wlim) { MN = mref; AT_QK(N0, N1, (t_) + 1); } \
        if ((t_) <= wlim) { AT_SM1(C0, C1, MC, t_, 1); AT_SM2(C0, C1, t_); } \
    } while (0)
    f32x16 pA0, pA1, pB0 = {}, pB1 = {}; float mA = 0.f, mB = 0.f;
    AT_LOADK(0); AT_WRITEK(0);
    __syncthreads();
    AT_LOADK(1); AT_LOADV(0);
    AT_QK(pA0, pA1, 0);
    int t = 0;
    for (; t < 4 * qb; t += 2) {
        AT_STEPM(pA0, pA1, mA, pB0, pB1, mB, t);
        AT_STEPM(pB0, pB1, mB, pA0, pA1, mA, t + 1);
    }
    for (; t < NT; t += 2) {
        AT_STEPB(pA0, pA1, mA, pB0, pB1, mB, t);
        AT_STEPB(pB0, pB1, mB, pA0, pA1, mA, t + 1);
    }
#undef AT_STEPM
#undef AT_STEPB
#undef AT_LOADK
#undef AT_LOADV
#undef AT_WRITEK
#undef AT_WRITEV
#undef AT_QK
#undef AT_SM1
#undef AT_SM2
    lrun += __shfl_xor(lrun, 32);
    const float inv = 1.f / lrun;
    bf16_t* op = MIX + (size_t)qg * 1024 + 512 + h * 64;
#pragma unroll
    for (int g = 0; g < 4; ++g) { const int dv = 8 * g + 4 * hi;
        u32x2 w; w.x = pk2(o0[4 * g] * inv, o0[4 * g + 1] * inv); w.y = pk2(o0[4 * g + 2] * inv, o0[4 * g + 3] * inv); *(u32x2*)(op + dv) = w;
        u32x2 w2; w2.x = pk2(o1[4 * g] * inv, o1[4 * g + 1] * inv); w2.y = pk2(o1[4 * g + 2] * inv, o1[4 * g + 3] * inv); *(u32x2*)(op + 32 + dv) = w2; }
    __syncthreads();
}
DI void phase_attn(int wv, const ArgP a, LAS unsigned char* lds) {
    unsigned char* ws = a.ws();
    const bf16_t* QB = (const bf16_t*)(ws + O_QB); const bf16_t* KB = (const bf16_t*)(ws + O_KB); const bf16_t* VT = (const bf16_t*)(ws + O_VT); bf16_t* MIX = (bf16_t*)(ws + O_MIX);
    for (int b = blockIdx.x; b < 256; b += gridDim.x) {
        const int v = (b & 7) * 32 + (b >> 3), h = v >> 5, s = v & 31;
        attn_unit(wv, h, 63 - s, QB, KB, VT, MIX, lds);
        attn_unit(wv, h, s, QB, KB, VT, MIX, lds);
    }
}

DI void phase_m_gates(int wv, const ArgP a, LAS unsigned char* lds) {
    unsigned char* ws = a.ws(); const int tid = ltid(wv), wave = tid >> 6, lane = tid & 63;
    const bf16_t* XBr = (const bf16_t*)(ws + O_XB) + 2 * 1024; const u64* rowss = (const u64*)(ws + O_ROWSS) + 2 * S;
    const float* Wg = a.in(17); const float* gn = a.in(16);
    LAS float* wgs = (LAS float*)lds;
    LAS float* pre = (LAS float*)(lds + 32768);
    float* GB = (float*)(ws + O_GB); float* GE = (float*)(ws + O_GE); float* GPM = (float*)(ws + O_GPM);
    float* BL = (float*)(ws + O_BL); float* ML = (float*)(ws + O_ML);
    for (int e = tid; e < 8192; e += 512) { const int k = e >> 3, j = e & 7; wgs[j * 1024 + k] = Wg[(size_t)k * 3080 + 3072 + j] * gn[k]; }
    __syncthreads();
    for (int c = blockIdx.x; c < 256; c += gridDim.x) {
#pragma unroll 4
        for (int i = 0; i < 8; ++i) { const int t = c * 64 + wave * 8 + i;
            float acc[8];
#pragma unroll
            for (int j = 0; j < 8; ++j) acc[j] = 0.f;
#pragma unroll
            for (int jj = 0; jj < 4; ++jj) { const int k0 = jj * 256 + lane * 4; const u32x2 hb = *(const u32x2*)(XBr + (size_t)t * 1024 + k0); const f32x4 hv = {bflo(hb.x), bfhi(hb.x), bflo(hb.y), bfhi(hb.y)};
#pragma unroll
                for (int j = 0; j < 8; ++j) { const f32x4 wj = *(const LAS f32x4*)(wgs + j * 1024 + k0); acc[j] += hv[0] * wj[0] + hv[1] * wj[1] + hv[2] * wj[2] + hv[3] * wj[3]; } }
            const float rs = rs_from_ss(rowss[t]);
            { const bool b5 = lane & 32, b4 = lane & 16, b3 = lane & 8;
#pragma unroll
              for (int j = 0; j < 4; ++j) { const float snd = b5 ? acc[j] : acc[j + 4], kp = b5 ? acc[j + 4] : acc[j]; acc[j] = kp + __shfl_xor(snd, 32); }
#pragma unroll
              for (int j = 0; j < 2; ++j) { const float snd = b4 ? acc[j] : acc[j + 2], kp = b4 ? acc[j + 2] : acc[j]; acc[j] = kp + __shfl_xor(snd, 16); }
              { const float snd = b3 ? acc[0] : acc[1], kp = b3 ? acc[1] : acc[0]; acc[0] = kp + __shfl_xor(snd, 8); }
              acc[0] += __shfl_xor(acc[0], 4); acc[0] += __shfl_xor(acc[0], 2); acc[0] += __shfl_xor(acc[0], 1);
              if ((lane & 7) == 0) pre[(wave * 8 + i) * 8 + (b5 ? 4 : 0) + (b4 ? 2 : 0) + (b3 ? 1 : 0)] = acc[0] * rs; }
        }
        __syncthreads();
        if (wave < 4) { const int h = wave; const float bi = a.in(18)[h], bfg = a.in(19)[h];
            const float ig = 15.f * tanhf((pre[lane * 8 + h] + bi) * (1.f / 15.f));
            const float fg = 15.f * tanhf((pre[lane * 8 + 4 + h] + bfg) * (1.f / 15.f));
            float b = -log1pf(expf(-fg));
#pragma unroll
            for (int o = 1; o < 64; o <<= 1) { const float v = __shfl_up(b, o); if (lane >= o) b += v; }
            const float e = ig - b; float pm = e;
#pragma unroll
            for (int o = 1; o < 64; o <<= 1) { const float v = __shfl_up(pm, o); if (lane >= o) pm = fmaxf(pm, v); }
            const size_t o_ = (size_t)h * S + c * 64 + lane; GB[o_] = b; GE[o_] = e; GPM[o_] = pm;
            if (lane == 63) { BL[c * 4 + h] = b; ML[c * 4 + h] = b + pm; } }
        __syncthreads();
    }
}
DI void phase_m_dc(int wv, const ArgP a) {
    unsigned char* ws = a.ws(); const int tid = ltid(wv), lane = tid & 63, r32 = lane & 31, hi = lane >> 5; const int w = __builtin_amdgcn_readfirstlane(tid >> 6);
    const float* BL = (const float*)(ws + O_BL); const float* ML = (const float*)(ws + O_ML); float* NST = (float*)(ws + O_NST);
    const float* GE = (const float*)(ws + O_GE); const bf16_t* KVT = (const bf16_t*)(ws + O_KVT); bf16_t* CST = (bf16_t*)(ws + O_CST);
    for (int u = blockIdx.x; u < 1024; u += gridDim.x) {
        const int c = u >> 2, h = u & 3; const size_t t0 = (size_t)c * 64;
        const float emax = ML[c * 4 + h] - BL[c * 4 + h];
        bf16x8 bfr[4];
        { const bf16_t* vp = KVT + (size_t)(512 + h * 256 + 32 * w + r32) * S + t0 + 8 * hi; const float* gp = GE + (size_t)h * S + t0 + 8 * hi;
#pragma unroll
          for (int ks = 0; ks < 4; ++ks) { const u32x4 v = *(const u32x4*)(vp + 16 * ks); const f32x4 e0 = *(const f32x4*)(gp + 16 * ks), e1 = *(const f32x4*)(gp + 16 * ks + 4);
              u32x4 o; o.x = pk2(bflo(v.x) * fexp(e0[0] - emax), bfhi(v.x) * fexp(e0[1] - emax)); o.y = pk2(bflo(v.y) * fexp(e0[2] - emax), bfhi(v.y) * fexp(e0[3] - emax));
              o.z = pk2(bflo(v.z) * fexp(e1[0] - emax), bfhi(v.z) * fexp(e1[1] - emax)); o.w = pk2(bflo(v.w) * fexp(e1[2] - emax), bfhi(v.w) * fexp(e1[3] - emax));
              bfr[ks] = __builtin_bit_cast(bf16x8, o); } }
        const bf16_t* kp = KVT + (size_t)(h * 128 + r32) * S + t0 + 8 * hi;
        bf16_t* op = CST + ((size_t)(c * 4 + h) * 256 + 32 * w + r32) * 128 + 4 * hi;
#pragma unroll
        for (int rb = 0; rb < 4; ++rb) { f32x16 acc = {};
#pragma unroll
            for (int ks = 0; ks < 4; ++ks) { const bf16x8 ka = *(const bf16x8*)(kp + (size_t)(32 * rb) * S + 16 * ks); acc = __builtin_amdgcn_mfma_f32_32x32x16_bf16(ka, bfr[ks], acc, 0, 0, 0); }
#pragma unroll
            for (int g = 0; g < 4; ++g) { u32x2 o; o.x = pk2(acc[4 * g], acc[4 * g + 1]); o.y = pk2(acc[4 * g + 2], acc[4 * g + 3]); *(u32x2*)(op + 32 * rb + 8 * g) = o; } }
        if (tid < 128) { const bf16_t* kr = KVT + (size_t)(h * 128 + tid) * S + t0; const float* gp = GE + (size_t)h * S + t0; float s = 0.f;
#pragma unroll
            for (int p = 0; p < 8; ++p) { const u32x4 v = *(const u32x4*)(kr + 8 * p); const f32x4 e0 = *(const f32x4*)(gp + 8 * p), e1 = *(const f32x4*)(gp + 8 * p + 4);
                s += bflo(v.x) * fexp(e0[0] - emax) + bfhi(v.x) * fexp(e0[1] - emax) + bflo(v.y) * fexp(e0[2] - emax) + bfhi(v.y) * fexp(e0[3] - emax)
                   + bflo(v.z) * fexp(e1[0] - emax) + bfhi(v.z) * fexp(e1[1] - emax) + bflo(v.w) * fexp(e1[2] - emax) + bfhi(v.w) * fexp(e1[3] - emax); }
            NST[(size_t)(c * 4 + h) * 128 + tid] = s; }
    }
}
DI void phase_m_comb(int wv, const ArgP a, LAS unsigned char* lds, int dry) {
    unsigned char* ws = a.ws(); const int tid = ltid(wv);
    const float* BL = (const float*)(ws + O_BL); const float* ML = (const float*)(ws + O_ML); float* MST = (float*)(ws + O_MST); float* NST = (float*)(ws + O_NST);
    bf16_t* CST = (bf16_t*)(ws + O_CST);
    LAS float* bls = (LAS float*)lds; LAS float* mls = bls + 1024; LAS float* ga = mls + 1024; LAS float* gb = ga + 1024;
    for (int e = tid; e < 1024; e += 512) { bls[e] = BL[e]; mls[e] = ML[e]; }
    __syncthreads();
    if (tid < 256) { const int h = tid >> 6, l = tid & 63;
        float a_ = 0.f, b_ = -1e30f;
#pragma unroll
        for (int k = 0; k < 4; ++k) { const float bl = bls[(4 * l + k) * 4 + h], ml = mls[(4 * l + k) * 4 + h]; a_ += bl; b_ = fmaxf(b_ + bl, ml); }
        float pa = a_, pb = b_;
#pragma unroll
        for (int o = 1; o < 64; o <<= 1) { const float qa = __shfl_up(pa, o), qb = __shfl_up(pb, o); if (l >= o) { pb = fmaxf(qb + pa, pb); pa = qa + pa; } }
        float ea = __shfl_up(pa, 1), eb_ = __shfl_up(pb, 1); if (l == 0) { ea = 0.f; eb_ = -1e30f; }
        float m = fmaxf(0.f + ea, eb_);
#pragma unroll
        for (int k = 0; k < 4; ++k) { const int c = 4 * l + k; const float bl = bls[c * 4 + h], ml = mls[c * 4 + h]; const float mn = fmaxf(bl + m, ml);
            ga[c * 4 + h] = fexp(bl + m - mn); gb[c * 4 + h] = fexp(ml - mn);
            if (blockIdx.x == 0 && !dry) MST[c * 4 + h] = m;
            m = mn; } }
    __syncthreads();
    for (int eb = blockIdx.x; eb < 129; eb += gridDim.x) {
        if (eb < 128) { const int h = eb >> 5; unsigned* p = (unsigned*)(CST + (size_t)h * 32768 + (size_t)(eb & 31) * 1024 + 2 * tid); float C0 = 0.f, C1 = 0.f;
            for (int c = 0; c < 256; c += 64) { unsigned d[64];
#pragma unroll
                for (int k = 0; k < 64; ++k) d[k] = p[(size_t)(c + k) * 65536];
#pragma unroll
                for (int k = 0; k < 64; ++k) { if (!dry) p[(size_t)(c + k) * 65536] = pk2(C0, C1); const float a_ = ga[(c + k) * 4 + h], b_ = gb[(c + k) * 4 + h]; C0 = a_ * C0 + b_ * bflo(d[k]); C1 = a_ * C1 + b_ * bfhi(d[k]); } }
        } else { const int h = tid >> 7; float* p = NST + tid; float C = 0.f;
            for (int c = 0; c < 256; c += 8) { float d[8];
#pragma unroll
                for (int k = 0; k < 8; ++k) d[k] = p[(size_t)(c + k) * 512];
#pragma unroll
                for (int k = 0; k < 8; ++k) { if (!dry) p[(size_t)(c + k) * 512] = C; C = ga[(c + k) * 4 + h] * C + gb[(c + k) * 4 + h] * d[k]; } } }
    }
    __syncthreads();
}
constexpr int MC_QROW = 272, MC_SROW = 144;
constexpr int MC_QS = 0, MC_KS = 64 * MC_QROW, MC_SC = 2 * 64 * MC_QROW, MC_F = MC_SC + 64 * MC_SROW;
DI void phase_m_out(int wv, const ArgP a, LAS unsigned char* lds, int dry) {
    unsigned char* ws = a.ws(); const int tid = ltid(wv), lane = tid & 63, r32 = lane & 31, hi = lane >> 5; const int w = __builtin_amdgcn_readfirstlane(tid >> 6);
    bf16_t* QOK = (bf16_t*)(ws + O_QOK); const bf16_t* KVT = (const bf16_t*)(ws + O_KVT); const bf16_t* CST = (const bf16_t*)(ws + O_CST);
    const float* GB = (const float*)(ws + O_GB); const float* GE = (const float*)(ws + O_GE); const float* GPM = (const float*)(ws + O_GPM);
    const float* MST = (const float*)(ws + O_MST); const float* NST = (const float*)(ws + O_NST); const float* ong = a.in(20);
    LAS unsigned char* Qs = lds + MC_QS; LAS unsigned char* Ks = lds + MC_KS; LAS unsigned char* Sc = lds + MC_SC;
    LAS float* F = (LAS float*)(lds + MC_F);
    LAS float* f_b = F, *f_e = F + 64, *f_m = F + 128, *f_g = F + 192, *f_qn = F + 256, *f_ps = F + 320  , *f_n = F + 576  , *f_part = F + 704  ;
    for (int u = blockIdx.x; u < 1024; u += gridDim.x) {
        const int c = u >> 2, h = u & 3; const size_t t0 = (size_t)c * 64;
        for (int e = tid; e < 1024; e += 512) { const int r = e >> 4, p = e & 15;
            *(LAS u32x4*)(Qs + r * MC_QROW + p * 16) = *(const u32x4*)(QOK + (t0 + r) * 2048 + h * 128 + p * 8);
            *(LAS u32x4*)(Ks + r * MC_QROW + p * 16) = *(const u32x4*)(QOK + (t0 + r) * 2048 + 1536 + h * 128 + p * 8); }
        if (tid < 64) { const float mstv = MST[c * 4 + h]; const float b = GB[(size_t)h * S + t0 + tid], e = GE[(size_t)h * S + t0 + tid], pm = GPM[(size_t)h * S + t0 + tid];
            const float m = b + fmaxf(mstv, pm); f_b[tid] = b; f_e[tid] = e; f_m[tid] = m; f_g[tid] = fexp(b + mstv - m); }
        if (tid >= 64 && tid < 192) f_n[tid - 64] = NST[(size_t)(c * 4 + h) * 128 + tid - 64];
        __syncthreads();
        if (w < 4) {
            const int sb = w & 1, tb = w >> 1; const int tl = 32 * tb + r32;
            f32x16 x = {};
#pragma unroll
            for (int ks = 0; ks < 8; ++ks) {
                const bf16x8 ka = *(const LAS bf16x8*)(Ks + (32 * sb + r32) * MC_QROW + (16 * ks + 8 * hi) * 2);
                const bf16x8 qb = *(const LAS bf16x8*)(Qs + tl * MC_QROW + (16 * ks + 8 * hi) * 2);
                x = __builtin_amdgcn_mfma_f32_32x32x16_bf16(ka, qb, x, 0, 0, 0); }
            const float bt = f_b[tl], mt = f_m[tl]; float ps = 0.f;
#pragma unroll
            for (int g = 0; g < 4; ++g) { float v[4];
#pragma unroll
                for (int j = 0; j < 4; ++j) { const int sl = 32 * sb + 8 * g + 4 * hi + j; const float wgt = (sl <= tl) ? fexp(bt + f_e[sl] - mt) : 0.f; v[j] = x[4 * g + j] * wgt; ps += v[j]; }
                u32x2 o; o.x = pk2(v[0], v[1]); o.y = pk2(v[2], v[3]);
                *(LAS u32x2*)(Sc + tl * MC_SROW + (32 * sb + 8 * g + 4 * hi) * 2) = o; }
            f_ps[(sb * 2 + hi) * 64 + tl] = ps;
        } else {
            const int tl = 16 * (w - 4) + (lane >> 2), qq = lane & 3; float s = 0.f;
#pragma unroll
            for (int p = 0; p < 4; ++p) { const u32x4 v = *(const LAS u32x4*)(Qs + tl * MC_QROW + (32 * qq + 8 * p) * 2); LAS float* np = f_n + 32 * qq + 8 * p;
                s += bflo(v.x) * np[0] + bfhi(v.x) * np[1] + bflo(v.y) * np[2] + bfhi(v.y) * np[3] + bflo(v.z) * np[4] + bfhi(v.z) * np[5] + bflo(v.w) * np[6] + bfhi(v.w) * np[7]; }
            s += __shfl_xor(s, 1); s += __shfl_xor(s, 2);
            if (qq == 0) f_qn[tl] = s;
        }
        __syncthreads();
        f32x16 acc0 = {}, acc1 = {};
        { const bf16_t* cp = CST + ((size_t)(c * 4 + h) * 256 + 32 * w + r32) * 128 + 8 * hi;
#pragma unroll
          for (int ks = 0; ks < 8; ++ks) { const bf16x8 ca = *(const bf16x8*)(cp + 16 * ks);
              const bf16x8 q0 = *(const LAS bf16x8*)(Qs + r32 * MC_QROW + (16 * ks + 8 * hi) * 2), q1 = *(const LAS bf16x8*)(Qs + (32 + r32) * MC_QROW + (16 * ks + 8 * hi) * 2);
              acc0 = __builtin_amdgcn_mfma_f32_32x32x16_bf16(ca, q0, acc0, 0, 0, 0); acc1 = __builtin_amdgcn_mfma_f32_32x32x16_bf16(ca, q1, acc1, 0, 0, 0); } }
        const float g0 = f_g[r32], g1 = f_g[32 + r32];
#pragma unroll
        for (int r = 0; r < 16; ++r) { acc0[r] *= g0; acc1[r] *= g1; }
        { const bf16_t* vp = KVT + (size_t)(512 + h * 256 + 32 * w + r32) * S + t0 + 8 * hi;
#pragma unroll
          for (int ks = 0; ks < 4; ++ks) { const bf16x8 va = *(const bf16x8*)(vp + 16 * ks);
              const bf16x8 s0 = *(const LAS bf16x8*)(Sc + r32 * MC_SROW + (16 * ks + 8 * hi) * 2), s1 = *(const LAS bf16x8*)(Sc + (32 + r32) * MC_SROW + (16 * ks + 8 * hi) * 2);
              acc0 = __builtin_amdgcn_mfma_f32_32x32x16_bf16(va, s0, acc0, 0, 0, 0); acc1 = __builtin_amdgcn_mfma_f32_32x32x16_bf16(va, s1, acc1, 0, 0, 0); } }
        float inv[2];
#pragma unroll
        for (int tb = 0; tb < 2; ++tb) { const int tl = 32 * tb + r32;
            const float den = f_g[tl] * f_qn[tl] + f_ps[tl] + f_ps[64 + tl] + f_ps[128 + tl] + f_ps[192 + tl];
            inv[tb] = 1.f / fmaxf(fabsf(den), fexp(-f_m[tl])); }
        float ss0 = 0.f, ss1 = 0.f;
#pragma unroll
        for (int r = 0; r < 16; ++r) { acc0[r] *= inv[0]; acc1[r] *= inv[1]; ss0 += acc0[r] * acc0[r]; ss1 += acc1[r] * acc1[r]; }
        ss0 += __shfl_xor(ss0, 32); ss1 += __shfl_xor(ss1, 32);
        if (hi == 0) { f_part[w * 64 + r32] = ss0; f_part[w * 64 + 32 + r32] = ss1; }
        __syncthreads();
        float rn[2];
#pragma unroll
        for (int tb = 0; tb < 2; ++tb) { float s = 0.f;
#pragma unroll
            for (int ww = 0; ww < 8; ++ww) s += f_part[ww * 64 + 32 * tb + r32];
            rn[tb] = rsqrtf(s * (1.f / 256.f) + EPS); }
#pragma unroll
        for (int tb = 0; tb < 2; ++tb) { bf16_t* op = QOK + (t0 + 32 * tb + r32) * 2048 + 512 + h * 256 + 32 * w;
#pragma unroll
            for (int g = 0; g < 4; ++g) { const int dv = 8 * g + 4 * hi; const u32x2 ov = *(const u32x2*)(op + dv);
                const f32x4 gg = *(const f32x4*)(ong + h * 256 + 32 * w + dv);
                const float og[4] = {bflo(ov.x), bfhi(ov.x), bflo(ov.y), bfhi(ov.y)}; float y[4];
#pragma unroll
                for (int j = 0; j < 4; ++j) { const float hv = (tb ? acc1[4 * g + j] : acc0[4 * g + j]) * rn[tb]; y[j] = hv * gg[j] * sigmoidf_(og[j]); }
                u32x2 o; o.x = pk2(y[0], y[1]); o.y = pk2(y[2], y[3]); if (!dry) *(u32x2*)(op + dv) = o; } }
        __syncthreads();
    }
}

DI void phase_final(int wv, const ArgP a) {
    float* out = a.out(); const u64* rowss = (const u64*)(a.ws() + O_ROWSS) + 4 * S; const float* g = a.in(27); const bf16_t* XBr = (const bf16_t*)(a.ws() + O_XB) + 2 * 1024;
    for (size_t e = (size_t)blockIdx.x * 512 + ltid(wv); e < (size_t)S * 128; e += (size_t)gridDim.x * 512) { const int t = (int)(e >> 7), c = (int)(e & 127) * 8;
        const float rs = rs_from_ss(rowss[t]); const u32x4 hb = *(const u32x4*)(XBr + (size_t)t * 1024 + c); const f32x4 g0 = *(const f32x4*)(g + c), g1 = *(const f32x4*)(g + c + 4);
        const f32x4 v0 = (f32x4){bflo(hb.x), bfhi(hb.x), bflo(hb.y), bfhi(hb.y)} * rs * g0, v1 = (f32x4){bflo(hb.z), bfhi(hb.z), bflo(hb.w), bfhi(hb.w)} * rs * g1;
        *(f32x4*)(out + (size_t)t * 1024 + c) = v0; *(f32x4*)(out + (size_t)t * 1024 + c + 4) = v1; }
}

#ifndef DIS
#define DIS 0u
#endif
#ifndef REP
#define REP 0u
#endif
#ifndef XSYNC
#define XSYNC 0
#endif

#define XB_TMO      128
#define XB_XCNT(j)  (256  + 64 * (j))
#define XB_XSUB(j)  (1280 + 64 * (j))
#define XB_XGEN(j)  (2304 + 64 * (j))
#define XB_TOP      3328
#define XB_TOPGEN   3392
#define XB_SPIN_CAP (1u << 18)
DI unsigned xb_ld(unsigned* p) { return __hip_atomic_load(p, __ATOMIC_RELAXED, __HIP_MEMORY_SCOPE_AGENT); }
DI unsigned xb_add(unsigned* p, unsigned v) { return __hip_atomic_fetch_add(p, v, __ATOMIC_RELAXED, __HIP_MEMORY_SCOPE_AGENT); }
DI unsigned xb_xcc_id() { return (unsigned)__builtin_amdgcn_s_getreg((3 << 11) | 20) & 0xFu; }
#define XB_SPIN(cond, bar) do { unsigned _sp = 0; while (cond) { __builtin_amdgcn_s_sleep(1); \
    if ((++_sp & 255u) == 0u) { if (xb_ld(&(bar)[XB_TMO])) break; if (_sp > XB_SPIN_CAP) { atomicAdd(&(bar)[XB_TMO], 1u); break; } } } } while (0)
DI void xcd_barrier_complete(unsigned* bar, unsigned x, unsigned& nloc, unsigned& nx) {
    const unsigned G = gridDim.x;
    unsigned sum, cnt, mine, sp = 0u;
    for (;;) {
        sum = 0u; cnt = 0u; mine = 0u;
#pragma unroll
        for (unsigned j = 0; j < 16; ++j) { const unsigned c = xb_ld(&bar[XB_XCNT(j)]); sum += c; cnt += (c > 0u) ? 1u : 0u; mine = (j == x) ? c : mine; }
        if (sum == G) break;
        __builtin_amdgcn_s_sleep(1);
        if ((++sp & 255u) == 0u) { if (xb_ld(&bar[XB_TMO])) break; if (sp > XB_SPIN_CAP) { atomicAdd(&bar[XB_TMO], 1u); break; } }
    }
    nloc = mine > 0u ? mine : 1u; nx = cnt > 0u ? cnt : 1u;
}
DI void xcd_barrier(int wv, unsigned* bar, volatile LAS unsigned* st) {
    asm volatile("s_waitcnt vmcnt(0)" ::: "memory");
    __syncthreads();
    if (ltid(wv) == 0) {
        const unsigned x = xb_xcc_id();
        __builtin_amdgcn_s_waitcnt(0);
        unsigned nloc = st[0], nx = st[1];
        if (nloc == 0u) { xcd_barrier_complete(bar, x, nloc, nx); st[0] = nloc; st[1] = nx; }
        const unsigned old = xb_add(&bar[XB_XSUB(x)], 1u);
        const unsigned gen = old / nloc;
        if (old + 1u == (gen + 1u) * nloc) {
            __builtin_amdgcn_fence(__ATOMIC_RELEASE, "agent");
            asm volatile("s_waitcnt vmcnt(0)" ::: "memory");
            const unsigned og = xb_add(&bar[XB_TOP], 1u);
            const unsigned tg = og / nx;
            if (og + 1u == (tg + 1u) * nx) xb_add(&bar[XB_TOPGEN], 1u);
            else XB_SPIN(xb_ld(&bar[XB_TOPGEN]) == tg, bar);
            __builtin_amdgcn_fence(__ATOMIC_ACQUIRE, "agent");
            xb_add(&bar[XB_XGEN(x)], 1u);
            asm volatile("s_waitcnt vmcnt(0)" ::: "memory");
        } else {
            XB_SPIN(xb_ld(&bar[XB_XGEN(x)]) == gen, bar);
            __builtin_amdgcn_fence(__ATOMIC_ACQUIRE, "agent");
            asm volatile("s_waitcnt vmcnt(0)" ::: "memory");
        }
    }
    __syncthreads();
}
DI ArgP getargs() { ArgP r; r.p = (const __attribute__((address_space(4))) Args*)__builtin_amdgcn_kernarg_segment_ptr(); asm volatile("" : "+s"(r.p)); return r; }
#define WSB (getargs().ws())
#define XBP ((bf16_t*)(getargs().ws() + O_XB) + 2 * 1024)
#define RSS ((u64*)(getargs().ws() + O_ROWSS))
#define HFP (getargs().out())
__global__ void __launch_bounds__(512, 2) fwd_kernel(Args a_unused) {
    extern __shared__ __attribute__((aligned(16))) unsigned char shm[];
    LAS unsigned char* lds = (LAS unsigned char*)shm;
    const int wv = __builtin_amdgcn_readfirstlane(threadIdx.x >> 6);
#define BARW ((unsigned*)(getargs().ws() + O_BAR))
#define BARST ((volatile LAS unsigned*)(lds + 139264))
#define GSYNC() xcd_barrier(wv, BARW, BARST)
    { unsigned* barw0 = BARW; if (threadIdx.x == 0) { BARST[0] = 0u; BARST[1] = 0u; (void)xb_add(&barw0[XB_XCNT(xb_xcc_id())], 1u); } }
    if (getargs().p->pad == 0x7fffffff) cg::this_grid().sync();

#if !(DIS & (1u << 0))
    for (int rep_ = 0; rep_ < ((REP >> 0) & 1u) + 1; ++rep_) { const int dry_ = rep_ < (int)((REP >> 0) & 1u); (void)dry_;
    phase_prologue(wv, getargs(), lds, dry_ ? PROPART : 7);
    }
#endif
    GSYNC();
#if !(DIS & (1u << 1))
    for (int rep_ = 0; rep_ < ((REP >> 1) & 1u) + 1; ++rep_) { const int dry_ = rep_ < (int)((REP >> 1) & 1u); (void)dry_;
    { EpiRowBf16<1> E{(bf16_t*)(WSB + O_Z), 1536, RSS};
      pg8::gemm_phase<false>(wv, lds, XBP, 1024, (const bf16_t*)(WSB + O_W1T), 1024, 1024, 64, 6, E); }
    }
#endif
    GSYNC();
#if !(DIS & (1u << 2))
    for (int rep_ = 0; rep_ < ((REP >> 2) & 1u) + 1; ++rep_) { const int dry_ = rep_ < (int)((REP >> 2) & 1u); (void)dry_;
    phase_l0_prep(wv, getargs());
    }
#endif
    GSYNC();
#if !(DIS & (1u << 3))
    for (int rep_ = 0; rep_ < ((REP >> 3) & 1u) + 1; ++rep_) { const int dry_ = rep_ < (int)((REP >> 3) & 1u); (void)dry_;
    { EpiRowBf16<0> E{(bf16_t*)(WSB + O_RI), 1024, nullptr};
      pg8::gemm_phase<false>(wv, lds, (const bf16_t*)(WSB + O_XC), 512, (const bf16_t*)(WSB + O_WRIT), 512, 512, 64, 4, E); }
    }
#endif
#if !(DIS & (1u << 4))
    for (int rep_ = 0; rep_ < ((REP >> 4) & 1u) + 1; ++rep_) { const int dry_ = rep_ < (int)((REP >> 4) & 1u); (void)dry_;
    { EpiQ E{(bf16_t*)(WSB + O_QB), (const float*)(WSB + O_RSQ), (const float*)(WSB + O_CSTAB)};
      pg8::gemm_phase<false>(wv, lds, (const bf16_t*)(WSB + O_Z) + 1024, 1536, (const bf16_t*)(WSB + O_WQT), 256, 256, 64, 3, E); }
    }
#endif
#if !(DIS & (1u << 5))
    for (int rep_ = 0; rep_ < ((REP >> 5) & 1u) + 1; ++rep_) { const int dry_ = rep_ < (int)((REP >> 5) & 1u); (void)dry_;
    { EpiK E{(bf16_t*)(WSB + O_KB), (const float*)(WSB + O_RSKV)};
      pg8::gemm_phase<false>(wv, lds, (const bf16_t*)(WSB + O_Z) + 1280, 1536, (const bf16_t*)(WSB + O_WKT), 256, 256, 64, 2, E, 192); }
    }
#endif
#if !(DIS & (1u << 6))
    for (int rep_ = 0; rep_ < ((REP >> 6) & 1u) + 1; ++rep_) { const int dry_ = rep_ < (int)((REP >> 6) & 1u); (void)dry_;
    { EpiColBf16<2> E{(bf16_t*)(WSB + O_VT), S, (const float*)(WSB + O_RSKV)};
      pg8::gemm_phase<false>(wv, lds, (const bf16_t*)(WSB + O_WVT), 256, (const bf16_t*)(WSB + O_Z) + 1280, 1536, 256, 2, 64, E, 64); }
    }
#endif
    GSYNC();
#if !(DIS & (1u << 7))
    for (int rep_ = 0; rep_ < ((REP >> 7) & 1u) + 1; ++rep_) { const int dry_ = rep_ < (int)((REP >> 7) & 1u); (void)dry_;
    phase_lru_s1(wv, getargs());
    }
#endif
    GSYNC();
#if !(DIS & (1u << 8))
    for (int rep_ = 0; rep_ < ((REP >> 8) & 1u) + 1; ++rep_) { const int dry_ = rep_ < (int)((REP >> 8) & 1u); (void)dry_;
    phase_lru_s3(wv, getargs());
    }
#endif
#if !(DIS & (1u << 9))
    for (int rep_ = 0; rep_ < ((REP >> 9) & 1u) + 1; ++rep_) { const int dry_ = rep_ < (int)((REP >> 9) & 1u); (void)dry_;
    phase_attn(wv, getargs(), lds);
    }
#endif
    GSYNC();
#if !(DIS & (1u << 10))
    for (int rep_ = 0; rep_ < ((REP >> 10) & 1u) + 1; ++rep_) { const int dry_ = rep_ < (int)((REP >> 10) & 1u); (void)dry_;
    { EpiRes<false> E{getargs().in(0), XBP, RSS + 1 * S, dry_};
      pg8::gemm_phase<false>(wv, lds, (const bf16_t*)(WSB + O_MIX), 1024, (const bf16_t*)(WSB + O_WO1T), 1024, 1024, 64, 4, E); }
    }
#endif
    GSYNC();
#if !(DIS & (1u << 11))
    for (int rep_ = 0; rep_ < ((REP >> 11) & 1u) + 1; ++rep_) { const int dry_ = rep_ < (int)((REP >> 11) & 1u); (void)dry_;
    { EpiUp E{(bf16_t*)(WSB + O_ACT), RSS + 1 * S, getargs().in(24), getargs().in(25), lds + 131072};
      pg8::gemm_phase<true>(wv, lds, XBP, 1024, (const bf16_t*)(WSB + O_WUPT0), 1024, 1024, 67, 22, E); }
    }
#endif
    GSYNC();
#if !(DIS & (1u << 12))
    for (int rep_ = 0; rep_ < ((REP >> 12) & 1u) + 1; ++rep_) { const int dry_ = rep_ < (int)((REP >> 12) & 1u); (void)dry_;
    { EpiRes<true> E{nullptr, XBP, RSS + 2 * S, dry_};
      pg8::gemm_phase<false>(wv, lds, (const bf16_t*)(WSB + O_ACT), 2816, (const bf16_t*)(WSB + O_WDNT0), 2816, 2816, 64, 4, E); }
    }
#endif
    GSYNC();
#if !(DIS & (1u << 13))
    for (int rep_ = 0; rep_ < ((REP >> 13) & 1u) + 1; ++rep_) { const int dry_ = rep_ < (int)((REP >> 13) & 1u); (void)dry_;
    { EpiRowBf16<1> E{(bf16_t*)(WSB + O_QOK), 2048, RSS + 2 * S};
      pg8::gemm_phase<false>(wv, lds, XBP, 1024, (const bf16_t*)(WSB + O_WOINT), 1024, 1024, 64, 8, E); }
    }
#endif
#if !(DIS & (1u << 14))
    for (int rep_ = 0; rep_ < ((REP >> 14) & 1u) + 1; ++rep_) { const int dry_ = rep_ < (int)((REP >> 14) & 1u); (void)dry_;
    { EpiColBf16<1> E{(bf16_t*)(WSB + O_KVT), S, RSS + 2 * S};
      pg8::gemm_phase<false>(wv, lds, (const bf16_t*)(WSB + O_WOINT) + (size_t)1536 * 1024, 1024, XBP, 1024, 1024, 6, 64, E); }
    }
#endif
#if !(DIS & (1u << 15))
    for (int rep_ = 0; rep_ < ((REP >> 15) & 1u) + 1; ++rep_) { const int dry_ = rep_ < (int)((REP >> 15) & 1u); (void)dry_;
    phase_m_gates(wv, getargs(), lds);
    }
#endif
    GSYNC();
#if !(DIS & (1u << 16))
    for (int rep_ = 0; rep_ < ((REP >> 16) & 1u) + 1; ++rep_) { const int dry_ = rep_ < (int)((REP >> 16) & 1u); (void)dry_;
    phase_m_dc(wv, getargs());
    }
#endif
    GSYNC();
#if !(DIS & (1u << 22))
    for (int rep_ = 0; rep_ < ((REP >> 22) & 1u) + 1; ++rep_) { const int dry_ = rep_ < (int)((REP >> 22) & 1u); (void)dry_;
    phase_m_comb(wv, getargs(), lds, dry_);
    }
#endif
    GSYNC();
#if !(DIS & (1u << 17))
    for (int rep_ = 0; rep_ < ((REP >> 17) & 1u) + 1; ++rep_) { const int dry_ = rep_ < (int)((REP >> 17) & 1u); (void)dry_;
    phase_m_out(wv, getargs(), lds, dry_);
    }
#endif
    GSYNC();
#if !(DIS & (1u << 18))
    for (int rep_ = 0; rep_ < ((REP >> 18) & 1u) + 1; ++rep_) { const int dry_ = rep_ < (int)((REP >> 18) & 1u); (void)dry_;
    { EpiRes<true> E{nullptr, XBP, RSS + 3 * S, dry_};
      pg8::gemm_phase<false>(wv, lds, (const bf16_t*)(WSB + O_QOK) + 512, 2048, (const bf16_t*)(WSB + O_WO2T), 1024, 1024, 64, 4, E); }
    }
#endif
    GSYNC();
#if !(DIS & (1u << 19))
    for (int rep_ = 0; rep_ < ((REP >> 19) & 1u) + 1; ++rep_) { const int dry_ = rep_ < (int)((REP >> 19) & 1u); (void)dry_;
    { EpiUp E{(bf16_t*)(WSB + O_ACT), RSS + 3 * S, getargs().in(24) + 3 * 5632, getargs().in(25) + 5632, lds + 131072};
      pg8::gemm_phase<true>(wv, lds, XBP, 1024, (const bf16_t*)(WSB + O_WUPT1), 1024, 1024, 67, 22, E); }
    }
#endif
    GSYNC();
#if !(DIS & (1u << 20))
    for (int rep_ = 0; rep_ < ((REP >> 20) & 1u) + 1; ++rep_) { const int dry_ = rep_ < (int)((REP >> 20) & 1u); (void)dry_;
    { EpiRes<true> E{nullptr, XBP, RSS + 4 * S, dry_};
      pg8::gemm_phase<false>(wv, lds, (const bf16_t*)(WSB + O_ACT), 2816, (const bf16_t*)(WSB + O_WDNT1), 2816, 2816, 64, 4, E); }
    }
#endif
    GSYNC();
#if !(DIS & (1u << 21))
    for (int rep_ = 0; rep_ < ((REP >> 21) & 1u) + 1; ++rep_) { const int dry_ = rep_ < (int)((REP >> 21) & 1u); (void)dry_;
    phase_final(wv, getargs());
    }
#endif
    for (int i = 0; i < XSYNC; ++i) GSYNC();
}

extern "C" void kernel_launch(void* const* d_in, const int* in_sizes, int n_in, void* d_out, int out_size, void* d_ws, size_t ws_size, hipStream_t stream) {
    static int grid = 0;
    if (grid == 0) {
        if (n_in != 28 || out_size != S * 1024 || ws_size < WS_NEED) { fprintf(stderr, "kernel_launch: unexpected shapes (n_in %d out %d ws %zu need %zu)\n", n_in, out_size, ws_size, (size_t)WS_NEED); grid = -1; return; }
        int dev = 0, cus = 0, per_cu = 0;
        (void)hipGetDevice(&dev);
        (void)hipDeviceGetAttribute(&cus, hipDeviceAttributeMultiprocessorCount, dev);
        if (hipFuncSetAttribute((const void*)fwd_kernel, hipFuncAttributeMaxDynamicSharedMemorySize, LDS_BYTES) != hipSuccess) { fprintf(stderr, "kernel_launch: hipFuncSetAttribute failed\n"); grid = -1; return; }
        if (hipOccupancyMaxActiveBlocksPerMultiprocessor(&per_cu, (const void*)fwd_kernel, 512, LDS_BYTES) != hipSuccess || per_cu < 1) { fprintf(stderr, "kernel_launch: occupancy query says %d\n", per_cu); per_cu = 1; }
        (void)hipGetLastError();
        grid = cus * 1;
        if (grid > 256) grid = 256;
    }
    if (grid < 0) return;
    Args a{};
    for (int i = 0; i < 28; ++i) a.in[i] = (const float*)d_in[i];
    a.out = (float*)d_out; a.ws = (unsigned char*)d_ws;
    if (hipMemsetAsync((char*)d_ws + O_BAR, 0, BAR_BYTES, stream) != hipSuccess) { fprintf(stderr, "kernel_launch: memset failed\n"); return; }
    void* args[] = {&a};
    hipError_t e = hipLaunchCooperativeKernel((void*)fwd_kernel, dim3(grid), dim3(512), args, LDS_BYTES, stream);
    if (e != hipSuccess) fprintf(stderr, "kernel_launch: cooperative launch failed: %s (grid %d)\n", hipGetErrorString(e), grid);
}
```

```cpp
#include <hip/hip_runtime.h>
#include <hip/hip_cooperative_groups.h>
#include <cstdio>
#include <cstdint>
namespace cg = cooperative_groups;

typedef unsigned short bf16_t;
typedef short bf16x8 __attribute__((ext_vector_type(8)));
typedef short s16x4 __attribute__((ext_vector_type(4)));
typedef float f32x2 __attribute__((ext_vector_type(2)));
typedef float f32x4 __attribute__((ext_vector_type(4)));
typedef float f32x16 __attribute__((ext_vector_type(16)));
typedef unsigned u32x2 __attribute__((ext_vector_type(2)));
typedef unsigned u32x4 __attribute__((ext_vector_type(4)));
typedef __bf16 bf16x2_t __attribute__((ext_vector_type(2)));
#define LAS __attribute__((address_space(3)))
#define DI __device__ __forceinline__

constexpr int S = 16384;
constexpr float EPS = 1e-6f;
constexpr float LOG2E = 1.4426950408889634f;

constexpr size_t SZ_WUPT = (size_t)5632 * 1024 * 2, SZ_WDNT = (size_t)1024 * 2816 * 2;
constexpr size_t O_WUPT1 = 0;
constexpr size_t O_WDNT1 = O_WUPT1 + SZ_WUPT;
constexpr size_t O_WOINT = O_WDNT1 + SZ_WDNT;
constexpr size_t O_WO2T = O_WOINT + (size_t)3072 * 1024 * 2;
constexpr size_t O_ROWSS = O_WO2T + (size_t)1024 * 1024 * 2;
constexpr size_t O_RSQ = O_ROWSS + (size_t)5 * S * 8;
constexpr size_t O_RSKV = O_RSQ + (size_t)S * 4;
constexpr size_t O_CSTAB = O_RSKV + (size_t)S * 4;
constexpr size_t O_CHA = O_CSTAB + (size_t)S * 32 * 4;
constexpr size_t O_CHH = O_CHA + (size_t)256 * 512 * 4;
constexpr size_t O_GB = O_CHH + (size_t)256 * 512 * 4;
constexpr size_t O_GE = O_GB + (size_t)4 * S * 4;
constexpr size_t O_GPM = O_GE + (size_t)4 * S * 4;
constexpr size_t O_BL = O_GPM + (size_t)4 * S * 4;
constexpr size_t O_ML = O_BL + 4096;
constexpr size_t O_MST = O_ML + 4096;
constexpr size_t O_NST = O_MST + 4096;
constexpr size_t O_BAR = O_NST + (size_t)256 * 4 * 128 * 4;
constexpr size_t BAR_BYTES = 16384;
constexpr size_t O_XB = O_BAR + BAR_BYTES;
constexpr size_t XB_ROWS = 16648;
constexpr size_t O_L0W = O_XB + XB_ROWS * 2048;
constexpr size_t O_W1T = O_L0W;
constexpr size_t O_WQT = O_W1T + (size_t)1536 * 1024 * 2;
constexpr size_t O_WKT = O_WQT + (size_t)768 * 256 * 2;
constexpr size_t O_WVT = O_WKT + (size_t)512 * 256 * 2;
constexpr size_t O_WRIT = O_WVT + (size_t)512 * 256 * 2;
constexpr size_t O_WO1T = O_WRIT + (size_t)1024 * 512 * 2;
constexpr size_t O_WUPT0 = O_WO1T + (size_t)1024 * 1024 * 2;
constexpr size_t O_WDNT0 = O_WUPT0 + SZ_WUPT;
constexpr size_t O_ARENA = O_WDNT0 + SZ_WDNT;
constexpr size_t O_Z = O_ARENA;
constexpr size_t O_XC = O_Z + (size_t)S * 1536 * 2;
constexpr size_t O_QB = O_XC + (size_t)S * 512 * 2;
constexpr size_t O_KB = O_QB + (size_t)8 * S * 96 * 2;
constexpr size_t O_VT = O_KB + (size_t)8 * S * 96 * 2;
constexpr size_t O_MIX = O_VT + (size_t)512 * S * 2;
constexpr size_t O_END0 = O_MIX + (size_t)S * 1024 * 2;
constexpr size_t O_ACT = O_ARENA;
constexpr size_t O_RI = O_XB;
constexpr size_t O_CST = O_L0W;
constexpr size_t O_QOK = O_CST + (size_t)256 * 4 * 256 * 128 * 2;
constexpr size_t O_KVT = O_QOK + (size_t)S * 2048 * 2;
constexpr size_t O_END1 = O_KVT + (size_t)1536 * S * 2;
constexpr size_t WS_NEED = (O_END0 > O_END1 ? O_END0 : O_END1);
static_assert(WS_NEED <= (size_t)268435456, "workspace");
static_assert(O_ACT + (size_t)(S + 240) * 2816 * 2 <= (size_t)268435456, "act");

constexpr int LDS_BYTES = 147456;

struct Args {
    const float* in[28];
    float* out;
    unsigned char* ws;
    int pad; int pad2;
};

struct ArgP { const __attribute__((address_space(4))) Args* p;
    DI const float* in(int i) const { return p->in[i]; } DI float* out() const { return p->out; } DI unsigned char* ws() const { return p->ws; } };
DI unsigned pk2(float lo, float hi) { f32x2 v = {lo, hi}; bf16x2_t b = __builtin_convertvector(v, bf16x2_t); return __builtin_bit_cast(unsigned, b); }
DI bf16_t f2bf(float f) { return (bf16_t)(pk2(f, 0.f) & 0xffffu); }
DI int ltid(int wv) { asm volatile("" : "+s"(wv)); int l = __builtin_amdgcn_mbcnt_hi(~0u, __builtin_amdgcn_mbcnt_lo(~0u, 0u)); asm volatile("" : "+v"(l)); return wv * 64 + l; }
DI int lbid() { int t = blockIdx.x; asm volatile("" : "+s"(t)); return t; }
DI float bf2f(bf16_t b) { return __uint_as_float(((unsigned)b) << 16); }
DI float bflo(unsigned u) { return __uint_as_float(u << 16); }
DI float bfhi(unsigned u) { return __uint_as_float(u & 0xffff0000u); }
DI float wave_sum(float v) {
#pragma unroll
    for (int o = 1; o < 64; o <<= 1) v += __shfl_xor(v, o);
    return v;
}
DI float fexp(float x) { return __builtin_amdgcn_exp2f(x * LOG2E); }
DI float sigmoidf_(float x) { return __builtin_amdgcn_rcpf(1.f + fexp(-x)); }
DI int crow(int r, int hi) { return (r & 3) + 8 * (r >> 2) + 4 * hi; }
typedef unsigned long long u64;
DI float rs_from_ss(u64 ssq) { return rsqrtf((float)ssq * (1.f / (1048576.f * 1024.f)) + EPS); }
DI u64 ss_to_fix(float ss) { return (u64)(ss * 1048576.f); }

namespace pg8 {
constexpr int BM = 256, BK = 64, HALF = 128, HTB = HALF * BK * 2, STAGE_BYTES = 8 * HTB, NXCD = 8, WGM = 8;
DI int lds_byte(int r, int c) { const int st = (r >> 4) * 2 + (c >> 5), rr = r & 15, cc = c & 31, ob = rr * 64 + cc * 2; return st * 1024 + (ob ^ (((ob >> 9) & 1) << 5)); }
DI void stage_rc(int b, int& R, int& C) { const int st = b / 1024, sb = b % 1024, swz = sb ^ (((sb >> 9) & 1) << 5); R = (st >> 1) * 16 + swz / 64; C = (st & 1) * 32 + (swz % 64) / 2; }
DI int perm32(int rho) { const int n = rho >> 4, i = rho & 15; return 8 * (i >> 2) + 4 * n + (i & 3); }
struct Unit { int pm, pn; };
struct StaticOrder {
    int nM, nN, nwg, G, c;
    DI void init(int nM_, int nN_, int G_, int c_) { nM = nM_; nN = nN_; nwg = nM * nN; G = G_; c = c_; }
    DI bool next(int i, Unit& u) const {
        const long L = (long)i * G + c; if (L >= nwg) return false;
        int wgid = (int)L; { const int q = nwg / NXCD, r = nwg % NXCD, xcd = wgid % NXCD, off = wgid / NXCD; wgid = (xcd < r ? xcd * (q + 1) : r * (q + 1) + (xcd - r) * q) + off; }
        const int nig = WGM * nN, gid = wgid / nig, fm = gid * WGM, gsz = (nM - fm) < WGM ? (nM - fm) : WGM;
        u.pm = fm + ((wgid % nig) % gsz); u.pn = (wgid % nig) / gsz; return true;
    }
};

template <bool AMAP, class Epi>
DI void gemm_phase(int wv, LAS unsigned char* lds, const bf16_t* A, int lda, const bf16_t* Bt, int ldb, int K_, int nM, int nN, const Epi& E, int rot = 0) {
    int K = K_; asm volatile("" : "+s"(K));
    const int tid = ltid(wv), wid = __builtin_amdgcn_readfirstlane(tid >> 6), lane = tid & 63, wr = wid >> 2, wc = wid & 3, fr = lane & 15, fq = lane >> 4;
    const int nt = K / BK;
    StaticOrder SO; { int c_ = lbid() - rot; if (c_ < 0) c_ += (int)gridDim.x; SO.init(nM, nN, (int)gridDim.x, c_); }
    unsigned voffA[2], voffB[2];
#pragma unroll
    for (int i = 0; i < 2; ++i) { int R, C; stage_rc(tid * 16 + i * 8192, R, C); const int Rb = (R & ~31) + perm32(R & 31);
        const int Ra = AMAP ? (62 * (R >> 6) + (R & 63) - 2) : R;
        voffA[i] = (unsigned)((Ra + (AMAP ? 2 : 0)) * lda + C) * 2u; voffB[i] = (unsigned)(Rb * ldb + C) * 2u; }
    const size_t kstep = (size_t)(BK * 2);
    const size_t hstepA = (size_t)(AMAP ? 124 : 128) * lda * 2, hstepB = (size_t)HALF * ldb * 2;
    const size_t tstepA = 2 * hstepA, tstepB = 2 * hstepB;
    const unsigned ldsw = (unsigned)wid * 1024u;
    const int aoff = lds_byte(wr * 64 + fr, fq * 8), boff = lds_byte(wc * 32 + fr, fq * 8);
#define PG8_SA(b, h) (((b) * 2 + (h)) * HTB)
#define PG8_SB(b, h) ((4 + (b) * 2 + (h)) * HTB)
#define PG8_STAGE(bufoff, gbase, voff) do { _Pragma("unroll") for (int _i = 0; _i < 2; ++_i) \
        __builtin_amdgcn_global_load_lds((const unsigned*)((const char*)(gbase) + (voff)[_i]), (LAS unsigned*)(lds + (bufoff) + ldsw + _i * 8192), 16, 0, 0); } while (0)
#define PG8_LDA(dst, b, h) do { _Pragma("unroll") for (int m = 0; m < 4; ++m) _Pragma("unroll") for (int k = 0; k < 2; ++k) dst[m][k] = *(const LAS bf16x8*)(lds + PG8_SA(b, h) + aoff + m * 2048 + k * 1024); } while (0)
#define PG8_LDB(dst, b, h) do { _Pragma("unroll") for (int n = 0; n < 2; ++n) _Pragma("unroll") for (int k = 0; k < 2; ++k) dst[n][k] = *(const LAS bf16x8*)(lds + PG8_SB(b, h) + boff + n * 2048 + k * 1024); } while (0)
#define PG8_MMA(ai, bj, At, Bt_) do { __builtin_amdgcn_s_setprio(1); _Pragma("unroll") for (int m = 0; m < 4; ++m) _Pragma("unroll") for (int n = 0; n < 2; ++n) _Pragma("unroll") for (int k = 0; k < 2; ++k) \
        acc[ai][bj][m][n] = __builtin_amdgcn_mfma_f32_16x16x32_bf16(Bt_[n][k], At[m][k], acc[ai][bj][m][n], 0, 0, 0); __builtin_amdgcn_s_setprio(0); } while (0)
#define PG8_WAIT_V(n) asm volatile("s_waitcnt vmcnt(" #n ")" ::: "memory")
#define PG8_WAIT_L(n) asm volatile("s_waitcnt lgkmcnt(" #n ")" ::: "memory")
#define PG8_BAR __builtin_amdgcn_s_barrier()
#define PG8_SCHED __builtin_amdgcn_sched_barrier(0)
    if (AMAP) A -= 2 * lda;
    Unit cur, nxt; int ui = 0;
    if (!SO.next(0, cur)) return;
    f32x4 acc[2][2][4][2];
#pragma unroll
    for (int a = 0; a < 2; ++a)
#pragma unroll
        for (int b = 0; b < 2; ++b)
#pragma unroll
            for (int m = 0; m < 4; ++m)
#pragma unroll
                for (int n = 0; n < 2; ++n) acc[a][b][m][n] = (f32x4){0.f, 0.f, 0.f, 0.f};
    bf16x8 At[4][2], B0[2][2], B1[2][2];
    const char* cA = (const char*)A + (size_t)cur.pm * tstepA; const char* cB = (const char*)Bt + (size_t)cur.pn * tstepB;
    PG8_STAGE(PG8_SB(0, 0), cB, voffB); PG8_STAGE(PG8_SB(0, 1), cB + hstepB, voffB); PG8_STAGE(PG8_SA(0, 0), cA, voffA); PG8_STAGE(PG8_SA(0, 1), cA + hstepA, voffA);
    if (wr == 1) PG8_BAR;
    PG8_WAIT_V(2); PG8_BAR;
    PG8_STAGE(PG8_SB(1, 0), cB + kstep, voffB); PG8_STAGE(PG8_SA(1, 0), cA + kstep, voffA); PG8_STAGE(PG8_SB(1, 1), cB + hstepB + kstep, voffB);
    PG8_WAIT_V(6); PG8_BAR;
    for (;;) {
        const bool has_next = SO.next(ui + 1, nxt);
        const char* nA = has_next ? (const char*)A + (size_t)nxt.pm * tstepA : cA; const char* nB = has_next ? (const char*)Bt + (size_t)nxt.pn * tstepB : cB;
        for (int t = 0; t < nt; t += 2) {
            const bool last = (t == nt - 2);
            const char* a1 = cA + (size_t)(t + 1) * kstep;
            const char* a2 = last ? nA : cA + (size_t)(t + 2) * kstep; const char* b2 = last ? nB : cB + (size_t)(t + 2) * kstep;
            const char* a3 = a2 + kstep; const char* b3 = b2 + kstep;
            PG8_LDB(B0, 0, 0); PG8_LDB(B1, 0, 1); PG8_SCHED; PG8_LDA(At, 0, 0); PG8_STAGE(PG8_SA(1, 1), a1 + hstepA, voffA);
            PG8_WAIT_V(8); PG8_WAIT_L(0); PG8_BAR; PG8_MMA(0, 0, At, B0); PG8_MMA(0, 1, At, B1); PG8_BAR; PG8_SCHED;
            PG8_LDA(At, 0, 1); PG8_STAGE(PG8_SB(0, 0), b2, voffB); PG8_STAGE(PG8_SB(0, 1), b2 + hstepB, voffB); PG8_STAGE(PG8_SA(0, 0), a2, voffA);
            PG8_WAIT_V(8); PG8_WAIT_L(0); PG8_BAR; PG8_MMA(1, 0, At, B0); PG8_MMA(1, 1, At, B1); PG8_BAR; PG8_SCHED;
            PG8_LDB(B0, 1, 0); PG8_LDB(B1, 1, 1); PG8_SCHED; PG8_LDA(At, 1, 0); PG8_STAGE(PG8_SA(0, 1), a2 + hstepA, voffA);
            PG8_WAIT_V(8); PG8_WAIT_L(0); PG8_BAR; PG8_MMA(0, 0, At, B0); PG8_MMA(0, 1, At, B1); PG8_BAR; PG8_SCHED;
            PG8_LDA(At, 1, 1); PG8_STAGE(PG8_SB(1, 0), b3, voffB); PG8_STAGE(PG8_SB(1, 1), b3 + hstepB, voffB); PG8_STAGE(PG8_SA(1, 0), a3, voffA);
            PG8_WAIT_V(8); PG8_WAIT_L(0); PG8_BAR; PG8_MMA(1, 0, At, B0); PG8_MMA(1, 1, At, B1); PG8_BAR; PG8_SCHED;
        }
        if (wr == 0) PG8_BAR;
        E(acc, cur, wr, wc, fr, fq);
        if (!has_next) break;
#pragma unroll
        for (int a = 0; a < 2; ++a)
#pragma unroll
            for (int b = 0; b < 2; ++b)
#pragma unroll
                for (int m = 0; m < 4; ++m)
#pragma unroll
                    for (int n = 0; n < 2; ++n) acc[a][b][m][n] = (f32x4){0.f, 0.f, 0.f, 0.f};
        cur = nxt; cA = nA; cB = nB; ++ui;
        if (wr == 1) PG8_BAR;
    }
    PG8_WAIT_V(0);
    PG8_BAR;
#undef PG8_SA
#undef PG8_SB
#undef PG8_STAGE
#undef PG8_LDA
#undef PG8_LDB
#undef PG8_MMA
#undef PG8_WAIT_V
#undef PG8_WAIT_L
#undef PG8_BAR
#undef PG8_SCHED
}
}
using pg8::Unit;
typedef f32x4 AccT[2][2][4][2];

template <int SMODE> struct EpiRowBf16 {
    bf16_t* O; int ldc; const void* sc;
    DI void operator()(const AccT& acc, const Unit& u, int wr, int wc, int fr, int fq) const {
        const int row0 = u.pm * 256 + wr * 64 + fr, col0 = u.pn * 256 + wc * 32 + 8 * fq;
#pragma unroll
        for (int ai = 0; ai < 2; ++ai)
#pragma unroll
            for (int m = 0; m < 4; ++m) { const int row = row0 + ai * 128 + m * 16;
                float s = 1.f; if (SMODE == 1) s = rs_from_ss(((const u64*)sc)[row]); if (SMODE == 2) s = ((const float*)sc)[row];
                bf16_t* rowp = O + (size_t)row * ldc + col0;
#pragma unroll
                for (int bj = 0; bj < 2; ++bj) { const f32x4 v0 = acc[ai][bj][m][0] * s, v1 = acc[ai][bj][m][1] * s;
                    u32x4 w; w.x = pk2(v0[0], v0[1]); w.y = pk2(v0[2], v0[3]); w.z = pk2(v1[0], v1[1]); w.w = pk2(v1[2], v1[3]);
                    *(u32x4*)(rowp + bj * 128) = w; } }
    }
};
template <int SMODE> struct EpiColBf16 {
    bf16_t* O; int ldc; const void* sc;
    DI void operator()(const AccT& acc, const Unit& u, int wr, int wc, int fr, int fq) const {
        const int row0 = u.pm * 256 + wr * 64 + fr, col0 = u.pn * 256 + wc * 32 + 8 * fq;
#pragma unroll
        for (int bj = 0; bj < 2; ++bj) { float s[8];
#pragma unroll
            for (int j = 0; j < 8; ++j) s[j] = (SMODE == 1) ? rs_from_ss(((const u64*)sc)[col0 + bj * 128 + j]) : ((const float*)sc)[col0 + bj * 128 + j];
#pragma unroll
            for (int ai = 0; ai < 2; ++ai)
#pragma unroll
                for (int m = 0; m < 4; ++m) { const int row = row0 + ai * 128 + m * 16; const f32x4 v0 = acc[ai][bj][m][0], v1 = acc[ai][bj][m][1];
                    u32x4 w; w.x = pk2(v0[0] * s[0], v0[1] * s[1]); w.y = pk2(v0[2] * s[2], v0[3] * s[3]); w.z = pk2(v1[0] * s[4], v1[1] * s[5]); w.w = pk2(v1[2] * s[6], v1[3] * s[7]);
                    *(u32x4*)(O + (size_t)row * ldc + col0 + bj * 128) = w; } }
    }
};
struct EpiQ {
    bf16_t* QB; const float* rsq; const float* cstab;
    DI void operator()(const AccT& acc, const Unit& u, int wr, int wc, int fr, int fq) const {
        const int row0 = u.pm * 256 + wr * 64 + fr, col0 = u.pn * 256 + wc * 32 + 8 * fq;
        const float QS = 0.10206207261596577f * LOG2E;
#pragma unroll
        for (int ai = 0; ai < 2; ++ai)
#pragma unroll
            for (int m = 0; m < 4; ++m) { const int t = row0 + ai * 128 + m * 16; const float s = rsq[t] * QS;
#pragma unroll
                for (int bj = 0; bj < 2; ++bj) { const int c = col0 + bj * 128, h = c / 96, d = c - h * 96;
                    f32x4 v0 = acc[ai][bj][m][0] * s, v1 = acc[ai][bj][m][1] * s;
                    if (d >= 64) { const int i0 = (d - 64) >> 1; const f32x4 cs0 = *(const f32x4*)(cstab + (size_t)t * 32 + 2 * i0), cs1 = *(const f32x4*)(cstab + (size_t)t * 32 + 2 * i0 + 4);
                        f32x4 a, b;
                        a[0] = v0[0] * cs0[0] - v0[1] * cs0[1]; a[1] = v0[1] * cs0[0] + v0[0] * cs0[1];
                        a[2] = v0[2] * cs0[2] - v0[3] * cs0[3]; a[3] = v0[3] * cs0[2] + v0[2] * cs0[3];
                        b[0] = v1[0] * cs1[0] - v1[1] * cs1[1]; b[1] = v1[1] * cs1[0] + v1[0] * cs1[1];
                        b[2] = v1[2] * cs1[2] - v1[3] * cs1[3]; b[3] = v1[3] * cs1[2] + v1[2] * cs1[3];
                        v0 = a; v1 = b; }
                    u32x4 w; w.x = pk2(v0[0], v0[1]); w.y = pk2(v0[2], v0[3]); w.z = pk2(v1[0], v1[1]); w.w = pk2(v1[2], v1[3]);
                    *(u32x4*)(QB + ((size_t)h * S + t) * 96 + d) = w; } }
    }
};
struct EpiK {
    bf16_t* KB; const float* rskv;
    DI void operator()(const AccT& acc, const Unit& u, int wr, int wc, int fr, int fq) const {
        const int row0 = u.pm * 256 + wr * 64 + fr, col0 = u.pn * 256 + wc * 32 + 8 * fq;
#pragma unroll
        for (int ai = 0; ai < 2; ++ai)
#pragma unroll
            for (int m = 0; m < 4; ++m) { const int t = row0 + ai * 128 + m * 16; const float s = rskv[t];
#pragma unroll
                for (int bj = 0; bj < 2; ++bj) { const int c = col0 + bj * 128, h = c >> 6, d = c & 63;
                    const f32x4 v0 = acc[ai][bj][m][0] * s, v1 = acc[ai][bj][m][1] * s;
                    u32x4 w; w.x = pk2(v0[0], v0[1]); w.y = pk2(v0[2], v0[3]); w.z = pk2(v1[0], v1[1]); w.w = pk2(v1[2], v1[3]);
                    *(u32x4*)(KB + ((size_t)h * S + t) * 96 + d) = w; } }
    }
};
template <bool RESBF> struct EpiRes {
    const float* res; bf16_t* XB; u64* rowss; int dry;
    DI void operator()(const AccT& acc, const Unit& u, int wr, int wc, int fr, int fq) const {
        const int row0 = u.pm * 256 + wr * 64 + fr, col0 = u.pn * 256 + wc * 32 + 8 * fq;
#pragma unroll
        for (int ai = 0; ai < 2; ++ai)
#pragma unroll
            for (int m = 0; m < 4; ++m) { const int t = row0 + ai * 128 + m * 16; float ss = 0.f;
#pragma unroll
                for (int bj = 0; bj < 2; ++bj) { const size_t o = (size_t)t * 1024 + col0 + bj * 128;
                    f32x4 r0, r1;
                    if (RESBF) { const u32x4 rb = *(const u32x4*)(XB + o); r0 = (f32x4){bflo(rb.x), bfhi(rb.x), bflo(rb.y), bfhi(rb.y)}; r1 = (f32x4){bflo(rb.z), bfhi(rb.z), bflo(rb.w), bfhi(rb.w)}; }
                    else { r0 = *(const f32x4*)(res + o); r1 = *(const f32x4*)(res + o + 4); }
                    const f32x4 v0 = acc[ai][bj][m][0] + r0, v1 = acc[ai][bj][m][1] + r1;
                    u32x4 w; w.x = pk2(v0[0], v0[1]); w.y = pk2(v0[2], v0[3]); w.z = pk2(v1[0], v1[1]); w.w = pk2(v1[2], v1[3]);
                    if (!dry) *(u32x4*)(XB + o) = w;
                    ss += v0[0] * v0[0] + v0[1] * v0[1] + v0[2] * v0[2] + v0[3] * v0[3] + v1[0] * v1[0] + v1[1] * v1[1] + v1[2] * v1[2] + v1[3] * v1[3]; }
                ss += __shfl_xor(ss, 16); ss += __shfl_xor(ss, 32);
                if (fq == 0 && !dry) atomicAdd(rowss + t, ss_to_fix(ss)); }
    }
};
DI float dpp_prev1(float cur, float prevm) {
    const int o = __builtin_amdgcn_update_dpp(0, __builtin_bit_cast(int, prevm), 0x121, 0xf, 0xf, false);
    return __builtin_bit_cast(float, __builtin_amdgcn_update_dpp(o, __builtin_bit_cast(int, cur), 0x111, 0xf, 0xf, false));
}
DI float dpp_prev2(float cur, float prevm) {
    const int o = __builtin_amdgcn_update_dpp(0, __builtin_bit_cast(int, prevm), 0x122, 0xf, 0xf, false);
    return __builtin_bit_cast(float, __builtin_amdgcn_update_dpp(o, __builtin_bit_cast(int, cur), 0x112, 0xf, 0xf, false));
}
struct EpiUp {
    bf16_t* ACT; const u64* rowss; const float* cw; const float* cb; LAS unsigned char* plds;
    DI void operator()(const AccT& acc, const Unit& u, int wr, int wc, int fr, int fq) const {
        const int cl = u.pn * 128 + wc * 32 + 8 * fq;
        LAS float* P = (LAS float*)(plds + (wr * 4 + wc) * 1024);
        { const int lane = fq * 16 + fr, kind = lane >> 3, c4 = 4 * (lane & 7), k3 = kind & 3;
          const float* src = (k3 == 0 ? cb : cw + (k3 - 1) * 5632) + (kind >= 4 ? 2816 : 0) + u.pn * 128 + wc * 32 + c4;
          *(LAS f32x4*)(P + kind * 32 + c4) = *(const f32x4*)src; }
#pragma unroll
        for (int ai = 0; ai < 2; ++ai) {
            const int tok0 = u.pm * 248 + 62 * (2 * ai + wr) - 2 + fr;
            float rs[4];
#pragma unroll
            for (int m = 0; m < 4; ++m) { const int t = tok0 + 16 * m; const int tc = t < 0 ? 0 : (t >= S ? S - 1 : t); const float r = rs_from_ss(rowss[tc]); rs[m] = t < 0 ? 0.f : r; }
            const int row0 = fr < 2 ? (S + 236 + fr) : tok0;
#pragma unroll
            for (int n = 0; n < 2; ++n) {
                const int lc = 8 * fq + 4 * n;
                unsigned wpk[4][2];
#pragma unroll
                for (int jp = 0; jp < 2; ++jp) {
                    const f32x2 bg = *(const LAS f32x2*)(P + lc + 2 * jp), g0 = *(const LAS f32x2*)(P + 32 + lc + 2 * jp), g1 = *(const LAS f32x2*)(P + 64 + lc + 2 * jp), g2 = *(const LAS f32x2*)(P + 96 + lc + 2 * jp);
                    const f32x2 bv = *(const LAS f32x2*)(P + 128 + lc + 2 * jp), v0 = *(const LAS f32x2*)(P + 160 + lc + 2 * jp), v1 = *(const LAS f32x2*)(P + 192 + lc + 2 * jp), v2 = *(const LAS f32x2*)(P + 224 + lc + 2 * jp);
                    f32x2 G[4], V[4];
#pragma unroll
                    for (int m = 0; m < 4; ++m) { G[m] = (f32x2){acc[ai][0][m][n][2 * jp], acc[ai][0][m][n][2 * jp + 1]} * rs[m]; V[m] = (f32x2){acc[ai][1][m][n][2 * jp], acc[ai][1][m][n][2 * jp + 1]} * rs[m]; }
#pragma unroll
                    for (int m = 0; m < 4; ++m) {
                        const f32x2 zz = {0.f, 0.f}; const f32x2 Gp = m ? G[m - 1] : zz, Vp = m ? V[m - 1] : zz;
                        const f32x2 gp1 = {dpp_prev1(G[m].x, Gp.x), dpp_prev1(G[m].y, Gp.y)}, gp2 = {dpp_prev2(G[m].x, Gp.x), dpp_prev2(G[m].y, Gp.y)};
                        const f32x2 vp1 = {dpp_prev1(V[m].x, Vp.x), dpp_prev1(V[m].y, Vp.y)}, vp2 = {dpp_prev2(V[m].x, Vp.x), dpp_prev2(V[m].y, Vp.y)};
                        const f32x2 gc = bg + g0 * gp2 + g1 * gp1 + g2 * G[m];
                        const f32x2 vc = bv + v0 * vp2 + v1 * vp1 + v2 * V[m];
                        const f32x2 xe = gc * (-LOG2E);
                        f32x2 dn = {__builtin_amdgcn_exp2f(xe.x), __builtin_amdgcn_exp2f(xe.y)}; dn = dn + 1.0f;
                        const f32x2 rc = {__builtin_amdgcn_rcpf(dn.x), __builtin_amdgcn_rcpf(dn.y)};
                        const f32x2 rr = gc * rc * vc;
                        wpk[m][jp] = pk2(rr.x, rr.y); }
                }
#pragma unroll
                for (int m = 0; m < 4; ++m) { const int row = m ? tok0 + 16 * m : row0;
                    *(u32x2*)(ACT + (size_t)row * 2816 + cl + 4 * n) = (u32x2){wpk[m][0], wpk[m][1]}; }
                __builtin_amdgcn_sched_barrier(0);
            }
        }
    }
};

template <class F> DI void tr_items(const F& f, int Kdst, int Nrows, bf16_t* WT, LAS float* scr, int gw, int NGW, int lane, int& cum) {
    const int nblk = Nrows / 32, nitems = (Kdst / 64) * nblk;
    int first = (gw - cum) % NGW; if (first < 0) first += NGW; cum = (cum + nitems) % NGW;
    for (int item = first; item < nitems; item += NGW) {
        const int kb = item / nblk, nb = item % nblk, k0 = 64 * kb, n0 = 32 * nb;
        float tv[32];
#pragma unroll
        for (int i = 0; i < 32; ++i) tv[i] = f(k0 + 2 * i + (lane >> 5), n0 + (lane & 31));
#pragma unroll
        for (int i = 0; i < 32; ++i) scr[(2 * i + (lane >> 5)) * 33 + (lane & 31)] = tv[i];
        asm volatile("s_waitcnt lgkmcnt(0)" ::: "memory");
        const int c = lane & 7;
#pragma unroll
        for (int j = 0; j < 4; ++j) { const int n = (lane >> 3) + 8 * j; const LAS float* s = scr + (8 * c) * 33 + n;
            u32x4 o; o.x = pk2(s[0 * 33], s[1 * 33]); o.y = pk2(s[2 * 33], s[3 * 33]); o.z = pk2(s[4 * 33], s[5 * 33]); o.w = pk2(s[6 * 33], s[7 * 33]);
            *(u32x4*)(WT + (size_t)(n0 + n) * Kdst + k0 + 8 * c) = o; }
        asm volatile("s_waitcnt lgkmcnt(0)" ::: "memory");
    }
}
struct FW1 { const float* W; const float* g; DI float operator()(int k, int n) const { return n < 1440 ? __builtin_nontemporal_load(&W[(size_t)k * 1440 + n]) * g[k] : 0.f; } };
struct FWQ { const float* W; const float* g; DI float operator()(int k, int n) const { const int h = n / 96, d = n - h * 96; int c = d; if (d >= 64) { const int r = d - 64; c = 64 + (r >> 1) + 16 * (r & 1); } return __builtin_nontemporal_load(&W[(size_t)k * 768 + h * 96 + c]) * g[k]; } };
struct FWKV { const float* W; const float* g; int off; DI float operator()(int k, int n) const { return k < 128 ? __builtin_nontemporal_load(&W[(size_t)k * 1024 + (n >> 6) * 128 + off + (n & 63)]) * g[k] : 0.f; } };
struct FWRI { const float* Wa; const float* Wx; DI float operator()(int k, int n) const { const float* W = n < 512 ? Wa : Wx; const int ch = n & 511, g = ch >> 6, j = ch & 63; return (k >> 6) == g ? __builtin_nontemporal_load(&W[(size_t)k * 64 + j]) : 0.f; } };
struct FWP { const float* W; int N; DI float operator()(int k, int n) const { return __builtin_nontemporal_load(&W[(size_t)k * N + n]); } };
struct FWUP { const float* W; const float* g; DI float operator()(int k, int n) const { const int pn = n >> 8, r = n & 255; const int c = r < 128 ? 128 * pn + r : 2816 + 128 * pn + r - 128; return __builtin_nontemporal_load(&W[(size_t)k * 5632 + c]) * g[k]; } };
struct FWOIN { const float* W; const float* g; DI float operator()(int k, int n) const {
    int c; float s = 1.f; if (n < 512) { c = n; s = 0.08838834764831845f; } else if (n < 1536) c = 2048 + (n - 512); else if (n < 2048) c = 512 + (n - 1536); else c = 1024 + (n - 2048);
    return __builtin_nontemporal_load(&W[(size_t)k * 3080 + c]) * g[k] * s; } };

#ifndef PROPART
#define PROPART 7
#endif
DI void phase_prologue(int wv, const ArgP a, LAS unsigned char* lds, int parts) {
    unsigned char* ws = a.ws();
    const int tid = ltid(wv), wave = tid >> 6, lane = tid & 63;
    LAS float* scr = (LAS float*)(lds + wave * 8448);
    const int gw = blockIdx.x * 8 + wave, NGW = gridDim.x * 8; int cum = 0;
    if (parts & 1) {
    { FW1 f{a.in(3), a.in(2)}; tr_items(f, 1024, 1536, (bf16_t*)(ws + O_W1T), scr, gw, NGW, lane, cum); }
    { FWQ f{a.in(12), a.in(11)}; tr_items(f, 256, 768, (bf16_t*)(ws + O_WQT), scr, gw, NGW, lane, cum); }
    { FWKV f{a.in(14), a.in(13), 0}; tr_items(f, 256, 512, (bf16_t*)(ws + O_WKT), scr, gw, NGW, lane, cum); }
    { FWKV f{a.in(14), a.in(13), 64}; tr_items(f, 256, 512, (bf16_t*)(ws + O_WVT), scr, gw, NGW, lane, cum); }
    { FWRI f{a.in(6), a.in(8)}; tr_items(f, 512, 1024, (bf16_t*)(ws + O_WRIT), scr, gw, NGW, lane, cum); }
    { FWP f{a.in(15), 1024}; tr_items(f, 1024, 1024, (bf16_t*)(ws + O_WO1T), scr, gw, NGW, lane, cum); }
    for (int l = 0; l < 2; ++l) {
        { FWUP f{a.in(23) + (size_t)l * 1024 * 5632, a.in(22) + l * 1024}; tr_items(f, 1024, 5632, (bf16_t*)(ws + (l ? O_WUPT1 : O_WUPT0)), scr, gw, NGW, lane, cum); }
        { FWP f{a.in(26) + (size_t)l * 2816 * 1024, 1024}; tr_items(f, 2816, 1024, (bf16_t*)(ws + (l ? O_WDNT1 : O_WDNT0)), scr, gw, NGW, lane, cum); }
    }
    { FWOIN f{a.in(17), a.in(16)}; tr_items(f, 1024, 3072, (bf16_t*)(ws + O_WOINT), scr, gw, NGW, lane, cum); }
    { FWP f{a.in(21), 1024}; tr_items(f, 1024, 1024, (bf16_t*)(ws + O_WO2T), scr, gw, NGW, lane, cum); }
    }
    if (parts & 2) {
    const float* x = a.in(0); bf16_t* XB = (bf16_t*)(ws + O_XB) + 2 * 1024; u64* rowss = (u64*)(ws + O_ROWSS);
#pragma unroll 4
    for (int t = gw; t < S; t += NGW) {
        float ss = 0.f;
#pragma unroll
        for (int j = 0; j < 4; ++j) { const f32x4 v = __builtin_nontemporal_load((const f32x4*)(x + (size_t)t * 1024 + j * 256 + lane * 4));
            ss += v[0] * v[0] + v[1] * v[1] + v[2] * v[2] + v[3] * v[3];
            u32x2 w; w.x = pk2(v[0], v[1]); w.y = pk2(v[2], v[3]); *(u32x2*)(XB + (size_t)t * 1024 + j * 256 + lane * 4) = w; }
        ss = wave_sum(ss);
        if (lane == 0) rowss[t] = ss_to_fix(ss);
        if (lane >= 1 && lane < 5) rowss[(size_t)lane * S + t] = 0ull;
    }
    }
    if (parts & 4) {
    const int* pos = (const int*)a.in(1); float* cst = (float*)(ws + O_CSTAB);
    for (int e = blockIdx.x * 512 + tid; e < S * 16; e += gridDim.x * 512) { const int t = e >> 4, i = e & 15;
        const float invf = __builtin_amdgcn_exp2f(-(float)i * (13.287712379549449f / 16.f)); const float ang = (float)pos[t] * invf;
        const float k = rintf(ang * 0.15915494309189535f);
        float r = fmaf(-k, 6.28318548202514648f, ang); r = fmaf(-k, -1.7484555e-7f, r);
        const float rr = r * 0.15915494309189535f;
        cst[2 * e] = __builtin_amdgcn_cosf(rr); cst[2 * e + 1] = __builtin_amdgcn_sinf(rr); }
    }
}

DI void phase_l0_prep(int wv, const ArgP a) {
    unsigned char* ws = a.ws();
    const bf16_t* Z = (const bf16_t*)(ws + O_Z); bf16_t* XC = (bf16_t*)(ws + O_XC); bf16_t* KB = (bf16_t*)(ws + O_KB);
    float* rsq = (float*)(ws + O_RSQ); float* rskv = (float*)(ws + O_RSKV); const float* cst = (const float*)(ws + O_CSTAB);
    const float* cw = a.in(4); const float* cb = a.in(5);
    const int tid = ltid(wv), wave = tid >> 6, lane = tid & 63;
#pragma unroll 2
    for (int e = blockIdx.x * 512 + tid; e < S * 64; e += gridDim.x * 512) { const int t = e >> 6, c0 = (e & 63) * 8;
        float acc[8];
#pragma unroll
        for (int j = 0; j < 8; ++j) acc[j] = cb[c0 + j];
#pragma unroll
        for (int k = 0; k < 4; ++k) { const int tt = t - 3 + k; if (tt < 0) continue;
            const u32x4 v = *(const u32x4*)(Z + (size_t)tt * 1536 + c0);
            const f32x4 w0 = *(const f32x4*)(cw + k * 512 + c0), w1 = *(const f32x4*)(cw + k * 512 + c0 + 4);
            acc[0] += w0[0] * bflo(v.x); acc[1] += w0[1] * bfhi(v.x); acc[2] += w0[2] * bflo(v.y); acc[3] += w0[3] * bfhi(v.y);
            acc[4] += w1[0] * bflo(v.z); acc[5] += w1[1] * bfhi(v.z); acc[6] += w1[2] * bflo(v.w); acc[7] += w1[3] * bfhi(v.w); }
        u32x4 o; o.x = pk2(acc[0], acc[1]); o.y = pk2(acc[2], acc[3]); o.z = pk2(acc[4], acc[5]); o.w = pk2(acc[6], acc[7]);
        *(u32x4*)(XC + (size_t)t * 512 + c0) = o; }
#pragma unroll 4
    for (int t = blockIdx.x * 8 + wave; t < S; t += gridDim.x * 8) {
        const bf16_t* zr = Z + (size_t)t * 1536;
        float sq = 0.f, skv = 0.f;
        { const u32x2 v = *(const u32x2*)(zr + 1024 + lane * 4); const float p0 = bflo(v.x), p1 = bfhi(v.x), p2 = bflo(v.y), p3 = bfhi(v.y); sq = p0 * p0 + p1 * p1 + p2 * p2 + p3 * p3; }
        { const unsigned v = *(const unsigned*)(zr + 1280 + lane * 2); const float p0 = bflo(v), p1 = bfhi(v); skv = p0 * p0 + p1 * p1; }
        sq = wave_sum(sq); skv = wave_sum(skv);
        if (lane == 0) { rsq[t] = rsqrtf(sq * (1.f / 256.f) + EPS); rskv[t] = rsqrtf(skv * (1.f / 128.f) + EPS); }
        if (lane < 16) { const float x1 = bf2f(zr[1408 + lane]), x2 = bf2f(zr[1424 + lane]); const float c = cst[(size_t)t * 32 + 2 * lane], s = cst[(size_t)t * 32 + 2 * lane + 1];
            const unsigned w = pk2(x1 * c - x2 * s, x2 * c + x1 * s);
#pragma unroll
            for (int h = 0; h < 8; ++h) *(unsigned*)(KB + ((size_t)h * S + t) * 96 + 64 + 2 * lane) = w; }
    }
}

DI void lru_coeff(float rpre, float ipre, float xc, float sp8, float& av, float& uv) {
    const float r = sigmoidf_(rpre), ig = sigmoidf_(ipre);
    const float la = -sp8 * r;
    av = fexp(la);
    uv = __builtin_amdgcn_sqrtf(fmaxf(1.f - av * av, 0.f)) * (ig * xc);
}
DI void phase_lru_s1(int wv, const ArgP a) {
    unsigned char* ws = a.ws(); const int ch = ltid(wv);
    const bf16_t* RI = (const bf16_t*)(ws + O_RI); const bf16_t* XC = (const bf16_t*)(ws + O_XC);
    float* CHA = (float*)(ws + O_CHA); float* CHH = (float*)(ws + O_CHH);
    const float ba = a.in(7)[ch], bx = a.in(9)[ch]; const float lam = a.in(10)[ch];
    const float sp8 = 8.f * log1pf(expf(-lam));
    for (int c = blockIdx.x; c < 256; c += gridDim.x) {
        float A = 1.f, H = 0.f;
#pragma unroll 8
        for (int i = 0; i < 64; ++i) { const size_t t = (size_t)c * 64 + i;
            float av, uv; lru_coeff(bf2f(RI[t * 1024 + ch]) + ba, bf2f(RI[t * 1024 + 512 + ch]) + bx, bf2f(XC[t * 512 + ch]), sp8, av, uv);
            A *= av; H = av * H + uv; }
        CHA[c * 512 + ch] = A; CHH[c * 512 + ch] = H;
    }
}
DI void phase_lru_s3(int wv, const ArgP a) {
    unsigned char* ws = a.ws(); const int ch = ltid(wv);
    const bf16_t* RI = (const bf16_t*)(ws + O_RI); const bf16_t* XC = (const bf16_t*)(ws + O_XC); const bf16_t* Z = (const bf16_t*)(ws + O_Z);
    const float* CHA = (const float*)(ws + O_CHA); const float* CHH = (const float*)(ws + O_CHH); bf16_t* MIX = (bf16_t*)(ws + O_MIX);
    const float ba = a.in(7)[ch], bx = a.in(9)[ch]; const float lam = a.in(10)[ch];
    const float sp8 = 8.f * log1pf(expf(-lam));
    for (int c = blockIdx.x; c < 256; c += gridDim.x) {
        float H = 0.f;
#pragma unroll 16
        for (int cc = 0; cc < c; ++cc) H = CHA[cc * 512 + ch] * H + CHH[cc * 512 + ch];
#pragma unroll 4
        for (int i = 0; i < 64; ++i) { const size_t t = (size_t)c * 64 + i;
            float av, uv; lru_coeff(bf2f(RI[t * 1024 + ch]) + ba, bf2f(RI[t * 1024 + 512 + ch]) + bx, bf2f(XC[t * 512 + ch]), sp8, av, uv);
            H = av * H + uv;
            const float g = bf2f(Z[t * 1536 + 512 + ch]);
            const float y = 0.7978845608028654f * (g + 0.044715f * g * g * g);
            const float th = 1.f - 2.f * __builtin_amdgcn_rcpf(1.f + fexp(2.f * y));
            MIX[t * 1024 + ch] = f2bf(H * 0.5f * g * (1.f + th)); }
    }
}

constexpr int AT_KROW = 208, AT_VROW = 136, AT_KT = 64 * AT_KROW, AT_VT = 64 * AT_VROW;
DI float rowmax32(const f32x16& p0, const f32x16& p1) {
    float a = fmaxf(fmaxf(p0[0], p0[1]), p1[0]), b = fmaxf(fmaxf(p0[2], p0[3]), p1[1]); a = fmaxf(fmaxf(a, p1[2]), p1[3]);
#pragma unroll
    for (int r = 4; r < 16; r += 4) { a = fmaxf(fmaxf(a, p0[r]), p0[r + 1]); b = fmaxf(fmaxf(b, p0[r + 2]), p0[r + 3]); a = fmaxf(fmaxf(a, p1[r]), p1[r + 1]); b = fmaxf(fmaxf(b, p1[r + 2]), p1[r + 3]); }
    const float m = fmaxf(a, b);
    const auto rr = __builtin_amdgcn_permlane32_swap(__float_as_uint(m), __float_as_uint(m), false, false);
    return fmaxf(__uint_as_float(rr[0]), __uint_as_float(rr[1]));
}
DI void attn_unit(int wv, int h, int qb, const bf16_t* QB, const bf16_t* KB, const bf16_t* VT, bf16_t* MIX, LAS unsigned char* lds) {
    const int tid = ltid(wv), lane = tid & 63, r32 = lane & 31, hi = lane >> 5; const int wid = __builtin_amdgcn_readfirstlane(tid >> 6);
    const int qg = qb * 256 + wid * 32 + r32;
    const bf16_t* Kh = KB + (size_t)h * S * 96; const bf16_t* Vh = VT + (size_t)h * 64 * S;
    bf16x8 qf[6];
    { const bf16_t* qp = QB + ((size_t)h * S + qg) * 96 + 8 * hi;
#pragma unroll
      for (int s = 0; s < 6; ++s) qf[s] = *(const bf16x8*)(qp + 16 * s); }
    f32x16 o0 = {}, o1 = {}, negm = {};
    float mref = 0.f, lrun = 0.f;
    const int NT = 4 * qb + 4, wlim = 4 * qb + (wid >> 1);
    const int kc0 = tid, kkey0 = kc0 / 12, kpart0 = kc0 % 12;
    const int kc1 = tid + 512, kkey1 = kc1 / 12, kpart1 = kc1 % 12;
    const int vdv = tid >> 3, vpart = tid & 7;
    u32x4 rk0, rk1 = {}, rv;
#define AT_LOADK(t_) do { const size_t kb_ = (size_t)(t_) * 64; rk0 = *(const u32x4*)(Kh + (kb_ + kkey0) * 96 + kpart0 * 8); if (tid < 256) rk1 = *(const u32x4*)(Kh + (kb_ + kkey1) * 96 + kpart1 * 8); } while (0)
#define AT_LOADV(t_) do { rv = *(const u32x4*)(Vh + (size_t)vdv * S + (size_t)(t_) * 64 + vpart * 8); } while (0)
#define AT_WRITEK(t_) do { LAS unsigned char* Ks_ = lds + ((t_) & 1) * AT_KT; *(LAS u32x4*)(Ks_ + kkey0 * AT_KROW + kpart0 * 16) = rk0; if (tid < 256) *(LAS u32x4*)(Ks_ + kkey1 * AT_KROW + kpart1 * 16) = rk1; } while (0)
#define AT_WRITEV(t_) do { LAS unsigned char* Vs_ = lds + 2 * AT_KT + ((t_) & 1) * AT_VT; *(LAS u32x2*)(Vs_ + vdv * AT_VROW + vpart * 16) = (u32x2){rv.x, rv.y}; *(LAS u32x2*)(Vs_ + vdv * AT_VROW + vpart * 16 + 8) = (u32x2){rv.z, rv.w}; } while (0)
#define AT_QK(P0, P1, t_) do { const LAS unsigned char* Ks_ = lds + ((t_) & 1) * AT_KT + r32 * AT_KROW + 16 * hi; f32x16 c0_ = negm, c1_ = negm; \
        _Pragma("unroll") for (int s = 0; s < 6; ++s) { const bf16x8 k0_ = *(const LAS bf16x8*)(Ks_ + 32 * s), k1_ = *(const LAS bf16x8*)(Ks_ + 32 * AT_KROW + 32 * s); \
            c0_ = __builtin_amdgcn_mfma_f32_32x32x16_bf16(k0_, qf[s], c0_, 0, 0, 0); c1_ = __builtin_amdgcn_mfma_f32_32x32x16_bf16(k1_, qf[s], c1_, 0, 0, 0); } \
        P0 = c0_; P1 = c1_; } while (0)
#define AT_SM1(P0, P1, MOFF, t_, MASK) do { \
        if (MASK && (t_) == wlim) { const int kbase_ = (t_) * 64 + 4 * hi; \
            _Pragma("unroll") for (int r = 0; r < 16; ++r) { const int kv_ = kbase_ + (r & 3) + 8 * (r >> 2); if (kv_ > qg) P0[r] = -1e30f; if (kv_ + 32 > qg) P1[r] = -1e30f; } } \
        const float d_ = mref - MOFF;                         \
        const float mx_ = rowmax32(P0, P1) - d_;              \
        if ((t_) == 0 || __any(mx_ > 8.f || d_ != 0.f)) { const float dl_ = ((t_) == 0) ? mx_ : fmaxf(mx_, 0.f); mref += dl_; \
            const float sh_ = d_ + dl_; \
            _Pragma("unroll") for (int r = 0; r < 16; ++r) { P0[r] -= sh_; P1[r] -= sh_; } \
            const float al_ = ((t_) == 0) ? 1.f : __builtin_amdgcn_exp2f(-dl_); lrun *= al_;     \
            _Pragma("unroll") for (int r = 0; r < 16; ++r) { o0[r] *= al_; o1[r] *= al_; negm[r] = -mref; } asm volatile("" : "+v"(negm)); } \
    } while (0)
#define AT_SM2(P0, P1, t_) do { \
        float ps_ = 0.f; \
        _Pragma("unroll") for (int r = 0; r < 16; ++r) { P0[r] = __builtin_amdgcn_exp2f(P0[r]); P1[r] = __builtin_amdgcn_exp2f(P1[r]); ps_ += P0[r] + P1[r]; } \
        lrun += ps_; \
        const LAS unsigned char* Vs_ = lds + 2 * AT_KT + ((t_) & 1) * AT_VT + r32 * AT_VROW + 8 * hi; \
        _Pragma("unroll") for (int ks = 0; ks < 4; ++ks) { u32x4 w_; \
            if (ks < 2) { w_.x = pk2(P0[8 * ks], P0[8 * ks + 1]); w_.y = pk2(P0[8 * ks + 2], P0[8 * ks + 3]); w_.z = pk2(P0[8 * ks + 4], P0[8 * ks + 5]); w_.w = pk2(P0[8 * ks + 6], P0[8 * ks + 7]); } \
            else { w_.x = pk2(P1[8 * ks - 16], P1[8 * ks - 15]); w_.y = pk2(P1[8 * ks - 14], P1[8 * ks - 13]); w_.z = pk2(P1[8 * ks - 12], P1[8 * ks - 11]); w_.w = pk2(P1[8 * ks - 10], P1[8 * ks - 9]); } \
            const bf16x8 pa_ = __builtin_bit_cast(bf16x8, w_); \
            const u32x2 a0_ = *(const LAS u32x2*)(Vs_ + 32 * ks), a1_ = *(const LAS u32x2*)(Vs_ + 32 * ks + 16); \
            const u32x2 b0_ = *(const LAS u32x2*)(Vs_ + 32 * AT_VROW + 32 * ks), b1_ = *(const LAS u32x2*)(Vs_ + 32 * AT_VROW + 32 * ks + 16); \
            o0 = __builtin_amdgcn_mfma_f32_32x32x16_bf16(__builtin_bit_cast(bf16x8, (u32x4){a0_.x, a0_.y, a1_.x, a1_.y}), pa_, o0, 0, 0, 0); \
            o1 = __builtin_amdgcn_mfma_f32_32x32x16_bf16(__builtin_bit_cast(bf16x8, (u32x4){b0_.x, b0_.y, b1_.x, b1_.y}), pa_, o1, 0, 0, 0); } \
    } while (0)
#define AT_STEPM(C0, C1, MC, N0, N1, MN, t_) do { \
        AT_WRITEK((t_) + 1); AT_WRITEV(t_); \
        __syncthreads(); \
        AT_LOADK((t_) + 2); AT_LOADV((t_) + 1); \
        AT_SM1(C0, C1, MC, t_, 0); MN = mref; AT_QK(N0, N1, (t_) + 1); AT_SM2(C0, C1, t_); \
    } while (0)
#define AT_STEPB(C0, C1, MC, N0, N1, MN, t_) do { \
        if ((t_) + 1 < NT) AT_WRITEK((t_) + 1); AT_WRITEV(t_); \
        __syncthreads(); \
        if ((t_) + 2 < NT) AT_LOADK((t_) + 2); if ((t_) + 1 < NT) AT_LOADV((t_) + 1); \
        if ((t_) + 1 <= wlim) { MN = mref; AT_QK(N0, N1, (t_) + 1); } \
        if ((t_) <= wlim) { AT_SM1(C0, C1, MC, t_, 1); AT_SM2(C0, C1, t_); } \
    } while (0)
    f32x16 pA0, pA1, pB0 = {}, pB1 = {}; float mA = 0.f, mB = 0.f;
    AT_LOADK(0); AT_WRITEK(0);
    __syncthreads();
    AT_LOADK(1); AT_LOADV(0);
    AT_QK(pA0, pA1, 0);
    int t = 0;
    for (; t < 4 * qb; t += 2) {
        AT_STEPM(pA0, pA1, mA, pB0, pB1, mB, t);
        AT_STEPM(pB0, pB1, mB, pA0, pA1, mA, t + 1);
    }
    for (; t < NT; t += 2) {
        AT_STEPB(pA0, pA1, mA, pB0, pB1, mB, t);
        AT_STEPB(pB0, pB1, mB, pA0, pA1, mA, t + 1);
    }
#undef AT_STEPM
#undef AT_STEPB
#undef AT_LOADK
#undef AT_LOADV
#undef AT_WRITEK
#undef AT_WRITEV
#undef AT_QK
#undef AT_SM1
#undef AT_SM2
    lrun += __shfl_xor(lrun, 32);
    const float inv = 1.f / lrun;
    bf16_t* op = MIX + (size_t)qg * 1024 + 512 + h * 64;
#pragma unroll
    for (int g = 0; g < 4; ++g) { const int dv = 8 * g + 4 * hi;
        u32x2 w; w.x = pk2(o0[4 * g] * inv, o0[4 * g + 1] * inv); w.y = pk2(o0[4 * g + 2] * inv, o0[4 * g + 3] * inv); *(u32x2*)(op + dv) = w;
        u32x2 w2; w2.x = pk2(o1[4 * g] * inv, o1[4 * g + 1] * inv); w2.y = pk2(o1[4 * g + 2] * inv, o1[4 * g + 3] * inv); *(u32x2*)(op + 32 + dv) = w2; }
    __syncthreads();
}
DI void phase_attn(int wv, const ArgP a, LAS unsigned char* lds) {
    unsigned char* ws = a.ws();
    const bf16_t* QB = (const bf16_t*)(ws + O_QB); const bf16_t* KB = (const bf16_t*)(ws + O_KB); const bf16_t* VT = (const bf16_t*)(ws + O_VT); bf16_t* MIX = (bf16_t*)(ws + O_MIX);
    if (wv >= 4) __builtin_amdgcn_s_setprio(1);
    for (int b = blockIdx.x; b < 256; b += gridDim.x) {
        const int v = (b & 7) * 32 + (b >> 3), h = v >> 5, s = v & 31;
        attn_unit(wv, h, 63 - s, QB, KB, VT, MIX, lds);
        attn_unit(wv, h, s, QB, KB, VT, MIX, lds);
    }
    __builtin_amdgcn_s_setprio(0);
}

DI void phase_m_gates(int wv, const ArgP a, LAS unsigned char* lds) {
    unsigned char* ws = a.ws(); const int tid = ltid(wv), wave = tid >> 6, lane = tid & 63;
    const bf16_t* XBr = (const bf16_t*)(ws + O_XB) + 2 * 1024; const u64* rowss = (const u64*)(ws + O_ROWSS) + 2 * S;
    const float* Wg = a.in(17); const float* gn = a.in(16);
    LAS float* wgs = (LAS float*)lds;
    LAS float* pre = (LAS float*)(lds + 32768);
    float* GB = (float*)(ws + O_GB); float* GE = (float*)(ws + O_GE); float* GPM = (float*)(ws + O_GPM);
    float* BL = (float*)(ws + O_BL); float* ML = (float*)(ws + O_ML);
    for (int e = tid; e < 8192; e += 512) { const int k = e >> 3, j = e & 7; wgs[j * 1024 + k] = Wg[(size_t)k * 3080 + 3072 + j] * gn[k]; }
    __syncthreads();
    for (int c = blockIdx.x; c < 256; c += gridDim.x) {
#pragma unroll 4
        for (int i = 0; i < 8; ++i) { const int t = c * 64 + wave * 8 + i;
            float acc[8];
#pragma unroll
            for (int j = 0; j < 8; ++j) acc[j] = 0.f;
#pragma unroll
            for (int jj = 0; jj < 4; ++jj) { const int k0 = jj * 256 + lane * 4; const u32x2 hb = *(const u32x2*)(XBr + (size_t)t * 1024 + k0); const f32x4 hv = {bflo(hb.x), bfhi(hb.x), bflo(hb.y), bfhi(hb.y)};
#pragma unroll
                for (int j = 0; j < 8; ++j) { const f32x4 wj = *(const LAS f32x4*)(wgs + j * 1024 + k0); acc[j] += hv[0] * wj[0] + hv[1] * wj[1] + hv[2] * wj[2] + hv[3] * wj[3]; } }
            const float rs = rs_from_ss(rowss[t]);
            { const bool b5 = lane & 32, b4 = lane & 16, b3 = lane & 8;
#pragma unroll
              for (int j = 0; j < 4; ++j) { const float snd = b5 ? acc[j] : acc[j + 4], kp = b5 ? acc[j + 4] : acc[j]; acc[j] = kp + __shfl_xor(snd, 32); }
#pragma unroll
              for (int j = 0; j < 2; ++j) { const float snd = b4 ? acc[j] : acc[j + 2], kp = b4 ? acc[j + 2] : acc[j]; acc[j] = kp + __shfl_xor(snd, 16); }
              { const float snd = b3 ? acc[0] : acc[1], kp = b3 ? acc[1] : acc[0]; acc[0] = kp + __shfl_xor(snd, 8); }
              acc[0] += __shfl_xor(acc[0], 4); acc[0] += __shfl_xor(acc[0], 2); acc[0] += __shfl_xor(acc[0], 1);
              if ((lane & 7) == 0) pre[(wave * 8 + i) * 8 + (b5 ? 4 : 0) + (b4 ? 2 : 0) + (b3 ? 1 : 0)] = acc[0] * rs; }
        }
        __syncthreads();
        if (wave < 4) { const int h = wave; const float bi = a.in(18)[h], bfg = a.in(19)[h];
            const float ig = 15.f * tanhf((pre[lane * 8 + h] + bi) * (1.f / 15.f));
            const float fg = 15.f * tanhf((pre[lane * 8 + 4 + h] + bfg) * (1.f / 15.f));
            float b = -log1pf(expf(-fg));
#pragma unroll
            for (int o = 1; o < 64; o <<= 1) { const float v = __shfl_up(b, o); if (lane >= o) b += v; }
            const float e = ig - b; float pm = e;
#pragma unroll
            for (int o = 1; o < 64; o <<= 1) { const float v = __shfl_up(pm, o); if (lane >= o) pm = fmaxf(pm, v); }
            const size_t o_ = (size_t)h * S + c * 64 + lane; GB[o_] = b; GE[o_] = e; GPM[o_] = pm;
            if (lane == 63) { BL[c * 4 + h] = b; ML[c * 4 + h] = b + pm; } }
        __syncthreads();
    }
}
DI void phase_m_dc(int wv, const ArgP a) {
    unsigned char* ws = a.ws(); const int tid = ltid(wv), lane = tid & 63, r32 = lane & 31, hi = lane >> 5; const int w = __builtin_amdgcn_readfirstlane(tid >> 6);
    const float* __restrict__ BL = (const float*)(ws + O_BL); const float* __restrict__ ML = (const float*)(ws + O_ML); float* __restrict__ NST = (float*)(ws + O_NST);
    const float* __restrict__ GE = (const float*)(ws + O_GE); const bf16_t* __restrict__ KVT = (const bf16_t*)(ws + O_KVT); bf16_t* __restrict__ CST = (bf16_t*)(ws + O_CST);
#pragma unroll 2
    for (int u = blockIdx.x; u < 1024; u += gridDim.x) {
        const int c = u >> 2, h = u & 3; const size_t t0 = (size_t)c * 64;
        const float emax = ML[c * 4 + h] - BL[c * 4 + h];
        bf16x8 bfr[4];
        { const bf16_t* vp = KVT + (size_t)(512 + h * 256 + 32 * w + r32) * S + t0 + 8 * hi; const float* gp = GE + (size_t)h * S + t0 + 8 * hi;
#pragma unroll
          for (int ks = 0; ks < 4; ++ks) { const u32x4 v = *(const u32x4*)(vp + 16 * ks); const f32x4 e0 = *(const f32x4*)(gp + 16 * ks), e1 = *(const f32x4*)(gp + 16 * ks + 4);
              u32x4 o; o.x = pk2(bflo(v.x) * fexp(e0[0] - emax), bfhi(v.x) * fexp(e0[1] - emax)); o.y = pk2(bflo(v.y) * fexp(e0[2] - emax), bfhi(v.y) * fexp(e0[3] - emax));
              o.z = pk2(bflo(v.z) * fexp(e1[0] - emax), bfhi(v.z) * fexp(e1[1] - emax)); o.w = pk2(bflo(v.w) * fexp(e1[2] - emax), bfhi(v.w) * fexp(e1[3] - emax));
              bfr[ks] = __builtin_bit_cast(bf16x8, o); } }
        const bf16_t* kp = KVT + (size_t)(h * 128 + r32) * S + t0 + 8 * hi;
        bf16_t* op = CST + ((size_t)(c * 4 + h) * 256 + 32 * w + r32) * 128 + 4 * hi;
#pragma unroll
        for (int rb = 0; rb < 4; ++rb) { f32x16 acc = {};
#pragma unroll
            for (int ks = 0; ks < 4; ++ks) { const bf16x8 ka = *(const bf16x8*)(kp + (size_t)(32 * rb) * S + 16 * ks); acc = __builtin_amdgcn_mfma_f32_32x32x16_bf16(ka, bfr[ks], acc, 0, 0, 0); }
#pragma unroll
            for (int g = 0; g < 4; ++g) { u32x2 o; o.x = pk2(acc[4 * g], acc[4 * g + 1]); o.y = pk2(acc[4 * g + 2], acc[4 * g + 3]); *(u32x2*)(op + 32 * rb + 8 * g) = o; } }
        if (tid < 128) { const bf16_t* kr = KVT + (size_t)(h * 128 + tid) * S + t0; const float* gp = GE + (size_t)h * S + t0; float s = 0.f;
#pragma unroll
            for (int p = 0; p < 8; ++p) { const u32x4 v = *(const u32x4*)(kr + 8 * p); const f32x4 e0 = *(const f32x4*)(gp + 8 * p), e1 = *(const f32x4*)(gp + 8 * p + 4);
                s += bflo(v.x) * fexp(e0[0] - emax) + bfhi(v.x) * fexp(e0[1] - emax) + bflo(v.y) * fexp(e0[2] - emax) + bfhi(v.y) * fexp(e0[3] - emax)
                   + bflo(v.z) * fexp(e1[0] - emax) + bfhi(v.z) * fexp(e1[1] - emax) + bflo(v.w) * fexp(e1[2] - emax) + bfhi(v.w) * fexp(e1[3] - emax); }
            NST[(size_t)(c * 4 + h) * 128 + tid] = s; }
    }
}
DI void phase_m_comb(int wv, const ArgP a, LAS unsigned char* lds, int dry) {
    unsigned char* ws = a.ws(); const int tid = ltid(wv);
    const float* BL = (const float*)(ws + O_BL); const float* ML = (const float*)(ws + O_ML); float* MST = (float*)(ws + O_MST); float* NST = (float*)(ws + O_NST);
    bf16_t* CST = (bf16_t*)(ws + O_CST);
    LAS float* bls = (LAS float*)lds; LAS float* mls = bls + 1024; LAS float* ga = mls + 1024; LAS float* gb = ga + 1024;
    for (int e = tid; e < 1024; e += 512) { bls[e] = BL[e]; mls[e] = ML[e]; }
    __syncthreads();
    if (tid < 256) { const int h = tid >> 6, l = tid & 63;
        float a_ = 0.f, b_ = -1e30f;
#pragma unroll
        for (int k = 0; k < 4; ++k) { const float bl = bls[(4 * l + k) * 4 + h], ml = mls[(4 * l + k) * 4 + h]; a_ += bl; b_ = fmaxf(b_ + bl, ml); }
        float pa = a_, pb = b_;
#pragma unroll
        for (int o = 1; o < 64; o <<= 1) { const float qa = __shfl_up(pa, o), qb = __shfl_up(pb, o); if (l >= o) { pb = fmaxf(qb + pa, pb); pa = qa + pa; } }
        float ea = __shfl_up(pa, 1), eb_ = __shfl_up(pb, 1); if (l == 0) { ea = 0.f; eb_ = -1e30f; }
        float m = fmaxf(0.f + ea, eb_);
#pragma unroll
        for (int k = 0; k < 4; ++k) { const int c = 4 * l + k; const float bl = bls[c * 4 + h], ml = mls[c * 4 + h]; const float mn = fmaxf(bl + m, ml);
            ga[c * 4 + h] = fexp(bl + m - mn); gb[c * 4 + h] = fexp(ml - mn);
            if (blockIdx.x == 0 && !dry) MST[c * 4 + h] = m;
            m = mn; } }
    __syncthreads();
    for (int eb = blockIdx.x; eb < 129; eb += gridDim.x) {
        if (eb < 128) { const int h = eb >> 5; unsigned* p = (unsigned*)(CST + (size_t)h * 32768 + (size_t)(eb & 31) * 1024 + 2 * tid); float C0 = 0.f, C1 = 0.f;
            for (int c = 0; c < 256; c += 64) { unsigned d[64];
#pragma unroll
                for (int k = 0; k < 64; ++k) d[k] = p[(size_t)(c + k) * 65536];
#pragma unroll
                for (int k = 0; k < 64; ++k) { if (!dry) p[(size_t)(c + k) * 65536] = pk2(C0, C1); const float a_ = ga[(c + k) * 4 + h], b_ = gb[(c + k) * 4 + h]; C0 = a_ * C0 + b_ * bflo(d[k]); C1 = a_ * C1 + b_ * bfhi(d[k]); } }
        } else { const int h = tid >> 7; float* p = NST + tid; float C = 0.f;
            for (int c = 0; c < 256; c += 8) { float d[8];
#pragma unroll
                for (int k = 0; k < 8; ++k) d[k] = p[(size_t)(c + k) * 512];
#pragma unroll
                for (int k = 0; k < 8; ++k) { if (!dry) p[(size_t)(c + k) * 512] = C; C = ga[(c + k) * 4 + h] * C + gb[(c + k) * 4 + h] * d[k]; } } }
    }
    __syncthreads();
}
constexpr int MC_QROW = 272, MC_SROW = 144;
constexpr int MC_QS = 0, MC_KS = 64 * MC_QROW, MC_SC = 2 * 64 * MC_QROW, MC_F = MC_SC + 64 * MC_SROW;
DI void phase_m_out(int wv, const ArgP a, LAS unsigned char* lds, int dry) {
    unsigned char* ws = a.ws(); const int tid = ltid(wv), lane = tid & 63, r32 = lane & 31, hi = lane >> 5; const int w = __builtin_amdgcn_readfirstlane(tid >> 6);
    bf16_t* QOK = (bf16_t*)(ws + O_QOK); const bf16_t* KVT = (const bf16_t*)(ws + O_KVT); const bf16_t* CST = (const bf16_t*)(ws + O_CST);
    const float* GB = (const float*)(ws + O_GB); const float* GE = (const float*)(ws + O_GE); const float* GPM = (const float*)(ws + O_GPM);
    const float* MST = (const float*)(ws + O_MST); const float* NST = (const float*)(ws + O_NST); const float* ong = a.in(20);
    LAS unsigned char* Qs = lds + MC_QS; LAS unsigned char* Ks = lds + MC_KS; LAS unsigned char* Sc = lds + MC_SC;
    LAS float* F = (LAS float*)(lds + MC_F);
    LAS float* f_b = F, *f_e = F + 64, *f_m = F + 128, *f_g = F + 192, *f_qn = F + 256, *f_ps = F + 320  , *f_n = F + 576  , *f_part = F + 704  ;
    for (int u = blockIdx.x; u < 1024; u += gridDim.x) {
        const int c = u >> 2, h = u & 3; const size_t t0 = (size_t)c * 64;
        for (int e = tid; e < 1024; e += 512) { const int r = e >> 4, p = e & 15;
            *(LAS u32x4*)(Qs + r * MC_QROW + p * 16) = *(const u32x4*)(QOK + (t0 + r) * 2048 + h * 128 + p * 8);
            *(LAS u32x4*)(Ks + r * MC_QROW + p * 16) = *(const u32x4*)(QOK + (t0 + r) * 2048 + 1536 + h * 128 + p * 8); }
        if (tid < 64) { const float mstv = MST[c * 4 + h]; const float b = GB[(size_t)h * S + t0 + tid], e = GE[(size_t)h * S + t0 + tid], pm = GPM[(size_t)h * S + t0 + tid];
            const float m = b + fmaxf(mstv, pm); f_b[tid] = b; f_e[tid] = e; f_m[tid] = m; f_g[tid] = fexp(b + mstv - m); }
        if (tid >= 64 && tid < 192) f_n[tid - 64] = NST[(size_t)(c * 4 + h) * 128 + tid - 64];
        __syncthreads();
        if (w < 4) {
            const int sb = w & 1, tb = w >> 1; const int tl = 32 * tb + r32;
            f32x16 x = {};
#pragma unroll
            for (int ks = 0; ks < 8; ++ks) {
                const bf16x8 ka = *(const LAS bf16x8*)(Ks + (32 * sb + r32) * MC_QROW + (16 * ks + 8 * hi) * 2);
                const bf16x8 qb = *(const LAS bf16x8*)(Qs + tl * MC_QROW + (16 * ks + 8 * hi) * 2);
                x = __builtin_amdgcn_mfma_f32_32x32x16_bf16(ka, qb, x, 0, 0, 0); }
            const float bt = f_b[tl], mt = f_m[tl]; float ps = 0.f;
#pragma unroll
            for (int g = 0; g < 4; ++g) { float v[4];
#pragma unroll
                for (int j = 0; j < 4; ++j) { const int sl = 32 * sb + 8 * g + 4 * hi + j; const float wgt = (sl <= tl) ? fexp(bt + f_e[sl] - mt) : 0.f; v[j] = x[4 * g + j] * wgt; ps += v[j]; }
                u32x2 o; o.x = pk2(v[0], v[1]); o.y = pk2(v[2], v[3]);
                *(LAS u32x2*)(Sc + tl * MC_SROW + (32 * sb + 8 * g + 4 * hi) * 2) = o; }
            f_ps[(sb * 2 + hi) * 64 + tl] = ps;
        } else {
            const int tl = 16 * (w - 4) + (lane >> 2), qq = lane & 3; float s = 0.f;
#pragma unroll
            for (int p = 0; p < 4; ++p) { const u32x4 v = *(const LAS u32x4*)(Qs + tl * MC_QROW + (32 * qq + 8 * p) * 2); LAS float* np = f_n + 32 * qq + 8 * p;
                s += bflo(v.x) * np[0] + bfhi(v.x) * np[1] + bflo(v.y) * np[2] + bfhi(v.y) * np[3] + bflo(v.z) * np[4] + bfhi(v.z) * np[5] + bflo(v.w) * np[6] + bfhi(v.w) * np[7]; }
            s += __shfl_xor(s, 1); s += __shfl_xor(s, 2);
            if (qq == 0) f_qn[tl] = s;
        }
        __syncthreads();
        f32x16 acc0 = {}, acc1 = {};
        { const bf16_t* cp = CST + ((size_t)(c * 4 + h) * 256 + 32 * w + r32) * 128 + 8 * hi;
#pragma unroll
          for (int ks = 0; ks < 8; ++ks) { const bf16x8 ca = *(const bf16x8*)(cp + 16 * ks);
              const bf16x8 q0 = *(const LAS bf16x8*)(Qs + r32 * MC_QROW + (16 * ks + 8 * hi) * 2), q1 = *(const LAS bf16x8*)(Qs + (32 + r32) * MC_QROW + (16 * ks + 8 * hi) * 2);
              acc0 = __builtin_amdgcn_mfma_f32_32x32x16_bf16(ca, q0, acc0, 0, 0, 0); acc1 = __builtin_amdgcn_mfma_f32_32x32x16_bf16(ca, q1, acc1, 0, 0, 0); } }
        const float g0 = f_g[r32], g1 = f_g[32 + r32];
#pragma unroll
        for (int r = 0; r < 16; ++r) { acc0[r] *= g0; acc1[r] *= g1; }
        { const bf16_t* vp = KVT + (size_t)(512 + h * 256 + 32 * w + r32) * S + t0 + 8 * hi;
#pragma unroll
          for (int ks = 0; ks < 4; ++ks) { const bf16x8 va = *(const bf16x8*)(vp + 16 * ks);
              const bf16x8 s0 = *(const LAS bf16x8*)(Sc + r32 * MC_SROW + (16 * ks + 8 * hi) * 2), s1 = *(const LAS bf16x8*)(Sc + (32 + r32) * MC_SROW + (16 * ks + 8 * hi) * 2);
              acc0 = __builtin_amdgcn_mfma_f32_32x32x16_bf16(va, s0, acc0, 0, 0, 0); acc1 = __builtin_amdgcn_mfma_f32_32x32x16_bf16(va, s1, acc1, 0, 0, 0); } }
        float inv[2];
#pragma unroll
        for (int tb = 0; tb < 2; ++tb) { const int tl = 32 * tb + r32;
            const float den = f_g[tl] * f_qn[tl] + f_ps[tl] + f_ps[64 + tl] + f_ps[128 + tl] + f_ps[192 + tl];
            inv[tb] = 1.f / fmaxf(fabsf(den), fexp(-f_m[tl])); }
        float ss0 = 0.f, ss1 = 0.f;
#pragma unroll
        for (int r = 0; r < 16; ++r) { acc0[r] *= inv[0]; acc1[r] *= inv[1]; ss0 += acc0[r] * acc0[r]; ss1 += acc1[r] * acc1[r]; }
        ss0 += __shfl_xor(ss0, 32); ss1 += __shfl_xor(ss1, 32);
        if (hi == 0) { f_part[w * 64 + r32] = ss0; f_part[w * 64 + 32 + r32] = ss1; }
        __syncthreads();
        float rn[2];
#pragma unroll
        for (int tb = 0; tb < 2; ++tb) { float s = 0.f;
#pragma unroll
            for (int ww = 0; ww < 8; ++ww) s += f_part[ww * 64 + 32 * tb + r32];
            rn[tb] = rsqrtf(s * (1.f / 256.f) + EPS); }
#pragma unroll
        for (int tb = 0; tb < 2; ++tb) { bf16_t* op = QOK + (t0 + 32 * tb + r32) * 2048 + 512 + h * 256 + 32 * w;
#pragma unroll
            for (int g = 0; g < 4; ++g) { const int dv = 8 * g + 4 * hi; const u32x2 ov = *(const u32x2*)(op + dv);
                const f32x4 gg = *(const f32x4*)(ong + h * 256 + 32 * w + dv);
                const float og[4] = {bflo(ov.x), bfhi(ov.x), bflo(ov.y), bfhi(ov.y)}; float y[4];
#pragma unroll
                for (int j = 0; j < 4; ++j) { const float hv = (tb ? acc1[4 * g + j] : acc0[4 * g + j]) * rn[tb]; y[j] = hv * gg[j] * sigmoidf_(og[j]); }
                u32x2 o; o.x = pk2(y[0], y[1]); o.y = pk2(y[2], y[3]); if (!dry) *(u32x2*)(op + dv) = o; } }
        __syncthreads();
    }
}

DI void phase_final(int wv, const ArgP a) {
    float* out = a.out(); const u64* rowss = (const u64*)(a.ws() + O_ROWSS) + 4 * S; const float* g = a.in(27); const bf16_t* XBr = (const bf16_t*)(a.ws() + O_XB) + 2 * 1024;
    for (size_t e = (size_t)blockIdx.x * 512 + ltid(wv); e < (size_t)S * 128; e += (size_t)gridDim.x * 512) { const int t = (int)(e >> 7), c = (int)(e & 127) * 8;
        const float rs = rs_from_ss(rowss[t]); const u32x4 hb = *(const u32x4*)(XBr + (size_t)t * 1024 + c); const f32x4 g0 = *(const f32x4*)(g + c), g1 = *(const f32x4*)(g + c + 4);
        const f32x4 v0 = (f32x4){bflo(hb.x), bfhi(hb.x), bflo(hb.y), bfhi(hb.y)} * rs * g0, v1 = (f32x4){bflo(hb.z), bfhi(hb.z), bflo(hb.w), bfhi(hb.w)} * rs * g1;
        *(f32x4*)(out + (size_t)t * 1024 + c) = v0; *(f32x4*)(out + (size_t)t * 1024 + c + 4) = v1; }
}

#ifndef DIS
#define DIS 0u
#endif
#ifndef REP
#define REP 0u
#endif
#ifndef XSYNC
#define XSYNC 0
#endif

#define XB_TMO      128
#define XB_XCNT(j)  (256  + 64 * (j))
#define XB_XSUB(j)  (1280 + 64 * (j))
#define XB_XGEN(j)  (2304 + 64 * (j))
#define XB_TOP      3328
#define XB_TOPGEN   3392
#define XB_SPIN_CAP (1u << 18)
DI unsigned xb_ld(unsigned* p) { return __hip_atomic_load(p, __ATOMIC_RELAXED, __HIP_MEMORY_SCOPE_AGENT); }
DI unsigned xb_add(unsigned* p, unsigned v) { return __hip_atomic_fetch_add(p, v, __ATOMIC_RELAXED, __HIP_MEMORY_SCOPE_AGENT); }
DI unsigned xb_xcc_id() { return (unsigned)__builtin_amdgcn_s_getreg((3 << 11) | 20) & 0xFu; }
#define XB_SPIN(cond, bar) do { unsigned _sp = 0; while (cond) { __builtin_amdgcn_s_sleep(1); \
    if ((++_sp & 255u) == 0u) { if (xb_ld(&(bar)[XB_TMO])) break; if (_sp > XB_SPIN_CAP) { atomicAdd(&(bar)[XB_TMO], 1u); break; } } } } while (0)
DI void xcd_barrier_complete(unsigned* bar, unsigned x, unsigned& nloc, unsigned& nx) {
    const unsigned G = gridDim.x;
    unsigned sum, cnt, mine, sp = 0u;
    for (;;) {
        sum = 0u; cnt = 0u; mine = 0u;
#pragma unroll
        for (unsigned j = 0; j < 16; ++j) { const unsigned c = xb_ld(&bar[XB_XCNT(j)]); sum += c; cnt += (c > 0u) ? 1u : 0u; mine = (j == x) ? c : mine; }
        if (sum == G) break;
        __builtin_amdgcn_s_sleep(1);
        if ((++sp & 255u) == 0u) { if (xb_ld(&bar[XB_TMO])) break; if (sp > XB_SPIN_CAP) { atomicAdd(&bar[XB_TMO], 1u); break; } }
    }
    nloc = mine > 0u ? mine : 1u; nx = cnt > 0u ? cnt : 1u;
}
DI void xcd_barrier(int wv, unsigned* bar, volatile LAS unsigned* st) {
    asm volatile("s_waitcnt vmcnt(0)" ::: "memory");
    __syncthreads();
    if (ltid(wv) == 0) {
        const unsigned x = xb_xcc_id();
        __builtin_amdgcn_s_waitcnt(0);
        unsigned nloc = st[0], nx = st[1];
        if (nloc == 0u) { xcd_barrier_complete(bar, x, nloc, nx); st[0] = nloc; st[1] = nx; }
        const unsigned old = xb_add(&bar[XB_XSUB(x)], 1u);
        const unsigned gen = old / nloc;
        if (old + 1u == (gen + 1u) * nloc) {
            __builtin_amdgcn_fence(__ATOMIC_RELEASE, "agent");
            asm volatile("s_waitcnt vmcnt(0)" ::: "memory");
            const unsigned og = xb_add(&bar[XB_TOP], 1u);
            const unsigned tg = og / nx;
            if (og + 1u == (tg + 1u) * nx) xb_add(&bar[XB_TOPGEN], 1u);
            else XB_SPIN(xb_ld(&bar[XB_TOPGEN]) == tg, bar);
            __builtin_amdgcn_fence(__ATOMIC_ACQUIRE, "agent");
            xb_add(&bar[XB_XGEN(x)], 1u);
            asm volatile("s_waitcnt vmcnt(0)" ::: "memory");
        } else {
            XB_SPIN(xb_ld(&bar[XB_XGEN(x)]) == gen, bar);
            __builtin_amdgcn_fence(__ATOMIC_ACQUIRE, "agent");
            asm volatile("s_waitcnt vmcnt(0)" ::: "memory");
        }
    }
    __syncthreads();
}
DI ArgP getargs() { ArgP r; r.p = (const __attribute__((address_space(4))) Args*)__builtin_amdgcn_kernarg_segment_ptr(); asm volatile("" : "+s"(r.p)); return r; }
#define WSB (getargs().ws())
#define XBP ((bf16_t*)(getargs().ws() + O_XB) + 2 * 1024)
#define RSS ((u64*)(getargs().ws() + O_ROWSS))
#define HFP (getargs().out())
__global__ void __launch_bounds__(512, 2) fwd_kernel(Args a_unused) {
    extern __shared__ __attribute__((aligned(16))) unsigned char shm[];
    LAS unsigned char* lds = (LAS unsigned char*)shm;
    const int wv = __builtin_amdgcn_readfirstlane(threadIdx.x >> 6);
#define BARW ((unsigned*)(getargs().ws() + O_BAR))
#define BARST ((volatile LAS unsigned*)(lds + 139264))
#define GSYNC() xcd_barrier(wv, BARW, BARST)
    { unsigned* barw0 = BARW; if (threadIdx.x == 0) { BARST[0] = 0u; BARST[1] = 0u; (void)xb_add(&barw0[XB_XCNT(xb_xcc_id())], 1u); } }
    if (getargs().p->pad == 0x7fffffff) cg::this_grid().sync();

#if !(DIS & (1u << 0))
    for (int rep_ = 0; rep_ < ((REP >> 0) & 1u) + 1; ++rep_) { const int dry_ = rep_ < (int)((REP >> 0) & 1u); (void)dry_;
    phase_prologue(wv, getargs(), lds, dry_ ? PROPART : 7);
    }
#endif
    GSYNC();
#if !(DIS & (1u << 1))
    for (int rep_ = 0; rep_ < ((REP >> 1) & 1u) + 1; ++rep_) { const int dry_ = rep_ < (int)((REP >> 1) & 1u); (void)dry_;
    { EpiRowBf16<1> E{(bf16_t*)(WSB + O_Z), 1536, RSS};
      pg8::gemm_phase<false>(wv, lds, XBP, 1024, (const bf16_t*)(WSB + O_W1T), 1024, 1024, 64, 6, E); }
    }
#endif
    GSYNC();
#if !(DIS & (1u << 2))
    for (int rep_ = 0; rep_ < ((REP >> 2) & 1u) + 1; ++rep_) { const int dry_ = rep_ < (int)((REP >> 2) & 1u); (void)dry_;
    phase_l0_prep(wv, getargs());
    }
#endif
    GSYNC();
#if !(DIS & (1u << 3))
    for (int rep_ = 0; rep_ < ((REP >> 3) & 1u) + 1; ++rep_) { const int dry_ = rep_ < (int)((REP >> 3) & 1u); (void)dry_;
    { EpiRowBf16<0> E{(bf16_t*)(WSB + O_RI), 1024, nullptr};
      pg8::gemm_phase<false>(wv, lds, (const bf16_t*)(WSB + O_XC), 512, (const bf16_t*)(WSB + O_WRIT), 512, 512, 64, 4, E); }
    }
#endif
#if !(DIS & (1u << 4))
    for (int rep_ = 0; rep_ < ((REP >> 4) & 1u) + 1; ++rep_) { const int dry_ = rep_ < (int)((REP >> 4) & 1u); (void)dry_;
    { EpiQ E{(bf16_t*)(WSB + O_QB), (const float*)(WSB + O_RSQ), (const float*)(WSB + O_CSTAB)};
      pg8::gemm_phase<false>(wv, lds, (const bf16_t*)(WSB + O_Z) + 1024, 1536, (const bf16_t*)(WSB + O_WQT), 256, 256, 64, 3, E); }
    }
#endif
#if !(DIS & (1u << 5))
    for (int rep_ = 0; rep_ < ((REP >> 5) & 1u) + 1; ++rep_) { const int dry_ = rep_ < (int)((REP >> 5) & 1u); (void)dry_;
    { EpiK E{(bf16_t*)(WSB + O_KB), (const float*)(WSB + O_RSKV)};
      pg8::gemm_phase<false>(wv, lds, (const bf16_t*)(WSB + O_Z) + 1280, 1536, (const bf16_t*)(WSB + O_WKT), 256, 256, 64, 2, E, 192); }
    }
#endif
#if !(DIS & (1u << 6))
    for (int rep_ = 0; rep_ < ((REP >> 6) & 1u) + 1; ++rep_) { const int dry_ = rep_ < (int)((REP >> 6) & 1u); (void)dry_;
    { EpiColBf16<2> E{(bf16_t*)(WSB + O_VT), S, (const float*)(WSB + O_RSKV)};
      pg8::gemm_phase<false>(wv, lds, (const bf16_t*)(WSB + O_WVT), 256, (const bf16_t*)(WSB + O_Z) + 1280, 1536, 256, 2, 64, E, 64); }
    }
#endif
    GSYNC();
#if !(DIS & (1u << 7))
    for (int rep_ = 0; rep_ < ((REP >> 7) & 1u) + 1; ++rep_) { const int dry_ = rep_ < (int)((REP >> 7) & 1u); (void)dry_;
    phase_lru_s1(wv, getargs());
    }
#endif
    GSYNC();
#if !(DIS & (1u << 8))
    for (int rep_ = 0; rep_ < ((REP >> 8) & 1u) + 1; ++rep_) { const int dry_ = rep_ < (int)((REP >> 8) & 1u); (void)dry_;
    phase_lru_s3(wv, getargs());
    }
#endif
#if !(DIS & (1u << 9))
    for (int rep_ = 0; rep_ < ((REP >> 9) & 1u) + 1; ++rep_) { const int dry_ = rep_ < (int)((REP >> 9) & 1u); (void)dry_;
    phase_attn(wv, getargs(), lds);
    }
#endif
    GSYNC();
#if !(DIS & (1u << 10))
    for (int rep_ = 0; rep_ < ((REP >> 10) & 1u) + 1; ++rep_) { const int dry_ = rep_ < (int)((REP >> 10) & 1u); (void)dry_;
    { EpiRes<false> E{getargs().in(0), XBP, RSS + 1 * S, dry_};
      pg8::gemm_phase<false>(wv, lds, (const bf16_t*)(WSB + O_MIX), 1024, (const bf16_t*)(WSB + O_WO1T), 1024, 1024, 64, 4, E); }
    }
#endif
    GSYNC();
#if !(DIS & (1u << 11))
    for (int rep_ = 0; rep_ < ((REP >> 11) & 1u) + 1; ++rep_) { const int dry_ = rep_ < (int)((REP >> 11) & 1u); (void)dry_;
    { EpiUp E{(bf16_t*)(WSB + O_ACT), RSS + 1 * S, getargs().in(24), getargs().in(25), lds + 131072};
      pg8::gemm_phase<true>(wv, lds, XBP, 1024, (const bf16_t*)(WSB + O_WUPT0), 1024, 1024, 67, 22, E); }
    }
#endif
    GSYNC();
#if !(DIS & (1u << 12))
    for (int rep_ = 0; rep_ < ((REP >> 12) & 1u) + 1; ++rep_) { const int dry_ = rep_ < (int)((REP >> 12) & 1u); (void)dry_;
    { EpiRes<true> E{nullptr, XBP, RSS + 2 * S, dry_};
      pg8::gemm_phase<false>(wv, lds, (const bf16_t*)(WSB + O_ACT), 2816, (const bf16_t*)(WSB + O_WDNT0), 2816, 2816, 64, 4, E); }
    }
#endif
    GSYNC();
#if !(DIS & (1u << 13))
    for (int rep_ = 0; rep_ < ((REP >> 13) & 1u) + 1; ++rep_) { const int dry_ = rep_ < (int)((REP >> 13) & 1u); (void)dry_;
    { EpiRowBf16<1> E{(bf16_t*)(WSB + O_QOK), 2048, RSS + 2 * S};
      pg8::gemm_phase<false>(wv, lds, XBP, 1024, (const bf16_t*)(WSB + O_WOINT), 1024, 1024, 64, 8, E); }
    }
#endif
#if !(DIS & (1u << 14))
    for (int rep_ = 0; rep_ < ((REP >> 14) & 1u) + 1; ++rep_) { const int dry_ = rep_ < (int)((REP >> 14) & 1u); (void)dry_;
    { EpiColBf16<1> E{(bf16_t*)(WSB + O_KVT), S, RSS + 2 * S};
      pg8::gemm_phase<false>(wv, lds, (const bf16_t*)(WSB + O_WOINT) + (size_t)1536 * 1024, 1024, XBP, 1024, 1024, 6, 64, E); }
    }
#endif
#if !(DIS & (1u << 15))
    for (int rep_ = 0; rep_ < ((REP >> 15) & 1u) + 1; ++rep_) { const int dry_ = rep_ < (int)((REP >> 15) & 1u); (void)dry_;
    phase_m_gates(wv, getargs(), lds);
    }
#endif
    GSYNC();
#if !(DIS & (1u << 16))
    for (int rep_ = 0; rep_ < ((REP >> 16) & 1u) + 1; ++rep_) { const int dry_ = rep_ < (int)((REP >> 16) & 1u); (void)dry_;
    phase_m_dc(wv, getargs());
    }
#endif
    GSYNC();
#if !(DIS & (1u << 22))
    for (int rep_ = 0; rep_ < ((REP >> 22) & 1u) + 1; ++rep_) { const int dry_ = rep_ < (int)((REP >> 22) & 1u); (void)dry_;
    phase_m_comb(wv, getargs(), lds, dry_);
    }
#endif
    GSYNC();
#if !(DIS & (1u << 17))
    for (int rep_ = 0; rep_ < ((REP >> 17) & 1u) + 1; ++rep_) { const int dry_ = rep_ < (int)((REP >> 17) & 1u); (void)dry_;
    phase_m_out(wv, getargs(), lds, dry_);
    }
#endif
    GSYNC();
#if !(DIS & (1u << 18))
    for (int rep_ = 0; rep_ < ((REP >> 18) & 1u) + 1; ++rep_) { const int dry_ = rep_ < (int)((REP >> 18) & 1u); (void)dry_;
    { EpiRes<true> E{nullptr, XBP, RSS + 3 * S, dry_};
      pg8::gemm_phase<false>(wv, lds, (const bf16_t*)(WSB + O_QOK) + 512, 2048, (const bf16_t*)(WSB + O_WO2T), 1024, 1024, 64, 4, E); }
    }
#endif
    GSYNC();
#if !(DIS & (1u << 19))
    for (int rep_ = 0; rep_ < ((REP >> 19) & 1u) + 1; ++rep_) { const int dry_ = rep_ < (int)((REP >> 19) & 1u); (void)dry_;
    { EpiUp E{(bf16_t*)(WSB + O_ACT), RSS + 3 * S, getargs().in(24) + 3 * 5632, getargs().in(25) + 5632, lds + 131072};
      pg8::gemm_phase<true>(wv, lds, XBP, 1024, (const bf16_t*)(WSB + O_WUPT1), 1024, 1024, 67, 22, E); }
    }
#endif
    GSYNC();
#if !(DIS & (1u << 20))
    for (int rep_ = 0; rep_ < ((REP >> 20) & 1u) + 1; ++rep_) { const int dry_ = rep_ < (int)((REP >> 20) & 1u); (void)dry_;
    { EpiRes<true> E{nullptr, XBP, RSS + 4 * S, dry_};
      pg8::gemm_phase<false>(wv, lds, (const bf16_t*)(WSB + O_ACT), 2816, (const bf16_t*)(WSB + O_WDNT1), 2816, 2816, 64, 4, E); }
    }
#endif
    GSYNC();
#if !(DIS & (1u << 21))
    for (int rep_ = 0; rep_ < ((REP >> 21) & 1u) + 1; ++rep_) { const int dry_ = rep_ < (int)((REP >> 21) & 1u); (void)dry_;
    phase_final(wv, getargs());
    }
#endif
    for (int i = 0; i < XSYNC; ++i) GSYNC();
}

extern "C" void kernel_launch(void* const* d_in, const int* in_sizes, int n_in, void* d_out, int out_size, void* d_ws, size_t ws_size, hipStream_t stream) {
    static int grid = 0;
    if (grid == 0) {
        if (n_in != 28 || out_size != S * 1024 || ws_size < WS_NEED) { fprintf(stderr, "kernel_launch: unexpected shapes (n_in %d out %d ws %zu need %zu)\n", n_in, out_size, ws_size, (size_t)WS_NEED); grid = -1; return; }
        int dev = 0, cus = 0, per_cu = 0;
        (void)hipGetDevice(&dev);
        (void)hipDeviceGetAttribute(&cus, hipDeviceAttributeMultiprocessorCount, dev);
        if (hipFuncSetAttribute((const void*)fwd_kernel, hipFuncAttributeMaxDynamicSharedMemorySize, LDS_BYTES) != hipSuccess) { fprintf(stderr, "kernel_launch: hipFuncSetAttribute failed\n"); grid = -1; return; }
        if (hipOccupancyMaxActiveBlocksPerMultiprocessor(&per_cu, (const void*)fwd_kernel, 512, LDS_BYTES) != hipSuccess || per_cu < 1) { fprintf(stderr, "kernel_launch: occupancy query says %d\n", per_cu); per_cu = 1; }
        (void)hipGetLastError();
        grid = cus * 1;
        if (grid > 256) grid = 256;
    }
    if (grid < 0) return;
    Args a{};
    for (int i = 0; i < 28; ++i) a.in[i] = (const float*)d_in[i];
    a.out = (float*)d_out; a.ws = (unsigned char*)d_ws;
    if (hipMemsetAsync((char*)d_ws + O_BAR, 0, BAR_BYTES, stream) != hipSuccess) { fprintf(stderr, "kernel_launch: memset failed\n"); return; }
    void* args[] = {&a};
    hipError_t e = hipLaunchCooperativeKernel((void*)fwd_kernel, dim3(grid), dim3(512), args, LDS_BYTES, stream);
    if (e != hipSuccess) fprintf(stderr, "kernel_launch: cooperative launch failed: %s (grid %d)\n", hipGetErrorString(e), grid);
}
```

```cpp
#include <hip/hip_runtime.h>
#include <hip/hip_cooperative_groups.h>
#include <cstdio>
#include <cstdint>
namespace cg = cooperative_groups;

typedef unsigned short bf16_t;
typedef short bf16x8 __attribute__((ext_vector_type(8)));
typedef short s16x4 __attribute__((ext_vector_type(4)));
typedef float f32x2 __attribute__((ext_vector_type(2)));
typedef float f32x4 __attribute__((ext_vector_type(4)));
typedef float f32x16 __attribute__((ext_vector_type(16)));
typedef unsigned u32x2 __attribute__((ext_vector_type(2)));
typedef unsigned u32x4 __attribute__((ext_vector_type(4)));
typedef __bf16 bf16x2_t __attribute__((ext_vector_type(2)));
#define LAS __attribute__((address_space(3)))
#define DI __device__ __forceinline__

constexpr int S = 16384;
constexpr float EPS = 1e-6f;
constexpr float LOG2E = 1.4426950408889634f;

constexpr size_t SZ_WUPT = (size_t)5632 * 1024 * 2, SZ_WDNT = (size_t)1024 * 2816 * 2;
constexpr size_t O_WUPT1 = 0;
constexpr size_t O_WDNT1 = O_WUPT1 + SZ_WUPT;
constexpr size_t O_WOINT = O_WDNT1 + SZ_WDNT;
constexpr size_t O_WO2T = O_WOINT + (size_t)3072 * 1024 * 2;
constexpr size_t O_ROWSS = O_WO2T + (size_t)1024 * 1024 * 2;
constexpr size_t O_RSQ = O_ROWSS + (size_t)5 * S * 8;
constexpr size_t O_RSKV = O_RSQ + (size_t)S * 4;
constexpr size_t O_CSTAB = O_RSKV + (size_t)S * 4;
constexpr size_t O_CHA = O_CSTAB + (size_t)S * 32 * 4;
constexpr size_t O_CHH = O_CHA + (size_t)256 * 512 * 4;
constexpr size_t O_GB = O_CHH + (size_t)256 * 512 * 4;
constexpr size_t O_GE = O_GB + (size_t)4 * S * 4;
constexpr size_t O_GPM = O_GE + (size_t)4 * S * 4;
constexpr size_t O_BL = O_GPM + (size_t)4 * S * 4;
constexpr size_t O_ML = O_BL + 4096;
constexpr size_t O_MST = O_ML + 4096;
constexpr size_t O_NST = O_MST + 4096;
constexpr size_t O_BAR = O_NST + (size_t)256 * 4 * 128 * 4;
constexpr size_t BAR_BYTES = 16384;
constexpr size_t O_XB = O_BAR + BAR_BYTES;
constexpr size_t XB_ROWS = 16648;
constexpr size_t O_L0W = O_XB + XB_ROWS * 2048;
constexpr size_t O_W1T = O_L0W;
constexpr size_t O_WQT = O_W1T + (size_t)1536 * 1024 * 2;
constexpr size_t O_WKT = O_WQT + (size_t)768 * 256 * 2;
constexpr size_t O_WVT = O_WKT + (size_t)512 * 256 * 2;
constexpr size_t O_WRIT = O_WVT + (size_t)512 * 256 * 2;
constexpr size_t O_WO1T = O_WRIT + (size_t)1024 * 512 * 2;
constexpr size_t O_WUPT0 = O_WO1T + (size_t)1024 * 1024 * 2;
constexpr size_t O_WDNT0 = O_WUPT0 + SZ_WUPT;
constexpr size_t O_ARENA = O_WDNT0 + SZ_WDNT;
constexpr size_t O_Z = O_ARENA;
constexpr size_t O_XC = O_Z + (size_t)S * 1536 * 2;
constexpr size_t O_QB = O_XC + (size_t)S * 512 * 2;
constexpr size_t O_KB = O_QB + (size_t)8 * S * 96 * 2;
constexpr size_t O_VT = O_KB + (size_t)8 * S * 96 * 2;
constexpr size_t O_MIX = O_VT + (size_t)512 * S * 2;
constexpr size_t O_END0 = O_MIX + (size_t)S * 1024 * 2;
constexpr size_t O_ACT = O_ARENA;
constexpr size_t O_RI = O_XB;
constexpr size_t O_CST = O_L0W;
constexpr size_t O_QOK = O_CST + (size_t)256 * 4 * 256 * 128 * 2;
constexpr size_t O_KVT = O_QOK + (size_t)S * 2048 * 2;
constexpr size_t O_END1 = O_KVT + (size_t)1536 * S * 2;
constexpr size_t WS_NEED = (O_END0 > O_END1 ? O_END0 : O_END1);
static_assert(WS_NEED <= (size_t)268435456, "workspace");
static_assert(O_ACT + (size_t)(S + 240) * 2816 * 2 <= (size_t)268435456, "act");

constexpr int LDS_BYTES = 147456;

struct Args {
    const float* in[28];
    float* out;
    unsigned char* ws;
    int pad; int pad2;
};

struct ArgP { const __attribute__((address_space(4))) Args* p;
    DI const float* in(int i) const { return p->in[i]; } DI float* out() const { return p->out; } DI unsigned char* ws() const { return p->ws; } };
DI unsigned pk2(float lo, float hi) { f32x2 v = {lo, hi}; bf16x2_t b = __builtin_convertvector(v, bf16x2_t); return __builtin_bit_cast(unsigned, b); }
DI bf16_t f2bf(float f) { return (bf16_t)(pk2(f, 0.f) & 0xffffu); }
DI int ltid(int wv) { asm volatile("" : "+s"(wv)); int l = __builtin_amdgcn_mbcnt_hi(~0u, __builtin_amdgcn_mbcnt_lo(~0u, 0u)); asm volatile("" : "+v"(l)); return wv * 64 + l; }
DI int lbid() { int t = blockIdx.x; asm volatile("" : "+s"(t)); return t; }
DI float bf2f(bf16_t b) { return __uint_as_float(((unsigned)b) << 16); }
DI float bflo(unsigned u) { return __uint_as_float(u << 16); }
DI float bfhi(unsigned u) { return __uint_as_float(u & 0xffff0000u); }
DI float wave_sum(float v) {
#pragma unroll
    for (int o = 1; o < 64; o <<= 1) v += __shfl_xor(v, o);
    return v;
}
DI float fexp(float x) { return __builtin_amdgcn_exp2f(x * LOG2E); }
DI float sigmoidf_(float x) { return __builtin_amdgcn_rcpf(1.f + fexp(-x)); }
DI int crow(int r, int hi) { return (r & 3) + 8 * (r >> 2) + 4 * hi; }
typedef unsigned long long u64;
DI float rs_from_ss(u64 ssq) { return rsqrtf((float)ssq * (1.f / (1048576.f * 1024.f)) + EPS); }
DI u64 ss_to_fix(float ss) { return (u64)(ss * 1048576.f); }

namespace pg8 {
constexpr int BM = 256, BK = 64, HALF = 128, HTB = HALF * BK * 2, STAGE_BYTES = 8 * HTB, NXCD = 8, WGM = 8;
DI int lds_byte(int r, int c) { const int st = (r >> 4) * 2 + (c >> 5), rr = r & 15, cc = c & 31, ob = rr * 64 + cc * 2; return st * 1024 + (ob ^ (((ob >> 9) & 1) << 5)); }
DI void stage_rc(int b, int& R, int& C) { const int st = b / 1024, sb = b % 1024, swz = sb ^ (((sb >> 9) & 1) << 5); R = (st >> 1) * 16 + swz / 64; C = (st & 1) * 32 + (swz % 64) / 2; }
DI int perm32(int rho) { const int n = rho >> 4, i = rho & 15; return 8 * (i >> 2) + 4 * n + (i & 3); }
struct Unit { int pm, pn; };
struct StaticOrder {
    int nM, nN, nwg, G, c;
    DI void init(int nM_, int nN_, int G_, int c_) { nM = nM_; nN = nN_; nwg = nM * nN; G = G_; c = c_; }
    DI bool next(int i, Unit& u) const {
        const long L = (long)i * G + c; if (L >= nwg) return false;
        int wgid = (int)L; { const int q = nwg / NXCD, r = nwg % NXCD, xcd = wgid % NXCD, off = wgid / NXCD; wgid = (xcd < r ? xcd * (q + 1) : r * (q + 1) + (xcd - r) * q) + off; }
        const int nig = WGM * nN, gid = wgid / nig, fm = gid * WGM, gsz = (nM - fm) < WGM ? (nM - fm) : WGM;
        u.pm = fm + ((wgid % nig) % gsz); u.pn = (wgid % nig) / gsz; return true;
    }
};

template <bool AMAP, class Epi>
DI void gemm_phase(int wv, LAS unsigned char* lds, const bf16_t* A, int lda, const bf16_t* Bt, int ldb, int K_, int nM, int nN, const Epi& E, int rot = 0) {
    int K = K_; asm volatile("" : "+s"(K));
    const int tid = ltid(wv), wid = __builtin_amdgcn_readfirstlane(tid >> 6), lane = tid & 63, wr = wid >> 2, wc = wid & 3, fr = lane & 15, fq = lane >> 4;
    const int nt = K / BK;
    StaticOrder SO; { int c_ = lbid() - rot; if (c_ < 0) c_ += (int)gridDim.x; SO.init(nM, nN, (int)gridDim.x, c_); }
    unsigned voffA[2], voffB[2];
#pragma unroll
    for (int i = 0; i < 2; ++i) { int R, C; stage_rc(tid * 16 + i * 8192, R, C); const int Rb = (R & ~31) + perm32(R & 31);
        const int Ra = AMAP ? (62 * (R >> 6) + (R & 63) - 2) : R;
        voffA[i] = (unsigned)((Ra + (AMAP ? 2 : 0)) * lda + C) * 2u; voffB[i] = (unsigned)(Rb * ldb + C) * 2u; }
    const size_t kstep = (size_t)(BK * 2);
    const size_t hstepA = (size_t)(AMAP ? 124 : 128) * lda * 2, hstepB = (size_t)HALF * ldb * 2;
    const size_t tstepA = 2 * hstepA, tstepB = 2 * hstepB;
    const unsigned ldsw = (unsigned)wid * 1024u;
    const int aoff = lds_byte(wr * 64 + fr, fq * 8), boff = lds_byte(wc * 32 + fr, fq * 8);
#define PG8_SA(b, h) (((b) * 2 + (h)) * HTB)
#define PG8_SB(b, h) ((4 + (b) * 2 + (h)) * HTB)
#define PG8_STAGE(bufoff, gbase, voff) do { _Pragma("unroll") for (int _i = 0; _i < 2; ++_i) \
        __builtin_amdgcn_global_load_lds((const unsigned*)((const char*)(gbase) + (voff)[_i]), (LAS unsigned*)(lds + (bufoff) + ldsw + _i * 8192), 16, 0, 0); } while (0)
#define PG8_LDA(dst, b, h) do { _Pragma("unroll") for (int m = 0; m < 4; ++m) _Pragma("unroll") for (int k = 0; k < 2; ++k) dst[m][k] = *(const LAS bf16x8*)(lds + PG8_SA(b, h) + aoff + m * 2048 + k * 1024); } while (0)
#define PG8_LDB(dst, b, h) do { _Pragma("unroll") for (int n = 0; n < 2; ++n) _Pragma("unroll") for (int k = 0; k < 2; ++k) dst[n][k] = *(const LAS bf16x8*)(lds + PG8_SB(b, h) + boff + n * 2048 + k * 1024); } while (0)
#define PG8_MMA(ai, bj, At, Bt_) do { __builtin_amdgcn_s_setprio(1); _Pragma("unroll") for (int m = 0; m < 4; ++m) _Pragma("unroll") for (int n = 0; n < 2; ++n) _Pragma("unroll") for (int k = 0; k < 2; ++k) \
        acc[ai][bj][m][n] = __builtin_amdgcn_mfma_f32_16x16x32_bf16(Bt_[n][k], At[m][k], acc[ai][bj][m][n], 0, 0, 0); __builtin_amdgcn_s_setprio(0); } while (0)
#define PG8_WAIT_V(n) asm volatile("s_waitcnt vmcnt(" #n ")" ::: "memory")
#define PG8_WAIT_L(n) asm volatile("s_waitcnt lgkmcnt(" #n ")" ::: "memory")
#define PG8_BAR __builtin_amdgcn_s_barrier()
#define PG8_SCHED __builtin_amdgcn_sched_barrier(0)
    if (AMAP) A -= 2 * lda;
    Unit cur, nxt; int ui = 0;
    if (!SO.next(0, cur)) return;
    f32x4 acc[2][2][4][2];
#pragma unroll
    for (int a = 0; a < 2; ++a)
#pragma unroll
        for (int b = 0; b < 2; ++b)
#pragma unroll
            for (int m = 0; m < 4; ++m)
#pragma unroll
                for (int n = 0; n < 2; ++n) acc[a][b][m][n] = (f32x4){0.f, 0.f, 0.f, 0.f};
    bf16x8 At[4][2], B0[2][2], B1[2][2];
    const char* cA = (const char*)A + (size_t)cur.pm * tstepA; const char* cB = (const char*)Bt + (size_t)cur.pn * tstepB;
    PG8_STAGE(PG8_SB(0, 0), cB, voffB); PG8_STAGE(PG8_SB(0, 1), cB + hstepB, voffB); PG8_STAGE(PG8_SA(0, 0), cA, voffA); PG8_STAGE(PG8_SA(0, 1), cA + hstepA, voffA);
    if (wr == 1) PG8_BAR;
    PG8_WAIT_V(2); PG8_BAR;
    PG8_STAGE(PG8_SB(1, 0), cB + kstep, voffB); PG8_STAGE(PG8_SA(1, 0), cA + kstep, voffA); PG8_STAGE(PG8_SB(1, 1), cB + hstepB + kstep, voffB);
    PG8_WAIT_V(6); PG8_BAR;
    for (;;) {
        const bool has_next = SO.next(ui + 1, nxt);
        const char* nA = has_next ? (const char*)A + (size_t)nxt.pm * tstepA : cA; const char* nB = has_next ? (const char*)Bt + (size_t)nxt.pn * tstepB : cB;
        for (int t = 0; t < nt; t += 2) {
            const bool last = (t == nt - 2);
            const char* a1 = cA + (size_t)(t + 1) * kstep;
            const char* a2 = last ? nA : cA + (size_t)(t + 2) * kstep; const char* b2 = last ? nB : cB + (size_t)(t + 2) * kstep;
            const char* a3 = a2 + kstep; const char* b3 = b2 + kstep;
            PG8_LDB(B0, 0, 0); PG8_LDB(B1, 0, 1); PG8_SCHED; PG8_LDA(At, 0, 0); PG8_STAGE(PG8_SA(1, 1), a1 + hstepA, voffA);
            PG8_WAIT_V(8); PG8_WAIT_L(0); PG8_BAR; PG8_MMA(0, 0, At, B0); PG8_MMA(0, 1, At, B1); PG8_BAR; PG8_SCHED;
            PG8_LDA(At, 0, 1); PG8_STAGE(PG8_SB(0, 0), b2, voffB); PG8_STAGE(PG8_SB(0, 1), b2 + hstepB, voffB); PG8_STAGE(PG8_SA(0, 0), a2, voffA);
            PG8_WAIT_V(8); PG8_WAIT_L(0); PG8_BAR; PG8_MMA(1, 0, At, B0); PG8_MMA(1, 1, At, B1); PG8_BAR; PG8_SCHED;
            PG8_LDB(B0, 1, 0); PG8_LDB(B1, 1, 1); PG8_SCHED; PG8_LDA(At, 1, 0); PG8_STAGE(PG8_SA(0, 1), a2 + hstepA, voffA);
            PG8_WAIT_V(8); PG8_WAIT_L(0); PG8_BAR; PG8_MMA(0, 0, At, B0); PG8_MMA(0, 1, At, B1); PG8_BAR; PG8_SCHED;
            PG8_LDA(At, 1, 1); PG8_STAGE(PG8_SB(1, 0), b3, voffB); PG8_STAGE(PG8_SB(1, 1), b3 + hstepB, voffB); PG8_STAGE(PG8_SA(1, 0), a3, voffA);
            PG8_WAIT_V(8); PG8_WAIT_L(0); PG8_BAR; PG8_MMA(1, 0, At, B0); PG8_MMA(1, 1, At, B1); PG8_BAR; PG8_SCHED;
        }
        if (wr == 0) PG8_BAR;
        E(acc, cur, wr, wc, fr, fq);
        if (!has_next) break;
#pragma unroll
        for (int a = 0; a < 2; ++a)
#pragma unroll
            for (int b = 0; b < 2; ++b)
#pragma unroll
                for (int m = 0; m < 4; ++m)
#pragma unroll
                    for (int n = 0; n < 2; ++n) acc[a][b][m][n] = (f32x4){0.f, 0.f, 0.f, 0.f};
        cur = nxt; cA = nA; cB = nB; ++ui;
        if (wr == 1) PG8_BAR;
    }
    PG8_WAIT_V(0);
    PG8_BAR;
#undef PG8_SA
#undef PG8_SB
#undef PG8_STAGE
#undef PG8_LDA
#undef PG8_LDB
#undef PG8_MMA
#undef PG8_WAIT_V
#undef PG8_WAIT_L
#undef PG8_BAR
#undef PG8_SCHED
}
}
using pg8::Unit;
typedef f32x4 AccT[2][2][4][2];

template <int SMODE> struct EpiRowBf16 {
    bf16_t* O; int ldc; const void* sc;
    DI void operator()(const AccT& acc, const Unit& u, int wr, int wc, int fr, int fq) const {
        const int row0 = u.pm * 256 + wr * 64 + fr, col0 = u.pn * 256 + wc * 32 + 8 * fq;
#pragma unroll
        for (int ai = 0; ai < 2; ++ai)
#pragma unroll
            for (int m = 0; m < 4; ++m) { const int row = row0 + ai * 128 + m * 16;
                float s = 1.f; if (SMODE == 1) s = rs_from_ss(((const u64*)sc)[row]); if (SMODE == 2) s = ((const float*)sc)[row];
                bf16_t* rowp = O + (size_t)row * ldc + col0;
#pragma unroll
                for (int bj = 0; bj < 2; ++bj) { const f32x4 v0 = acc[ai][bj][m][0] * s, v1 = acc[ai][bj][m][1] * s;
                    u32x4 w; w.x = pk2(v0[0], v0[1]); w.y = pk2(v0[2], v0[3]); w.z = pk2(v1[0], v1[1]); w.w = pk2(v1[2], v1[3]);
                    *(u32x4*)(rowp + bj * 128) = w; } }
    }
};
template <int SMODE> struct EpiColBf16 {
    bf16_t* O; int ldc; const void* sc;
    DI void operator()(const AccT& acc, const Unit& u, int wr, int wc, int fr, int fq) const {
        const int row0 = u.pm * 256 + wr * 64 + fr, col0 = u.pn * 256 + wc * 32 + 8 * fq;
#pragma unroll
        for (int bj = 0; bj < 2; ++bj) { float s[8];
#pragma unroll
            for (int j = 0; j < 8; ++j) s[j] = (SMODE == 1) ? rs_from_ss(((const u64*)sc)[col0 + bj * 128 + j]) : ((const float*)sc)[col0 + bj * 128 + j];
#pragma unroll
            for (int ai = 0; ai < 2; ++ai)
#pragma unroll
                for (int m = 0; m < 4; ++m) { const int row = row0 + ai * 128 + m * 16; const f32x4 v0 = acc[ai][bj][m][0], v1 = acc[ai][bj][m][1];
                    u32x4 w; w.x = pk2(v0[0] * s[0], v0[1] * s[1]); w.y = pk2(v0[2] * s[2], v0[3] * s[3]); w.z = pk2(v1[0] * s[4], v1[1] * s[5]); w.w = pk2(v1[2] * s[6], v1[3] * s[7]);
                    *(u32x4*)(O + (size_t)row * ldc + col0 + bj * 128) = w; } }
    }
};
struct EpiQ {
    bf16_t* QB; const float* rsq; const float* cstab;
    DI void operator()(const AccT& acc, const Unit& u, int wr, int wc, int fr, int fq) const {
        const int row0 = u.pm * 256 + wr * 64 + fr, col0 = u.pn * 256 + wc * 32 + 8 * fq;
        const float QS = 0.10206207261596577f * LOG2E;
#pragma unroll
        for (int ai = 0; ai < 2; ++ai)
#pragma unroll
            for (int m = 0; m < 4; ++m) { const int t = row0 + ai * 128 + m * 16; const float s = rsq[t] * QS;
#pragma unroll
                for (int bj = 0; bj < 2; ++bj) { const int c = col0 + bj * 128, h = c / 96, d = c - h * 96;
                    f32x4 v0 = acc[ai][bj][m][0] * s, v1 = acc[ai][bj][m][1] * s;
                    if (d >= 64) { const int i0 = (d - 64) >> 1; const f32x4 cs0 = *(const f32x4*)(cstab + (size_t)t * 32 + 2 * i0), cs1 = *(const f32x4*)(cstab + (size_t)t * 32 + 2 * i0 + 4);
                        f32x4 a, b;
                        a[0] = v0[0] * cs0[0] - v0[1] * cs0[1]; a[1] = v0[1] * cs0[0] + v0[0] * cs0[1];
                        a[2] = v0[2] * cs0[2] - v0[3] * cs0[3]; a[3] = v0[3] * cs0[2] + v0[2] * cs0[3];
                        b[0] = v1[0] * cs1[0] - v1[1] * cs1[1]; b[1] = v1[1] * cs1[0] + v1[0] * cs1[1];
                        b[2] = v1[2] * cs1[2] - v1[3] * cs1[3]; b[3] = v1[3] * cs1[2] + v1[2] * cs1[3];
                        v0 = a; v1 = b; }
                    u32x4 w; w.x = pk2(v0[0], v0[1]); w.y = pk2(v0[2], v0[3]); w.z = pk2(v1[0], v1[1]); w.w = pk2(v1[2], v1[3]);
                    *(u32x4*)(QB + ((size_t)h * S + t) * 96 + d) = w; } }
    }
};
struct EpiK {
    bf16_t* KB; const float* rskv;
    DI void operator()(const AccT& acc, const Unit& u, int wr, int wc, int fr, int fq) const {
        const int row0 = u.pm * 256 + wr * 64 + fr, col0 = u.pn * 256 + wc * 32 + 8 * fq;
#pragma unroll
        for (int ai = 0; ai < 2; ++ai)
#pragma unroll
            for (int m = 0; m < 4; ++m) { const int t = row0 + ai * 128 + m * 16; const float s = rskv[t];
#pragma unroll
                for (int bj = 0; bj < 2; ++bj) { const int c = col0 + bj * 128, h = c >> 6, d = c & 63;
                    const f32x4 v0 = acc[ai][bj][m][0] * s, v1 = acc[ai][bj][m][1] * s;
                    u32x4 w; w.x = pk2(v0[0], v0[1]); w.y = pk2(v0[2], v0[3]); w.z = pk2(v1[0], v1[1]); w.w = pk2(v1[2], v1[3]);
                    *(u32x4*)(KB + ((size_t)h * S + t) * 96 + d) = w; } }
    }
};
template <bool RESBF> struct EpiRes {
    const float* res; bf16_t* XB; u64* rowss; int dry;
    DI void operator()(const AccT& acc, const Unit& u, int wr, int wc, int fr, int fq) const {
        const int row0 = u.pm * 256 + wr * 64 + fr, col0 = u.pn * 256 + wc * 32 + 8 * fq;
#pragma unroll
        for (int ai = 0; ai < 2; ++ai)
#pragma unroll
            for (int m = 0; m < 4; ++m) { const int t = row0 + ai * 128 + m * 16; float ss = 0.f;
#pragma unroll
                for (int bj = 0; bj < 2; ++bj) { const size_t o = (size_t)t * 1024 + col0 + bj * 128;
                    f32x4 r0, r1;
                    if (RESBF) { const u32x4 rb = *(const u32x4*)(XB + o); r0 = (f32x4){bflo(rb.x), bfhi(rb.x), bflo(rb.y), bfhi(rb.y)}; r1 = (f32x4){bflo(rb.z), bfhi(rb.z), bflo(rb.w), bfhi(rb.w)}; }
                    else { r0 = __builtin_nontemporal_load((const f32x4*)(res + o)); r1 = __builtin_nontemporal_load((const f32x4*)(res + o + 4)); }
                    const f32x4 v0 = acc[ai][bj][m][0] + r0, v1 = acc[ai][bj][m][1] + r1;
                    u32x4 w; w.x = pk2(v0[0], v0[1]); w.y = pk2(v0[2], v0[3]); w.z = pk2(v1[0], v1[1]); w.w = pk2(v1[2], v1[3]);
                    if (!dry) *(u32x4*)(XB + o) = w;
                    ss += v0[0] * v0[0] + v0[1] * v0[1] + v0[2] * v0[2] + v0[3] * v0[3] + v1[0] * v1[0] + v1[1] * v1[1] + v1[2] * v1[2] + v1[3] * v1[3]; }
                ss += __shfl_xor(ss, 16); ss += __shfl_xor(ss, 32);
                if (fq == 0 && !dry) atomicAdd(rowss + t, ss_to_fix(ss)); }
    }
};
DI float dpp_prev1(float cur, float prevm) {
    const int o = __builtin_amdgcn_update_dpp(0, __builtin_bit_cast(int, prevm), 0x121, 0xf, 0xf, false);
    return __builtin_bit_cast(float, __builtin_amdgcn_update_dpp(o, __builtin_bit_cast(int, cur), 0x111, 0xf, 0xf, false));
}
DI float dpp_prev2(float cur, float prevm) {
    const int o = __builtin_amdgcn_update_dpp(0, __builtin_bit_cast(int, prevm), 0x122, 0xf, 0xf, false);
    return __builtin_bit_cast(float, __builtin_amdgcn_update_dpp(o, __builtin_bit_cast(int, cur), 0x112, 0xf, 0xf, false));
}
struct EpiUp {
    bf16_t* ACT; const u64* rowss; const float* cw; const float* cb; LAS unsigned char* plds;
    DI void operator()(const AccT& acc, const Unit& u, int wr, int wc, int fr, int fq) const {
        const int cl = u.pn * 128 + wc * 32 + 8 * fq;
        LAS float* P = (LAS float*)(plds + (wr * 4 + wc) * 1024);
        { const int lane = fq * 16 + fr, kind = lane >> 3, c4 = 4 * (lane & 7), k3 = kind & 3;
          const float* src = (k3 == 0 ? cb : cw + (k3 - 1) * 5632) + (kind >= 4 ? 2816 : 0) + u.pn * 128 + wc * 32 + c4;
          *(LAS f32x4*)(P + kind * 32 + c4) = *(const f32x4*)src; }
#pragma unroll
        for (int ai = 0; ai < 2; ++ai) {
            const int tok0 = u.pm * 248 + 62 * (2 * ai + wr) - 2 + fr;
            float rs[4];
#pragma unroll
            for (int m = 0; m < 4; ++m) { const int t = tok0 + 16 * m; const int tc = t < 0 ? 0 : (t >= S ? S - 1 : t); const float r = rs_from_ss(rowss[tc]); rs[m] = t < 0 ? 0.f : r; }
            const int row0 = fr < 2 ? (S + 236 + fr) : tok0;
#pragma unroll
            for (int n = 0; n < 2; ++n) {
                const int lc = 8 * fq + 4 * n;
                unsigned wpk[4][2];
#pragma unroll
                for (int jp = 0; jp < 2; ++jp) {
                    const f32x2 bg = *(const LAS f32x2*)(P + lc + 2 * jp), g0 = *(const LAS f32x2*)(P + 32 + lc + 2 * jp), g1 = *(const LAS f32x2*)(P + 64 + lc + 2 * jp), g2 = *(const LAS f32x2*)(P + 96 + lc + 2 * jp);
                    const f32x2 bv = *(const LAS f32x2*)(P + 128 + lc + 2 * jp), v0 = *(const LAS f32x2*)(P + 160 + lc + 2 * jp), v1 = *(const LAS f32x2*)(P + 192 + lc + 2 * jp), v2 = *(const LAS f32x2*)(P + 224 + lc + 2 * jp);
                    f32x2 G[4], V[4];
#pragma unroll
                    for (int m = 0; m < 4; ++m) { G[m] = (f32x2){acc[ai][0][m][n][2 * jp], acc[ai][0][m][n][2 * jp + 1]} * rs[m]; V[m] = (f32x2){acc[ai][1][m][n][2 * jp], acc[ai][1][m][n][2 * jp + 1]} * rs[m]; }
#pragma unroll
                    for (int m = 0; m < 4; ++m) {
                        const f32x2 zz = {0.f, 0.f}; const f32x2 Gp = m ? G[m - 1] : zz, Vp = m ? V[m - 1] : zz;
                        const f32x2 gp1 = {dpp_prev1(G[m].x, Gp.x), dpp_prev1(G[m].y, Gp.y)}, gp2 = {dpp_prev2(G[m].x, Gp.x), dpp_prev2(G[m].y, Gp.y)};
                        const f32x2 vp1 = {dpp_prev1(V[m].x, Vp.x), dpp_prev1(V[m].y, Vp.y)}, vp2 = {dpp_prev2(V[m].x, Vp.x), dpp_prev2(V[m].y, Vp.y)};
                        const f32x2 gc = bg + g0 * gp2 + g1 * gp1 + g2 * G[m];
                        const f32x2 vc = bv + v0 * vp2 + v1 * vp1 + v2 * V[m];
                        const f32x2 xe = gc * (-LOG2E);
                        f32x2 dn = {__builtin_amdgcn_exp2f(xe.x), __builtin_amdgcn_exp2f(xe.y)}; dn = dn + 1.0f;
                        const f32x2 rc = {__builtin_amdgcn_rcpf(dn.x), __builtin_amdgcn_rcpf(dn.y)};
                        const f32x2 rr = gc * rc * vc;
                        wpk[m][jp] = pk2(rr.x, rr.y); }
                }
#pragma unroll
                for (int m = 0; m < 4; ++m) { const int row = m ? tok0 + 16 * m : row0;
                    *(u32x2*)(ACT + (size_t)row * 2816 + cl + 4 * n) = (u32x2){wpk[m][0], wpk[m][1]}; }
                __builtin_amdgcn_sched_barrier(0);
            }
        }
    }
};

template <class F> DI void tr_items(const F& f, int Kdst, int Nrows, bf16_t* WT, LAS float* scr, int gw, int NGW, int lane, int& cum) {
    const int nblk = Nrows / 32, nitems = (Kdst / 64) * nblk;
    int first = (gw - cum) % NGW; if (first < 0) first += NGW; cum = (cum + nitems) % NGW;
    for (int item = first; item < nitems; item += NGW) {
        const int kb = item / nblk, nb = item % nblk, k0 = 64 * kb, n0 = 32 * nb;
        float tv[32];
#pragma unroll
        for (int i = 0; i < 32; ++i) tv[i] = f(k0 + 2 * i + (lane >> 5), n0 + (lane & 31));
#pragma unroll
        for (int i = 0; i < 32; ++i) scr[(2 * i + (lane >> 5)) * 33 + (lane & 31)] = tv[i];
        asm volatile("s_waitcnt lgkmcnt(0)" ::: "memory");
        const int c = lane & 7;
#pragma unroll
        for (int j = 0; j < 4; ++j) { const int n = (lane >> 3) + 8 * j; const LAS float* s = scr + (8 * c) * 33 + n;
            u32x4 o; o.x = pk2(s[0 * 33], s[1 * 33]); o.y = pk2(s[2 * 33], s[3 * 33]); o.z = pk2(s[4 * 33], s[5 * 33]); o.w = pk2(s[6 * 33], s[7 * 33]);
            *(u32x4*)(WT + (size_t)(n0 + n) * Kdst + k0 + 8 * c) = o; }
        asm volatile("s_waitcnt lgkmcnt(0)" ::: "memory");
    }
}
struct FW1 { const float* W; const float* g; DI float operator()(int k, int n) const { return n < 1440 ? __builtin_nontemporal_load(&W[(size_t)k * 1440 + n]) * g[k] : 0.f; } };
struct FWQ { const float* W; const float* g; DI float operator()(int k, int n) const { const int h = n / 96, d = n - h * 96; int c = d; if (d >= 64) { const int r = d - 64; c = 64 + (r >> 1) + 16 * (r & 1); } return __builtin_nontemporal_load(&W[(size_t)k * 768 + h * 96 + c]) * g[k]; } };
struct FWKV { const float* W; const float* g; int off; DI float operator()(int k, int n) const { return k < 128 ? __builtin_nontemporal_load(&W[(size_t)k * 1024 + (n >> 6) * 128 + off + (n & 63)]) * g[k] : 0.f; } };
struct FWRI { const float* Wa; const float* Wx; DI float operator()(int k, int n) const { const float* W = n < 512 ? Wa : Wx; const int ch = n & 511, g = ch >> 6, j = ch & 63; return (k >> 6) == g ? __builtin_nontemporal_load(&W[(size_t)k * 64 + j]) : 0.f; } };
struct FWP { const float* W; int N; DI float operator()(int k, int n) const { return __builtin_nontemporal_load(&W[(size_t)k * N + n]); } };
struct FWUP { const float* W; const float* g; DI float operator()(int k, int n) const { const int pn = n >> 8, r = n & 255; const int c = r < 128 ? 128 * pn + r : 2816 + 128 * pn + r - 128; return __builtin_nontemporal_load(&W[(size_t)k * 5632 + c]) * g[k]; } };
struct FWOIN { const float* W; const float* g; DI float operator()(int k, int n) const {
    int c; float s = 1.f; if (n < 512) { c = n; s = 0.08838834764831845f; } else if (n < 1536) c = 2048 + (n - 512); else if (n < 2048) c = 512 + (n - 1536); else c = 1024 + (n - 2048);
    return __builtin_nontemporal_load(&W[(size_t)k * 3080 + c]) * g[k] * s; } };

#ifndef PROPART
#define PROPART 7
#endif
DI void phase_prologue(int wv, const ArgP a, LAS unsigned char* lds, int parts) {
    unsigned char* ws = a.ws();
    const int tid = ltid(wv), wave = tid >> 6, lane = tid & 63;
    LAS float* scr = (LAS float*)(lds + wave * 8448);
    const int gw = blockIdx.x * 8 + wave, NGW = gridDim.x * 8; int cum = 0;
    if (parts & 1) {
    { FW1 f{a.in(3), a.in(2)}; tr_items(f, 1024, 1536, (bf16_t*)(ws + O_W1T), scr, gw, NGW, lane, cum); }
    { FWQ f{a.in(12), a.in(11)}; tr_items(f, 256, 768, (bf16_t*)(ws + O_WQT), scr, gw, NGW, lane, cum); }
    { FWKV f{a.in(14), a.in(13), 0}; tr_items(f, 256, 512, (bf16_t*)(ws + O_WKT), scr, gw, NGW, lane, cum); }
    { FWKV f{a.in(14), a.in(13), 64}; tr_items(f, 256, 512, (bf16_t*)(ws + O_WVT), scr, gw, NGW, lane, cum); }
    { FWRI f{a.in(6), a.in(8)}; tr_items(f, 512, 1024, (bf16_t*)(ws + O_WRIT), scr, gw, NGW, lane, cum); }
    { FWP f{a.in(15), 1024}; tr_items(f, 1024, 1024, (bf16_t*)(ws + O_WO1T), scr, gw, NGW, lane, cum); }
    for (int l = 0; l < 2; ++l) {
        { FWUP f{a.in(23) + (size_t)l * 1024 * 5632, a.in(22) + l * 1024}; tr_items(f, 1024, 5632, (bf16_t*)(ws + (l ? O_WUPT1 : O_WUPT0)), scr, gw, NGW, lane, cum); }
        { FWP f{a.in(26) + (size_t)l * 2816 * 1024, 1024}; tr_items(f, 2816, 1024, (bf16_t*)(ws + (l ? O_WDNT1 : O_WDNT0)), scr, gw, NGW, lane, cum); }
    }
    { FWOIN f{a.in(17), a.in(16)}; tr_items(f, 1024, 3072, (bf16_t*)(ws + O_WOINT), scr, gw, NGW, lane, cum); }
    { FWP f{a.in(21), 1024}; tr_items(f, 1024, 1024, (bf16_t*)(ws + O_WO2T), scr, gw, NGW, lane, cum); }
    }
    if (parts & 2) {
    const float* x = a.in(0); bf16_t* XB = (bf16_t*)(ws + O_XB) + 2 * 1024; u64* rowss = (u64*)(ws + O_ROWSS);
#pragma unroll 4
    for (int t = gw; t < S; t += NGW) {
        float ss = 0.f;
#pragma unroll
        for (int j = 0; j < 4; ++j) { const f32x4 v = __builtin_nontemporal_load((const f32x4*)(x + (size_t)t * 1024 + j * 256 + lane * 4));
            ss += v[0] * v[0] + v[1] * v[1] + v[2] * v[2] + v[3] * v[3];
            u32x2 w; w.x = pk2(v[0], v[1]); w.y = pk2(v[2], v[3]); *(u32x2*)(XB + (size_t)t * 1024 + j * 256 + lane * 4) = w; }
        ss = wave_sum(ss);
        if (lane == 0) rowss[t] = ss_to_fix(ss);
        if (lane >= 1 && lane < 5) rowss[(size_t)lane * S + t] = 0ull;
    }
    }
    if (parts & 4) {
    const int* pos = (const int*)a.in(1); float* cst = (float*)(ws + O_CSTAB);
    for (int e = blockIdx.x * 512 + tid; e < S * 16; e += gridDim.x * 512) { const int t = e >> 4, i = e & 15;
        const float invf = __builtin_amdgcn_exp2f(-(float)i * (13.287712379549449f / 16.f)); const float ang = (float)pos[t] * invf;
        const float k = rintf(ang * 0.15915494309189535f);
        float r = fmaf(-k, 6.28318548202514648f, ang); r = fmaf(-k, -1.7484555e-7f, r);
        const float rr = r * 0.15915494309189535f;
        cst[2 * e] = __builtin_amdgcn_cosf(rr); cst[2 * e + 1] = __builtin_amdgcn_sinf(rr); }
    }
}

DI void phase_l0_prep(int wv, const ArgP a) {
    unsigned char* ws = a.ws();
    const bf16_t* Z = (const bf16_t*)(ws + O_Z); bf16_t* XC = (bf16_t*)(ws + O_XC); bf16_t* KB = (bf16_t*)(ws + O_KB);
    float* rsq = (float*)(ws + O_RSQ); float* rskv = (float*)(ws + O_RSKV); const float* cst = (const float*)(ws + O_CSTAB);
    const float* cw = a.in(4); const float* cb = a.in(5);
    const int tid = ltid(wv), wave = tid >> 6, lane = tid & 63;
#pragma unroll 2
    for (int e = blockIdx.x * 512 + tid; e < S * 64; e += gridDim.x * 512) { const int t = e >> 6, c0 = (e & 63) * 8;
        float acc[8];
#pragma unroll
        for (int j = 0; j < 8; ++j) acc[j] = cb[c0 + j];
#pragma unroll
        for (int k = 0; k < 4; ++k) { const int tt = t - 3 + k; if (tt < 0) continue;
            const u32x4 v = *(const u32x4*)(Z + (size_t)tt * 1536 + c0);
            const f32x4 w0 = *(const f32x4*)(cw + k * 512 + c0), w1 = *(const f32x4*)(cw + k * 512 + c0 + 4);
            acc[0] += w0[0] * bflo(v.x); acc[1] += w0[1] * bfhi(v.x); acc[2] += w0[2] * bflo(v.y); acc[3] += w0[3] * bfhi(v.y);
            acc[4] += w1[0] * bflo(v.z); acc[5] += w1[1] * bfhi(v.z); acc[6] += w1[2] * bflo(v.w); acc[7] += w1[3] * bfhi(v.w); }
        u32x4 o; o.x = pk2(acc[0], acc[1]); o.y = pk2(acc[2], acc[3]); o.z = pk2(acc[4], acc[5]); o.w = pk2(acc[6], acc[7]);
        *(u32x4*)(XC + (size_t)t * 512 + c0) = o; }
#pragma unroll 4
    for (int t = blockIdx.x * 8 + wave; t < S; t += gridDim.x * 8) {
        const bf16_t* zr = Z + (size_t)t * 1536;
        float sq = 0.f, skv = 0.f;
        { const u32x2 v = *(const u32x2*)(zr + 1024 + lane * 4); const float p0 = bflo(v.x), p1 = bfhi(v.x), p2 = bflo(v.y), p3 = bfhi(v.y); sq = p0 * p0 + p1 * p1 + p2 * p2 + p3 * p3; }
        { const unsigned v = *(const unsigned*)(zr + 1280 + lane * 2); const float p0 = bflo(v), p1 = bfhi(v); skv = p0 * p0 + p1 * p1; }
        sq = wave_sum(sq); skv = wave_sum(skv);
        if (lane == 0) { rsq[t] = rsqrtf(sq * (1.f / 256.f) + EPS); rskv[t] = rsqrtf(skv * (1.f / 128.f) + EPS); }
        if (lane < 16) { const float x1 = bf2f(zr[1408 + lane]), x2 = bf2f(zr[1424 + lane]); const float c = cst[(size_t)t * 32 + 2 * lane], s = cst[(size_t)t * 32 + 2 * lane + 1];
            const unsigned w = pk2(x1 * c - x2 * s, x2 * c + x1 * s);
#pragma unroll
            for (int h = 0; h < 8; ++h) *(unsigned*)(KB + ((size_t)h * S + t) * 96 + 64 + 2 * lane) = w; }
    }
}

DI void lru_coeff(float rpre, float ipre, float xc, float sp8, float& av, float& uv) {
    const float r = sigmoidf_(rpre), ig = sigmoidf_(ipre);
    const float la = -sp8 * r;
    av = fexp(la);
    uv = __builtin_amdgcn_sqrtf(fmaxf(1.f - av * av, 0.f)) * (ig * xc);
}
DI void phase_lru_s1(int wv, const ArgP a) {
    unsigned char* ws = a.ws(); const int ch = ltid(wv);
    const bf16_t* RI = (const bf16_t*)(ws + O_RI); const bf16_t* XC = (const bf16_t*)(ws + O_XC);
    float* CHA = (float*)(ws + O_CHA); float* CHH = (float*)(ws + O_CHH);
    const float ba = a.in(7)[ch], bx = a.in(9)[ch]; const float lam = a.in(10)[ch];
    const float sp8 = 8.f * log1pf(expf(-lam));
    for (int c = blockIdx.x; c < 256; c += gridDim.x) {
        float A = 1.f, H = 0.f;
#pragma unroll 8
        for (int i = 0; i < 64; ++i) { const size_t t = (size_t)c * 64 + i;
            float av, uv; lru_coeff(bf2f(RI[t * 1024 + ch]) + ba, bf2f(RI[t * 1024 + 512 + ch]) + bx, bf2f(XC[t * 512 + ch]), sp8, av, uv);
            A *= av; H = av * H + uv; }
        CHA[c * 512 + ch] = A; CHH[c * 512 + ch] = H;
    }
}
DI void phase_lru_s3(int wv, const ArgP a) {
    unsigned char* ws = a.ws(); const int ch = ltid(wv);
    const bf16_t* RI = (const bf16_t*)(ws + O_RI); const bf16_t* XC = (const bf16_t*)(ws + O_XC); const bf16_t* Z = (const bf16_t*)(ws + O_Z);
    const float* CHA = (const float*)(ws + O_CHA); const float* CHH = (const float*)(ws + O_CHH); bf16_t* MIX = (bf16_t*)(ws + O_MIX);
    const float ba = a.in(7)[ch], bx = a.in(9)[ch]; const float lam = a.in(10)[ch];
    const float sp8 = 8.f * log1pf(expf(-lam));
    for (int c = blockIdx.x; c < 256; c += gridDim.x) {
        float H = 0.f;
#pragma unroll 16
        for (int cc = 0; cc < c; ++cc) H = CHA[cc * 512 + ch] * H + CHH[cc * 512 + ch];
#pragma unroll 4
        for (int i = 0; i < 64; ++i) { const size_t t = (size_t)c * 64 + i;
            float av, uv; lru_coeff(bf2f(RI[t * 1024 + ch]) + ba, bf2f(RI[t * 1024 + 512 + ch]) + bx, bf2f(XC[t * 512 + ch]), sp8, av, uv);
            H = av * H + uv;
            const float g = bf2f(Z[t * 1536 + 512 + ch]);
            const float y = 0.7978845608028654f * (g + 0.044715f * g * g * g);
            const float th = 1.f - 2.f * __builtin_amdgcn_rcpf(1.f + fexp(2.f * y));
            MIX[t * 1024 + ch] = f2bf(H * 0.5f * g * (1.f + th)); }
    }
}

constexpr int AT_KROW = 208, AT_VROW = 136, AT_KT = 64 * AT_KROW, AT_VT = 64 * AT_VROW;
DI float rowmax32(const f32x16& p0, const f32x16& p1) {
    float a = fmaxf(fmaxf(p0[0], p0[1]), p1[0]), b = fmaxf(fmaxf(p0[2], p0[3]), p1[1]); a = fmaxf(fmaxf(a, p1[2]), p1[3]);
#pragma unroll
    for (int r = 4; r < 16; r += 4) { a = fmaxf(fmaxf(a, p0[r]), p0[r + 1]); b = fmaxf(fmaxf(b, p0[r + 2]), p0[r + 3]); a = fmaxf(fmaxf(a, p1[r]), p1[r + 1]); b = fmaxf(fmaxf(b, p1[r + 2]), p1[r + 3]); }
    const float m = fmaxf(a, b);
    const auto rr = __builtin_amdgcn_permlane32_swap(__float_as_uint(m), __float_as_uint(m), false, false);
    return fmaxf(__uint_as_float(rr[0]), __uint_as_float(rr[1]));
}
DI void attn_unit(int wv, int h, int qb, const bf16_t* QB, const bf16_t* KB, const bf16_t* VT, bf16_t* MIX, LAS unsigned char* lds) {
    const int tid = ltid(wv), lane = tid & 63, r32 = lane & 31, hi = lane >> 5; const int wid = __builtin_amdgcn_readfirstlane(tid >> 6);
    const int qg = qb * 256 + wid * 32 + r32;
    const bf16_t* Kh = KB + (size_t)h * S * 96; const bf16_t* Vh = VT + (size_t)h * 64 * S;
    bf16x8 qf[6];
    { const bf16_t* qp = QB + ((size_t)h * S + qg) * 96 + 8 * hi;
#pragma unroll
      for (int s = 0; s < 6; ++s) qf[s] = *(const bf16x8*)(qp + 16 * s); }
    f32x16 o0 = {}, o1 = {}, negm = {};
    float mref = 0.f, lrun = 0.f;
    const int NT = 4 * qb + 4, wlim = 4 * qb + (wid >> 1);
    const int kc0 = tid, kkey0 = kc0 / 12, kpart0 = kc0 % 12;
    const int kc1 = tid + 512, kkey1 = kc1 / 12, kpart1 = kc1 % 12;
    const int vdv = tid >> 3, vpart = tid & 7;
    u32x4 rk0, rk1 = {}, rv;
#define AT_LOADK(t_) do { const size_t kb_ = (size_t)(t_) * 64; rk0 = *(const u32x4*)(Kh + (kb_ + kkey0) * 96 + kpart0 * 8); if (tid < 256) rk1 = *(const u32x4*)(Kh + (kb_ + kkey1) * 96 + kpart1 * 8); } while (0)
#define AT_LOADV(t_) do { rv = *(const u32x4*)(Vh + (size_t)vdv * S + (size_t)(t_) * 64 + vpart * 8); } while (0)
#define AT_WRITEK(t_) do { LAS unsigned char* Ks_ = lds + ((t_) & 1) * AT_KT; *(LAS u32x4*)(Ks_ + kkey0 * AT_KROW + kpart0 * 16) = rk0; if (tid < 256) *(LAS u32x4*)(Ks_ + kkey1 * AT_KROW + kpart1 * 16) = rk1; } while (0)
#define AT_WRITEV(t_) do { LAS unsigned char* Vs_ = lds + 2 * AT_KT + ((t_) & 1) * AT_VT; *(LAS u32x2*)(Vs_ + vdv * AT_VROW + vpart * 16) = (u32x2){rv.x, rv.y}; *(LAS u32x2*)(Vs_ + vdv * AT_VROW + vpart * 16 + 8) = (u32x2){rv.z, rv.w}; } while (0)
#define AT_QK(P0, P1, t_) do { const LAS unsigned char* Ks_ = lds + ((t_) & 1) * AT_KT + r32 * AT_KROW + 16 * hi; f32x16 c0_ = negm, c1_ = negm; \
        _Pragma("unroll") for (int s = 0; s < 6; ++s) { const bf16x8 k0_ = *(const LAS bf16x8*)(Ks_ + 32 * s), k1_ = *(const LAS bf16x8*)(Ks_ + 32 * AT_KROW + 32 * s); \
            c0_ = __builtin_amdgcn_mfma_f32_32x32x16_bf16(k0_, qf[s], c0_, 0, 0, 0); c1_ = __builtin_amdgcn_mfma_f32_32x32x16_bf16(k1_, qf[s], c1_, 0, 0, 0); } \
        P0 = c0_; P1 = c1_; } while (0)
#define AT_SM1(P0, P1, MOFF, t_, MASK) do { \
        if (MASK && (t_) == wlim) { const int kbase_ = (t_) * 64 + 4 * hi; \
            _Pragma("unroll") for (int r = 0; r < 16; ++r) { const int kv_ = kbase_ + (r & 3) + 8 * (r >> 2); if (kv_ > qg) P0[r] = -1e30f; if (kv_ + 32 > qg) P1[r] = -1e30f; } } \
        const float d_ = mref - MOFF;                         \
        const float mx_ = rowmax32(P0, P1) - d_;              \
        if ((t_) == 0 || __any(mx_ > 8.f || d_ != 0.f)) { const float dl_ = ((t_) == 0) ? mx_ : fmaxf(mx_, 0.f); mref += dl_; \
            const float sh_ = d_ + dl_; \
            _Pragma("unroll") for (int r = 0; r < 16; ++r) { P0[r] -= sh_; P1[r] -= sh_; } \
            const float al_ = ((t_) == 0) ? 1.f : __builtin_amdgcn_exp2f(-dl_); lrun *= al_;     \
            _Pragma("unroll") for (int r = 0; r < 16; ++r) { o0[r] *= al_; o1[r] *= al_; negm[r] = -mref; } asm volatile("" : "+v"(negm)); } \
    } while (0)
#define AT_SM2(P0, P1, t_) do { \
        float ps_ = 0.f; \
        _Pragma("unroll") for (int r = 0; r < 16; ++r) { P0[r] = __builtin_amdgcn_exp2f(P0[r]); P1[r] = __builtin_amdgcn_exp2f(P1[r]); ps_ += P0[r] + P1[r]; } \
        lrun += ps_; \
        const LAS unsigned char* Vs_ = lds + 2 * AT_KT + ((t_) & 1) * AT_VT + r32 * AT_VROW + 8 * hi; \
        _Pragma("unroll") for (int ks = 0; ks < 4; ++ks) { u32x4 w_; \
            if (ks < 2) { w_.x = pk2(P0[8 * ks], P0[8 * ks + 1]); w_.y = pk2(P0[8 * ks + 2], P0[8 * ks + 3]); w_.z = pk2(P0[8 * ks + 4], P0[8 * ks + 5]); w_.w = pk2(P0[8 * ks + 6], P0[8 * ks + 7]); } \
            else { w_.x = pk2(P1[8 * ks - 16], P1[8 * ks - 15]); w_.y = pk2(P1[8 * ks - 14], P1[8 * ks - 13]); w_.z = pk2(P1[8 * ks - 12], P1[8 * ks - 11]); w_.w = pk2(P1[8 * ks - 10], P1[8 * ks - 9]); } \
            const bf16x8 pa_ = __builtin_bit_cast(bf16x8, w_); \
            const u32x2 a0_ = *(const LAS u32x2*)(Vs_ + 32 * ks), a1_ = *(const LAS u32x2*)(Vs_ + 32 * ks + 16); \
            const u32x2 b0_ = *(const LAS u32x2*)(Vs_ + 32 * AT_VROW + 32 * ks), b1_ = *(const LAS u32x2*)(Vs_ + 32 * AT_VROW + 32 * ks + 16); \
            o0 = __builtin_amdgcn_mfma_f32_32x32x16_bf16(__builtin_bit_cast(bf16x8, (u32x4){a0_.x, a0_.y, a1_.x, a1_.y}), pa_, o0, 0, 0, 0); \
            o1 = __builtin_amdgcn_mfma_f32_32x32x16_bf16(__builtin_bit_cast(bf16x8, (u32x4){b0_.x, b0_.y, b1_.x, b1_.y}), pa_, o1, 0, 0, 0); } \
    } while (0)
#define AT_STEPM(C0, C1, MC, N0, N1, MN, t_) do { \
        AT_WRITEK((t_) + 1); AT_WRITEV(t_); \
        __syncthreads(); \
        AT_LOADK((t_) + 2); AT_LOADV((t_) + 1); \
        AT_SM1(C0, C1, MC, t_, 0); MN = mref; AT_QK(N0, N1, (t_) + 1); AT_SM2(C0, C1, t_); \
    } while (0)
#define AT_STEPB(C0, C1, MC, N0, N1, MN, t_) do { \
        if ((t_) + 1 < NT) AT_WRITEK((t_) + 1); AT_WRITEV(t_); \
        __syncthreads(); \
        if ((t_) + 2 < NT) AT_LOADK((t_) + 2); if ((t_) + 1 < NT) AT_LOADV((t_) + 1); \
        if ((t_) + 1 <= wlim) { MN = mref; AT_QK(N0, N1, (t_) + 1); } \
        if ((t_) <= wlim) { AT_SM1(C0, C1, MC, t_, 1); AT_SM2(C0, C1, t_); } \
    } while (0)
    f32x16 pA0, pA1, pB0 = {}, pB1 = {}; float mA = 0.f, mB = 0.f;
    AT_LOADK(0); AT_WRITEK(0);
    __syncthreads();
    AT_LOADK(1); AT_LOADV(0);
    AT_QK(pA0, pA1, 0);
    int t = 0;
    for (; t < 4 * qb; t += 2) {
        AT_STEPM(pA0, pA1, mA, pB0, pB1, mB, t);
        AT_STEPM(pB0, pB1, mB, pA0, pA1, mA, t + 1);
    }
    for (; t < NT; t += 2) {
        AT_STEPB(pA0, pA1, mA, pB0, pB1, mB, t);
        AT_STEPB(pB0, pB1, mB, pA0, pA1, mA, t + 1);
    }
#undef AT_STEPM
#undef AT_STEPB
#undef AT_LOADK
#undef AT_LOADV
#undef AT_WRITEK
#undef AT_WRITEV
#undef AT_QK
#undef AT_SM1
#undef AT_SM2
    lrun += __shfl_xor(lrun, 32);
    const float inv = 1.f / lrun;
    bf16_t* op = MIX + (size_t)qg * 1024 + 512 + h * 64;
#pragma unroll
    for (int g = 0; g < 4; ++g) { const int dv = 8 * g + 4 * hi;
        u32x2 w; w.x = pk2(o0[4 * g] * inv, o0[4 * g + 1] * inv); w.y = pk2(o0[4 * g + 2] * inv, o0[4 * g + 3] * inv); *(u32x2*)(op + dv) = w;
        u32x2 w2; w2.x = pk2(o1[4 * g] * inv, o1[4 * g + 1] * inv); w2.y = pk2(o1[4 * g + 2] * inv, o1[4 * g + 3] * inv); *(u32x2*)(op + 32 + dv) = w2; }
    __syncthreads();
}
DI void phase_attn(int wv, const ArgP a, LAS unsigned char* lds) {
    unsigned char* ws = a.ws();
    const bf16_t* QB = (const bf16_t*)(ws + O_QB); const bf16_t* KB = (const bf16_t*)(ws + O_KB); const bf16_t* VT = (const bf16_t*)(ws + O_VT); bf16_t* MIX = (bf16_t*)(ws + O_MIX);
    if (wv >= 4) __builtin_amdgcn_s_setprio(1);
    for (int b = blockIdx.x; b < 256; b += gridDim.x) {
        const int v = (b & 7) * 32 + (b >> 3), h = v >> 5, s = v & 31;
        attn_unit(wv, h, 63 - s, QB, KB, VT, MIX, lds);
        attn_unit(wv, h, s, QB, KB, VT, MIX, lds);
    }
    __builtin_amdgcn_s_setprio(0);
}

DI void phase_m_gates(int wv, const ArgP a, LAS unsigned char* lds) {
    unsigned char* ws = a.ws(); const int tid = ltid(wv), wave = tid >> 6, lane = tid & 63;
    const bf16_t* XBr = (const bf16_t*)(ws + O_XB) + 2 * 1024; const u64* rowss = (const u64*)(ws + O_ROWSS) + 2 * S;
    const float* Wg = a.in(17); const float* gn = a.in(16);
    LAS float* wgs = (LAS float*)lds;
    LAS float* pre = (LAS float*)(lds + 32768);
    float* GB = (float*)(ws + O_GB); float* GE = (float*)(ws + O_GE); float* GPM = (float*)(ws + O_GPM);
    float* BL = (float*)(ws + O_BL); float* ML = (float*)(ws + O_ML);
    for (int e = tid; e < 8192; e += 512) { const int k = e >> 3, j = e & 7; wgs[j * 1024 + k] = Wg[(size_t)k * 3080 + 3072 + j] * gn[k]; }
    __syncthreads();
    for (int c = blockIdx.x; c < 256; c += gridDim.x) {
#pragma unroll 4
        for (int i = 0; i < 8; ++i) { const int t = c * 64 + wave * 8 + i;
            float acc[8];
#pragma unroll
            for (int j = 0; j < 8; ++j) acc[j] = 0.f;
#pragma unroll
            for (int jj = 0; jj < 4; ++jj) { const int k0 = jj * 256 + lane * 4; const u32x2 hb = *(const u32x2*)(XBr + (size_t)t * 1024 + k0); const f32x4 hv = {bflo(hb.x), bfhi(hb.x), bflo(hb.y), bfhi(hb.y)};
#pragma unroll
                for (int j = 0; j < 8; ++j) { const f32x4 wj = *(const LAS f32x4*)(wgs + j * 1024 + k0); acc[j] += hv[0] * wj[0] + hv[1] * wj[1] + hv[2] * wj[2] + hv[3] * wj[3]; } }
            const float rs = rs_from_ss(rowss[t]);
            { const bool b5 = lane & 32, b4 = lane & 16, b3 = lane & 8;
#pragma unroll
              for (int j = 0; j < 4; ++j) { const float snd = b5 ? acc[j] : acc[j + 4], kp = b5 ? acc[j + 4] : acc[j]; acc[j] = kp + __shfl_xor(snd, 32); }
#pragma unroll
              for (int j = 0; j < 2; ++j) { const float snd = b4 ? acc[j] : acc[j + 2], kp = b4 ? acc[j + 2] : acc[j]; acc[j] = kp + __shfl_xor(snd, 16); }
              { const float snd = b3 ? acc[0] : acc[1], kp = b3 ? acc[1] : acc[0]; acc[0] = kp + __shfl_xor(snd, 8); }
              acc[0] += __shfl_xor(acc[0], 4); acc[0] += __shfl_xor(acc[0], 2); acc[0] += __shfl_xor(acc[0], 1);
              if ((lane & 7) == 0) pre[(wave * 8 + i) * 8 + (b5 ? 4 : 0) + (b4 ? 2 : 0) + (b3 ? 1 : 0)] = acc[0] * rs; }
        }
        __syncthreads();
        if (wave < 4) { const int h = wave; const float bi = a.in(18)[h], bfg = a.in(19)[h];
            const float ig = 15.f * tanhf((pre[lane * 8 + h] + bi) * (1.f / 15.f));
            const float fg = 15.f * tanhf((pre[lane * 8 + 4 + h] + bfg) * (1.f / 15.f));
            float b = -log1pf(expf(-fg));
#pragma unroll
            for (int o = 1; o < 64; o <<= 1) { const float v = __shfl_up(b, o); if (lane >= o) b += v; }
            const float e = ig - b; float pm = e;
#pragma unroll
            for (int o = 1; o < 64; o <<= 1) { const float v = __shfl_up(pm, o); if (lane >= o) pm = fmaxf(pm, v); }
            const size_t o_ = (size_t)h * S + c * 64 + lane; GB[o_] = b; GE[o_] = e; GPM[o_] = pm;
            if (lane == 63) { BL[c * 4 + h] = b; ML[c * 4 + h] = b + pm; } }
        __syncthreads();
    }
}
DI void phase_m_dc(int wv, const ArgP a) {
    unsigned char* ws = a.ws(); const int tid = ltid(wv), lane = tid & 63, r32 = lane & 31, hi = lane >> 5; const int w = __builtin_amdgcn_readfirstlane(tid >> 6);
    const float* __restrict__ BL = (const float*)(ws + O_BL); const float* __restrict__ ML = (const float*)(ws + O_ML); float* __restrict__ NST = (float*)(ws + O_NST);
    const float* __restrict__ GE = (const float*)(ws + O_GE); const bf16_t* __restrict__ KVT = (const bf16_t*)(ws + O_KVT); bf16_t* __restrict__ CST = (bf16_t*)(ws + O_CST);
#pragma unroll 2
    for (int u = blockIdx.x; u < 1024; u += gridDim.x) {
        const int c = u >> 2, h = u & 3; const size_t t0 = (size_t)c * 64;
        const float emax = ML[c * 4 + h] - BL[c * 4 + h];
        bf16x8 bfr[4];
        { const bf16_t* vp = KVT + (size_t)(512 + h * 256 + 32 * w + r32) * S + t0 + 8 * hi; const float* gp = GE + (size_t)h * S + t0 + 8 * hi;
#pragma unroll
          for (int ks = 0; ks < 4; ++ks) { const u32x4 v = *(const u32x4*)(vp + 16 * ks); const f32x4 e0 = *(const f32x4*)(gp + 16 * ks), e1 = *(const f32x4*)(gp + 16 * ks + 4);
              u32x4 o; o.x = pk2(bflo(v.x) * fexp(e0[0] - emax), bfhi(v.x) * fexp(e0[1] - emax)); o.y = pk2(bflo(v.y) * fexp(e0[2] - emax), bfhi(v.y) * fexp(e0[3] - emax));
              o.z = pk2(bflo(v.z) * fexp(e1[0] - emax), bfhi(v.z) * fexp(e1[1] - emax)); o.w = pk2(bflo(v.w) * fexp(e1[2] - emax), bfhi(v.w) * fexp(e1[3] - emax));
              bfr[ks] = __builtin_bit_cast(bf16x8, o); } }
        const bf16_t* kp = KVT + (size_t)(h * 128 + r32) * S + t0 + 8 * hi;
        bf16_t* op = CST + ((size_t)(c * 4 + h) * 256 + 32 * w + r32) * 128 + 4 * hi;
#pragma unroll
        for (int rb = 0; rb < 4; ++rb) { f32x16 acc = {};
#pragma unroll
            for (int ks = 0; ks < 4; ++ks) { const bf16x8 ka = *(const bf16x8*)(kp + (size_t)(32 * rb) * S + 16 * ks); acc = __builtin_amdgcn_mfma_f32_32x32x16_bf16(ka, bfr[ks], acc, 0, 0, 0); }
#pragma unroll
            for (int g = 0; g < 4; ++g) { u32x2 o; o.x = pk2(acc[4 * g], acc[4 * g + 1]); o.y = pk2(acc[4 * g + 2], acc[4 * g + 3]); *(u32x2*)(op + 32 * rb + 8 * g) = o; } }
        if (tid < 128) { const bf16_t* kr = KVT + (size_t)(h * 128 + tid) * S + t0; const float* gp = GE + (size_t)h * S + t0; float s = 0.f;
#pragma unroll
            for (int p = 0; p < 8; ++p) { const u32x4 v = *(const u32x4*)(kr + 8 * p); const f32x4 e0 = *(const f32x4*)(gp + 8 * p), e1 = *(const f32x4*)(gp + 8 * p + 4);
                s += bflo(v.x) * fexp(e0[0] - emax) + bfhi(v.x) * fexp(e0[1] - emax) + bflo(v.y) * fexp(e0[2] - emax) + bfhi(v.y) * fexp(e0[3] - emax)
                   + bflo(v.z) * fexp(e1[0] - emax) + bfhi(v.z) * fexp(e1[1] - emax) + bflo(v.w) * fexp(e1[2] - emax) + bfhi(v.w) * fexp(e1[3] - emax); }
            NST[(size_t)(c * 4 + h) * 128 + tid] = s; }
    }
}
DI void phase_m_comb(int wv, const ArgP a, LAS unsigned char* lds, int dry) {
    unsigned char* ws = a.ws(); const int tid = ltid(wv);
    const float* BL = (const float*)(ws + O_BL); const float* ML = (const float*)(ws + O_ML); float* MST = (float*)(ws + O_MST); float* NST = (float*)(ws + O_NST);
    bf16_t* CST = (bf16_t*)(ws + O_CST);
    LAS float* bls = (LAS float*)lds; LAS float* mls = bls + 1024; LAS float* ga = mls + 1024; LAS float* gb = ga + 1024;
    for (int e = tid; e < 1024; e += 512) { bls[e] = BL[e]; mls[e] = ML[e]; }
    __syncthreads();
    if (tid < 256) { const int h = tid >> 6, l = tid & 63;
        float a_ = 0.f, b_ = -1e30f;
#pragma unroll
        for (int k = 0; k < 4; ++k) { const float bl = bls[(4 * l + k) * 4 + h], ml = mls[(4 * l + k) * 4 + h]; a_ += bl; b_ = fmaxf(b_ + bl, ml); }
        float pa = a_, pb = b_;
#pragma unroll
        for (int o = 1; o < 64; o <<= 1) { const float qa = __shfl_up(pa, o), qb = __shfl_up(pb, o); if (l >= o) { pb = fmaxf(qb + pa, pb); pa = qa + pa; } }
        float ea = __shfl_up(pa, 1), eb_ = __shfl_up(pb, 1); if (l == 0) { ea = 0.f; eb_ = -1e30f; }
        float m = fmaxf(0.f + ea, eb_);
#pragma unroll
        for (int k = 0; k < 4; ++k) { const int c = 4 * l + k; const float bl = bls[c * 4 + h], ml = mls[c * 4 + h]; const float mn = fmaxf(bl + m, ml);
            ga[c * 4 + h] = fexp(bl + m - mn); gb[c * 4 + h] = fexp(ml - mn);
            if (blockIdx.x == 0 && !dry) MST[c * 4 + h] = m;
            m = mn; } }
    __syncthreads();
    for (int eb = blockIdx.x; eb < 129; eb += gridDim.x) {
        if (eb < 128) { const int h = eb >> 5; unsigned* p = (unsigned*)(CST + (size_t)h * 32768 + (size_t)(eb & 31) * 1024 + 2 * tid); float C0 = 0.f, C1 = 0.f;
            for (int c = 0; c < 256; c += 64) { unsigned d[64];
#pragma unroll
                for (int k = 0; k < 64; ++k) d[k] = p[(size_t)(c + k) * 65536];
#pragma unroll
                for (int k = 0; k < 64; ++k) { if (!dry) p[(size_t)(c + k) * 65536] = pk2(C0, C1); const float a_ = ga[(c + k) * 4 + h], b_ = gb[(c + k) * 4 + h]; C0 = a_ * C0 + b_ * bflo(d[k]); C1 = a_ * C1 + b_ * bfhi(d[k]); } }
        } else { const int h = tid >> 7; float* p = NST + tid; float C = 0.f;
            for (int c = 0; c < 256; c += 8) { float d[8];
#pragma unroll
                for (int k = 0; k < 8; ++k) d[k] = p[(size_t)(c + k) * 512];
#pragma unroll
                for (int k = 0; k < 8; ++k) { if (!dry) p[(size_t)(c + k) * 512] = C; C = ga[(c + k) * 4 + h] * C + gb[(c + k) * 4 + h] * d[k]; } } }
    }
    __syncthreads();
}
constexpr int MC_QROW = 272, MC_SROW = 144;
constexpr int MC_QS = 0, MC_KS = 64 * MC_QROW, MC_SC = 2 * 64 * MC_QROW, MC_F = MC_SC + 64 * MC_SROW;
DI void phase_m_out(int wv, const ArgP a, LAS unsigned char* lds, int dry) {
    unsigned char* ws = a.ws(); const int tid = ltid(wv), lane = tid & 63, r32 = lane & 31, hi = lane >> 5; const int w = __builtin_amdgcn_readfirstlane(tid >> 6);
    bf16_t* QOK = (bf16_t*)(ws + O_QOK); const bf16_t* KVT = (const bf16_t*)(ws + O_KVT); const bf16_t* CST = (const bf16_t*)(ws + O_CST);
    const float* GB = (const float*)(ws + O_GB); const float* GE = (const float*)(ws + O_GE); const float* GPM = (const float*)(ws + O_GPM);
    const float* MST = (const float*)(ws + O_MST); const float* NST = (const float*)(ws + O_NST); const float* ong = a.in(20);
    LAS unsigned char* Qs = lds + MC_QS; LAS unsigned char* Ks = lds + MC_KS; LAS unsigned char* Sc = lds + MC_SC;
    LAS float* F = (LAS float*)(lds + MC_F);
    LAS float* f_b = F, *f_e = F + 64, *f_m = F + 128, *f_g = F + 192, *f_qn = F + 256, *f_ps = F + 320  , *f_n = F + 576  , *f_part = F + 704  ;
    for (int u = blockIdx.x; u < 1024; u += gridDim.x) {
        const int c = u >> 2, h = u & 3; const size_t t0 = (size_t)c * 64;
        for (int e = tid; e < 1024; e += 512) { const int r = e >> 4, p = e & 15;
            *(LAS u32x4*)(Qs + r * MC_QROW + p * 16) = *(const u32x4*)(QOK + (t0 + r) * 2048 + h * 128 + p * 8);
            *(LAS u32x4*)(Ks + r * MC_QROW + p * 16) = *(const u32x4*)(QOK + (t0 + r) * 2048 + 1536 + h * 128 + p * 8); }
        if (tid < 64) { const float mstv = MST[c * 4 + h]; const float b = GB[(size_t)h * S + t0 + tid], e = GE[(size_t)h * S + t0 + tid], pm = GPM[(size_t)h * S + t0 + tid];
            const float m = b + fmaxf(mstv, pm); f_b[tid] = b; f_e[tid] = e; f_m[tid] = m; f_g[tid] = fexp(b + mstv - m); }
        if (tid >= 64 && tid < 192) f_n[tid - 64] = NST[(size_t)(c * 4 + h) * 128 + tid - 64];
        __syncthreads();
        if (w < 4) {
            const int sb = w & 1, tb = w >> 1; const int tl = 32 * tb + r32;
            f32x16 x = {};
#pragma unroll
            for (int ks = 0; ks < 8; ++ks) {
                const bf16x8 ka = *(const LAS bf16x8*)(Ks + (32 * sb + r32) * MC_QROW + (16 * ks + 8 * hi) * 2);
                const bf16x8 qb = *(const LAS bf16x8*)(Qs + tl * MC_QROW + (16 * ks + 8 * hi) * 2);
                x = __builtin_amdgcn_mfma_f32_32x32x16_bf16(ka, qb, x, 0, 0, 0); }
            const float bt = f_b[tl], mt = f_m[tl]; float ps = 0.f;
#pragma unroll
            for (int g = 0; g < 4; ++g) { float v[4];
#pragma unroll
                for (int j = 0; j < 4; ++j) { const int sl = 32 * sb + 8 * g + 4 * hi + j; const float wgt = (sl <= tl) ? fexp(bt + f_e[sl] - mt) : 0.f; v[j] = x[4 * g + j] * wgt; ps += v[j]; }
                u32x2 o; o.x = pk2(v[0], v[1]); o.y = pk2(v[2], v[3]);
                *(LAS u32x2*)(Sc + tl * MC_SROW + (32 * sb + 8 * g + 4 * hi) * 2) = o; }
            f_ps[(sb * 2 + hi) * 64 + tl] = ps;
        } else {
            const int tl = 16 * (w - 4) + (lane >> 2), qq = lane & 3; float s = 0.f;
#pragma unroll
            for (int p = 0; p < 4; ++p) { const u32x4 v = *(const LAS u32x4*)(Qs + tl * MC_QROW + (32 * qq + 8 * p) * 2); LAS float* np = f_n + 32 * qq + 8 * p;
                s += bflo(v.x) * np[0] + bfhi(v.x) * np[1] + bflo(v.y) * np[2] + bfhi(v.y) * np[3] + bflo(v.z) * np[4] + bfhi(v.z) * np[5] + bflo(v.w) * np[6] + bfhi(v.w) * np[7]; }
            s += __shfl_xor(s, 1); s += __shfl_xor(s, 2);
            if (qq == 0) f_qn[tl] = s;
        }
        __syncthreads();
        f32x16 acc0 = {}, acc1 = {};
        { const bf16_t* cp = CST + ((size_t)(c * 4 + h) * 256 + 32 * w + r32) * 128 + 8 * hi;
#pragma unroll
          for (int ks = 0; ks < 8; ++ks) { const bf16x8 ca = *(const bf16x8*)(cp + 16 * ks);
              const bf16x8 q0 = *(const LAS bf16x8*)(Qs + r32 * MC_QROW + (16 * ks + 8 * hi) * 2), q1 = *(const LAS bf16x8*)(Qs + (32 + r32) * MC_QROW + (16 * ks + 8 * hi) * 2);
              acc0 = __builtin_amdgcn_mfma_f32_32x32x16_bf16(ca, q0, acc0, 0, 0, 0); acc1 = __builtin_amdgcn_mfma_f32_32x32x16_bf16(ca, q1, acc1, 0, 0, 0); } }
        const float g0 = f_g[r32], g1 = f_g[32 + r32];
#pragma unroll
        for (int r = 0; r < 16; ++r) { acc0[r] *= g0; acc1[r] *= g1; }
        { const bf16_t* vp = KVT + (size_t)(512 + h * 256 + 32 * w + r32) * S + t0 + 8 * hi;
#pragma unroll
          for (int ks = 0; ks < 4; ++ks) { const bf16x8 va = *(const bf16x8*)(vp + 16 * ks);
              const bf16x8 s0 = *(const LAS bf16x8*)(Sc + r32 * MC_SROW + (16 * ks + 8 * hi) * 2), s1 = *(const LAS bf16x8*)(Sc + (32 + r32) * MC_SROW + (16 * ks + 8 * hi) * 2);
              acc0 = __builtin_amdgcn_mfma_f32_32x32x16_bf16(va, s0, acc0, 0, 0, 0); acc1 = __builtin_amdgcn_mfma_f32_32x32x16_bf16(va, s1, acc1, 0, 0, 0); } }
        float inv[2];
#pragma unroll
        for (int tb = 0; tb < 2; ++tb) { const int tl = 32 * tb + r32;
            const float den = f_g[tl] * f_qn[tl] + f_ps[tl] + f_ps[64 + tl] + f_ps[128 + tl] + f_ps[192 + tl];
            inv[tb] = 1.f / fmaxf(fabsf(den), fexp(-f_m[tl])); }
        float ss0 = 0.f, ss1 = 0.f;
#pragma unroll
        for (int r = 0; r < 16; ++r) { acc0[r] *= inv[0]; acc1[r] *= inv[1]; ss0 += acc0[r] * acc0[r]; ss1 += acc1[r] * acc1[r]; }
        ss0 += __shfl_xor(ss0, 32); ss1 += __shfl_xor(ss1, 32);
        if (hi == 0) { f_part[w * 64 + r32] = ss0; f_part[w * 64 + 32 + r32] = ss1; }
        __syncthreads();
        float rn[2];
#pragma unroll
        for (int tb = 0; tb < 2; ++tb) { float s = 0.f;
#pragma unroll
            for (int ww = 0; ww < 8; ++ww) s += f_part[ww * 64 + 32 * tb + r32];
            rn[tb] = rsqrtf(s * (1.f / 256.f) + EPS); }
#pragma unroll
        for (int tb = 0; tb < 2; ++tb) { bf16_t* op = QOK + (t0 + 32 * tb + r32) * 2048 + 512 + h * 256 + 32 * w;
#pragma unroll
            for (int g = 0; g < 4; ++g) { const int dv = 8 * g + 4 * hi; const u32x2 ov = *(const u32x2*)(op + dv);
                const f32x4 gg = *(const f32x4*)(ong + h * 256 + 32 * w + dv);
                const float og[4] = {bflo(ov.x), bfhi(ov.x), bflo(ov.y), bfhi(ov.y)}; float y[4];
#pragma unroll
                for (int j = 0; j < 4; ++j) { const float hv = (tb ? acc1[4 * g + j] : acc0[4 * g + j]) * rn[tb]; y[j] = hv * gg[j] * sigmoidf_(og[j]); }
                u32x2 o; o.x = pk2(y[0], y[1]); o.y = pk2(y[2], y[3]); if (!dry) *(u32x2*)(op + dv) = o; } }
        __syncthreads();
    }
}

DI void phase_final(int wv, const ArgP a) {
    float* out = a.out(); const u64* rowss = (const u64*)(a.ws() + O_ROWSS) + 4 * S; const float* g = a.in(27); const bf16_t* XBr = (const bf16_t*)(a.ws() + O_XB) + 2 * 1024;
    for (size_t e = (size_t)blockIdx.x * 512 + ltid(wv); e < (size_t)S * 128; e += (size_t)gridDim.x * 512) { const int t = (int)(e >> 7), c = (int)(e & 127) * 8;
        const float rs = rs_from_ss(rowss[t]); const u32x4 hb = __builtin_nontemporal_load((const u32x4*)(XBr + (size_t)t * 1024 + c)); const f32x4 g0 = *(const f32x4*)(g + c), g1 = *(const f32x4*)(g + c + 4);
        const f32x4 v0 = (f32x4){bflo(hb.x), bfhi(hb.x), bflo(hb.y), bfhi(hb.y)} * rs * g0, v1 = (f32x4){bflo(hb.z), bfhi(hb.z), bflo(hb.w), bfhi(hb.w)} * rs * g1;
        __builtin_nontemporal_store(v0, (f32x4*)(out + (size_t)t * 1024 + c)); __builtin_nontemporal_store(v1, (f32x4*)(out + (size_t)t * 1024 + c + 4)); }
}

#ifndef DIS
#define DIS 0u
#endif
#ifndef REP
#define REP 0u
#endif
#ifndef XSYNC
#define XSYNC 0
#endif

#define XB_TMO      128
#define XB_XCNT(j)  (256  + 64 * (j))
#define XB_XSUB(j)  (1280 + 64 * (j))
#define XB_XGEN(j)  (2304 + 64 * (j))
#define XB_TOP      3328
#define XB_TOPGEN   3392
#define XB_SPIN_CAP (1u << 18)
DI unsigned xb_ld(unsigned* p) { return __hip_atomic_load(p, __ATOMIC_RELAXED, __HIP_MEMORY_SCOPE_AGENT); }
DI unsigned xb_add(unsigned* p, unsigned v) { return __hip_atomic_fetch_add(p, v, __ATOMIC_RELAXED, __HIP_MEMORY_SCOPE_AGENT); }
DI unsigned xb_xcc_id() { return (unsigned)__builtin_amdgcn_s_getreg((3 << 11) | 20) & 0xFu; }
#define XB_SPIN(cond, bar) do { unsigned _sp = 0; while (cond) { __builtin_amdgcn_s_sleep(1); \
    if ((++_sp & 255u) == 0u) { if (xb_ld(&(bar)[XB_TMO])) break; if (_sp > XB_SPIN_CAP) { atomicAdd(&(bar)[XB_TMO], 1u); break; } } } } while (0)
DI void xcd_barrier_complete(unsigned* bar, unsigned x, unsigned& nloc, unsigned& nx) {
    const unsigned G = gridDim.x;
    unsigned sum, cnt, mine, sp = 0u;
    for (;;) {
        sum = 0u; cnt = 0u; mine = 0u;
#pragma unroll
        for (unsigned j = 0; j < 16; ++j) { const unsigned c = xb_ld(&bar[XB_XCNT(j)]); sum += c; cnt += (c > 0u) ? 1u : 0u; mine = (j == x) ? c : mine; }
        if (sum == G) break;
        __builtin_amdgcn_s_sleep(1);
        if ((++sp & 255u) == 0u) { if (xb_ld(&bar[XB_TMO])) break; if (sp > XB_SPIN_CAP) { atomicAdd(&bar[XB_TMO], 1u); break; } }
    }
    nloc = mine > 0u ? mine : 1u; nx = cnt > 0u ? cnt : 1u;
}
DI void xcd_barrier(int wv, unsigned* bar, volatile LAS unsigned* st) {
    asm volatile("s_waitcnt vmcnt(0)" ::: "memory");
    __syncthreads();
    if (ltid(wv) == 0) {
        const unsigned x = xb_xcc_id();
        __builtin_amdgcn_s_waitcnt(0);
        unsigned nloc = st[0], nx = st[1];
        if (nloc == 0u) { xcd_barrier_complete(bar, x, nloc, nx); st[0] = nloc; st[1] = nx; }
        const unsigned old = xb_add(&bar[XB_XSUB(x)], 1u);
        const unsigned gen = old / nloc;
        if (old + 1u == (gen + 1u) * nloc) {
            __builtin_amdgcn_fence(__ATOMIC_RELEASE, "agent");
            asm volatile("s_waitcnt vmcnt(0)" ::: "memory");
            const unsigned og = xb_add(&bar[XB_TOP], 1u);
            const unsigned tg = og / nx;
            if (og + 1u == (tg + 1u) * nx) xb_add(&bar[XB_TOPGEN], 1u);
            else XB_SPIN(xb_ld(&bar[XB_TOPGEN]) == tg, bar);
            __builtin_amdgcn_fence(__ATOMIC_ACQUIRE, "agent");
            xb_add(&bar[XB_XGEN(x)], 1u);
            asm volatile("s_waitcnt vmcnt(0)" ::: "memory");
        } else {
            XB_SPIN(xb_ld(&bar[XB_XGEN(x)]) == gen, bar);
            __builtin_amdgcn_fence(__ATOMIC_ACQUIRE, "agent");
            asm volatile("s_waitcnt vmcnt(0)" ::: "memory");
        }
    }
    __syncthreads();
}
DI ArgP getargs() { ArgP r; r.p = (const __attribute__((address_space(4))) Args*)__builtin_amdgcn_kernarg_segment_ptr(); asm volatile("" : "+s"(r.p)); return r; }
#define WSB (getargs().ws())
#define XBP ((bf16_t*)(getargs().ws() + O_XB) + 2 * 1024)
#define RSS ((u64*)(getargs().ws() + O_ROWSS))
#define HFP (getargs().out())
__global__ void __launch_bounds__(512, 2) fwd_kernel(Args a_unused) {
    extern __shared__ __attribute__((aligned(16))) unsigned char shm[];
    LAS unsigned char* lds = (LAS unsigned char*)shm;
    const int wv = __builtin_amdgcn_readfirstlane(threadIdx.x >> 6);
#define BARW ((unsigned*)(getargs().ws() + O_BAR))
#define BARST ((volatile LAS unsigned*)(lds + 139264))
#define GSYNC() xcd_barrier(wv, BARW, BARST)
    { unsigned* barw0 = BARW; if (threadIdx.x == 0) { BARST[0] = 0u; BARST[1] = 0u; (void)xb_add(&barw0[XB_XCNT(xb_xcc_id())], 1u); } }
    if (getargs().p->pad == 0x7fffffff) cg::this_grid().sync();

#if !(DIS & (1u << 0))
    for (int rep_ = 0; rep_ < ((REP >> 0) & 1u) + 1; ++rep_) { const int dry_ = rep_ < (int)((REP >> 0) & 1u); (void)dry_;
    phase_prologue(wv, getargs(), lds, dry_ ? PROPART : 7);
    }
#endif
    GSYNC();
#if !(DIS & (1u << 1))
    for (int rep_ = 0; rep_ < ((REP >> 1) & 1u) + 1; ++rep_) { const int dry_ = rep_ < (int)((REP >> 1) & 1u); (void)dry_;
    { EpiRowBf16<1> E{(bf16_t*)(WSB + O_Z), 1536, RSS};
      pg8::gemm_phase<false>(wv, lds, XBP, 1024, (const bf16_t*)(WSB + O_W1T), 1024, 1024, 64, 6, E); }
    }
#endif
    GSYNC();
#if !(DIS & (1u << 2))
    for (int rep_ = 0; rep_ < ((REP >> 2) & 1u) + 1; ++rep_) { const int dry_ = rep_ < (int)((REP >> 2) & 1u); (void)dry_;
    phase_l0_prep(wv, getargs());
    }
#endif
    GSYNC();
#if !(DIS & (1u << 3))
    for (int rep_ = 0; rep_ < ((REP >> 3) & 1u) + 1; ++rep_) { const int dry_ = rep_ < (int)((REP >> 3) & 1u); (void)dry_;
    { EpiRowBf16<0> E{(bf16_t*)(WSB + O_RI), 1024, nullptr};
      pg8::gemm_phase<false>(wv, lds, (const bf16_t*)(WSB + O_XC), 512, (const bf16_t*)(WSB + O_WRIT), 512, 512, 64, 4, E); }
    }
#endif
#if !(DIS & (1u << 4))
    for (int rep_ = 0; rep_ < ((REP >> 4) & 1u) + 1; ++rep_) { const int dry_ = rep_ < (int)((REP >> 4) & 1u); (void)dry_;
    { EpiQ E{(bf16_t*)(WSB + O_QB), (const float*)(WSB + O_RSQ), (const float*)(WSB + O_CSTAB)};
      pg8::gemm_phase<false>(wv, lds, (const bf16_t*)(WSB + O_Z) + 1024, 1536, (const bf16_t*)(WSB + O_WQT), 256, 256, 64, 3, E); }
    }
#endif
#if !(DIS & (1u << 5))
    for (int rep_ = 0; rep_ < ((REP >> 5) & 1u) + 1; ++rep_) { const int dry_ = rep_ < (int)((REP >> 5) & 1u); (void)dry_;
    { EpiK E{(bf16_t*)(WSB + O_KB), (const float*)(WSB + O_RSKV)};
      pg8::gemm_phase<false>(wv, lds, (const bf16_t*)(WSB + O_Z) + 1280, 1536, (const bf16_t*)(WSB + O_WKT), 256, 256, 64, 2, E, 192); }
    }
#endif
#if !(DIS & (1u << 6))
    for (int rep_ = 0; rep_ < ((REP >> 6) & 1u) + 1; ++rep_) { const int dry_ = rep_ < (int)((REP >> 6) & 1u); (void)dry_;
    { EpiColBf16<2> E{(bf16_t*)(WSB + O_VT), S, (const float*)(WSB + O_RSKV)};
      pg8::gemm_phase<false>(wv, lds, (const bf16_t*)(WSB + O_WVT), 256, (const bf16_t*)(WSB + O_Z) + 1280, 1536, 256, 2, 64, E, 64); }
    }
#endif
    GSYNC();
#if !(DIS & (1u << 7))
    for (int rep_ = 0; rep_ < ((REP >> 7) & 1u) + 1; ++rep_) { const int dry_ = rep_ < (int)((REP >> 7) & 1u); (void)dry_;
    phase_lru_s1(wv, getargs());
    }
#endif
    GSYNC();
#if !(DIS & (1u << 8))
    for (int rep_ = 0; rep_ < ((REP >> 8) & 1u) + 1; ++rep_) { const int dry_ = rep_ < (int)((REP >> 8) & 1u); (void)dry_;
    phase_lru_s3(wv, getargs());
    }
#endif
#if !(DIS & (1u << 9))
    for (int rep_ = 0; rep_ < ((REP >> 9) & 1u) + 1; ++rep_) { const int dry_ = rep_ < (int)((REP >> 9) & 1u); (void)dry_;
    phase_attn(wv, getargs(), lds);
    }
#endif
    GSYNC();
#if !(DIS & (1u << 10))
    for (int rep_ = 0; rep_ < ((REP >> 10) & 1u) + 1; ++rep_) { const int dry_ = rep_ < (int)((REP >> 10) & 1u); (void)dry_;
    { EpiRes<false> E{getargs().in(0), XBP, RSS + 1 * S, dry_};
      pg8::gemm_phase<false>(wv, lds, (const bf16_t*)(WSB + O_MIX), 1024, (const bf16_t*)(WSB + O_WO1T), 1024, 1024, 64, 4, E); }
    }
#endif
    GSYNC();
#if !(DIS & (1u << 11))
    for (int rep_ = 0; rep_ < ((REP >> 11) & 1u) + 1; ++rep_) { const int dry_ = rep_ < (int)((REP >> 11) & 1u); (void)dry_;
    { EpiUp E{(bf16_t*)(WSB + O_ACT), RSS + 1 * S, getargs().in(24), getargs().in(25), lds + 131072};
      pg8::gemm_phase<true>(wv, lds, XBP, 1024, (const bf16_t*)(WSB + O_WUPT0), 1024, 1024, 67, 22, E); }
    }
#endif
    GSYNC();
#if !(DIS & (1u << 12))
    for (int rep_ = 0; rep_ < ((REP >> 12) & 1u) + 1; ++rep_) { const int dry_ = rep_ < (int)((REP >> 12) & 1u); (void)dry_;
    { EpiRes<true> E{nullptr, XBP, RSS + 2 * S, dry_};
      pg8::gemm_phase<false>(wv, lds, (const bf16_t*)(WSB + O_ACT), 2816, (const bf16_t*)(WSB + O_WDNT0), 2816, 2816, 64, 4, E); }
    }
#endif
    GSYNC();
#if !(DIS & (1u << 13))
    for (int rep_ = 0; rep_ < ((REP >> 13) & 1u) + 1; ++rep_) { const int dry_ = rep_ < (int)((REP >> 13) & 1u); (void)dry_;
    { EpiRowBf16<1> E{(bf16_t*)(WSB + O_QOK), 2048, RSS + 2 * S};
      pg8::gemm_phase<false>(wv, lds, XBP, 1024, (const bf16_t*)(WSB + O_WOINT), 1024, 1024, 64, 8, E); }
    }
#endif
#if !(DIS & (1u << 14))
    for (int rep_ = 0; rep_ < ((REP >> 14) & 1u) + 1; ++rep_) { const int dry_ = rep_ < (int)((REP >> 14) & 1u); (void)dry_;
    { EpiColBf16<1> E{(bf16_t*)(WSB + O_KVT), S, RSS + 2 * S};
      pg8::gemm_phase<false>(wv, lds, (const bf16_t*)(WSB + O_WOINT) + (size_t)1536 * 1024, 1024, XBP, 1024, 1024, 6, 64, E); }
    }
#endif
#if !(DIS & (1u << 15))
    for (int rep_ = 0; rep_ < ((REP >> 15) & 1u) + 1; ++rep_) { const int dry_ = rep_ < (int)((REP >> 15) & 1u); (void)dry_;
    phase_m_gates(wv, getargs(), lds);
    }
#endif
    GSYNC();
#if !(DIS & (1u << 16))
    for (int rep_ = 0; rep_ < ((REP >> 16) & 1u) + 1; ++rep_) { const int dry_ = rep_ < (int)((REP >> 16) & 1u); (void)dry_;
    phase_m_dc(wv, getargs());
    }
#endif
    GSYNC();
#if !(DIS & (1u << 22))
    for (int rep_ = 0; rep_ < ((REP >> 22) & 1u) + 1; ++rep_) { const int dry_ = rep_ < (int)((REP >> 22) & 1u); (void)dry_;
    phase_m_comb(wv, getargs(), lds, dry_);
    }
#endif
    GSYNC();
#if !(DIS & (1u << 17))
    for (int rep_ = 0; rep_ < ((REP >> 17) & 1u) + 1; ++rep_) { const int dry_ = rep_ < (int)((REP >> 17) & 1u); (void)dry_;
    phase_m_out(wv, getargs(), lds, dry_);
    }
#endif
    GSYNC();
#if !(DIS & (1u << 18))
    for (int rep_ = 0; rep_ < ((REP >> 18) & 1u) + 1; ++rep_) { const int dry_ = rep_ < (int)((REP >> 18) & 1u); (void)dry_;
    { EpiRes<true> E{nullptr, XBP, RSS + 3 * S, dry_};
      pg8::gemm_phase<false>(wv, lds, (const bf16_t*)(WSB + O_QOK) + 512, 2048, (const bf16_t*)(WSB + O_WO2T), 1024, 1024, 64, 4, E); }
    }
#endif
    GSYNC();
#if !(DIS & (1u << 19))
    for (int rep_ = 0; rep_ < ((REP >> 19) & 1u) + 1; ++rep_) { const int dry_ = rep_ < (int)((REP >> 19) & 1u); (void)dry_;
    { EpiUp E{(bf16_t*)(WSB + O_ACT), RSS + 3 * S, getargs().in(24) + 3 * 5632, getargs().in(25) + 5632, lds + 131072};
      pg8::gemm_phase<true>(wv, lds, XBP, 1024, (const bf16_t*)(WSB + O_WUPT1), 1024, 1024, 67, 22, E); }
    }
#endif
    GSYNC();
#if !(DIS & (1u << 20))
    for (int rep_ = 0; rep_ < ((REP >> 20) & 1u) + 1; ++rep_) { const int dry_ = rep_ < (int)((REP >> 20) & 1u); (void)dry_;
    { EpiRes<true> E{nullptr, XBP, RSS + 4 * S, dry_};
      pg8::gemm_phase<false>(wv, lds, (const bf16_t*)(WSB + O_ACT), 2816, (const bf16_t*)(WSB + O_WDNT1), 2816, 2816, 64, 4, E); }
    }
#endif
    GSYNC();
#if !(DIS & (1u << 21))
    for (int rep_ = 0; rep_ < ((REP >> 21) & 1u) + 1; ++rep_) { const int dry_ = rep_ < (int)((REP >> 21) & 1u); (void)dry_;
    phase_final(wv, getargs());
    }
#endif
    for (int i = 0; i < XSYNC; ++i) GSYNC();
}

extern "C" void kernel_launch(void* const* d_in, const int* in_sizes, int n_in, void* d_out, int out_size, void* d_ws, size_t ws_size, hipStream_t stream) {
    static int grid = 0;
    if (grid == 0) {
        if (n_in != 28 || out_size != S * 1024 || ws_size < WS_NEED) { fprintf(stderr, "kernel_launch: unexpected shapes (n_in %d out %d ws %zu need %zu)\n", n_in, out_size, ws_size, (size_t)WS_NEED); grid = -1; return; }
        int dev = 0, cus = 0, per_cu = 0;
        (void)hipGetDevice(&dev);
        (void)hipDeviceGetAttribute(&cus, hipDeviceAttributeMultiprocessorCount, dev);
        if (hipFuncSetAttribute((const void*)fwd_kernel, hipFuncAttributeMaxDynamicSharedMemorySize, LDS_BYTES) != hipSuccess) { fprintf(stderr, "kernel_launch: hipFuncSetAttribute failed\n"); grid = -1; return; }
        if (hipOccupancyMaxActiveBlocksPerMultiprocessor(&per_cu, (const void*)fwd_kernel, 512, LDS_BYTES) != hipSuccess || per_cu < 1) { fprintf(stderr, "kernel_launch: occupancy query says %d\n", per_cu); per_cu = 1; }
        (void)hipGetLastError();
        grid = cus * 1;
        if (grid > 256) grid = 256;
    }
    if (grid < 0) return;
    Args a{};
    for (int i = 0; i < 28; ++i) a.in[i] = (const float*)d_in[i];
    a.out = (float*)d_out; a.ws = (unsigned char*)d_ws;
    if (hipMemsetAsync((char*)d_ws + O_BAR, 0, BAR_BYTES, stream) != hipSuccess) { fprintf(stderr, "kernel_launch: memset failed\n"); return; }
    void* args[] = {&a};
    hipError_t e = hipLaunchCooperativeKernel((void*)fwd_kernel, dim3(grid), dim3(512), args, LDS_BYTES, stream);
    if (e != hipSuccess) fprintf(stderr, "kernel_launch: cooperative launch failed: %s (grid %d)\n", hipGetErrorString(e), grid);
}
```

```cpp
#include <hip/hip_runtime.h>
#include <hip/hip_cooperative_groups.h>
#include <cstdio>
#include <cstdint>
namespace cg = cooperative_groups;

typedef unsigned short bf16_t;
typedef short bf16x8 __attribute__((ext_vector_type(8)));
typedef short s16x4 __attribute__((ext_vector_type(4)));
typedef float f32x2 __attribute__((ext_vector_type(2)));
typedef float f32x4 __attribute__((ext_vector_type(4)));
typedef float f32x16 __attribute__((ext_vector_type(16)));
typedef unsigned u32x2 __attribute__((ext_vector_type(2)));
typedef unsigned u32x4 __attribute__((ext_vector_type(4)));
typedef __bf16 bf16x2_t __attribute__((ext_vector_type(2)));
#define LAS __attribute__((address_space(3)))
#define DI __device__ __forceinline__

constexpr int S = 16384;
constexpr float EPS = 1e-6f;
constexpr float LOG2E = 1.4426950408889634f;

constexpr size_t SZ_WUPT = (size_t)5632 * 1024 * 2, SZ_WDNT = (size_t)1024 * 2816 * 2;
constexpr size_t O_WUPT1 = 0;
constexpr size_t O_WDNT1 = O_WUPT1 + SZ_WUPT;
constexpr size_t O_WOINT = O_WDNT1 + SZ_WDNT;
constexpr size_t O_WO2T = O_WOINT + (size_t)3072 * 1024 * 2;
constexpr size_t O_ROWSS = O_WO2T + (size_t)1024 * 1024 * 2;
constexpr size_t O_RSQ = O_ROWSS + (size_t)5 * S * 8;
constexpr size_t O_RSKV = O_RSQ + (size_t)S * 4;
constexpr size_t O_CSTAB = O_RSKV + (size_t)S * 4;
constexpr size_t O_CHA = O_CSTAB + (size_t)S * 32 * 4;
constexpr size_t O_CHH = O_CHA + (size_t)256 * 512 * 4;
constexpr size_t O_GB = O_CHH + (size_t)256 * 512 * 4;
constexpr size_t O_GE = O_GB + (size_t)4 * S * 4;
constexpr size_t O_GPM = O_GE + (size_t)4 * S * 4;
constexpr size_t O_BL = O_GPM + (size_t)4 * S * 4;
constexpr size_t O_ML = O_BL + 4096;
constexpr size_t O_MST = O_ML + 4096;
constexpr size_t O_NST = O_MST + 4096;
constexpr size_t O_BAR = O_NST + (size_t)256 * 4 * 128 * 4;
constexpr size_t BAR_BYTES = 16384;
constexpr size_t O_XB = O_BAR + BAR_BYTES;
constexpr size_t XB_ROWS = 16648;
constexpr size_t O_L0W = O_XB + XB_ROWS * 2048;
constexpr size_t O_W1T = O_L0W;
constexpr size_t O_WQT = O_W1T + (size_t)1536 * 1024 * 2;
constexpr size_t O_WKT = O_WQT + (size_t)768 * 256 * 2;
constexpr size_t O_WVT = O_WKT + (size_t)512 * 256 * 2;
constexpr size_t O_WRIT = O_WVT + (size_t)512 * 256 * 2;
constexpr size_t O_WO1T = O_WRIT + (size_t)1024 * 512 * 2;
constexpr size_t O_WUPT0 = O_WO1T + (size_t)1024 * 1024 * 2;
constexpr size_t O_WDNT0 = O_WUPT0 + SZ_WUPT;
constexpr size_t O_ARENA = O_WDNT0 + SZ_WDNT;
constexpr size_t O_Z = O_ARENA;
constexpr size_t O_XC = O_Z + (size_t)S * 1536 * 2;
constexpr size_t O_QB = O_XC + (size_t)S * 512 * 2;
constexpr size_t O_KB = O_QB + (size_t)8 * S * 96 * 2;
constexpr size_t O_VT = O_KB + (size_t)8 * S * 96 * 2;
constexpr size_t O_MIX = O_VT + (size_t)512 * S * 2;
constexpr size_t O_END0 = O_MIX + (size_t)S * 1024 * 2;
constexpr size_t O_ACT = O_ARENA;
constexpr size_t O_RI = O_XB;
constexpr size_t O_CST = O_L0W;
constexpr size_t O_QOK = O_CST + (size_t)256 * 4 * 256 * 128 * 2;
constexpr size_t O_KVT = O_QOK + (size_t)S * 2048 * 2;
constexpr size_t O_END1 = O_KVT + (size_t)1536 * S * 2;
constexpr size_t WS_NEED = (O_END0 > O_END1 ? O_END0 : O_END1);
static_assert(WS_NEED <= (size_t)268435456, "workspace");
static_assert(O_ACT + (size_t)(S + 240) * 2816 * 2 <= (size_t)268435456, "act");

constexpr int LDS_BYTES = 147456;

struct Args {
    const float* in[28];
    float* out;
    unsigned char* ws;
    int pad; int pad2;
};

struct ArgP { const __attribute__((address_space(4))) Args* p;
    DI const float* in(int i) const { return p->in[i]; } DI float* out() const { return p->out; } DI unsigned char* ws() const { return p->ws; } };
DI unsigned pk2(float lo, float hi) { f32x2 v = {lo, hi}; bf16x2_t b = __builtin_convertvector(v, bf16x2_t); return __builtin_bit_cast(unsigned, b); }
DI bf16_t f2bf(float f) { return (bf16_t)(pk2(f, 0.f) & 0xffffu); }
DI int ltid(int wv) { asm volatile("" : "+s"(wv)); int l = __builtin_amdgcn_mbcnt_hi(~0u, __builtin_amdgcn_mbcnt_lo(~0u, 0u)); asm volatile("" : "+v"(l)); return wv * 64 + l; }
DI int lbid() { int t = blockIdx.x; asm volatile("" : "+s"(t)); return t; }
DI float bf2f(bf16_t b) { return __uint_as_float(((unsigned)b) << 16); }
DI float bflo(unsigned u) { return __uint_as_float(u << 16); }
DI float bfhi(unsigned u) { return __uint_as_float(u & 0xffff0000u); }
DI float wave_sum(float v) {
#pragma unroll
    for (int o = 1; o < 64; o <<= 1) v += __shfl_xor(v, o);
    return v;
}
DI float fexp(float x) { return __builtin_amdgcn_exp2f(x * LOG2E); }
DI float sigmoidf_(float x) { return __builtin_amdgcn_rcpf(1.f + fexp(-x)); }
DI int crow(int r, int hi) { return (r & 3) + 8 * (r >> 2) + 4 * hi; }
typedef unsigned long long u64;
DI float rs_from_ss(u64 ssq) { return rsqrtf((float)ssq * (1.f / (1048576.f * 1024.f)) + EPS); }
DI u64 ss_to_fix(float ss) { return (u64)(ss * 1048576.f); }

namespace pg8 {
constexpr int BM = 256, BK = 64, HALF = 128, HTB = HALF * BK * 2, STAGE_BYTES = 8 * HTB, NXCD = 8, WGM = 8;
DI int lds_byte(int r, int c) { const int st = (r >> 4) * 2 + (c >> 5), rr = r & 15, cc = c & 31, ob = rr * 64 + cc * 2; return st * 1024 + (ob ^ (((ob >> 9) & 1) << 5)); }
DI void stage_rc(int b, int& R, int& C) { const int st = b / 1024, sb = b % 1024, swz = sb ^ (((sb >> 9) & 1) << 5); R = (st >> 1) * 16 + swz / 64; C = (st & 1) * 32 + (swz % 64) / 2; }
DI int perm32(int rho) { const int n = rho >> 4, i = rho & 15; return 8 * (i >> 2) + 4 * n + (i & 3); }
struct Unit { int pm, pn; };
struct StaticOrder {
    int nM, nN, nwg, G, c;
    DI void init(int nM_, int nN_, int G_, int c_) { nM = nM_; nN = nN_; nwg = nM * nN; G = G_; c = c_; }
    DI bool next(int i, Unit& u) const {
        const long L = (long)i * G + c; if (L >= nwg) return false;
        int wgid = (int)L; { const int q = nwg / NXCD, r = nwg % NXCD, xcd = wgid % NXCD, off = wgid / NXCD; wgid = (xcd < r ? xcd * (q + 1) : r * (q + 1) + (xcd - r) * q) + off; }
        const int nig = WGM * nN, gid = wgid / nig, fm = gid * WGM, gsz = (nM - fm) < WGM ? (nM - fm) : WGM;
        u.pm = fm + ((wgid % nig) % gsz); u.pn = (wgid % nig) / gsz; return true;
    }
};

template <bool AMAP, class Epi, bool KOFS = false>
DI void gemm_phase(int wv, LAS unsigned char* lds, const bf16_t* A, int lda, const bf16_t* Bt, int ldb, int K_, int nM, int nN, const Epi& E, int rot = 0) {
    int K = K_; asm volatile("" : "+s"(K));
    const int tid = ltid(wv), wid = __builtin_amdgcn_readfirstlane(tid >> 6), lane = tid & 63, wr = wid >> 2, wc = wid & 3, fr = lane & 15, fq = lane >> 4;
    const int nt = K / BK;
    StaticOrder SO; { int c_ = lbid() - rot; if (c_ < 0) c_ += (int)gridDim.x; SO.init(nM, nN, (int)gridDim.x, c_); }
    unsigned voffA[2], voffB[2];
#pragma unroll
    for (int i = 0; i < 2; ++i) { int R, C; stage_rc(tid * 16 + i * 8192, R, C); const int Rb = (R & ~31) + perm32(R & 31);
        const int Ra = AMAP ? (62 * (R >> 6) + (R & 63) - 2) : R;
        voffA[i] = (unsigned)((Ra + (AMAP ? 2 : 0)) * lda + C) * 2u; voffB[i] = (unsigned)(Rb * ldb + C) * 2u; }
    const size_t kstep = (size_t)(BK * 2);
    const size_t hstepA = (size_t)(AMAP ? 124 : 128) * lda * 2, hstepB = (size_t)HALF * ldb * 2;
    const size_t tstepA = 2 * hstepA, tstepB = 2 * hstepB;
    const unsigned ldsw = (unsigned)wid * 1024u;
    const int aoff = lds_byte(wr * 64 + fr, fq * 8), boff = lds_byte(wc * 32 + fr, fq * 8);
#define PG8_SA(b, h) (((b) * 2 + (h)) * HTB)
#define PG8_SB(b, h) ((4 + (b) * 2 + (h)) * HTB)
#define PG8_STAGE(bufoff, gbase, voff) do { _Pragma("unroll") for (int _i = 0; _i < 2; ++_i) \
        __builtin_amdgcn_global_load_lds((const unsigned*)((const char*)(gbase) + (voff)[_i]), (LAS unsigned*)(lds + (bufoff) + ldsw + _i * 8192), 16, 0, 0); } while (0)
#define PG8_LDA(dst, b, h) do { _Pragma("unroll") for (int m = 0; m < 4; ++m) _Pragma("unroll") for (int k = 0; k < 2; ++k) dst[m][k] = *(const LAS bf16x8*)(lds + PG8_SA(b, h) + aoff + m * 2048 + k * 1024); } while (0)
#define PG8_LDB(dst, b, h) do { _Pragma("unroll") for (int n = 0; n < 2; ++n) _Pragma("unroll") for (int k = 0; k < 2; ++k) dst[n][k] = *(const LAS bf16x8*)(lds + PG8_SB(b, h) + boff + n * 2048 + k * 1024); } while (0)
#define PG8_MMA(ai, bj, At, Bt_) do { __builtin_amdgcn_s_setprio(1); _Pragma("unroll") for (int m = 0; m < 4; ++m) _Pragma("unroll") for (int n = 0; n < 2; ++n) _Pragma("unroll") for (int k = 0; k < 2; ++k) \
        acc[ai][bj][m][n] = __builtin_amdgcn_mfma_f32_16x16x32_bf16(Bt_[n][k], At[m][k], acc[ai][bj][m][n], 0, 0, 0); __builtin_amdgcn_s_setprio(0); } while (0)
#define PG8_WAIT_V(n) asm volatile("s_waitcnt vmcnt(" #n ")" ::: "memory")
#define PG8_WAIT_L(n) asm volatile("s_waitcnt lgkmcnt(" #n ")" ::: "memory")
#define PG8_BAR __builtin_amdgcn_s_barrier()
#define PG8_SCHED __builtin_amdgcn_sched_barrier(0)
    if (AMAP) A -= 2 * lda;
    Unit cur, nxt; int ui = 0;
    if (!SO.next(0, cur)) return;
    f32x4 acc[2][2][4][2];
#pragma unroll
    for (int a = 0; a < 2; ++a)
#pragma unroll
        for (int b = 0; b < 2; ++b)
#pragma unroll
            for (int m = 0; m < 4; ++m)
#pragma unroll
                for (int n = 0; n < 2; ++n) acc[a][b][m][n] = (f32x4){0.f, 0.f, 0.f, 0.f};
    bf16x8 At[4][2], B0[2][2], B1[2][2];
    const char* cA = (const char*)A + (size_t)cur.pm * tstepA + (KOFS ? (cur.pn & 1) * 512 : 0); const char* cB = (const char*)Bt + (size_t)cur.pn * tstepB + (KOFS ? (cur.pn & 1) * 512 : 0);
    PG8_STAGE(PG8_SB(0, 0), cB, voffB); PG8_STAGE(PG8_SB(0, 1), cB + hstepB, voffB); PG8_STAGE(PG8_SA(0, 0), cA, voffA); PG8_STAGE(PG8_SA(0, 1), cA + hstepA, voffA);
    if (wr == 1) PG8_BAR;
    PG8_WAIT_V(2); PG8_BAR;
    PG8_STAGE(PG8_SB(1, 0), cB + kstep, voffB); PG8_STAGE(PG8_SA(1, 0), cA + kstep, voffA); PG8_STAGE(PG8_SB(1, 1), cB + hstepB + kstep, voffB);
    PG8_WAIT_V(6); PG8_BAR;
    for (;;) {
        const bool has_next = SO.next(ui + 1, nxt);
        const char* nA = has_next ? (const char*)A + (size_t)nxt.pm * tstepA + (KOFS ? (nxt.pn & 1) * 512 : 0) : cA; const char* nB = has_next ? (const char*)Bt + (size_t)nxt.pn * tstepB + (KOFS ? (nxt.pn & 1) * 512 : 0) : cB;
        for (int t = 0; t < nt; t += 2) {
            const bool last = (t == nt - 2);
            const char* a1 = cA + (size_t)(t + 1) * kstep;
            const char* a2 = last ? nA : cA + (size_t)(t + 2) * kstep; const char* b2 = last ? nB : cB + (size_t)(t + 2) * kstep;
            const char* a3 = a2 + kstep; const char* b3 = b2 + kstep;
            PG8_LDB(B0, 0, 0); PG8_LDB(B1, 0, 1); PG8_SCHED; PG8_LDA(At, 0, 0); PG8_STAGE(PG8_SA(1, 1), a1 + hstepA, voffA);
            PG8_WAIT_V(8); PG8_WAIT_L(0); PG8_BAR; PG8_MMA(0, 0, At, B0); PG8_MMA(0, 1, At, B1); PG8_BAR; PG8_SCHED;
            PG8_LDA(At, 0, 1); PG8_STAGE(PG8_SB(0, 0), b2, voffB); PG8_STAGE(PG8_SB(0, 1), b2 + hstepB, voffB); PG8_STAGE(PG8_SA(0, 0), a2, voffA);
            PG8_WAIT_V(8); PG8_WAIT_L(0); PG8_BAR; PG8_MMA(1, 0, At, B0); PG8_MMA(1, 1, At, B1); PG8_BAR; PG8_SCHED;
            PG8_LDB(B0, 1, 0); PG8_LDB(B1, 1, 1); PG8_SCHED; PG8_LDA(At, 1, 0); PG8_STAGE(PG8_SA(0, 1), a2 + hstepA, voffA);
            PG8_WAIT_V(8); PG8_WAIT_L(0); PG8_BAR; PG8_MMA(0, 0, At, B0); PG8_MMA(0, 1, At, B1); PG8_BAR; PG8_SCHED;
            PG8_LDA(At, 1, 1); PG8_STAGE(PG8_SB(1, 0), b3, voffB); PG8_STAGE(PG8_SB(1, 1), b3 + hstepB, voffB); PG8_STAGE(PG8_SA(1, 0), a3, voffA);
            PG8_WAIT_V(8); PG8_WAIT_L(0); PG8_BAR; PG8_MMA(1, 0, At, B0); PG8_MMA(1, 1, At, B1); PG8_BAR; PG8_SCHED;
        }
        if (wr == 0) PG8_BAR;
        E(acc, cur, wr, wc, fr, fq);
        if (!has_next) break;
#pragma unroll
        for (int a = 0; a < 2; ++a)
#pragma unroll
            for (int b = 0; b < 2; ++b)
#pragma unroll
                for (int m = 0; m < 4; ++m)
#pragma unroll
                    for (int n = 0; n < 2; ++n) acc[a][b][m][n] = (f32x4){0.f, 0.f, 0.f, 0.f};
        cur = nxt; cA = nA; cB = nB; ++ui;
        if (wr == 1) PG8_BAR;
    }
    PG8_WAIT_V(0);
    PG8_BAR;
#undef PG8_SA
#undef PG8_SB
#undef PG8_STAGE
#undef PG8_LDA
#undef PG8_LDB
#undef PG8_MMA
#undef PG8_WAIT_V
#undef PG8_WAIT_L
#undef PG8_BAR
#undef PG8_SCHED
}
}
using pg8::Unit;
typedef f32x4 AccT[2][2][4][2];

template <int SMODE> struct EpiRowBf16 {
    bf16_t* O; int ldc; const void* sc;
    DI void operator()(const AccT& acc, const Unit& u, int wr, int wc, int fr, int fq) const {
        const int row0 = u.pm * 256 + wr * 64 + fr, col0 = u.pn * 256 + wc * 32 + 8 * fq;
#pragma unroll
        for (int ai = 0; ai < 2; ++ai)
#pragma unroll
            for (int m = 0; m < 4; ++m) { const int row = row0 + ai * 128 + m * 16;
                float s = 1.f; if (SMODE == 1) s = rs_from_ss(((const u64*)sc)[row]); if (SMODE == 2) s = ((const float*)sc)[row];
                bf16_t* rowp = O + (size_t)row * ldc + col0;
#pragma unroll
                for (int bj = 0; bj < 2; ++bj) { const f32x4 v0 = acc[ai][bj][m][0] * s, v1 = acc[ai][bj][m][1] * s;
                    u32x4 w; w.x = pk2(v0[0], v0[1]); w.y = pk2(v0[2], v0[3]); w.z = pk2(v1[0], v1[1]); w.w = pk2(v1[2], v1[3]);
                    *(u32x4*)(rowp + bj * 128) = w; } }
    }
};
template <int SMODE> struct EpiColBf16 {
    bf16_t* O; int ldc; const void* sc;
    DI void operator()(const AccT& acc, const Unit& u, int wr, int wc, int fr, int fq) const {
        const int row0 = u.pm * 256 + wr * 64 + fr, col0 = u.pn * 256 + wc * 32 + 8 * fq;
#pragma unroll
        for (int bj = 0; bj < 2; ++bj) { float s[8];
#pragma unroll
            for (int j = 0; j < 8; ++j) s[j] = (SMODE == 1) ? rs_from_ss(((const u64*)sc)[col0 + bj * 128 + j]) : ((const float*)sc)[col0 + bj * 128 + j];
#pragma unroll
            for (int ai = 0; ai < 2; ++ai)
#pragma unroll
                for (int m = 0; m < 4; ++m) { const int row = row0 + ai * 128 + m * 16; const f32x4 v0 = acc[ai][bj][m][0], v1 = acc[ai][bj][m][1];
                    u32x4 w; w.x = pk2(v0[0] * s[0], v0[1] * s[1]); w.y = pk2(v0[2] * s[2], v0[3] * s[3]); w.z = pk2(v1[0] * s[4], v1[1] * s[5]); w.w = pk2(v1[2] * s[6], v1[3] * s[7]);
                    *(u32x4*)(O + (size_t)row * ldc + col0 + bj * 128) = w; } }
    }
};
struct EpiQ {
    bf16_t* QB; const float* rsq; const float* cstab;
    DI void operator()(const AccT& acc, const Unit& u, int wr, int wc, int fr, int fq) const {
        const int row0 = u.pm * 256 + wr * 64 + fr, col0 = u.pn * 256 + wc * 32 + 8 * fq;
        const float QS = 0.10206207261596577f * LOG2E;
#pragma unroll
        for (int ai = 0; ai < 2; ++ai)
#pragma unroll
            for (int m = 0; m < 4; ++m) { const int t = row0 + ai * 128 + m * 16; const float s = rsq[t] * QS;
#pragma unroll
                for (int bj = 0; bj < 2; ++bj) { const int c = col0 + bj * 128, h = c / 96, d = c - h * 96;
                    f32x4 v0 = acc[ai][bj][m][0] * s, v1 = acc[ai][bj][m][1] * s;
                    if (d >= 64) { const int i0 = (d - 64) >> 1; const f32x4 cs0 = *(const f32x4*)(cstab + (size_t)t * 32 + 2 * i0), cs1 = *(const f32x4*)(cstab + (size_t)t * 32 + 2 * i0 + 4);
                        f32x4 a, b;
                        a[0] = v0[0] * cs0[0] - v0[1] * cs0[1]; a[1] = v0[1] * cs0[0] + v0[0] * cs0[1];
                        a[2] = v0[2] * cs0[2] - v0[3] * cs0[3]; a[3] = v0[3] * cs0[2] + v0[2] * cs0[3];
                        b[0] = v1[0] * cs1[0] - v1[1] * cs1[1]; b[1] = v1[1] * cs1[0] + v1[0] * cs1[1];
                        b[2] = v1[2] * cs1[2] - v1[3] * cs1[3]; b[3] = v1[3] * cs1[2] + v1[2] * cs1[3];
                        v0 = a; v1 = b; }
                    u32x4 w; w.x = pk2(v0[0], v0[1]); w.y = pk2(v0[2], v0[3]); w.z = pk2(v1[0], v1[1]); w.w = pk2(v1[2], v1[3]);
                    *(u32x4*)(QB + ((size_t)h * S + t) * 96 + d) = w; } }
    }
};
struct EpiK {
    bf16_t* KB; const float* rskv;
    DI void operator()(const AccT& acc, const Unit& u, int wr, int wc, int fr, int fq) const {
        const int row0 = u.pm * 256 + wr * 64 + fr, col0 = u.pn * 256 + wc * 32 + 8 * fq;
#pragma unroll
        for (int ai = 0; ai < 2; ++ai)
#pragma unroll
            for (int m = 0; m < 4; ++m) { const int t = row0 + ai * 128 + m * 16; const float s = rskv[t];
#pragma unroll
                for (int bj = 0; bj < 2; ++bj) { const int c = col0 + bj * 128, h = c >> 6, d = c & 63;
                    const f32x4 v0 = acc[ai][bj][m][0] * s, v1 = acc[ai][bj][m][1] * s;
                    u32x4 w; w.x = pk2(v0[0], v0[1]); w.y = pk2(v0[2], v0[3]); w.z = pk2(v1[0], v1[1]); w.w = pk2(v1[2], v1[3]);
                    *(u32x4*)(KB + ((size_t)h * S + t) * 96 + d) = w; } }
    }
};
template <bool RESBF> struct EpiRes {
    const float* res; bf16_t* XB; u64* rowss; int dry;
    DI void operator()(const AccT& acc, const Unit& u, int wr, int wc, int fr, int fq) const {
        const int row0 = u.pm * 256 + wr * 64 + fr, col0 = u.pn * 256 + wc * 32 + 8 * fq;
#pragma unroll
        for (int ai = 0; ai < 2; ++ai)
#pragma unroll
            for (int m = 0; m < 4; ++m) { const int t = row0 + ai * 128 + m * 16; float ss = 0.f;
#pragma unroll
                for (int bj = 0; bj < 2; ++bj) { const size_t o = (size_t)t * 1024 + col0 + bj * 128;
                    f32x4 r0, r1;
                    if (RESBF) { const u32x4 rb = *(const u32x4*)(XB + o); r0 = (f32x4){bflo(rb.x), bfhi(rb.x), bflo(rb.y), bfhi(rb.y)}; r1 = (f32x4){bflo(rb.z), bfhi(rb.z), bflo(rb.w), bfhi(rb.w)}; }
                    else { r0 = __builtin_nontemporal_load((const f32x4*)(res + o)); r1 = __builtin_nontemporal_load((const f32x4*)(res + o + 4)); }
                    const f32x4 v0 = acc[ai][bj][m][0] + r0, v1 = acc[ai][bj][m][1] + r1;
                    u32x4 w; w.x = pk2(v0[0], v0[1]); w.y = pk2(v0[2], v0[3]); w.z = pk2(v1[0], v1[1]); w.w = pk2(v1[2], v1[3]);
                    if (!dry) *(u32x4*)(XB + o) = w;
                    ss += v0[0] * v0[0] + v0[1] * v0[1] + v0[2] * v0[2] + v0[3] * v0[3] + v1[0] * v1[0] + v1[1] * v1[1] + v1[2] * v1[2] + v1[3] * v1[3]; }
                ss += __shfl_xor(ss, 16); ss += __shfl_xor(ss, 32);
                if (fq == 0 && !dry) atomicAdd(rowss + t, ss_to_fix(ss)); }
    }
};
DI float dpp_prev1(float cur, float prevm) {
    const int o = __builtin_amdgcn_update_dpp(0, __builtin_bit_cast(int, prevm), 0x121, 0xf, 0xf, false);
    return __builtin_bit_cast(float, __builtin_amdgcn_update_dpp(o, __builtin_bit_cast(int, cur), 0x111, 0xf, 0xf, false));
}
DI float dpp_prev2(float cur, float prevm) {
    const int o = __builtin_amdgcn_update_dpp(0, __builtin_bit_cast(int, prevm), 0x122, 0xf, 0xf, false);
    return __builtin_bit_cast(float, __builtin_amdgcn_update_dpp(o, __builtin_bit_cast(int, cur), 0x112, 0xf, 0xf, false));
}
struct EpiUp {
    bf16_t* ACT; const u64* rowss; const float* cw; const float* cb; LAS unsigned char* plds;
    DI void operator()(const AccT& acc, const Unit& u, int wr, int wc, int fr, int fq) const {
        const int cl = u.pn * 128 + wc * 32 + 8 * fq;
        LAS float* P = (LAS float*)(plds + (wr * 4 + wc) * 1024);
        { const int lane = fq * 16 + fr, kind = lane >> 3, c4 = 4 * (lane & 7), k3 = kind & 3;
          const float* src = (k3 == 0 ? cb : cw + (k3 - 1) * 5632) + (kind >= 4 ? 2816 : 0) + u.pn * 128 + wc * 32 + c4;
          *(LAS f32x4*)(P + kind * 32 + c4) = *(const f32x4*)src; }
#pragma unroll
        for (int ai = 0; ai < 2; ++ai) {
            const int tok0 = u.pm * 248 + 62 * (2 * ai + wr) - 2 + fr;
            float rs[4];
#pragma unroll
            for (int m = 0; m < 4; ++m) { const int t = tok0 + 16 * m; const int tc = t < 0 ? 0 : (t >= S ? S - 1 : t); const float r = rs_from_ss(rowss[tc]); rs[m] = t < 0 ? 0.f : r; }
            const int row0 = fr < 2 ? (S + 236 + fr) : tok0;
#pragma unroll
            for (int n = 0; n < 2; ++n) {
                const int lc = 8 * fq + 4 * n;
                unsigned wpk[4][2];
#pragma unroll
                for (int jp = 0; jp < 2; ++jp) {
                    const f32x2 bg = *(const LAS f32x2*)(P + lc + 2 * jp), g0 = *(const LAS f32x2*)(P + 32 + lc + 2 * jp), g1 = *(const LAS f32x2*)(P + 64 + lc + 2 * jp), g2 = *(const LAS f32x2*)(P + 96 + lc + 2 * jp);
                    const f32x2 bv = *(const LAS f32x2*)(P + 128 + lc + 2 * jp), v0 = *(const LAS f32x2*)(P + 160 + lc + 2 * jp), v1 = *(const LAS f32x2*)(P + 192 + lc + 2 * jp), v2 = *(const LAS f32x2*)(P + 224 + lc + 2 * jp);
                    f32x2 G[4], V[4];
#pragma unroll
                    for (int m = 0; m < 4; ++m) { G[m] = (f32x2){acc[ai][0][m][n][2 * jp], acc[ai][0][m][n][2 * jp + 1]} * rs[m]; V[m] = (f32x2){acc[ai][1][m][n][2 * jp], acc[ai][1][m][n][2 * jp + 1]} * rs[m]; }
#pragma unroll
                    for (int m = 0; m < 4; ++m) {
                        const f32x2 zz = {0.f, 0.f}; const f32x2 Gp = m ? G[m - 1] : zz, Vp = m ? V[m - 1] : zz;
                        const f32x2 gp1 = {dpp_prev1(G[m].x, Gp.x), dpp_prev1(G[m].y, Gp.y)}, gp2 = {dpp_prev2(G[m].x, Gp.x), dpp_prev2(G[m].y, Gp.y)};
                        const f32x2 vp1 = {dpp_prev1(V[m].x, Vp.x), dpp_prev1(V[m].y, Vp.y)}, vp2 = {dpp_prev2(V[m].x, Vp.x), dpp_prev2(V[m].y, Vp.y)};
                        const f32x2 gc = bg + g0 * gp2 + g1 * gp1 + g2 * G[m];
                        const f32x2 vc = bv + v0 * vp2 + v1 * vp1 + v2 * V[m];
                        const f32x2 xe = gc * (-LOG2E);
                        f32x2 dn = {__builtin_amdgcn_exp2f(xe.x), __builtin_amdgcn_exp2f(xe.y)}; dn = dn + 1.0f;
                        const f32x2 rc = {__builtin_amdgcn_rcpf(dn.x), __builtin_amdgcn_rcpf(dn.y)};
                        const f32x2 rr = gc * rc * vc;
                        wpk[m][jp] = pk2(rr.x, rr.y); }
                }
#pragma unroll
                for (int m = 0; m < 4; ++m) { const int row = m ? tok0 + 16 * m : row0;
                    *(u32x2*)(ACT + (size_t)row * 2816 + cl + 4 * n) = (u32x2){wpk[m][0], wpk[m][1]}; }
                __builtin_amdgcn_sched_barrier(0);
            }
        }
    }
};

template <class F> DI void tr_items(const F& f, int Kdst, int Nrows, bf16_t* WT, LAS float* scr, int gw, int NGW, int lane, int& cum) {
    const int nblk = Nrows / 32, nitems = (Kdst / 64) * nblk;
    int first = (gw - cum) % NGW; if (first < 0) first += NGW; cum = (cum + nitems) % NGW;
    for (int item = first; item < nitems; item += NGW) {
        const int kb = item / nblk, nb = item % nblk, k0 = 64 * kb, n0 = 32 * nb;
        float tv[32];
#pragma unroll
        for (int i = 0; i < 32; ++i) tv[i] = f(k0 + 2 * i + (lane >> 5), n0 + (lane & 31));
#pragma unroll
        for (int i = 0; i < 32; ++i) scr[(2 * i + (lane >> 5)) * 33 + (lane & 31)] = tv[i];
        asm volatile("s_waitcnt lgkmcnt(0)" ::: "memory");
        const int c = lane & 7;
#pragma unroll
        for (int j = 0; j < 4; ++j) { const int n = (lane >> 3) + 8 * j; const LAS float* s = scr + (8 * c) * 33 + n;
            u32x4 o; o.x = pk2(s[0 * 33], s[1 * 33]); o.y = pk2(s[2 * 33], s[3 * 33]); o.z = pk2(s[4 * 33], s[5 * 33]); o.w = pk2(s[6 * 33], s[7 * 33]);
            *(u32x4*)(WT + (size_t)(n0 + n) * Kdst + k0 + 8 * c) = o; }
        asm volatile("s_waitcnt lgkmcnt(0)" ::: "memory");
    }
}
struct FW1 { const float* W; const float* g; DI float operator()(int k, int n) const { return n < 1440 ? __builtin_nontemporal_load(&W[(size_t)k * 1440 + n]) * g[k] : 0.f; } };
struct FWQ { const float* W; const float* g; DI float operator()(int k, int n) const { const int h = n / 96, d = n - h * 96; int c = d; if (d >= 64) { const int r = d - 64; c = 64 + (r >> 1) + 16 * (r & 1); } return __builtin_nontemporal_load(&W[(size_t)k * 768 + h * 96 + c]) * g[k]; } };
struct FWKV { const float* W; const float* g; int off; DI float operator()(int k, int n) const { return k < 128 ? __builtin_nontemporal_load(&W[(size_t)k * 1024 + (n >> 6) * 128 + off + (n & 63)]) * g[k] : 0.f; } };
struct FWRI { const float* Wa; const float* Wx; DI float operator()(int k, int n) const { const float* W = n < 512 ? Wa : Wx; const int ch = n & 511, g = ch >> 6, j = ch & 63; return (k >> 6) == g ? __builtin_nontemporal_load(&W[(size_t)k * 64 + j]) : 0.f; } };
struct FWP { const float* W; int N; DI float operator()(int k, int n) const { return __builtin_nontemporal_load(&W[(size_t)k * N + n]); } };
struct FWUP { const float* W; const float* g; DI float operator()(int k, int n) const { const int pn = n >> 8, r = n & 255; const int c = r < 128 ? 128 * pn + r : 2816 + 128 * pn + r - 128; return __builtin_nontemporal_load(&W[(size_t)k * 5632 + c]) * g[k]; } };
struct FWOIN { const float* W; const float* g; DI float operator()(int k, int n) const {
    int c; float s = 1.f; if (n < 512) { c = n; s = 0.08838834764831845f; } else if (n < 1536) c = 2048 + (n - 512); else if (n < 2048) c = 512 + (n - 1536); else c = 1024 + (n - 2048);
    return __builtin_nontemporal_load(&W[(size_t)k * 3080 + c]) * g[k] * s; } };

#ifndef PROPART
#define PROPART 7
#endif
DI void phase_prologue(int wv, const ArgP a, LAS unsigned char* lds, int parts) {
    unsigned char* ws = a.ws();
    const int tid = ltid(wv), wave = tid >> 6, lane = tid & 63;
    LAS float* scr = (LAS float*)(lds + wave * 8448);
    const int gw = blockIdx.x * 8 + wave, NGW = gridDim.x * 8; int cum = 0;
    if (parts & 1) {
    { FW1 f{a.in(3), a.in(2)}; tr_items(f, 1024, 1536, (bf16_t*)(ws + O_W1T), scr, gw, NGW, lane, cum); }
    { FWQ f{a.in(12), a.in(11)}; tr_items(f, 256, 768, (bf16_t*)(ws + O_WQT), scr, gw, NGW, lane, cum); }
    { FWKV f{a.in(14), a.in(13), 0}; tr_items(f, 256, 512, (bf16_t*)(ws + O_WKT), scr, gw, NGW, lane, cum); }
    { FWKV f{a.in(14), a.in(13), 64}; tr_items(f, 256, 512, (bf16_t*)(ws + O_WVT), scr, gw, NGW, lane, cum); }
    { FWRI f{a.in(6), a.in(8)}; tr_items(f, 512, 1024, (bf16_t*)(ws + O_WRIT), scr, gw, NGW, lane, cum); }
    { FWP f{a.in(15), 1024}; tr_items(f, 1024, 1024, (bf16_t*)(ws + O_WO1T), scr, gw, NGW, lane, cum); }
    for (int l = 0; l < 2; ++l) {
        { FWUP f{a.in(23) + (size_t)l * 1024 * 5632, a.in(22) + l * 1024}; tr_items(f, 1024, 5632, (bf16_t*)(ws + (l ? O_WUPT1 : O_WUPT0)), scr, gw, NGW, lane, cum); }
        { FWP f{a.in(26) + (size_t)l * 2816 * 1024, 1024}; tr_items(f, 2816, 1024, (bf16_t*)(ws + (l ? O_WDNT1 : O_WDNT0)), scr, gw, NGW, lane, cum); }
    }
    { FWOIN f{a.in(17), a.in(16)}; tr_items(f, 1024, 3072, (bf16_t*)(ws + O_WOINT), scr, gw, NGW, lane, cum); }
    { FWP f{a.in(21), 1024}; tr_items(f, 1024, 1024, (bf16_t*)(ws + O_WO2T), scr, gw, NGW, lane, cum); }
    }
    if (parts & 2) {
    const float* x = a.in(0); bf16_t* XB = (bf16_t*)(ws + O_XB) + 2 * 1024; u64* rowss = (u64*)(ws + O_ROWSS);
#pragma unroll 4
    for (int t = gw; t < S; t += NGW) {
        float ss = 0.f;
#pragma unroll
        for (int j = 0; j < 4; ++j) { const f32x4 v = __builtin_nontemporal_load((const f32x4*)(x + (size_t)t * 1024 + j * 256 + lane * 4));
            ss += v[0] * v[0] + v[1] * v[1] + v[2] * v[2] + v[3] * v[3];
            u32x2 w; w.x = pk2(v[0], v[1]); w.y = pk2(v[2], v[3]); *(u32x2*)(XB + (size_t)t * 1024 + j * 256 + lane * 4) = w; }
        ss = wave_sum(ss);
        if (lane == 0) rowss[t] = ss_to_fix(ss);
        if (lane >= 1 && lane < 5) rowss[(size_t)lane * S + t] = 0ull;
    }
    }
    if (parts & 4) {
    const int* pos = (const int*)a.in(1); float* cst = (float*)(ws + O_CSTAB);
    for (int e = blockIdx.x * 512 + tid; e < S * 16; e += gridDim.x * 512) { const int t = e >> 4, i = e & 15;
        const float invf = __builtin_amdgcn_exp2f(-(float)i * (13.287712379549449f / 16.f)); const float ang = (float)pos[t] * invf;
        const float k = rintf(ang * 0.15915494309189535f);
        float r = fmaf(-k, 6.28318548202514648f, ang); r = fmaf(-k, -1.7484555e-7f, r);
        const float rr = r * 0.15915494309189535f;
        cst[2 * e] = __builtin_amdgcn_cosf(rr); cst[2 * e + 1] = __builtin_amdgcn_sinf(rr); }
    }
}

DI void phase_l0_prep(int wv, const ArgP a) {
    unsigned char* ws = a.ws();
    const bf16_t* Z = (const bf16_t*)(ws + O_Z); bf16_t* XC = (bf16_t*)(ws + O_XC); bf16_t* KB = (bf16_t*)(ws + O_KB);
    float* rsq = (float*)(ws + O_RSQ); float* rskv = (float*)(ws + O_RSKV); const float* cst = (const float*)(ws + O_CSTAB);
    const float* cw = a.in(4); const float* cb = a.in(5);
    const int tid = ltid(wv), wave = tid >> 6, lane = tid & 63;
#pragma unroll 2
    for (int e = blockIdx.x * 512 + tid; e < S * 64; e += gridDim.x * 512) { const int t = e >> 6, c0 = (e & 63) * 8;
        float acc[8];
#pragma unroll
        for (int j = 0; j < 8; ++j) acc[j] = cb[c0 + j];
#pragma unroll
        for (int k = 0; k < 4; ++k) { const int tt = t - 3 + k; if (tt < 0) continue;
            const u32x4 v = *(const u32x4*)(Z + (size_t)tt * 1536 + c0);
            const f32x4 w0 = *(const f32x4*)(cw + k * 512 + c0), w1 = *(const f32x4*)(cw + k * 512 + c0 + 4);
            acc[0] += w0[0] * bflo(v.x); acc[1] += w0[1] * bfhi(v.x); acc[2] += w0[2] * bflo(v.y); acc[3] += w0[3] * bfhi(v.y);
            acc[4] += w1[0] * bflo(v.z); acc[5] += w1[1] * bfhi(v.z); acc[6] += w1[2] * bflo(v.w); acc[7] += w1[3] * bfhi(v.w); }
        u32x4 o; o.x = pk2(acc[0], acc[1]); o.y = pk2(acc[2], acc[3]); o.z = pk2(acc[4], acc[5]); o.w = pk2(acc[6], acc[7]);
        *(u32x4*)(XC + (size_t)t * 512 + c0) = o; }
#pragma unroll 4
    for (int t = blockIdx.x * 8 + wave; t < S; t += gridDim.x * 8) {
        const bf16_t* zr = Z + (size_t)t * 1536;
        float sq = 0.f, skv = 0.f;
        { const u32x2 v = *(const u32x2*)(zr + 1024 + lane * 4); const float p0 = bflo(v.x), p1 = bfhi(v.x), p2 = bflo(v.y), p3 = bfhi(v.y); sq = p0 * p0 + p1 * p1 + p2 * p2 + p3 * p3; }
        { const unsigned v = *(const unsigned*)(zr + 1280 + lane * 2); const float p0 = bflo(v), p1 = bfhi(v); skv = p0 * p0 + p1 * p1; }
        sq = wave_sum(sq); skv = wave_sum(skv);
        if (lane == 0) { rsq[t] = rsqrtf(sq * (1.f / 256.f) + EPS); rskv[t] = rsqrtf(skv * (1.f / 128.f) + EPS); }
        if (lane < 16) { const float x1 = bf2f(zr[1408 + lane]), x2 = bf2f(zr[1424 + lane]); const float c = cst[(size_t)t * 32 + 2 * lane], s = cst[(size_t)t * 32 + 2 * lane + 1];
            const unsigned w = pk2(x1 * c - x2 * s, x2 * c + x1 * s);
#pragma unroll
            for (int h = 0; h < 8; ++h) *(unsigned*)(KB + ((size_t)h * S + t) * 96 + 64 + 2 * lane) = w; }
    }
}

DI void lru_coeff(float rpre, float ipre, float xc, float sp8, float& av, float& uv) {
    const float r = sigmoidf_(rpre), ig = sigmoidf_(ipre);
    const float la = -sp8 * r;
    av = fexp(la);
    uv = __builtin_amdgcn_sqrtf(fmaxf(1.f - av * av, 0.f)) * (ig * xc);
}
DI void phase_lru_s1(int wv, const ArgP a) {
    unsigned char* ws = a.ws(); const int ch = ltid(wv);
    const bf16_t* RI = (const bf16_t*)(ws + O_RI); const bf16_t* XC = (const bf16_t*)(ws + O_XC);
    float* CHA = (float*)(ws + O_CHA); float* CHH = (float*)(ws + O_CHH);
    const float ba = a.in(7)[ch], bx = a.in(9)[ch]; const float lam = a.in(10)[ch];
    const float sp8 = 8.f * log1pf(expf(-lam));
    for (int c = blockIdx.x; c < 256; c += gridDim.x) {
        float A = 1.f, H = 0.f;
#pragma unroll 8
        for (int i = 0; i < 64; ++i) { const size_t t = (size_t)c * 64 + i;
            float av, uv; lru_coeff(bf2f(RI[t * 1024 + ch]) + ba, bf2f(RI[t * 1024 + 512 + ch]) + bx, bf2f(XC[t * 512 + ch]), sp8, av, uv);
            A *= av; H = av * H + uv; }
        CHA[c * 512 + ch] = A; CHH[c * 512 + ch] = H;
    }
}
DI void phase_lru_s3(int wv, const ArgP a) {
    unsigned char* ws = a.ws(); const int ch = ltid(wv);
    const bf16_t* RI = (const bf16_t*)(ws + O_RI); const bf16_t* XC = (const bf16_t*)(ws + O_XC); const bf16_t* Z = (const bf16_t*)(ws + O_Z);
    const float* CHA = (const float*)(ws + O_CHA); const float* CHH = (const float*)(ws + O_CHH); bf16_t* MIX = (bf16_t*)(ws + O_MIX);
    const float ba = a.in(7)[ch], bx = a.in(9)[ch]; const float lam = a.in(10)[ch];
    const float sp8 = 8.f * log1pf(expf(-lam));
    for (int c = blockIdx.x; c < 256; c += gridDim.x) {
        float H = 0.f;
        { int cc = 0;
          for (; cc + 28 <= c; cc += 28) { float aa[28], hh[28];
#pragma unroll
              for (int k = 0; k < 28; ++k) { aa[k] = CHA[(cc + k) * 512 + ch]; hh[k] = CHH[(cc + k) * 512 + ch]; }
#pragma unroll
              for (int k = 0; k < 28; ++k) H = aa[k] * H + hh[k]; }
          for (; cc < c; ++cc) H = CHA[cc * 512 + ch] * H + CHH[cc * 512 + ch]; }
#pragma unroll 4
        for (int i = 0; i < 64; ++i) { const size_t t = (size_t)c * 64 + i;
            float av, uv; lru_coeff(bf2f(RI[t * 1024 + ch]) + ba, bf2f(RI[t * 1024 + 512 + ch]) + bx, bf2f(XC[t * 512 + ch]), sp8, av, uv);
            H = av * H + uv;
            const float g = bf2f(Z[t * 1536 + 512 + ch]);
            const float y = 0.7978845608028654f * (g + 0.044715f * g * g * g);
            const float th = 1.f - 2.f * __builtin_amdgcn_rcpf(1.f + fexp(2.f * y));
            MIX[t * 1024 + ch] = f2bf(H * 0.5f * g * (1.f + th)); }
    }
}

constexpr int AT_KROW = 208, AT_VROW = 136, AT_KT = 64 * AT_KROW, AT_VT = 64 * AT_VROW;
DI float rowmax32(const f32x16& p0, const f32x16& p1) {
    float a = fmaxf(fmaxf(p0[0], p0[1]), p1[0]), b = fmaxf(fmaxf(p0[2], p0[3]), p1[1]); a = fmaxf(fmaxf(a, p1[2]), p1[3]);
#pragma unroll
    for (int r = 4; r < 16; r += 4) { a = fmaxf(fmaxf(a, p0[r]), p0[r + 1]); b = fmaxf(fmaxf(b, p0[r + 2]), p0[r + 3]); a = fmaxf(fmaxf(a, p1[r]), p1[r + 1]); b = fmaxf(fmaxf(b, p1[r + 2]), p1[r + 3]); }
    const float m = fmaxf(a, b);
    const auto rr = __builtin_amdgcn_permlane32_swap(__float_as_uint(m), __float_as_uint(m), false, false);
    return fmaxf(__uint_as_float(rr[0]), __uint_as_float(rr[1]));
}
DI void attn_unit(int wv, int h, int qb, const bf16_t* QB, const bf16_t* KB, const bf16_t* VT, bf16_t* MIX, LAS unsigned char* lds) {
    const int tid = ltid(wv), lane = tid & 63, r32 = lane & 31, hi = lane >> 5; const int wid = __builtin_amdgcn_readfirstlane(tid >> 6);
    const int qg = qb * 256 + wid * 32 + r32;
    const bf16_t* Kh = KB + (size_t)h * S * 96; const bf16_t* Vh = VT + (size_t)h * 64 * S;
    bf16x8 qf[6];
    { const bf16_t* qp = QB + ((size_t)h * S + qg) * 96 + 8 * hi;
#pragma unroll
      for (int s = 0; s < 6; ++s) qf[s] = *(const bf16x8*)(qp + 16 * s); }
    f32x16 o0 = {}, o1 = {}, negm = {};
    float mref = 0.f, lrun = 0.f;
    const int NT = 4 * qb + 4, wlim = 4 * qb + (wid >> 1);
    const int kc0 = tid, kkey0 = kc0 / 12, kpart0 = kc0 % 12;
    const int kc1 = tid + 512, kkey1 = kc1 / 12, kpart1 = kc1 % 12;
    const int vdv = tid >> 3, vpart = tid & 7;
    u32x4 rk0, rk1 = {}, rv;
#define AT_LOADK(t_) do { const size_t kb_ = (size_t)(t_) * 64; rk0 = *(const u32x4*)(Kh + (kb_ + kkey0) * 96 + kpart0 * 8); if (tid < 256) rk1 = *(const u32x4*)(Kh + (kb_ + kkey1) * 96 + kpart1 * 8); } while (0)
#define AT_LOADV(t_) do { rv = *(const u32x4*)(Vh + (size_t)vdv * S + (size_t)(t_) * 64 + vpart * 8); } while (0)
#define AT_WRITEK(t_) do { LAS unsigned char* Ks_ = lds + ((t_) & 1) * AT_KT; *(LAS u32x4*)(Ks_ + kkey0 * AT_KROW + kpart0 * 16) = rk0; if (tid < 256) *(LAS u32x4*)(Ks_ + kkey1 * AT_KROW + kpart1 * 16) = rk1; } while (0)
#define AT_WRITEV(t_) do { LAS unsigned char* Vs_ = lds + 2 * AT_KT + ((t_) & 1) * AT_VT; *(LAS u32x2*)(Vs_ + vdv * AT_VROW + vpart * 16) = (u32x2){rv.x, rv.y}; *(LAS u32x2*)(Vs_ + vdv * AT_VROW + vpart * 16 + 8) = (u32x2){rv.z, rv.w}; } while (0)
#define AT_QK(P0, P1, t_) do { const LAS unsigned char* Ks_ = lds + ((t_) & 1) * AT_KT + r32 * AT_KROW + 16 * hi; f32x16 c0_ = negm, c1_ = negm; \
        _Pragma("unroll") for (int s = 0; s < 6; ++s) { const bf16x8 k0_ = *(const LAS bf16x8*)(Ks_ + 32 * s), k1_ = *(const LAS bf16x8*)(Ks_ + 32 * AT_KROW + 32 * s); \
            c0_ = __builtin_amdgcn_mfma_f32_32x32x16_bf16(k0_, qf[s], c0_, 0, 0, 0); c1_ = __builtin_amdgcn_mfma_f32_32x32x16_bf16(k1_, qf[s], c1_, 0, 0, 0); } \
        P0 = c0_; P1 = c1_; } while (0)
#define AT_SM1(P0, P1, MOFF, t_, MASK) do { \
        if (MASK && (t_) == wlim) { const int kbase_ = (t_) * 64 + 4 * hi; \
            _Pragma("unroll") for (int r = 0; r < 16; ++r) { const int kv_ = kbase_ + (r & 3) + 8 * (r >> 2); if (kv_ > qg) P0[r] = -1e30f; if (kv_ + 32 > qg) P1[r] = -1e30f; } } \
        const float d_ = mref - MOFF;                         \
        const float mx_ = rowmax32(P0, P1) - d_;              \
        if ((t_) == 0 || __any(mx_ > 8.f || d_ != 0.f)) { const float dl_ = ((t_) == 0) ? mx_ : fmaxf(mx_, 0.f); mref += dl_; \
            const float sh_ = d_ + dl_; \
            _Pragma("unroll") for (int r = 0; r < 16; ++r) { P0[r] -= sh_; P1[r] -= sh_; } \
            const float al_ = ((t_) == 0) ? 1.f : __builtin_amdgcn_exp2f(-dl_); lrun *= al_;     \
            _Pragma("unroll") for (int r = 0; r < 16; ++r) { o0[r] *= al_; o1[r] *= al_; negm[r] = -mref; } asm volatile("" : "+v"(negm)); } \
    } while (0)
#define AT_SM2(P0, P1, t_) do { \
        float ps_ = 0.f; \
        _Pragma("unroll") for (int r = 0; r < 16; ++r) { P0[r] = __builtin_amdgcn_exp2f(P0[r]); P1[r] = __builtin_amdgcn_exp2f(P1[r]); ps_ += P0[r] + P1[r]; } \
        lrun += ps_; \
        const LAS unsigned char* Vs_ = lds + 2 * AT_KT + ((t_) & 1) * AT_VT + r32 * AT_VROW + 8 * hi; \
        _Pragma("unroll") for (int ks = 0; ks < 4; ++ks) { u32x4 w_; \
            if (ks < 2) { w_.x = pk2(P0[8 * ks], P0[8 * ks + 1]); w_.y = pk2(P0[8 * ks + 2], P0[8 * ks + 3]); w_.z = pk2(P0[8 * ks + 4], P0[8 * ks + 5]); w_.w = pk2(P0[8 * ks + 6], P0[8 * ks + 7]); } \
            else { w_.x = pk2(P1[8 * ks - 16], P1[8 * ks - 15]); w_.y = pk2(P1[8 * ks - 14], P1[8 * ks - 13]); w_.z = pk2(P1[8 * ks - 12], P1[8 * ks - 11]); w_.w = pk2(P1[8 * ks - 10], P1[8 * ks - 9]); } \
            const bf16x8 pa_ = __builtin_bit_cast(bf16x8, w_); \
            const u32x2 a0_ = *(const LAS u32x2*)(Vs_ + 32 * ks), a1_ = *(const LAS u32x2*)(Vs_ + 32 * ks + 16); \
            const u32x2 b0_ = *(const LAS u32x2*)(Vs_ + 32 * AT_VROW + 32 * ks), b1_ = *(const LAS u32x2*)(Vs_ + 32 * AT_VROW + 32 * ks + 16); \
            o0 = __builtin_amdgcn_mfma_f32_32x32x16_bf16(__builtin_bit_cast(bf16x8, (u32x4){a0_.x, a0_.y, a1_.x, a1_.y}), pa_, o0, 0, 0, 0); \
            o1 = __builtin_amdgcn_mfma_f32_32x32x16_bf16(__builtin_bit_cast(bf16x8, (u32x4){b0_.x, b0_.y, b1_.x, b1_.y}), pa_, o1, 0, 0, 0); } \
    } while (0)
#define AT_STEPM(C0, C1, MC, N0, N1, MN, t_) do { \
        AT_WRITEK((t_) + 1); AT_WRITEV(t_); \
        __syncthreads(); \
        AT_LOADK((t_) + 2); AT_LOADV((t_) + 1); \
        AT_SM1(C0, C1, MC, t_, 0); MN = mref; AT_QK(N0, N1, (t_) + 1); AT_SM2(C0, C1, t_); \
    } while (0)
#define AT_STEPB(C0, C1, MC, N0, N1, MN, t_) do { \
        if ((t_) + 1 < NT) AT_WRITEK((t_) + 1); AT_WRITEV(t_); \
        __syncthreads(); \
        if ((t_) + 2 < NT) AT_LOADK((t_) + 2); if ((t_) + 1 < NT) AT_LOADV((t_) + 1); \
        if ((t_) + 1 <= wlim) { MN = mref; AT_QK(N0, N1, (t_) + 1); } \
        if ((t_) <= wlim) { AT_SM1(C0, C1, MC, t_, 1); AT_SM2(C0, C1, t_); } \
    } while (0)
    f32x16 pA0, pA1, pB0 = {}, pB1 = {}; float mA = 0.f, mB = 0.f;
    AT_LOADK(0); AT_WRITEK(0);
    __syncthreads();
    AT_LOADK(1); AT_LOADV(0);
    AT_QK(pA0, pA1, 0);
    int t = 0;
    for (; t < 4 * qb; t += 2) {
        AT_STEPM(pA0, pA1, mA, pB0, pB1, mB, t);
        AT_STEPM(pB0, pB1, mB, pA0, pA1, mA, t + 1);
    }
    for (; t < NT; t += 2) {
        AT_STEPB(pA0, pA1, mA, pB0, pB1, mB, t);
        AT_STEPB(pB0, pB1, mB, pA0, pA1, mA, t + 1);
    }
#undef AT_STEPM
#undef AT_STEPB
#undef AT_LOADK
#undef AT_LOADV
#undef AT_WRITEK
#undef AT_WRITEV
#undef AT_QK
#undef AT_SM1
#undef AT_SM2
    lrun += __shfl_xor(lrun, 32);
    const float inv = 1.f / lrun;
    bf16_t* op = MIX + (size_t)qg * 1024 + 512 + h * 64;
#pragma unroll
    for (int g = 0; g < 4; ++g) { const int dv = 8 * g + 4 * hi;
        u32x2 w; w.x = pk2(o0[4 * g] * inv, o0[4 * g + 1] * inv); w.y = pk2(o0[4 * g + 2] * inv, o0[4 * g + 3] * inv); *(u32x2*)(op + dv) = w;
        u32x2 w2; w2.x = pk2(o1[4 * g] * inv, o1[4 * g + 1] * inv); w2.y = pk2(o1[4 * g + 2] * inv, o1[4 * g + 3] * inv); *(u32x2*)(op + 32 + dv) = w2; }
    __syncthreads();
}
DI void phase_attn(int wv, const ArgP a, LAS unsigned char* lds) {
    unsigned char* ws = a.ws();
    const bf16_t* QB = (const bf16_t*)(ws + O_QB); const bf16_t* KB = (const bf16_t*)(ws + O_KB); const bf16_t* VT = (const bf16_t*)(ws + O_VT); bf16_t* MIX = (bf16_t*)(ws + O_MIX);
    if (wv >= 4) __builtin_amdgcn_s_setprio(1);
    for (int b = blockIdx.x; b < 256; b += gridDim.x) {
        const int v = (b & 7) * 32 + (b >> 3), h = v >> 5, s = v & 31;
        attn_unit(wv, h, 63 - s, QB, KB, VT, MIX, lds);
        attn_unit(wv, h, s, QB, KB, VT, MIX, lds);
    }
    __builtin_amdgcn_s_setprio(0);
}

DI void phase_m_gates(int wv, const ArgP a, LAS unsigned char* lds) {
    unsigned char* ws = a.ws(); const int tid = ltid(wv), wave = tid >> 6, lane = tid & 63;
    const bf16_t* XBr = (const bf16_t*)(ws + O_XB) + 2 * 1024; const u64* rowss = (const u64*)(ws + O_ROWSS) + 2 * S;
    const float* Wg = a.in(17); const float* gn = a.in(16);
    LAS float* wgs = (LAS float*)lds;
    LAS float* pre = (LAS float*)(lds + 32768);
    float* GB = (float*)(ws + O_GB); float* GE = (float*)(ws + O_GE); float* GPM = (float*)(ws + O_GPM);
    float* BL = (float*)(ws + O_BL); float* ML = (float*)(ws + O_ML);
    for (int e = tid; e < 8192; e += 512) { const int k = e >> 3, j = e & 7; wgs[j * 1024 + k] = Wg[(size_t)k * 3080 + 3072 + j] * gn[k]; }
    __syncthreads();
    for (int c = blockIdx.x; c < 256; c += gridDim.x) {
#pragma unroll 4
        for (int i = 0; i < 8; ++i) { const int t = c * 64 + wave * 8 + i;
            float acc[8];
#pragma unroll
            for (int j = 0; j < 8; ++j) acc[j] = 0.f;
#pragma unroll
            for (int jj = 0; jj < 4; ++jj) { const int k0 = jj * 256 + lane * 4; const u32x2 hb = *(const u32x2*)(XBr + (size_t)t * 1024 + k0); const f32x4 hv = {bflo(hb.x), bfhi(hb.x), bflo(hb.y), bfhi(hb.y)};
#pragma unroll
                for (int j = 0; j < 8; ++j) { const f32x4 wj = *(const LAS f32x4*)(wgs + j * 1024 + k0); acc[j] += hv[0] * wj[0] + hv[1] * wj[1] + hv[2] * wj[2] + hv[3] * wj[3]; } }
            const float rs = rs_from_ss(rowss[t]);
            { const bool b5 = lane & 32, b4 = lane & 16, b3 = lane & 8;
#pragma unroll
              for (int j = 0; j < 4; ++j) { const float snd = b5 ? acc[j] : acc[j + 4], kp = b5 ? acc[j + 4] : acc[j]; acc[j] = kp + __shfl_xor(snd, 32); }
#pragma unroll
              for (int j = 0; j < 2; ++j) { const float snd = b4 ? acc[j] : acc[j + 2], kp = b4 ? acc[j + 2] : acc[j]; acc[j] = kp + __shfl_xor(snd, 16); }
              { const float snd = b3 ? acc[0] : acc[1], kp = b3 ? acc[1] : acc[0]; acc[0] = kp + __shfl_xor(snd, 8); }
              acc[0] += __shfl_xor(acc[0], 4); acc[0] += __shfl_xor(acc[0], 2); acc[0] += __shfl_xor(acc[0], 1);
              if ((lane & 7) == 0) pre[(wave * 8 + i) * 8 + (b5 ? 4 : 0) + (b4 ? 2 : 0) + (b3 ? 1 : 0)] = acc[0] * rs; }
        }
        __syncthreads();
        if (wave < 4) { const int h = wave; const float bi = a.in(18)[h], bfg = a.in(19)[h];
            const float ig = 15.f * tanhf((pre[lane * 8 + h] + bi) * (1.f / 15.f));
            const float fg = 15.f * tanhf((pre[lane * 8 + 4 + h] + bfg) * (1.f / 15.f));
            float b = -log1pf(expf(-fg));
#pragma unroll
            for (int o = 1; o < 64; o <<= 1) { const float v = __shfl_up(b, o); if (lane >= o) b += v; }
            const float e = ig - b; float pm = e;
#pragma unroll
            for (int o = 1; o < 64; o <<= 1) { const float v = __shfl_up(pm, o); if (lane >= o) pm = fmaxf(pm, v); }
            const size_t o_ = (size_t)h * S + c * 64 + lane; GB[o_] = b; GE[o_] = e; GPM[o_] = pm;
            if (lane == 63) { BL[c * 4 + h] = b; ML[c * 4 + h] = b + pm; } }
        __syncthreads();
    }
}
DI void phase_m_dc(int wv, const ArgP a) {
    unsigned char* ws = a.ws(); const int tid = ltid(wv), lane = tid & 63, r32 = lane & 31, hi = lane >> 5; const int w = __builtin_amdgcn_readfirstlane(tid >> 6);
    const float* __restrict__ BL = (const float*)(ws + O_BL); const float* __restrict__ ML = (const float*)(ws + O_ML); float* __restrict__ NST = (float*)(ws + O_NST);
    const float* __restrict__ GE = (const float*)(ws + O_GE); const bf16_t* __restrict__ KVT = (const bf16_t*)(ws + O_KVT); bf16_t* __restrict__ CST = (bf16_t*)(ws + O_CST);
#pragma unroll 2
    for (int u = blockIdx.x; u < 1024; u += gridDim.x) {
        const int c = u >> 2, h = u & 3; const size_t t0 = (size_t)c * 64;
        const float emax = ML[c * 4 + h] - BL[c * 4 + h];
        bf16x8 bfr[4];
        { const bf16_t* vp = KVT + (size_t)(512 + h * 256 + 32 * w + r32) * S + t0 + 8 * hi; const float* gp = GE + (size_t)h * S + t0 + 8 * hi;
#pragma unroll
          for (int ks = 0; ks < 4; ++ks) { const u32x4 v = *(const u32x4*)(vp + 16 * ks); const f32x4 e0 = *(const f32x4*)(gp + 16 * ks), e1 = *(const f32x4*)(gp + 16 * ks + 4);
              u32x4 o; o.x = pk2(bflo(v.x) * fexp(e0[0] - emax), bfhi(v.x) * fexp(e0[1] - emax)); o.y = pk2(bflo(v.y) * fexp(e0[2] - emax), bfhi(v.y) * fexp(e0[3] - emax));
              o.z = pk2(bflo(v.z) * fexp(e1[0] - emax), bfhi(v.z) * fexp(e1[1] - emax)); o.w = pk2(bflo(v.w) * fexp(e1[2] - emax), bfhi(v.w) * fexp(e1[3] - emax));
              bfr[ks] = __builtin_bit_cast(bf16x8, o); } }
        const bf16_t* kp = KVT + (size_t)(h * 128 + r32) * S + t0 + 8 * hi;
        bf16_t* op = CST + ((size_t)(c * 4 + h) * 256 + 32 * w + r32) * 128 + 4 * hi;
#pragma unroll
        for (int rb = 0; rb < 4; ++rb) { f32x16 acc = {};
#pragma unroll
            for (int ks = 0; ks < 4; ++ks) { const bf16x8 ka = *(const bf16x8*)(kp + (size_t)(32 * rb) * S + 16 * ks); acc = __builtin_amdgcn_mfma_f32_32x32x16_bf16(ka, bfr[ks], acc, 0, 0, 0); }
#pragma unroll
            for (int g = 0; g < 4; ++g) { u32x2 o; o.x = pk2(acc[4 * g], acc[4 * g + 1]); o.y = pk2(acc[4 * g + 2], acc[4 * g + 3]); *(u32x2*)(op + 32 * rb + 8 * g) = o; } }
        if (tid < 128) { const bf16_t* kr = KVT + (size_t)(h * 128 + tid) * S + t0; const float* gp = GE + (size_t)h * S + t0; float s = 0.f;
#pragma unroll
            for (int p = 0; p < 8; ++p) { const u32x4 v = *(const u32x4*)(kr + 8 * p); const f32x4 e0 = *(const f32x4*)(gp + 8 * p), e1 = *(const f32x4*)(gp + 8 * p + 4);
                s += bflo(v.x) * fexp(e0[0] - emax) + bfhi(v.x) * fexp(e0[1] - emax) + bflo(v.y) * fexp(e0[2] - emax) + bfhi(v.y) * fexp(e0[3] - emax)
                   + bflo(v.z) * fexp(e1[0] - emax) + bfhi(v.z) * fexp(e1[1] - emax) + bflo(v.w) * fexp(e1[2] - emax) + bfhi(v.w) * fexp(e1[3] - emax); }
            NST[(size_t)(c * 4 + h) * 128 + tid] = s; }
    }
}
DI void phase_m_comb(int wv, const ArgP a, LAS unsigned char* lds, int dry) {
    unsigned char* ws = a.ws(); const int tid = ltid(wv);
    const float* BL = (const float*)(ws + O_BL); const float* ML = (const float*)(ws + O_ML); float* MST = (float*)(ws + O_MST); float* NST = (float*)(ws + O_NST);
    bf16_t* CST = (bf16_t*)(ws + O_CST);
    LAS float* bls = (LAS float*)lds; LAS float* mls = bls + 1024; LAS float* ga = mls + 1024; LAS float* gb = ga + 1024;
    for (int e = tid; e < 1024; e += 512) { bls[e] = BL[e]; mls[e] = ML[e]; }
    __syncthreads();
    if (tid < 256) { const int h = tid >> 6, l = tid & 63;
        float a_ = 0.f, b_ = -1e30f;
#pragma unroll
        for (int k = 0; k < 4; ++k) { const float bl = bls[(4 * l + k) * 4 + h], ml = mls[(4 * l + k) * 4 + h]; a_ += bl; b_ = fmaxf(b_ + bl, ml); }
        float pa = a_, pb = b_;
#pragma unroll
        for (int o = 1; o < 64; o <<= 1) { const float qa = __shfl_up(pa, o), qb = __shfl_up(pb, o); if (l >= o) { pb = fmaxf(qb + pa, pb); pa = qa + pa; } }
        float ea = __shfl_up(pa, 1), eb_ = __shfl_up(pb, 1); if (l == 0) { ea = 0.f; eb_ = -1e30f; }
        float m = fmaxf(0.f + ea, eb_);
#pragma unroll
        for (int k = 0; k < 4; ++k) { const int c = 4 * l + k; const float bl = bls[c * 4 + h], ml = mls[c * 4 + h]; const float mn = fmaxf(bl + m, ml);
            ga[c * 4 + h] = fexp(bl + m - mn); gb[c * 4 + h] = fexp(ml - mn);
            if (blockIdx.x == 0 && !dry) MST[c * 4 + h] = m;
            m = mn; } }
    __syncthreads();
    for (int eb = blockIdx.x; eb < 129; eb += gridDim.x) {
        if (eb < 128) { const int h = eb >> 5; unsigned* p = (unsigned*)(CST + (size_t)h * 32768 + (size_t)(eb & 31) * 1024 + 2 * tid); float C0 = 0.f, C1 = 0.f;
            for (int c = 0; c < 256; c += 64) { unsigned d[64];
#pragma unroll
                for (int k = 0; k < 64; ++k) d[k] = p[(size_t)(c + k) * 65536];
#pragma unroll
                for (int k = 0; k < 64; ++k) { if (!dry) p[(size_t)(c + k) * 65536] = pk2(C0, C1); const float a_ = ga[(c + k) * 4 + h], b_ = gb[(c + k) * 4 + h]; C0 = a_ * C0 + b_ * bflo(d[k]); C1 = a_ * C1 + b_ * bfhi(d[k]); } }
        } else { const int h = tid >> 7; float* p = NST + tid; float C = 0.f;
            for (int c = 0; c < 256; c += 8) { float d[8];
#pragma unroll
                for (int k = 0; k < 8; ++k) d[k] = p[(size_t)(c + k) * 512];
#pragma unroll
                for (int k = 0; k < 8; ++k) { if (!dry) p[(size_t)(c + k) * 512] = C; C = ga[(c + k) * 4 + h] * C + gb[(c + k) * 4 + h] * d[k]; } } }
    }
    __syncthreads();
}
constexpr int MC_QROW = 272, MC_SROW = 144;
constexpr int MC_QS = 0, MC_KS = 64 * MC_QROW, MC_SC = 2 * 64 * MC_QROW, MC_F = MC_SC + 64 * MC_SROW;
DI void phase_m_out(int wv, const ArgP a, LAS unsigned char* lds, int dry) {
    unsigned char* ws = a.ws(); const int tid = ltid(wv), lane = tid & 63, r32 = lane & 31, hi = lane >> 5; const int w = __builtin_amdgcn_readfirstlane(tid >> 6);
    bf16_t* QOK = (bf16_t*)(ws + O_QOK); const bf16_t* KVT = (const bf16_t*)(ws + O_KVT); const bf16_t* CST = (const bf16_t*)(ws + O_CST);
    const float* GB = (const float*)(ws + O_GB); const float* GE = (const float*)(ws + O_GE); const float* GPM = (const float*)(ws + O_GPM);
    const float* MST = (const float*)(ws + O_MST); const float* NST = (const float*)(ws + O_NST); const float* ong = a.in(20);
    LAS unsigned char* Qs = lds + MC_QS; LAS unsigned char* Ks = lds + MC_KS; LAS unsigned char* Sc = lds + MC_SC;
    LAS float* F = (LAS float*)(lds + MC_F);
    LAS float* f_b = F, *f_e = F + 64, *f_m = F + 128, *f_g = F + 192, *f_qn = F + 256, *f_ps = F + 320  , *f_n = F + 576  , *f_part = F + 704  ;
    for (int u = blockIdx.x; u < 1024; u += gridDim.x) {
        const int c = u >> 2, h = u & 3; const size_t t0 = (size_t)c * 64;
        for (int e = tid; e < 1024; e += 512) { const int r = e >> 4, p = e & 15;
            *(LAS u32x4*)(Qs + r * MC_QROW + p * 16) = *(const u32x4*)(QOK + (t0 + r) * 2048 + h * 128 + p * 8);
            *(LAS u32x4*)(Ks + r * MC_QROW + p * 16) = *(const u32x4*)(QOK + (t0 + r) * 2048 + 1536 + h * 128 + p * 8); }
        if (tid < 64) { const float mstv = MST[c * 4 + h]; const float b = GB[(size_t)h * S + t0 + tid], e = GE[(size_t)h * S + t0 + tid], pm = GPM[(size_t)h * S + t0 + tid];
            const float m = b + fmaxf(mstv, pm); f_b[tid] = b; f_e[tid] = e; f_m[tid] = m; f_g[tid] = fexp(b + mstv - m); }
        if (tid >= 64 && tid < 192) f_n[tid - 64] = NST[(size_t)(c * 4 + h) * 128 + tid - 64];
        __syncthreads();
        if (w < 4) {
            const int sb = w & 1, tb = w >> 1; const int tl = 32 * tb + r32;
            f32x16 x = {};
#pragma unroll
            for (int ks = 0; ks < 8; ++ks) {
                const bf16x8 ka = *(const LAS bf16x8*)(Ks + (32 * sb + r32) * MC_QROW + (16 * ks + 8 * hi) * 2);
                const bf16x8 qb = *(const LAS bf16x8*)(Qs + tl * MC_QROW + (16 * ks + 8 * hi) * 2);
                x = __builtin_amdgcn_mfma_f32_32x32x16_bf16(ka, qb, x, 0, 0, 0); }
            const float bt = f_b[tl], mt = f_m[tl]; float ps = 0.f;
#pragma unroll
            for (int g = 0; g < 4; ++g) { float v[4];
#pragma unroll
                for (int j = 0; j < 4; ++j) { const int sl = 32 * sb + 8 * g + 4 * hi + j; const float wgt = (sl <= tl) ? fexp(bt + f_e[sl] - mt) : 0.f; v[j] = x[4 * g + j] * wgt; ps += v[j]; }
                u32x2 o; o.x = pk2(v[0], v[1]); o.y = pk2(v[2], v[3]);
                *(LAS u32x2*)(Sc + tl * MC_SROW + (32 * sb + 8 * g + 4 * hi) * 2) = o; }
            f_ps[(sb * 2 + hi) * 64 + tl] = ps;
        } else {
            const int tl = 16 * (w - 4) + (lane >> 2), qq = lane & 3; float s = 0.f;
#pragma unroll
            for (int p = 0; p < 4; ++p) { const u32x4 v = *(const LAS u32x4*)(Qs + tl * MC_QROW + (32 * qq + 8 * p) * 2); LAS float* np = f_n + 32 * qq + 8 * p;
                s += bflo(v.x) * np[0] + bfhi(v.x) * np[1] + bflo(v.y) * np[2] + bfhi(v.y) * np[3] + bflo(v.z) * np[4] + bfhi(v.z) * np[5] + bflo(v.w) * np[6] + bfhi(v.w) * np[7]; }
            s += __shfl_xor(s, 1); s += __shfl_xor(s, 2);
            if (qq == 0) f_qn[tl] = s;
        }
        __syncthreads();
        f32x16 acc0 = {}, acc1 = {};
        { const bf16_t* cp = CST + ((size_t)(c * 4 + h) * 256 + 32 * w + r32) * 128 + 8 * hi;
#pragma unroll
          for (int ks = 0; ks < 8; ++ks) { const bf16x8 ca = *(const bf16x8*)(cp + 16 * ks);
              const bf16x8 q0 = *(const LAS bf16x8*)(Qs + r32 * MC_QROW + (16 * ks + 8 * hi) * 2), q1 = *(const LAS bf16x8*)(Qs + (32 + r32) * MC_QROW + (16 * ks + 8 * hi) * 2);
              acc0 = __builtin_amdgcn_mfma_f32_32x32x16_bf16(ca, q0, acc0, 0, 0, 0); acc1 = __builtin_amdgcn_mfma_f32_32x32x16_bf16(ca, q1, acc1, 0, 0, 0); } }
        const float g0 = f_g[r32], g1 = f_g[32 + r32];
#pragma unroll
        for (int r = 0; r < 16; ++r) { acc0[r] *= g0; acc1[r] *= g1; }
        { const bf16_t* vp = KVT + (size_t)(512 + h * 256 + 32 * w + r32) * S + t0 + 8 * hi;
#pragma unroll
          for (int ks = 0; ks < 4; ++ks) { const bf16x8 va = *(const bf16x8*)(vp + 16 * ks);
              const bf16x8 s0 = *(const LAS bf16x8*)(Sc + r32 * MC_SROW + (16 * ks + 8 * hi) * 2), s1 = *(const LAS bf16x8*)(Sc + (32 + r32) * MC_SROW + (16 * ks + 8 * hi) * 2);
              acc0 = __builtin_amdgcn_mfma_f32_32x32x16_bf16(va, s0, acc0, 0, 0, 0); acc1 = __builtin_amdgcn_mfma_f32_32x32x16_bf16(va, s1, acc1, 0, 0, 0); } }
        float inv[2];
#pragma unroll
        for (int tb = 0; tb < 2; ++tb) { const int tl = 32 * tb + r32;
            const float den = f_g[tl] * f_qn[tl] + f_ps[tl] + f_ps[64 + tl] + f_ps[128 + tl] + f_ps[192 + tl];
            inv[tb] = 1.f / fmaxf(fabsf(den), fexp(-f_m[tl])); }
        float ss0 = 0.f, ss1 = 0.f;
#pragma unroll
        for (int r = 0; r < 16; ++r) { acc0[r] *= inv[0]; acc1[r] *= inv[1]; ss0 += acc0[r] * acc0[r]; ss1 += acc1[r] * acc1[r]; }
        ss0 += __shfl_xor(ss0, 32); ss1 += __shfl_xor(ss1, 32);
        if (hi == 0) { f_part[w * 64 + r32] = ss0; f_part[w * 64 + 32 + r32] = ss1; }
        __syncthreads();
        float rn[2];
#pragma unroll
        for (int tb = 0; tb < 2; ++tb) { float s = 0.f;
#pragma unroll
            for (int ww = 0; ww < 8; ++ww) s += f_part[ww * 64 + 32 * tb + r32];
            rn[tb] = rsqrtf(s * (1.f / 256.f) + EPS); }
#pragma unroll
        for (int tb = 0; tb < 2; ++tb) { bf16_t* op = QOK + (t0 + 32 * tb + r32) * 2048 + 512 + h * 256 + 32 * w;
#pragma unroll
            for (int g = 0; g < 4; ++g) { const int dv = 8 * g + 4 * hi; const u32x2 ov = *(const u32x2*)(op + dv);
                const f32x4 gg = *(const f32x4*)(ong + h * 256 + 32 * w + dv);
                const float og[4] = {bflo(ov.x), bfhi(ov.x), bflo(ov.y), bfhi(ov.y)}; float y[4];
#pragma unroll
                for (int j = 0; j < 4; ++j) { const float hv = (tb ? acc1[4 * g + j] : acc0[4 * g + j]) * rn[tb]; y[j] = hv * gg[j] * sigmoidf_(og[j]); }
                u32x2 o; o.x = pk2(y[0], y[1]); o.y = pk2(y[2], y[3]); if (!dry) *(u32x2*)(op + dv) = o; } }
        __syncthreads();
    }
}

DI void phase_final(int wv, const ArgP a) {
    float* out = a.out(); const u64* rowss = (const u64*)(a.ws() + O_ROWSS) + 4 * S; const float* g = a.in(27); const bf16_t* XBr = (const bf16_t*)(a.ws() + O_XB) + 2 * 1024;
    for (size_t e = (size_t)blockIdx.x * 512 + ltid(wv); e < (size_t)S * 128; e += (size_t)gridDim.x * 512) { const int t = (int)(e >> 7), c = (int)(e & 127) * 8;
        const float rs = rs_from_ss(rowss[t]); const u32x4 hb = __builtin_nontemporal_load((const u32x4*)(XBr + (size_t)t * 1024 + c)); const f32x4 g0 = *(const f32x4*)(g + c), g1 = *(const f32x4*)(g + c + 4);
        const f32x4 v0 = (f32x4){bflo(hb.x), bfhi(hb.x), bflo(hb.y), bfhi(hb.y)} * rs * g0, v1 = (f32x4){bflo(hb.z), bfhi(hb.z), bflo(hb.w), bfhi(hb.w)} * rs * g1;
        __builtin_nontemporal_store(v0, (f32x4*)(out + (size_t)t * 1024 + c)); __builtin_nontemporal_store(v1, (f32x4*)(out + (size_t)t * 1024 + c + 4)); }
}

#ifndef DIS
#define DIS 0u
#endif
#ifndef REP
#define REP 0u
#endif
#ifndef XSYNC
#define XSYNC 0
#endif

#define XB_TMO      128
#define XB_XCNT(j)  (256  + 64 * (j))
#define XB_XSUB(j)  (1280 + 64 * (j))
#define XB_XGEN(j)  (2304 + 64 * (j))
#define XB_TOP      3328
#define XB_TOPGEN   3392
#define XB_SPIN_CAP (1u << 18)
DI unsigned xb_ld(unsigned* p) { return __hip_atomic_load(p, __ATOMIC_RELAXED, __HIP_MEMORY_SCOPE_AGENT); }
DI unsigned xb_add(unsigned* p, unsigned v) { return __hip_atomic_fetch_add(p, v, __ATOMIC_RELAXED, __HIP_MEMORY_SCOPE_AGENT); }
DI unsigned xb_xcc_id() { return (unsigned)__builtin_amdgcn_s_getreg((3 << 11) | 20) & 0xFu; }
#define XB_SPIN(cond, bar) do { unsigned _sp = 0; while (cond) { __builtin_amdgcn_s_sleep(1); \
    if ((++_sp & 255u) == 0u) { if (xb_ld(&(bar)[XB_TMO])) break; if (_sp > XB_SPIN_CAP) { atomicAdd(&(bar)[XB_TMO], 1u); break; } } } } while (0)
DI void xcd_barrier_complete(unsigned* bar, unsigned x, unsigned& nloc, unsigned& nx) {
    const unsigned G = gridDim.x;
    unsigned sum, cnt, mine, sp = 0u;
    for (;;) {
        sum = 0u; cnt = 0u; mine = 0u;
#pragma unroll
        for (unsigned j = 0; j < 16; ++j) { const unsigned c = xb_ld(&bar[XB_XCNT(j)]); sum += c; cnt += (c > 0u) ? 1u : 0u; mine = (j == x) ? c : mine; }
        if (sum == G) break;
        __builtin_amdgcn_s_sleep(1);
        if ((++sp & 255u) == 0u) { if (xb_ld(&bar[XB_TMO])) break; if (sp > XB_SPIN_CAP) { atomicAdd(&bar[XB_TMO], 1u); break; } }
    }
    nloc = mine > 0u ? mine : 1u; nx = cnt > 0u ? cnt : 1u;
}
DI void xcd_barrier(int wv, unsigned* bar, volatile LAS unsigned* st) {
    asm volatile("s_waitcnt vmcnt(0)" ::: "memory");
    __syncthreads();
    if (ltid(wv) == 0) {
        const unsigned x = xb_xcc_id();
        __builtin_amdgcn_s_waitcnt(0);
        unsigned nloc = st[0], nx = st[1];
        if (nloc == 0u) { xcd_barrier_complete(bar, x, nloc, nx); st[0] = nloc; st[1] = nx; }
        const unsigned old = xb_add(&bar[XB_XSUB(x)], 1u);
        const unsigned gen = old / nloc;
        if (old + 1u == (gen + 1u) * nloc) {
            __builtin_amdgcn_fence(__ATOMIC_RELEASE, "agent");
            asm volatile("s_waitcnt vmcnt(0)" ::: "memory");
            const unsigned og = xb_add(&bar[XB_TOP], 1u);
            const unsigned tg = og / nx;
            if (og + 1u == (tg + 1u) * nx) xb_add(&bar[XB_TOPGEN], 1u);
            else XB_SPIN(xb_ld(&bar[XB_TOPGEN]) == tg, bar);
            __builtin_amdgcn_fence(__ATOMIC_ACQUIRE, "agent");
            xb_add(&bar[XB_XGEN(x)], 1u);
            asm volatile("s_waitcnt vmcnt(0)" ::: "memory");
        } else {
            XB_SPIN(xb_ld(&bar[XB_XGEN(x)]) == gen, bar);
            __builtin_amdgcn_fence(__ATOMIC_ACQUIRE, "agent");
            asm volatile("s_waitcnt vmcnt(0)" ::: "memory");
        }
    }
    __syncthreads();
}
DI ArgP getargs() { ArgP r; r.p = (const __attribute__((address_space(4))) Args*)__builtin_amdgcn_kernarg_segment_ptr(); asm volatile("" : "+s"(r.p)); return r; }
#define WSB (getargs().ws())
#define XBP ((bf16_t*)(getargs().ws() + O_XB) + 2 * 1024)
#define RSS ((u64*)(getargs().ws() + O_ROWSS))
#define HFP (getargs().out())
__global__ void __launch_bounds__(512, 2) fwd_kernel(Args a_unused) {
    extern __shared__ __attribute__((aligned(16))) unsigned char shm[];
    LAS unsigned char* lds = (LAS unsigned char*)shm;
    const int wv = __builtin_amdgcn_readfirstlane(threadIdx.x >> 6);
#define BARW ((unsigned*)(getargs().ws() + O_BAR))
#define BARST ((volatile LAS unsigned*)(lds + 139264))
#define GSYNC() xcd_barrier(wv, BARW, BARST)
    { unsigned* barw0 = BARW; if (threadIdx.x == 0) { BARST[0] = 0u; BARST[1] = 0u; (void)xb_add(&barw0[XB_XCNT(xb_xcc_id())], 1u); } }
    if (getargs().p->pad == 0x7fffffff) cg::this_grid().sync();

#if !(DIS & (1u << 0))
    for (int rep_ = 0; rep_ < ((REP >> 0) & 1u) + 1; ++rep_) { const int dry_ = rep_ < (int)((REP >> 0) & 1u); (void)dry_;
    phase_prologue(wv, getargs(), lds, dry_ ? PROPART : 7);
    }
#endif
    GSYNC();
#if !(DIS & (1u << 1))
    for (int rep_ = 0; rep_ < ((REP >> 1) & 1u) + 1; ++rep_) { const int dry_ = rep_ < (int)((REP >> 1) & 1u); (void)dry_;
    { EpiRowBf16<1> E{(bf16_t*)(WSB + O_Z), 1536, RSS};
      pg8::gemm_phase<false>(wv, lds, XBP, 1024, (const bf16_t*)(WSB + O_W1T), 1024, 1024, 64, 6, E); }
    }
#endif
    GSYNC();
#if !(DIS & (1u << 2))
    for (int rep_ = 0; rep_ < ((REP >> 2) & 1u) + 1; ++rep_) { const int dry_ = rep_ < (int)((REP >> 2) & 1u); (void)dry_;
    phase_l0_prep(wv, getargs());
    }
#endif
    GSYNC();
#if !(DIS & (1u << 3))
    for (int rep_ = 0; rep_ < ((REP >> 3) & 1u) + 1; ++rep_) { const int dry_ = rep_ < (int)((REP >> 3) & 1u); (void)dry_;
    { EpiRowBf16<0> E{(bf16_t*)(WSB + O_RI), 1024, nullptr};
      pg8::gemm_phase<false, EpiRowBf16<0>, true>(wv, lds, (const bf16_t*)(WSB + O_XC), 512, (const bf16_t*)(WSB + O_WRIT), 512, 256, 64, 4, E); }
    }
#endif
#if !(DIS & (1u << 4))
    for (int rep_ = 0; rep_ < ((REP >> 4) & 1u) + 1; ++rep_) { const int dry_ = rep_ < (int)((REP >> 4) & 1u); (void)dry_;
    { EpiQ E{(bf16_t*)(WSB + O_QB), (const float*)(WSB + O_RSQ), (const float*)(WSB + O_CSTAB)};
      pg8::gemm_phase<false>(wv, lds, (const bf16_t*)(WSB + O_Z) + 1024, 1536, (const bf16_t*)(WSB + O_WQT), 256, 256, 64, 3, E); }
    }
#endif
#if !(DIS & (1u << 5))
    for (int rep_ = 0; rep_ < ((REP >> 5) & 1u) + 1; ++rep_) { const int dry_ = rep_ < (int)((REP >> 5) & 1u); (void)dry_;
    { EpiK E{(bf16_t*)(WSB + O_KB), (const float*)(WSB + O_RSKV)};
      pg8::gemm_phase<false>(wv, lds, (const bf16_t*)(WSB + O_Z) + 1280, 1536, (const bf16_t*)(WSB + O_WKT), 256, 256, 64, 2, E, 192); }
    }
#endif
#if !(DIS & (1u << 6))
    for (int rep_ = 0; rep_ < ((REP >> 6) & 1u) + 1; ++rep_) { const int dry_ = rep_ < (int)((REP >> 6) & 1u); (void)dry_;
    { EpiColBf16<2> E{(bf16_t*)(WSB + O_VT), S, (const float*)(WSB + O_RSKV)};
      pg8::gemm_phase<false>(wv, lds, (const bf16_t*)(WSB + O_WVT), 256, (const bf16_t*)(WSB + O_Z) + 1280, 1536, 256, 2, 64, E, 64); }
    }
#endif
    GSYNC();
#if !(DIS & (1u << 7))
    for (int rep_ = 0; rep_ < ((REP >> 7) & 1u) + 1; ++rep_) { const int dry_ = rep_ < (int)((REP >> 7) & 1u); (void)dry_;
    phase_lru_s1(wv, getargs());
    }
#endif
    GSYNC();
#if !(DIS & (1u << 8))
    for (int rep_ = 0; rep_ < ((REP >> 8) & 1u) + 1; ++rep_) { const int dry_ = rep_ < (int)((REP >> 8) & 1u); (void)dry_;
    phase_lru_s3(wv, getargs());
    }
#endif
#if !(DIS & (1u << 9))
    for (int rep_ = 0; rep_ < ((REP >> 9) & 1u) + 1; ++rep_) { const int dry_ = rep_ < (int)((REP >> 9) & 1u); (void)dry_;
    phase_attn(wv, getargs(), lds);
    }
#endif
    GSYNC();
#if !(DIS & (1u << 10))
    for (int rep_ = 0; rep_ < ((REP >> 10) & 1u) + 1; ++rep_) { const int dry_ = rep_ < (int)((REP >> 10) & 1u); (void)dry_;
    { EpiRes<false> E{getargs().in(0), XBP, RSS + 1 * S, dry_};
      pg8::gemm_phase<false>(wv, lds, (const bf16_t*)(WSB + O_MIX), 1024, (const bf16_t*)(WSB + O_WO1T), 1024, 1024, 64, 4, E); }
    }
#endif
    GSYNC();
#if !(DIS & (1u << 11))
    for (int rep_ = 0; rep_ < ((REP >> 11) & 1u) + 1; ++rep_) { const int dry_ = rep_ < (int)((REP >> 11) & 1u); (void)dry_;
    { EpiUp E{(bf16_t*)(WSB + O_ACT), RSS + 1 * S, getargs().in(24), getargs().in(25), lds + 131072};
      pg8::gemm_phase<true>(wv, lds, XBP, 1024, (const bf16_t*)(WSB + O_WUPT0), 1024, 1024, 67, 22, E); }
    }
#endif
    GSYNC();
#if !(DIS & (1u << 12))
    for (int rep_ = 0; rep_ < ((REP >> 12) & 1u) + 1; ++rep_) { const int dry_ = rep_ < (int)((REP >> 12) & 1u); (void)dry_;
    { EpiRes<true> E{nullptr, XBP, RSS + 2 * S, dry_};
      pg8::gemm_phase<false>(wv, lds, (const bf16_t*)(WSB + O_ACT), 2816, (const bf16_t*)(WSB + O_WDNT0), 2816, 2816, 64, 4, E); }
    }
#endif
    GSYNC();
#if !(DIS & (1u << 13))
    for (int rep_ = 0; rep_ < ((REP >> 13) & 1u) + 1; ++rep_) { const int dry_ = rep_ < (int)((REP >> 13) & 1u); (void)dry_;
    { EpiRowBf16<1> E{(bf16_t*)(WSB + O_QOK), 2048, RSS + 2 * S};
      pg8::gemm_phase<false>(wv, lds, XBP, 1024, (const bf16_t*)(WSB + O_WOINT), 1024, 1024, 64, 8, E); }
    }
#endif
#if !(DIS & (1u << 14))
    for (int rep_ = 0; rep_ < ((REP >> 14) & 1u) + 1; ++rep_) { const int dry_ = rep_ < (int)((REP >> 14) & 1u); (void)dry_;
    { EpiColBf16<1> E{(bf16_t*)(WSB + O_KVT), S, RSS + 2 * S};
      pg8::gemm_phase<false>(wv, lds, (const bf16_t*)(WSB + O_WOINT) + (size_t)1536 * 1024, 1024, XBP, 1024, 1024, 6, 64, E); }
    }
#endif
#if !(DIS & (1u << 15))
    for (int rep_ = 0; rep_ < ((REP >> 15) & 1u) + 1; ++rep_) { const int dry_ = rep_ < (int)((REP >> 15) & 1u); (void)dry_;
    phase_m_gates(wv, getargs(), lds);
    }
#endif
    GSYNC();
#if !(DIS & (1u << 16))
    for (int rep_ = 0; rep_ < ((REP >> 16) & 1u) + 1; ++rep_) { const int dry_ = rep_ < (int)((REP >> 16) & 1u); (void)dry_;
    phase_m_dc(wv, getargs());
    }
#endif
    GSYNC();
#if !(DIS & (1u << 22))
    for (int rep_ = 0; rep_ < ((REP >> 22) & 1u) + 1; ++rep_) { const int dry_ = rep_ < (int)((REP >> 22) & 1u); (void)dry_;
    phase_m_comb(wv, getargs(), lds, dry_);
    }
#endif
    GSYNC();
#if !(DIS & (1u << 17))
    for (int rep_ = 0; rep_ < ((REP >> 17) & 1u) + 1; ++rep_) { const int dry_ = rep_ < (int)((REP >> 17) & 1u); (void)dry_;
    phase_m_out(wv, getargs(), lds, dry_);
    }
#endif
    GSYNC();
#if !(DIS & (1u << 18))
    for (int rep_ = 0; rep_ < ((REP >> 18) & 1u) + 1; ++rep_) { const int dry_ = rep_ < (int)((REP >> 18) & 1u); (void)dry_;
    { EpiRes<true> E{nullptr, XBP, RSS + 3 * S, dry_};
      pg8::gemm_phase<false>(wv, lds, (const bf16_t*)(WSB + O_QOK) + 512, 2048, (const bf16_t*)(WSB + O_WO2T), 1024, 1024, 64, 4, E); }
    }
#endif
    GSYNC();
#if !(DIS & (1u << 19))
    for (int rep_ = 0; rep_ < ((REP >> 19) & 1u) + 1; ++rep_) { const int dry_ = rep_ < (int)((REP >> 19) & 1u); (void)dry_;
    { EpiUp E{(bf16_t*)(WSB + O_ACT), RSS + 3 * S, getargs().in(24) + 3 * 5632, getargs().in(25) + 5632, lds + 131072};
      pg8::gemm_phase<true>(wv, lds, XBP, 1024, (const bf16_t*)(WSB + O_WUPT1), 1024, 1024, 67, 22, E); }
    }
#endif
    GSYNC();
#if !(DIS & (1u << 20))
    for (int rep_ = 0; rep_ < ((REP >> 20) & 1u) + 1; ++rep_) { const int dry_ = rep_ < (int)((REP >> 20) & 1u); (void)dry_;
    { EpiRes<true> E{nullptr, XBP, RSS + 4 * S, dry_};
      pg8::gemm_phase<false>(wv, lds, (const bf16_t*)(WSB + O_ACT), 2816, (const bf16_t*)(WSB + O_WDNT1), 2816, 2816, 64, 4, E); }
    }
#endif
    GSYNC();
#if !(DIS & (1u << 21))
    for (int rep_ = 0; rep_ < ((REP >> 21) & 1u) + 1; ++rep_) { const int dry_ = rep_ < (int)((REP >> 21) & 1u); (void)dry_;
    phase_final(wv, getargs());
    }
#endif
    for (int i = 0; i < XSYNC; ++i) GSYNC();
}

extern "C" void kernel_launch(void* const* d_in, const int* in_sizes, int n_in, void* d_out, int out_size, void* d_ws, size_t ws_size, hipStream_t stream) {
    static int grid = 0;
    if (grid == 0) {
        if (n_in != 28 || out_size != S * 1024 || ws_size < WS_NEED) { fprintf(stderr, "kernel_launch: unexpected shapes (n_in %d out %d ws %zu need %zu)\n", n_in, out_size, ws_size, (size_t)WS_NEED); grid = -1; return; }
        int dev = 0, cus = 0, per_cu = 0;
        (void)hipGetDevice(&dev);
        (void)hipDeviceGetAttribute(&cus, hipDeviceAttributeMultiprocessorCount, dev);
        if (hipFuncSetAttribute((const void*)fwd_kernel, hipFuncAttributeMaxDynamicSharedMemorySize, LDS_BYTES) != hipSuccess) { fprintf(stderr, "kernel_launch: hipFuncSetAttribute failed\n"); grid = -1; return; }
        if (hipOccupancyMaxActiveBlocksPerMultiprocessor(&per_cu, (const void*)fwd_kernel, 512, LDS_BYTES) != hipSuccess || per_cu < 1) { fprintf(stderr, "kernel_launch: occupancy query says %d\n", per_cu); per_cu = 1; }
        (void)hipGetLastError();
        grid = cus * 1;
        if (grid > 256) grid = 256;
    }
    if (grid < 0) return;
    Args a{};
    for (int i = 0; i < 28; ++i) a.in[i] = (const float*)d_in[i];
    a.out = (float*)d_out; a.ws = (unsigned char*)d_ws;
    if (hipMemsetAsync((char*)d_ws + O_BAR, 0, BAR_BYTES, stream) != hipSuccess) { fprintf(stderr, "kernel_launch: memset failed\n"); return; }
    void* args[] = {&a};
    hipError_t e = hipLaunchCooperativeKernel((void*)fwd_kernel, dim3(grid), dim3(512), args, LDS_BYTES, stream);
    if (e != hipSuccess) fprintf(stderr, "kernel_launch: cooperative launch failed: %s (grid %d)\n", hipGetErrorString(e), grid);
}
```

```cpp
#include <hip/hip_runtime.h>
#include <hip/hip_cooperative_groups.h>
#include <cstdio>
#include <cstdint>
namespace cg = cooperative_groups;

typedef unsigned short bf16_t;
typedef short bf16x8 __attribute__((ext_vector_type(8)));
typedef short s16x4 __attribute__((ext_vector_type(4)));
typedef float f32x2 __attribute__((ext_vector_type(2)));
typedef float f32x4 __attribute__((ext_vector_type(4)));
typedef float f32x16 __attribute__((ext_vector_type(16)));
typedef unsigned u32x2 __attribute__((ext_vector_type(2)));
typedef unsigned u32x4 __attribute__((ext_vector_type(4)));
typedef __bf16 bf16x2_t __attribute__((ext_vector_type(2)));
#define LAS __attribute__((address_space(3)))
#define DI __device__ __forceinline__

constexpr int S = 16384;
constexpr float EPS = 1e-6f;
constexpr float LOG2E = 1.4426950408889634f;

constexpr size_t SZ_WUPT = (size_t)5632 * 1024 * 2, SZ_WDNT = (size_t)1024 * 2816 * 2;
constexpr size_t O_WUPT1 = 0;
constexpr size_t O_WDNT1 = O_WUPT1 + SZ_WUPT;
constexpr size_t O_WOINT = O_WDNT1 + SZ_WDNT;
constexpr size_t O_WO2T = O_WOINT + (size_t)3072 * 1024 * 2;
constexpr size_t O_ROWSS = O_WO2T + (size_t)1024 * 1024 * 2;
constexpr size_t O_RSQ = O_ROWSS + (size_t)5 * S * 8;
constexpr size_t O_RSKV = O_RSQ + (size_t)S * 4;
constexpr size_t O_CSTAB = O_RSKV + (size_t)S * 4;
constexpr size_t O_CHA = O_CSTAB + (size_t)S * 32 * 4;
constexpr size_t O_CHH = O_CHA + (size_t)256 * 512 * 4;
constexpr size_t O_GB = O_CHH + (size_t)256 * 512 * 4;
constexpr size_t O_GE = O_GB + (size_t)4 * S * 4;
constexpr size_t O_GPM = O_GE + (size_t)4 * S * 4;
constexpr size_t O_BL = O_GPM + (size_t)4 * S * 4;
constexpr size_t O_ML = O_BL + 4096;
constexpr size_t O_MST = O_ML + 4096;
constexpr size_t O_NST = O_MST + 4096;
constexpr size_t O_BAR = O_NST + (size_t)256 * 4 * 128 * 4;
constexpr size_t BAR_BYTES = 16384;
constexpr size_t O_XB = O_BAR + BAR_BYTES;
constexpr size_t XB_ROWS = 16648;
constexpr size_t O_L0W = O_XB + XB_ROWS * 2048;
constexpr size_t O_W1T = O_L0W;
constexpr size_t O_WQT = O_W1T + (size_t)1536 * 1024 * 2;
constexpr size_t O_WKT = O_WQT + (size_t)768 * 256 * 2;
constexpr size_t O_WVT = O_WKT + (size_t)512 * 256 * 2;
constexpr size_t O_WRIT = O_WVT + (size_t)512 * 256 * 2;
constexpr size_t O_WO1T = O_WRIT + (size_t)1024 * 512 * 2;
constexpr size_t O_WUPT0 = O_WO1T + (size_t)1024 * 1024 * 2;
constexpr size_t O_WDNT0 = O_WUPT0 + SZ_WUPT;
constexpr size_t O_ARENA = O_WDNT0 + SZ_WDNT;
constexpr size_t O_Z = O_ARENA;
constexpr size_t O_XC = O_Z + (size_t)S * 1536 * 2;
constexpr size_t O_QB = O_XC + (size_t)S * 512 * 2;
constexpr size_t O_KB = O_QB + (size_t)8 * S * 96 * 2;
constexpr size_t O_VT = O_KB + (size_t)8 * S * 96 * 2;
constexpr size_t O_MIX = O_VT + (size_t)512 * S * 2;
constexpr size_t O_END0 = O_MIX + (size_t)S * 1024 * 2;
constexpr size_t O_ACT = O_ARENA;
constexpr size_t O_RI = O_XB;
constexpr size_t O_CST = O_L0W;
constexpr size_t O_QOK = O_CST + (size_t)256 * 4 * 256 * 128 * 2;
constexpr size_t O_KVT = O_QOK + (size_t)S * 2048 * 2;
constexpr size_t O_END1 = O_KVT + (size_t)1536 * S * 2;
constexpr size_t WS_NEED = (O_END0 > O_END1 ? O_END0 : O_END1);
static_assert(WS_NEED <= (size_t)268435456, "workspace");
static_assert(O_ACT + (size_t)(S + 240) * 2816 * 2 <= (size_t)268435456, "act");

constexpr int LDS_BYTES = 147456;

struct Args {
    const float* in[28];
    float* out;
    unsigned char* ws;
    int pad; int pad2;
};

struct ArgP { const __attribute__((address_space(4))) Args* p;
    DI const float* in(int i) const { return p->in[i]; } DI float* out() const { return p->out; } DI unsigned char* ws() const { return p->ws; } };
DI unsigned pk2(float lo, float hi) { f32x2 v = {lo, hi}; bf16x2_t b = __builtin_convertvector(v, bf16x2_t); return __builtin_bit_cast(unsigned, b); }
DI bf16_t f2bf(float f) { return (bf16_t)(pk2(f, 0.f) & 0xffffu); }
DI int ltid(int wv) { asm volatile("" : "+s"(wv)); int l = __builtin_amdgcn_mbcnt_hi(~0u, __builtin_amdgcn_mbcnt_lo(~0u, 0u)); asm volatile("" : "+v"(l)); return wv * 64 + l; }
DI int lbid() { int t = blockIdx.x; asm volatile("" : "+s"(t)); return t; }
DI float bf2f(bf16_t b) { return __uint_as_float(((unsigned)b) << 16); }
DI float bflo(unsigned u) { return __uint_as_float(u << 16); }
DI float bfhi(unsigned u) { return __uint_as_float(u & 0xffff0000u); }
DI float wave_sum(float v) {
#pragma unroll
    for (int o = 1; o < 64; o <<= 1) v += __shfl_xor(v, o);
    return v;
}
DI float fexp(float x) { return __builtin_amdgcn_exp2f(x * LOG2E); }
DI float sigmoidf_(float x) { return __builtin_amdgcn_rcpf(1.f + fexp(-x)); }
DI int crow(int r, int hi) { return (r & 3) + 8 * (r >> 2) + 4 * hi; }
typedef unsigned long long u64;
DI float rs_from_ss(u64 ssq) { return rsqrtf((float)ssq * (1.f / (1048576.f * 1024.f)) + EPS); }
DI u64 ss_to_fix(float ss) { return (u64)(ss * 1048576.f); }

namespace pg8 {
constexpr int BM = 256, BK = 64, HALF = 128, HTB = HALF * BK * 2, STAGE_BYTES = 8 * HTB, NXCD = 8, WGM = 8;
DI int lds_byte(int r, int c) { const int st = (r >> 4) * 2 + (c >> 5), rr = r & 15, cc = c & 31, ob = rr * 64 + cc * 2; return st * 1024 + (ob ^ (((ob >> 9) & 1) << 5)); }
DI void stage_rc(int b, int& R, int& C) { const int st = b / 1024, sb = b % 1024, swz = sb ^ (((sb >> 9) & 1) << 5); R = (st >> 1) * 16 + swz / 64; C = (st & 1) * 32 + (swz % 64) / 2; }
DI int perm32(int rho) { const int n = rho >> 4, i = rho & 15; return 8 * (i >> 2) + 4 * n + (i & 3); }
struct Unit { int pm, pn; };
struct StaticOrder {
    int nM, nN, nwg, G, c;
    DI void init(int nM_, int nN_, int G_, int c_) { nM = nM_; nN = nN_; nwg = nM * nN; G = G_; c = c_; }
    DI bool next(int i, Unit& u) const {
        const long L = (long)i * G + c; if (L >= nwg) return false;
        int wgid = (int)L; { const int q = nwg / NXCD, r = nwg % NXCD, xcd = wgid % NXCD, off = wgid / NXCD; wgid = (xcd < r ? xcd * (q + 1) : r * (q + 1) + (xcd - r) * q) + off; }
        const int nig = WGM * nN, gid = wgid / nig, fm = gid * WGM, gsz = (nM - fm) < WGM ? (nM - fm) : WGM;
        u.pm = fm + ((wgid % nig) % gsz); u.pn = (wgid % nig) / gsz; return true;
    }
};

template <bool AMAP, class Epi, bool KOFS = false>
DI void gemm_phase(int wv, LAS unsigned char* lds, const bf16_t* A, int lda, const bf16_t* Bt, int ldb, int K_, int nM, int nN, const Epi& E, int rot = 0) {
    int K = K_; asm volatile("" : "+s"(K));
    const int tid = ltid(wv), wid = __builtin_amdgcn_readfirstlane(tid >> 6), lane = tid & 63, wr = wid >> 2, wc = wid & 3, fr = lane & 15, fq = lane >> 4;
    const int nt = K / BK;
    StaticOrder SO; { int c_ = lbid() - rot; if (c_ < 0) c_ += (int)gridDim.x; SO.init(nM, nN, (int)gridDim.x, c_); }
    unsigned voffA[2], voffB[2];
#pragma unroll
    for (int i = 0; i < 2; ++i) { int R, C; stage_rc(tid * 16 + i * 8192, R, C); const int Rb = (R & ~31) + perm32(R & 31);
        const int Ra = AMAP ? (62 * (R >> 6) + (R & 63) - 2) : R;
        voffA[i] = (unsigned)((Ra + (AMAP ? 2 : 0)) * lda + C) * 2u; voffB[i] = (unsigned)(Rb * ldb + C) * 2u; }
    const size_t kstep = (size_t)(BK * 2);
    const size_t hstepA = (size_t)(AMAP ? 124 : 128) * lda * 2, hstepB = (size_t)HALF * ldb * 2;
    const size_t tstepA = 2 * hstepA, tstepB = 2 * hstepB;
    const unsigned ldsw = (unsigned)wid * 1024u;
    const int aoff = lds_byte(wr * 64 + fr, fq * 8), boff = lds_byte(wc * 32 + fr, fq * 8);
#define PG8_SA(b, h) (((b) * 2 + (h)) * HTB)
#define PG8_SB(b, h) ((4 + (b) * 2 + (h)) * HTB)
#define PG8_STAGE(bufoff, gbase, voff) do { _Pragma("unroll") for (int _i = 0; _i < 2; ++_i) \
        __builtin_amdgcn_global_load_lds((const unsigned*)((const char*)(gbase) + (voff)[_i]), (LAS unsigned*)(lds + (bufoff) + ldsw + _i * 8192), 16, 0, 0); } while (0)
#define PG8_LDA(dst, b, h) do { _Pragma("unroll") for (int m = 0; m < 4; ++m) _Pragma("unroll") for (int k = 0; k < 2; ++k) dst[m][k] = *(const LAS bf16x8*)(lds + PG8_SA(b, h) + aoff + m * 2048 + k * 1024); } while (0)
#define PG8_LDB(dst, b, h) do { _Pragma("unroll") for (int n = 0; n < 2; ++n) _Pragma("unroll") for (int k = 0; k < 2; ++k) dst[n][k] = *(const LAS bf16x8*)(lds + PG8_SB(b, h) + boff + n * 2048 + k * 1024); } while (0)
#define PG8_MMA(ai, bj, At, Bt_) do { __builtin_amdgcn_s_setprio(1); _Pragma("unroll") for (int m = 0; m < 4; ++m) _Pragma("unroll") for (int n = 0; n < 2; ++n) _Pragma("unroll") for (int k = 0; k < 2; ++k) \
        acc[ai][bj][m][n] = __builtin_amdgcn_mfma_f32_16x16x32_bf16(Bt_[n][k], At[m][k], acc[ai][bj][m][n], 0, 0, 0); __builtin_amdgcn_s_setprio(0); } while (0)
#define PG8_WAIT_V(n) asm volatile("s_waitcnt vmcnt(" #n ")" ::: "memory")
#define PG8_WAIT_L(n) asm volatile("s_waitcnt lgkmcnt(" #n ")" ::: "memory")
#define PG8_BAR __builtin_amdgcn_s_barrier()
#define PG8_SCHED __builtin_amdgcn_sched_barrier(0)
    if (AMAP) A -= 2 * lda;
    Unit cur, nxt; int ui = 0;
    if (!SO.next(0, cur)) return;
    f32x4 acc[2][2][4][2];
#pragma unroll
    for (int a = 0; a < 2; ++a)
#pragma unroll
        for (int b = 0; b < 2; ++b)
#pragma unroll
            for (int m = 0; m < 4; ++m)
#pragma unroll
                for (int n = 0; n < 2; ++n) acc[a][b][m][n] = (f32x4){0.f, 0.f, 0.f, 0.f};
    bf16x8 At[4][2], B0[2][2], B1[2][2];
    const char* cA = (const char*)A + (size_t)cur.pm * tstepA + (KOFS ? (cur.pn & 1) * 512 : 0); const char* cB = (const char*)Bt + (size_t)cur.pn * tstepB + (KOFS ? (cur.pn & 1) * 512 : 0);
    PG8_STAGE(PG8_SB(0, 0), cB, voffB); PG8_STAGE(PG8_SB(0, 1), cB + hstepB, voffB); PG8_STAGE(PG8_SA(0, 0), cA, voffA); PG8_STAGE(PG8_SA(0, 1), cA + hstepA, voffA);
    if (wr == 1) PG8_BAR;
    PG8_WAIT_V(2); PG8_BAR;
    PG8_STAGE(PG8_SB(1, 0), cB + kstep, voffB); PG8_STAGE(PG8_SA(1, 0), cA + kstep, voffA); PG8_STAGE(PG8_SB(1, 1), cB + hstepB + kstep, voffB);
    PG8_WAIT_V(6); PG8_BAR;
    for (;;) {
        const bool has_next = SO.next(ui + 1, nxt);
        const char* nA = has_next ? (const char*)A + (size_t)nxt.pm * tstepA + (KOFS ? (nxt.pn & 1) * 512 : 0) : cA; const char* nB = has_next ? (const char*)Bt + (size_t)nxt.pn * tstepB + (KOFS ? (nxt.pn & 1) * 512 : 0) : cB;
        for (int t = 0; t < nt; t += 2) {
            const bool last = (t == nt - 2);
            const char* a1 = cA + (size_t)(t + 1) * kstep;
            const char* a2 = last ? nA : cA + (size_t)(t + 2) * kstep; const char* b2 = last ? nB : cB + (size_t)(t + 2) * kstep;
            const char* a3 = a2 + kstep; const char* b3 = b2 + kstep;
            PG8_LDB(B0, 0, 0); PG8_LDB(B1, 0, 1); PG8_SCHED; PG8_LDA(At, 0, 0); PG8_STAGE(PG8_SA(1, 1), a1 + hstepA, voffA);
            PG8_WAIT_V(8); PG8_WAIT_L(0); PG8_BAR; PG8_MMA(0, 0, At, B0); PG8_MMA(0, 1, At, B1); PG8_BAR; PG8_SCHED;
            PG8_LDA(At, 0, 1); PG8_STAGE(PG8_SB(0, 0), b2, voffB); PG8_STAGE(PG8_SB(0, 1), b2 + hstepB, voffB); PG8_STAGE(PG8_SA(0, 0), a2, voffA);
            PG8_WAIT_V(8); PG8_WAIT_L(0); PG8_BAR; PG8_MMA(1, 0, At, B0); PG8_MMA(1, 1, At, B1); PG8_BAR; PG8_SCHED;
            PG8_LDB(B0, 1, 0); PG8_LDB(B1, 1, 1); PG8_SCHED; PG8_LDA(At, 1, 0); PG8_STAGE(PG8_SA(0, 1), a2 + hstepA, voffA);
            PG8_WAIT_V(8); PG8_WAIT_L(0); PG8_BAR; PG8_MMA(0, 0, At, B0); PG8_MMA(0, 1, At, B1); PG8_BAR; PG8_SCHED;
            PG8_LDA(At, 1, 1); PG8_STAGE(PG8_SB(1, 0), b3, voffB); PG8_STAGE(PG8_SB(1, 1), b3 + hstepB, voffB); PG8_STAGE(PG8_SA(1, 0), a3, voffA);
            PG8_WAIT_V(8); PG8_WAIT_L(0); PG8_BAR; PG8_MMA(1, 0, At, B0); PG8_MMA(1, 1, At, B1); PG8_BAR; PG8_SCHED;
        }
        if (wr == 0) PG8_BAR;
        E(acc, cur, wr, wc, fr, fq);
        if (!has_next) break;
#pragma unroll
        for (int a = 0; a < 2; ++a)
#pragma unroll
            for (int b = 0; b < 2; ++b)
#pragma unroll
                for (int m = 0; m < 4; ++m)
#pragma unroll
                    for (int n = 0; n < 2; ++n) acc[a][b][m][n] = (f32x4){0.f, 0.f, 0.f, 0.f};
        cur = nxt; cA = nA; cB = nB; ++ui;
        if (wr == 1) PG8_BAR;
    }
    PG8_WAIT_V(0);
    PG8_BAR;
#undef PG8_SA
#undef PG8_SB
#undef PG8_STAGE
#undef PG8_LDA
#undef PG8_LDB
#undef PG8_MMA
#undef PG8_WAIT_V
#undef PG8_WAIT_L
#undef PG8_BAR
#undef PG8_SCHED
}
}
using pg8::Unit;
typedef f32x4 AccT[2][2][4][2];

template <int SMODE> struct EpiRowBf16 {
    bf16_t* O; int ldc; const void* sc;
    DI void operator()(const AccT& acc, const Unit& u, int wr, int wc, int fr, int fq) const {
        const int row0 = u.pm * 256 + wr * 64 + fr, col0 = u.pn * 256 + wc * 32 + 8 * fq;
#pragma unroll
        for (int ai = 0; ai < 2; ++ai)
#pragma unroll
            for (int m = 0; m < 4; ++m) { const int row = row0 + ai * 128 + m * 16;
                float s = 1.f; if (SMODE == 1) s = rs_from_ss(((const u64*)sc)[row]); if (SMODE == 2) s = ((const float*)sc)[row];
                bf16_t* rowp = O + (size_t)row * ldc + col0;
#pragma unroll
                for (int bj = 0; bj < 2; ++bj) { const f32x4 v0 = acc[ai][bj][m][0] * s, v1 = acc[ai][bj][m][1] * s;
                    u32x4 w; w.x = pk2(v0[0], v0[1]); w.y = pk2(v0[2], v0[3]); w.z = pk2(v1[0], v1[1]); w.w = pk2(v1[2], v1[3]);
                    *(u32x4*)(rowp + bj * 128) = w; } }
    }
};
struct EpiQOK {
    bf16_t* O; const void* sc; bf16_t* KT;
    DI void operator()(const AccT& acc, const Unit& u, int wr, int wc, int fr, int fq) const {
        const int row0 = u.pm * 256 + wr * 64 + fr, col0 = u.pn * 256 + wc * 32 + 8 * fq;
#pragma unroll
        for (int ai = 0; ai < 2; ++ai)
#pragma unroll
            for (int m = 0; m < 4; ++m) { const int row = row0 + ai * 128 + m * 16;
                const float s = rs_from_ss(((const u64*)sc)[row]);
                bf16_t* rowp = O + (size_t)row * 2048 + col0;
#pragma unroll
                for (int bj = 0; bj < 2; ++bj) { const f32x4 v0 = acc[ai][bj][m][0] * s, v1 = acc[ai][bj][m][1] * s;
                    u32x4 w; w.x = pk2(v0[0], v0[1]); w.y = pk2(v0[2], v0[3]); w.z = pk2(v1[0], v1[1]); w.w = pk2(v1[2], v1[3]);
                    *(u32x4*)(rowp + bj * 128) = w;
                    if (u.pn >= 6) { bf16_t* kt = KT + (size_t)(col0 + bj * 128 - 1536) * S + row;
                        kt[0] = (bf16_t)(w.x & 0xffffu); kt[(size_t)S] = (bf16_t)(w.x >> 16); kt[(size_t)2 * S] = (bf16_t)(w.y & 0xffffu); kt[(size_t)3 * S] = (bf16_t)(w.y >> 16);
                        kt[(size_t)4 * S] = (bf16_t)(w.z & 0xffffu); kt[(size_t)5 * S] = (bf16_t)(w.z >> 16); kt[(size_t)6 * S] = (bf16_t)(w.w & 0xffffu); kt[(size_t)7 * S] = (bf16_t)(w.w >> 16); } } }
    }
};
template <int SMODE> struct EpiColBf16 {
    bf16_t* O; int ldc; const void* sc;
    DI void operator()(const AccT& acc, const Unit& u, int wr, int wc, int fr, int fq) const {
        const int row0 = u.pm * 256 + wr * 64 + fr, col0 = u.pn * 256 + wc * 32 + 8 * fq;
#pragma unroll
        for (int bj = 0; bj < 2; ++bj) { float s[8];
#pragma unroll
            for (int j = 0; j < 8; ++j) s[j] = (SMODE == 1) ? rs_from_ss(((const u64*)sc)[col0 + bj * 128 + j]) : ((const float*)sc)[col0 + bj * 128 + j];
#pragma unroll
            for (int ai = 0; ai < 2; ++ai)
#pragma unroll
                for (int m = 0; m < 4; ++m) { const int row = row0 + ai * 128 + m * 16; const f32x4 v0 = acc[ai][bj][m][0], v1 = acc[ai][bj][m][1];
                    u32x4 w; w.x = pk2(v0[0] * s[0], v0[1] * s[1]); w.y = pk2(v0[2] * s[2], v0[3] * s[3]); w.z = pk2(v1[0] * s[4], v1[1] * s[5]); w.w = pk2(v1[2] * s[6], v1[3] * s[7]);
                    *(u32x4*)(O + (size_t)row * ldc + col0 + bj * 128) = w; } }
    }
};
struct EpiQ {
    bf16_t* QB; const float* rsq; const float* cstab;
    DI void operator()(const AccT& acc, const Unit& u, int wr, int wc, int fr, int fq) const {
        const int row0 = u.pm * 256 + wr * 64 + fr, col0 = u.pn * 256 + wc * 32 + 8 * fq;
        const float QS = 0.10206207261596577f * LOG2E;
#pragma unroll
        for (int ai = 0; ai < 2; ++ai)
#pragma unroll
            for (int m = 0; m < 4; ++m) { const int t = row0 + ai * 128 + m * 16; const float s = rsq[t] * QS;
#pragma unroll
                for (int bj = 0; bj < 2; ++bj) { const int c = col0 + bj * 128, h = c / 96, d = c - h * 96;
                    f32x4 v0 = acc[ai][bj][m][0] * s, v1 = acc[ai][bj][m][1] * s;
                    if (d >= 64) { const int i0 = (d - 64) >> 1; const f32x4 cs0 = *(const f32x4*)(cstab + (size_t)t * 32 + 2 * i0), cs1 = *(const f32x4*)(cstab + (size_t)t * 32 + 2 * i0 + 4);
                        f32x4 a, b;
                        a[0] = v0[0] * cs0[0] - v0[1] * cs0[1]; a[1] = v0[1] * cs0[0] + v0[0] * cs0[1];
                        a[2] = v0[2] * cs0[2] - v0[3] * cs0[3]; a[3] = v0[3] * cs0[2] + v0[2] * cs0[3];
                        b[0] = v1[0] * cs1[0] - v1[1] * cs1[1]; b[1] = v1[1] * cs1[0] + v1[0] * cs1[1];
                        b[2] = v1[2] * cs1[2] - v1[3] * cs1[3]; b[3] = v1[3] * cs1[2] + v1[2] * cs1[3];
                        v0 = a; v1 = b; }
                    u32x4 w; w.x = pk2(v0[0], v0[1]); w.y = pk2(v0[2], v0[3]); w.z = pk2(v1[0], v1[1]); w.w = pk2(v1[2], v1[3]);
                    *(u32x4*)(QB + ((size_t)h * S + t) * 96 + d) = w; } }
    }
};
struct EpiK {
    bf16_t* KB; const float* rskv;
    DI void operator()(const AccT& acc, const Unit& u, int wr, int wc, int fr, int fq) const {
        const int row0 = u.pm * 256 + wr * 64 + fr, col0 = u.pn * 256 + wc * 32 + 8 * fq;
#pragma unroll
        for (int ai = 0; ai < 2; ++ai)
#pragma unroll
            for (int m = 0; m < 4; ++m) { const int t = row0 + ai * 128 + m * 16; const float s = rskv[t];
#pragma unroll
                for (int bj = 0; bj < 2; ++bj) { const int c = col0 + bj * 128, h = c >> 6, d = c & 63;
                    const f32x4 v0 = acc[ai][bj][m][0] * s, v1 = acc[ai][bj][m][1] * s;
                    u32x4 w; w.x = pk2(v0[0], v0[1]); w.y = pk2(v0[2], v0[3]); w.z = pk2(v1[0], v1[1]); w.w = pk2(v1[2], v1[3]);
                    *(u32x4*)(KB + ((size_t)h * S + t) * 96 + d) = w; } }
    }
};
template <bool RESBF> struct EpiRes {
    const float* res; bf16_t* XB; u64* rowss; int dry;
    DI void operator()(const AccT& acc, const Unit& u, int wr, int wc, int fr, int fq) const {
        const int row0 = u.pm * 256 + wr * 64 + fr, col0 = u.pn * 256 + wc * 32 + 8 * fq;
#pragma unroll
        for (int ai = 0; ai < 2; ++ai)
#pragma unroll
            for (int m = 0; m < 4; ++m) { const int t = row0 + ai * 128 + m * 16; float ss = 0.f;
#pragma unroll
                for (int bj = 0; bj < 2; ++bj) { const size_t o = (size_t)t * 1024 + col0 + bj * 128;
                    f32x4 r0, r1;
                    if (RESBF) { const u32x4 rb = *(const u32x4*)(XB + o); r0 = (f32x4){bflo(rb.x), bfhi(rb.x), bflo(rb.y), bfhi(rb.y)}; r1 = (f32x4){bflo(rb.z), bfhi(rb.z), bflo(rb.w), bfhi(rb.w)}; }
                    else { r0 = __builtin_nontemporal_load((const f32x4*)(res + o)); r1 = __builtin_nontemporal_load((const f32x4*)(res + o + 4)); }
                    const f32x4 v0 = acc[ai][bj][m][0] + r0, v1 = acc[ai][bj][m][1] + r1;
                    u32x4 w; w.x = pk2(v0[0], v0[1]); w.y = pk2(v0[2], v0[3]); w.z = pk2(v1[0], v1[1]); w.w = pk2(v1[2], v1[3]);
                    if (!dry) *(u32x4*)(XB + o) = w;
                    ss += v0[0] * v0[0] + v0[1] * v0[1] + v0[2] * v0[2] + v0[3] * v0[3] + v1[0] * v1[0] + v1[1] * v1[1] + v1[2] * v1[2] + v1[3] * v1[3]; }
                ss += __shfl_xor(ss, 16); ss += __shfl_xor(ss, 32);
                if (fq == 0 && !dry) atomicAdd(rowss + t, ss_to_fix(ss)); }
    }
};
DI float dpp_prev1(float cur, float prevm) {
    const int o = __builtin_amdgcn_update_dpp(0, __builtin_bit_cast(int, prevm), 0x121, 0xf, 0xf, false);
    return __builtin_bit_cast(float, __builtin_amdgcn_update_dpp(o, __builtin_bit_cast(int, cur), 0x111, 0xf, 0xf, false));
}
DI float dpp_prev2(float cur, float prevm) {
    const int o = __builtin_amdgcn_update_dpp(0, __builtin_bit_cast(int, prevm), 0x122, 0xf, 0xf, false);
    return __builtin_bit_cast(float, __builtin_amdgcn_update_dpp(o, __builtin_bit_cast(int, cur), 0x112, 0xf, 0xf, false));
}
struct EpiUp {
    bf16_t* ACT; const u64* rowss; const float* cw; const float* cb; LAS unsigned char* plds;
    DI void operator()(const AccT& acc, const Unit& u, int wr, int wc, int fr, int fq) const {
        const int cl = u.pn * 128 + wc * 32 + 8 * fq;
        LAS float* P = (LAS float*)(plds + (wr * 4 + wc) * 1024);
        { const int lane = fq * 16 + fr, kind = lane >> 3, c4 = 4 * (lane & 7), k3 = kind & 3;
          const float* src = (k3 == 0 ? cb : cw + (k3 - 1) * 5632) + (kind >= 4 ? 2816 : 0) + u.pn * 128 + wc * 32 + c4;
          *(LAS f32x4*)(P + kind * 32 + c4) = *(const f32x4*)src; }
#pragma unroll
        for (int ai = 0; ai < 2; ++ai) {
            const int tok0 = u.pm * 248 + 62 * (2 * ai + wr) - 2 + fr;
            float rs[4];
#pragma unroll
            for (int m = 0; m < 4; ++m) { const int t = tok0 + 16 * m; const int tc = t < 0 ? 0 : (t >= S ? S - 1 : t); const float r = rs_from_ss(rowss[tc]); rs[m] = t < 0 ? 0.f : r; }
            const int row0 = fr < 2 ? (S + 236 + fr) : tok0;
#pragma unroll
            for (int n = 0; n < 2; ++n) {
                const int lc = 8 * fq + 4 * n;
                unsigned wpk[4][2];
#pragma unroll
                for (int jp = 0; jp < 2; ++jp) {
                    const f32x2 bg = *(const LAS f32x2*)(P + lc + 2 * jp), g0 = *(const LAS f32x2*)(P + 32 + lc + 2 * jp), g1 = *(const LAS f32x2*)(P + 64 + lc + 2 * jp), g2 = *(const LAS f32x2*)(P + 96 + lc + 2 * jp);
                    const f32x2 bv = *(const LAS f32x2*)(P + 128 + lc + 2 * jp), v0 = *(const LAS f32x2*)(P + 160 + lc + 2 * jp), v1 = *(const LAS f32x2*)(P + 192 + lc + 2 * jp), v2 = *(const LAS f32x2*)(P + 224 + lc + 2 * jp);
                    f32x2 G[4], V[4];
#pragma unroll
                    for (int m = 0; m < 4; ++m) { G[m] = (f32x2){acc[ai][0][m][n][2 * jp], acc[ai][0][m][n][2 * jp + 1]} * rs[m]; V[m] = (f32x2){acc[ai][1][m][n][2 * jp], acc[ai][1][m][n][2 * jp + 1]} * rs[m]; }
#pragma unroll
                    for (int m = 0; m < 4; ++m) {
                        const f32x2 zz = {0.f, 0.f}; const f32x2 Gp = m ? G[m - 1] : zz, Vp = m ? V[m - 1] : zz;
                        const f32x2 gp1 = {dpp_prev1(G[m].x, Gp.x), dpp_prev1(G[m].y, Gp.y)}, gp2 = {dpp_prev2(G[m].x, Gp.x), dpp_prev2(G[m].y, Gp.y)};
                        const f32x2 vp1 = {dpp_prev1(V[m].x, Vp.x), dpp_prev1(V[m].y, Vp.y)}, vp2 = {dpp_prev2(V[m].x, Vp.x), dpp_prev2(V[m].y, Vp.y)};
                        const f32x2 gc = bg + g0 * gp2 + g1 * gp1 + g2 * G[m];
                        const f32x2 vc = bv + v0 * vp2 + v1 * vp1 + v2 * V[m];
                        const f32x2 xe = gc * (-LOG2E);
                        f32x2 dn = {__builtin_amdgcn_exp2f(xe.x), __builtin_amdgcn_exp2f(xe.y)}; dn = dn + 1.0f;
                        const f32x2 rc = {__builtin_amdgcn_rcpf(dn.x), __builtin_amdgcn_rcpf(dn.y)};
                        const f32x2 rr = gc * rc * vc;
                        wpk[m][jp] = pk2(rr.x, rr.y); }
                }
#pragma unroll
                for (int m = 0; m < 4; ++m) { const int row = m ? tok0 + 16 * m : row0;
                    *(u32x2*)(ACT + (size_t)row * 2816 + cl + 4 * n) = (u32x2){wpk[m][0], wpk[m][1]}; }
                __builtin_amdgcn_sched_barrier(0);
            }
        }
    }
};

template <class F> DI void tr_items(const F& f, int Kdst, int Nrows, bf16_t* WT, LAS float* scr, int gw, int NGW, int lane, int& cum) {
    const int nblk = Nrows / 32, nitems = (Kdst / 64) * nblk;
    int first = (gw - cum) % NGW; if (first < 0) first += NGW; cum = (cum + nitems) % NGW;
    for (int item = first; item < nitems; item += NGW) {
        const int kb = item / nblk, nb = item % nblk, k0 = 64 * kb, n0 = 32 * nb;
        float tv[32];
#pragma unroll
        for (int i = 0; i < 32; ++i) tv[i] = f(k0 + 2 * i + (lane >> 5), n0 + (lane & 31));
#pragma unroll
        for (int i = 0; i < 32; ++i) scr[(2 * i + (lane >> 5)) * 33 + (lane & 31)] = tv[i];
        asm volatile("s_waitcnt lgkmcnt(0)" ::: "memory");
        const int c = lane & 7;
#pragma unroll
        for (int j = 0; j < 4; ++j) { const int n = (lane >> 3) + 8 * j; const LAS float* s = scr + (8 * c) * 33 + n;
            u32x4 o; o.x = pk2(s[0 * 33], s[1 * 33]); o.y = pk2(s[2 * 33], s[3 * 33]); o.z = pk2(s[4 * 33], s[5 * 33]); o.w = pk2(s[6 * 33], s[7 * 33]);
            *(u32x4*)(WT + (size_t)(n0 + n) * Kdst + k0 + 8 * c) = o; }
        asm volatile("s_waitcnt lgkmcnt(0)" ::: "memory");
    }
}
struct FW1 { const float* W; const float* g; DI float operator()(int k, int n) const { return n < 1440 ? __builtin_nontemporal_load(&W[(size_t)k * 1440 + n]) * g[k] : 0.f; } };
struct FWQ { const float* W; const float* g; DI float operator()(int k, int n) const { const int h = n / 96, d = n - h * 96; int c = d; if (d >= 64) { const int r = d - 64; c = 64 + (r >> 1) + 16 * (r & 1); } return __builtin_nontemporal_load(&W[(size_t)k * 768 + h * 96 + c]) * g[k]; } };
struct FWKV { const float* W; const float* g; int off; DI float operator()(int k, int n) const { return k < 128 ? __builtin_nontemporal_load(&W[(size_t)k * 1024 + (n >> 6) * 128 + off + (n & 63)]) * g[k] : 0.f; } };
struct FWRI { const float* Wa; const float* Wx; DI float operator()(int k, int n) const { const float* W = n < 512 ? Wa : Wx; const int ch = n & 511, g = ch >> 6, j = ch & 63; return (k >> 6) == g ? __builtin_nontemporal_load(&W[(size_t)k * 64 + j]) : 0.f; } };
struct FWP { const float* W; int N; DI float operator()(int k, int n) const { return __builtin_nontemporal_load(&W[(size_t)k * N + n]); } };
struct FWUP { const float* W; const float* g; DI float operator()(int k, int n) const { const int pn = n >> 8, r = n & 255; const int c = r < 128 ? 128 * pn + r : 2816 + 128 * pn + r - 128; return __builtin_nontemporal_load(&W[(size_t)k * 5632 + c]) * g[k]; } };
struct FWOIN { const float* W; const float* g; DI float operator()(int k, int n) const {
    int c; float s = 1.f; if (n < 512) { c = n; s = 0.08838834764831845f; } else if (n < 1536) c = 2048 + (n - 512); else if (n < 2048) c = 512 + (n - 1536); else c = 1024 + (n - 2048);
    return __builtin_nontemporal_load(&W[(size_t)k * 3080 + c]) * g[k] * s; } };

#ifndef PROPART
#define PROPART 7
#endif
DI void phase_prologue(int wv, const ArgP a, LAS unsigned char* lds, int parts) {
    unsigned char* ws = a.ws();
    const int tid = ltid(wv), wave = tid >> 6, lane = tid & 63;
    LAS float* scr = (LAS float*)(lds + wave * 8448);
    const int gw = blockIdx.x * 8 + wave, NGW = gridDim.x * 8; int cum = 0;
    if (parts & 1) {
    { FW1 f{a.in(3), a.in(2)}; tr_items(f, 1024, 1536, (bf16_t*)(ws + O_W1T), scr, gw, NGW, lane, cum); }
    { FWQ f{a.in(12), a.in(11)}; tr_items(f, 256, 768, (bf16_t*)(ws + O_WQT), scr, gw, NGW, lane, cum); }
    { FWKV f{a.in(14), a.in(13), 0}; tr_items(f, 256, 512, (bf16_t*)(ws + O_WKT), scr, gw, NGW, lane, cum); }
    { FWKV f{a.in(14), a.in(13), 64}; tr_items(f, 256, 512, (bf16_t*)(ws + O_WVT), scr, gw, NGW, lane, cum); }
    { FWRI f{a.in(6), a.in(8)}; tr_items(f, 512, 1024, (bf16_t*)(ws + O_WRIT), scr, gw, NGW, lane, cum); }
    { FWP f{a.in(15), 1024}; tr_items(f, 1024, 1024, (bf16_t*)(ws + O_WO1T), scr, gw, NGW, lane, cum); }
    for (int l = 0; l < 2; ++l) {
        { FWUP f{a.in(23) + (size_t)l * 1024 * 5632, a.in(22) + l * 1024}; tr_items(f, 1024, 5632, (bf16_t*)(ws + (l ? O_WUPT1 : O_WUPT0)), scr, gw, NGW, lane, cum); }
        { FWP f{a.in(26) + (size_t)l * 2816 * 1024, 1024}; tr_items(f, 2816, 1024, (bf16_t*)(ws + (l ? O_WDNT1 : O_WDNT0)), scr, gw, NGW, lane, cum); }
    }
    { FWOIN f{a.in(17), a.in(16)}; tr_items(f, 1024, 3072, (bf16_t*)(ws + O_WOINT), scr, gw, NGW, lane, cum); }
    { FWP f{a.in(21), 1024}; tr_items(f, 1024, 1024, (bf16_t*)(ws + O_WO2T), scr, gw, NGW, lane, cum); }
    }
    if (parts & 2) {
    const float* x = a.in(0); bf16_t* XB = (bf16_t*)(ws + O_XB) + 2 * 1024; u64* rowss = (u64*)(ws + O_ROWSS);
#pragma unroll 4
    for (int t = gw; t < S; t += NGW) {
        float ss = 0.f;
#pragma unroll
        for (int j = 0; j < 4; ++j) { const f32x4 v = __builtin_nontemporal_load((const f32x4*)(x + (size_t)t * 1024 + j * 256 + lane * 4));
            ss += v[0] * v[0] + v[1] * v[1] + v[2] * v[2] + v[3] * v[3];
            u32x2 w; w.x = pk2(v[0], v[1]); w.y = pk2(v[2], v[3]); *(u32x2*)(XB + (size_t)t * 1024 + j * 256 + lane * 4) = w; }
        ss = wave_sum(ss);
        if (lane == 0) rowss[t] = ss_to_fix(ss);
        if (lane >= 1 && lane < 5) rowss[(size_t)lane * S + t] = 0ull;
    }
    }
    if (parts & 4) {
    const int* pos = (const int*)a.in(1); float* cst = (float*)(ws + O_CSTAB);
    for (int e = blockIdx.x * 512 + tid; e < S * 16; e += gridDim.x * 512) { const int t = e >> 4, i = e & 15;
        const float invf = __builtin_amdgcn_exp2f(-(float)i * (13.287712379549449f / 16.f)); const float ang = (float)pos[t] * invf;
        const float k = rintf(ang * 0.15915494309189535f);
        float r = fmaf(-k, 6.28318548202514648f, ang); r = fmaf(-k, -1.7484555e-7f, r);
        const float rr = r * 0.15915494309189535f;
        cst[2 * e] = __builtin_amdgcn_cosf(rr); cst[2 * e + 1] = __builtin_amdgcn_sinf(rr); }
    }
}

DI void phase_l0_prep(int wv, const ArgP a) {
    unsigned char* ws = a.ws();
    const bf16_t* Z = (const bf16_t*)(ws + O_Z); bf16_t* XC = (bf16_t*)(ws + O_XC); bf16_t* KB = (bf16_t*)(ws + O_KB);
    float* rsq = (float*)(ws + O_RSQ); float* rskv = (float*)(ws + O_RSKV); const float* cst = (const float*)(ws + O_CSTAB);
    const float* cw = a.in(4); const float* cb = a.in(5);
    const int tid = ltid(wv), wave = tid >> 6, lane = tid & 63;
#pragma unroll 2
    for (int e = blockIdx.x * 512 + tid; e < S * 64; e += gridDim.x * 512) { const int t = e >> 6, c0 = (e & 63) * 8;
        float acc[8];
#pragma unroll
        for (int j = 0; j < 8; ++j) acc[j] = cb[c0 + j];
#pragma unroll
        for (int k = 0; k < 4; ++k) { const int tt = t - 3 + k; if (tt < 0) continue;
            const u32x4 v = *(const u32x4*)(Z + (size_t)tt * 1536 + c0);
            const f32x4 w0 = *(const f32x4*)(cw + k * 512 + c0), w1 = *(const f32x4*)(cw + k * 512 + c0 + 4);
            acc[0] += w0[0] * bflo(v.x); acc[1] += w0[1] * bfhi(v.x); acc[2] += w0[2] * bflo(v.y); acc[3] += w0[3] * bfhi(v.y);
            acc[4] += w1[0] * bflo(v.z); acc[5] += w1[1] * bfhi(v.z); acc[6] += w1[2] * bflo(v.w); acc[7] += w1[3] * bfhi(v.w); }
        u32x4 o; o.x = pk2(acc[0], acc[1]); o.y = pk2(acc[2], acc[3]); o.z = pk2(acc[4], acc[5]); o.w = pk2(acc[6], acc[7]);
        *(u32x4*)(XC + (size_t)t * 512 + c0) = o; }
#pragma unroll 4
    for (int t = blockIdx.x * 8 + wave; t < S; t += gridDim.x * 8) {
        const bf16_t* zr = Z + (size_t)t * 1536;
        float sq = 0.f, skv = 0.f;
        { const u32x2 v = *(const u32x2*)(zr + 1024 + lane * 4); const float p0 = bflo(v.x), p1 = bfhi(v.x), p2 = bflo(v.y), p3 = bfhi(v.y); sq = p0 * p0 + p1 * p1 + p2 * p2 + p3 * p3; }
        { const unsigned v = *(const unsigned*)(zr + 1280 + lane * 2); const float p0 = bflo(v), p1 = bfhi(v); skv = p0 * p0 + p1 * p1; }
        sq = wave_sum(sq); skv = wave_sum(skv);
        if (lane == 0) { rsq[t] = rsqrtf(sq * (1.f / 256.f) + EPS); rskv[t] = rsqrtf(skv * (1.f / 128.f) + EPS); }
        if (lane < 16) { const float x1 = bf2f(zr[1408 + lane]), x2 = bf2f(zr[1424 + lane]); const float c = cst[(size_t)t * 32 + 2 * lane], s = cst[(size_t)t * 32 + 2 * lane + 1];
            const unsigned w = pk2(x1 * c - x2 * s, x2 * c + x1 * s);
#pragma unroll
            for (int h = 0; h < 8; ++h) *(unsigned*)(KB + ((size_t)h * S + t) * 96 + 64 + 2 * lane) = w; }
    }
}

DI void lru_coeff(float rpre, float ipre, float xc, float sp8, float& av, float& uv) {
    const float r = sigmoidf_(rpre), ig = sigmoidf_(ipre);
    const float la = -sp8 * r;
    av = fexp(la);
    uv = __builtin_amdgcn_sqrtf(fmaxf(1.f - av * av, 0.f)) * (ig * xc);
}
DI void phase_lru_s1(int wv, const ArgP a) {
    unsigned char* ws = a.ws(); const int ch = ltid(wv);
    const bf16_t* RI = (const bf16_t*)(ws + O_RI); const bf16_t* XC = (const bf16_t*)(ws + O_XC);
    float* CHA = (float*)(ws + O_CHA); float* CHH = (float*)(ws + O_CHH);
    const float ba = a.in(7)[ch], bx = a.in(9)[ch]; const float lam = a.in(10)[ch];
    const float sp8 = 8.f * log1pf(expf(-lam));
    for (int c = blockIdx.x; c < 256; c += gridDim.x) {
        float A = 1.f, H = 0.f;
#pragma unroll 8
        for (int i = 0; i < 64; ++i) { const size_t t = (size_t)c * 64 + i;
            float av, uv; lru_coeff(bf2f(RI[t * 1024 + ch]) + ba, bf2f(RI[t * 1024 + 512 + ch]) + bx, bf2f(XC[t * 512 + ch]), sp8, av, uv);
            A *= av; H = av * H + uv; }
        CHA[c * 512 + ch] = A; CHH[c * 512 + ch] = H;
    }
}
DI void phase_lru_s3(int wv, const ArgP a) {
    unsigned char* ws = a.ws(); const int ch = ltid(wv);
    const bf16_t* RI = (const bf16_t*)(ws + O_RI); const bf16_t* XC = (const bf16_t*)(ws + O_XC); const bf16_t* Z = (const bf16_t*)(ws + O_Z);
    const float* CHA = (const float*)(ws + O_CHA); const float* CHH = (const float*)(ws + O_CHH); bf16_t* MIX = (bf16_t*)(ws + O_MIX);
    const float ba = a.in(7)[ch], bx = a.in(9)[ch]; const float lam = a.in(10)[ch];
    const float sp8 = 8.f * log1pf(expf(-lam));
    for (int c = blockIdx.x; c < 256; c += gridDim.x) {
        float H = 0.f;
        { int cc = 0;
          for (; cc + 28 <= c; cc += 28) { float aa[28], hh[28];
#pragma unroll
              for (int k = 0; k < 28; ++k) { aa[k] = CHA[(cc + k) * 512 + ch]; hh[k] = CHH[(cc + k) * 512 + ch]; }
#pragma unroll
              for (int k = 0; k < 28; ++k) H = aa[k] * H + hh[k]; }
          for (; cc < c; ++cc) H = CHA[cc * 512 + ch] * H + CHH[cc * 512 + ch]; }
#pragma unroll 4
        for (int i = 0; i < 64; ++i) { const size_t t = (size_t)c * 64 + i;
            float av, uv; lru_coeff(bf2f(RI[t * 1024 + ch]) + ba, bf2f(RI[t * 1024 + 512 + ch]) + bx, bf2f(XC[t * 512 + ch]), sp8, av, uv);
            H = av * H + uv;
            const float g = bf2f(Z[t * 1536 + 512 + ch]);
            const float y = 0.7978845608028654f * (g + 0.044715f * g * g * g);
            const float th = 1.f - 2.f * __builtin_amdgcn_rcpf(1.f + fexp(2.f * y));
            MIX[t * 1024 + ch] = f2bf(H * 0.5f * g * (1.f + th)); }
    }
}

constexpr int AT_KROW = 208, AT_VROW = 136, AT_KT = 64 * AT_KROW, AT_VT = 64 * AT_VROW;
DI float rowmax32(const f32x16& p0, const f32x16& p1) {
    float a = fmaxf(fmaxf(p0[0], p0[1]), p1[0]), b = fmaxf(fmaxf(p0[2], p0[3]), p1[1]); a = fmaxf(fmaxf(a, p1[2]), p1[3]);
#pragma unroll
    for (int r = 4; r < 16; r += 4) { a = fmaxf(fmaxf(a, p0[r]), p0[r + 1]); b = fmaxf(fmaxf(b, p0[r + 2]), p0[r + 3]); a = fmaxf(fmaxf(a, p1[r]), p1[r + 1]); b = fmaxf(fmaxf(b, p1[r + 2]), p1[r + 3]); }
    const float m = fmaxf(a, b);
    const auto rr = __builtin_amdgcn_permlane32_swap(__float_as_uint(m), __float_as_uint(m), false, false);
    return fmaxf(__uint_as_float(rr[0]), __uint_as_float(rr[1]));
}
DI void attn_unit(int wv, int h, int qb, const bf16_t* QB, const bf16_t* KB, const bf16_t* VT, bf16_t* MIX, LAS unsigned char* lds) {
    const int tid = ltid(wv), lane = tid & 63, r32 = lane & 31, hi = lane >> 5; const int wid = __builtin_amdgcn_readfirstlane(tid >> 6);
    const int qg = qb * 256 + wid * 32 + r32;
    const bf16_t* Kh = KB + (size_t)h * S * 96; const bf16_t* Vh = VT + (size_t)h * 64 * S;
    bf16x8 qf[6];
    { const bf16_t* qp = QB + ((size_t)h * S + qg) * 96 + 8 * hi;
#pragma unroll
      for (int s = 0; s < 6; ++s) qf[s] = *(const bf16x8*)(qp + 16 * s); }
    f32x16 o0 = {}, o1 = {}, negm = {};
    float mref = 0.f, lrun = 0.f;
    const int NT = 4 * qb + 4, wlim = 4 * qb + (wid >> 1);
    const int kc0 = tid, kkey0 = kc0 / 12, kpart0 = kc0 % 12;
    const int kc1 = tid + 512, kkey1 = kc1 / 12, kpart1 = kc1 % 12;
    const int vdv = tid >> 3, vpart = tid & 7;
    u32x4 rk0, rk1 = {}, rv;
#define AT_LOADK(t_) do { const size_t kb_ = (size_t)(t_) * 64; rk0 = *(const u32x4*)(Kh + (kb_ + kkey0) * 96 + kpart0 * 8); if (tid < 256) rk1 = *(const u32x4*)(Kh + (kb_ + kkey1) * 96 + kpart1 * 8); } while (0)
#define AT_LOADV(t_) do { rv = *(const u32x4*)(Vh + (size_t)vdv * S + (size_t)(t_) * 64 + vpart * 8); } while (0)
#define AT_WRITEK(t_) do { LAS unsigned char* Ks_ = lds + ((t_) & 1) * AT_KT; *(LAS u32x4*)(Ks_ + kkey0 * AT_KROW + kpart0 * 16) = rk0; if (tid < 256) *(LAS u32x4*)(Ks_ + kkey1 * AT_KROW + kpart1 * 16) = rk1; } while (0)
#define AT_WRITEV(t_) do { LAS unsigned char* Vs_ = lds + 2 * AT_KT + ((t_) & 1) * AT_VT; *(LAS u32x2*)(Vs_ + vdv * AT_VROW + vpart * 16) = (u32x2){rv.x, rv.y}; *(LAS u32x2*)(Vs_ + vdv * AT_VROW + vpart * 16 + 8) = (u32x2){rv.z, rv.w}; } while (0)
#define AT_QK(P0, P1, t_) do { const LAS unsigned char* Ks_ = lds + ((t_) & 1) * AT_KT + r32 * AT_KROW + 16 * hi; f32x16 c0_ = negm, c1_ = negm; \
        _Pragma("unroll") for (int s = 0; s < 6; ++s) { const bf16x8 k0_ = *(const LAS bf16x8*)(Ks_ + 32 * s), k1_ = *(const LAS bf16x8*)(Ks_ + 32 * AT_KROW + 32 * s); \
            c0_ = __builtin_amdgcn_mfma_f32_32x32x16_bf16(k0_, qf[s], c0_, 0, 0, 0); c1_ = __builtin_amdgcn_mfma_f32_32x32x16_bf16(k1_, qf[s], c1_, 0, 0, 0); } \
        P0 = c0_; P1 = c1_; } while (0)
#define AT_SM1(P0, P1, MOFF, t_, MASK) do { \
        if (MASK && (t_) == wlim) { const int kbase_ = (t_) * 64 + 4 * hi; \
            _Pragma("unroll") for (int r = 0; r < 16; ++r) { const int kv_ = kbase_ + (r & 3) + 8 * (r >> 2); if (kv_ > qg) P0[r] = -1e30f; if (kv_ + 32 > qg) P1[r] = -1e30f; } } \
        const float d_ = mref - MOFF;                         \
        const float mx_ = rowmax32(P0, P1) - d_;              \
        if ((t_) == 0 || __any(mx_ > 8.f || d_ != 0.f)) { const float dl_ = ((t_) == 0) ? mx_ : fmaxf(mx_, 0.f); mref += dl_; \
            const float sh_ = d_ + dl_; \
            _Pragma("unroll") for (int r = 0; r < 16; ++r) { P0[r] -= sh_; P1[r] -= sh_; } \
            const float al_ = ((t_) == 0) ? 1.f : __builtin_amdgcn_exp2f(-dl_); lrun *= al_;     \
            _Pragma("unroll") for (int r = 0; r < 16; ++r) { o0[r] *= al_; o1[r] *= al_; negm[r] = -mref; } asm volatile("" : "+v"(negm)); } \
    } while (0)
#define AT_SM2(P0, P1, t_) do { \
        float ps_ = 0.f; \
        _Pragma("unroll") for (int r = 0; r < 16; ++r) { P0[r] = __builtin_amdgcn_exp2f(P0[r]); P1[r] = __builtin_amdgcn_exp2f(P1[r]); ps_ += P0[r] + P1[r]; } \
        lrun += ps_; \
        const LAS unsigned char* Vs_ = lds + 2 * AT_KT + ((t_) & 1) * AT_VT + r32 * AT_VROW + 8 * hi; \
        _Pragma("unroll") for (int ks = 0; ks < 4; ++ks) { u32x4 w_; \
            if (ks < 2) { w_.x = pk2(P0[8 * ks], P0[8 * ks + 1]); w_.y = pk2(P0[8 * ks + 2], P0[8 * ks + 3]); w_.z = pk2(P0[8 * ks + 4], P0[8 * ks + 5]); w_.w = pk2(P0[8 * ks + 6], P0[8 * ks + 7]); } \
            else { w_.x = pk2(P1[8 * ks - 16], P1[8 * ks - 15]); w_.y = pk2(P1[8 * ks - 14], P1[8 * ks - 13]); w_.z = pk2(P1[8 * ks - 12], P1[8 * ks - 11]); w_.w = pk2(P1[8 * ks - 10], P1[8 * ks - 9]); } \
            const bf16x8 pa_ = __builtin_bit_cast(bf16x8, w_); \
            const u32x2 a0_ = *(const LAS u32x2*)(Vs_ + 32 * ks), a1_ = *(const LAS u32x2*)(Vs_ + 32 * ks + 16); \
            const u32x2 b0_ = *(const LAS u32x2*)(Vs_ + 32 * AT_VROW + 32 * ks), b1_ = *(const LAS u32x2*)(Vs_ + 32 * AT_VROW + 32 * ks + 16); \
            o0 = __builtin_amdgcn_mfma_f32_32x32x16_bf16(__builtin_bit_cast(bf16x8, (u32x4){a0_.x, a0_.y, a1_.x, a1_.y}), pa_, o0, 0, 0, 0); \
            o1 = __builtin_amdgcn_mfma_f32_32x32x16_bf16(__builtin_bit_cast(bf16x8, (u32x4){b0_.x, b0_.y, b1_.x, b1_.y}), pa_, o1, 0, 0, 0); } \
    } while (0)
#define AT_STEPM(C0, C1, MC, N0, N1, MN, t_) do { \
        AT_WRITEK((t_) + 1); AT_WRITEV(t_); \
        __syncthreads(); \
        AT_LOADK((t_) + 2); AT_LOADV((t_) + 1); \
        AT_SM1(C0, C1, MC, t_, 0); MN = mref; AT_QK(N0, N1, (t_) + 1); AT_SM2(C0, C1, t_); \
    } while (0)
#define AT_STEPB(C0, C1, MC, N0, N1, MN, t_) do { \
        if ((t_) + 1 < NT) AT_WRITEK((t_) + 1); AT_WRITEV(t_); \
        __syncthreads(); \
        if ((t_) + 2 < NT) AT_LOADK((t_) + 2); if ((t_) + 1 < NT) AT_LOADV((t_) + 1); \
        if ((t_) + 1 <= wlim) { MN = mref; AT_QK(N0, N1, (t_) + 1); } \
        if ((t_) <= wlim) { AT_SM1(C0, C1, MC, t_, 1); AT_SM2(C0, C1, t_); } \
    } while (0)
    f32x16 pA0, pA1, pB0 = {}, pB1 = {}; float mA = 0.f, mB = 0.f;
    AT_LOADK(0); AT_WRITEK(0);
    __syncthreads();
    AT_LOADK(1); AT_LOADV(0);
    AT_QK(pA0, pA1, 0);
    int t = 0;
    for (; t < 4 * qb; t += 2) {
        AT_STEPM(pA0, pA1, mA, pB0, pB1, mB, t);
        AT_STEPM(pB0, pB1, mB, pA0, pA1, mA, t + 1);
    }
    for (; t < NT; t += 2) {
        AT_STEPB(pA0, pA1, mA, pB0, pB1, mB, t);
        AT_STEPB(pB0, pB1, mB, pA0, pA1, mA, t + 1);
    }
#undef AT_STEPM
#undef AT_STEPB
#undef AT_LOADK
#undef AT_LOADV
#undef AT_WRITEK
#undef AT_WRITEV
#undef AT_QK
#undef AT_SM1
#undef AT_SM2
    lrun += __shfl_xor(lrun, 32);
    const float inv = 1.f / lrun;
    bf16_t* op = MIX + (size_t)qg * 1024 + 512 + h * 64;
#pragma unroll
    for (int g = 0; g < 4; ++g) { const int dv = 8 * g + 4 * hi;
        u32x2 w; w.x = pk2(o0[4 * g] * inv, o0[4 * g + 1] * inv); w.y = pk2(o0[4 * g + 2] * inv, o0[4 * g + 3] * inv); *(u32x2*)(op + dv) = w;
        u32x2 w2; w2.x = pk2(o1[4 * g] * inv, o1[4 * g + 1] * inv); w2.y = pk2(o1[4 * g + 2] * inv, o1[4 * g + 3] * inv); *(u32x2*)(op + 32 + dv) = w2; }
    __syncthreads();
}
DI void phase_attn(int wv, const ArgP a, LAS unsigned char* lds) {
    unsigned char* ws = a.ws();
    const bf16_t* QB = (const bf16_t*)(ws + O_QB); const bf16_t* KB = (const bf16_t*)(ws + O_KB); const bf16_t* VT = (const bf16_t*)(ws + O_VT); bf16_t* MIX = (bf16_t*)(ws + O_MIX);
    if (wv >= 4) __builtin_amdgcn_s_setprio(1);
    for (int b = blockIdx.x; b < 256; b += gridDim.x) {
        const int v = (b & 7) * 32 + (b >> 3), h = v >> 5, s = v & 31;
        attn_unit(wv, h, 63 - s, QB, KB, VT, MIX, lds);
        attn_unit(wv, h, s, QB, KB, VT, MIX, lds);
    }
    __builtin_amdgcn_s_setprio(0);
}

DI void phase_m_gates(int wv, const ArgP a, LAS unsigned char* lds) {
    unsigned char* ws = a.ws(); const int tid = ltid(wv), wave = tid >> 6, lane = tid & 63;
    const bf16_t* XBr = (const bf16_t*)(ws + O_XB) + 2 * 1024; const u64* rowss = (const u64*)(ws + O_ROWSS) + 2 * S;
    const float* Wg = a.in(17); const float* gn = a.in(16);
    LAS float* wgs = (LAS float*)lds;
    LAS float* pre = (LAS float*)(lds + 32768);
    float* GB = (float*)(ws + O_GB); float* GE = (float*)(ws + O_GE); float* GPM = (float*)(ws + O_GPM);
    float* BL = (float*)(ws + O_BL); float* ML = (float*)(ws + O_ML);
    for (int e = tid; e < 8192; e += 512) { const int k = e >> 3, j = e & 7; wgs[j * 1024 + k] = Wg[(size_t)k * 3080 + 3072 + j] * gn[k]; }
    __syncthreads();
    for (int c = blockIdx.x; c < 256; c += gridDim.x) {
#pragma unroll 4
        for (int i = 0; i < 8; ++i) { const int t = c * 64 + wave * 8 + i;
            float acc[8];
#pragma unroll
            for (int j = 0; j < 8; ++j) acc[j] = 0.f;
#pragma unroll
            for (int jj = 0; jj < 4; ++jj) { const int k0 = jj * 256 + lane * 4; const u32x2 hb = *(const u32x2*)(XBr + (size_t)t * 1024 + k0); const f32x4 hv = {bflo(hb.x), bfhi(hb.x), bflo(hb.y), bfhi(hb.y)};
#pragma unroll
                for (int j = 0; j < 8; ++j) { const f32x4 wj = *(const LAS f32x4*)(wgs + j * 1024 + k0); acc[j] += hv[0] * wj[0] + hv[1] * wj[1] + hv[2] * wj[2] + hv[3] * wj[3]; } }
            const float rs = rs_from_ss(rowss[t]);
            { const bool b5 = lane & 32, b4 = lane & 16, b3 = lane & 8;
#pragma unroll
              for (int j = 0; j < 4; ++j) { const float snd = b5 ? acc[j] : acc[j + 4], kp = b5 ? acc[j + 4] : acc[j]; acc[j] = kp + __shfl_xor(snd, 32); }
#pragma unroll
              for (int j = 0; j < 2; ++j) { const float snd = b4 ? acc[j] : acc[j + 2], kp = b4 ? acc[j + 2] : acc[j]; acc[j] = kp + __shfl_xor(snd, 16); }
              { const float snd = b3 ? acc[0] : acc[1], kp = b3 ? acc[1] : acc[0]; acc[0] = kp + __shfl_xor(snd, 8); }
              acc[0] += __shfl_xor(acc[0], 4); acc[0] += __shfl_xor(acc[0], 2); acc[0] += __shfl_xor(acc[0], 1);
              if ((lane & 7) == 0) pre[(wave * 8 + i) * 8 + (b5 ? 4 : 0) + (b4 ? 2 : 0) + (b3 ? 1 : 0)] = acc[0] * rs; }
        }
        __syncthreads();
        if (wave < 4) { const int h = wave; const float bi = a.in(18)[h], bfg = a.in(19)[h];
            const float ig = 15.f * tanhf((pre[lane * 8 + h] + bi) * (1.f / 15.f));
            const float fg = 15.f * tanhf((pre[lane * 8 + 4 + h] + bfg) * (1.f / 15.f));
            float b = -log1pf(expf(-fg));
#pragma unroll
            for (int o = 1; o < 64; o <<= 1) { const float v = __shfl_up(b, o); if (lane >= o) b += v; }
            const float e = ig - b; float pm = e;
#pragma unroll
            for (int o = 1; o < 64; o <<= 1) { const float v = __shfl_up(pm, o); if (lane >= o) pm = fmaxf(pm, v); }
            const size_t o_ = (size_t)h * S + c * 64 + lane; GB[o_] = b; GE[o_] = e; GPM[o_] = pm;
            if (lane == 63) { BL[c * 4 + h] = b; ML[c * 4 + h] = b + pm; } }
        __syncthreads();
    }
}
DI void phase_m_dc(int wv, const ArgP a) {
    unsigned char* ws = a.ws(); const int tid = ltid(wv), lane = tid & 63, r32 = lane & 31, hi = lane >> 5; const int w = __builtin_amdgcn_readfirstlane(tid >> 6);
    const float* __restrict__ BL = (const float*)(ws + O_BL); const float* __restrict__ ML = (const float*)(ws + O_ML); float* __restrict__ NST = (float*)(ws + O_NST);
    const float* __restrict__ GE = (const float*)(ws + O_GE); const bf16_t* __restrict__ KVT = (const bf16_t*)(ws + O_KVT); bf16_t* __restrict__ CST = (bf16_t*)(ws + O_CST);
#pragma unroll 2
    for (int u = blockIdx.x; u < 1024; u += gridDim.x) {
        const int c = u >> 2, h = u & 3; const size_t t0 = (size_t)c * 64;
        const float emax = ML[c * 4 + h] - BL[c * 4 + h];
        bf16x8 bfr[4];
        { const bf16_t* vp = KVT + (size_t)(512 + h * 256 + 32 * w + r32) * S + t0 + 8 * hi; const float* gp = GE + (size_t)h * S + t0 + 8 * hi;
#pragma unroll
          for (int ks = 0; ks < 4; ++ks) { const u32x4 v = *(const u32x4*)(vp + 16 * ks); const f32x4 e0 = *(const f32x4*)(gp + 16 * ks), e1 = *(const f32x4*)(gp + 16 * ks + 4);
              u32x4 o; o.x = pk2(bflo(v.x) * fexp(e0[0] - emax), bfhi(v.x) * fexp(e0[1] - emax)); o.y = pk2(bflo(v.y) * fexp(e0[2] - emax), bfhi(v.y) * fexp(e0[3] - emax));
              o.z = pk2(bflo(v.z) * fexp(e1[0] - emax), bfhi(v.z) * fexp(e1[1] - emax)); o.w = pk2(bflo(v.w) * fexp(e1[2] - emax), bfhi(v.w) * fexp(e1[3] - emax));
              bfr[ks] = __builtin_bit_cast(bf16x8, o); } }
        const bf16_t* kp = KVT + (size_t)(h * 128 + r32) * S + t0 + 8 * hi;
        bf16_t* op = CST + ((size_t)(c * 4 + h) * 256 + 32 * w + r32) * 128 + 4 * hi;
#pragma unroll
        for (int rb = 0; rb < 4; ++rb) { f32x16 acc = {};
#pragma unroll
            for (int ks = 0; ks < 4; ++ks) { const bf16x8 ka = *(const bf16x8*)(kp + (size_t)(32 * rb) * S + 16 * ks); acc = __builtin_amdgcn_mfma_f32_32x32x16_bf16(ka, bfr[ks], acc, 0, 0, 0); }
#pragma unroll
            for (int g = 0; g < 4; ++g) { u32x2 o; o.x = pk2(acc[4 * g], acc[4 * g + 1]); o.y = pk2(acc[4 * g + 2], acc[4 * g + 3]); *(u32x2*)(op + 32 * rb + 8 * g) = o; } }
        if (tid < 128) { const bf16_t* kr = KVT + (size_t)(h * 128 + tid) * S + t0; const float* gp = GE + (size_t)h * S + t0; float s = 0.f;
#pragma unroll
            for (int p = 0; p < 8; ++p) { const u32x4 v = *(const u32x4*)(kr + 8 * p); const f32x4 e0 = *(const f32x4*)(gp + 8 * p), e1 = *(const f32x4*)(gp + 8 * p + 4);
                s += bflo(v.x) * fexp(e0[0] - emax) + bfhi(v.x) * fexp(e0[1] - emax) + bflo(v.y) * fexp(e0[2] - emax) + bfhi(v.y) * fexp(e0[3] - emax)
                   + bflo(v.z) * fexp(e1[0] - emax) + bfhi(v.z) * fexp(e1[1] - emax) + bflo(v.w) * fexp(e1[2] - emax) + bfhi(v.w) * fexp(e1[3] - emax); }
            NST[(size_t)(c * 4 + h) * 128 + tid] = s; }
    }
}
DI void phase_m_comb(int wv, const ArgP a, LAS unsigned char* lds, int dry) {
    unsigned char* ws = a.ws(); const int tid = ltid(wv);
    const float* BL = (const float*)(ws + O_BL); const float* ML = (const float*)(ws + O_ML); float* MST = (float*)(ws + O_MST); float* NST = (float*)(ws + O_NST);
    bf16_t* CST = (bf16_t*)(ws + O_CST);
    LAS float* bls = (LAS float*)lds; LAS float* mls = bls + 1024; LAS float* ga = mls + 1024; LAS float* gb = ga + 1024;
    for (int e = tid; e < 1024; e += 512) { bls[e] = BL[e]; mls[e] = ML[e]; }
    __syncthreads();
    if (tid < 256) { const int h = tid >> 6, l = tid & 63;
        float a_ = 0.f, b_ = -1e30f;
#pragma unroll
        for (int k = 0; k < 4; ++k) { const float bl = bls[(4 * l + k) * 4 + h], ml = mls[(4 * l + k) * 4 + h]; a_ += bl; b_ = fmaxf(b_ + bl, ml); }
        float pa = a_, pb = b_;
#pragma unroll
        for (int o = 1; o < 64; o <<= 1) { const float qa = __shfl_up(pa, o), qb = __shfl_up(pb, o); if (l >= o) { pb = fmaxf(qb + pa, pb); pa = qa + pa; } }
        float ea = __shfl_up(pa, 1), eb_ = __shfl_up(pb, 1); if (l == 0) { ea = 0.f; eb_ = -1e30f; }
        float m = fmaxf(0.f + ea, eb_);
#pragma unroll
        for (int k = 0; k < 4; ++k) { const int c = 4 * l + k; const float bl = bls[c * 4 + h], ml = mls[c * 4 + h]; const float mn = fmaxf(bl + m, ml);
            ga[c * 4 + h] = fexp(bl + m - mn); gb[c * 4 + h] = fexp(ml - mn);
            if (blockIdx.x == 0 && !dry) MST[c * 4 + h] = m;
            m = mn; } }
    __syncthreads();
    for (int eb = blockIdx.x; eb < 129; eb += gridDim.x) {
        if (eb < 128) { const int h = eb >> 5; unsigned* p = (unsigned*)(CST + (size_t)h * 32768 + (size_t)(eb & 31) * 1024 + 2 * tid); float C0 = 0.f, C1 = 0.f;
            for (int c = 0; c < 256; c += 64) { unsigned d[64];
#pragma unroll
                for (int k = 0; k < 64; ++k) d[k] = p[(size_t)(c + k) * 65536];
#pragma unroll
                for (int k = 0; k < 64; ++k) { if (!dry) p[(size_t)(c + k) * 65536] = pk2(C0, C1); const float a_ = ga[(c + k) * 4 + h], b_ = gb[(c + k) * 4 + h]; C0 = a_ * C0 + b_ * bflo(d[k]); C1 = a_ * C1 + b_ * bfhi(d[k]); } }
        } else { const int h = tid >> 7; float* p = NST + tid; float C = 0.f;
            for (int c = 0; c < 256; c += 8) { float d[8];
#pragma unroll
                for (int k = 0; k < 8; ++k) d[k] = p[(size_t)(c + k) * 512];
#pragma unroll
                for (int k = 0; k < 8; ++k) { if (!dry) p[(size_t)(c + k) * 512] = C; C = ga[(c + k) * 4 + h] * C + gb[(c + k) * 4 + h] * d[k]; } } }
    }
    __syncthreads();
}
constexpr int MC_QROW = 272, MC_SROW = 144;
constexpr int MC_QS = 0, MC_KS = 64 * MC_QROW, MC_SC = 2 * 64 * MC_QROW, MC_F = MC_SC + 64 * MC_SROW;
DI void phase_m_out(int wv, const ArgP a, LAS unsigned char* lds, int dry) {
    unsigned char* ws = a.ws(); const int tid = ltid(wv), lane = tid & 63, r32 = lane & 31, hi = lane >> 5; const int w = __builtin_amdgcn_readfirstlane(tid >> 6);
    bf16_t* QOK = (bf16_t*)(ws + O_QOK); const bf16_t* KVT = (const bf16_t*)(ws + O_KVT); const bf16_t* CST = (const bf16_t*)(ws + O_CST);
    const float* GB = (const float*)(ws + O_GB); const float* GE = (const float*)(ws + O_GE); const float* GPM = (const float*)(ws + O_GPM);
    const float* MST = (const float*)(ws + O_MST); const float* NST = (const float*)(ws + O_NST); const float* ong = a.in(20);
    LAS unsigned char* Qs = lds + MC_QS; LAS unsigned char* Ks = lds + MC_KS; LAS unsigned char* Sc = lds + MC_SC;
    LAS float* F = (LAS float*)(lds + MC_F);
    LAS float* f_b = F, *f_e = F + 64, *f_m = F + 128, *f_g = F + 192, *f_qn = F + 256, *f_ps = F + 320  , *f_n = F + 576  , *f_part = F + 704  ;
    for (int u = blockIdx.x; u < 1024; u += gridDim.x) {
        const int c = u >> 2, h = u & 3; const size_t t0 = (size_t)c * 64;
        for (int e = tid; e < 1024; e += 512) { const int r = e >> 4, p = e & 15;
            *(LAS u32x4*)(Qs + r * MC_QROW + p * 16) = *(const u32x4*)(QOK + (t0 + r) * 2048 + h * 128 + p * 8);
            *(LAS u32x4*)(Ks + r * MC_QROW + p * 16) = *(const u32x4*)(QOK + (t0 + r) * 2048 + 1536 + h * 128 + p * 8); }
        if (tid < 64) { const float mstv = MST[c * 4 + h]; const float b = GB[(size_t)h * S + t0 + tid], e = GE[(size_t)h * S + t0 + tid], pm = GPM[(size_t)h * S + t0 + tid];
            const float m = b + fmaxf(mstv, pm); f_b[tid] = b; f_e[tid] = e; f_m[tid] = m; f_g[tid] = fexp(b + mstv - m); }
        if (tid >= 64 && tid < 192) f_n[tid - 64] = NST[(size_t)(c * 4 + h) * 128 + tid - 64];
        __syncthreads();
        if (w < 4) {
            const int sb = w & 1, tb = w >> 1; const int tl = 32 * tb + r32;
            f32x16 x = {};
#pragma unroll
            for (int ks = 0; ks < 8; ++ks) {
                const bf16x8 ka = *(const LAS bf16x8*)(Ks + (32 * sb + r32) * MC_QROW + (16 * ks + 8 * hi) * 2);
                const bf16x8 qb = *(const LAS bf16x8*)(Qs + tl * MC_QROW + (16 * ks + 8 * hi) * 2);
                x = __builtin_amdgcn_mfma_f32_32x32x16_bf16(ka, qb, x, 0, 0, 0); }
            const float bt = f_b[tl], mt = f_m[tl]; float ps = 0.f;
#pragma unroll
            for (int g = 0; g < 4; ++g) { float v[4];
#pragma unroll
                for (int j = 0; j < 4; ++j) { const int sl = 32 * sb + 8 * g + 4 * hi + j; const float wgt = (sl <= tl) ? fexp(bt + f_e[sl] - mt) : 0.f; v[j] = x[4 * g + j] * wgt; ps += v[j]; }
                u32x2 o; o.x = pk2(v[0], v[1]); o.y = pk2(v[2], v[3]);
                *(LAS u32x2*)(Sc + tl * MC_SROW + (32 * sb + 8 * g + 4 * hi) * 2) = o; }
            f_ps[(sb * 2 + hi) * 64 + tl] = ps;
        } else {
            const int tl = 16 * (w - 4) + (lane >> 2), qq = lane & 3; float s = 0.f;
#pragma unroll
            for (int p = 0; p < 4; ++p) { const u32x4 v = *(const LAS u32x4*)(Qs + tl * MC_QROW + (32 * qq + 8 * p) * 2); LAS float* np = f_n + 32 * qq + 8 * p;
                s += bflo(v.x) * np[0] + bfhi(v.x) * np[1] + bflo(v.y) * np[2] + bfhi(v.y) * np[3] + bflo(v.z) * np[4] + bfhi(v.z) * np[5] + bflo(v.w) * np[6] + bfhi(v.w) * np[7]; }
            s += __shfl_xor(s, 1); s += __shfl_xor(s, 2);
            if (qq == 0) f_qn[tl] = s;
        }
        __syncthreads();
        f32x16 acc0 = {}, acc1 = {};
        { const bf16_t* cp = CST + ((size_t)(c * 4 + h) * 256 + 32 * w + r32) * 128 + 8 * hi;
#pragma unroll
          for (int ks = 0; ks < 8; ++ks) { const bf16x8 ca = *(const bf16x8*)(cp + 16 * ks);
              const bf16x8 q0 = *(const LAS bf16x8*)(Qs + r32 * MC_QROW + (16 * ks + 8 * hi) * 2), q1 = *(const LAS bf16x8*)(Qs + (32 + r32) * MC_QROW + (16 * ks + 8 * hi) * 2);
              acc0 = __builtin_amdgcn_mfma_f32_32x32x16_bf16(ca, q0, acc0, 0, 0, 0); acc1 = __builtin_amdgcn_mfma_f32_32x32x16_bf16(ca, q1, acc1, 0, 0, 0); } }
        const float g0 = f_g[r32], g1 = f_g[32 + r32];
#pragma unroll
        for (int r = 0; r < 16; ++r) { acc0[r] *= g0; acc1[r] *= g1; }
        { const bf16_t* vp = KVT + (size_t)(512 + h * 256 + 32 * w + r32) * S + t0 + 8 * hi;
#pragma unroll
          for (int ks = 0; ks < 4; ++ks) { const bf16x8 va = *(const bf16x8*)(vp + 16 * ks);
              const bf16x8 s0 = *(const LAS bf16x8*)(Sc + r32 * MC_SROW + (16 * ks + 8 * hi) * 2), s1 = *(const LAS bf16x8*)(Sc + (32 + r32) * MC_SROW + (16 * ks + 8 * hi) * 2);
              acc0 = __builtin_amdgcn_mfma_f32_32x32x16_bf16(va, s0, acc0, 0, 0, 0); acc1 = __builtin_amdgcn_mfma_f32_32x32x16_bf16(va, s1, acc1, 0, 0, 0); } }
        float inv[2];
#pragma unroll
        for (int tb = 0; tb < 2; ++tb) { const int tl = 32 * tb + r32;
            const float den = f_g[tl] * f_qn[tl] + f_ps[tl] + f_ps[64 + tl] + f_ps[128 + tl] + f_ps[192 + tl];
            inv[tb] = 1.f / fmaxf(fabsf(den), fexp(-f_m[tl])); }
        float ss0 = 0.f, ss1 = 0.f;
#pragma unroll
        for (int r = 0; r < 16; ++r) { acc0[r] *= inv[0]; acc1[r] *= inv[1]; ss0 += acc0[r] * acc0[r]; ss1 += acc1[r] * acc1[r]; }
        ss0 += __shfl_xor(ss0, 32); ss1 += __shfl_xor(ss1, 32);
        if (hi == 0) { f_part[w * 64 + r32] = ss0; f_part[w * 64 + 32 + r32] = ss1; }
        __syncthreads();
        float rn[2];
#pragma unroll
        for (int tb = 0; tb < 2; ++tb) { float s = 0.f;
#pragma unroll
            for (int ww = 0; ww < 8; ++ww) s += f_part[ww * 64 + 32 * tb + r32];
            rn[tb] = rsqrtf(s * (1.f / 256.f) + EPS); }
#pragma unroll
        for (int tb = 0; tb < 2; ++tb) { bf16_t* op = QOK + (t0 + 32 * tb + r32) * 2048 + 512 + h * 256 + 32 * w;
#pragma unroll
            for (int g = 0; g < 4; ++g) { const int dv = 8 * g + 4 * hi; const u32x2 ov = *(const u32x2*)(op + dv);
                const f32x4 gg = *(const f32x4*)(ong + h * 256 + 32 * w + dv);
                const float og[4] = {bflo(ov.x), bfhi(ov.x), bflo(ov.y), bfhi(ov.y)}; float y[4];
#pragma unroll
                for (int j = 0; j < 4; ++j) { const float hv = (tb ? acc1[4 * g + j] : acc0[4 * g + j]) * rn[tb]; y[j] = hv * gg[j] * sigmoidf_(og[j]); }
                u32x2 o; o.x = pk2(y[0], y[1]); o.y = pk2(y[2], y[3]); if (!dry) *(u32x2*)(op + dv) = o; } }
        __syncthreads();
    }
}

DI void phase_final(int wv, const ArgP a) {
    float* out = a.out(); const u64* rowss = (const u64*)(a.ws() + O_ROWSS) + 4 * S; const float* g = a.in(27); const bf16_t* XBr = (const bf16_t*)(a.ws() + O_XB) + 2 * 1024;
    for (size_t e = (size_t)blockIdx.x * 512 + ltid(wv); e < (size_t)S * 128; e += (size_t)gridDim.x * 512) { const int t = (int)(e >> 7), c = (int)(e & 127) * 8;
        const float rs = rs_from_ss(rowss[t]); const u32x4 hb = __builtin_nontemporal_load((const u32x4*)(XBr + (size_t)t * 1024 + c)); const f32x4 g0 = *(const f32x4*)(g + c), g1 = *(const f32x4*)(g + c + 4);
        const f32x4 v0 = (f32x4){bflo(hb.x), bfhi(hb.x), bflo(hb.y), bfhi(hb.y)} * rs * g0, v1 = (f32x4){bflo(hb.z), bfhi(hb.z), bflo(hb.w), bfhi(hb.w)} * rs * g1;
        __builtin_nontemporal_store(v0, (f32x4*)(out + (size_t)t * 1024 + c)); __builtin_nontemporal_store(v1, (f32x4*)(out + (size_t)t * 1024 + c + 4)); }
}

#ifndef DIS
#define DIS 0u
#endif
#ifndef REP
#define REP 0u
#endif
#ifndef XSYNC
#define XSYNC 0
#endif

#define XB_TMO      128
#define XB_XCNT(j)  (256  + 64 * (j))
#define XB_XSUB(j)  (1280 + 64 * (j))
#define XB_XGEN(j)  (2304 + 64 * (j))
#define XB_TOP      3328
#define XB_TOPGEN   3392
#define XB_SPIN_CAP (1u << 18)
DI unsigned xb_ld(unsigned* p) { return __hip_atomic_load(p, __ATOMIC_RELAXED, __HIP_MEMORY_SCOPE_AGENT); }
DI unsigned xb_add(unsigned* p, unsigned v) { return __hip_atomic_fetch_add(p, v, __ATOMIC_RELAXED, __HIP_MEMORY_SCOPE_AGENT); }
DI unsigned xb_xcc_id() { return (unsigned)__builtin_amdgcn_s_getreg((3 << 11) | 20) & 0xFu; }
#define XB_SPIN(cond, bar) do { unsigned _sp = 0; while (cond) { __builtin_amdgcn_s_sleep(1); \
    if ((++_sp & 255u) == 0u) { if (xb_ld(&(bar)[XB_TMO])) break; if (_sp > XB_SPIN_CAP) { atomicAdd(&(bar)[XB_TMO], 1u); break; } } } } while (0)
DI void xcd_barrier_complete(unsigned* bar, unsigned x, unsigned& nloc, unsigned& nx) {
    const unsigned G = gridDim.x;
    unsigned sum, cnt, mine, sp = 0u;
    for (;;) {
        sum = 0u; cnt = 0u; mine = 0u;
#pragma unroll
        for (unsigned j = 0; j < 16; ++j) { const unsigned c = xb_ld(&bar[XB_XCNT(j)]); sum += c; cnt += (c > 0u) ? 1u : 0u; mine = (j == x) ? c : mine; }
        if (sum == G) break;
        __builtin_amdgcn_s_sleep(1);
        if ((++sp & 255u) == 0u) { if (xb_ld(&bar[XB_TMO])) break; if (sp > XB_SPIN_CAP) { atomicAdd(&bar[XB_TMO], 1u); break; } }
    }
    nloc = mine > 0u ? mine : 1u; nx = cnt > 0u ? cnt : 1u;
}
DI void xcd_barrier(int wv, unsigned* bar, volatile LAS unsigned* st) {
    asm volatile("s_waitcnt vmcnt(0)" ::: "memory");
    __syncthreads();
    if (ltid(wv) == 0) {
        const unsigned x = xb_xcc_id();
        __builtin_amdgcn_s_waitcnt(0);
        unsigned nloc = st[0], nx = st[1];
        if (nloc == 0u) { xcd_barrier_complete(bar, x, nloc, nx); st[0] = nloc; st[1] = nx; }
        const unsigned old = xb_add(&bar[XB_XSUB(x)], 1u);
        const unsigned gen = old / nloc;
        if (old + 1u == (gen + 1u) * nloc) {
            __builtin_amdgcn_fence(__ATOMIC_RELEASE, "agent");
            asm volatile("s_waitcnt vmcnt(0)" ::: "memory");
            const unsigned og = xb_add(&bar[XB_TOP], 1u);
            const unsigned tg = og / nx;
            if (og + 1u == (tg + 1u) * nx) xb_add(&bar[XB_TOPGEN], 1u);
            else XB_SPIN(xb_ld(&bar[XB_TOPGEN]) == tg, bar);
            __builtin_amdgcn_fence(__ATOMIC_ACQUIRE, "agent");
            xb_add(&bar[XB_XGEN(x)], 1u);
            asm volatile("s_waitcnt vmcnt(0)" ::: "memory");
        } else {
            XB_SPIN(xb_ld(&bar[XB_XGEN(x)]) == gen, bar);
            __builtin_amdgcn_fence(__ATOMIC_ACQUIRE, "agent");
            asm volatile("s_waitcnt vmcnt(0)" ::: "memory");
        }
    }
    __syncthreads();
}
DI ArgP getargs() { ArgP r; r.p = (const __attribute__((address_space(4))) Args*)__builtin_amdgcn_kernarg_segment_ptr(); asm volatile("" : "+s"(r.p)); return r; }
#define WSB (getargs().ws())
#define XBP ((bf16_t*)(getargs().ws() + O_XB) + 2 * 1024)
#define RSS ((u64*)(getargs().ws() + O_ROWSS))
#define HFP (getargs().out())
__global__ void __launch_bounds__(512, 2) fwd_kernel(Args a_unused) {
    extern __shared__ __attribute__((aligned(16))) unsigned char shm[];
    LAS unsigned char* lds = (LAS unsigned char*)shm;
    const int wv = __builtin_amdgcn_readfirstlane(threadIdx.x >> 6);
#define BARW ((unsigned*)(getargs().ws() + O_BAR))
#define BARST ((volatile LAS unsigned*)(lds + 139264))
#define GSYNC() xcd_barrier(wv, BARW, BARST)
    { unsigned* barw0 = BARW; if (threadIdx.x == 0) { BARST[0] = 0u; BARST[1] = 0u; (void)xb_add(&barw0[XB_XCNT(xb_xcc_id())], 1u); } }
    if (getargs().p->pad == 0x7fffffff) cg::this_grid().sync();

#if !(DIS & (1u << 0))
    for (int rep_ = 0; rep_ < ((REP >> 0) & 1u) + 1; ++rep_) { const int dry_ = rep_ < (int)((REP >> 0) & 1u); (void)dry_;
    phase_prologue(wv, getargs(), lds, dry_ ? PROPART : 7);
    }
#endif
    GSYNC();
#if !(DIS & (1u << 1))
    for (int rep_ = 0; rep_ < ((REP >> 1) & 1u) + 1; ++rep_) { const int dry_ = rep_ < (int)((REP >> 1) & 1u); (void)dry_;
    { EpiRowBf16<1> E{(bf16_t*)(WSB + O_Z), 1536, RSS};
      pg8::gemm_phase<false>(wv, lds, XBP, 1024, (const bf16_t*)(WSB + O_W1T), 1024, 1024, 64, 6, E); }
    }
#endif
    GSYNC();
#if !(DIS & (1u << 2))
    for (int rep_ = 0; rep_ < ((REP >> 2) & 1u) + 1; ++rep_) { const int dry_ = rep_ < (int)((REP >> 2) & 1u); (void)dry_;
    phase_l0_prep(wv, getargs());
    }
#endif
    GSYNC();
#if !(DIS & (1u << 3))
    for (int rep_ = 0; rep_ < ((REP >> 3) & 1u) + 1; ++rep_) { const int dry_ = rep_ < (int)((REP >> 3) & 1u); (void)dry_;
    { EpiRowBf16<0> E{(bf16_t*)(WSB + O_RI), 1024, nullptr};
      pg8::gemm_phase<false, EpiRowBf16<0>, true>(wv, lds, (const bf16_t*)(WSB + O_XC), 512, (const bf16_t*)(WSB + O_WRIT), 512, 256, 64, 4, E); }
    }
#endif
#if !(DIS & (1u << 4))
    for (int rep_ = 0; rep_ < ((REP >> 4) & 1u) + 1; ++rep_) { const int dry_ = rep_ < (int)((REP >> 4) & 1u); (void)dry_;
    { EpiQ E{(bf16_t*)(WSB + O_QB), (const float*)(WSB + O_RSQ), (const float*)(WSB + O_CSTAB)};
      pg8::gemm_phase<false>(wv, lds, (const bf16_t*)(WSB + O_Z) + 1024, 1536, (const bf16_t*)(WSB + O_WQT), 256, 256, 64, 3, E); }
    }
#endif
#if !(DIS & (1u << 5))
    for (int rep_ = 0; rep_ < ((REP >> 5) & 1u) + 1; ++rep_) { const int dry_ = rep_ < (int)((REP >> 5) & 1u); (void)dry_;
    { EpiK E{(bf16_t*)(WSB + O_KB), (const float*)(WSB + O_RSKV)};
      pg8::gemm_phase<false>(wv, lds, (const bf16_t*)(WSB + O_Z) + 1280, 1536, (const bf16_t*)(WSB + O_WKT), 256, 256, 64, 2, E, 192); }
    }
#endif
#if !(DIS & (1u << 6))
    for (int rep_ = 0; rep_ < ((REP >> 6) & 1u) + 1; ++rep_) { const int dry_ = rep_ < (int)((REP >> 6) & 1u); (void)dry_;
    { EpiColBf16<2> E{(bf16_t*)(WSB + O_VT), S, (const float*)(WSB + O_RSKV)};
      pg8::gemm_phase<false>(wv, lds, (const bf16_t*)(WSB + O_WVT), 256, (const bf16_t*)(WSB + O_Z) + 1280, 1536, 256, 2, 64, E, 64); }
    }
#endif
    GSYNC();
#if !(DIS & (1u << 7))
    for (int rep_ = 0; rep_ < ((REP >> 7) & 1u) + 1; ++rep_) { const int dry_ = rep_ < (int)((REP >> 7) & 1u); (void)dry_;
    phase_lru_s1(wv, getargs());
    }
#endif
    GSYNC();
#if !(DIS & (1u << 8))
    for (int rep_ = 0; rep_ < ((REP >> 8) & 1u) + 1; ++rep_) { const int dry_ = rep_ < (int)((REP >> 8) & 1u); (void)dry_;
    phase_lru_s3(wv, getargs());
    }
#endif
#if !(DIS & (1u << 9))
    for (int rep_ = 0; rep_ < ((REP >> 9) & 1u) + 1; ++rep_) { const int dry_ = rep_ < (int)((REP >> 9) & 1u); (void)dry_;
    phase_attn(wv, getargs(), lds);
    }
#endif
    GSYNC();
#if !(DIS & (1u << 10))
    for (int rep_ = 0; rep_ < ((REP >> 10) & 1u) + 1; ++rep_) { const int dry_ = rep_ < (int)((REP >> 10) & 1u); (void)dry_;
    { EpiRes<false> E{getargs().in(0), XBP, RSS + 1 * S, dry_};
      pg8::gemm_phase<false>(wv, lds, (const bf16_t*)(WSB + O_MIX), 1024, (const bf16_t*)(WSB + O_WO1T), 1024, 1024, 64, 4, E); }
    }
#endif
    GSYNC();
#if !(DIS & (1u << 11))
    for (int rep_ = 0; rep_ < ((REP >> 11) & 1u) + 1; ++rep_) { const int dry_ = rep_ < (int)((REP >> 11) & 1u); (void)dry_;
    { EpiUp E{(bf16_t*)(WSB + O_ACT), RSS + 1 * S, getargs().in(24), getargs().in(25), lds + 131072};
      pg8::gemm_phase<true>(wv, lds, XBP, 1024, (const bf16_t*)(WSB + O_WUPT0), 1024, 1024, 67, 22, E); }
    }
#endif
    GSYNC();
#if !(DIS & (1u << 12))
    for (int rep_ = 0; rep_ < ((REP >> 12) & 1u) + 1; ++rep_) { const int dry_ = rep_ < (int)((REP >> 12) & 1u); (void)dry_;
    { EpiRes<true> E{nullptr, XBP, RSS + 2 * S, dry_};
      pg8::gemm_phase<false>(wv, lds, (const bf16_t*)(WSB + O_ACT), 2816, (const bf16_t*)(WSB + O_WDNT0), 2816, 2816, 64, 4, E); }
    }
#endif
    GSYNC();
#if !(DIS & (1u << 13))
    for (int rep_ = 0; rep_ < ((REP >> 13) & 1u) + 1; ++rep_) { const int dry_ = rep_ < (int)((REP >> 13) & 1u); (void)dry_;
    { EpiQOK E{(bf16_t*)(WSB + O_QOK), RSS + 2 * S, (bf16_t*)(WSB + O_KVT)};
      pg8::gemm_phase<false>(wv, lds, XBP, 1024, (const bf16_t*)(WSB + O_WOINT), 1024, 1024, 64, 8, E); }
    }
#endif
#if !(DIS & (1u << 14))
    for (int rep_ = 0; rep_ < ((REP >> 14) & 1u) + 1; ++rep_) { const int dry_ = rep_ < (int)((REP >> 14) & 1u); (void)dry_;
    { EpiColBf16<1> E{(bf16_t*)(WSB + O_KVT) + (size_t)512 * S, S, RSS + 2 * S};
      pg8::gemm_phase<false>(wv, lds, (const bf16_t*)(WSB + O_WOINT) + (size_t)2048 * 1024, 1024, XBP, 1024, 1024, 4, 64, E); }
    }
#endif
#if !(DIS & (1u << 15))
    for (int rep_ = 0; rep_ < ((REP >> 15) & 1u) + 1; ++rep_) { const int dry_ = rep_ < (int)((REP >> 15) & 1u); (void)dry_;
    phase_m_gates(wv, getargs(), lds);
    }
#endif
    GSYNC();
#if !(DIS & (1u << 16))
    for (int rep_ = 0; rep_ < ((REP >> 16) & 1u) + 1; ++rep_) { const int dry_ = rep_ < (int)((REP >> 16) & 1u); (void)dry_;
    phase_m_dc(wv, getargs());
    }
#endif
    GSYNC();
#if !(DIS & (1u << 22))
    for (int rep_ = 0; rep_ < ((REP >> 22) & 1u) + 1; ++rep_) { const int dry_ = rep_ < (int)((REP >> 22) & 1u); (void)dry_;
    phase_m_comb(wv, getargs(), lds, dry_);
    }
#endif
    GSYNC();
#if !(DIS & (1u << 17))
    for (int rep_ = 0; rep_ < ((REP >> 17) & 1u) + 1; ++rep_) { const int dry_ = rep_ < (int)((REP >> 17) & 1u); (void)dry_;
    phase_m_out(wv, getargs(), lds, dry_);
    }
#endif
    GSYNC();
#if !(DIS & (1u << 18))
    for (int rep_ = 0; rep_ < ((REP >> 18) & 1u) + 1; ++rep_) { const int dry_ = rep_ < (int)((REP >> 18) & 1u); (void)dry_;
    { EpiRes<true> E{nullptr, XBP, RSS + 3 * S, dry_};
      pg8::gemm_phase<false>(wv, lds, (const bf16_t*)(WSB + O_QOK) + 512, 2048, (const bf16_t*)(WSB + O_WO2T), 1024, 1024, 64, 4, E); }
    }
#endif
    GSYNC();
#if !(DIS & (1u << 19))
    for (int rep_ = 0; rep_ < ((REP >> 19) & 1u) + 1; ++rep_) { const int dry_ = rep_ < (int)((REP >> 19) & 1u); (void)dry_;
    { EpiUp E{(bf16_t*)(WSB + O_ACT), RSS + 3 * S, getargs().in(24) + 3 * 5632, getargs().in(25) + 5632, lds + 131072};
      pg8::gemm_phase<true>(wv, lds, XBP, 1024, (const bf16_t*)(WSB + O_WUPT1), 1024, 1024, 67, 22, E); }
    }
#endif
    GSYNC();
#if !(DIS & (1u << 20))
    for (int rep_ = 0; rep_ < ((REP >> 20) & 1u) + 1; ++rep_) { const int dry_ = rep_ < (int)((REP >> 20) & 1u); (void)dry_;
    { EpiRes<true> E{nullptr, XBP, RSS + 4 * S, dry_};
      pg8::gemm_phase<false>(wv, lds, (const bf16_t*)(WSB + O_ACT), 2816, (const bf16_t*)(WSB + O_WDNT1), 2816, 2816, 64, 4, E); }
    }
#endif
    GSYNC();
#if !(DIS & (1u << 21))
    for (int rep_ = 0; rep_ < ((REP >> 21) & 1u) + 1; ++rep_) { const int dry_ = rep_ < (int)((REP >> 21) & 1u); (void)dry_;
    phase_final(wv, getargs());
    }
#endif
    for (int i = 0; i < XSYNC; ++i) GSYNC();
}

extern "C" void kernel_launch(void* const* d_in, const int* in_sizes, int n_in, void* d_out, int out_size, void* d_ws, size_t ws_size, hipStream_t stream) {
    static int grid = 0;
    if (grid == 0) {
        if (n_in != 28 || out_size != S * 1024 || ws_size < WS_NEED) { fprintf(stderr, "kernel_launch: unexpected shapes (n_in %d out %d ws %zu need %zu)\n", n_in, out_size, ws_size, (size_t)WS_NEED); grid = -1; return; }
        int dev = 0, cus = 0, per_cu = 0;
        (void)hipGetDevice(&dev);
        (void)hipDeviceGetAttribute(&cus, hipDeviceAttributeMultiprocessorCount, dev);
        if (hipFuncSetAttribute((const void*)fwd_kernel, hipFuncAttributeMaxDynamicSharedMemorySize, LDS_BYTES) != hipSuccess) { fprintf(stderr, "kernel_launch: hipFuncSetAttribute failed\n"); grid = -1; return; }
        if (hipOccupancyMaxActiveBlocksPerMultiprocessor(&per_cu, (const void*)fwd_kernel, 512, LDS_BYTES) != hipSuccess || per_cu < 1) { fprintf(stderr, "kernel_launch: occupancy query says %d\n", per_cu); per_cu = 1; }
        (void)hipGetLastError();
        grid = cus * 1;
        if (grid > 256) grid = 256;
    }
    if (grid < 0) return;
    Args a{};
    for (int i = 0; i < 28; ++i) a.in[i] = (const float*)d_in[i];
    a.out = (float*)d_out; a.ws = (unsigned char*)d_ws;
    if (hipMemsetAsync((char*)d_ws + O_BAR, 0, BAR_BYTES, stream) != hipSuccess) { fprintf(stderr, "kernel_launch: memset failed\n"); return; }
    void* args[] = {&a};
    hipError_t e = hipLaunchCooperativeKernel((void*)fwd_kernel, dim3(grid), dim3(512), args, LDS_BYTES, stream);
    if (e != hipSuccess) fprintf(stderr, "kernel_launch: cooperative launch failed: %s (grid %d)\n", hipGetErrorString(e), grid);
}
```

```cpp
#include <hip/hip_runtime.h>
#include <hip/hip_cooperative_groups.h>
#include <cstdio>
#include <cstdint>
namespace cg = cooperative_groups;

typedef unsigned short bf16_t;
typedef short bf16x8 __attribute__((ext_vector_type(8)));
typedef short s16x4 __attribute__((ext_vector_type(4)));
typedef float f32x2 __attribute__((ext_vector_type(2)));
typedef float f32x4 __attribute__((ext_vector_type(4)));
typedef float f32x16 __attribute__((ext_vector_type(16)));
typedef unsigned u32x2 __attribute__((ext_vector_type(2)));
typedef unsigned u32x4 __attribute__((ext_vector_type(4)));
typedef __bf16 bf16x2_t __attribute__((ext_vector_type(2)));
#define LAS __attribute__((address_space(3)))
#define DI __device__ __forceinline__

constexpr int S = 16384;
constexpr float EPS = 1e-6f;
constexpr float LOG2E = 1.4426950408889634f;

constexpr size_t SZ_WUPT = (size_t)5632 * 1024 * 2, SZ_WDNT = (size_t)1024 * 2816 * 2;
constexpr size_t O_WUPT1 = 0;
constexpr size_t O_WDNT1 = O_WUPT1 + SZ_WUPT;
constexpr size_t O_WOINT = O_WDNT1 + SZ_WDNT;
constexpr size_t O_WO2T = O_WOINT + (size_t)3072 * 1024 * 2;
constexpr size_t O_ROWSS = O_WO2T + (size_t)1024 * 1024 * 2;
constexpr size_t O_RSQ = O_ROWSS + (size_t)5 * S * 8;
constexpr size_t O_RSKV = O_RSQ + (size_t)S * 4;
constexpr size_t O_CSTAB = O_RSKV + (size_t)S * 4;
constexpr size_t O_CHA = O_CSTAB + (size_t)S * 32 * 4;
constexpr size_t O_CHH = O_CHA + (size_t)256 * 512 * 4;
constexpr size_t O_GB = O_CHH + (size_t)256 * 512 * 4;
constexpr size_t O_GE = O_GB + (size_t)4 * S * 4;
constexpr size_t O_GPM = O_GE + (size_t)4 * S * 4;
constexpr size_t O_BL = O_GPM + (size_t)4 * S * 4;
constexpr size_t O_ML = O_BL + 4096;
constexpr size_t O_MST = O_ML + 4096;
constexpr size_t O_NST = O_MST + 4096;
constexpr size_t O_BAR = O_NST + (size_t)256 * 4 * 128 * 4;
constexpr size_t BAR_BYTES = 16384;
constexpr size_t O_XB = O_BAR + BAR_BYTES;
constexpr size_t XB_ROWS = 16648;
constexpr size_t O_L0W = O_XB + XB_ROWS * 2048;
constexpr size_t O_W1T = O_L0W;
constexpr size_t O_WQT = O_W1T + (size_t)1536 * 1024 * 2;
constexpr size_t O_WKT = O_WQT + (size_t)768 * 256 * 2;
constexpr size_t O_WVT = O_WKT + (size_t)512 * 256 * 2;
constexpr size_t O_WRIT = O_WVT + (size_t)512 * 256 * 2;
constexpr size_t O_WO1T = O_WRIT + (size_t)1024 * 512 * 2;
constexpr size_t O_WUPT0 = O_WO1T + (size_t)1024 * 1024 * 2;
constexpr size_t O_WDNT0 = O_WUPT0 + SZ_WUPT;
constexpr size_t O_ARENA = O_WDNT0 + SZ_WDNT;
constexpr size_t O_Z = O_ARENA;
constexpr size_t O_XC = O_Z + (size_t)S * 1536 * 2;
constexpr size_t O_QB = O_XC + (size_t)S * 512 * 2;
constexpr size_t O_KB = O_QB + (size_t)8 * S * 96 * 2;
constexpr size_t O_VT = O_KB + (size_t)8 * S * 96 * 2;
constexpr size_t O_MIX = O_VT + (size_t)512 * S * 2;
constexpr size_t O_END0 = O_MIX + (size_t)S * 1024 * 2;
constexpr size_t O_ACT = O_ARENA;
constexpr size_t O_RI = O_XB;
constexpr size_t O_CST = O_L0W;
constexpr size_t O_QOK = O_CST + (size_t)256 * 4 * 256 * 128 * 2;
constexpr size_t O_KVT = O_QOK + (size_t)S * 2048 * 2;
constexpr size_t O_END1 = O_KVT + (size_t)1536 * S * 2;
constexpr size_t WS_NEED = (O_END0 > O_END1 ? O_END0 : O_END1);
static_assert(WS_NEED <= (size_t)268435456, "workspace");
static_assert(O_ACT + (size_t)(S + 240) * 2816 * 2 <= (size_t)268435456, "act");

constexpr int LDS_BYTES = 147456;

struct Args {
    const float* in[28];
    float* out;
    unsigned char* ws;
    int pad; int pad2;
};

struct ArgP { const __attribute__((address_space(4))) Args* p;
    DI const float* in(int i) const { return p->in[i]; } DI float* out() const { return p->out; } DI unsigned char* ws() const { return p->ws; } };
DI unsigned pk2(float lo, float hi) { f32x2 v = {lo, hi}; bf16x2_t b = __builtin_convertvector(v, bf16x2_t); return __builtin_bit_cast(unsigned, b); }
DI bf16_t f2bf(float f) { return (bf16_t)(pk2(f, 0.f) & 0xffffu); }
DI int ltid(int wv) { asm volatile("" : "+s"(wv)); int l = __builtin_amdgcn_mbcnt_hi(~0u, __builtin_amdgcn_mbcnt_lo(~0u, 0u)); asm volatile("" : "+v"(l)); return wv * 64 + l; }
DI int lbid() { int t = blockIdx.x; asm volatile("" : "+s"(t)); return t; }
DI float bf2f(bf16_t b) { return __uint_as_float(((unsigned)b) << 16); }
DI float bflo(unsigned u) { return __uint_as_float(u << 16); }
DI float bfhi(unsigned u) { return __uint_as_float(u & 0xffff0000u); }
DI float wave_sum(float v) {
#pragma unroll
    for (int o = 1; o < 64; o <<= 1) v += __shfl_xor(v, o);
    return v;
}
DI float fexp(float x) { return __builtin_amdgcn_exp2f(x * LOG2E); }
DI float sigmoidf_(float x) { return __builtin_amdgcn_rcpf(1.f + fexp(-x)); }
DI int crow(int r, int hi) { return (r & 3) + 8 * (r >> 2) + 4 * hi; }
typedef unsigned long long u64;
DI float rs_from_ss(u64 ssq) { return rsqrtf((float)ssq * (1.f / (1048576.f * 1024.f)) + EPS); }
DI u64 ss_to_fix(float ss) { return (u64)(ss * 1048576.f); }

namespace pg8 {
constexpr int BM = 256, BK = 64, HALF = 128, HTB = HALF * BK * 2, STAGE_BYTES = 8 * HTB, NXCD = 8, WGM = 8;
DI int lds_byte(int r, int c) { const int st = (r >> 4) * 2 + (c >> 5), rr = r & 15, cc = c & 31, ob = rr * 64 + cc * 2; return st * 1024 + (ob ^ (((ob >> 9) & 1) << 5)); }
DI void stage_rc(int b, int& R, int& C) { const int st = b / 1024, sb = b % 1024, swz = sb ^ (((sb >> 9) & 1) << 5); R = (st >> 1) * 16 + swz / 64; C = (st & 1) * 32 + (swz % 64) / 2; }
DI int perm32(int rho) { const int n = rho >> 4, i = rho & 15; return 8 * (i >> 2) + 4 * n + (i & 3); }
struct Unit { int pm, pn; };
struct StaticOrder {
    int nM, nN, nwg, G, c;
    DI void init(int nM_, int nN_, int G_, int c_) { nM = nM_; nN = nN_; nwg = nM * nN; G = G_; c = c_; }
    DI bool next(int i, Unit& u) const {
        const long L = (long)i * G + c; if (L >= nwg) return false;
        int wgid = (int)L; { const int q = nwg / NXCD, r = nwg % NXCD, xcd = wgid % NXCD, off = wgid / NXCD; wgid = (xcd < r ? xcd * (q + 1) : r * (q + 1) + (xcd - r) * q) + off; }
        const int nig = WGM * nN, gid = wgid / nig, fm = gid * WGM, gsz = (nM - fm) < WGM ? (nM - fm) : WGM;
        u.pm = fm + ((wgid % nig) % gsz); u.pn = (wgid % nig) / gsz; return true;
    }
};

template <bool AMAP, class Epi, bool KOFS = false>
DI void gemm_phase(int wv, LAS unsigned char* lds, const bf16_t* A, int lda, const bf16_t* Bt, int ldb, int K_, int nM, int nN, const Epi& E, int rot = 0) {
    int K = K_; asm volatile("" : "+s"(K));
    const int tid = ltid(wv), wid = __builtin_amdgcn_readfirstlane(tid >> 6), lane = tid & 63, wr = wid >> 2, wc = wid & 3, fr = lane & 15, fq = lane >> 4;
    const int nt = K / BK;
    StaticOrder SO; { int c_ = lbid() - rot; if (c_ < 0) c_ += (int)gridDim.x; SO.init(nM, nN, (int)gridDim.x, c_); }
    unsigned voffA[2], voffB[2];
#pragma unroll
    for (int i = 0; i < 2; ++i) { int R, C; stage_rc(tid * 16 + i * 8192, R, C); const int Rb = (R & ~31) + perm32(R & 31);
        const int Ra = AMAP ? (62 * (R >> 6) + (R & 63) - 2) : R;
        voffA[i] = (unsigned)((Ra + (AMAP ? 2 : 0)) * lda + C) * 2u; voffB[i] = (unsigned)(Rb * ldb + C) * 2u; }
    const size_t kstep = (size_t)(BK * 2);
    const size_t hstepA = (size_t)(AMAP ? 124 : 128) * lda * 2, hstepB = (size_t)HALF * ldb * 2;
    const size_t tstepA = 2 * hstepA, tstepB = 2 * hstepB;
    const unsigned ldsw = (unsigned)wid * 1024u;
    const int aoff = lds_byte(wr * 64 + fr, fq * 8), boff = lds_byte(wc * 32 + fr, fq * 8);
#define PG8_SA(b, h) (((b) * 2 + (h)) * HTB)
#define PG8_SB(b, h) ((4 + (b) * 2 + (h)) * HTB)
#define PG8_STAGE(bufoff, gbase, voff) do { _Pragma("unroll") for (int _i = 0; _i < 2; ++_i) \
        __builtin_amdgcn_global_load_lds((const unsigned*)((const char*)(gbase) + (voff)[_i]), (LAS unsigned*)(lds + (bufoff) + ldsw + _i * 8192), 16, 0, 0); } while (0)
#define PG8_LDA(dst, b, h) do { _Pragma("unroll") for (int m = 0; m < 4; ++m) _Pragma("unroll") for (int k = 0; k < 2; ++k) dst[m][k] = *(const LAS bf16x8*)(lds + PG8_SA(b, h) + aoff + m * 2048 + k * 1024); } while (0)
#define PG8_LDB(dst, b, h) do { _Pragma("unroll") for (int n = 0; n < 2; ++n) _Pragma("unroll") for (int k = 0; k < 2; ++k) dst[n][k] = *(const LAS bf16x8*)(lds + PG8_SB(b, h) + boff + n * 2048 + k * 1024); } while (0)
#define PG8_MMA(ai, bj, At, Bt_) do { __builtin_amdgcn_s_setprio(1); _Pragma("unroll") for (int m = 0; m < 4; ++m) _Pragma("unroll") for (int n = 0; n < 2; ++n) _Pragma("unroll") for (int k = 0; k < 2; ++k) \
        acc[ai][bj][m][n] = __builtin_amdgcn_mfma_f32_16x16x32_bf16(Bt_[n][k], At[m][k], acc[ai][bj][m][n], 0, 0, 0); __builtin_amdgcn_s_setprio(0); } while (0)
#define PG8_WAIT_V(n) asm volatile("s_waitcnt vmcnt(" #n ")" ::: "memory")
#define PG8_WAIT_L(n) asm volatile("s_waitcnt lgkmcnt(" #n ")" ::: "memory")
#define PG8_BAR __builtin_amdgcn_s_barrier()
#define PG8_SCHED __builtin_amdgcn_sched_barrier(0)
    if (AMAP) A -= 2 * lda;
    Unit cur, nxt; int ui = 0;
    if (!SO.next(0, cur)) return;
    f32x4 acc[2][2][4][2];
#pragma unroll
    for (int a = 0; a < 2; ++a)
#pragma unroll
        for (int b = 0; b < 2; ++b)
#pragma unroll
            for (int m = 0; m < 4; ++m)
#pragma unroll
                for (int n = 0; n < 2; ++n) acc[a][b][m][n] = (f32x4){0.f, 0.f, 0.f, 0.f};
    bf16x8 At[4][2], B0[2][2], B1[2][2];
    const char* cA = (const char*)A + (size_t)cur.pm * tstepA + (KOFS ? (cur.pn & 1) * 512 : 0); const char* cB = (const char*)Bt + (size_t)cur.pn * tstepB + (KOFS ? (cur.pn & 1) * 512 : 0);
    PG8_STAGE(PG8_SB(0, 0), cB, voffB); PG8_STAGE(PG8_SB(0, 1), cB + hstepB, voffB); PG8_STAGE(PG8_SA(0, 0), cA, voffA); PG8_STAGE(PG8_SA(0, 1), cA + hstepA, voffA);
    if (wr == 1) PG8_BAR;
    PG8_WAIT_V(2); PG8_BAR;
    PG8_STAGE(PG8_SB(1, 0), cB + kstep, voffB); PG8_STAGE(PG8_SA(1, 0), cA + kstep, voffA); PG8_STAGE(PG8_SB(1, 1), cB + hstepB + kstep, voffB);
    PG8_WAIT_V(6); PG8_BAR;
    for (;;) {
        const bool has_next = SO.next(ui + 1, nxt);
        const char* nA = has_next ? (const char*)A + (size_t)nxt.pm * tstepA + (KOFS ? (nxt.pn & 1) * 512 : 0) : cA; const char* nB = has_next ? (const char*)Bt + (size_t)nxt.pn * tstepB + (KOFS ? (nxt.pn & 1) * 512 : 0) : cB;
        for (int t = 0; t < nt; t += 2) {
            const bool last = (t == nt - 2);
            const char* a1 = cA + (size_t)(t + 1) * kstep;
            const char* a2 = last ? nA : cA + (size_t)(t + 2) * kstep; const char* b2 = last ? nB : cB + (size_t)(t + 2) * kstep;
            const char* a3 = a2 + kstep; const char* b3 = b2 + kstep;
            PG8_LDB(B0, 0, 0); PG8_LDB(B1, 0, 1); PG8_SCHED; PG8_LDA(At, 0, 0); PG8_STAGE(PG8_SA(1, 1), a1 + hstepA, voffA);
            PG8_WAIT_V(8); PG8_WAIT_L(0); PG8_BAR; PG8_MMA(0, 0, At, B0); PG8_MMA(0, 1, At, B1); PG8_BAR; PG8_SCHED;
            PG8_LDA(At, 0, 1); PG8_STAGE(PG8_SB(0, 0), b2, voffB); PG8_STAGE(PG8_SB(0, 1), b2 + hstepB, voffB); PG8_STAGE(PG8_SA(0, 0), a2, voffA);
            PG8_WAIT_V(8); PG8_WAIT_L(0); PG8_BAR; PG8_MMA(1, 0, At, B0); PG8_MMA(1, 1, At, B1); PG8_BAR; PG8_SCHED;
            PG8_LDB(B0, 1, 0); PG8_LDB(B1, 1, 1); PG8_SCHED; PG8_LDA(At, 1, 0); PG8_STAGE(PG8_SA(0, 1), a2 + hstepA, voffA);
            PG8_WAIT_V(8); PG8_WAIT_L(0); PG8_BAR; PG8_MMA(0, 0, At, B0); PG8_MMA(0, 1, At, B1); PG8_BAR; PG8_SCHED;
            PG8_LDA(At, 1, 1); PG8_STAGE(PG8_SB(1, 0), b3, voffB); PG8_STAGE(PG8_SB(1, 1), b3 + hstepB, voffB); PG8_STAGE(PG8_SA(1, 0), a3, voffA);
            PG8_WAIT_V(8); PG8_WAIT_L(0); PG8_BAR; PG8_MMA(1, 0, At, B0); PG8_MMA(1, 1, At, B1); PG8_BAR; PG8_SCHED;
        }
        if (wr == 0) PG8_BAR;
        E(acc, cur, wr, wc, fr, fq);
        if (!has_next) break;
#pragma unroll
        for (int a = 0; a < 2; ++a)
#pragma unroll
            for (int b = 0; b < 2; ++b)
#pragma unroll
                for (int m = 0; m < 4; ++m)
#pragma unroll
                    for (int n = 0; n < 2; ++n) acc[a][b][m][n] = (f32x4){0.f, 0.f, 0.f, 0.f};
        cur = nxt; cA = nA; cB = nB; ++ui;
        if (wr == 1) PG8_BAR;
    }
    PG8_WAIT_V(0);
    PG8_BAR;
#undef PG8_SA
#undef PG8_SB
#undef PG8_STAGE
#undef PG8_LDA
#undef PG8_LDB
#undef PG8_MMA
#undef PG8_WAIT_V
#undef PG8_WAIT_L
#undef PG8_BAR
#undef PG8_SCHED
}
}
using pg8::Unit;
typedef f32x4 AccT[2][2][4][2];

template <int SMODE> struct EpiRowBf16 {
    bf16_t* O; int ldc; const void* sc;
    DI void operator()(const AccT& acc, const Unit& u, int wr, int wc, int fr, int fq) const {
        const int row0 = u.pm * 256 + wr * 64 + fr, col0 = u.pn * 256 + wc * 32 + 8 * fq;
#pragma unroll
        for (int ai = 0; ai < 2; ++ai)
#pragma unroll
            for (int m = 0; m < 4; ++m) { const int row = row0 + ai * 128 + m * 16;
                float s = 1.f; if (SMODE == 1) s = rs_from_ss(((const u64*)sc)[row]); if (SMODE == 2) s = ((const float*)sc)[row];
                bf16_t* rowp = O + (size_t)row * ldc + col0;
#pragma unroll
                for (int bj = 0; bj < 2; ++bj) { const f32x4 v0 = acc[ai][bj][m][0] * s, v1 = acc[ai][bj][m][1] * s;
                    u32x4 w; w.x = pk2(v0[0], v0[1]); w.y = pk2(v0[2], v0[3]); w.z = pk2(v1[0], v1[1]); w.w = pk2(v1[2], v1[3]);
                    *(u32x4*)(rowp + bj * 128) = w; } }
    }
};
struct EpiQOK {
    bf16_t* O; const void* sc; bf16_t* KT;
    DI void operator()(const AccT& acc, const Unit& u, int wr, int wc, int fr, int fq) const {
        const int row0 = u.pm * 256 + wr * 64 + fr, col0 = u.pn * 256 + wc * 32 + 8 * fq;
#pragma unroll
        for (int ai = 0; ai < 2; ++ai)
#pragma unroll
            for (int m = 0; m < 4; ++m) { const int row = row0 + ai * 128 + m * 16;
                const float s = rs_from_ss(((const u64*)sc)[row]);
                bf16_t* rowp = O + (size_t)row * 2048 + col0;
#pragma unroll
                for (int bj = 0; bj < 2; ++bj) { const f32x4 v0 = acc[ai][bj][m][0] * s, v1 = acc[ai][bj][m][1] * s;
                    u32x4 w; w.x = pk2(v0[0], v0[1]); w.y = pk2(v0[2], v0[3]); w.z = pk2(v1[0], v1[1]); w.w = pk2(v1[2], v1[3]);
                    *(u32x4*)(rowp + bj * 128) = w;
                    if (u.pn >= 6) { bf16_t* kt = KT + (size_t)(col0 + bj * 128 - 1536) * S + row;
                        kt[0] = (bf16_t)(w.x & 0xffffu); kt[(size_t)S] = (bf16_t)(w.x >> 16); kt[(size_t)2 * S] = (bf16_t)(w.y & 0xffffu); kt[(size_t)3 * S] = (bf16_t)(w.y >> 16);
                        kt[(size_t)4 * S] = (bf16_t)(w.z & 0xffffu); kt[(size_t)5 * S] = (bf16_t)(w.z >> 16); kt[(size_t)6 * S] = (bf16_t)(w.w & 0xffffu); kt[(size_t)7 * S] = (bf16_t)(w.w >> 16); } } }
    }
};
template <int SMODE> struct EpiColBf16 {
    bf16_t* O; int ldc; const void* sc;
    DI void operator()(const AccT& acc, const Unit& u, int wr, int wc, int fr, int fq) const {
        const int row0 = u.pm * 256 + wr * 64 + fr, col0 = u.pn * 256 + wc * 32 + 8 * fq;
#pragma unroll
        for (int bj = 0; bj < 2; ++bj) { float s[8];
#pragma unroll
            for (int j = 0; j < 8; ++j) s[j] = (SMODE == 1) ? rs_from_ss(((const u64*)sc)[col0 + bj * 128 + j]) : ((const float*)sc)[col0 + bj * 128 + j];
#pragma unroll
            for (int ai = 0; ai < 2; ++ai)
#pragma unroll
                for (int m = 0; m < 4; ++m) { const int row = row0 + ai * 128 + m * 16; const f32x4 v0 = acc[ai][bj][m][0], v1 = acc[ai][bj][m][1];
                    u32x4 w; w.x = pk2(v0[0] * s[0], v0[1] * s[1]); w.y = pk2(v0[2] * s[2], v0[3] * s[3]); w.z = pk2(v1[0] * s[4], v1[1] * s[5]); w.w = pk2(v1[2] * s[6], v1[3] * s[7]);
                    *(u32x4*)(O + (size_t)row * ldc + col0 + bj * 128) = w; } }
    }
};
struct EpiQ {
    bf16_t* QB; const float* rsq; const float* cstab;
    DI void operator()(const AccT& acc, const Unit& u, int wr, int wc, int fr, int fq) const {
        const int row0 = u.pm * 256 + wr * 64 + fr, col0 = u.pn * 256 + wc * 32 + 8 * fq;
        const float QS = 0.10206207261596577f * LOG2E;
#pragma unroll
        for (int ai = 0; ai < 2; ++ai)
#pragma unroll
            for (int m = 0; m < 4; ++m) { const int t = row0 + ai * 128 + m * 16; const float s = rsq[t] * QS;
#pragma unroll
                for (int bj = 0; bj < 2; ++bj) { const int c = col0 + bj * 128, h = c / 96, d = c - h * 96;
                    f32x4 v0 = acc[ai][bj][m][0] * s, v1 = acc[ai][bj][m][1] * s;
                    if (d >= 64) { const int i0 = (d - 64) >> 1; const f32x4 cs0 = *(const f32x4*)(cstab + (size_t)t * 32 + 2 * i0), cs1 = *(const f32x4*)(cstab + (size_t)t * 32 + 2 * i0 + 4);
                        f32x4 a, b;
                        a[0] = v0[0] * cs0[0] - v0[1] * cs0[1]; a[1] = v0[1] * cs0[0] + v0[0] * cs0[1];
                        a[2] = v0[2] * cs0[2] - v0[3] * cs0[3]; a[3] = v0[3] * cs0[2] + v0[2] * cs0[3];
                        b[0] = v1[0] * cs1[0] - v1[1] * cs1[1]; b[1] = v1[1] * cs1[0] + v1[0] * cs1[1];
                        b[2] = v1[2] * cs1[2] - v1[3] * cs1[3]; b[3] = v1[3] * cs1[2] + v1[2] * cs1[3];
                        v0 = a; v1 = b; }
                    u32x4 w; w.x = pk2(v0[0], v0[1]); w.y = pk2(v0[2], v0[3]); w.z = pk2(v1[0], v1[1]); w.w = pk2(v1[2], v1[3]);
                    *(u32x4*)(QB + ((size_t)h * S + t) * 96 + d) = w; } }
    }
};
struct EpiK {
    bf16_t* KB; const float* rskv;
    DI void operator()(const AccT& acc, const Unit& u, int wr, int wc, int fr, int fq) const {
        const int row0 = u.pm * 256 + wr * 64 + fr, col0 = u.pn * 256 + wc * 32 + 8 * fq;
#pragma unroll
        for (int ai = 0; ai < 2; ++ai)
#pragma unroll
            for (int m = 0; m < 4; ++m) { const int t = row0 + ai * 128 + m * 16; const float s = rskv[t];
#pragma unroll
                for (int bj = 0; bj < 2; ++bj) { const int c = col0 + bj * 128, h = c >> 6, d = c & 63;
                    const f32x4 v0 = acc[ai][bj][m][0] * s, v1 = acc[ai][bj][m][1] * s;
                    u32x4 w; w.x = pk2(v0[0], v0[1]); w.y = pk2(v0[2], v0[3]); w.z = pk2(v1[0], v1[1]); w.w = pk2(v1[2], v1[3]);
                    *(u32x4*)(KB + ((size_t)h * S + t) * 96 + d) = w; } }
    }
};
template <bool RESBF> struct EpiRes {
    const float* res; bf16_t* XB; u64* rowss; int dry;
    DI void operator()(const AccT& acc, const Unit& u, int wr, int wc, int fr, int fq) const {
        const int row0 = u.pm * 256 + wr * 64 + fr, col0 = u.pn * 256 + wc * 32 + 8 * fq;
#pragma unroll
        for (int ai = 0; ai < 2; ++ai)
#pragma unroll
            for (int m = 0; m < 4; ++m) { const int t = row0 + ai * 128 + m * 16; float ss = 0.f;
#pragma unroll
                for (int bj = 0; bj < 2; ++bj) { const size_t o = (size_t)t * 1024 + col0 + bj * 128;
                    f32x4 r0, r1;
                    if (RESBF) { const u32x4 rb = *(const u32x4*)(XB + o); r0 = (f32x4){bflo(rb.x), bfhi(rb.x), bflo(rb.y), bfhi(rb.y)}; r1 = (f32x4){bflo(rb.z), bfhi(rb.z), bflo(rb.w), bfhi(rb.w)}; }
                    else { r0 = __builtin_nontemporal_load((const f32x4*)(res + o)); r1 = __builtin_nontemporal_load((const f32x4*)(res + o + 4)); }
                    const f32x4 v0 = acc[ai][bj][m][0] + r0, v1 = acc[ai][bj][m][1] + r1;
                    u32x4 w; w.x = pk2(v0[0], v0[1]); w.y = pk2(v0[2], v0[3]); w.z = pk2(v1[0], v1[1]); w.w = pk2(v1[2], v1[3]);
                    if (!dry) *(u32x4*)(XB + o) = w;
                    ss += v0[0] * v0[0] + v0[1] * v0[1] + v0[2] * v0[2] + v0[3] * v0[3] + v1[0] * v1[0] + v1[1] * v1[1] + v1[2] * v1[2] + v1[3] * v1[3]; }
                ss += __shfl_xor(ss, 16); ss += __shfl_xor(ss, 32);
                if (fq == 0 && !dry) atomicAdd(rowss + t, ss_to_fix(ss)); }
    }
};
DI float dpp_prev1(float cur, float prevm) {
    const int o = __builtin_amdgcn_update_dpp(0, __builtin_bit_cast(int, prevm), 0x121, 0xf, 0xf, false);
    return __builtin_bit_cast(float, __builtin_amdgcn_update_dpp(o, __builtin_bit_cast(int, cur), 0x111, 0xf, 0xf, false));
}
DI float dpp_prev2(float cur, float prevm) {
    const int o = __builtin_amdgcn_update_dpp(0, __builtin_bit_cast(int, prevm), 0x122, 0xf, 0xf, false);
    return __builtin_bit_cast(float, __builtin_amdgcn_update_dpp(o, __builtin_bit_cast(int, cur), 0x112, 0xf, 0xf, false));
}
struct EpiUp {
    bf16_t* ACT; const u64* rowss; const float* cw; const float* cb; LAS unsigned char* plds;
    DI void operator()(const AccT& acc, const Unit& u, int wr, int wc, int fr, int fq) const {
        const int cl = u.pn * 128 + wc * 32 + 8 * fq;
        LAS float* P = (LAS float*)(plds + (wr * 4 + wc) * 1024);
        { const int lane = fq * 16 + fr, kind = lane >> 3, c4 = 4 * (lane & 7), k3 = kind & 3;
          const float* src = (k3 == 0 ? cb : cw + (k3 - 1) * 5632) + (kind >= 4 ? 2816 : 0) + u.pn * 128 + wc * 32 + c4;
          *(LAS f32x4*)(P + kind * 32 + c4) = *(const f32x4*)src; }
#pragma unroll
        for (int ai = 0; ai < 2; ++ai) {
            const int tok0 = u.pm * 248 + 62 * (2 * ai + wr) - 2 + fr;
            float rs[4];
#pragma unroll
            for (int m = 0; m < 4; ++m) { const int t = tok0 + 16 * m; const int tc = t < 0 ? 0 : (t >= S ? S - 1 : t); const float r = rs_from_ss(rowss[tc]); rs[m] = t < 0 ? 0.f : r; }
            const int row0 = fr < 2 ? (S + 236 + fr) : tok0;
#pragma unroll
            for (int n = 0; n < 2; ++n) {
                const int lc = 8 * fq + 4 * n;
                unsigned wpk[4][2];
#pragma unroll
                for (int jp = 0; jp < 2; ++jp) {
                    const f32x2 bg = *(const LAS f32x2*)(P + lc + 2 * jp), g0 = *(const LAS f32x2*)(P + 32 + lc + 2 * jp), g1 = *(const LAS f32x2*)(P + 64 + lc + 2 * jp), g2 = *(const LAS f32x2*)(P + 96 + lc + 2 * jp);
                    const f32x2 bv = *(const LAS f32x2*)(P + 128 + lc + 2 * jp), v0 = *(const LAS f32x2*)(P + 160 + lc + 2 * jp), v1 = *(const LAS f32x2*)(P + 192 + lc + 2 * jp), v2 = *(const LAS f32x2*)(P + 224 + lc + 2 * jp);
                    f32x2 G[4], V[4];
#pragma unroll
                    for (int m = 0; m < 4; ++m) { G[m] = (f32x2){acc[ai][0][m][n][2 * jp], acc[ai][0][m][n][2 * jp + 1]} * rs[m]; V[m] = (f32x2){acc[ai][1][m][n][2 * jp], acc[ai][1][m][n][2 * jp + 1]} * rs[m]; }
#pragma unroll
                    for (int m = 0; m < 4; ++m) {
                        const f32x2 zz = {0.f, 0.f}; const f32x2 Gp = m ? G[m - 1] : zz, Vp = m ? V[m - 1] : zz;
                        const f32x2 gp1 = {dpp_prev1(G[m].x, Gp.x), dpp_prev1(G[m].y, Gp.y)}, gp2 = {dpp_prev2(G[m].x, Gp.x), dpp_prev2(G[m].y, Gp.y)};
                        const f32x2 vp1 = {dpp_prev1(V[m].x, Vp.x), dpp_prev1(V[m].y, Vp.y)}, vp2 = {dpp_prev2(V[m].x, Vp.x), dpp_prev2(V[m].y, Vp.y)};
                        const f32x2 gc = bg + g0 * gp2 + g1 * gp1 + g2 * G[m];
                        const f32x2 vc = bv + v0 * vp2 + v1 * vp1 + v2 * V[m];
                        const f32x2 xe = gc * (-LOG2E);
                        f32x2 dn = {__builtin_amdgcn_exp2f(xe.x), __builtin_amdgcn_exp2f(xe.y)}; dn = dn + 1.0f;
                        const f32x2 rc = {__builtin_amdgcn_rcpf(dn.x), __builtin_amdgcn_rcpf(dn.y)};
                        const f32x2 rr = gc * rc * vc;
                        wpk[m][jp] = pk2(rr.x, rr.y); }
                }
#pragma unroll
                for (int m = 0; m < 4; ++m) { const int row = m ? tok0 + 16 * m : row0;
                    *(u32x2*)(ACT + (size_t)row * 2816 + cl + 4 * n) = (u32x2){wpk[m][0], wpk[m][1]}; }
                __builtin_amdgcn_sched_barrier(0);
            }
        }
    }
};

template <class F> DI void tr_items(const F& f, int Kdst, int Nrows, bf16_t* WT, LAS float* scr, int gw, int NGW, int lane, int& cum) {
    const int nblk = Nrows / 32, nitems = (Kdst / 64) * nblk;
    int first = (gw - cum) % NGW; if (first < 0) first += NGW; cum = (cum + nitems) % NGW;
    for (int item = first; item < nitems; item += NGW) {
        const int kb = item / nblk, nb = item % nblk, k0 = 64 * kb, n0 = 32 * nb;
        float tv[32];
#pragma unroll
        for (int i = 0; i < 32; ++i) tv[i] = f(k0 + 2 * i + (lane >> 5), n0 + (lane & 31));
#pragma unroll
        for (int i = 0; i < 32; ++i) scr[(2 * i + (lane >> 5)) * 33 + (lane & 31)] = tv[i];
        asm volatile("s_waitcnt lgkmcnt(0)" ::: "memory");
        const int c = lane & 7;
#pragma unroll
        for (int j = 0; j < 4; ++j) { const int n = (lane >> 3) + 8 * j; const LAS float* s = scr + (8 * c) * 33 + n;
            u32x4 o; o.x = pk2(s[0 * 33], s[1 * 33]); o.y = pk2(s[2 * 33], s[3 * 33]); o.z = pk2(s[4 * 33], s[5 * 33]); o.w = pk2(s[6 * 33], s[7 * 33]);
            *(u32x4*)(WT + (size_t)(n0 + n) * Kdst + k0 + 8 * c) = o; }
        asm volatile("s_waitcnt lgkmcnt(0)" ::: "memory");
    }
}
struct FW1 { const float* W; const float* g; DI float operator()(int k, int n) const { return n < 1440 ? __builtin_nontemporal_load(&W[(size_t)k * 1440 + n]) * g[k] : 0.f; } };
struct FWQ { const float* W; const float* g; DI float operator()(int k, int n) const { const int h = n / 96, d = n - h * 96; int c = d; if (d >= 64) { const int r = d - 64; c = 64 + (r >> 1) + 16 * (r & 1); } return __builtin_nontemporal_load(&W[(size_t)k * 768 + h * 96 + c]) * g[k]; } };
struct FWKV { const float* W; const float* g; int off; DI float operator()(int k, int n) const { return k < 128 ? __builtin_nontemporal_load(&W[(size_t)k * 1024 + (n >> 6) * 128 + off + (n & 63)]) * g[k] : 0.f; } };
struct FWRI { const float* Wa; const float* Wx; DI float operator()(int k, int n) const { const float* W = n < 512 ? Wa : Wx; const int ch = n & 511, g = ch >> 6, j = ch & 63; return (k >> 6) == g ? __builtin_nontemporal_load(&W[(size_t)k * 64 + j]) : 0.f; } };
struct FWP { const float* W; int N; DI float operator()(int k, int n) const { return __builtin_nontemporal_load(&W[(size_t)k * N + n]); } };
struct FWUP { const float* W; const float* g; DI float operator()(int k, int n) const { const int pn = n >> 8, r = n & 255; const int c = r < 128 ? 128 * pn + r : 2816 + 128 * pn + r - 128; return __builtin_nontemporal_load(&W[(size_t)k * 5632 + c]) * g[k]; } };
struct FWOIN { const float* W; const float* g; DI float operator()(int k, int n) const {
    int c; float s = 1.f; if (n < 512) { c = n; s = 0.08838834764831845f; } else if (n < 1536) c = 2048 + (n - 512); else if (n < 2048) c = 512 + (n - 1536); else c = 1024 + (n - 2048);
    return __builtin_nontemporal_load(&W[(size_t)k * 3080 + c]) * g[k] * s; } };

#ifndef PROPART
#define PROPART 7
#endif
DI void phase_prologue(int wv, const ArgP a, LAS unsigned char* lds, int parts) {
    unsigned char* ws = a.ws();
    const int tid = ltid(wv), wave = tid >> 6, lane = tid & 63;
    LAS float* scr = (LAS float*)(lds + wave * 8448);
    const int gw = blockIdx.x * 8 + wave, NGW = gridDim.x * 8; int cum = 0;
    if (parts & 1) {
    { FW1 f{a.in(3), a.in(2)}; tr_items(f, 1024, 1536, (bf16_t*)(ws + O_W1T), scr, gw, NGW, lane, cum); }
    { FWQ f{a.in(12), a.in(11)}; tr_items(f, 256, 768, (bf16_t*)(ws + O_WQT), scr, gw, NGW, lane, cum); }
    { FWKV f{a.in(14), a.in(13), 0}; tr_items(f, 256, 512, (bf16_t*)(ws + O_WKT), scr, gw, NGW, lane, cum); }
    { FWKV f{a.in(14), a.in(13), 64}; tr_items(f, 256, 512, (bf16_t*)(ws + O_WVT), scr, gw, NGW, lane, cum); }
    { FWRI f{a.in(6), a.in(8)}; tr_items(f, 512, 1024, (bf16_t*)(ws + O_WRIT), scr, gw, NGW, lane, cum); }
    { FWP f{a.in(15), 1024}; tr_items(f, 1024, 1024, (bf16_t*)(ws + O_WO1T), scr, gw, NGW, lane, cum); }
    for (int l = 0; l < 2; ++l) {
        { FWUP f{a.in(23) + (size_t)l * 1024 * 5632, a.in(22) + l * 1024}; tr_items(f, 1024, 5632, (bf16_t*)(ws + (l ? O_WUPT1 : O_WUPT0)), scr, gw, NGW, lane, cum); }
        { FWP f{a.in(26) + (size_t)l * 2816 * 1024, 1024}; tr_items(f, 2816, 1024, (bf16_t*)(ws + (l ? O_WDNT1 : O_WDNT0)), scr, gw, NGW, lane, cum); }
    }
    { FWOIN f{a.in(17), a.in(16)}; tr_items(f, 1024, 3072, (bf16_t*)(ws + O_WOINT), scr, gw, NGW, lane, cum); }
    { FWP f{a.in(21), 1024}; tr_items(f, 1024, 1024, (bf16_t*)(ws + O_WO2T), scr, gw, NGW, lane, cum); }
    }
    if (parts & 2) {
    const float* x = a.in(0); bf16_t* XB = (bf16_t*)(ws + O_XB) + 2 * 1024; u64* rowss = (u64*)(ws + O_ROWSS);
#pragma unroll 4
    for (int t = gw; t < S; t += NGW) {
        float ss = 0.f;
#pragma unroll
        for (int j = 0; j < 4; ++j) { const f32x4 v = __builtin_nontemporal_load((const f32x4*)(x + (size_t)t * 1024 + j * 256 + lane * 4));
            ss += v[0] * v[0] + v[1] * v[1] + v[2] * v[2] + v[3] * v[3];
            u32x2 w; w.x = pk2(v[0], v[1]); w.y = pk2(v[2], v[3]); *(u32x2*)(XB + (size_t)t * 1024 + j * 256 + lane * 4) = w; }
        ss = wave_sum(ss);
        if (lane == 0) rowss[t] = ss_to_fix(ss);
        if (lane >= 1 && lane < 5) rowss[(size_t)lane * S + t] = 0ull;
    }
    }
    if (parts & 4) {
    const int* pos = (const int*)a.in(1); float* cst = (float*)(ws + O_CSTAB);
    for (int e = blockIdx.x * 512 + tid; e < S * 16; e += gridDim.x * 512) { const int t = e >> 4, i = e & 15;
        const float invf = __builtin_amdgcn_exp2f(-(float)i * (13.287712379549449f / 16.f)); const float ang = (float)pos[t] * invf;
        const float k = rintf(ang * 0.15915494309189535f);
        float r = fmaf(-k, 6.28318548202514648f, ang); r = fmaf(-k, -1.7484555e-7f, r);
        const float rr = r * 0.15915494309189535f;
        cst[2 * e] = __builtin_amdgcn_cosf(rr); cst[2 * e + 1] = __builtin_amdgcn_sinf(rr); }
    }
}

DI void phase_l0_prep(int wv, const ArgP a) {
    unsigned char* ws = a.ws();
    const bf16_t* Z = (const bf16_t*)(ws + O_Z); bf16_t* XC = (bf16_t*)(ws + O_XC); bf16_t* KB = (bf16_t*)(ws + O_KB);
    float* rsq = (float*)(ws + O_RSQ); float* rskv = (float*)(ws + O_RSKV); const float* cst = (const float*)(ws + O_CSTAB);
    const float* cw = a.in(4); const float* cb = a.in(5);
    const int tid = ltid(wv), wave = tid >> 6, lane = tid & 63;
#pragma unroll 2
    for (int e = blockIdx.x * 512 + tid; e < S * 64; e += gridDim.x * 512) { const int t = e >> 6, c0 = (e & 63) * 8;
        float acc[8];
#pragma unroll
        for (int j = 0; j < 8; ++j) acc[j] = cb[c0 + j];
#pragma unroll
        for (int k = 0; k < 4; ++k) { const int tt = t - 3 + k; if (tt < 0) continue;
            const u32x4 v = *(const u32x4*)(Z + (size_t)tt * 1536 + c0);
            const f32x4 w0 = *(const f32x4*)(cw + k * 512 + c0), w1 = *(const f32x4*)(cw + k * 512 + c0 + 4);
            acc[0] += w0[0] * bflo(v.x); acc[1] += w0[1] * bfhi(v.x); acc[2] += w0[2] * bflo(v.y); acc[3] += w0[3] * bfhi(v.y);
            acc[4] += w1[0] * bflo(v.z); acc[5] += w1[1] * bfhi(v.z); acc[6] += w1[2] * bflo(v.w); acc[7] += w1[3] * bfhi(v.w); }
        u32x4 o; o.x = pk2(acc[0], acc[1]); o.y = pk2(acc[2], acc[3]); o.z = pk2(acc[4], acc[5]); o.w = pk2(acc[6], acc[7]);
        *(u32x4*)(XC + (size_t)t * 512 + c0) = o; }
#pragma unroll 4
    for (int t = blockIdx.x * 8 + wave; t < S; t += gridDim.x * 8) {
        const bf16_t* zr = Z + (size_t)t * 1536;
        float sq = 0.f, skv = 0.f;
        { const u32x2 v = *(const u32x2*)(zr + 1024 + lane * 4); const float p0 = bflo(v.x), p1 = bfhi(v.x), p2 = bflo(v.y), p3 = bfhi(v.y); sq = p0 * p0 + p1 * p1 + p2 * p2 + p3 * p3; }
        { const unsigned v = *(const unsigned*)(zr + 1280 + lane * 2); const float p0 = bflo(v), p1 = bfhi(v); skv = p0 * p0 + p1 * p1; }
        sq = wave_sum(sq); skv = wave_sum(skv);
        if (lane == 0) { rsq[t] = rsqrtf(sq * (1.f / 256.f) + EPS); rskv[t] = rsqrtf(skv * (1.f / 128.f) + EPS); }
        if (lane < 16) { const float x1 = bf2f(zr[1408 + lane]), x2 = bf2f(zr[1424 + lane]); const float c = cst[(size_t)t * 32 + 2 * lane], s = cst[(size_t)t * 32 + 2 * lane + 1];
            const unsigned w = pk2(x1 * c - x2 * s, x2 * c + x1 * s);
#pragma unroll
            for (int h = 0; h < 8; ++h) *(unsigned*)(KB + ((size_t)h * S + t) * 96 + 64 + 2 * lane) = w; }
    }
}

DI void lru_coeff(float rpre, float ipre, float xc, float sp8, float& av, float& uv) {
    const float r = sigmoidf_(rpre), ig = sigmoidf_(ipre);
    const float la = -sp8 * r;
    av = fexp(la);
    uv = __builtin_amdgcn_sqrtf(fmaxf(1.f - av * av, 0.f)) * (ig * xc);
}
DI void phase_lru_s1(int wv, const ArgP a) {
    unsigned char* ws = a.ws(); const int ch = ltid(wv);
    const bf16_t* RI = (const bf16_t*)(ws + O_RI); const bf16_t* XC = (const bf16_t*)(ws + O_XC);
    float* CHA = (float*)(ws + O_CHA); float* CHH = (float*)(ws + O_CHH);
    const float ba = a.in(7)[ch], bx = a.in(9)[ch]; const float lam = a.in(10)[ch];
    const float sp8 = 8.f * log1pf(expf(-lam));
    for (int c = blockIdx.x; c < 256; c += gridDim.x) {
        float A = 1.f, H = 0.f;
#pragma unroll 8
        for (int i = 0; i < 64; ++i) { const size_t t = (size_t)c * 64 + i;
            float av, uv; lru_coeff(bf2f(RI[t * 1024 + ch]) + ba, bf2f(RI[t * 1024 + 512 + ch]) + bx, bf2f(XC[t * 512 + ch]), sp8, av, uv);
            A *= av; H = av * H + uv; }
        CHA[c * 512 + ch] = A; CHH[c * 512 + ch] = H;
    }
}
DI void phase_lru_s3(int wv, const ArgP a) {
    unsigned char* ws = a.ws(); const int ch = ltid(wv);
    const bf16_t* RI = (const bf16_t*)(ws + O_RI); const bf16_t* XC = (const bf16_t*)(ws + O_XC); const bf16_t* Z = (const bf16_t*)(ws + O_Z);
    const float* CHA = (const float*)(ws + O_CHA); const float* CHH = (const float*)(ws + O_CHH); bf16_t* MIX = (bf16_t*)(ws + O_MIX);
    const float ba = a.in(7)[ch], bx = a.in(9)[ch]; const float lam = a.in(10)[ch];
    const float sp8 = 8.f * log1pf(expf(-lam));
    for (int c = blockIdx.x; c < 256; c += gridDim.x) {
        float H = 0.f;
        { int cc = 0;
          for (; cc + 28 <= c; cc += 28) { float aa[28], hh[28];
#pragma unroll
              for (int k = 0; k < 28; ++k) { aa[k] = CHA[(cc + k) * 512 + ch]; hh[k] = CHH[(cc + k) * 512 + ch]; }
#pragma unroll
              for (int k = 0; k < 28; ++k) H = aa[k] * H + hh[k]; }
          for (; cc < c; ++cc) H = CHA[cc * 512 + ch] * H + CHH[cc * 512 + ch]; }
#pragma unroll 4
        for (int i = 0; i < 64; ++i) { const size_t t = (size_t)c * 64 + i;
            float av, uv; lru_coeff(bf2f(RI[t * 1024 + ch]) + ba, bf2f(RI[t * 1024 + 512 + ch]) + bx, bf2f(XC[t * 512 + ch]), sp8, av, uv);
            H = av * H + uv;
            const float g = bf2f(Z[t * 1536 + 512 + ch]);
            const float y = 0.7978845608028654f * (g + 0.044715f * g * g * g);
            const float th = 1.f - 2.f * __builtin_amdgcn_rcpf(1.f + fexp(2.f * y));
            MIX[t * 1024 + ch] = f2bf(H * 0.5f * g * (1.f + th)); }
    }
}

constexpr int AT_KROW = 208, AT_VROW = 136, AT_KT = 64 * AT_KROW, AT_VT = 64 * AT_VROW;
DI float rowmax32(const f32x16& p0, const f32x16& p1) {
    float a = fmaxf(fmaxf(p0[0], p0[1]), p1[0]), b = fmaxf(fmaxf(p0[2], p0[3]), p1[1]); a = fmaxf(fmaxf(a, p1[2]), p1[3]);
#pragma unroll
    for (int r = 4; r < 16; r += 4) { a = fmaxf(fmaxf(a, p0[r]), p0[r + 1]); b = fmaxf(fmaxf(b, p0[r + 2]), p0[r + 3]); a = fmaxf(fmaxf(a, p1[r]), p1[r + 1]); b = fmaxf(fmaxf(b, p1[r + 2]), p1[r + 3]); }
    const float m = fmaxf(a, b);
    const auto rr = __builtin_amdgcn_permlane32_swap(__float_as_uint(m), __float_as_uint(m), false, false);
    return fmaxf(__uint_as_float(rr[0]), __uint_as_float(rr[1]));
}
DI void attn_unit(int wv, int h, int qb, const bf16_t* QB, const bf16_t* KB, const bf16_t* VT, bf16_t* MIX, LAS unsigned char* lds) {
    const int tid = ltid(wv), lane = tid & 63, r32 = lane & 31, hi = lane >> 5; const int wid = __builtin_amdgcn_readfirstlane(tid >> 6);
    const int qg = qb * 256 + wid * 32 + r32;
    const bf16_t* Kh = KB + (size_t)h * S * 96; const bf16_t* Vh = VT + (size_t)h * 64 * S;
    bf16x8 qf[6];
    { const bf16_t* qp = QB + ((size_t)h * S + qg) * 96 + 8 * hi;
#pragma unroll
      for (int s = 0; s < 6; ++s) qf[s] = *(const bf16x8*)(qp + 16 * s); }
    f32x16 o0 = {}, o1 = {}, negm = {};
    float mref = 0.f, lrun = 0.f;
    const int NT = 4 * qb + 4, wlim = 4 * qb + (wid >> 1);
    const int kc0 = tid, kkey0 = kc0 / 12, kpart0 = kc0 % 12;
    const int kc1 = tid + 512, kkey1 = kc1 / 12, kpart1 = kc1 % 12;
    const int vdv = tid >> 3, vpart = tid & 7;
    u32x4 rk0, rk1 = {}, rv;
#define AT_LOADK(t_) do { const size_t kb_ = (size_t)(t_) * 64; rk0 = *(const u32x4*)(Kh + (kb_ + kkey0) * 96 + kpart0 * 8); if (tid < 256) rk1 = *(const u32x4*)(Kh + (kb_ + kkey1) * 96 + kpart1 * 8); } while (0)
#define AT_LOADV(t_) do { rv = *(const u32x4*)(Vh + (size_t)vdv * S + (size_t)(t_) * 64 + vpart * 8); } while (0)
#define AT_WRITEK(t_) do { LAS unsigned char* Ks_ = lds + ((t_) & 1) * AT_KT; *(LAS u32x4*)(Ks_ + kkey0 * AT_KROW + kpart0 * 16) = rk0; if (tid < 256) *(LAS u32x4*)(Ks_ + kkey1 * AT_KROW + kpart1 * 16) = rk1; } while (0)
#define AT_WRITEV(t_) do { LAS unsigned char* Vs_ = lds + 2 * AT_KT + ((t_) & 1) * AT_VT; *(LAS u32x2*)(Vs_ + vdv * AT_VROW + vpart * 16) = (u32x2){rv.x, rv.y}; *(LAS u32x2*)(Vs_ + vdv * AT_VROW + vpart * 16 + 8) = (u32x2){rv.z, rv.w}; } while (0)
#define AT_QK(P0, P1, t_) do { const LAS unsigned char* Ks_ = lds + ((t_) & 1) * AT_KT + r32 * AT_KROW + 16 * hi; f32x16 c0_ = negm, c1_ = negm; \
        _Pragma("unroll") for (int s = 0; s < 6; ++s) { const bf16x8 k0_ = *(const LAS bf16x8*)(Ks_ + 32 * s), k1_ = *(const LAS bf16x8*)(Ks_ + 32 * AT_KROW + 32 * s); \
            c0_ = __builtin_amdgcn_mfma_f32_32x32x16_bf16(k0_, qf[s], c0_, 0, 0, 0); c1_ = __builtin_amdgcn_mfma_f32_32x32x16_bf16(k1_, qf[s], c1_, 0, 0, 0); } \
        P0 = c0_; P1 = c1_; } while (0)
#define AT_SM1(P0, P1, MOFF, t_, MASK) do { \
        if (MASK && (t_) == wlim) { const int kbase_ = (t_) * 64 + 4 * hi; \
            _Pragma("unroll") for (int r = 0; r < 16; ++r) { const int kv_ = kbase_ + (r & 3) + 8 * (r >> 2); if (kv_ > qg) P0[r] = -1e30f; if (kv_ + 32 > qg) P1[r] = -1e30f; } } \
        const float d_ = mref - MOFF;                         \
        const float mx_ = rowmax32(P0, P1) - d_;              \
        if ((t_) == 0 || __any(mx_ > 8.f || d_ != 0.f)) { const float dl_ = ((t_) == 0) ? mx_ : fmaxf(mx_, 0.f); mref += dl_; \
            const float sh_ = d_ + dl_; \
            _Pragma("unroll") for (int r = 0; r < 16; ++r) { P0[r] -= sh_; P1[r] -= sh_; } \
            const float al_ = ((t_) == 0) ? 1.f : __builtin_amdgcn_exp2f(-dl_); lrun *= al_;     \
            _Pragma("unroll") for (int r = 0; r < 16; ++r) { o0[r] *= al_; o1[r] *= al_; negm[r] = -mref; } asm volatile("" : "+v"(negm)); } \
    } while (0)
#define AT_SM2(P0, P1, t_) do { \
        float ps_ = 0.f; \
        _Pragma("unroll") for (int r = 0; r < 16; ++r) { P0[r] = __builtin_amdgcn_exp2f(P0[r]); P1[r] = __builtin_amdgcn_exp2f(P1[r]); ps_ += P0[r] + P1[r]; } \
        lrun += ps_; \
        const LAS unsigned char* Vs_ = lds + 2 * AT_KT + ((t_) & 1) * AT_VT + r32 * AT_VROW + 8 * hi; \
        _Pragma("unroll") for (int ks = 0; ks < 4; ++ks) { u32x4 w_; \
            if (ks < 2) { w_.x = pk2(P0[8 * ks], P0[8 * ks + 1]); w_.y = pk2(P0[8 * ks + 2], P0[8 * ks + 3]); w_.z = pk2(P0[8 * ks + 4], P0[8 * ks + 5]); w_.w = pk2(P0[8 * ks + 6], P0[8 * ks + 7]); } \
            else { w_.x = pk2(P1[8 * ks - 16], P1[8 * ks - 15]); w_.y = pk2(P1[8 * ks - 14], P1[8 * ks - 13]); w_.z = pk2(P1[8 * ks - 12], P1[8 * ks - 11]); w_.w = pk2(P1[8 * ks - 10], P1[8 * ks - 9]); } \
            const bf16x8 pa_ = __builtin_bit_cast(bf16x8, w_); \
            const u32x2 a0_ = *(const LAS u32x2*)(Vs_ + 32 * ks), a1_ = *(const LAS u32x2*)(Vs_ + 32 * ks + 16); \
            const u32x2 b0_ = *(const LAS u32x2*)(Vs_ + 32 * AT_VROW + 32 * ks), b1_ = *(const LAS u32x2*)(Vs_ + 32 * AT_VROW + 32 * ks + 16); \
            o0 = __builtin_amdgcn_mfma_f32_32x32x16_bf16(__builtin_bit_cast(bf16x8, (u32x4){a0_.x, a0_.y, a1_.x, a1_.y}), pa_, o0, 0, 0, 0); \
            o1 = __builtin_amdgcn_mfma_f32_32x32x16_bf16(__builtin_bit_cast(bf16x8, (u32x4){b0_.x, b0_.y, b1_.x, b1_.y}), pa_, o1, 0, 0, 0); } \
    } while (0)
#define AT_STEPM(C0, C1, MC, N0, N1, MN, t_) do { \
        AT_WRITEK((t_) + 1); AT_WRITEV(t_); \
        __syncthreads(); \
        AT_LOADK((t_) + 2); AT_LOADV((t_) + 1); \
        AT_SM1(C0, C1, MC, t_, 0); MN = mref; AT_QK(N0, N1, (t_) + 1); AT_SM2(C0, C1, t_); \
    } while (0)
#define AT_STEPB(C0, C1, MC, N0, N1, MN, t_) do { \
        if ((t_) + 1 < NT) AT_WRITEK((t_) + 1); AT_WRITEV(t_); \
        __syncthreads(); \
        if ((t_) + 2 < NT) AT_LOADK((t_) + 2); if ((t_) + 1 < NT) AT_LOADV((t_) + 1); \
        if ((t_) + 1 <= wlim) { MN = mref; AT_QK(N0, N1, (t_) + 1); } \
        if ((t_) <= wlim) { AT_SM1(C0, C1, MC, t_, 1); AT_SM2(C0, C1, t_); } \
    } while (0)
    f32x16 pA0, pA1, pB0 = {}, pB1 = {}; float mA = 0.f, mB = 0.f;
    AT_LOADK(0); AT_WRITEK(0);
    __syncthreads();
    AT_LOADK(1); AT_LOADV(0);
    AT_QK(pA0, pA1, 0);
    int t = 0;
    for (; t < 4 * qb; t += 2) {
        AT_STEPM(pA0, pA1, mA, pB0, pB1, mB, t);
        AT_STEPM(pB0, pB1, mB, pA0, pA1, mA, t + 1);
    }
    for (; t < NT; t += 2) {
        AT_STEPB(pA0, pA1, mA, pB0, pB1, mB, t);
        AT_STEPB(pB0, pB1, mB, pA0, pA1, mA, t + 1);
    }
#undef AT_STEPM
#undef AT_STEPB
#undef AT_LOADK
#undef AT_LOADV
#undef AT_WRITEK
#undef AT_WRITEV
#undef AT_QK
#undef AT_SM1
#undef AT_SM2
    lrun += __shfl_xor(lrun, 32);
    const float inv = 1.f / lrun;
    bf16_t* op = MIX + (size_t)qg * 1024 + 512 + h * 64;
#pragma unroll
    for (int g = 0; g < 4; ++g) { const int dv = 8 * g + 4 * hi;
        u32x2 w; w.x = pk2(o0[4 * g] * inv, o0[4 * g + 1] * inv); w.y = pk2(o0[4 * g + 2] * inv, o0[4 * g + 3] * inv); *(u32x2*)(op + dv) = w;
        u32x2 w2; w2.x = pk2(o1[4 * g] * inv, o1[4 * g + 1] * inv); w2.y = pk2(o1[4 * g + 2] * inv, o1[4 * g + 3] * inv); *(u32x2*)(op + 32 + dv) = w2; }
    __syncthreads();
}
DI void phase_attn(int wv, const ArgP a, LAS unsigned char* lds) {
    unsigned char* ws = a.ws();
    const bf16_t* QB = (const bf16_t*)(ws + O_QB); const bf16_t* KB = (const bf16_t*)(ws + O_KB); const bf16_t* VT = (const bf16_t*)(ws + O_VT); bf16_t* MIX = (bf16_t*)(ws + O_MIX);
    if (wv >= 4) __builtin_amdgcn_s_setprio(1);
    for (int b = blockIdx.x; b < 256; b += gridDim.x) {
        const int v = (b & 7) * 32 + (b >> 3), h = v >> 5, s = v & 31;
        attn_unit(wv, h, 63 - s, QB, KB, VT, MIX, lds);
        attn_unit(wv, h, s, QB, KB, VT, MIX, lds);
    }
    __builtin_amdgcn_s_setprio(0);
}

DI void phase_m_gates(int wv, const ArgP a, LAS unsigned char* lds) {
    unsigned char* ws = a.ws(); const int tid = ltid(wv), wave = tid >> 6, lane = tid & 63;
    const bf16_t* XBr = (const bf16_t*)(ws + O_XB) + 2 * 1024; const u64* rowss = (const u64*)(ws + O_ROWSS) + 2 * S;
    const float* Wg = a.in(17); const float* gn = a.in(16);
    LAS float* wgs = (LAS float*)lds;
    LAS float* pre = (LAS float*)(lds + 32768);
    float* GB = (float*)(ws + O_GB); float* GE = (float*)(ws + O_GE); float* GPM = (float*)(ws + O_GPM);
    float* BL = (float*)(ws + O_BL); float* ML = (float*)(ws + O_ML);
    for (int e = tid; e < 8192; e += 512) { const int k = e >> 3, j = e & 7; wgs[j * 1024 + k] = Wg[(size_t)k * 3080 + 3072 + j] * gn[k]; }
    __syncthreads();
    for (int c = blockIdx.x; c < 256; c += gridDim.x) {
#pragma unroll 4
        for (int i = 0; i < 8; ++i) { const int t = c * 64 + wave * 8 + i;
            float acc[8];
#pragma unroll
            for (int j = 0; j < 8; ++j) acc[j] = 0.f;
#pragma unroll
            for (int jj = 0; jj < 4; ++jj) { const int k0 = jj * 256 + lane * 4; const u32x2 hb = *(const u32x2*)(XBr + (size_t)t * 1024 + k0); const f32x4 hv = {bflo(hb.x), bfhi(hb.x), bflo(hb.y), bfhi(hb.y)};
#pragma unroll
                for (int j = 0; j < 8; ++j) { const f32x4 wj = *(const LAS f32x4*)(wgs + j * 1024 + k0); acc[j] += hv[0] * wj[0] + hv[1] * wj[1] + hv[2] * wj[2] + hv[3] * wj[3]; } }
            const float rs = rs_from_ss(rowss[t]);
            { const bool b5 = lane & 32, b4 = lane & 16, b3 = lane & 8;
#pragma unroll
              for (int j = 0; j < 4; ++j) { const float snd = b5 ? acc[j] : acc[j + 4], kp = b5 ? acc[j + 4] : acc[j]; acc[j] = kp + __shfl_xor(snd, 32); }
#pragma unroll
              for (int j = 0; j < 2; ++j) { const float snd = b4 ? acc[j] : acc[j + 2], kp = b4 ? acc[j + 2] : acc[j]; acc[j] = kp + __shfl_xor(snd, 16); }
              { const float snd = b3 ? acc[0] : acc[1], kp = b3 ? acc[1] : acc[0]; acc[0] = kp + __shfl_xor(snd, 8); }
              acc[0] += __shfl_xor(acc[0], 4); acc[0] += __shfl_xor(acc[0], 2); acc[0] += __shfl_xor(acc[0], 1);
              if ((lane & 7) == 0) pre[(wave * 8 + i) * 8 + (b5 ? 4 : 0) + (b4 ? 2 : 0) + (b3 ? 1 : 0)] = acc[0] * rs; }
        }
        __syncthreads();
        if (wave < 4) { const int h = wave; const float bi = a.in(18)[h], bfg = a.in(19)[h];
            const float ig = 15.f * tanhf((pre[lane * 8 + h] + bi) * (1.f / 15.f));
            const float fg = 15.f * tanhf((pre[lane * 8 + 4 + h] + bfg) * (1.f / 15.f));
            float b = -log1pf(expf(-fg));
#pragma unroll
            for (int o = 1; o < 64; o <<= 1) { const float v = __shfl_up(b, o); if (lane >= o) b += v; }
            const float e = ig - b; float pm = e;
#pragma unroll
            for (int o = 1; o < 64; o <<= 1) { const float v = __shfl_up(pm, o); if (lane >= o) pm = fmaxf(pm, v); }
            const size_t o_ = (size_t)h * S + c * 64 + lane; GB[o_] = b; GE[o_] = e; GPM[o_] = pm;
            if (lane == 63) { BL[c * 4 + h] = b; ML[c * 4 + h] = b + pm; } }
        __syncthreads();
    }
}
DI void phase_m_dc(int wv, const ArgP a) {
    unsigned char* ws = a.ws(); const int tid = ltid(wv), lane = tid & 63, r32 = lane & 31, hi = lane >> 5; const int w = __builtin_amdgcn_readfirstlane(tid >> 6);
    const float* __restrict__ BL = (const float*)(ws + O_BL); const float* __restrict__ ML = (const float*)(ws + O_ML); float* __restrict__ NST = (float*)(ws + O_NST);
    const float* __restrict__ GE = (const float*)(ws + O_GE); const bf16_t* __restrict__ KVT = (const bf16_t*)(ws + O_KVT); bf16_t* __restrict__ CST = (bf16_t*)(ws + O_CST);
#pragma unroll 2
    for (int u = blockIdx.x; u < 1024; u += gridDim.x) {
        const int c = u >> 2, h = u & 3; const size_t t0 = (size_t)c * 64;
        const float emax = ML[c * 4 + h] - BL[c * 4 + h];
        bf16x8 bfr[4];
        { const bf16_t* vp = KVT + (size_t)(512 + h * 256 + 32 * w + r32) * S + t0 + 8 * hi; const float* gp = GE + (size_t)h * S + t0 + 8 * hi;
#pragma unroll
          for (int ks = 0; ks < 4; ++ks) { const u32x4 v = *(const u32x4*)(vp + 16 * ks); const f32x4 e0 = *(const f32x4*)(gp + 16 * ks), e1 = *(const f32x4*)(gp + 16 * ks + 4);
              u32x4 o; o.x = pk2(bflo(v.x) * fexp(e0[0] - emax), bfhi(v.x) * fexp(e0[1] - emax)); o.y = pk2(bflo(v.y) * fexp(e0[2] - emax), bfhi(v.y) * fexp(e0[3] - emax));
              o.z = pk2(bflo(v.z) * fexp(e1[0] - emax), bfhi(v.z) * fexp(e1[1] - emax)); o.w = pk2(bflo(v.w) * fexp(e1[2] - emax), bfhi(v.w) * fexp(e1[3] - emax));
              bfr[ks] = __builtin_bit_cast(bf16x8, o); } }
        const bf16_t* kp = KVT + (size_t)(h * 128 + r32) * S + t0 + 8 * hi;
        bf16_t* op = CST + ((size_t)(c * 4 + h) * 256 + 32 * w + r32) * 128 + 4 * hi;
#pragma unroll
        for (int rb = 0; rb < 4; ++rb) { f32x16 acc = {};
#pragma unroll
            for (int ks = 0; ks < 4; ++ks) { const bf16x8 ka = *(const bf16x8*)(kp + (size_t)(32 * rb) * S + 16 * ks); acc = __builtin_amdgcn_mfma_f32_32x32x16_bf16(ka, bfr[ks], acc, 0, 0, 0); }
#pragma unroll
            for (int g = 0; g < 4; ++g) { u32x2 o; o.x = pk2(acc[4 * g], acc[4 * g + 1]); o.y = pk2(acc[4 * g + 2], acc[4 * g + 3]); *(u32x2*)(op + 32 * rb + 8 * g) = o; } }
        if (tid < 128) { const bf16_t* kr = KVT + (size_t)(h * 128 + tid) * S + t0; const float* gp = GE + (size_t)h * S + t0; float s = 0.f;
#pragma unroll
            for (int p = 0; p < 8; ++p) { const u32x4 v = *(const u32x4*)(kr + 8 * p); const f32x4 e0 = *(const f32x4*)(gp + 8 * p), e1 = *(const f32x4*)(gp + 8 * p + 4);
                s += bflo(v.x) * fexp(e0[0] - emax) + bfhi(v.x) * fexp(e0[1] - emax) + bflo(v.y) * fexp(e0[2] - emax) + bfhi(v.y) * fexp(e0[3] - emax)
                   + bflo(v.z) * fexp(e1[0] - emax) + bfhi(v.z) * fexp(e1[1] - emax) + bflo(v.w) * fexp(e1[2] - emax) + bfhi(v.w) * fexp(e1[3] - emax); }
            NST[(size_t)(c * 4 + h) * 128 + tid] = s; }
    }
}
DI void phase_m_comb(int wv, const ArgP a, LAS unsigned char* lds, int dry) {
    unsigned char* ws = a.ws(); const int tid = ltid(wv);
    const float* BL = (const float*)(ws + O_BL); const float* ML = (const float*)(ws + O_ML); float* MST = (float*)(ws + O_MST); float* NST = (float*)(ws + O_NST);
    bf16_t* CST = (bf16_t*)(ws + O_CST);
    LAS float* bls = (LAS float*)lds; LAS float* mls = bls + 1024; LAS float* ga = mls + 1024; LAS float* gb = ga + 1024;
    for (int e = tid; e < 1024; e += 512) { bls[e] = BL[e]; mls[e] = ML[e]; }
    __syncthreads();
    if (tid < 256) { const int h = tid >> 6, l = tid & 63;
        float a_ = 0.f, b_ = -1e30f;
#pragma unroll
        for (int k = 0; k < 4; ++k) { const float bl = bls[(4 * l + k) * 4 + h], ml = mls[(4 * l + k) * 4 + h]; a_ += bl; b_ = fmaxf(b_ + bl, ml); }
        float pa = a_, pb = b_;
#pragma unroll
        for (int o = 1; o < 64; o <<= 1) { const float qa = __shfl_up(pa, o), qb = __shfl_up(pb, o); if (l >= o) { pb = fmaxf(qb + pa, pb); pa = qa + pa; } }
        float ea = __shfl_up(pa, 1), eb_ = __shfl_up(pb, 1); if (l == 0) { ea = 0.f; eb_ = -1e30f; }
        float m = fmaxf(0.f + ea, eb_);
#pragma unroll
        for (int k = 0; k < 4; ++k) { const int c = 4 * l + k; const float bl = bls[c * 4 + h], ml = mls[c * 4 + h]; const float mn = fmaxf(bl + m, ml);
            ga[c * 4 + h] = fexp(bl + m - mn); gb[c * 4 + h] = fexp(ml - mn);
            if (blockIdx.x == 0 && !dry) MST[c * 4 + h] = m;
            m = mn; } }
    __syncthreads();
    for (int eb = blockIdx.x; eb < 129; eb += gridDim.x) {
        if (eb < 128) { const int h = eb >> 5; unsigned* p = (unsigned*)(CST + (size_t)h * 32768 + (size_t)(eb & 31) * 1024 + 2 * tid); float C0 = 0.f, C1 = 0.f;
            for (int c = 0; c < 256; c += 64) { unsigned d[64];
#pragma unroll
                for (int k = 0; k < 64; ++k) d[k] = p[(size_t)(c + k) * 65536];
#pragma unroll
                for (int k = 0; k < 64; ++k) { if (!dry) p[(size_t)(c + k) * 65536] = pk2(C0, C1); const float a_ = ga[(c + k) * 4 + h], b_ = gb[(c + k) * 4 + h]; C0 = a_ * C0 + b_ * bflo(d[k]); C1 = a_ * C1 + b_ * bfhi(d[k]); } }
        } else { const int h = tid >> 7; float* p = NST + tid; float C = 0.f;
            for (int c = 0; c < 256; c += 8) { float d[8];
#pragma unroll
                for (int k = 0; k < 8; ++k) d[k] = p[(size_t)(c + k) * 512];
#pragma unroll
                for (int k = 0; k < 8; ++k) { if (!dry) p[(size_t)(c + k) * 512] = C; C = ga[(c + k) * 4 + h] * C + gb[(c + k) * 4 + h] * d[k]; } } }
    }
    __syncthreads();
}
constexpr int MC_QROW = 272, MC_SROW = 144;
constexpr int MC_QS = 0, MC_KS = 64 * MC_QROW, MC_SC = 2 * 64 * MC_QROW, MC_F = MC_SC + 64 * MC_SROW;
DI void phase_m_out(int wv, const ArgP a, LAS unsigned char* lds, int dry) {
    unsigned char* ws = a.ws(); const int tid = ltid(wv), lane = tid & 63, r32 = lane & 31, hi = lane >> 5; const int w = __builtin_amdgcn_readfirstlane(tid >> 6);
    bf16_t* QOK = (bf16_t*)(ws + O_QOK); const bf16_t* KVT = (const bf16_t*)(ws + O_KVT); const bf16_t* CST = (const bf16_t*)(ws + O_CST);
    const float* GB = (const float*)(ws + O_GB); const float* GE = (const float*)(ws + O_GE); const float* GPM = (const float*)(ws + O_GPM);
    const float* MST = (const float*)(ws + O_MST); const float* NST = (const float*)(ws + O_NST); const float* ong = a.in(20);
    LAS unsigned char* Qs = lds + MC_QS; LAS unsigned char* Ks = lds + MC_KS; LAS unsigned char* Sc = lds + MC_SC;
    LAS float* F = (LAS float*)(lds + MC_F);
    LAS float* f_b = F, *f_e = F + 64, *f_m = F + 128, *f_g = F + 192, *f_qn = F + 256, *f_ps = F + 320  , *f_n = F + 576  , *f_part = F + 704  ;
    for (int u = blockIdx.x; u < 1024; u += gridDim.x) {
        const int c = u >> 2, h = u & 3; const size_t t0 = (size_t)c * 64;
        for (int e = tid; e < 1024; e += 512) { const int r = e >> 4, p = e & 15;
            *(LAS u32x4*)(Qs + r * MC_QROW + p * 16) = *(const u32x4*)(QOK + (t0 + r) * 2048 + h * 128 + p * 8);
            *(LAS u32x4*)(Ks + r * MC_QROW + p * 16) = *(const u32x4*)(QOK + (t0 + r) * 2048 + 1536 + h * 128 + p * 8); }
        if (tid < 64) { const float mstv = MST[c * 4 + h]; const float b = GB[(size_t)h * S + t0 + tid], e = GE[(size_t)h * S + t0 + tid], pm = GPM[(size_t)h * S + t0 + tid];
            const float m = b + fmaxf(mstv, pm); f_b[tid] = b; f_e[tid] = e; f_m[tid] = m; f_g[tid] = fexp(b + mstv - m); }
        if (tid >= 64 && tid < 192) f_n[tid - 64] = NST[(size_t)(c * 4 + h) * 128 + tid - 64];
        __syncthreads();
        if (w < 4) {
            const int sb = w & 1, tb = w >> 1; const int tl = 32 * tb + r32;
            f32x16 x = {};
#pragma unroll
            for (int ks = 0; ks < 8; ++ks) {
                const bf16x8 ka = *(const LAS bf16x8*)(Ks + (32 * sb + r32) * MC_QROW + (16 * ks + 8 * hi) * 2);
                const bf16x8 qb = *(const LAS bf16x8*)(Qs + tl * MC_QROW + (16 * ks + 8 * hi) * 2);
                x = __builtin_amdgcn_mfma_f32_32x32x16_bf16(ka, qb, x, 0, 0, 0); }
            const float bt = f_b[tl], mt = f_m[tl]; float ps = 0.f;
#pragma unroll
            for (int g = 0; g < 4; ++g) { float v[4];
#pragma unroll
                for (int j = 0; j < 4; ++j) { const int sl = 32 * sb + 8 * g + 4 * hi + j; const float wgt = (sl <= tl) ? fexp(bt + f_e[sl] - mt) : 0.f; v[j] = x[4 * g + j] * wgt; ps += v[j]; }
                u32x2 o; o.x = pk2(v[0], v[1]); o.y = pk2(v[2], v[3]);
                *(LAS u32x2*)(Sc + tl * MC_SROW + (32 * sb + 8 * g + 4 * hi) * 2) = o; }
            f_ps[(sb * 2 + hi) * 64 + tl] = ps;
        } else {
            const int tl = 16 * (w - 4) + (lane >> 2), qq = lane & 3; float s = 0.f;
#pragma unroll
            for (int p = 0; p < 4; ++p) { const u32x4 v = *(const LAS u32x4*)(Qs + tl * MC_QROW + (32 * qq + 8 * p) * 2); LAS float* np = f_n + 32 * qq + 8 * p;
                s += bflo(v.x) * np[0] + bfhi(v.x) * np[1] + bflo(v.y) * np[2] + bfhi(v.y) * np[3] + bflo(v.z) * np[4] + bfhi(v.z) * np[5] + bflo(v.w) * np[6] + bfhi(v.w) * np[7]; }
            s += __shfl_xor(s, 1); s += __shfl_xor(s, 2);
            if (qq == 0) f_qn[tl] = s;
        }
        __syncthreads();
        f32x16 acc0 = {}, acc1 = {};
        { const bf16_t* cp = CST + ((size_t)(c * 4 + h) * 256 + 32 * w + r32) * 128 + 8 * hi;
#pragma unroll
          for (int ks = 0; ks < 8; ++ks) { const bf16x8 ca = *(const bf16x8*)(cp + 16 * ks);
              const bf16x8 q0 = *(const LAS bf16x8*)(Qs + r32 * MC_QROW + (16 * ks + 8 * hi) * 2), q1 = *(const LAS bf16x8*)(Qs + (32 + r32) * MC_QROW + (16 * ks + 8 * hi) * 2);
              acc0 = __builtin_amdgcn_mfma_f32_32x32x16_bf16(ca, q0, acc0, 0, 0, 0); acc1 = __builtin_amdgcn_mfma_f32_32x32x16_bf16(ca, q1, acc1, 0, 0, 0); } }
        const float g0 = f_g[r32], g1 = f_g[32 + r32];
#pragma unroll
        for (int r = 0; r < 16; ++r) { acc0[r] *= g0; acc1[r] *= g1; }
        { const bf16_t* vp = KVT + (size_t)(512 + h * 256 + 32 * w + r32) * S + t0 + 8 * hi;
#pragma unroll
          for (int ks = 0; ks < 4; ++ks) { const bf16x8 va = *(const bf16x8*)(vp + 16 * ks);
              const bf16x8 s0 = *(const LAS bf16x8*)(Sc + r32 * MC_SROW + (16 * ks + 8 * hi) * 2), s1 = *(const LAS bf16x8*)(Sc + (32 + r32) * MC_SROW + (16 * ks + 8 * hi) * 2);
              acc0 = __builtin_amdgcn_mfma_f32_32x32x16_bf16(va, s0, acc0, 0, 0, 0); acc1 = __builtin_amdgcn_mfma_f32_32x32x16_bf16(va, s1, acc1, 0, 0, 0); } }
        float inv[2];
#pragma unroll
        for (int tb = 0; tb < 2; ++tb) { const int tl = 32 * tb + r32;
            const float den = f_g[tl] * f_qn[tl] + f_ps[tl] + f_ps[64 + tl] + f_ps[128 + tl] + f_ps[192 + tl];
            inv[tb] = 1.f / fmaxf(fabsf(den), fexp(-f_m[tl])); }
        float ss0 = 0.f, ss1 = 0.f;
#pragma unroll
        for (int r = 0; r < 16; ++r) { acc0[r] *= inv[0]; acc1[r] *= inv[1]; ss0 += acc0[r] * acc0[r]; ss1 += acc1[r] * acc1[r]; }
        ss0 += __shfl_xor(ss0, 32); ss1 += __shfl_xor(ss1, 32);
        if (hi == 0) { f_part[w * 64 + r32] = ss0; f_part[w * 64 + 32 + r32] = ss1; }
        __syncthreads();
        float rn[2];
#pragma unroll
        for (int tb = 0; tb < 2; ++tb) { float s = 0.f;
#pragma unroll
            for (int ww = 0; ww < 8; ++ww) s += f_part[ww * 64 + 32 * tb + r32];
            rn[tb] = rsqrtf(s * (1.f / 256.f) + EPS); }
#pragma unroll
        for (int tb = 0; tb < 2; ++tb) { bf16_t* op = QOK + (t0 + 32 * tb + r32) * 2048 + 512 + h * 256 + 32 * w;
#pragma unroll
            for (int g = 0; g < 4; ++g) { const int dv = 8 * g + 4 * hi; const u32x2 ov = *(const u32x2*)(op + dv);
                const f32x4 gg = *(const f32x4*)(ong + h * 256 + 32 * w + dv);
                const float og[4] = {bflo(ov.x), bfhi(ov.x), bflo(ov.y), bfhi(ov.y)}; float y[4];
#pragma unroll
                for (int j = 0; j < 4; ++j) { const float hv = (tb ? acc1[4 * g + j] : acc0[4 * g + j]) * rn[tb]; y[j] = hv * gg[j] * sigmoidf_(og[j]); }
                u32x2 o; o.x = pk2(y[0], y[1]); o.y = pk2(y[2], y[3]); if (!dry) *(u32x2*)(op + dv) = o; } }
        __syncthreads();
    }
}

DI void phase_final(int wv, const ArgP a) {
    float* out = a.out(); const u64* rowss = (const u64*)(a.ws() + O_ROWSS) + 4 * S; const float* g = a.in(27); const bf16_t* XBr = (const bf16_t*)(a.ws() + O_XB) + 2 * 1024;
    for (size_t e = (size_t)blockIdx.x * 512 + ltid(wv); e < (size_t)S * 128; e += (size_t)gridDim.x * 512) { const int t = (int)(e >> 7), c = (int)(e & 127) * 8;
        const float rs = rs_from_ss(rowss[t]); const u32x4 hb = __builtin_nontemporal_load((const u32x4*)(XBr + (size_t)t * 1024 + c)); const f32x4 g0 = *(const f32x4*)(g + c), g1 = *(const f32x4*)(g + c + 4);
        const f32x4 v0 = (f32x4){bflo(hb.x), bfhi(hb.x), bflo(hb.y), bfhi(hb.y)} * rs * g0, v1 = (f32x4){bflo(hb.z), bfhi(hb.z), bflo(hb.w), bfhi(hb.w)} * rs * g1;
        __builtin_nontemporal_store(v0, (f32x4*)(out + (size_t)t * 1024 + c)); __builtin_nontemporal_store(v1, (f32x4*)(out + (size_t)t * 1024 + c + 4)); }
}

#ifndef DIS
#define DIS 0u
#endif
#ifndef REP
#define REP 0u
#endif
#ifndef XSYNC
#define XSYNC 0
#endif

#define XB_TMO      128
#define XB_XCNT(j)  (256  + 64 * (j))
#define XB_XSUB(j)  (1280 + 64 * (j))
#define XB_XGEN(j)  (2304 + 64 * (j))
#define XB_TOP      3328
#define XB_TOPGEN   3392
#define XB_SPIN_CAP (1u << 18)
DI unsigned xb_ld(unsigned* p) { return __hip_atomic_load(p, __ATOMIC_RELAXED, __HIP_MEMORY_SCOPE_AGENT); }
DI unsigned xb_add(unsigned* p, unsigned v) { return __hip_atomic_fetch_add(p, v, __ATOMIC_RELAXED, __HIP_MEMORY_SCOPE_AGENT); }
DI unsigned xb_xcc_id() { return (unsigned)__builtin_amdgcn_s_getreg((3 << 11) | 20) & 0xFu; }
#define XB_SPIN(cond, bar) do { unsigned _sp = 0; while (cond) { \
    if ((++_sp & 255u) == 0u) { if (xb_ld(&(bar)[XB_TMO])) break; if (_sp > XB_SPIN_CAP) { atomicAdd(&(bar)[XB_TMO], 1u); break; } } } } while (0)
DI void xcd_barrier_complete(unsigned* bar, unsigned x, unsigned& nloc, unsigned& nx) {
    const unsigned G = gridDim.x;
    unsigned sum, cnt, mine, sp = 0u;
    for (;;) {
        sum = 0u; cnt = 0u; mine = 0u;
#pragma unroll
        for (unsigned j = 0; j < 16; ++j) { const unsigned c = xb_ld(&bar[XB_XCNT(j)]); sum += c; cnt += (c > 0u) ? 1u : 0u; mine = (j == x) ? c : mine; }
        if (sum == G) break;
        __builtin_amdgcn_s_sleep(1);
        if ((++sp & 255u) == 0u) { if (xb_ld(&bar[XB_TMO])) break; if (sp > XB_SPIN_CAP) { atomicAdd(&bar[XB_TMO], 1u); break; } }
    }
    nloc = mine > 0u ? mine : 1u; nx = cnt > 0u ? cnt : 1u;
}
DI void xcd_barrier(int wv, unsigned* bar, volatile LAS unsigned* st) {
    asm volatile("s_waitcnt vmcnt(0)" ::: "memory");
    __syncthreads();
    if (ltid(wv) == 0) {
        const unsigned x = xb_xcc_id();
        __builtin_amdgcn_s_waitcnt(0);
        unsigned nloc = st[0], nx = st[1];
        if (nloc == 0u) { xcd_barrier_complete(bar, x, nloc, nx); st[0] = nloc; st[1] = nx; }
        const unsigned old = xb_add(&bar[XB_XSUB(x)], 1u);
        const unsigned gen = old / nloc;
        if (old + 1u == (gen + 1u) * nloc) {
            __builtin_amdgcn_fence(__ATOMIC_RELEASE, "agent");
            asm volatile("s_waitcnt vmcnt(0)" ::: "memory");
            const unsigned og = xb_add(&bar[XB_TOP], 1u);
            const unsigned tg = og / nx;
            if (og + 1u == (tg + 1u) * nx) xb_add(&bar[XB_TOPGEN], 1u);
            else XB_SPIN(xb_ld(&bar[XB_TOPGEN]) == tg, bar);
            __builtin_amdgcn_fence(__ATOMIC_ACQUIRE, "agent");
            xb_add(&bar[XB_XGEN(x)], 1u);
            asm volatile("s_waitcnt vmcnt(0)" ::: "memory");
        } else {
            XB_SPIN(xb_ld(&bar[XB_XGEN(x)]) == gen, bar);
            __builtin_amdgcn_fence(__ATOMIC_ACQUIRE, "agent");
            asm volatile("s_waitcnt vmcnt(0)" ::: "memory");
        }
    }
    __syncthreads();
}
DI ArgP getargs() { ArgP r; r.p = (const __attribute__((address_space(4))) Args*)__builtin_amdgcn_kernarg_segment_ptr(); asm volatile("" : "+s"(r.p)); return r; }
#define WSB (getargs().ws())
#define XBP ((bf16_t*)(getargs().ws() + O_XB) + 2 * 1024)
#define RSS ((u64*)(getargs().ws() + O_ROWSS))
#define HFP (getargs().out())
__global__ void __launch_bounds__(512, 2) fwd_kernel(Args a_unused) {
    extern __shared__ __attribute__((aligned(16))) unsigned char shm[];
    LAS unsigned char* lds = (LAS unsigned char*)shm;
    const int wv = __builtin_amdgcn_readfirstlane(threadIdx.x >> 6);
#define BARW ((unsigned*)(getargs().ws() + O_BAR))
#define BARST ((volatile LAS unsigned*)(lds + 139264))
#define GSYNC() xcd_barrier(wv, BARW, BARST)
    { unsigned* barw0 = BARW; if (threadIdx.x == 0) { BARST[0] = 0u; BARST[1] = 0u; (void)xb_add(&barw0[XB_XCNT(xb_xcc_id())], 1u); } }
    if (getargs().p->pad == 0x7fffffff) cg::this_grid().sync();

#if !(DIS & (1u << 0))
    for (int rep_ = 0; rep_ < ((REP >> 0) & 1u) + 1; ++rep_) { const int dry_ = rep_ < (int)((REP >> 0) & 1u); (void)dry_;
    phase_prologue(wv, getargs(), lds, dry_ ? PROPART : 7);
    }
#endif
    GSYNC();
#if !(DIS & (1u << 1))
    for (int rep_ = 0; rep_ < ((REP >> 1) & 1u) + 1; ++rep_) { const int dry_ = rep_ < (int)((REP >> 1) & 1u); (void)dry_;
    { EpiRowBf16<1> E{(bf16_t*)(WSB + O_Z), 1536, RSS};
      pg8::gemm_phase<false>(wv, lds, XBP, 1024, (const bf16_t*)(WSB + O_W1T), 1024, 1024, 64, 6, E); }
    }
#endif
    GSYNC();
#if !(DIS & (1u << 2))
    for (int rep_ = 0; rep_ < ((REP >> 2) & 1u) + 1; ++rep_) { const int dry_ = rep_ < (int)((REP >> 2) & 1u); (void)dry_;
    phase_l0_prep(wv, getargs());
    }
#endif
    GSYNC();
#if !(DIS & (1u << 3))
    for (int rep_ = 0; rep_ < ((REP >> 3) & 1u) + 1; ++rep_) { const int dry_ = rep_ < (int)((REP >> 3) & 1u); (void)dry_;
    { EpiRowBf16<0> E{(bf16_t*)(WSB + O_RI), 1024, nullptr};
      pg8::gemm_phase<false, EpiRowBf16<0>, true>(wv, lds, (const bf16_t*)(WSB + O_XC), 512, (const bf16_t*)(WSB + O_WRIT), 512, 256, 64, 4, E); }
    }
#endif
#if !(DIS & (1u << 4))
    for (int rep_ = 0; rep_ < ((REP >> 4) & 1u) + 1; ++rep_) { const int dry_ = rep_ < (int)((REP >> 4) & 1u); (void)dry_;
    { EpiQ E{(bf16_t*)(WSB + O_QB), (const float*)(WSB + O_RSQ), (const float*)(WSB + O_CSTAB)};
      pg8::gemm_phase<false>(wv, lds, (const bf16_t*)(WSB + O_Z) + 1024, 1536, (const bf16_t*)(WSB + O_WQT), 256, 256, 64, 3, E); }
    }
#endif
#if !(DIS & (1u << 5))
    for (int rep_ = 0; rep_ < ((REP >> 5) & 1u) + 1; ++rep_) { const int dry_ = rep_ < (int)((REP >> 5) & 1u); (void)dry_;
    { EpiK E{(bf16_t*)(WSB + O_KB), (const float*)(WSB + O_RSKV)};
      pg8::gemm_phase<false>(wv, lds, (const bf16_t*)(WSB + O_Z) + 1280, 1536, (const bf16_t*)(WSB + O_WKT), 256, 256, 64, 2, E, 192); }
    }
#endif
#if !(DIS & (1u << 6))
    for (int rep_ = 0; rep_ < ((REP >> 6) & 1u) + 1; ++rep_) { const int dry_ = rep_ < (int)((REP >> 6) & 1u); (void)dry_;
    { EpiColBf16<2> E{(bf16_t*)(WSB + O_VT), S, (const float*)(WSB + O_RSKV)};
      pg8::gemm_phase<false>(wv, lds, (const bf16_t*)(WSB + O_WVT), 256, (const bf16_t*)(WSB + O_Z) + 1280, 1536, 256, 2, 64, E, 64); }
    }
#endif
    GSYNC();
#if !(DIS & (1u << 7))
    for (int rep_ = 0; rep_ < ((REP >> 7) & 1u) + 1; ++rep_) { const int dry_ = rep_ < (int)((REP >> 7) & 1u); (void)dry_;
    phase_lru_s1(wv, getargs());
    }
#endif
    GSYNC();
#if !(DIS & (1u << 8))
    for (int rep_ = 0; rep_ < ((REP >> 8) & 1u) + 1; ++rep_) { const int dry_ = rep_ < (int)((REP >> 8) & 1u); (void)dry_;
    phase_lru_s3(wv, getargs());
    }
#endif
#if !(DIS & (1u << 9))
    for (int rep_ = 0; rep_ < ((REP >> 9) & 1u) + 1; ++rep_) { const int dry_ = rep_ < (int)((REP >> 9) & 1u); (void)dry_;
    phase_attn(wv, getargs(), lds);
    }
#endif
    GSYNC();
#if !(DIS & (1u << 10))
    for (int rep_ = 0; rep_ < ((REP >> 10) & 1u) + 1; ++rep_) { const int dry_ = rep_ < (int)((REP >> 10) & 1u); (void)dry_;
    { EpiRes<false> E{getargs().in(0), XBP, RSS + 1 * S, dry_};
      pg8::gemm_phase<false>(wv, lds, (const bf16_t*)(WSB + O_MIX), 1024, (const bf16_t*)(WSB + O_WO1T), 1024, 1024, 64, 4, E); }
    }
#endif
    GSYNC();
#if !(DIS & (1u << 11))
    for (int rep_ = 0; rep_ < ((REP >> 11) & 1u) + 1; ++rep_) { const int dry_ = rep_ < (int)((REP >> 11) & 1u); (void)dry_;
    { EpiUp E{(bf16_t*)(WSB + O_ACT), RSS + 1 * S, getargs().in(24), getargs().in(25), lds + 131072};
      pg8::gemm_phase<true>(wv, lds, XBP, 1024, (const bf16_t*)(WSB + O_WUPT0), 1024, 1024, 67, 22, E); }
    }
#endif
    GSYNC();
#if !(DIS & (1u << 12))
    for (int rep_ = 0; rep_ < ((REP >> 12) & 1u) + 1; ++rep_) { const int dry_ = rep_ < (int)((REP >> 12) & 1u); (void)dry_;
    { EpiRes<true> E{nullptr, XBP, RSS + 2 * S, dry_};
      pg8::gemm_phase<false>(wv, lds, (const bf16_t*)(WSB + O_ACT), 2816, (const bf16_t*)(WSB + O_WDNT0), 2816, 2816, 64, 4, E); }
    }
#endif
    GSYNC();
#if !(DIS & (1u << 13))
    for (int rep_ = 0; rep_ < ((REP >> 13) & 1u) + 1; ++rep_) { const int dry_ = rep_ < (int)((REP >> 13) & 1u); (void)dry_;
    { EpiQOK E{(bf16_t*)(WSB + O_QOK), RSS + 2 * S, (bf16_t*)(WSB + O_KVT)};
      pg8::gemm_phase<false>(wv, lds, XBP, 1024, (const bf16_t*)(WSB + O_WOINT), 1024, 1024, 64, 8, E); }
    }
#endif
#if !(DIS & (1u << 14))
    for (int rep_ = 0; rep_ < ((REP >> 14) & 1u) + 1; ++rep_) { const int dry_ = rep_ < (int)((REP >> 14) & 1u); (void)dry_;
    { EpiColBf16<1> E{(bf16_t*)(WSB + O_KVT) + (size_t)512 * S, S, RSS + 2 * S};
      pg8::gemm_phase<false>(wv, lds, (const bf16_t*)(WSB + O_WOINT) + (size_t)2048 * 1024, 1024, XBP, 1024, 1024, 4, 64, E); }
    }
#endif
#if !(DIS & (1u << 15))
    for (int rep_ = 0; rep_ < ((REP >> 15) & 1u) + 1; ++rep_) { const int dry_ = rep_ < (int)((REP >> 15) & 1u); (void)dry_;
    phase_m_gates(wv, getargs(), lds);
    }
#endif
    GSYNC();
#if !(DIS & (1u << 16))
    for (int rep_ = 0; rep_ < ((REP >> 16) & 1u) + 1; ++rep_) { const int dry_ = rep_ < (int)((REP >> 16) & 1u); (void)dry_;
    phase_m_dc(wv, getargs());
    }
#endif
    GSYNC();
#if !(DIS & (1u << 22))
    for (int rep_ = 0; rep_ < ((REP >> 22) & 1u) + 1; ++rep_) { const int dry_ = rep_ < (int)((REP >> 22) & 1u); (void)dry_;
    phase_m_comb(wv, getargs(), lds, dry_);
    }
#endif
    GSYNC();
#if !(DIS & (1u << 17))
    for (int rep_ = 0; rep_ < ((REP >> 17) & 1u) + 1; ++rep_) { const int dry_ = rep_ < (int)((REP >> 17) & 1u); (void)dry_;
    phase_m_out(wv, getargs(), lds, dry_);
    }
#endif
    GSYNC();
#if !(DIS & (1u << 18))
    for (int rep_ = 0; rep_ < ((REP >> 18) & 1u) + 1; ++rep_) { const int dry_ = rep_ < (int)((REP >> 18) & 1u); (void)dry_;
    { EpiRes<true> E{nullptr, XBP, RSS + 3 * S, dry_};
      pg8::gemm_phase<false>(wv, lds, (const bf16_t*)(WSB + O_QOK) + 512, 2048, (const bf16_t*)(WSB + O_WO2T), 1024, 1024, 64, 4, E); }
    }
#endif
    GSYNC();
#if !(DIS & (1u << 19))
    for (int rep_ = 0; rep_ < ((REP >> 19) & 1u) + 1; ++rep_) { const int dry_ = rep_ < (int)((REP >> 19) & 1u); (void)dry_;
    { EpiUp E{(bf16_t*)(WSB + O_ACT), RSS + 3 * S, getargs().in(24) + 3 * 5632, getargs().in(25) + 5632, lds + 131072};
      pg8::gemm_phase<true>(wv, lds, XBP, 1024, (const bf16_t*)(WSB + O_WUPT1), 1024, 1024, 67, 22, E); }
    }
#endif
    GSYNC();
#if !(DIS & (1u << 20))
    for (int rep_ = 0; rep_ < ((REP >> 20) & 1u) + 1; ++rep_) { const int dry_ = rep_ < (int)((REP >> 20) & 1u); (void)dry_;
    { EpiRes<true> E{nullptr, XBP, RSS + 4 * S, dry_};
      pg8::gemm_phase<false>(wv, lds, (const bf16_t*)(WSB + O_ACT), 2816, (const bf16_t*)(WSB + O_WDNT1), 2816, 2816, 64, 4, E); }
    }
#endif
    GSYNC();
#if !(DIS & (1u << 21))
    for (int rep_ = 0; rep_ < ((REP >> 21) & 1u) + 1; ++rep_) { const int dry_ = rep_ < (int)((REP >> 21) & 1u); (void)dry_;
    phase_final(wv, getargs());
    }
#endif
    for (int i = 0; i < XSYNC; ++i) GSYNC();
}

extern "C" void kernel_launch(void* const* d_in, const int* in_sizes, int n_in, void* d_out, int out_size, void* d_ws, size_t ws_size, hipStream_t stream) {
    static int grid = 0;
    if (grid == 0) {
        if (n_in != 28 || out_size != S * 1024 || ws_size < WS_NEED) { fprintf(stderr, "kernel_launch: unexpected shapes (n_in %d out %d ws %zu need %zu)\n", n_in, out_size, ws_size, (size_t)WS_NEED); grid = -1; return; }
        int dev = 0, cus = 0, per_cu = 0;
        (void)hipGetDevice(&dev);
        (void)hipDeviceGetAttribute(&cus, hipDeviceAttributeMultiprocessorCount, dev);
        if (hipFuncSetAttribute((const void*)fwd_kernel, hipFuncAttributeMaxDynamicSharedMemorySize, LDS_BYTES) != hipSuccess) { fprintf(stderr, "kernel_launch: hipFuncSetAttribute failed\n"); grid = -1; return; }
        if (hipOccupancyMaxActiveBlocksPerMultiprocessor(&per_cu, (const void*)fwd_kernel, 512, LDS_BYTES) != hipSuccess || per_cu < 1) { fprintf(stderr, "kernel_launch: occupancy query says %d\n", per_cu); per_cu = 1; }
        (void)hipGetLastError();
        grid = cus * 1;
        if (grid > 256) grid = 256;
    }
    if (grid < 0) return;
    Args a{};
    for (int i = 0; i < 28; ++i) a.in[i] = (const float*)d_in[i];
    a.out = (float*)d_out; a.ws = (unsigned char*)d_ws;
    if (hipMemsetAsync((char*)d_ws + O_BAR, 0, BAR_BYTES, stream) != hipSuccess) { fprintf(stderr, "kernel_launch: memset failed\n"); return; }
    void* args[] = {&a};
    hipError_t e = hipLaunchCooperativeKernel((void*)fwd_kernel, dim3(grid), dim3(512), args, LDS_BYTES, stream);
    if (e != hipSuccess) fprintf(stderr, "kernel_launch: cooperative launch failed: %s (grid %d)\n", hipGetErrorString(e), grid);
}
```

```cpp
#include <hip/hip_runtime.h>
#include <hip/hip_cooperative_groups.h>
#include <cstdio>
#include <cstdint>
namespace cg = cooperative_groups;

typedef unsigned short bf16_t;
typedef short bf16x8 __attribute__((ext_vector_type(8)));
typedef short s16x4 __attribute__((ext_vector_type(4)));
typedef float f32x2 __attribute__((ext_vector_type(2)));
typedef float f32x4 __attribute__((ext_vector_type(4)));
typedef float f32x16 __attribute__((ext_vector_type(16)));
typedef unsigned u32x2 __attribute__((ext_vector_type(2)));
typedef unsigned u32x4 __attribute__((ext_vector_type(4)));
typedef __bf16 bf16x2_t __attribute__((ext_vector_type(2)));
#define LAS __attribute__((address_space(3)))
#define DI __device__ __forceinline__

constexpr int S = 16384;
constexpr float EPS = 1e-6f;
constexpr float LOG2E = 1.4426950408889634f;

constexpr size_t SZ_WUPT = (size_t)5632 * 1024 * 2, SZ_WDNT = (size_t)1024 * 2816 * 2;
constexpr size_t O_WUPT1 = 0;
constexpr size_t O_WDNT1 = O_WUPT1 + SZ_WUPT;
constexpr size_t O_WOINT = O_WDNT1 + SZ_WDNT;
constexpr size_t O_WO2T = O_WOINT + (size_t)3072 * 1024 * 2;
constexpr size_t O_ROWSS = O_WO2T + (size_t)1024 * 1024 * 2;
constexpr size_t O_RSQ = O_ROWSS + (size_t)5 * S * 8;
constexpr size_t O_RSKV = O_RSQ + (size_t)S * 4;
constexpr size_t O_CSTAB = O_RSKV + (size_t)S * 4;
constexpr size_t O_CHA = O_CSTAB + (size_t)S * 32 * 4;
constexpr size_t O_CHH = O_CHA + (size_t)256 * 512 * 4;
constexpr size_t O_GB = O_CHH + (size_t)256 * 512 * 4;
constexpr size_t O_GE = O_GB + (size_t)4 * S * 4;
constexpr size_t O_GPM = O_GE + (size_t)4 * S * 4;
constexpr size_t O_BL = O_GPM + (size_t)4 * S * 4;
constexpr size_t O_ML = O_BL + 4096;
constexpr size_t O_MST = O_ML + 4096;
constexpr size_t O_NST = O_MST + 4096;
constexpr size_t O_BAR = O_NST + (size_t)256 * 4 * 128 * 4;
constexpr size_t BAR_BYTES = 16384;
constexpr size_t O_XB = O_BAR + BAR_BYTES;
constexpr size_t XB_ROWS = 16648;
constexpr size_t O_L0W = O_XB + XB_ROWS * 2048;
constexpr size_t O_W1T = O_L0W;
constexpr size_t O_WQT = O_W1T + (size_t)1536 * 1024 * 2;
constexpr size_t O_WKT = O_WQT + (size_t)768 * 256 * 2;
constexpr size_t O_WVT = O_WKT + (size_t)512 * 256 * 2;
constexpr size_t O_WRIT = O_WVT + (size_t)512 * 256 * 2;
constexpr size_t O_WO1T = O_WRIT + (size_t)1024 * 512 * 2;
constexpr size_t O_WUPT0 = O_WO1T + (size_t)1024 * 1024 * 2;
constexpr size_t O_WDNT0 = O_WUPT0 + SZ_WUPT;
constexpr size_t O_ARENA = O_WDNT0 + SZ_WDNT;
constexpr size_t O_Z = O_ARENA;
constexpr size_t O_XC = O_Z + (size_t)S * 1536 * 2;
constexpr size_t O_QB = O_XC + (size_t)S * 512 * 2;
constexpr size_t O_KB = O_QB + (size_t)8 * S * 96 * 2;
constexpr size_t O_VT = O_KB + (size_t)8 * S * 96 * 2;
constexpr size_t O_MIX = O_VT + (size_t)512 * S * 2;
constexpr size_t O_END0 = O_MIX + (size_t)S * 1024 * 2;
constexpr size_t O_ACT = O_ARENA;
constexpr size_t O_RI = O_XB;
constexpr size_t O_CST = O_L0W;
constexpr size_t O_QOK = O_CST + (size_t)256 * 4 * 256 * 128 * 2;
constexpr size_t O_KVT = O_QOK + (size_t)S * 2048 * 2;
constexpr size_t O_END1 = O_KVT + (size_t)1536 * S * 2;
constexpr size_t WS_NEED = (O_END0 > O_END1 ? O_END0 : O_END1);
static_assert(WS_NEED <= (size_t)268435456, "workspace");
static_assert(O_ACT + (size_t)(S + 240) * 2816 * 2 <= (size_t)268435456, "act");

constexpr int LDS_BYTES = 147456;

struct Args {
    const float* in[28];
    float* out;
    unsigned char* ws;
    int pad; int pad2;
};

struct ArgP { const __attribute__((address_space(4))) Args* p;
    DI const float* in(int i) const { return p->in[i]; } DI float* out() const { return p->out; } DI unsigned char* ws() const { return p->ws; } };
DI unsigned pk2(float lo, float hi) { f32x2 v = {lo, hi}; bf16x2_t b = __builtin_convertvector(v, bf16x2_t); return __builtin_bit_cast(unsigned, b); }
DI bf16_t f2bf(float f) { return (bf16_t)(pk2(f, 0.f) & 0xffffu); }
DI int ltid(int wv) { asm volatile("" : "+s"(wv)); int l = __builtin_amdgcn_mbcnt_hi(~0u, __builtin_amdgcn_mbcnt_lo(~0u, 0u)); asm volatile("" : "+v"(l)); return wv * 64 + l; }
DI int lbid() { int t = blockIdx.x; asm volatile("" : "+s"(t)); return t; }
DI float bf2f(bf16_t b) { return __uint_as_float(((unsigned)b) << 16); }
DI float bflo(unsigned u) { return __uint_as_float(u << 16); }
DI float bfhi(unsigned u) { return __uint_as_float(u & 0xffff0000u); }
DI float wave_sum(float v) {
#pragma unroll
    for (int o = 1; o < 64; o <<= 1) v += __shfl_xor(v, o);
    return v;
}
DI float fexp(float x) { return __builtin_amdgcn_exp2f(x * LOG2E); }
DI float sigmoidf_(float x) { return __builtin_amdgcn_rcpf(1.f + fexp(-x)); }
DI int crow(int r, int hi) { return (r & 3) + 8 * (r >> 2) + 4 * hi; }
typedef unsigned long long u64;
DI float rs_from_ss(u64 ssq) { return rsqrtf((float)ssq * (1.f / (1048576.f * 1024.f)) + EPS); }
DI u64 ss_to_fix(float ss) { return (u64)(ss * 1048576.f); }

namespace pg8 {
constexpr int BM = 256, BK = 64, HALF = 128, HTB = HALF * BK * 2, STAGE_BYTES = 8 * HTB, NXCD = 8, WGM = 8;
DI int lds_byte(int r, int c) { const int st = (r >> 4) * 2 + (c >> 5), rr = r & 15, cc = c & 31, ob = rr * 64 + cc * 2; return st * 1024 + (ob ^ (((ob >> 9) & 1) << 5)); }
DI void stage_rc(int b, int& R, int& C) { const int st = b / 1024, sb = b % 1024, swz = sb ^ (((sb >> 9) & 1) << 5); R = (st >> 1) * 16 + swz / 64; C = (st & 1) * 32 + (swz % 64) / 2; }
DI int perm32(int rho) { const int n = rho >> 4, i = rho & 15; return 8 * (i >> 2) + 4 * n + (i & 3); }
struct Unit { int pm, pn; };
struct StaticOrder {
    int nM, nN, nwg, G, c;
    DI void init(int nM_, int nN_, int G_, int c_) { nM = nM_; nN = nN_; nwg = nM * nN; G = G_; c = c_; }
    DI bool next(int i, Unit& u) const {
        const long L = (long)i * G + c; if (L >= nwg) return false;
        int wgid = (int)L; { const int q = nwg / NXCD, r = nwg % NXCD, xcd = wgid % NXCD, off = wgid / NXCD; wgid = (xcd < r ? xcd * (q + 1) : r * (q + 1) + (xcd - r) * q) + off; }
        const int nig = WGM * nN, gid = wgid / nig, fm = gid * WGM, gsz = (nM - fm) < WGM ? (nM - fm) : WGM;
        u.pm = fm + ((wgid % nig) % gsz); u.pn = (wgid % nig) / gsz; return true;
    }
};

template <bool AMAP, class Epi, bool KOFS = false>
DI void gemm_phase(int wv, LAS unsigned char* lds, const bf16_t* A, int lda, const bf16_t* Bt, int ldb, int K_, int nM, int nN, const Epi& E, int rot = 0) {
    int K = K_; asm volatile("" : "+s"(K));
    const int tid = ltid(wv), wid = __builtin_amdgcn_readfirstlane(tid >> 6), lane = tid & 63, wr = wid >> 2, wc = wid & 3, fr = lane & 15, fq = lane >> 4;
    const int nt = K / BK;
    StaticOrder SO; { int c_ = lbid() - rot; if (c_ < 0) c_ += (int)gridDim.x; SO.init(nM, nN, (int)gridDim.x, c_); }
    unsigned voffA[2], voffB[2];
#pragma unroll
    for (int i = 0; i < 2; ++i) { int R, C; stage_rc(tid * 16 + i * 8192, R, C); const int Rb = (R & ~31) + perm32(R & 31);
        const int Ra = AMAP ? (62 * (R >> 6) + (R & 63) - 2) : R;
        voffA[i] = (unsigned)((Ra + (AMAP ? 2 : 0)) * lda + C) * 2u; voffB[i] = (unsigned)(Rb * ldb + C) * 2u; }
    const size_t kstep = (size_t)(BK * 2);
    const size_t hstepA = (size_t)(AMAP ? 124 : 128) * lda * 2, hstepB = (size_t)HALF * ldb * 2;
    const size_t tstepA = 2 * hstepA, tstepB = 2 * hstepB;
    const unsigned ldsw = (unsigned)wid * 1024u;
    const int aoff = lds_byte(wr * 64 + fr, fq * 8), boff = lds_byte(wc * 32 + fr, fq * 8);
#define PG8_SA(b, h) (((b) * 2 + (h)) * HTB)
#define PG8_SB(b, h) ((4 + (b) * 2 + (h)) * HTB)
#define PG8_STAGE(bufoff, gbase, voff) do { _Pragma("unroll") for (int _i = 0; _i < 2; ++_i) \
        __builtin_amdgcn_global_load_lds((const unsigned*)((const char*)(gbase) + (voff)[_i]), (LAS unsigned*)(lds + (bufoff) + ldsw + _i * 8192), 16, 0, 0); } while (0)
#define PG8_LDA(dst, b, h) do { _Pragma("unroll") for (int m = 0; m < 4; ++m) _Pragma("unroll") for (int k = 0; k < 2; ++k) dst[m][k] = *(const LAS bf16x8*)(lds + PG8_SA(b, h) + aoff + m * 2048 + k * 1024); } while (0)
#define PG8_LDB(dst, b, h) do { _Pragma("unroll") for (int n = 0; n < 2; ++n) _Pragma("unroll") for (int k = 0; k < 2; ++k) dst[n][k] = *(const LAS bf16x8*)(lds + PG8_SB(b, h) + boff + n * 2048 + k * 1024); } while (0)
#define PG8_MMA(ai, bj, At, Bt_) do { __builtin_amdgcn_s_setprio(1); _Pragma("unroll") for (int m = 0; m < 4; ++m) _Pragma("unroll") for (int n = 0; n < 2; ++n) _Pragma("unroll") for (int k = 0; k < 2; ++k) \
        acc[ai][bj][m][n] = __builtin_amdgcn_mfma_f32_16x16x32_bf16(Bt_[n][k], At[m][k], acc[ai][bj][m][n], 0, 0, 0); __builtin_amdgcn_s_setprio(0); } while (0)
#define PG8_WAIT_V(n) asm volatile("s_waitcnt vmcnt(" #n ")" ::: "memory")
#define PG8_WAIT_L(n) asm volatile("s_waitcnt lgkmcnt(" #n ")" ::: "memory")
#define PG8_BAR __builtin_amdgcn_s_barrier()
#define PG8_SCHED __builtin_amdgcn_sched_barrier(0)
    if (AMAP) A -= 2 * lda;
    Unit cur, nxt; int ui = 0;
    if (!SO.next(0, cur)) return;
    f32x4 acc[2][2][4][2];
#pragma unroll
    for (int a = 0; a < 2; ++a)
#pragma unroll
        for (int b = 0; b < 2; ++b)
#pragma unroll
            for (int m = 0; m < 4; ++m)
#pragma unroll
                for (int n = 0; n < 2; ++n) acc[a][b][m][n] = (f32x4){0.f, 0.f, 0.f, 0.f};
    bf16x8 At[4][2], B0[2][2], B1[2][2];
    const char* cA = (const char*)A + (size_t)cur.pm * tstepA + (KOFS ? (cur.pn & 1) * 512 : 0); const char* cB = (const char*)Bt + (size_t)cur.pn * tstepB + (KOFS ? (cur.pn & 1) * 512 : 0);
    PG8_STAGE(PG8_SB(0, 0), cB, voffB); PG8_STAGE(PG8_SB(0, 1), cB + hstepB, voffB); PG8_STAGE(PG8_SA(0, 0), cA, voffA); PG8_STAGE(PG8_SA(0, 1), cA + hstepA, voffA);
    if (wr == 1) PG8_BAR;
    PG8_WAIT_V(2); PG8_BAR;
    PG8_STAGE(PG8_SB(1, 0), cB + kstep, voffB); PG8_STAGE(PG8_SA(1, 0), cA + kstep, voffA); PG8_STAGE(PG8_SB(1, 1), cB + hstepB + kstep, voffB);
    PG8_WAIT_V(6); PG8_BAR;
    for (;;) {
        const bool has_next = SO.next(ui + 1, nxt);
        const char* nA = has_next ? (const char*)A + (size_t)nxt.pm * tstepA + (KOFS ? (nxt.pn & 1) * 512 : 0) : cA; const char* nB = has_next ? (const char*)Bt + (size_t)nxt.pn * tstepB + (KOFS ? (nxt.pn & 1) * 512 : 0) : cB;
        for (int t = 0; t < nt; t += 2) {
            const bool last = (t == nt - 2);
            const char* a1 = cA + (size_t)(t + 1) * kstep;
            const char* a2 = last ? nA : cA + (size_t)(t + 2) * kstep; const char* b2 = last ? nB : cB + (size_t)(t + 2) * kstep;
            const char* a3 = a2 + kstep; const char* b3 = b2 + kstep;
            PG8_LDB(B0, 0, 0); PG8_LDB(B1, 0, 1); PG8_SCHED; PG8_LDA(At, 0, 0); PG8_STAGE(PG8_SA(1, 1), a1 + hstepA, voffA);
            PG8_WAIT_V(8); PG8_WAIT_L(0); PG8_BAR; PG8_MMA(0, 0, At, B0); PG8_MMA(0, 1, At, B1); PG8_BAR; PG8_SCHED;
            PG8_LDA(At, 0, 1); PG8_STAGE(PG8_SB(0, 0), b2, voffB); PG8_STAGE(PG8_SB(0, 1), b2 + hstepB, voffB); PG8_STAGE(PG8_SA(0, 0), a2, voffA);
            PG8_WAIT_V(8); PG8_WAIT_L(0); PG8_BAR; PG8_MMA(1, 0, At, B0); PG8_MMA(1, 1, At, B1); PG8_BAR; PG8_SCHED;
            PG8_LDB(B0, 1, 0); PG8_LDB(B1, 1, 1); PG8_SCHED; PG8_LDA(At, 1, 0); PG8_STAGE(PG8_SA(0, 1), a2 + hstepA, voffA);
            PG8_WAIT_V(8); PG8_WAIT_L(0); PG8_BAR; PG8_MMA(0, 0, At, B0); PG8_MMA(0, 1, At, B1); PG8_BAR; PG8_SCHED;
            PG8_LDA(At, 1, 1); PG8_STAGE(PG8_SB(1, 0), b3, voffB); PG8_STAGE(PG8_SB(1, 1), b3 + hstepB, voffB); PG8_STAGE(PG8_SA(1, 0), a3, voffA);
            PG8_WAIT_V(8); PG8_WAIT_L(0); PG8_BAR; PG8_MMA(1, 0, At, B0); PG8_MMA(1, 1, At, B1); PG8_BAR; PG8_SCHED;
        }
        if (wr == 0) PG8_BAR;
        E(acc, cur, wr, wc, fr, fq);
        if (!has_next) break;
#pragma unroll
        for (int a = 0; a < 2; ++a)
#pragma unroll
            for (int b = 0; b < 2; ++b)
#pragma unroll
                for (int m = 0; m < 4; ++m)
#pragma unroll
                    for (int n = 0; n < 2; ++n) acc[a][b][m][n] = (f32x4){0.f, 0.f, 0.f, 0.f};
        cur = nxt; cA = nA; cB = nB; ++ui;
        if (wr == 1) PG8_BAR;
    }
    PG8_WAIT_V(0);
    PG8_BAR;
#undef PG8_SA
#undef PG8_SB
#undef PG8_STAGE
#undef PG8_LDA
#undef PG8_LDB
#undef PG8_MMA
#undef PG8_WAIT_V
#undef PG8_WAIT_L
#undef PG8_BAR
#undef PG8_SCHED
}
}
using pg8::Unit;
typedef f32x4 AccT[2][2][4][2];

template <int SMODE> struct EpiRowBf16 {
    bf16_t* O; int ldc; const void* sc;
    DI void operator()(const AccT& acc, const Unit& u, int wr, int wc, int fr, int fq) const {
        const int row0 = u.pm * 256 + wr * 64 + fr, col0 = u.pn * 256 + wc * 32 + 8 * fq;
#pragma unroll
        for (int ai = 0; ai < 2; ++ai)
#pragma unroll
            for (int m = 0; m < 4; ++m) { const int row = row0 + ai * 128 + m * 16;
                float s = 1.f; if (SMODE == 1) s = rs_from_ss(((const u64*)sc)[row]); if (SMODE == 2) s = ((const float*)sc)[row];
                bf16_t* rowp = O + (size_t)row * ldc + col0;
#pragma unroll
                for (int bj = 0; bj < 2; ++bj) { const f32x4 v0 = acc[ai][bj][m][0] * s, v1 = acc[ai][bj][m][1] * s;
                    u32x4 w; w.x = pk2(v0[0], v0[1]); w.y = pk2(v0[2], v0[3]); w.z = pk2(v1[0], v1[1]); w.w = pk2(v1[2], v1[3]);
                    *(u32x4*)(rowp + bj * 128) = w; } }
    }
};
struct EpiQOK {
    bf16_t* O; const void* sc; bf16_t* KT;
    DI void operator()(const AccT& acc, const Unit& u, int wr, int wc, int fr, int fq) const {
        const int row0 = u.pm * 256 + wr * 64 + fr, col0 = u.pn * 256 + wc * 32 + 8 * fq;
#pragma unroll
        for (int ai = 0; ai < 2; ++ai)
#pragma unroll
            for (int m = 0; m < 4; ++m) { const int row = row0 + ai * 128 + m * 16;
                const float s = rs_from_ss(((const u64*)sc)[row]);
                bf16_t* rowp = O + (size_t)row * 2048 + col0;
#pragma unroll
                for (int bj = 0; bj < 2; ++bj) { const f32x4 v0 = acc[ai][bj][m][0] * s, v1 = acc[ai][bj][m][1] * s;
                    u32x4 w; w.x = pk2(v0[0], v0[1]); w.y = pk2(v0[2], v0[3]); w.z = pk2(v1[0], v1[1]); w.w = pk2(v1[2], v1[3]);
                    *(u32x4*)(rowp + bj * 128) = w;
                    if (u.pn >= 6) { bf16_t* kt = KT + (size_t)(col0 + bj * 128 - 1536) * S + row;
                        kt[0] = (bf16_t)(w.x & 0xffffu); kt[(size_t)S] = (bf16_t)(w.x >> 16); kt[(size_t)2 * S] = (bf16_t)(w.y & 0xffffu); kt[(size_t)3 * S] = (bf16_t)(w.y >> 16);
                        kt[(size_t)4 * S] = (bf16_t)(w.z & 0xffffu); kt[(size_t)5 * S] = (bf16_t)(w.z >> 16); kt[(size_t)6 * S] = (bf16_t)(w.w & 0xffffu); kt[(size_t)7 * S] = (bf16_t)(w.w >> 16); } } }
    }
};
template <int SMODE> struct EpiColBf16 {
    bf16_t* O; int ldc; const void* sc;
    DI void operator()(const AccT& acc, const Unit& u, int wr, int wc, int fr, int fq) const {
        const int row0 = u.pm * 256 + wr * 64 + fr, col0 = u.pn * 256 + wc * 32 + 8 * fq;
#pragma unroll
        for (int bj = 0; bj < 2; ++bj) { float s[8];
#pragma unroll
            for (int j = 0; j < 8; ++j) s[j] = (SMODE == 1) ? rs_from_ss(((const u64*)sc)[col0 + bj * 128 + j]) : ((const float*)sc)[col0 + bj * 128 + j];
#pragma unroll
            for (int ai = 0; ai < 2; ++ai)
#pragma unroll
                for (int m = 0; m < 4; ++m) { const int row = row0 + ai * 128 + m * 16; const f32x4 v0 = acc[ai][bj][m][0], v1 = acc[ai][bj][m][1];
                    u32x4 w; w.x = pk2(v0[0] * s[0], v0[1] * s[1]); w.y = pk2(v0[2] * s[2], v0[3] * s[3]); w.z = pk2(v1[0] * s[4], v1[1] * s[5]); w.w = pk2(v1[2] * s[6], v1[3] * s[7]);
                    *(u32x4*)(O + (size_t)row * ldc + col0 + bj * 128) = w; } }
    }
};
struct EpiQ {
    bf16_t* QB; const float* rsq; const float* cstab;
    DI void operator()(const AccT& acc, const Unit& u, int wr, int wc, int fr, int fq) const {
        const int row0 = u.pm * 256 + wr * 64 + fr, col0 = u.pn * 256 + wc * 32 + 8 * fq;
        const float QS = 0.10206207261596577f * LOG2E;
#pragma unroll
        for (int ai = 0; ai < 2; ++ai)
#pragma unroll
            for (int m = 0; m < 4; ++m) { const int t = row0 + ai * 128 + m * 16; const float s = rsq[t] * QS;
#pragma unroll
                for (int bj = 0; bj < 2; ++bj) { const int c = col0 + bj * 128, h = c / 96, d = c - h * 96;
                    f32x4 v0 = acc[ai][bj][m][0] * s, v1 = acc[ai][bj][m][1] * s;
                    if (d >= 64) { const int i0 = (d - 64) >> 1; const f32x4 cs0 = *(const f32x4*)(cstab + (size_t)t * 32 + 2 * i0), cs1 = *(const f32x4*)(cstab + (size_t)t * 32 + 2 * i0 + 4);
                        f32x4 a, b;
                        a[0] = v0[0] * cs0[0] - v0[1] * cs0[1]; a[1] = v0[1] * cs0[0] + v0[0] * cs0[1];
                        a[2] = v0[2] * cs0[2] - v0[3] * cs0[3]; a[3] = v0[3] * cs0[2] + v0[2] * cs0[3];
                        b[0] = v1[0] * cs1[0] - v1[1] * cs1[1]; b[1] = v1[1] * cs1[0] + v1[0] * cs1[1];
                        b[2] = v1[2] * cs1[2] - v1[3] * cs1[3]; b[3] = v1[3] * cs1[2] + v1[2] * cs1[3];
                        v0 = a; v1 = b; }
                    u32x4 w; w.x = pk2(v0[0], v0[1]); w.y = pk2(v0[2], v0[3]); w.z = pk2(v1[0], v1[1]); w.w = pk2(v1[2], v1[3]);
                    *(u32x4*)(QB + ((size_t)h * S + t) * 96 + d) = w; } }
    }
};
struct EpiK {
    bf16_t* KB; const float* rskv;
    DI void operator()(const AccT& acc, const Unit& u, int wr, int wc, int fr, int fq) const {
        const int row0 = u.pm * 256 + wr * 64 + fr, col0 = u.pn * 256 + wc * 32 + 8 * fq;
#pragma unroll
        for (int ai = 0; ai < 2; ++ai)
#pragma unroll
            for (int m = 0; m < 4; ++m) { const int t = row0 + ai * 128 + m * 16; const float s = rskv[t];
#pragma unroll
                for (int bj = 0; bj < 2; ++bj) { const int c = col0 + bj * 128, h = c >> 6, d = c & 63;
                    const f32x4 v0 = acc[ai][bj][m][0] * s, v1 = acc[ai][bj][m][1] * s;
                    u32x4 w; w.x = pk2(v0[0], v0[1]); w.y = pk2(v0[2], v0[3]); w.z = pk2(v1[0], v1[1]); w.w = pk2(v1[2], v1[3]);
                    *(u32x4*)(KB + ((size_t)h * S + t) * 96 + d) = w; } }
    }
};
template <bool RESBF> struct EpiRes {
    const float* res; bf16_t* XB; u64* rowss; int dry;
    DI void operator()(const AccT& acc, const Unit& u, int wr, int wc, int fr, int fq) const {
        const int row0 = u.pm * 256 + wr * 64 + fr, col0 = u.pn * 256 + wc * 32 + 8 * fq;
#pragma unroll
        for (int ai = 0; ai < 2; ++ai)
#pragma unroll
            for (int m = 0; m < 4; ++m) { const int t = row0 + ai * 128 + m * 16; float ss = 0.f;
#pragma unroll
                for (int bj = 0; bj < 2; ++bj) { const size_t o = (size_t)t * 1024 + col0 + bj * 128;
                    f32x4 r0, r1;
                    if (RESBF) { const u32x4 rb = *(const u32x4*)(XB + o); r0 = (f32x4){bflo(rb.x), bfhi(rb.x), bflo(rb.y), bfhi(rb.y)}; r1 = (f32x4){bflo(rb.z), bfhi(rb.z), bflo(rb.w), bfhi(rb.w)}; }
                    else { r0 = __builtin_nontemporal_load((const f32x4*)(res + o)); r1 = __builtin_nontemporal_load((const f32x4*)(res + o + 4)); }
                    const f32x4 v0 = acc[ai][bj][m][0] + r0, v1 = acc[ai][bj][m][1] + r1;
                    u32x4 w; w.x = pk2(v0[0], v0[1]); w.y = pk2(v0[2], v0[3]); w.z = pk2(v1[0], v1[1]); w.w = pk2(v1[2], v1[3]);
                    if (!dry) *(u32x4*)(XB + o) = w;
                    ss += v0[0] * v0[0] + v0[1] * v0[1] + v0[2] * v0[2] + v0[3] * v0[3] + v1[0] * v1[0] + v1[1] * v1[1] + v1[2] * v1[2] + v1[3] * v1[3]; }
                ss += __shfl_xor(ss, 16); ss += __shfl_xor(ss, 32);
                if (fq == 0 && !dry) atomicAdd(rowss + t, ss_to_fix(ss)); }
    }
};
DI float dpp_prev1(float cur, float prevm) {
    const int o = __builtin_amdgcn_update_dpp(0, __builtin_bit_cast(int, prevm), 0x121, 0xf, 0xf, false);
    return __builtin_bit_cast(float, __builtin_amdgcn_update_dpp(o, __builtin_bit_cast(int, cur), 0x111, 0xf, 0xf, false));
}
DI float dpp_prev2(float cur, float prevm) {
    const int o = __builtin_amdgcn_update_dpp(0, __builtin_bit_cast(int, prevm), 0x122, 0xf, 0xf, false);
    return __builtin_bit_cast(float, __builtin_amdgcn_update_dpp(o, __builtin_bit_cast(int, cur), 0x112, 0xf, 0xf, false));
}
struct EpiUp {
    bf16_t* ACT; const u64* rowss; const float* cw; const float* cb; LAS unsigned char* plds;
    DI void operator()(const AccT& acc, const Unit& u, int wr, int wc, int fr, int fq) const {
        const int cl = u.pn * 128 + wc * 32 + 8 * fq;
        LAS float* P = (LAS float*)(plds + (wr * 4 + wc) * 1024);
        { const int lane = fq * 16 + fr, kind = lane >> 3, c4 = 4 * (lane & 7), k3 = kind & 3;
          const float* src = (k3 == 0 ? cb : cw + (k3 - 1) * 5632) + (kind >= 4 ? 2816 : 0) + u.pn * 128 + wc * 32 + c4;
          *(LAS f32x4*)(P + kind * 32 + c4) = *(const f32x4*)src; }
#pragma unroll
        for (int ai = 0; ai < 2; ++ai) {
            const int tok0 = u.pm * 248 + 62 * (2 * ai + wr) - 2 + fr;
            float rs[4];
#pragma unroll
            for (int m = 0; m < 4; ++m) { const int t = tok0 + 16 * m; const int tc = t < 0 ? 0 : (t >= S ? S - 1 : t); const float r = rs_from_ss(rowss[tc]); rs[m] = t < 0 ? 0.f : r; }
            const int row0 = fr < 2 ? (S + 236 + fr) : tok0;
#pragma unroll
            for (int n = 0; n < 2; ++n) {
                const int lc = 8 * fq + 4 * n;
                unsigned wpk[4][2];
#pragma unroll
                for (int jp = 0; jp < 2; ++jp) {
                    const f32x2 bg = *(const LAS f32x2*)(P + lc + 2 * jp), g0 = *(const LAS f32x2*)(P + 32 + lc + 2 * jp), g1 = *(const LAS f32x2*)(P + 64 + lc + 2 * jp), g2 = *(const LAS f32x2*)(P + 96 + lc + 2 * jp);
                    const f32x2 bv = *(const LAS f32x2*)(P + 128 + lc + 2 * jp), v0 = *(const LAS f32x2*)(P + 160 + lc + 2 * jp), v1 = *(const LAS f32x2*)(P + 192 + lc + 2 * jp), v2 = *(const LAS f32x2*)(P + 224 + lc + 2 * jp);
                    f32x2 G[4], V[4];
#pragma unroll
                    for (int m = 0; m < 4; ++m) { G[m] = (f32x2){acc[ai][0][m][n][2 * jp], acc[ai][0][m][n][2 * jp + 1]} * rs[m]; V[m] = (f32x2){acc[ai][1][m][n][2 * jp], acc[ai][1][m][n][2 * jp + 1]} * rs[m]; }
#pragma unroll
                    for (int m = 0; m < 4; ++m) {
                        const f32x2 zz = {0.f, 0.f}; const f32x2 Gp = m ? G[m - 1] : zz, Vp = m ? V[m - 1] : zz;
                        const f32x2 gp1 = {dpp_prev1(G[m].x, Gp.x), dpp_prev1(G[m].y, Gp.y)}, gp2 = {dpp_prev2(G[m].x, Gp.x), dpp_prev2(G[m].y, Gp.y)};
                        const f32x2 vp1 = {dpp_prev1(V[m].x, Vp.x), dpp_prev1(V[m].y, Vp.y)}, vp2 = {dpp_prev2(V[m].x, Vp.x), dpp_prev2(V[m].y, Vp.y)};
                        const f32x2 gc = bg + g0 * gp2 + g1 * gp1 + g2 * G[m];
                        const f32x2 vc = bv + v0 * vp2 + v1 * vp1 + v2 * V[m];
                        const f32x2 xe = gc * (-LOG2E);
                        f32x2 dn = {__builtin_amdgcn_exp2f(xe.x), __builtin_amdgcn_exp2f(xe.y)}; dn = dn + 1.0f;
                        const f32x2 rc = {__builtin_amdgcn_rcpf(dn.x), __builtin_amdgcn_rcpf(dn.y)};
                        const f32x2 rr = gc * rc * vc;
                        wpk[m][jp] = pk2(rr.x, rr.y); }
                }
#pragma unroll
                for (int m = 0; m < 4; ++m) { const int row = m ? tok0 + 16 * m : row0;
                    *(u32x2*)(ACT + (size_t)row * 2816 + cl + 4 * n) = (u32x2){wpk[m][0], wpk[m][1]}; }
                __builtin_amdgcn_sched_barrier(0);
            }
        }
    }
};

template <class F> DI void tr_items(const F& f, int Kdst, int Nrows, bf16_t* WT, LAS float* scr, int gw, int NGW, int lane, int& cum) {
    const int nblk = Nrows / 32, nitems = (Kdst / 64) * nblk;
    int first = (gw - cum) % NGW; if (first < 0) first += NGW; cum = (cum + nitems) % NGW;
    for (int item = first; item < nitems; item += NGW) {
        const int kb = item / nblk, nb = item % nblk, k0 = 64 * kb, n0 = 32 * nb;
        float tv[32];
#pragma unroll
        for (int i = 0; i < 32; ++i) tv[i] = f(k0 + 2 * i + (lane >> 5), n0 + (lane & 31));
#pragma unroll
        for (int i = 0; i < 32; ++i) scr[(2 * i + (lane >> 5)) * 33 + (lane & 31)] = tv[i];
        asm volatile("s_waitcnt lgkmcnt(0)" ::: "memory");
        const int c = lane & 7;
#pragma unroll
        for (int j = 0; j < 4; ++j) { const int n = (lane >> 3) + 8 * j; const LAS float* s = scr + (8 * c) * 33 + n;
            u32x4 o; o.x = pk2(s[0 * 33], s[1 * 33]); o.y = pk2(s[2 * 33], s[3 * 33]); o.z = pk2(s[4 * 33], s[5 * 33]); o.w = pk2(s[6 * 33], s[7 * 33]);
            *(u32x4*)(WT + (size_t)(n0 + n) * Kdst + k0 + 8 * c) = o; }
        asm volatile("s_waitcnt lgkmcnt(0)" ::: "memory");
    }
}
struct FW1 { const float* W; const float* g; DI float operator()(int k, int n) const { return n < 1440 ? __builtin_nontemporal_load(&W[(size_t)k * 1440 + n]) * g[k] : 0.f; } };
struct FWQ { const float* W; const float* g; DI float operator()(int k, int n) const { const int h = n / 96, d = n - h * 96; int c = d; if (d >= 64) { const int r = d - 64; c = 64 + (r >> 1) + 16 * (r & 1); } return __builtin_nontemporal_load(&W[(size_t)k * 768 + h * 96 + c]) * g[k]; } };
struct FWKV { const float* W; const float* g; int off; DI float operator()(int k, int n) const { return k < 128 ? __builtin_nontemporal_load(&W[(size_t)k * 1024 + (n >> 6) * 128 + off + (n & 63)]) * g[k] : 0.f; } };
struct FWRI { const float* Wa; const float* Wx; DI float operator()(int k, int n) const { const float* W = n < 512 ? Wa : Wx; const int ch = n & 511, g = ch >> 6, j = ch & 63; return (k >> 6) == g ? __builtin_nontemporal_load(&W[(size_t)k * 64 + j]) : 0.f; } };
struct FWP { const float* W; int N; DI float operator()(int k, int n) const { return __builtin_nontemporal_load(&W[(size_t)k * N + n]); } };
struct FWUP { const float* W; const float* g; DI float operator()(int k, int n) const { const int pn = n >> 8, r = n & 255; const int c = r < 128 ? 128 * pn + r : 2816 + 128 * pn + r - 128; return __builtin_nontemporal_load(&W[(size_t)k * 5632 + c]) * g[k]; } };
struct FWOIN { const float* W; const float* g; DI float operator()(int k, int n) const {
    int c; float s = 1.f; if (n < 512) { c = n; s = 0.08838834764831845f; } else if (n < 1536) c = 2048 + (n - 512); else if (n < 2048) c = 512 + (n - 1536); else c = 1024 + (n - 2048);
    return __builtin_nontemporal_load(&W[(size_t)k * 3080 + c]) * g[k] * s; } };

#ifndef PROPART
#define PROPART 7
#endif
DI void phase_prologue(int wv, const ArgP a, LAS unsigned char* lds, int parts) {
    unsigned char* ws = a.ws();
    const int tid = ltid(wv), wave = tid >> 6, lane = tid & 63;
    LAS float* scr = (LAS float*)(lds + wave * 8448);
    const int gw = blockIdx.x * 8 + wave, NGW = gridDim.x * 8; int cum = 0;
    if (parts & 1) {
    { FW1 f{a.in(3), a.in(2)}; tr_items(f, 1024, 1536, (bf16_t*)(ws + O_W1T), scr, gw, NGW, lane, cum); }
    { FWQ f{a.in(12), a.in(11)}; tr_items(f, 256, 768, (bf16_t*)(ws + O_WQT), scr, gw, NGW, lane, cum); }
    { FWKV f{a.in(14), a.in(13), 0}; tr_items(f, 256, 512, (bf16_t*)(ws + O_WKT), scr, gw, NGW, lane, cum); }
    { FWKV f{a.in(14), a.in(13), 64}; tr_items(f, 256, 512, (bf16_t*)(ws + O_WVT), scr, gw, NGW, lane, cum); }
    { FWRI f{a.in(6), a.in(8)}; tr_items(f, 512, 1024, (bf16_t*)(ws + O_WRIT), scr, gw, NGW, lane, cum); }
    { FWP f{a.in(15), 1024}; tr_items(f, 1024, 1024, (bf16_t*)(ws + O_WO1T), scr, gw, NGW, lane, cum); }
    for (int l = 0; l < 2; ++l) {
        { FWUP f{a.in(23) + (size_t)l * 1024 * 5632, a.in(22) + l * 1024}; tr_items(f, 1024, 5632, (bf16_t*)(ws + (l ? O_WUPT1 : O_WUPT0)), scr, gw, NGW, lane, cum); }
        { FWP f{a.in(26) + (size_t)l * 2816 * 1024, 1024}; tr_items(f, 2816, 1024, (bf16_t*)(ws + (l ? O_WDNT1 : O_WDNT0)), scr, gw, NGW, lane, cum); }
    }
    { FWOIN f{a.in(17), a.in(16)}; tr_items(f, 1024, 3072, (bf16_t*)(ws + O_WOINT), scr, gw, NGW, lane, cum); }
    { FWP f{a.in(21), 1024}; tr_items(f, 1024, 1024, (bf16_t*)(ws + O_WO2T), scr, gw, NGW, lane, cum); }
    }
    if (parts & 2) {
    const float* x = a.in(0); bf16_t* XB = (bf16_t*)(ws + O_XB) + 2 * 1024; u64* rowss = (u64*)(ws + O_ROWSS);
#pragma unroll 4
    for (int t = gw; t < S; t += NGW) {
        float ss = 0.f;
#pragma unroll
        for (int j = 0; j < 4; ++j) { const f32x4 v = __builtin_nontemporal_load((const f32x4*)(x + (size_t)t * 1024 + j * 256 + lane * 4));
            ss += v[0] * v[0] + v[1] * v[1] + v[2] * v[2] + v[3] * v[3];
            u32x2 w; w.x = pk2(v[0], v[1]); w.y = pk2(v[2], v[3]); *(u32x2*)(XB + (size_t)t * 1024 + j * 256 + lane * 4) = w; }
        ss = wave_sum(ss);
        if (lane == 0) rowss[t] = ss_to_fix(ss);
        if (lane >= 1 && lane < 5) rowss[(size_t)lane * S + t] = 0ull;
    }
    }
    if (parts & 4) {
    const int* pos = (const int*)a.in(1); float* cst = (float*)(ws + O_CSTAB);
    for (int e = blockIdx.x * 512 + tid; e < S * 16; e += gridDim.x * 512) { const int t = e >> 4, i = e & 15;
        const float invf = __builtin_amdgcn_exp2f(-(float)i * (13.287712379549449f / 16.f)); const float ang = (float)pos[t] * invf;
        const float k = rintf(ang * 0.15915494309189535f);
        float r = fmaf(-k, 6.28318548202514648f, ang); r = fmaf(-k, -1.7484555e-7f, r);
        const float rr = r * 0.15915494309189535f;
        cst[2 * e] = __builtin_amdgcn_cosf(rr); cst[2 * e + 1] = __builtin_amdgcn_sinf(rr); }
    }
}

DI void phase_l0_prep(int wv, const ArgP a) {
    unsigned char* ws = a.ws();
    const bf16_t* Z = (const bf16_t*)(ws + O_Z); bf16_t* XC = (bf16_t*)(ws + O_XC); bf16_t* KB = (bf16_t*)(ws + O_KB);
    float* rsq = (float*)(ws + O_RSQ); float* rskv = (float*)(ws + O_RSKV); const float* cst = (const float*)(ws + O_CSTAB);
    const float* cw = a.in(4); const float* cb = a.in(5);
    const int tid = ltid(wv), wave = tid >> 6, lane = tid & 63;
#pragma unroll 2
    for (int e = blockIdx.x * 512 + tid; e < S * 64; e += gridDim.x * 512) { const int t = e >> 6, c0 = (e & 63) * 8;
        float acc[8];
#pragma unroll
        for (int j = 0; j < 8; ++j) acc[j] = cb[c0 + j];
#pragma unroll
        for (int k = 0; k < 4; ++k) { const int tt = t - 3 + k; if (tt < 0) continue;
            const u32x4 v = *(const u32x4*)(Z + (size_t)tt * 1536 + c0);
            const f32x4 w0 = *(const f32x4*)(cw + k * 512 + c0), w1 = *(const f32x4*)(cw + k * 512 + c0 + 4);
            acc[0] += w0[0] * bflo(v.x); acc[1] += w0[1] * bfhi(v.x); acc[2] += w0[2] * bflo(v.y); acc[3] += w0[3] * bfhi(v.y);
            acc[4] += w1[0] * bflo(v.z); acc[5] += w1[1] * bfhi(v.z); acc[6] += w1[2] * bflo(v.w); acc[7] += w1[3] * bfhi(v.w); }
        u32x4 o; o.x = pk2(acc[0], acc[1]); o.y = pk2(acc[2], acc[3]); o.z = pk2(acc[4], acc[5]); o.w = pk2(acc[6], acc[7]);
        *(u32x4*)(XC + (size_t)t * 512 + c0) = o; }
#pragma unroll 4
    for (int t = blockIdx.x * 8 + wave; t < S; t += gridDim.x * 8) {
        const bf16_t* zr = Z + (size_t)t * 1536;
        float sq = 0.f, skv = 0.f;
        { const u32x2 v = *(const u32x2*)(zr + 1024 + lane * 4); const float p0 = bflo(v.x), p1 = bfhi(v.x), p2 = bflo(v.y), p3 = bfhi(v.y); sq = p0 * p0 + p1 * p1 + p2 * p2 + p3 * p3; }
        { const unsigned v = *(const unsigned*)(zr + 1280 + lane * 2); const float p0 = bflo(v), p1 = bfhi(v); skv = p0 * p0 + p1 * p1; }
        sq = wave_sum(sq); skv = wave_sum(skv);
        if (lane == 0) { rsq[t] = rsqrtf(sq * (1.f / 256.f) + EPS); rskv[t] = rsqrtf(skv * (1.f / 128.f) + EPS); }
        if (lane < 16) { const float x1 = bf2f(zr[1408 + lane]), x2 = bf2f(zr[1424 + lane]); const float c = cst[(size_t)t * 32 + 2 * lane], s = cst[(size_t)t * 32 + 2 * lane + 1];
            const unsigned w = pk2(x1 * c - x2 * s, x2 * c + x1 * s);
#pragma unroll
            for (int h = 0; h < 8; ++h) *(unsigned*)(KB + ((size_t)h * S + t) * 96 + 64 + 2 * lane) = w; }
    }
}

DI void lru_coeff(float rpre, float ipre, float xc, float sp8, float& av, float& uv) {
    const float r = sigmoidf_(rpre), ig = sigmoidf_(ipre);
    const float la = -sp8 * r;
    av = fexp(la);
    uv = __builtin_amdgcn_sqrtf(fmaxf(1.f - av * av, 0.f)) * (ig * xc);
}
DI void phase_lru_s1(int wv, const ArgP a) {
    unsigned char* ws = a.ws(); const int ch = ltid(wv);
    const bf16_t* RI = (const bf16_t*)(ws + O_RI); const bf16_t* XC = (const bf16_t*)(ws + O_XC);
    float* CHA = (float*)(ws + O_CHA); float* CHH = (float*)(ws + O_CHH);
    const float ba = a.in(7)[ch], bx = a.in(9)[ch]; const float lam = a.in(10)[ch];
    const float sp8 = 8.f * log1pf(expf(-lam));
    for (int c = blockIdx.x; c < 256; c += gridDim.x) {
        float A = 1.f, H = 0.f;
#pragma unroll 8
        for (int i = 0; i < 64; ++i) { const size_t t = (size_t)c * 64 + i;
            float av, uv; lru_coeff(bf2f(RI[t * 1024 + ch]) + ba, bf2f(RI[t * 1024 + 512 + ch]) + bx, bf2f(XC[t * 512 + ch]), sp8, av, uv);
            A *= av; H = av * H + uv; }
        CHA[c * 512 + ch] = A; CHH[c * 512 + ch] = H;
    }
}
DI void phase_lru_s3(int wv, const ArgP a) {
    unsigned char* ws = a.ws(); const int ch = ltid(wv);
    const bf16_t* RI = (const bf16_t*)(ws + O_RI); const bf16_t* XC = (const bf16_t*)(ws + O_XC); const bf16_t* Z = (const bf16_t*)(ws + O_Z);
    const float* CHA = (const float*)(ws + O_CHA); const float* CHH = (const float*)(ws + O_CHH); bf16_t* MIX = (bf16_t*)(ws + O_MIX);
    const float ba = a.in(7)[ch], bx = a.in(9)[ch]; const float lam = a.in(10)[ch];
    const float sp8 = 8.f * log1pf(expf(-lam));
    for (int c = blockIdx.x; c < 256; c += gridDim.x) {
        float H = 0.f;
        { int cc = 0;
          for (; cc + 28 <= c; cc += 28) { float aa[28], hh[28];
#pragma unroll
              for (int k = 0; k < 28; ++k) { aa[k] = CHA[(cc + k) * 512 + ch]; hh[k] = CHH[(cc + k) * 512 + ch]; }
#pragma unroll
              for (int k = 0; k < 28; ++k) H = aa[k] * H + hh[k]; }
          for (; cc < c; ++cc) H = CHA[cc * 512 + ch] * H + CHH[cc * 512 + ch]; }
#pragma unroll 4
        for (int i = 0; i < 64; ++i) { const size_t t = (size_t)c * 64 + i;
            float av, uv; lru_coeff(bf2f(RI[t * 1024 + ch]) + ba, bf2f(RI[t * 1024 + 512 + ch]) + bx, bf2f(XC[t * 512 + ch]), sp8, av, uv);
            H = av * H + uv;
            const float g = bf2f(Z[t * 1536 + 512 + ch]);
            const float y = 0.7978845608028654f * (g + 0.044715f * g * g * g);
            const float th = 1.f - 2.f * __builtin_amdgcn_rcpf(1.f + fexp(2.f * y));
            MIX[t * 1024 + ch] = f2bf(H * 0.5f * g * (1.f + th)); }
    }
}

constexpr int AT_KROW = 208, AT_VROW = 136, AT_KT = 64 * AT_KROW, AT_VT = 64 * AT_VROW;
DI float rowmax32(const f32x16& p0, const f32x16& p1) {
    float a = fmaxf(fmaxf(p0[0], p0[1]), p1[0]), b = fmaxf(fmaxf(p0[2], p0[3]), p1[1]); a = fmaxf(fmaxf(a, p1[2]), p1[3]);
#pragma unroll
    for (int r = 4; r < 16; r += 4) { a = fmaxf(fmaxf(a, p0[r]), p0[r + 1]); b = fmaxf(fmaxf(b, p0[r + 2]), p0[r + 3]); a = fmaxf(fmaxf(a, p1[r]), p1[r + 1]); b = fmaxf(fmaxf(b, p1[r + 2]), p1[r + 3]); }
    const float m = fmaxf(a, b);
    const auto rr = __builtin_amdgcn_permlane32_swap(__float_as_uint(m), __float_as_uint(m), false, false);
    return fmaxf(__uint_as_float(rr[0]), __uint_as_float(rr[1]));
}
DI void attn_unit(int wv, int h, int qb, const bf16_t* QB, const bf16_t* KB, const bf16_t* VT, bf16_t* MIX, LAS unsigned char* lds) {
    const int tid = ltid(wv), lane = tid & 63, r32 = lane & 31, hi = lane >> 5; const int wid = __builtin_amdgcn_readfirstlane(tid >> 6);
    const int qg = qb * 256 + wid * 32 + r32;
    const bf16_t* Kh = KB + (size_t)h * S * 96; const bf16_t* Vh = VT + (size_t)h * 64 * S;
    bf16x8 qf[6];
    { const bf16_t* qp = QB + ((size_t)h * S + qg) * 96 + 8 * hi;
#pragma unroll
      for (int s = 0; s < 6; ++s) qf[s] = *(const bf16x8*)(qp + 16 * s); }
    f32x16 o0 = {}, o1 = {}, negm = {};
    float mref = 0.f, lrun = 0.f;
    const int NT = 4 * qb + 4, wlim = 4 * qb + (wid >> 1);
    const int kc0 = tid, kkey0 = kc0 / 12, kpart0 = kc0 % 12;
    const int kc1 = tid + 512, kkey1 = kc1 / 12, kpart1 = kc1 % 12;
    const int vdv = tid >> 3, vpart = tid & 7;
    u32x4 rk0, rk1 = {}, rv;
#define AT_LOADK(t_) do { const size_t kb_ = (size_t)(t_) * 64; rk0 = *(const u32x4*)(Kh + (kb_ + kkey0) * 96 + kpart0 * 8); if (tid < 256) rk1 = *(const u32x4*)(Kh + (kb_ + kkey1) * 96 + kpart1 * 8); } while (0)
#define AT_LOADV(t_) do { rv = *(const u32x4*)(Vh + (size_t)vdv * S + (size_t)(t_) * 64 + vpart * 8); } while (0)
#define AT_WRITEK(t_) do { LAS unsigned char* Ks_ = lds + ((t_) & 1) * AT_KT; *(LAS u32x4*)(Ks_ + kkey0 * AT_KROW + kpart0 * 16) = rk0; if (tid < 256) *(LAS u32x4*)(Ks_ + kkey1 * AT_KROW + kpart1 * 16) = rk1; } while (0)
#define AT_WRITEV(t_) do { LAS unsigned char* Vs_ = lds + 2 * AT_KT + ((t_) & 1) * AT_VT; *(LAS u32x2*)(Vs_ + vdv * AT_VROW + vpart * 16) = (u32x2){rv.x, rv.y}; *(LAS u32x2*)(Vs_ + vdv * AT_VROW + vpart * 16 + 8) = (u32x2){rv.z, rv.w}; } while (0)
#define AT_QK(P0, P1, t_) do { const LAS unsigned char* Ks_ = lds + ((t_) & 1) * AT_KT + r32 * AT_KROW + 16 * hi; f32x16 c0_ = negm, c1_ = negm; \
        _Pragma("unroll") for (int s = 0; s < 6; ++s) { const bf16x8 k0_ = *(const LAS bf16x8*)(Ks_ + 32 * s), k1_ = *(const LAS bf16x8*)(Ks_ + 32 * AT_KROW + 32 * s); \
            c0_ = __builtin_amdgcn_mfma_f32_32x32x16_bf16(k0_, qf[s], c0_, 0, 0, 0); c1_ = __builtin_amdgcn_mfma_f32_32x32x16_bf16(k1_, qf[s], c1_, 0, 0, 0); } \
        P0 = c0_; P1 = c1_; } while (0)
#define AT_SM1(P0, P1, MOFF, t_, MASK) do { \
        if (MASK && (t_) == wlim) { const int kbase_ = (t_) * 64 + 4 * hi; \
            _Pragma("unroll") for (int r = 0; r < 16; ++r) { const int kv_ = kbase_ + (r & 3) + 8 * (r >> 2); if (kv_ > qg) P0[r] = -1e30f; if (kv_ + 32 > qg) P1[r] = -1e30f; } } \
        const float d_ = mref - MOFF;                         \
        const float mx_ = rowmax32(P0, P1) - d_;              \
        if ((t_) == 0 || __any(mx_ > 8.f || d_ != 0.f)) { const float dl_ = ((t_) == 0) ? mx_ : fmaxf(mx_, 0.f); mref += dl_; \
            const float sh_ = d_ + dl_; \
            _Pragma("unroll") for (int r = 0; r < 16; ++r) { P0[r] -= sh_; P1[r] -= sh_; } \
            const float al_ = ((t_) == 0) ? 1.f : __builtin_amdgcn_exp2f(-dl_); lrun *= al_;     \
            _Pragma("unroll") for (int r = 0; r < 16; ++r) { o0[r] *= al_; o1[r] *= al_; negm[r] = -mref; } asm volatile("" : "+v"(negm)); } \
    } while (0)
#define AT_SM2(P0, P1, t_) do { \
        float ps_ = 0.f; \
        _Pragma("unroll") for (int r = 0; r < 16; ++r) { P0[r] = __builtin_amdgcn_exp2f(P0[r]); P1[r] = __builtin_amdgcn_exp2f(P1[r]); ps_ += P0[r] + P1[r]; } \
        lrun += ps_; \
        const LAS unsigned char* Vs_ = lds + 2 * AT_KT + ((t_) & 1) * AT_VT + r32 * AT_VROW + 8 * hi; \
        _Pragma("unroll") for (int ks = 0; ks < 4; ++ks) { u32x4 w_; \
            if (ks < 2) { w_.x = pk2(P0[8 * ks], P0[8 * ks + 1]); w_.y = pk2(P0[8 * ks + 2], P0[8 * ks + 3]); w_.z = pk2(P0[8 * ks + 4], P0[8 * ks + 5]); w_.w = pk2(P0[8 * ks + 6], P0[8 * ks + 7]); } \
            else { w_.x = pk2(P1[8 * ks - 16], P1[8 * ks - 15]); w_.y = pk2(P1[8 * ks - 14], P1[8 * ks - 13]); w_.z = pk2(P1[8 * ks - 12], P1[8 * ks - 11]); w_.w = pk2(P1[8 * ks - 10], P1[8 * ks - 9]); } \
            const bf16x8 pa_ = __builtin_bit_cast(bf16x8, w_); \
            const u32x2 a0_ = *(const LAS u32x2*)(Vs_ + 32 * ks), a1_ = *(const LAS u32x2*)(Vs_ + 32 * ks + 16); \
            const u32x2 b0_ = *(const LAS u32x2*)(Vs_ + 32 * AT_VROW + 32 * ks), b1_ = *(const LAS u32x2*)(Vs_ + 32 * AT_VROW + 32 * ks + 16); \
            o0 = __builtin_amdgcn_mfma_f32_32x32x16_bf16(__builtin_bit_cast(bf16x8, (u32x4){a0_.x, a0_.y, a1_.x, a1_.y}), pa_, o0, 0, 0, 0); \
            o1 = __builtin_amdgcn_mfma_f32_32x32x16_bf16(__builtin_bit_cast(bf16x8, (u32x4){b0_.x, b0_.y, b1_.x, b1_.y}), pa_, o1, 0, 0, 0); } \
    } while (0)
#define AT_STEPM(C0, C1, MC, N0, N1, MN, t_) do { \
        AT_WRITEK((t_) + 1); AT_WRITEV(t_); \
        __syncthreads(); \
        AT_LOADK((t_) + 2); AT_LOADV((t_) + 1); \
        AT_SM1(C0, C1, MC, t_, 0); MN = mref; AT_QK(N0, N1, (t_) + 1); AT_SM2(C0, C1, t_); \
    } while (0)
#define AT_STEPB(C0, C1, MC, N0, N1, MN, t_) do { \
        if ((t_) + 1 < NT) AT_WRITEK((t_) + 1); AT_WRITEV(t_); \
        __syncthreads(); \
        if ((t_) + 2 < NT) AT_LOADK((t_) + 2); if ((t_) + 1 < NT) AT_LOADV((t_) + 1); \
        if ((t_) + 1 <= wlim) { MN = mref; AT_QK(N0, N1, (t_) + 1); } \
        if ((t_) <= wlim) { AT_SM1(C0, C1, MC, t_, 1); AT_SM2(C0, C1, t_); } \
    } while (0)
    f32x16 pA0, pA1, pB0 = {}, pB1 = {}; float mA = 0.f, mB = 0.f;
    AT_LOADK(0); AT_WRITEK(0);
    __syncthreads();
    AT_LOADK(1); AT_LOADV(0);
    AT_QK(pA0, pA1, 0);
    int t = 0;
    for (; t < 4 * qb; t += 2) {
        AT_STEPM(pA0, pA1, mA, pB0, pB1, mB, t);
        AT_STEPM(pB0, pB1, mB, pA0, pA1, mA, t + 1);
    }
    for (; t < NT; t += 2) {
        AT_STEPB(pA0, pA1, mA, pB0, pB1, mB, t);
        AT_STEPB(pB0, pB1, mB, pA0, pA1, mA, t + 1);
    }
#undef AT_STEPM
#undef AT_STEPB
#undef AT_LOADK
#undef AT_LOADV
#undef AT_WRITEK
#undef AT_WRITEV
#undef AT_QK
#undef AT_SM1
#undef AT_SM2
    lrun += __shfl_xor(lrun, 32);
    const float inv = 1.f / lrun;
    bf16_t* op = MIX + (size_t)qg * 1024 + 512 + h * 64;
#pragma unroll
    for (int g = 0; g < 4; ++g) { const int dv = 8 * g + 4 * hi;
        u32x2 w; w.x = pk2(o0[4 * g] * inv, o0[4 * g + 1] * inv); w.y = pk2(o0[4 * g + 2] * inv, o0[4 * g + 3] * inv); *(u32x2*)(op + dv) = w;
        u32x2 w2; w2.x = pk2(o1[4 * g] * inv, o1[4 * g + 1] * inv); w2.y = pk2(o1[4 * g + 2] * inv, o1[4 * g + 3] * inv); *(u32x2*)(op + 32 + dv) = w2; }
    __syncthreads();
}
DI void phase_attn(int wv, const ArgP a, LAS unsigned char* lds) {
    unsigned char* ws = a.ws();
    const bf16_t* QB = (const bf16_t*)(ws + O_QB); const bf16_t* KB = (const bf16_t*)(ws + O_KB); const bf16_t* VT = (const bf16_t*)(ws + O_VT); bf16_t* MIX = (bf16_t*)(ws + O_MIX);
    if (wv >= 4) __builtin_amdgcn_s_setprio(1);
    for (int b = blockIdx.x; b < 256; b += gridDim.x) {
        const int v = (b & 7) * 32 + (b >> 3), h = v >> 5, s = v & 31;
        attn_unit(wv, h, 63 - s, QB, KB, VT, MIX, lds);
        attn_unit(wv, h, s, QB, KB, VT, MIX, lds);
    }
    __builtin_amdgcn_s_setprio(0);
}

DI void phase_m_gates(int wv, const ArgP a, LAS unsigned char* lds) {
    unsigned char* ws = a.ws(); const int tid = ltid(wv), wave = tid >> 6, lane = tid & 63;
    const bf16_t* XBr = (const bf16_t*)(ws + O_XB) + 2 * 1024; const u64* rowss = (const u64*)(ws + O_ROWSS) + 2 * S;
    const float* Wg = a.in(17); const float* gn = a.in(16);
    LAS float* wgs = (LAS float*)lds;
    LAS float* pre = (LAS float*)(lds + 32768);
    float* GB = (float*)(ws + O_GB); float* GE = (float*)(ws + O_GE); float* GPM = (float*)(ws + O_GPM);
    float* BL = (float*)(ws + O_BL); float* ML = (float*)(ws + O_ML);
    for (int e = tid; e < 8192; e += 512) { const int k = e >> 3, j = e & 7; wgs[j * 1024 + k] = Wg[(size_t)k * 3080 + 3072 + j] * gn[k]; }
    __syncthreads();
    for (int c = blockIdx.x; c < 256; c += gridDim.x) {
#pragma unroll 4
        for (int i = 0; i < 8; ++i) { const int t = c * 64 + wave * 8 + i;
            float acc[8];
#pragma unroll
            for (int j = 0; j < 8; ++j) acc[j] = 0.f;
#pragma unroll
            for (int jj = 0; jj < 4; ++jj) { const int k0 = jj * 256 + lane * 4; const u32x2 hb = *(const u32x2*)(XBr + (size_t)t * 1024 + k0); const f32x4 hv = {bflo(hb.x), bfhi(hb.x), bflo(hb.y), bfhi(hb.y)};
#pragma unroll
                for (int j = 0; j < 8; ++j) { const f32x4 wj = *(const LAS f32x4*)(wgs + j * 1024 + k0); acc[j] += hv[0] * wj[0] + hv[1] * wj[1] + hv[2] * wj[2] + hv[3] * wj[3]; } }
            const float rs = rs_from_ss(rowss[t]);
            { const bool b5 = lane & 32, b4 = lane & 16, b3 = lane & 8;
#pragma unroll
              for (int j = 0; j < 4; ++j) { const float snd = b5 ? acc[j] : acc[j + 4], kp = b5 ? acc[j + 4] : acc[j]; acc[j] = kp + __shfl_xor(snd, 32); }
#pragma unroll
              for (int j = 0; j < 2; ++j) { const float snd = b4 ? acc[j] : acc[j + 2], kp = b4 ? acc[j + 2] : acc[j]; acc[j] = kp + __shfl_xor(snd, 16); }
              { const float snd = b3 ? acc[0] : acc[1], kp = b3 ? acc[1] : acc[0]; acc[0] = kp + __shfl_xor(snd, 8); }
              acc[0] += __shfl_xor(acc[0], 4); acc[0] += __shfl_xor(acc[0], 2); acc[0] += __shfl_xor(acc[0], 1);
              if ((lane & 7) == 0) pre[(wave * 8 + i) * 8 + (b5 ? 4 : 0) + (b4 ? 2 : 0) + (b3 ? 1 : 0)] = acc[0] * rs; }
        }
        __syncthreads();
        if (wave < 4) { const int h = wave; const float bi = a.in(18)[h], bfg = a.in(19)[h];
            const float ig = 15.f * tanhf((pre[lane * 8 + h] + bi) * (1.f / 15.f));
            const float fg = 15.f * tanhf((pre[lane * 8 + 4 + h] + bfg) * (1.f / 15.f));
            float b = -log1pf(expf(-fg));
#pragma unroll
            for (int o = 1; o < 64; o <<= 1) { const float v = __shfl_up(b, o); if (lane >= o) b += v; }
            const float e = ig - b; float pm = e;
#pragma unroll
            for (int o = 1; o < 64; o <<= 1) { const float v = __shfl_up(pm, o); if (lane >= o) pm = fmaxf(pm, v); }
            const size_t o_ = (size_t)h * S + c * 64 + lane; GB[o_] = b; GE[o_] = e; GPM[o_] = pm;
            if (lane == 63) { BL[c * 4 + h] = b; ML[c * 4 + h] = b + pm; } }
        __syncthreads();
    }
}
DI void phase_m_dc(int wv, const ArgP a) {
    unsigned char* ws = a.ws(); const int tid = ltid(wv), lane = tid & 63, r32 = lane & 31, hi = lane >> 5; const int w = __builtin_amdgcn_readfirstlane(tid >> 6);
    const float* __restrict__ BL = (const float*)(ws + O_BL); const float* __restrict__ ML = (const float*)(ws + O_ML); float* __restrict__ NST = (float*)(ws + O_NST);
    const float* __restrict__ GE = (const float*)(ws + O_GE); const bf16_t* __restrict__ KVT = (const bf16_t*)(ws + O_KVT); bf16_t* __restrict__ CST = (bf16_t*)(ws + O_CST);
#pragma unroll 2
    for (int u = blockIdx.x; u < 1024; u += gridDim.x) {
        const int c = u >> 2, h = u & 3; const size_t t0 = (size_t)c * 64;
        const float emax = ML[c * 4 + h] - BL[c * 4 + h];
        bf16x8 bfr[4];
        { const bf16_t* vp = KVT + (size_t)(512 + h * 256 + 32 * w + r32) * S + t0 + 8 * hi; const float* gp = GE + (size_t)h * S + t0 + 8 * hi;
#pragma unroll
          for (int ks = 0; ks < 4; ++ks) { const u32x4 v = *(const u32x4*)(vp + 16 * ks); const f32x4 e0 = *(const f32x4*)(gp + 16 * ks), e1 = *(const f32x4*)(gp + 16 * ks + 4);
              u32x4 o; o.x = pk2(bflo(v.x) * fexp(e0[0] - emax), bfhi(v.x) * fexp(e0[1] - emax)); o.y = pk2(bflo(v.y) * fexp(e0[2] - emax), bfhi(v.y) * fexp(e0[3] - emax));
              o.z = pk2(bflo(v.z) * fexp(e1[0] - emax), bfhi(v.z) * fexp(e1[1] - emax)); o.w = pk2(bflo(v.w) * fexp(e1[2] - emax), bfhi(v.w) * fexp(e1[3] - emax));
              bfr[ks] = __builtin_bit_cast(bf16x8, o); } }
        const bf16_t* kp = KVT + (size_t)(h * 128 + r32) * S + t0 + 8 * hi;
        bf16_t* op = CST + ((size_t)(c * 4 + h) * 256 + 32 * w + r32) * 128 + 8 * hi;
#pragma unroll
        for (int rb = 0; rb < 4; ++rb) { f32x16 acc = {};
#pragma unroll
            for (int ks = 0; ks < 4; ++ks) { const bf16x8 ka = *(const bf16x8*)(kp + (size_t)(32 * rb) * S + 16 * ks); acc = __builtin_amdgcn_mfma_f32_32x32x16_bf16(ka, bfr[ks], acc, 0, 0, 0); }
#pragma unroll
            for (int p = 0; p < 2; ++p) {
                const unsigned a0 = pk2(acc[8 * p], acc[8 * p + 1]), a1 = pk2(acc[8 * p + 2], acc[8 * p + 3]), b0 = pk2(acc[8 * p + 4], acc[8 * p + 5]), b1 = pk2(acc[8 * p + 6], acc[8 * p + 7]);
                const auto r0 = __builtin_amdgcn_permlane32_swap(a0, b0, false, false), r1 = __builtin_amdgcn_permlane32_swap(a1, b1, false, false);
                *(u32x4*)(op + 32 * rb + 16 * p) = (u32x4){r0[0], r1[0], r0[1], r1[1]}; } }
        if (tid < 128) { const bf16_t* kr = KVT + (size_t)(h * 128 + tid) * S + t0; const float* gp = GE + (size_t)h * S + t0; float s = 0.f;
#pragma unroll
            for (int p = 0; p < 8; ++p) { const u32x4 v = *(const u32x4*)(kr + 8 * p); const f32x4 e0 = *(const f32x4*)(gp + 8 * p), e1 = *(const f32x4*)(gp + 8 * p + 4);
                s += bflo(v.x) * fexp(e0[0] - emax) + bfhi(v.x) * fexp(e0[1] - emax) + bflo(v.y) * fexp(e0[2] - emax) + bfhi(v.y) * fexp(e0[3] - emax)
                   + bflo(v.z) * fexp(e1[0] - emax) + bfhi(v.z) * fexp(e1[1] - emax) + bflo(v.w) * fexp(e1[2] - emax) + bfhi(v.w) * fexp(e1[3] - emax); }
            NST[(size_t)(c * 4 + h) * 128 + tid] = s; }
    }
}
DI void phase_m_comb(int wv, const ArgP a, LAS unsigned char* lds, int dry) {
    unsigned char* ws = a.ws(); const int tid = ltid(wv);
    const float* BL = (const float*)(ws + O_BL); const float* ML = (const float*)(ws + O_ML); float* MST = (float*)(ws + O_MST); float* NST = (float*)(ws + O_NST);
    bf16_t* CST = (bf16_t*)(ws + O_CST);
    LAS float* bls = (LAS float*)lds; LAS float* mls = bls + 1024; LAS float* ga = mls + 1024; LAS float* gb = ga + 1024;
    for (int e = tid; e < 1024; e += 512) { bls[e] = BL[e]; mls[e] = ML[e]; }
    __syncthreads();
    if (tid < 256) { const int h = tid >> 6, l = tid & 63;
        float a_ = 0.f, b_ = -1e30f;
#pragma unroll
        for (int k = 0; k < 4; ++k) { const float bl = bls[(4 * l + k) * 4 + h], ml = mls[(4 * l + k) * 4 + h]; a_ += bl; b_ = fmaxf(b_ + bl, ml); }
        float pa = a_, pb = b_;
#pragma unroll
        for (int o = 1; o < 64; o <<= 1) { const float qa = __shfl_up(pa, o), qb = __shfl_up(pb, o); if (l >= o) { pb = fmaxf(qb + pa, pb); pa = qa + pa; } }
        float ea = __shfl_up(pa, 1), eb_ = __shfl_up(pb, 1); if (l == 0) { ea = 0.f; eb_ = -1e30f; }
        float m = fmaxf(0.f + ea, eb_);
#pragma unroll
        for (int k = 0; k < 4; ++k) { const int c = 4 * l + k; const float bl = bls[c * 4 + h], ml = mls[c * 4 + h]; const float mn = fmaxf(bl + m, ml);
            ga[c * 4 + h] = fexp(bl + m - mn); gb[c * 4 + h] = fexp(ml - mn);
            if (blockIdx.x == 0 && !dry) MST[c * 4 + h] = m;
            m = mn; } }
    __syncthreads();
    for (int eb = blockIdx.x; eb < 129; eb += gridDim.x) {
        if (eb < 128) { const int h = eb >> 5; unsigned* p = (unsigned*)(CST + (size_t)h * 32768 + (size_t)(eb & 31) * 1024 + 2 * tid); float C0 = 0.f, C1 = 0.f;
            for (int c = 0; c < 256; c += 64) { unsigned d[64];
#pragma unroll
                for (int k = 0; k < 64; ++k) d[k] = p[(size_t)(c + k) * 65536];
#pragma unroll
                for (int k = 0; k < 64; ++k) { if (!dry) p[(size_t)(c + k) * 65536] = pk2(C0, C1); const float a_ = ga[(c + k) * 4 + h], b_ = gb[(c + k) * 4 + h]; C0 = a_ * C0 + b_ * bflo(d[k]); C1 = a_ * C1 + b_ * bfhi(d[k]); } }
        } else { const int h = tid >> 7; float* p = NST + tid; float C = 0.f;
            for (int c = 0; c < 256; c += 8) { float d[8];
#pragma unroll
                for (int k = 0; k < 8; ++k) d[k] = p[(size_t)(c + k) * 512];
#pragma unroll
                for (int k = 0; k < 8; ++k) { if (!dry) p[(size_t)(c + k) * 512] = C; C = ga[(c + k) * 4 + h] * C + gb[(c + k) * 4 + h] * d[k]; } } }
    }
    __syncthreads();
}
constexpr int MC_QROW = 272, MC_SROW = 144;
constexpr int MC_QS = 0, MC_KS = 64 * MC_QROW, MC_SC = 2 * 64 * MC_QROW, MC_F = MC_SC + 64 * MC_SROW;
DI void phase_m_out(int wv, const ArgP a, LAS unsigned char* lds, int dry) {
    unsigned char* ws = a.ws(); const int tid = ltid(wv), lane = tid & 63, r32 = lane & 31, hi = lane >> 5; const int w = __builtin_amdgcn_readfirstlane(tid >> 6);
    bf16_t* QOK = (bf16_t*)(ws + O_QOK); const bf16_t* KVT = (const bf16_t*)(ws + O_KVT); const bf16_t* CST = (const bf16_t*)(ws + O_CST);
    const float* GB = (const float*)(ws + O_GB); const float* GE = (const float*)(ws + O_GE); const float* GPM = (const float*)(ws + O_GPM);
    const float* MST = (const float*)(ws + O_MST); const float* NST = (const float*)(ws + O_NST); const float* ong = a.in(20);
    LAS unsigned char* Qs = lds + MC_QS; LAS unsigned char* Ks = lds + MC_KS; LAS unsigned char* Sc = lds + MC_SC;
    LAS float* F = (LAS float*)(lds + MC_F);
    LAS float* f_b = F, *f_e = F + 64, *f_m = F + 128, *f_g = F + 192, *f_qn = F + 256, *f_ps = F + 320  , *f_n = F + 576  , *f_part = F + 704  ;
    for (int u = blockIdx.x; u < 1024; u += gridDim.x) {
        const int c = u >> 2, h = u & 3; const size_t t0 = (size_t)c * 64;
        for (int e = tid; e < 1024; e += 512) { const int r = e >> 4, p = e & 15;
            *(LAS u32x4*)(Qs + r * MC_QROW + p * 16) = *(const u32x4*)(QOK + (t0 + r) * 2048 + h * 128 + p * 8);
            *(LAS u32x4*)(Ks + r * MC_QROW + p * 16) = *(const u32x4*)(QOK + (t0 + r) * 2048 + 1536 + h * 128 + p * 8); }
        if (tid < 64) { const float mstv = MST[c * 4 + h]; const float b = GB[(size_t)h * S + t0 + tid], e = GE[(size_t)h * S + t0 + tid], pm = GPM[(size_t)h * S + t0 + tid];
            const float m = b + fmaxf(mstv, pm); f_b[tid] = b; f_e[tid] = e; f_m[tid] = m; f_g[tid] = fexp(b + mstv - m); }
        if (tid >= 64 && tid < 192) f_n[tid - 64] = NST[(size_t)(c * 4 + h) * 128 + tid - 64];
        __syncthreads();
        if (w < 4) {
            const int sb = w & 1, tb = w >> 1; const int tl = 32 * tb + r32;
            f32x16 x = {};
#pragma unroll
            for (int ks = 0; ks < 8; ++ks) {
                const bf16x8 ka = *(const LAS bf16x8*)(Ks + (32 * sb + r32) * MC_QROW + (16 * ks + 8 * hi) * 2);
                const bf16x8 qb = *(const LAS bf16x8*)(Qs + tl * MC_QROW + (16 * ks + 8 * hi) * 2);
                x = __builtin_amdgcn_mfma_f32_32x32x16_bf16(ka, qb, x, 0, 0, 0); }
            const float bt = f_b[tl], mt = f_m[tl]; float ps = 0.f;
#pragma unroll
            for (int g = 0; g < 4; ++g) { float v[4];
#pragma unroll
                for (int j = 0; j < 4; ++j) { const int sl = 32 * sb + 8 * g + 4 * hi + j; const float wgt = (sl <= tl) ? fexp(bt + f_e[sl] - mt) : 0.f; v[j] = x[4 * g + j] * wgt; ps += v[j]; }
                u32x2 o; o.x = pk2(v[0], v[1]); o.y = pk2(v[2], v[3]);
                *(LAS u32x2*)(Sc + tl * MC_SROW + (32 * sb + 8 * g + 4 * hi) * 2) = o; }
            f_ps[(sb * 2 + hi) * 64 + tl] = ps;
        } else {
            const int tl = 16 * (w - 4) + (lane >> 2), qq = lane & 3; float s = 0.f;
#pragma unroll
            for (int p = 0; p < 4; ++p) { const u32x4 v = *(const LAS u32x4*)(Qs + tl * MC_QROW + (32 * qq + 8 * p) * 2); LAS float* np = f_n + 32 * qq + 8 * p;
                s += bflo(v.x) * np[0] + bfhi(v.x) * np[1] + bflo(v.y) * np[2] + bfhi(v.y) * np[3] + bflo(v.z) * np[4] + bfhi(v.z) * np[5] + bflo(v.w) * np[6] + bfhi(v.w) * np[7]; }
            s += __shfl_xor(s, 1); s += __shfl_xor(s, 2);
            if (qq == 0) f_qn[tl] = s;
        }
        __syncthreads();
        f32x16 acc0 = {}, acc1 = {};
        { const bf16_t* cp = CST + ((size_t)(c * 4 + h) * 256 + 32 * w + r32) * 128 + 8 * hi;
#pragma unroll
          for (int ks = 0; ks < 8; ++ks) { const bf16x8 ca = *(const bf16x8*)(cp + 16 * ks);
              const bf16x8 q0 = *(const LAS bf16x8*)(Qs + r32 * MC_QROW + (16 * ks + 8 * hi) * 2), q1 = *(const LAS bf16x8*)(Qs + (32 + r32) * MC_QROW + (16 * ks + 8 * hi) * 2);
              acc0 = __builtin_amdgcn_mfma_f32_32x32x16_bf16(ca, q0, acc0, 0, 0, 0); acc1 = __builtin_amdgcn_mfma_f32_32x32x16_bf16(ca, q1, acc1, 0, 0, 0); } }
        const float g0 = f_g[r32], g1 = f_g[32 + r32];
#pragma unroll
        for (int r = 0; r < 16; ++r) { acc0[r] *= g0; acc1[r] *= g1; }
        { const bf16_t* vp = KVT + (size_t)(512 + h * 256 + 32 * w + r32) * S + t0 + 8 * hi;
#pragma unroll
          for (int ks = 0; ks < 4; ++ks) { const bf16x8 va = *(const bf16x8*)(vp + 16 * ks);
              const bf16x8 s0 = *(const LAS bf16x8*)(Sc + r32 * MC_SROW + (16 * ks + 8 * hi) * 2), s1 = *(const LAS bf16x8*)(Sc + (32 + r32) * MC_SROW + (16 * ks + 8 * hi) * 2);
              acc0 = __builtin_amdgcn_mfma_f32_32x32x16_bf16(va, s0, acc0, 0, 0, 0); acc1 = __builtin_amdgcn_mfma_f32_32x32x16_bf16(va, s1, acc1, 0, 0, 0); } }
        float inv[2];
#pragma unroll
        for (int tb = 0; tb < 2; ++tb) { const int tl = 32 * tb + r32;
            const float den = f_g[tl] * f_qn[tl] + f_ps[tl] + f_ps[64 + tl] + f_ps[128 + tl] + f_ps[192 + tl];
            inv[tb] = 1.f / fmaxf(fabsf(den), fexp(-f_m[tl])); }
        float ss0 = 0.f, ss1 = 0.f;
#pragma unroll
        for (int r = 0; r < 16; ++r) { acc0[r] *= inv[0]; acc1[r] *= inv[1]; ss0 += acc0[r] * acc0[r]; ss1 += acc1[r] * acc1[r]; }
        ss0 += __shfl_xor(ss0, 32); ss1 += __shfl_xor(ss1, 32);
        if (hi == 0) { f_part[w * 64 + r32] = ss0; f_part[w * 64 + 32 + r32] = ss1; }
        __syncthreads();
        float rn[2];
#pragma unroll
        for (int tb = 0; tb < 2; ++tb) { float s = 0.f;
#pragma unroll
            for (int ww = 0; ww < 8; ++ww) s += f_part[ww * 64 + 32 * tb + r32];
            rn[tb] = rsqrtf(s * (1.f / 256.f) + EPS); }
#pragma unroll
        for (int tb = 0; tb < 2; ++tb) { bf16_t* op = QOK + (t0 + 32 * tb + r32) * 2048 + 512 + h * 256 + 32 * w;
#pragma unroll
            for (int g = 0; g < 4; ++g) { const int dv = 8 * g + 4 * hi; const u32x2 ov = *(const u32x2*)(op + dv);
                const f32x4 gg = *(const f32x4*)(ong + h * 256 + 32 * w + dv);
                const float og[4] = {bflo(ov.x), bfhi(ov.x), bflo(ov.y), bfhi(ov.y)}; float y[4];
#pragma unroll
                for (int j = 0; j < 4; ++j) { const float hv = (tb ? acc1[4 * g + j] : acc0[4 * g + j]) * rn[tb]; y[j] = hv * gg[j] * sigmoidf_(og[j]); }
                u32x2 o; o.x = pk2(y[0], y[1]); o.y = pk2(y[2], y[3]); if (!dry) *(u32x2*)(op + dv) = o; } }
        __syncthreads();
    }
}

DI void phase_final(int wv, const ArgP a) {
    float* out = a.out(); const u64* rowss = (const u64*)(a.ws() + O_ROWSS) + 4 * S; const float* g = a.in(27); const bf16_t* XBr = (const bf16_t*)(a.ws() + O_XB) + 2 * 1024;
    for (size_t e = (size_t)blockIdx.x * 512 + ltid(wv); e < (size_t)S * 128; e += (size_t)gridDim.x * 512) { const int t = (int)(e >> 7), c = (int)(e & 127) * 8;
        const float rs = rs_from_ss(rowss[t]); const u32x4 hb = __builtin_nontemporal_load((const u32x4*)(XBr + (size_t)t * 1024 + c)); const f32x4 g0 = *(const f32x4*)(g + c), g1 = *(const f32x4*)(g + c + 4);
        const f32x4 v0 = (f32x4){bflo(hb.x), bfhi(hb.x), bflo(hb.y), bfhi(hb.y)} * rs * g0, v1 = (f32x4){bflo(hb.z), bfhi(hb.z), bflo(hb.w), bfhi(hb.w)} * rs * g1;
        __builtin_nontemporal_store(v0, (f32x4*)(out + (size_t)t * 1024 + c)); __builtin_nontemporal_store(v1, (f32x4*)(out + (size_t)t * 1024 + c + 4)); }
}

#ifndef DIS
#define DIS 0u
#endif
#ifndef REP
#define REP 0u
#endif
#ifndef XSYNC
#define XSYNC 0
#endif

#define XB_TMO      128
#define XB_XCNT(j)  (256  + 64 * (j))
#define XB_XSUB(j)  (1280 + 64 * (j))
#define XB_XGEN(j)  (2304 + 64 * (j))
#define XB_TOP      3328
#define XB_TOPGEN   3392
#define XB_SPIN_CAP (1u << 18)
DI unsigned xb_ld(unsigned* p) { return __hip_atomic_load(p, __ATOMIC_RELAXED, __HIP_MEMORY_SCOPE_AGENT); }
DI unsigned xb_add(unsigned* p, unsigned v) { return __hip_atomic_fetch_add(p, v, __ATOMIC_RELAXED, __HIP_MEMORY_SCOPE_AGENT); }
DI unsigned xb_xcc_id() { return (unsigned)__builtin_amdgcn_s_getreg((3 << 11) | 20) & 0xFu; }
#define XB_SPIN(cond, bar) do { unsigned _sp = 0; while (cond) { __builtin_amdgcn_s_sleep(1); \
    if ((++_sp & 255u) == 0u) { if (xb_ld(&(bar)[XB_TMO])) break; if (_sp > XB_SPIN_CAP) { atomicAdd(&(bar)[XB_TMO], 1u); break; } } } } while (0)
DI void xcd_barrier_complete(unsigned* bar, unsigned x, unsigned& nloc, unsigned& nx) {
    const unsigned G = gridDim.x;
    unsigned sum, cnt, mine, sp = 0u;
    for (;;) {
        sum = 0u; cnt = 0u; mine = 0u;
#pragma unroll
        for (unsigned j = 0; j < 16; ++j) { const unsigned c = xb_ld(&bar[XB_XCNT(j)]); sum += c; cnt += (c > 0u) ? 1u : 0u; mine = (j == x) ? c : mine; }
        if (sum == G) break;
        __builtin_amdgcn_s_sleep(1);
        if ((++sp & 255u) == 0u) { if (xb_ld(&bar[XB_TMO])) break; if (sp > XB_SPIN_CAP) { atomicAdd(&bar[XB_TMO], 1u); break; } }
    }
    nloc = mine > 0u ? mine : 1u; nx = cnt > 0u ? cnt : 1u;
}
DI void xcd_barrier(int wv, unsigned* bar, volatile LAS unsigned* st) {
    asm volatile("s_waitcnt vmcnt(0)" ::: "memory");
    __syncthreads();
    if (ltid(wv) == 0) {
        const unsigned x = xb_xcc_id();
        __builtin_amdgcn_s_waitcnt(0);
        unsigned nloc = st[0], nx = st[1];
        if (nloc == 0u) { xcd_barrier_complete(bar, x, nloc, nx); st[0] = nloc; st[1] = nx; }
        const unsigned old = xb_add(&bar[XB_XSUB(x)], 1u);
        const unsigned gen = old / nloc;
        if (old + 1u == (gen + 1u) * nloc) {
            __builtin_amdgcn_fence(__ATOMIC_RELEASE, "agent");
            asm volatile("s_waitcnt vmcnt(0)" ::: "memory");
            const unsigned og = xb_add(&bar[XB_TOP], 1u);
            const unsigned tg = og / nx;
            if (og + 1u == (tg + 1u) * nx) xb_add(&bar[XB_TOPGEN], 1u);
            else XB_SPIN(xb_ld(&bar[XB_TOPGEN]) == tg, bar);
            __builtin_amdgcn_fence(__ATOMIC_ACQUIRE, "agent");
            xb_add(&bar[XB_XGEN(x)], 1u);
            asm volatile("s_waitcnt vmcnt(0)" ::: "memory");
        } else {
            XB_SPIN(xb_ld(&bar[XB_XGEN(x)]) == gen, bar);
            __builtin_amdgcn_fence(__ATOMIC_ACQUIRE, "agent");
            asm volatile("s_waitcnt vmcnt(0)" ::: "memory");
        }
    }
    __syncthreads();
}
DI ArgP getargs() { ArgP r; r.p = (const __attribute__((address_space(4))) Args*)__builtin_amdgcn_kernarg_segment_ptr(); asm volatile("" : "+s"(r.p)); return r; }
#define WSB (getargs().ws())
#define XBP ((bf16_t*)(getargs().ws() + O_XB) + 2 * 1024)
#define RSS ((u64*)(getargs().ws() + O_ROWSS))
#define HFP (getargs().out())
__global__ void __launch_bounds__(512, 2) fwd_kernel(Args a_unused) {
    extern __shared__ __attribute__((aligned(16))) unsigned char shm[];
    LAS unsigned char* lds = (LAS unsigned char*)shm;
    const int wv = __builtin_amdgcn_readfirstlane(threadIdx.x >> 6);
#define BARW ((unsigned*)(getargs().ws() + O_BAR))
#define BARST ((volatile LAS unsigned*)(lds + 139264))
#define GSYNC() xcd_barrier(wv, BARW, BARST)
    { unsigned* barw0 = BARW; if (threadIdx.x == 0) { BARST[0] = 0u; BARST[1] = 0u; (void)xb_add(&barw0[XB_XCNT(xb_xcc_id())], 1u); } }
    if (getargs().p->pad == 0x7fffffff) cg::this_grid().sync();

#if !(DIS & (1u << 0))
    for (int rep_ = 0; rep_ < ((REP >> 0) & 1u) + 1; ++rep_) { const int dry_ = rep_ < (int)((REP >> 0) & 1u); (void)dry_;
    phase_prologue(wv, getargs(), lds, dry_ ? PROPART : 7);
    }
#endif
    GSYNC();
#if !(DIS & (1u << 1))
    for (int rep_ = 0; rep_ < ((REP >> 1) & 1u) + 1; ++rep_) { const int dry_ = rep_ < (int)((REP >> 1) & 1u); (void)dry_;
    { EpiRowBf16<1> E{(bf16_t*)(WSB + O_Z), 1536, RSS};
      pg8::gemm_phase<false>(wv, lds, XBP, 1024, (const bf16_t*)(WSB + O_W1T), 1024, 1024, 64, 6, E); }
    }
#endif
    GSYNC();
#if !(DIS & (1u << 2))
    for (int rep_ = 0; rep_ < ((REP >> 2) & 1u) + 1; ++rep_) { const int dry_ = rep_ < (int)((REP >> 2) & 1u); (void)dry_;
    phase_l0_prep(wv, getargs());
    }
#endif
    GSYNC();
#if !(DIS & (1u << 3))
    for (int rep_ = 0; rep_ < ((REP >> 3) & 1u) + 1; ++rep_) { const int dry_ = rep_ < (int)((REP >> 3) & 1u); (void)dry_;
    { EpiRowBf16<0> E{(bf16_t*)(WSB + O_RI), 1024, nullptr};
      pg8::gemm_phase<false, EpiRowBf16<0>, true>(wv, lds, (const bf16_t*)(WSB + O_XC), 512, (const bf16_t*)(WSB + O_WRIT), 512, 256, 64, 4, E); }
    }
#endif
#if !(DIS & (1u << 4))
    for (int rep_ = 0; rep_ < ((REP >> 4) & 1u) + 1; ++rep_) { const int dry_ = rep_ < (int)((REP >> 4) & 1u); (void)dry_;
    { EpiQ E{(bf16_t*)(WSB + O_QB), (const float*)(WSB + O_RSQ), (const float*)(WSB + O_CSTAB)};
      pg8::gemm_phase<false>(wv, lds, (const bf16_t*)(WSB + O_Z) + 1024, 1536, (const bf16_t*)(WSB + O_WQT), 256, 256, 64, 3, E); }
    }
#endif
#if !(DIS & (1u << 5))
    for (int rep_ = 0; rep_ < ((REP >> 5) & 1u) + 1; ++rep_) { const int dry_ = rep_ < (int)((REP >> 5) & 1u); (void)dry_;
    { EpiK E{(bf16_t*)(WSB + O_KB), (const float*)(WSB + O_RSKV)};
      pg8::gemm_phase<false>(wv, lds, (const bf16_t*)(WSB + O_Z) + 1280, 1536, (const bf16_t*)(WSB + O_WKT), 256, 256, 64, 2, E, 192); }
    }
#endif
#if !(DIS & (1u << 6))
    for (int rep_ = 0; rep_ < ((REP >> 6) & 1u) + 1; ++rep_) { const int dry_ = rep_ < (int)((REP >> 6) & 1u); (void)dry_;
    { EpiColBf16<2> E{(bf16_t*)(WSB + O_VT), S, (const float*)(WSB + O_RSKV)};
      pg8::gemm_phase<false>(wv, lds, (const bf16_t*)(WSB + O_WVT), 256, (const bf16_t*)(WSB + O_Z) + 1280, 1536, 256, 2, 64, E, 64); }
    }
#endif
    GSYNC();
#if !(DIS & (1u << 7))
    for (int rep_ = 0; rep_ < ((REP >> 7) & 1u) + 1; ++rep_) { const int dry_ = rep_ < (int)((REP >> 7) & 1u); (void)dry_;
    phase_lru_s1(wv, getargs());
    }
#endif
    GSYNC();
#if !(DIS & (1u << 8))
    for (int rep_ = 0; rep_ < ((REP >> 8) & 1u) + 1; ++rep_) { const int dry_ = rep_ < (int)((REP >> 8) & 1u); (void)dry_;
    phase_lru_s3(wv, getargs());
    }
#endif
#if !(DIS & (1u << 9))
    for (int rep_ = 0; rep_ < ((REP >> 9) & 1u) + 1; ++rep_) { const int dry_ = rep_ < (int)((REP >> 9) & 1u); (void)dry_;
    phase_attn(wv, getargs(), lds);
    }
#endif
    GSYNC();
#if !(DIS & (1u << 10))
    for (int rep_ = 0; rep_ < ((REP >> 10) & 1u) + 1; ++rep_) { const int dry_ = rep_ < (int)((REP >> 10) & 1u); (void)dry_;
    { EpiRes<false> E{getargs().in(0), XBP, RSS + 1 * S, dry_};
      pg8::gemm_phase<false>(wv, lds, (const bf16_t*)(WSB + O_MIX), 1024, (const bf16_t*)(WSB + O_WO1T), 1024, 1024, 64, 4, E); }
    }
#endif
    GSYNC();
#if !(DIS & (1u << 11))
    for (int rep_ = 0; rep_ < ((REP >> 11) & 1u) + 1; ++rep_) { const int dry_ = rep_ < (int)((REP >> 11) & 1u); (void)dry_;
    { EpiUp E{(bf16_t*)(WSB + O_ACT), RSS + 1 * S, getargs().in(24), getargs().in(25), lds + 131072};
      pg8::gemm_phase<true>(wv, lds, XBP, 1024, (const bf16_t*)(WSB + O_WUPT0), 1024, 1024, 67, 22, E); }
    }
#endif
    GSYNC();
#if !(DIS & (1u << 12))
    for (int rep_ = 0; rep_ < ((REP >> 12) & 1u) + 1; ++rep_) { const int dry_ = rep_ < (int)((REP >> 12) & 1u); (void)dry_;
    { EpiRes<true> E{nullptr, XBP, RSS + 2 * S, dry_};
      pg8::gemm_phase<false>(wv, lds, (const bf16_t*)(WSB + O_ACT), 2816, (const bf16_t*)(WSB + O_WDNT0), 2816, 2816, 64, 4, E); }
    }
#endif
    GSYNC();
#if !(DIS & (1u << 13))
    for (int rep_ = 0; rep_ < ((REP >> 13) & 1u) + 1; ++rep_) { const int dry_ = rep_ < (int)((REP >> 13) & 1u); (void)dry_;
    { EpiQOK E{(bf16_t*)(WSB + O_QOK), RSS + 2 * S, (bf16_t*)(WSB + O_KVT)};
      pg8::gemm_phase<false>(wv, lds, XBP, 1024, (const bf16_t*)(WSB + O_WOINT), 1024, 1024, 64, 8, E); }
    }
#endif
#if !(DIS & (1u << 14))
    for (int rep_ = 0; rep_ < ((REP >> 14) & 1u) + 1; ++rep_) { const int dry_ = rep_ < (int)((REP >> 14) & 1u); (void)dry_;
    { EpiColBf16<1> E{(bf16_t*)(WSB + O_KVT) + (size_t)512 * S, S, RSS + 2 * S};
      pg8::gemm_phase<false>(wv, lds, (const bf16_t*)(WSB + O_WOINT) + (size_t)2048 * 1024, 1024, XBP, 1024, 1024, 4, 64, E); }
    }
#endif
#if !(DIS & (1u << 15))
    for (int rep_ = 0; rep_ < ((REP >> 15) & 1u) + 1; ++rep_) { const int dry_ = rep_ < (int)((REP >> 15) & 1u); (void)dry_;
    phase_m_gates(wv, getargs(), lds);
    }
#endif
    GSYNC();
#if !(DIS & (1u << 16))
    for (int rep_ = 0; rep_ < ((REP >> 16) & 1u) + 1; ++rep_) { const int dry_ = rep_ < (int)((REP >> 16) & 1u); (void)dry_;
    phase_m_dc(wv, getargs());
    }
#endif
    GSYNC();
#if !(DIS & (1u << 22))
    for (int rep_ = 0; rep_ < ((REP >> 22) & 1u) + 1; ++rep_) { const int dry_ = rep_ < (int)((REP >> 22) & 1u); (void)dry_;
    phase_m_comb(wv, getargs(), lds, dry_);
    }
#endif
    GSYNC();
#if !(DIS & (1u << 17))
    for (int rep_ = 0; rep_ < ((REP >> 17) & 1u) + 1; ++rep_) { const int dry_ = rep_ < (int)((REP >> 17) & 1u); (void)dry_;
    phase_m_out(wv, getargs(), lds, dry_);
    }
#endif
    GSYNC();
#if !(DIS & (1u << 18))
    for (int rep_ = 0; rep_ < ((REP >> 18) & 1u) + 1; ++rep_) { const int dry_ = rep_ < (int)((REP >> 18) & 1u); (void)dry_;
    { EpiRes<true> E{nullptr, XBP, RSS + 3 * S, dry_};
      pg8::gemm_phase<false>(wv, lds, (const bf16_t*)(WSB + O_QOK) + 512, 2048, (const bf16_t*)(WSB + O_WO2T), 1024, 1024, 64, 4, E); }
    }
#endif
    GSYNC();
#if !(DIS & (1u << 19))
    for (int rep_ = 0; rep_ < ((REP >> 19) & 1u) + 1; ++rep_) { const int dry_ = rep_ < (int)((REP >> 19) & 1u); (void)dry_;
    { EpiUp E{(bf16_t*)(WSB + O_ACT), RSS + 3 * S, getargs().in(24) + 3 * 5632, getargs().in(25) + 5632, lds + 131072};
      pg8::gemm_phase<true>(wv, lds, XBP, 1024, (const bf16_t*)(WSB + O_WUPT1), 1024, 1024, 67, 22, E); }
    }
#endif
    GSYNC();
#if !(DIS & (1u << 20))
    for (int rep_ = 0; rep_ < ((REP >> 20) & 1u) + 1; ++rep_) { const int dry_ = rep_ < (int)((REP >> 20) & 1u); (void)dry_;
    { EpiRes<true> E{nullptr, XBP, RSS + 4 * S, dry_};
      pg8::gemm_phase<false>(wv, lds, (const bf16_t*)(WSB + O_ACT), 2816, (const bf16_t*)(WSB + O_WDNT1), 2816, 2816, 64, 4, E); }
    }
#endif
    GSYNC();
#if !(DIS & (1u << 21))
    for (int rep_ = 0; rep_ < ((REP >> 21) & 1u) + 1; ++rep_) { const int dry_ = rep_ < (int)((REP >> 21) & 1u); (void)dry_;
    phase_final(wv, getargs());
    }
#endif
    for (int i = 0; i < XSYNC; ++i) GSYNC();
}

extern "C" void kernel_launch(void* const* d_in, const int* in_sizes, int n_in, void* d_out, int out_size, void* d_ws, size_t ws_size, hipStream_t stream) {
    static int grid = 0;
    if (grid == 0) {
        if (n_in != 28 || out_size != S * 1024 || ws_size < WS_NEED) { fprintf(stderr, "kernel_launch: unexpected shapes (n_in %d out %d ws %zu need %zu)\n", n_in, out_size, ws_size, (size_t)WS_NEED); grid = -1; return; }
        int dev = 0, cus = 0, per_cu = 0;
        (void)hipGetDevice(&dev);
        (void)hipDeviceGetAttribute(&cus, hipDeviceAttributeMultiprocessorCount, dev);
        if (hipFuncSetAttribute((const void*)fwd_kernel, hipFuncAttributeMaxDynamicSharedMemorySize, LDS_BYTES) != hipSuccess) { fprintf(stderr, "kernel_launch: hipFuncSetAttribute failed\n"); grid = -1; return; }
        if (hipOccupancyMaxActiveBlocksPerMultiprocessor(&per_cu, (const void*)fwd_kernel, 512, LDS_BYTES) != hipSuccess || per_cu < 1) { fprintf(stderr, "kernel_launch: occupancy query says %d\n", per_cu); per_cu = 1; }
        (void)hipGetLastError();
        grid = cus * 1;
        if (grid > 256) grid = 256;
    }
    if (grid < 0) return;
    Args a{};
    for (int i = 0; i < 28; ++i) a.in[i] = (const float*)d_in[i];
    a.out = (float*)d_out; a.ws = (unsigned char*)d_ws;
    if (hipMemsetAsync((char*)d_ws + O_BAR, 0, BAR_BYTES, stream) != hipSuccess) { fprintf(stderr, "kernel_launch: memset failed\n"); return; }
    void* args[] = {&a};
    hipError_t e = hipLaunchCooperativeKernel((void*)fwd_kernel, dim3(grid), dim3(512), args, LDS_BYTES, stream);
    if (e != hipSuccess) fprintf(stderr, "kernel_launch: cooperative launch failed: %s (grid %d)\n", hipGetErrorString(e), grid);
}
```

```cpp
#include <hip/hip_runtime.h>
#include <hip/hip_cooperative_groups.h>
#include <cstdio>
#include <cstdint>
namespace cg = cooperative_groups;

typedef unsigned short bf16_t;
typedef short bf16x8 __attribute__((ext_vector_type(8)));
typedef short s16x4 __attribute__((ext_vector_type(4)));
typedef float f32x2 __attribute__((ext_vector_type(2)));
typedef float f32x4 __attribute__((ext_vector_type(4)));
typedef float f32x16 __attribute__((ext_vector_type(16)));
typedef unsigned u32x2 __attribute__((ext_vector_type(2)));
typedef unsigned u32x4 __attribute__((ext_vector_type(4)));
typedef __bf16 bf16x2_t __attribute__((ext_vector_type(2)));
#define LAS __attribute__((address_space(3)))
#define DI __device__ __forceinline__

constexpr int S = 16384;
constexpr float EPS = 1e-6f;
constexpr float LOG2E = 1.4426950408889634f;

constexpr size_t SZ_WUPT = (size_t)5632 * 1024 * 2, SZ_WDNT = (size_t)1024 * 2816 * 2;
constexpr size_t O_WUPT1 = 0;
constexpr size_t O_WDNT1 = O_WUPT1 + SZ_WUPT;
constexpr size_t O_WOINT = O_WDNT1 + SZ_WDNT;
constexpr size_t O_WO2T = O_WOINT + (size_t)3072 * 1024 * 2;
constexpr size_t O_ROWSS = O_WO2T + (size_t)1024 * 1024 * 2;
constexpr size_t O_RSQ = O_ROWSS + (size_t)5 * S * 8;
constexpr size_t O_RSKV = O_RSQ + (size_t)S * 4;
constexpr size_t O_CSTAB = O_RSKV + (size_t)S * 4;
constexpr size_t O_CHA = O_CSTAB + (size_t)S * 32 * 4;
constexpr size_t O_CHH = O_CHA + (size_t)256 * 512 * 4;
constexpr size_t O_GB = O_CHH + (size_t)256 * 512 * 4;
constexpr size_t O_GE = O_GB + (size_t)4 * S * 4;
constexpr size_t O_GPM = O_GE + (size_t)4 * S * 4;
constexpr size_t O_BL = O_GPM + (size_t)4 * S * 4;
constexpr size_t O_ML = O_BL + 4096;
constexpr size_t O_MST = O_ML + 4096;
constexpr size_t O_NST = O_MST + 4096;
constexpr size_t O_BAR = O_NST + (size_t)256 * 4 * 128 * 4;
constexpr size_t BAR_BYTES = 16384;
constexpr size_t O_XB = O_BAR + BAR_BYTES;
constexpr size_t XB_ROWS = 16648;
constexpr size_t O_L0W = O_XB + XB_ROWS * 2048;
constexpr size_t O_W1T = O_L0W;
constexpr size_t O_WQT = O_W1T + (size_t)1536 * 1024 * 2;
constexpr size_t O_WKT = O_WQT + (size_t)768 * 256 * 2;
constexpr size_t O_WVT = O_WKT + (size_t)512 * 256 * 2;
constexpr size_t O_WRIT = O_WVT + (size_t)512 * 256 * 2;
constexpr size_t O_WO1T = O_WRIT + (size_t)1024 * 512 * 2;
constexpr size_t O_WUPT0 = O_WO1T + (size_t)1024 * 1024 * 2;
constexpr size_t O_WDNT0 = O_WUPT0 + SZ_WUPT;
constexpr size_t O_ARENA = O_WDNT0 + SZ_WDNT;
constexpr size_t O_Z = O_ARENA;
constexpr size_t O_XC = O_Z + (size_t)S * 1536 * 2;
constexpr size_t O_QB = O_XC + (size_t)S * 512 * 2;
constexpr size_t O_KB = O_QB + (size_t)8 * S * 96 * 2;
constexpr size_t O_VT = O_KB + (size_t)8 * S * 96 * 2;
constexpr size_t O_MIX = O_VT + (size_t)512 * S * 2;
constexpr size_t O_END0 = O_MIX + (size_t)S * 1024 * 2;
constexpr size_t O_ACT = O_ARENA;
constexpr size_t O_RI = O_XB;
constexpr size_t O_CST = O_L0W;
constexpr size_t O_QOK = O_CST + (size_t)256 * 4 * 256 * 128 * 2;
constexpr size_t O_KVT = O_QOK + (size_t)S * 2048 * 2;
constexpr size_t O_END1 = O_KVT + (size_t)1536 * S * 2;
constexpr size_t WS_NEED = (O_END0 > O_END1 ? O_END0 : O_END1);
static_assert(WS_NEED <= (size_t)268435456, "workspace");
static_assert(O_ACT + (size_t)(S + 240) * 2816 * 2 <= (size_t)268435456, "act");

constexpr int LDS_BYTES = 147456;

struct Args {
    const float* in[28];
    float* out;
    unsigned char* ws;
    int pad; int pad2;
};

struct ArgP { const __attribute__((address_space(4))) Args* p;
    DI const float* in(int i) const { return p->in[i]; } DI float* out() const { return p->out; } DI unsigned char* ws() const { return p->ws; } };
DI unsigned pk2(float lo, float hi) { f32x2 v = {lo, hi}; bf16x2_t b = __builtin_convertvector(v, bf16x2_t); return __builtin_bit_cast(unsigned, b); }
DI bf16_t f2bf(float f) { return (bf16_t)(pk2(f, 0.f) & 0xffffu); }
DI int ltid(int wv) { asm volatile("" : "+s"(wv)); int l = __builtin_amdgcn_mbcnt_hi(~0u, __builtin_amdgcn_mbcnt_lo(~0u, 0u)); asm volatile("" : "+v"(l)); return wv * 64 + l; }
DI int lbid() { int t = blockIdx.x; asm volatile("" : "+s"(t)); return t; }
DI float bf2f(bf16_t b) { return __uint_as_float(((unsigned)b) << 16); }
DI float bflo(unsigned u) { return __uint_as_float(u << 16); }
DI float bfhi(unsigned u) { return __uint_as_float(u & 0xffff0000u); }
DI float wave_sum(float v) {
#pragma unroll
    for (int o = 1; o < 64; o <<= 1) v += __shfl_xor(v, o);
    return v;
}
DI float fexp(float x) { return __builtin_amdgcn_exp2f(x * LOG2E); }
DI float sigmoidf_(float x) { return __builtin_amdgcn_rcpf(1.f + fexp(-x)); }
DI int crow(int r, int hi) { return (r & 3) + 8 * (r >> 2) + 4 * hi; }
typedef unsigned long long u64;
DI float rs_from_ss(u64 ssq) { return rsqrtf((float)ssq * (1.f / (1048576.f * 1024.f)) + EPS); }
DI u64 ss_to_fix(float ss) { return (u64)(ss * 1048576.f); }

namespace pg8 {
constexpr int BM = 256, BK = 64, HALF = 128, HTB = HALF * BK * 2, STAGE_BYTES = 8 * HTB, NXCD = 8, WGM = 8;
DI int lds_byte(int r, int c) { const int st = (r >> 4) * 2 + (c >> 5), rr = r & 15, cc = c & 31, ob = rr * 64 + cc * 2; return st * 1024 + (ob ^ (((ob >> 9) & 1) << 5)); }
DI void stage_rc(int b, int& R, int& C) { const int st = b / 1024, sb = b % 1024, swz = sb ^ (((sb >> 9) & 1) << 5); R = (st >> 1) * 16 + swz / 64; C = (st & 1) * 32 + (swz % 64) / 2; }
DI int perm32(int rho) { const int n = rho >> 4, i = rho & 15; return 8 * (i >> 2) + 4 * n + (i & 3); }
struct Unit { int pm, pn; };
struct StaticOrder {
    int nM, nN, nwg, G, c;
    DI void init(int nM_, int nN_, int G_, int c_) { nM = nM_; nN = nN_; nwg = nM * nN; G = G_; c = c_; }
    DI bool next(int i, Unit& u) const {
        const long L = (long)i * G + c; if (L >= nwg) return false;
        int wgid = (int)L; { const int q = nwg / NXCD, r = nwg % NXCD, xcd = wgid % NXCD, off = wgid / NXCD; wgid = (xcd < r ? xcd * (q + 1) : r * (q + 1) + (xcd - r) * q) + off; }
        const int nig = WGM * nN, gid = wgid / nig, fm = gid * WGM, gsz = (nM - fm) < WGM ? (nM - fm) : WGM;
        u.pm = fm + ((wgid % nig) % gsz); u.pn = (wgid % nig) / gsz; return true;
    }
};

template <bool AMAP, class Epi, bool KOFS = false>
DI void gemm_phase(int wv, LAS unsigned char* lds, const bf16_t* A, int lda, const bf16_t* Bt, int ldb, int K_, int nM, int nN, const Epi& E, int rot = 0) {
    int K = K_; asm volatile("" : "+s"(K));
    const int tid = ltid(wv), wid = __builtin_amdgcn_readfirstlane(tid >> 6), lane = tid & 63, wr = wid >> 2, wc = wid & 3, fr = lane & 15, fq = lane >> 4;
    const int nt = K / BK;
    StaticOrder SO; { int c_ = lbid() - rot; if (c_ < 0) c_ += (int)gridDim.x; SO.init(nM, nN, (int)gridDim.x, c_); }
    unsigned voffA[2], voffB[2];
#pragma unroll
    for (int i = 0; i < 2; ++i) { int R, C; stage_rc(tid * 16 + i * 8192, R, C); const int Rb = (R & ~31) + perm32(R & 31);
        const int Ra = AMAP ? (62 * (R >> 6) + (R & 63) - 2) : R;
        voffA[i] = (unsigned)((Ra + (AMAP ? 2 : 0)) * lda + C) * 2u; voffB[i] = (unsigned)(Rb * ldb + C) * 2u; }
    const size_t kstep = (size_t)(BK * 2);
    const size_t hstepA = (size_t)(AMAP ? 124 : 128) * lda * 2, hstepB = (size_t)HALF * ldb * 2;
    const size_t tstepA = 2 * hstepA, tstepB = 2 * hstepB;
    const unsigned ldsw = (unsigned)wid * 1024u;
    const int aoff = lds_byte(wr * 64 + fr, fq * 8), boff = lds_byte(wc * 32 + fr, fq * 8);
#define PG8_SA(b, h) (((b) * 2 + (h)) * HTB)
#define PG8_SB(b, h) ((4 + (b) * 2 + (h)) * HTB)
#define PG8_STAGE(bufoff, gbase, voff) do { _Pragma("unroll") for (int _i = 0; _i < 2; ++_i) \
        __builtin_amdgcn_global_load_lds((const unsigned*)((const char*)(gbase) + (voff)[_i]), (LAS unsigned*)(lds + (bufoff) + ldsw + _i * 8192), 16, 0, 0); } while (0)
#define PG8_LDA(dst, b, h) do { _Pragma("unroll") for (int m = 0; m < 4; ++m) _Pragma("unroll") for (int k = 0; k < 2; ++k) dst[m][k] = *(const LAS bf16x8*)(lds + PG8_SA(b, h) + aoff + m * 2048 + k * 1024); } while (0)
#define PG8_LDB(dst, b, h) do { _Pragma("unroll") for (int n = 0; n < 2; ++n) _Pragma("unroll") for (int k = 0; k < 2; ++k) dst[n][k] = *(const LAS bf16x8*)(lds + PG8_SB(b, h) + boff + n * 2048 + k * 1024); } while (0)
#define PG8_MMA(ai, bj, At, Bt_) do { __builtin_amdgcn_s_setprio(1); _Pragma("unroll") for (int m = 0; m < 4; ++m) _Pragma("unroll") for (int n = 0; n < 2; ++n) _Pragma("unroll") for (int k = 0; k < 2; ++k) \
        acc[ai][bj][m][n] = __builtin_amdgcn_mfma_f32_16x16x32_bf16(Bt_[n][k], At[m][k], acc[ai][bj][m][n], 0, 0, 0); __builtin_amdgcn_s_setprio(0); } while (0)
#define PG8_WAIT_V(n) asm volatile("s_waitcnt vmcnt(" #n ")" ::: "memory")
#define PG8_WAIT_L(n) asm volatile("s_waitcnt lgkmcnt(" #n ")" ::: "memory")
#define PG8_BAR __builtin_amdgcn_s_barrier()
#define PG8_SCHED __builtin_amdgcn_sched_barrier(0)
    if (AMAP) A -= 2 * lda;
    Unit cur, nxt; int ui = 0;
    if (!SO.next(0, cur)) return;
    f32x4 acc[2][2][4][2];
#pragma unroll
    for (int a = 0; a < 2; ++a)
#pragma unroll
        for (int b = 0; b < 2; ++b)
#pragma unroll
            for (int m = 0; m < 4; ++m)
#pragma unroll
                for (int n = 0; n < 2; ++n) acc[a][b][m][n] = (f32x4){0.f, 0.f, 0.f, 0.f};
    bf16x8 At[4][2], B0[2][2], B1[2][2];
    const char* cA = (const char*)A + (size_t)cur.pm * tstepA + (KOFS ? (cur.pn & 1) * 512 : 0); const char* cB = (const char*)Bt + (size_t)cur.pn * tstepB + (KOFS ? (cur.pn & 1) * 512 : 0);
    PG8_STAGE(PG8_SB(0, 0), cB, voffB); PG8_STAGE(PG8_SB(0, 1), cB + hstepB, voffB); PG8_STAGE(PG8_SA(0, 0), cA, voffA); PG8_STAGE(PG8_SA(0, 1), cA + hstepA, voffA);
    if (wr == 1) PG8_BAR;
    PG8_WAIT_V(2); PG8_BAR;
    PG8_STAGE(PG8_SB(1, 0), cB + kstep, voffB); PG8_STAGE(PG8_SA(1, 0), cA + kstep, voffA); PG8_STAGE(PG8_SB(1, 1), cB + hstepB + kstep, voffB);
    PG8_WAIT_V(6); PG8_BAR;
    for (;;) {
        const bool has_next = SO.next(ui + 1, nxt);
        const char* nA = has_next ? (const char*)A + (size_t)nxt.pm * tstepA + (KOFS ? (nxt.pn & 1) * 512 : 0) : cA; const char* nB = has_next ? (const char*)Bt + (size_t)nxt.pn * tstepB + (KOFS ? (nxt.pn & 1) * 512 : 0) : cB;
        for (int t = 0; t < nt; t += 2) {
            const bool last = (t == nt - 2);
            const char* a1 = cA + (size_t)(t + 1) * kstep;
            const char* a2 = last ? nA : cA + (size_t)(t + 2) * kstep; const char* b2 = last ? nB : cB + (size_t)(t + 2) * kstep;
            const char* a3 = a2 + kstep; const char* b3 = b2 + kstep;
            PG8_LDB(B0, 0, 0); PG8_LDB(B1, 0, 1); PG8_SCHED; PG8_LDA(At, 0, 0); PG8_STAGE(PG8_SA(1, 1), a1 + hstepA, voffA);
            PG8_WAIT_V(8); PG8_WAIT_L(0); PG8_BAR; PG8_MMA(0, 0, At, B0); PG8_MMA(0, 1, At, B1); PG8_BAR; PG8_SCHED;
            PG8_LDA(At, 0, 1); PG8_STAGE(PG8_SB(0, 0), b2, voffB); PG8_STAGE(PG8_SB(0, 1), b2 + hstepB, voffB); PG8_STAGE(PG8_SA(0, 0), a2, voffA);
            PG8_WAIT_V(8); PG8_WAIT_L(0); PG8_BAR; PG8_MMA(1, 0, At, B0); PG8_MMA(1, 1, At, B1); PG8_BAR; PG8_SCHED;
            PG8_LDB(B0, 1, 0); PG8_LDB(B1, 1, 1); PG8_SCHED; PG8_LDA(At, 1, 0); PG8_STAGE(PG8_SA(0, 1), a2 + hstepA, voffA);
            PG8_WAIT_V(8); PG8_WAIT_L(0); PG8_BAR; PG8_MMA(0, 0, At, B0); PG8_MMA(0, 1, At, B1); PG8_BAR; PG8_SCHED;
            PG8_LDA(At, 1, 1); PG8_STAGE(PG8_SB(1, 0), b3, voffB); PG8_STAGE(PG8_SB(1, 1), b3 + hstepB, voffB); PG8_STAGE(PG8_SA(1, 0), a3, voffA);
            PG8_WAIT_V(8); PG8_WAIT_L(0); PG8_BAR; PG8_MMA(1, 0, At, B0); PG8_MMA(1, 1, At, B1); PG8_BAR; PG8_SCHED;
        }
        if (wr == 0) PG8_BAR;
        E(acc, cur, wr, wc, fr, fq);
        if (!has_next) break;
#pragma unroll
        for (int a = 0; a < 2; ++a)
#pragma unroll
            for (int b = 0; b < 2; ++b)
#pragma unroll
                for (int m = 0; m < 4; ++m)
#pragma unroll
                    for (int n = 0; n < 2; ++n) acc[a][b][m][n] = (f32x4){0.f, 0.f, 0.f, 0.f};
        cur = nxt; cA = nA; cB = nB; ++ui;
        if (wr == 1) PG8_BAR;
    }
    PG8_WAIT_V(0);
    PG8_BAR;
#undef PG8_SA
#undef PG8_SB
#undef PG8_STAGE
#undef PG8_LDA
#undef PG8_LDB
#undef PG8_MMA
#undef PG8_WAIT_V
#undef PG8_WAIT_L
#undef PG8_BAR
#undef PG8_SCHED
}
}
using pg8::Unit;
typedef f32x4 AccT[2][2][4][2];

template <int SMODE> struct EpiRowBf16 {
    bf16_t* O; int ldc; const void* sc;
    DI void operator()(const AccT& acc, const Unit& u, int wr, int wc, int fr, int fq) const {
        const int row0 = u.pm * 256 + wr * 64 + fr, col0 = u.pn * 256 + wc * 32 + 8 * fq;
#pragma unroll
        for (int ai = 0; ai < 2; ++ai)
#pragma unroll
            for (int m = 0; m < 4; ++m) { const int row = row0 + ai * 128 + m * 16;
                float s = 1.f; if (SMODE == 1) s = rs_from_ss(((const u64*)sc)[row]); if (SMODE == 2) s = ((const float*)sc)[row];
                bf16_t* rowp = O + (size_t)row * ldc + col0;
#pragma unroll
                for (int bj = 0; bj < 2; ++bj) { const f32x4 v0 = acc[ai][bj][m][0] * s, v1 = acc[ai][bj][m][1] * s;
                    u32x4 w; w.x = pk2(v0[0], v0[1]); w.y = pk2(v0[2], v0[3]); w.z = pk2(v1[0], v1[1]); w.w = pk2(v1[2], v1[3]);
                    *(u32x4*)(rowp + bj * 128) = w; } }
    }
};
struct EpiQOK {
    bf16_t* O; const void* sc; bf16_t* KT;
    DI void operator()(const AccT& acc, const Unit& u, int wr, int wc, int fr, int fq) const {
        const int row0 = u.pm * 256 + wr * 64 + fr, col0 = u.pn * 256 + wc * 32 + 8 * fq;
#pragma unroll
        for (int ai = 0; ai < 2; ++ai)
#pragma unroll
            for (int m = 0; m < 4; ++m) { const int row = row0 + ai * 128 + m * 16;
                const float s = rs_from_ss(((const u64*)sc)[row]);
                bf16_t* rowp = O + (size_t)row * 2048 + col0;
#pragma unroll
                for (int bj = 0; bj < 2; ++bj) { const f32x4 v0 = acc[ai][bj][m][0] * s, v1 = acc[ai][bj][m][1] * s;
                    u32x4 w; w.x = pk2(v0[0], v0[1]); w.y = pk2(v0[2], v0[3]); w.z = pk2(v1[0], v1[1]); w.w = pk2(v1[2], v1[3]);
                    *(u32x4*)(rowp + bj * 128) = w;
                    if (u.pn >= 6) { bf16_t* kt = KT + (size_t)(col0 + bj * 128 - 1536) * S + row;
                        kt[0] = (bf16_t)(w.x & 0xffffu); kt[(size_t)S] = (bf16_t)(w.x >> 16); kt[(size_t)2 * S] = (bf16_t)(w.y & 0xffffu); kt[(size_t)3 * S] = (bf16_t)(w.y >> 16);
                        kt[(size_t)4 * S] = (bf16_t)(w.z & 0xffffu); kt[(size_t)5 * S] = (bf16_t)(w.z >> 16); kt[(size_t)6 * S] = (bf16_t)(w.w & 0xffffu); kt[(size_t)7 * S] = (bf16_t)(w.w >> 16); } } }
    }
};
template <int SMODE> struct EpiColBf16 {
    bf16_t* O; int ldc; const void* sc;
    DI void operator()(const AccT& acc, const Unit& u, int wr, int wc, int fr, int fq) const {
        const int row0 = u.pm * 256 + wr * 64 + fr, col0 = u.pn * 256 + wc * 32 + 8 * fq;
#pragma unroll
        for (int bj = 0; bj < 2; ++bj) { float s[8];
#pragma unroll
            for (int j = 0; j < 8; ++j) s[j] = (SMODE == 1) ? rs_from_ss(((const u64*)sc)[col0 + bj * 128 + j]) : ((const float*)sc)[col0 + bj * 128 + j];
#pragma unroll
            for (int ai = 0; ai < 2; ++ai)
#pragma unroll
                for (int m = 0; m < 4; ++m) { const int row = row0 + ai * 128 + m * 16; const f32x4 v0 = acc[ai][bj][m][0], v1 = acc[ai][bj][m][1];
                    u32x4 w; w.x = pk2(v0[0] * s[0], v0[1] * s[1]); w.y = pk2(v0[2] * s[2], v0[3] * s[3]); w.z = pk2(v1[0] * s[4], v1[1] * s[5]); w.w = pk2(v1[2] * s[6], v1[3] * s[7]);
                    *(u32x4*)(O + (size_t)row * ldc + col0 + bj * 128) = w; } }
    }
};
struct EpiQ {
    bf16_t* QB; const float* rsq; const float* cstab;
    DI void operator()(const AccT& acc, const Unit& u, int wr, int wc, int fr, int fq) const {
        const int row0 = u.pm * 256 + wr * 64 + fr, col0 = u.pn * 256 + wc * 32 + 8 * fq;
        const float QS = 0.10206207261596577f * LOG2E;
#pragma unroll
        for (int ai = 0; ai < 2; ++ai)
#pragma unroll
            for (int m = 0; m < 4; ++m) { const int t = row0 + ai * 128 + m * 16; const float s = rsq[t] * QS;
#pragma unroll
                for (int bj = 0; bj < 2; ++bj) { const int c = col0 + bj * 128, h = c / 96, d = c - h * 96;
                    f32x4 v0 = acc[ai][bj][m][0] * s, v1 = acc[ai][bj][m][1] * s;
                    if (d >= 64) { const int i0 = (d - 64) >> 1; const f32x4 cs0 = *(const f32x4*)(cstab + (size_t)t * 32 + 2 * i0), cs1 = *(const f32x4*)(cstab + (size_t)t * 32 + 2 * i0 + 4);
                        f32x4 a, b;
                        a[0] = v0[0] * cs0[0] - v0[1] * cs0[1]; a[1] = v0[1] * cs0[0] + v0[0] * cs0[1];
                        a[2] = v0[2] * cs0[2] - v0[3] * cs0[3]; a[3] = v0[3] * cs0[2] + v0[2] * cs0[3];
                        b[0] = v1[0] * cs1[0] - v1[1] * cs1[1]; b[1] = v1[1] * cs1[0] + v1[0] * cs1[1];
                        b[2] = v1[2] * cs1[2] - v1[3] * cs1[3]; b[3] = v1[3] * cs1[2] + v1[2] * cs1[3];
                        v0 = a; v1 = b; }
                    u32x4 w; w.x = pk2(v0[0], v0[1]); w.y = pk2(v0[2], v0[3]); w.z = pk2(v1[0], v1[1]); w.w = pk2(v1[2], v1[3]);
                    *(u32x4*)(QB + ((size_t)h * S + t) * 96 + d) = w; } }
    }
};
struct EpiK {
    bf16_t* KB; const float* rskv;
    DI void operator()(const AccT& acc, const Unit& u, int wr, int wc, int fr, int fq) const {
        const int row0 = u.pm * 256 + wr * 64 + fr, col0 = u.pn * 256 + wc * 32 + 8 * fq;
#pragma unroll
        for (int ai = 0; ai < 2; ++ai)
#pragma unroll
            for (int m = 0; m < 4; ++m) { const int t = row0 + ai * 128 + m * 16; const float s = rskv[t];
#pragma unroll
                for (int bj = 0; bj < 2; ++bj) { const int c = col0 + bj * 128, h = c >> 6, d = c & 63;
                    const f32x4 v0 = acc[ai][bj][m][0] * s, v1 = acc[ai][bj][m][1] * s;
                    u32x4 w; w.x = pk2(v0[0], v0[1]); w.y = pk2(v0[2], v0[3]); w.z = pk2(v1[0], v1[1]); w.w = pk2(v1[2], v1[3]);
                    *(u32x4*)(KB + ((size_t)h * S + t) * 96 + d) = w; } }
    }
};
template <bool RESBF> struct EpiRes {
    const float* res; bf16_t* XB; u64* rowss; int dry;
    DI void operator()(const AccT& acc, const Unit& u, int wr, int wc, int fr, int fq) const {
        const int row0 = u.pm * 256 + wr * 64 + fr, col0 = u.pn * 256 + wc * 32 + 8 * fq;
#pragma unroll
        for (int ai = 0; ai < 2; ++ai)
#pragma unroll
            for (int m = 0; m < 4; ++m) { const int t = row0 + ai * 128 + m * 16; float ss = 0.f;
#pragma unroll
                for (int bj = 0; bj < 2; ++bj) { const size_t o = (size_t)t * 1024 + col0 + bj * 128;
                    f32x4 r0, r1;
                    if (RESBF) { const u32x4 rb = *(const u32x4*)(XB + o); r0 = (f32x4){bflo(rb.x), bfhi(rb.x), bflo(rb.y), bfhi(rb.y)}; r1 = (f32x4){bflo(rb.z), bfhi(rb.z), bflo(rb.w), bfhi(rb.w)}; }
                    else { r0 = __builtin_nontemporal_load((const f32x4*)(res + o)); r1 = __builtin_nontemporal_load((const f32x4*)(res + o + 4)); }
                    const f32x4 v0 = acc[ai][bj][m][0] + r0, v1 = acc[ai][bj][m][1] + r1;
                    u32x4 w; w.x = pk2(v0[0], v0[1]); w.y = pk2(v0[2], v0[3]); w.z = pk2(v1[0], v1[1]); w.w = pk2(v1[2], v1[3]);
                    if (!dry) *(u32x4*)(XB + o) = w;
                    ss += v0[0] * v0[0] + v0[1] * v0[1] + v0[2] * v0[2] + v0[3] * v0[3] + v1[0] * v1[0] + v1[1] * v1[1] + v1[2] * v1[2] + v1[3] * v1[3]; }
                ss += __shfl_xor(ss, 16); ss += __shfl_xor(ss, 32);
                if (fq == 0 && !dry) atomicAdd(rowss + t, ss_to_fix(ss)); }
    }
};
DI float dpp_prev1(float cur, float prevm) {
    const int o = __builtin_amdgcn_update_dpp(0, __builtin_bit_cast(int, prevm), 0x121, 0xf, 0xf, false);
    return __builtin_bit_cast(float, __builtin_amdgcn_update_dpp(o, __builtin_bit_cast(int, cur), 0x111, 0xf, 0xf, false));
}
DI float dpp_prev2(float cur, float prevm) {
    const int o = __builtin_amdgcn_update_dpp(0, __builtin_bit_cast(int, prevm), 0x122, 0xf, 0xf, false);
    return __builtin_bit_cast(float, __builtin_amdgcn_update_dpp(o, __builtin_bit_cast(int, cur), 0x112, 0xf, 0xf, false));
}
struct EpiUp {
    bf16_t* ACT; const u64* rowss; const float* cw; const float* cb; LAS unsigned char* plds;
    DI void operator()(const AccT& acc, const Unit& u, int wr, int wc, int fr, int fq) const {
        const int cl = u.pn * 128 + wc * 32 + 8 * fq;
        LAS float* P = (LAS float*)(plds + (wr * 4 + wc) * 1024);
        { const int lane = fq * 16 + fr, kind = lane >> 3, c4 = 4 * (lane & 7), k3 = kind & 3;
          const float* src = (k3 == 0 ? cb : cw + (k3 - 1) * 5632) + (kind >= 4 ? 2816 : 0) + u.pn * 128 + wc * 32 + c4;
          *(LAS f32x4*)(P + kind * 32 + c4) = *(const f32x4*)src; }
#pragma unroll
        for (int ai = 0; ai < 2; ++ai) {
            const int tok0 = u.pm * 248 + 62 * (2 * ai + wr) - 2 + fr;
            float rs[4];
#pragma unroll
            for (int m = 0; m < 4; ++m) { const int t = tok0 + 16 * m; const int tc = t < 0 ? 0 : (t >= S ? S - 1 : t); const float r = rs_from_ss(rowss[tc]); rs[m] = t < 0 ? 0.f : r; }
            const int row0 = fr < 2 ? (S + 236 + fr) : tok0;
#pragma unroll
            for (int n = 0; n < 2; ++n) {
                const int lc = 8 * fq + 4 * n;
                unsigned wpk[4][2];
#pragma unroll
                for (int jp = 0; jp < 2; ++jp) {
                    const f32x2 bg = *(const LAS f32x2*)(P + lc + 2 * jp), g0 = *(const LAS f32x2*)(P + 32 + lc + 2 * jp), g1 = *(const LAS f32x2*)(P + 64 + lc + 2 * jp), g2 = *(const LAS f32x2*)(P + 96 + lc + 2 * jp);
                    const f32x2 bv = *(const LAS f32x2*)(P + 128 + lc + 2 * jp), v0 = *(const LAS f32x2*)(P + 160 + lc + 2 * jp), v1 = *(const LAS f32x2*)(P + 192 + lc + 2 * jp), v2 = *(const LAS f32x2*)(P + 224 + lc + 2 * jp);
                    f32x2 G[4], V[4];
#pragma unroll
                    for (int m = 0; m < 4; ++m) { G[m] = (f32x2){acc[ai][0][m][n][2 * jp], acc[ai][0][m][n][2 * jp + 1]} * rs[m]; V[m] = (f32x2){acc[ai][1][m][n][2 * jp], acc[ai][1][m][n][2 * jp + 1]} * rs[m]; }
#pragma unroll
                    for (int m = 0; m < 4; ++m) {
                        const f32x2 zz = {0.f, 0.f}; const f32x2 Gp = m ? G[m - 1] : zz, Vp = m ? V[m - 1] : zz;
                        const f32x2 gp1 = {dpp_prev1(G[m].x, Gp.x), dpp_prev1(G[m].y, Gp.y)}, gp2 = {dpp_prev2(G[m].x, Gp.x), dpp_prev2(G[m].y, Gp.y)};
                        const f32x2 vp1 = {dpp_prev1(V[m].x, Vp.x), dpp_prev1(V[m].y, Vp.y)}, vp2 = {dpp_prev2(V[m].x, Vp.x), dpp_prev2(V[m].y, Vp.y)};
                        const f32x2 gc = bg + g0 * gp2 + g1 * gp1 + g2 * G[m];
                        const f32x2 vc = bv + v0 * vp2 + v1 * vp1 + v2 * V[m];
                        const f32x2 xe = gc * (-LOG2E);
                        f32x2 dn = {__builtin_amdgcn_exp2f(xe.x), __builtin_amdgcn_exp2f(xe.y)}; dn = dn + 1.0f;
                        const f32x2 rc = {__builtin_amdgcn_rcpf(dn.x), __builtin_amdgcn_rcpf(dn.y)};
                        const f32x2 rr = gc * rc * vc;
                        wpk[m][jp] = pk2(rr.x, rr.y); }
                }
#pragma unroll
                for (int m = 0; m < 4; ++m) { const int row = m ? tok0 + 16 * m : row0;
                    *(u32x2*)(ACT + (size_t)row * 2816 + cl + 4 * n) = (u32x2){wpk[m][0], wpk[m][1]}; }
                __builtin_amdgcn_sched_barrier(0);
            }
        }
    }
};

template <class F> DI void tr_items(const F& f, int Kdst, int Nrows, bf16_t* WT, LAS float* scr, int gw, int NGW, int lane, int& cum) {
    const int nblk = Nrows / 32, nitems = (Kdst / 64) * nblk;
    int first = (gw - cum) % NGW; if (first < 0) first += NGW; cum = (cum + nitems) % NGW;
    for (int item = first; item < nitems; item += NGW) {
        const int kb = item / nblk, nb = item % nblk, k0 = 64 * kb, n0 = 32 * nb;
        float tv[32];
#pragma unroll
        for (int i = 0; i < 32; ++i) tv[i] = f(k0 + 2 * i + (lane >> 5), n0 + (lane & 31));
#pragma unroll
        for (int i = 0; i < 32; ++i) scr[(2 * i + (lane >> 5)) * 33 + (lane & 31)] = tv[i];
        asm volatile("s_waitcnt lgkmcnt(0)" ::: "memory");
        const int c = lane & 7;
#pragma unroll
        for (int j = 0; j < 4; ++j) { const int n = (lane >> 3) + 8 * j; const LAS float* s = scr + (8 * c) * 33 + n;
            u32x4 o; o.x = pk2(s[0 * 33], s[1 * 33]); o.y = pk2(s[2 * 33], s[3 * 33]); o.z = pk2(s[4 * 33], s[5 * 33]); o.w = pk2(s[6 * 33], s[7 * 33]);
            *(u32x4*)(WT + (size_t)(n0 + n) * Kdst + k0 + 8 * c) = o; }
        asm volatile("s_waitcnt lgkmcnt(0)" ::: "memory");
    }
}
struct FW1 { const float* W; const float* g; DI float operator()(int k, int n) const { return n < 1440 ? __builtin_nontemporal_load(&W[(size_t)k * 1440 + n]) * g[k] : 0.f; } };
struct FWQ { const float* W; const float* g; DI float operator()(int k, int n) const { const int h = n / 96, d = n - h * 96; int c = d; if (d >= 64) { const int r = d - 64; c = 64 + (r >> 1) + 16 * (r & 1); } return __builtin_nontemporal_load(&W[(size_t)k * 768 + h * 96 + c]) * g[k]; } };
struct FWKV { const float* W; const float* g; int off; DI float operator()(int k, int n) const { return k < 128 ? __builtin_nontemporal_load(&W[(size_t)k * 1024 + (n >> 6) * 128 + off + (n & 63)]) * g[k] : 0.f; } };
struct FWRI { const float* Wa; const float* Wx; DI float operator()(int k, int n) const { const float* W = n < 512 ? Wa : Wx; const int ch = n & 511, g = ch >> 6, j = ch & 63; return (k >> 6) == g ? __builtin_nontemporal_load(&W[(size_t)k * 64 + j]) : 0.f; } };
struct FWP { const float* W; int N; DI float operator()(int k, int n) const { return __builtin_nontemporal_load(&W[(size_t)k * N + n]); } };
struct FWUP { const float* W; const float* g; DI float operator()(int k, int n) const { const int pn = n >> 8, r = n & 255; const int c = r < 128 ? 128 * pn + r : 2816 + 128 * pn + r - 128; return __builtin_nontemporal_load(&W[(size_t)k * 5632 + c]) * g[k]; } };
struct FWOIN { const float* W; const float* g; DI float operator()(int k, int n) const {
    int c; float s = 1.f; if (n < 512) { c = n; s = 0.08838834764831845f; } else if (n < 1536) c = 2048 + (n - 512); else if (n < 2048) c = 512 + (n - 1536); else c = 1024 + (n - 2048);
    return __builtin_nontemporal_load(&W[(size_t)k * 3080 + c]) * g[k] * s; } };

#ifndef PROPART
#define PROPART 7
#endif
DI void phase_prologue(int wv, const ArgP a, LAS unsigned char* lds, int parts) {
    unsigned char* ws = a.ws();
    const int tid = ltid(wv), wave = tid >> 6, lane = tid & 63;
    LAS float* scr = (LAS float*)(lds + wave * 8448);
    const int gw = blockIdx.x * 8 + wave, NGW = gridDim.x * 8; int cum = 0;
    if (parts & 1) {
    { FW1 f{a.in(3), a.in(2)}; tr_items(f, 1024, 1536, (bf16_t*)(ws + O_W1T), scr, gw, NGW, lane, cum); }
    { FWQ f{a.in(12), a.in(11)}; tr_items(f, 256, 768, (bf16_t*)(ws + O_WQT), scr, gw, NGW, lane, cum); }
    { FWKV f{a.in(14), a.in(13), 0}; tr_items(f, 256, 512, (bf16_t*)(ws + O_WKT), scr, gw, NGW, lane, cum); }
    { FWKV f{a.in(14), a.in(13), 64}; tr_items(f, 256, 512, (bf16_t*)(ws + O_WVT), scr, gw, NGW, lane, cum); }
    { FWRI f{a.in(6), a.in(8)}; tr_items(f, 512, 1024, (bf16_t*)(ws + O_WRIT), scr, gw, NGW, lane, cum); }
    { FWP f{a.in(15), 1024}; tr_items(f, 1024, 1024, (bf16_t*)(ws + O_WO1T), scr, gw, NGW, lane, cum); }
    for (int l = 0; l < 2; ++l) {
        { FWUP f{a.in(23) + (size_t)l * 1024 * 5632, a.in(22) + l * 1024}; tr_items(f, 1024, 5632, (bf16_t*)(ws + (l ? O_WUPT1 : O_WUPT0)), scr, gw, NGW, lane, cum); }
        { FWP f{a.in(26) + (size_t)l * 2816 * 1024, 1024}; tr_items(f, 2816, 1024, (bf16_t*)(ws + (l ? O_WDNT1 : O_WDNT0)), scr, gw, NGW, lane, cum); }
    }
    { FWOIN f{a.in(17), a.in(16)}; tr_items(f, 1024, 3072, (bf16_t*)(ws + O_WOINT), scr, gw, NGW, lane, cum); }
    { FWP f{a.in(21), 1024}; tr_items(f, 1024, 1024, (bf16_t*)(ws + O_WO2T), scr, gw, NGW, lane, cum); }
    }
    if (parts & 2) {
    const float* x = a.in(0); bf16_t* XB = (bf16_t*)(ws + O_XB) + 2 * 1024; u64* rowss = (u64*)(ws + O_ROWSS);
#pragma unroll 4
    for (int t = gw; t < S; t += NGW) {
        float ss = 0.f;
#pragma unroll
        for (int j = 0; j < 4; ++j) { const f32x4 v = __builtin_nontemporal_load((const f32x4*)(x + (size_t)t * 1024 + j * 256 + lane * 4));
            ss += v[0] * v[0] + v[1] * v[1] + v[2] * v[2] + v[3] * v[3];
            u32x2 w; w.x = pk2(v[0], v[1]); w.y = pk2(v[2], v[3]); *(u32x2*)(XB + (size_t)t * 1024 + j * 256 + lane * 4) = w; }
        ss = wave_sum(ss);
        if (lane == 0) rowss[t] = ss_to_fix(ss);
        if (lane >= 1 && lane < 5) rowss[(size_t)lane * S + t] = 0ull;
    }
    }
    if (parts & 4) {
    const int* pos = (const int*)a.in(1); float* cst = (float*)(ws + O_CSTAB);
    for (int e = blockIdx.x * 512 + tid; e < S * 16; e += gridDim.x * 512) { const int t = e >> 4, i = e & 15;
        const float invf = __builtin_amdgcn_exp2f(-(float)i * (13.287712379549449f / 16.f)); const float ang = (float)pos[t] * invf;
        const float k = rintf(ang * 0.15915494309189535f);
        float r = fmaf(-k, 6.28318548202514648f, ang); r = fmaf(-k, -1.7484555e-7f, r);
        const float rr = r * 0.15915494309189535f;
        cst[2 * e] = __builtin_amdgcn_cosf(rr); cst[2 * e + 1] = __builtin_amdgcn_sinf(rr); }
    }
}

DI void phase_l0_prep(int wv, const ArgP a) {
    unsigned char* ws = a.ws();
    const bf16_t* Z = (const bf16_t*)(ws + O_Z); bf16_t* XC = (bf16_t*)(ws + O_XC); bf16_t* KB = (bf16_t*)(ws + O_KB);
    float* rsq = (float*)(ws + O_RSQ); float* rskv = (float*)(ws + O_RSKV); const float* cst = (const float*)(ws + O_CSTAB);
    const float* cw = a.in(4); const float* cb = a.in(5);
    const int tid = ltid(wv), wave = tid >> 6, lane = tid & 63;
#pragma unroll 2
    for (int e = blockIdx.x * 512 + tid; e < S * 64; e += gridDim.x * 512) { const int t = e >> 6, c0 = (e & 63) * 8;
        float acc[8];
#pragma unroll
        for (int j = 0; j < 8; ++j) acc[j] = cb[c0 + j];
#pragma unroll
        for (int k = 0; k < 4; ++k) { const int tt = t - 3 + k; if (tt < 0) continue;
            const u32x4 v = *(const u32x4*)(Z + (size_t)tt * 1536 + c0);
            const f32x4 w0 = *(const f32x4*)(cw + k * 512 + c0), w1 = *(const f32x4*)(cw + k * 512 + c0 + 4);
            acc[0] += w0[0] * bflo(v.x); acc[1] += w0[1] * bfhi(v.x); acc[2] += w0[2] * bflo(v.y); acc[3] += w0[3] * bfhi(v.y);
            acc[4] += w1[0] * bflo(v.z); acc[5] += w1[1] * bfhi(v.z); acc[6] += w1[2] * bflo(v.w); acc[7] += w1[3] * bfhi(v.w); }
        u32x4 o; o.x = pk2(acc[0], acc[1]); o.y = pk2(acc[2], acc[3]); o.z = pk2(acc[4], acc[5]); o.w = pk2(acc[6], acc[7]);
        *(u32x4*)(XC + (size_t)t * 512 + c0) = o; }
#pragma unroll 4
    for (int t = blockIdx.x * 8 + wave; t < S; t += gridDim.x * 8) {
        const bf16_t* zr = Z + (size_t)t * 1536;
        float sq = 0.f, skv = 0.f;
        { const u32x2 v = *(const u32x2*)(zr + 1024 + lane * 4); const float p0 = bflo(v.x), p1 = bfhi(v.x), p2 = bflo(v.y), p3 = bfhi(v.y); sq = p0 * p0 + p1 * p1 + p2 * p2 + p3 * p3; }
        { const unsigned v = *(const unsigned*)(zr + 1280 + lane * 2); const float p0 = bflo(v), p1 = bfhi(v); skv = p0 * p0 + p1 * p1; }
        sq = wave_sum(sq); skv = wave_sum(skv);
        if (lane == 0) { rsq[t] = rsqrtf(sq * (1.f / 256.f) + EPS); rskv[t] = rsqrtf(skv * (1.f / 128.f) + EPS); }
        if (lane < 16) { const float x1 = bf2f(zr[1408 + lane]), x2 = bf2f(zr[1424 + lane]); const float c = cst[(size_t)t * 32 + 2 * lane], s = cst[(size_t)t * 32 + 2 * lane + 1];
            const unsigned w = pk2(x1 * c - x2 * s, x2 * c + x1 * s);
#pragma unroll
            for (int h = 0; h < 8; ++h) *(unsigned*)(KB + ((size_t)h * S + t) * 96 + 64 + 2 * lane) = w; }
    }
}

DI void lru_coeff(float rpre, float ipre, float xc, float sp8, float& av, float& uv) {
    const float r = sigmoidf_(rpre), ig = sigmoidf_(ipre);
    const float la = -sp8 * r;
    av = fexp(la);
    uv = __builtin_amdgcn_sqrtf(fmaxf(1.f - av * av, 0.f)) * (ig * xc);
}
DI void phase_lru_s1(int wv, const ArgP a) {
    unsigned char* ws = a.ws(); const int ch = ltid(wv);
    const bf16_t* RI = (const bf16_t*)(ws + O_RI); const bf16_t* XC = (const bf16_t*)(ws + O_XC);
    float* CHA = (float*)(ws + O_CHA); float* CHH = (float*)(ws + O_CHH);
    const float ba = a.in(7)[ch], bx = a.in(9)[ch]; const float lam = a.in(10)[ch];
    const float sp8 = 8.f * log1pf(expf(-lam));
    for (int c = blockIdx.x; c < 256; c += gridDim.x) {
        float A = 1.f, H = 0.f;
#pragma unroll 8
        for (int i = 0; i < 64; ++i) { const size_t t = (size_t)c * 64 + i;
            float av, uv; lru_coeff(bf2f(RI[t * 1024 + ch]) + ba, bf2f(RI[t * 1024 + 512 + ch]) + bx, bf2f(XC[t * 512 + ch]), sp8, av, uv);
            A *= av; H = av * H + uv; }
        CHA[c * 512 + ch] = A; CHH[c * 512 + ch] = H;
    }
}
DI void phase_lru_s3(int wv, const ArgP a) {
    unsigned char* ws = a.ws(); const int ch = ltid(wv);
    const bf16_t* RI = (const bf16_t*)(ws + O_RI); const bf16_t* XC = (const bf16_t*)(ws + O_XC); const bf16_t* Z = (const bf16_t*)(ws + O_Z);
    const float* CHA = (const float*)(ws + O_CHA); const float* CHH = (const float*)(ws + O_CHH); bf16_t* MIX = (bf16_t*)(ws + O_MIX);
    const float ba = a.in(7)[ch], bx = a.in(9)[ch]; const float lam = a.in(10)[ch];
    const float sp8 = 8.f * log1pf(expf(-lam));
    for (int c = blockIdx.x; c < 256; c += gridDim.x) {
        float H = 0.f;
        { int cc = 0;
          for (; cc + 28 <= c; cc += 28) { float aa[28], hh[28];
#pragma unroll
              for (int k = 0; k < 28; ++k) { aa[k] = CHA[(cc + k) * 512 + ch]; hh[k] = CHH[(cc + k) * 512 + ch]; }
#pragma unroll
              for (int k = 0; k < 28; ++k) H = aa[k] * H + hh[k]; }
          for (; cc < c; ++cc) H = CHA[cc * 512 + ch] * H + CHH[cc * 512 + ch]; }
#pragma unroll 4
        for (int i = 0; i < 64; ++i) { const size_t t = (size_t)c * 64 + i;
            float av, uv; lru_coeff(bf2f(RI[t * 1024 + ch]) + ba, bf2f(RI[t * 1024 + 512 + ch]) + bx, bf2f(XC[t * 512 + ch]), sp8, av, uv);
            H = av * H + uv;
            const float g = bf2f(Z[t * 1536 + 512 + ch]);
            const float y = 0.7978845608028654f * (g + 0.044715f * g * g * g);
            const float th = 1.f - 2.f * __builtin_amdgcn_rcpf(1.f + fexp(2.f * y));
            MIX[t * 1024 + ch] = f2bf(H * 0.5f * g * (1.f + th)); }
    }
}

constexpr int AT_KROW = 208, AT_VROW = 136, AT_KT = 64 * AT_KROW, AT_VT = 64 * AT_VROW;
DI float rowmax32(const f32x16& p0, const f32x16& p1) {
    float a = fmaxf(fmaxf(p0[0], p0[1]), p1[0]), b = fmaxf(fmaxf(p0[2], p0[3]), p1[1]); a = fmaxf(fmaxf(a, p1[2]), p1[3]);
#pragma unroll
    for (int r = 4; r < 16; r += 4) { a = fmaxf(fmaxf(a, p0[r]), p0[r + 1]); b = fmaxf(fmaxf(b, p0[r + 2]), p0[r + 3]); a = fmaxf(fmaxf(a, p1[r]), p1[r + 1]); b = fmaxf(fmaxf(b, p1[r + 2]), p1[r + 3]); }
    const float m = fmaxf(a, b);
    const auto rr = __builtin_amdgcn_permlane32_swap(__float_as_uint(m), __float_as_uint(m), false, false);
    return fmaxf(__uint_as_float(rr[0]), __uint_as_float(rr[1]));
}
DI void attn_unit(int wv, int h, int qb, const bf16_t* QB, const bf16_t* KB, const bf16_t* VT, bf16_t* MIX, LAS unsigned char* lds) {
    const int tid = ltid(wv), lane = tid & 63, r32 = lane & 31, hi = lane >> 5; const int wid = __builtin_amdgcn_readfirstlane(tid >> 6);
    const int qg = qb * 256 + wid * 32 + r32;
    const bf16_t* Kh = KB + (size_t)h * S * 96; const bf16_t* Vh = VT + (size_t)h * 64 * S;
    bf16x8 qf[6];
    { const bf16_t* qp = QB + ((size_t)h * S + qg) * 96 + 8 * hi;
#pragma unroll
      for (int s = 0; s < 6; ++s) qf[s] = *(const bf16x8*)(qp + 16 * s); }
    f32x16 o0 = {}, o1 = {}, negm = {};
    float mref = 0.f, lrun = 0.f;
    const int NT = 4 * qb + 4, wlim = 4 * qb + (wid >> 1);
    const int kc0 = tid, kkey0 = kc0 / 12, kpart0 = kc0 % 12;
    const int kc1 = tid + 512, kkey1 = kc1 / 12, kpart1 = kc1 % 12;
    const int vdv = tid >> 3, vpart = tid & 7;
    u32x4 rk0, rk1 = {}, rv;
#define AT_LOADK(t_) do { const size_t kb_ = (size_t)(t_) * 64; rk0 = *(const u32x4*)(Kh + (kb_ + kkey0) * 96 + kpart0 * 8); if (tid < 256) rk1 = *(const u32x4*)(Kh + (kb_ + kkey1) * 96 + kpart1 * 8); } while (0)
#define AT_LOADV(t_) do { rv = *(const u32x4*)(Vh + (size_t)vdv * S + (size_t)(t_) * 64 + vpart * 8); } while (0)
#define AT_WRITEK(t_) do { LAS unsigned char* Ks_ = lds + ((t_) & 1) * AT_KT; *(LAS u32x4*)(Ks_ + kkey0 * AT_KROW + kpart0 * 16) = rk0; if (tid < 256) *(LAS u32x4*)(Ks_ + kkey1 * AT_KROW + kpart1 * 16) = rk1; } while (0)
#define AT_WRITEV(t_) do { LAS unsigned char* Vs_ = lds + 2 * AT_KT + ((t_) & 1) * AT_VT; *(LAS u32x2*)(Vs_ + vdv * AT_VROW + vpart * 16) = (u32x2){rv.x, rv.y}; *(LAS u32x2*)(Vs_ + vdv * AT_VROW + vpart * 16 + 8) = (u32x2){rv.z, rv.w}; } while (0)
#define AT_QK(P0, P1, t_) do { const LAS unsigned char* Ks_ = lds + ((t_) & 1) * AT_KT + r32 * AT_KROW + 16 * hi; f32x16 c0_ = negm, c1_ = negm; \
        _Pragma("unroll") for (int s = 0; s < 6; ++s) { const bf16x8 k0_ = *(const LAS bf16x8*)(Ks_ + 32 * s), k1_ = *(const LAS bf16x8*)(Ks_ + 32 * AT_KROW + 32 * s); \
            c0_ = __builtin_amdgcn_mfma_f32_32x32x16_bf16(k0_, qf[s], c0_, 0, 0, 0); c1_ = __builtin_amdgcn_mfma_f32_32x32x16_bf16(k1_, qf[s], c1_, 0, 0, 0); } \
        P0 = c0_; P1 = c1_; } while (0)
#define AT_SM1(P0, P1, MOFF, t_, MASK) do { \
        if (MASK && (t_) == wlim) { const int kbase_ = (t_) * 64 + 4 * hi; \
            _Pragma("unroll") for (int r = 0; r < 16; ++r) { const int kv_ = kbase_ + (r & 3) + 8 * (r >> 2); if (kv_ > qg) P0[r] = -1e30f; if (kv_ + 32 > qg) P1[r] = -1e30f; } } \
        const float d_ = mref - MOFF;                         \
        const float mx_ = rowmax32(P0, P1) - d_;              \
        if ((t_) == 0 || __any(mx_ > 8.f || d_ != 0.f)) { const float dl_ = ((t_) == 0) ? mx_ : fmaxf(mx_, 0.f); mref += dl_; \
            const float sh_ = d_ + dl_; \
            _Pragma("unroll") for (int r = 0; r < 16; ++r) { P0[r] -= sh_; P1[r] -= sh_; } \
            const float al_ = ((t_) == 0) ? 1.f : __builtin_amdgcn_exp2f(-dl_); lrun *= al_;     \
            _Pragma("unroll") for (int r = 0; r < 16; ++r) { o0[r] *= al_; o1[r] *= al_; negm[r] = -mref; } asm volatile("" : "+v"(negm)); } \
    } while (0)
#define AT_SM2(P0, P1, t_) do { \
        float ps_ = 0.f; \
        _Pragma("unroll") for (int r = 0; r < 16; ++r) { P0[r] = __builtin_amdgcn_exp2f(P0[r]); P1[r] = __builtin_amdgcn_exp2f(P1[r]); ps_ += P0[r] + P1[r]; } \
        lrun += ps_; \
        const LAS unsigned char* Vs_ = lds + 2 * AT_KT + ((t_) & 1) * AT_VT + r32 * AT_VROW + 8 * hi; \
        _Pragma("unroll") for (int ks = 0; ks < 4; ++ks) { u32x4 w_; \
            if (ks < 2) { w_.x = pk2(P0[8 * ks], P0[8 * ks + 1]); w_.y = pk2(P0[8 * ks + 2], P0[8 * ks + 3]); w_.z = pk2(P0[8 * ks + 4], P0[8 * ks + 5]); w_.w = pk2(P0[8 * ks + 6], P0[8 * ks + 7]); } \
            else { w_.x = pk2(P1[8 * ks - 16], P1[8 * ks - 15]); w_.y = pk2(P1[8 * ks - 14], P1[8 * ks - 13]); w_.z = pk2(P1[8 * ks - 12], P1[8 * ks - 11]); w_.w = pk2(P1[8 * ks - 10], P1[8 * ks - 9]); } \
            const bf16x8 pa_ = __builtin_bit_cast(bf16x8, w_); \
            const u32x2 a0_ = *(const LAS u32x2*)(Vs_ + 32 * ks), a1_ = *(const LAS u32x2*)(Vs_ + 32 * ks + 16); \
            const u32x2 b0_ = *(const LAS u32x2*)(Vs_ + 32 * AT_VROW + 32 * ks), b1_ = *(const LAS u32x2*)(Vs_ + 32 * AT_VROW + 32 * ks + 16); \
            o0 = __builtin_amdgcn_mfma_f32_32x32x16_bf16(__builtin_bit_cast(bf16x8, (u32x4){a0_.x, a0_.y, a1_.x, a1_.y}), pa_, o0, 0, 0, 0); \
            o1 = __builtin_amdgcn_mfma_f32_32x32x16_bf16(__builtin_bit_cast(bf16x8, (u32x4){b0_.x, b0_.y, b1_.x, b1_.y}), pa_, o1, 0, 0, 0); } \
    } while (0)
#define AT_STEPM(C0, C1, MC, N0, N1, MN, t_) do { \
        AT_WRITEK((t_) + 1); AT_WRITEV(t_); \
        __syncthreads(); \
        AT_LOADK((t_) + 2); AT_LOADV((t_) + 1); \
        AT_SM1(C0, C1, MC, t_, 0); MN = mref; AT_QK(N0, N1, (t_) + 1); AT_SM2(C0, C1, t_); \
    } while (0)
#define AT_STEPB(C0, C1, MC, N0, N1, MN, t_) do { \
        if ((t_) + 1 < NT) AT_WRITEK((t_) + 1); AT_WRITEV(t_); \
        __syncthreads(); \
        if ((t_) + 2 < NT) AT_LOADK((t_) + 2); if ((t_) + 1 < NT) AT_LOADV((t_) + 1); \
        if ((t_) + 1 <= wlim) { MN = mref; AT_QK(N0, N1, (t_) + 1); } \
        if ((t_) <= wlim) { AT_SM1(C0, C1, MC, t_, 1); AT_SM2(C0, C1, t_); } \
    } while (0)
    f32x16 pA0, pA1, pB0 = {}, pB1 = {}; float mA = 0.f, mB = 0.f;
    AT_LOADK(0); AT_WRITEK(0);
    __syncthreads();
    AT_LOADK(1); AT_LOADV(0);
    AT_QK(pA0, pA1, 0);
    int t = 0;
    for (; t < 4 * qb; t += 2) {
        AT_STEPM(pA0, pA1, mA, pB0, pB1, mB, t);
        AT_STEPM(pB0, pB1, mB, pA0, pA1, mA, t + 1);
    }
    for (; t < NT; t += 2) {
        AT_STEPB(pA0, pA1, mA, pB0, pB1, mB, t);
        AT_STEPB(pB0, pB1, mB, pA0, pA1, mA, t + 1);
    }
#undef AT_STEPM
#undef AT_STEPB
#undef AT_LOADK
#undef AT_LOADV
#undef AT_WRITEK
#undef AT_WRITEV
#undef AT_QK
#undef AT_SM1
#undef AT_SM2
    lrun += __shfl_xor(lrun, 32);
    const float inv = 1.f / lrun;
    bf16_t* op = MIX + (size_t)qg * 1024 + 512 + h * 64;
#pragma unroll
    for (int g = 0; g < 4; ++g) { const int dv = 8 * g + 4 * hi;
        u32x2 w; w.x = pk2(o0[4 * g] * inv, o0[4 * g + 1] * inv); w.y = pk2(o0[4 * g + 2] * inv, o0[4 * g + 3] * inv); *(u32x2*)(op + dv) = w;
        u32x2 w2; w2.x = pk2(o1[4 * g] * inv, o1[4 * g + 1] * inv); w2.y = pk2(o1[4 * g + 2] * inv, o1[4 * g + 3] * inv); *(u32x2*)(op + 32 + dv) = w2; }
    __syncthreads();
}
DI void phase_attn(int wv, const ArgP a, LAS unsigned char* lds) {
    unsigned char* ws = a.ws();
    const bf16_t* QB = (const bf16_t*)(ws + O_QB); const bf16_t* KB = (const bf16_t*)(ws + O_KB); const bf16_t* VT = (const bf16_t*)(ws + O_VT); bf16_t* MIX = (bf16_t*)(ws + O_MIX);
    if (wv >= 4) __builtin_amdgcn_s_setprio(1);
    for (int b = blockIdx.x; b < 256; b += gridDim.x) {
        const int v = (b & 7) * 32 + (b >> 3), h = v >> 5, s = v & 31;
        attn_unit(wv, h, 63 - s, QB, KB, VT, MIX, lds);
        attn_unit(wv, h, s, QB, KB, VT, MIX, lds);
    }
    __builtin_amdgcn_s_setprio(0);
}

DI void phase_m_gates(int wv, const ArgP a, LAS unsigned char* lds) {
    unsigned char* ws = a.ws(); const int tid = ltid(wv), wave = tid >> 6, lane = tid & 63;
    const bf16_t* XBr = (const bf16_t*)(ws + O_XB) + 2 * 1024; const u64* rowss = (const u64*)(ws + O_ROWSS) + 2 * S;
    const float* Wg = a.in(17); const float* gn = a.in(16);
    LAS float* wgs = (LAS float*)lds;
    LAS float* pre = (LAS float*)(lds + 32768);
    float* GB = (float*)(ws + O_GB); float* GE = (float*)(ws + O_GE); float* GPM = (float*)(ws + O_GPM);
    float* BL = (float*)(ws + O_BL); float* ML = (float*)(ws + O_ML);
    for (int e = tid; e < 8192; e += 512) { const int k = e >> 3, j = e & 7; wgs[j * 1024 + k] = Wg[(size_t)k * 3080 + 3072 + j] * gn[k]; }
    __syncthreads();
    for (int c = blockIdx.x; c < 256; c += gridDim.x) {
#pragma unroll 4
        for (int i = 0; i < 8; ++i) { const int t = c * 64 + wave * 8 + i;
            float acc[8];
#pragma unroll
            for (int j = 0; j < 8; ++j) acc[j] = 0.f;
#pragma unroll
            for (int jj = 0; jj < 4; ++jj) { const int k0 = jj * 256 + lane * 4; const u32x2 hb = *(const u32x2*)(XBr + (size_t)t * 1024 + k0); const f32x4 hv = {bflo(hb.x), bfhi(hb.x), bflo(hb.y), bfhi(hb.y)};
#pragma unroll
                for (int j = 0; j < 8; ++j) { const f32x4 wj = *(const LAS f32x4*)(wgs + j * 1024 + k0); acc[j] += hv[0] * wj[0] + hv[1] * wj[1] + hv[2] * wj[2] + hv[3] * wj[3]; } }
            const float rs = rs_from_ss(rowss[t]);
            { const bool b5 = lane & 32, b4 = lane & 16, b3 = lane & 8;
#pragma unroll
              for (int j = 0; j < 4; ++j) { const float snd = b5 ? acc[j] : acc[j + 4], kp = b5 ? acc[j + 4] : acc[j]; acc[j] = kp + __shfl_xor(snd, 32); }
#pragma unroll
              for (int j = 0; j < 2; ++j) { const float snd = b4 ? acc[j] : acc[j + 2], kp = b4 ? acc[j + 2] : acc[j]; acc[j] = kp + __shfl_xor(snd, 16); }
              { const float snd = b3 ? acc[0] : acc[1], kp = b3 ? acc[1] : acc[0]; acc[0] = kp + __shfl_xor(snd, 8); }
              acc[0] += __shfl_xor(acc[0], 4); acc[0] += __shfl_xor(acc[0], 2); acc[0] += __shfl_xor(acc[0], 1);
              if ((lane & 7) == 0) pre[(wave * 8 + i) * 8 + (b5 ? 4 : 0) + (b4 ? 2 : 0) + (b3 ? 1 : 0)] = acc[0] * rs; }
        }
        __syncthreads();
        if (wave < 4) { const int h = wave; const float bi = a.in(18)[h], bfg = a.in(19)[h];
            const float ig = 15.f * tanhf((pre[lane * 8 + h] + bi) * (1.f / 15.f));
            const float fg = 15.f * tanhf((pre[lane * 8 + 4 + h] + bfg) * (1.f / 15.f));
            float b = -log1pf(expf(-fg));
#pragma unroll
            for (int o = 1; o < 64; o <<= 1) { const float v = __shfl_up(b, o); if (lane >= o) b += v; }
            const float e = ig - b; float pm = e;
#pragma unroll
            for (int o = 1; o < 64; o <<= 1) { const float v = __shfl_up(pm, o); if (lane >= o) pm = fmaxf(pm, v); }
            const size_t o_ = (size_t)h * S + c * 64 + lane; GB[o_] = b; GE[o_] = e; GPM[o_] = pm;
            if (lane == 63) { BL[c * 4 + h] = b; ML[c * 4 + h] = b + pm; } }
        __syncthreads();
    }
}
DI void phase_m_dc(int wv, const ArgP a) {
    unsigned char* ws = a.ws(); const int tid = ltid(wv), lane = tid & 63, r32 = lane & 31, hi = lane >> 5; const int w = __builtin_amdgcn_readfirstlane(tid >> 6);
    const float* __restrict__ BL = (const float*)(ws + O_BL); const float* __restrict__ ML = (const float*)(ws + O_ML); float* __restrict__ NST = (float*)(ws + O_NST);
    const float* __restrict__ GE = (const float*)(ws + O_GE); const bf16_t* __restrict__ KVT = (const bf16_t*)(ws + O_KVT); bf16_t* __restrict__ CST = (bf16_t*)(ws + O_CST);
#pragma unroll 2
    for (int u = blockIdx.x; u < 1024; u += gridDim.x) {
        const int c = u >> 2, h = u & 3; const size_t t0 = (size_t)c * 64;
        const float emax = ML[c * 4 + h] - BL[c * 4 + h];
        bf16x8 bfr[4];
        { const bf16_t* vp = KVT + (size_t)(512 + h * 256 + 32 * w + r32) * S + t0 + 8 * hi; const float* gp = GE + (size_t)h * S + t0 + 8 * hi;
#pragma unroll
          for (int ks = 0; ks < 4; ++ks) { const u32x4 v = *(const u32x4*)(vp + 16 * ks); const f32x4 e0 = *(const f32x4*)(gp + 16 * ks), e1 = *(const f32x4*)(gp + 16 * ks + 4);
              u32x4 o; o.x = pk2(bflo(v.x) * fexp(e0[0] - emax), bfhi(v.x) * fexp(e0[1] - emax)); o.y = pk2(bflo(v.y) * fexp(e0[2] - emax), bfhi(v.y) * fexp(e0[3] - emax));
              o.z = pk2(bflo(v.z) * fexp(e1[0] - emax), bfhi(v.z) * fexp(e1[1] - emax)); o.w = pk2(bflo(v.w) * fexp(e1[2] - emax), bfhi(v.w) * fexp(e1[3] - emax));
              bfr[ks] = __builtin_bit_cast(bf16x8, o); } }
        const bf16_t* kp = KVT + (size_t)(h * 128 + r32) * S + t0 + 8 * hi;
        bf16_t* op = CST + ((size_t)(c * 4 + h) * 256 + 32 * w + r32) * 128 + 8 * hi;
#pragma unroll
        for (int rb = 0; rb < 4; ++rb) { f32x16 acc = {};
#pragma unroll
            for (int ks = 0; ks < 4; ++ks) { const bf16x8 ka = *(const bf16x8*)(kp + (size_t)(32 * rb) * S + 16 * ks); acc = __builtin_amdgcn_mfma_f32_32x32x16_bf16(ka, bfr[ks], acc, 0, 0, 0); }
#pragma unroll
            for (int p = 0; p < 2; ++p) {
                const unsigned a0 = pk2(acc[8 * p], acc[8 * p + 1]), a1 = pk2(acc[8 * p + 2], acc[8 * p + 3]), b0 = pk2(acc[8 * p + 4], acc[8 * p + 5]), b1 = pk2(acc[8 * p + 6], acc[8 * p + 7]);
                const auto r0 = __builtin_amdgcn_permlane32_swap(a0, b0, false, false), r1 = __builtin_amdgcn_permlane32_swap(a1, b1, false, false);
                *(u32x4*)(op + 32 * rb + 16 * p) = (u32x4){r0[0], r1[0], r0[1], r1[1]}; } }
        if (tid < 128) { const bf16_t* kr = KVT + (size_t)(h * 128 + tid) * S + t0; const float* gp = GE + (size_t)h * S + t0; float s = 0.f;
#pragma unroll
            for (int p = 0; p < 8; ++p) { const u32x4 v = *(const u32x4*)(kr + 8 * p); const f32x4 e0 = *(const f32x4*)(gp + 8 * p), e1 = *(const f32x4*)(gp + 8 * p + 4);
                s += bflo(v.x) * fexp(e0[0] - emax) + bfhi(v.x) * fexp(e0[1] - emax) + bflo(v.y) * fexp(e0[2] - emax) + bfhi(v.y) * fexp(e0[3] - emax)
                   + bflo(v.z) * fexp(e1[0] - emax) + bfhi(v.z) * fexp(e1[1] - emax) + bflo(v.w) * fexp(e1[2] - emax) + bfhi(v.w) * fexp(e1[3] - emax); }
            NST[(size_t)(c * 4 + h) * 128 + tid] = s; }
    }
}
DI void phase_m_comb(int wv, const ArgP a, LAS unsigned char* lds, int dry) {
    unsigned char* ws = a.ws(); const int tid = ltid(wv);
    const float* BL = (const float*)(ws + O_BL); const float* ML = (const float*)(ws + O_ML); float* MST = (float*)(ws + O_MST); float* NST = (float*)(ws + O_NST);
    bf16_t* CST = (bf16_t*)(ws + O_CST);
    LAS float* bls = (LAS float*)lds; LAS float* mls = bls + 1024; LAS float* ga = mls + 1024; LAS float* gb = ga + 1024;
    for (int e = tid; e < 1024; e += 512) { bls[e] = BL[e]; mls[e] = ML[e]; }
    __syncthreads();
    if (tid < 256) { const int h = tid >> 6, l = tid & 63;
        float a_ = 0.f, b_ = -1e30f;
#pragma unroll
        for (int k = 0; k < 4; ++k) { const float bl = bls[(4 * l + k) * 4 + h], ml = mls[(4 * l + k) * 4 + h]; a_ += bl; b_ = fmaxf(b_ + bl, ml); }
        float pa = a_, pb = b_;
#pragma unroll
        for (int o = 1; o < 64; o <<= 1) { const float qa = __shfl_up(pa, o), qb = __shfl_up(pb, o); if (l >= o) { pb = fmaxf(qb + pa, pb); pa = qa + pa; } }
        float ea = __shfl_up(pa, 1), eb_ = __shfl_up(pb, 1); if (l == 0) { ea = 0.f; eb_ = -1e30f; }
        float m = fmaxf(0.f + ea, eb_);
#pragma unroll
        for (int k = 0; k < 4; ++k) { const int c = 4 * l + k; const float bl = bls[c * 4 + h], ml = mls[c * 4 + h]; const float mn = fmaxf(bl + m, ml);
            ga[c * 4 + h] = fexp(bl + m - mn); gb[c * 4 + h] = fexp(ml - mn);
            if (blockIdx.x == 0 && !dry) MST[c * 4 + h] = m;
            m = mn; } }
    __syncthreads();
    for (int eb = blockIdx.x; eb < 129; eb += gridDim.x) {
        if (eb < 128) { const int h = eb >> 5; unsigned* p = (unsigned*)(CST + (size_t)h * 32768 + (size_t)(eb & 31) * 1024 + 2 * tid); float C0 = 0.f, C1 = 0.f;
            for (int c = 0; c < 256; c += 64) { unsigned d[64];
#pragma unroll
                for (int k = 0; k < 64; ++k) d[k] = p[(size_t)(c + k) * 65536];
#pragma unroll
                for (int k = 0; k < 64; ++k) { if (!dry) p[(size_t)(c + k) * 65536] = pk2(C0, C1); const float a_ = ga[(c + k) * 4 + h], b_ = gb[(c + k) * 4 + h]; C0 = a_ * C0 + b_ * bflo(d[k]); C1 = a_ * C1 + b_ * bfhi(d[k]); } }
        } else { const int h = tid >> 7; float* p = NST + tid; float C = 0.f;
            for (int c = 0; c < 256; c += 8) { float d[8];
#pragma unroll
                for (int k = 0; k < 8; ++k) d[k] = p[(size_t)(c + k) * 512];
#pragma unroll
                for (int k = 0; k < 8; ++k) { if (!dry) p[(size_t)(c + k) * 512] = C; C = ga[(c + k) * 4 + h] * C + gb[(c + k) * 4 + h] * d[k]; } } }
    }
    __syncthreads();
}
constexpr int MC_QROW = 272, MC_SROW = 144;
constexpr int MC_QS = 0, MC_KS = 64 * MC_QROW, MC_SC = 2 * 64 * MC_QROW, MC_F = MC_SC + 64 * MC_SROW;
DI void phase_m_out(int wv, const ArgP a, LAS unsigned char* lds, int dry) {
    unsigned char* ws = a.ws(); const int tid = ltid(wv), lane = tid & 63, r32 = lane & 31, hi = lane >> 5; const int w = __builtin_amdgcn_readfirstlane(tid >> 6);
    bf16_t* QOK = (bf16_t*)(ws + O_QOK); const bf16_t* KVT = (const bf16_t*)(ws + O_KVT); const bf16_t* CST = (const bf16_t*)(ws + O_CST);
    const float* GB = (const float*)(ws + O_GB); const float* GE = (const float*)(ws + O_GE); const float* GPM = (const float*)(ws + O_GPM);
    const float* MST = (const float*)(ws + O_MST); const float* NST = (const float*)(ws + O_NST); const float* ong = a.in(20);
    LAS unsigned char* Qs = lds + MC_QS; LAS unsigned char* Ks = lds + MC_KS; LAS unsigned char* Sc = lds + MC_SC;
    LAS float* F = (LAS float*)(lds + MC_F);
    LAS float* f_b = F, *f_e = F + 64, *f_m = F + 128, *f_g = F + 192, *f_qn = F + 256, *f_ps = F + 320  , *f_n = F + 576  , *f_part = F + 704  ;
    for (int u = blockIdx.x; u < 1024; u += gridDim.x) {
        const int c = u >> 2, h = u & 3; const size_t t0 = (size_t)c * 64;
        for (int e = tid; e < 1024; e += 512) { const int r = e >> 4, p = e & 15;
            *(LAS u32x4*)(Qs + r * MC_QROW + p * 16) = *(const u32x4*)(QOK + (t0 + r) * 2048 + h * 128 + p * 8);
            *(LAS u32x4*)(Ks + r * MC_QROW + p * 16) = *(const u32x4*)(QOK + (t0 + r) * 2048 + 1536 + h * 128 + p * 8); }
        if (tid < 64) { const float mstv = MST[c * 4 + h]; const float b = GB[(size_t)h * S + t0 + tid], e = GE[(size_t)h * S + t0 + tid], pm = GPM[(size_t)h * S + t0 + tid];
            const float m = b + fmaxf(mstv, pm); f_b[tid] = b; f_e[tid] = e; f_m[tid] = m; f_g[tid] = fexp(b + mstv - m); }
        if (tid >= 64 && tid < 192) f_n[tid - 64] = NST[(size_t)(c * 4 + h) * 128 + tid - 64];
        __syncthreads();
        if (w < 4) {
            const int sb = w & 1, tb = w >> 1; const int tl = 32 * tb + r32;
            f32x16 x = {};
#pragma unroll
            for (int ks = 0; ks < 8; ++ks) {
                const bf16x8 ka = *(const LAS bf16x8*)(Ks + (32 * sb + r32) * MC_QROW + (16 * ks + 8 * hi) * 2);
                const bf16x8 qb = *(const LAS bf16x8*)(Qs + tl * MC_QROW + (16 * ks + 8 * hi) * 2);
                x = __builtin_amdgcn_mfma_f32_32x32x16_bf16(ka, qb, x, 0, 0, 0); }
            const float bt = f_b[tl], mt = f_m[tl]; float ps = 0.f;
#pragma unroll
            for (int g = 0; g < 4; ++g) { float v[4];
#pragma unroll
                for (int j = 0; j < 4; ++j) { const int sl = 32 * sb + 8 * g + 4 * hi + j; const float wgt = (sl <= tl) ? fexp(bt + f_e[sl] - mt) : 0.f; v[j] = x[4 * g + j] * wgt; ps += v[j]; }
                u32x2 o; o.x = pk2(v[0], v[1]); o.y = pk2(v[2], v[3]);
                *(LAS u32x2*)(Sc + tl * MC_SROW + (32 * sb + 8 * g + 4 * hi) * 2) = o; }
            f_ps[(sb * 2 + hi) * 64 + tl] = ps;
        } else {
            const int tl = 16 * (w - 4) + (lane >> 2), qq = lane & 3; float s = 0.f;
#pragma unroll
            for (int p = 0; p < 4; ++p) { const u32x4 v = *(const LAS u32x4*)(Qs + tl * MC_QROW + (32 * qq + 8 * p) * 2); LAS float* np = f_n + 32 * qq + 8 * p;
                s += bflo(v.x) * np[0] + bfhi(v.x) * np[1] + bflo(v.y) * np[2] + bfhi(v.y) * np[3] + bflo(v.z) * np[4] + bfhi(v.z) * np[5] + bflo(v.w) * np[6] + bfhi(v.w) * np[7]; }
            s += __shfl_xor(s, 1); s += __shfl_xor(s, 2);
            if (qq == 0) f_qn[tl] = s;
        }
        __syncthreads();
        f32x16 acc0 = {}, acc1 = {};
        { const bf16_t* cp = CST + ((size_t)(c * 4 + h) * 256 + 32 * w + r32) * 128 + 8 * hi;
#pragma unroll
          for (int ks = 0; ks < 8; ++ks) { const bf16x8 ca = *(const bf16x8*)(cp + 16 * ks);
              const bf16x8 q0 = *(const LAS bf16x8*)(Qs + r32 * MC_QROW + (16 * ks + 8 * hi) * 2), q1 = *(const LAS bf16x8*)(Qs + (32 + r32) * MC_QROW + (16 * ks + 8 * hi) * 2);
              acc0 = __builtin_amdgcn_mfma_f32_32x32x16_bf16(ca, q0, acc0, 0, 0, 0); acc1 = __builtin_amdgcn_mfma_f32_32x32x16_bf16(ca, q1, acc1, 0, 0, 0); } }
        const float g0 = f_g[r32], g1 = f_g[32 + r32];
#pragma unroll
        for (int r = 0; r < 16; ++r) { acc0[r] *= g0; acc1[r] *= g1; }
        { const bf16_t* vp = KVT + (size_t)(512 + h * 256 + 32 * w + r32) * S + t0 + 8 * hi;
#pragma unroll
          for (int ks = 0; ks < 4; ++ks) { const bf16x8 va = *(const bf16x8*)(vp + 16 * ks);
              const bf16x8 s0 = *(const LAS bf16x8*)(Sc + r32 * MC_SROW + (16 * ks + 8 * hi) * 2), s1 = *(const LAS bf16x8*)(Sc + (32 + r32) * MC_SROW + (16 * ks + 8 * hi) * 2);
              acc0 = __builtin_amdgcn_mfma_f32_32x32x16_bf16(va, s0, acc0, 0, 0, 0); acc1 = __builtin_amdgcn_mfma_f32_32x32x16_bf16(va, s1, acc1, 0, 0, 0); } }
        float inv[2];
#pragma unroll
        for (int tb = 0; tb < 2; ++tb) { const int tl = 32 * tb + r32;
            const float den = f_g[tl] * f_qn[tl] + f_ps[tl] + f_ps[64 + tl] + f_ps[128 + tl] + f_ps[192 + tl];
            inv[tb] = 1.f / fmaxf(fabsf(den), fexp(-f_m[tl])); }
        float ss0 = 0.f, ss1 = 0.f;
#pragma unroll
        for (int r = 0; r < 16; ++r) { acc0[r] *= inv[0]; acc1[r] *= inv[1]; ss0 += acc0[r] * acc0[r]; ss1 += acc1[r] * acc1[r]; }
        ss0 += __shfl_xor(ss0, 32); ss1 += __shfl_xor(ss1, 32);
        if (hi == 0) { f_part[w * 64 + r32] = ss0; f_part[w * 64 + 32 + r32] = ss1; }
        __syncthreads();
        float rn[2];
#pragma unroll
        for (int tb = 0; tb < 2; ++tb) { float s = 0.f;
#pragma unroll
            for (int ww = 0; ww < 8; ++ww) s += f_part[ww * 64 + 32 * tb + r32];
            rn[tb] = rsqrtf(s * (1.f / 256.f) + EPS); }
#pragma unroll
        for (int tb = 0; tb < 2; ++tb) { bf16_t* op = QOK + (t0 + 32 * tb + r32) * 2048 + 512 + h * 256 + 32 * w;
#pragma unroll
            for (int p = 0; p < 2; ++p) {
                unsigned pk[2][2];
#pragma unroll
                for (int q = 0; q < 2; ++q) { const int g = 2 * p + q, dv = 8 * g + 4 * hi; const u32x2 ov = *(const u32x2*)(op + dv);
                    const f32x4 gg = *(const f32x4*)(ong + h * 256 + 32 * w + dv);
                    const float og[4] = {bflo(ov.x), bfhi(ov.x), bflo(ov.y), bfhi(ov.y)}; float y[4];
#pragma unroll
                    for (int j = 0; j < 4; ++j) { const float hv = (tb ? acc1[4 * g + j] : acc0[4 * g + j]) * rn[tb]; y[j] = hv * gg[j] * sigmoidf_(og[j]); }
                    pk[q][0] = pk2(y[0], y[1]); pk[q][1] = pk2(y[2], y[3]); }
                const auto r0 = __builtin_amdgcn_permlane32_swap(pk[0][0], pk[1][0], false, false), r1 = __builtin_amdgcn_permlane32_swap(pk[0][1], pk[1][1], false, false);
                if (!dry) *(u32x4*)(op + 16 * p + 8 * hi) = (u32x4){r0[0], r1[0], r0[1], r1[1]}; } }
        __syncthreads();
    }
}

DI void phase_final(int wv, const ArgP a) {
    float* out = a.out(); const u64* rowss = (const u64*)(a.ws() + O_ROWSS) + 4 * S; const float* g = a.in(27); const bf16_t* XBr = (const bf16_t*)(a.ws() + O_XB) + 2 * 1024;
    for (size_t e = (size_t)blockIdx.x * 512 + ltid(wv); e < (size_t)S * 128; e += (size_t)gridDim.x * 512) { const int t = (int)(e >> 7), c = (int)(e & 127) * 8;
        const float rs = rs_from_ss(rowss[t]); const u32x4 hb = __builtin_nontemporal_load((const u32x4*)(XBr + (size_t)t * 1024 + c)); const f32x4 g0 = *(const f32x4*)(g + c), g1 = *(const f32x4*)(g + c + 4);
        const f32x4 v0 = (f32x4){bflo(hb.x), bfhi(hb.x), bflo(hb.y), bfhi(hb.y)} * rs * g0, v1 = (f32x4){bflo(hb.z), bfhi(hb.z), bflo(hb.w), bfhi(hb.w)} * rs * g1;
        __builtin_nontemporal_store(v0, (f32x4*)(out + (size_t)t * 1024 + c)); __builtin_nontemporal_store(v1, (f32x4*)(out + (size_t)t * 1024 + c + 4)); }
}

#ifndef DIS
#define DIS 0u
#endif
#ifndef REP
#define REP 0u
#endif
#ifndef XSYNC
#define XSYNC 0
#endif

#define XB_TMO      128
#define XB_XCNT(j)  (256  + 64 * (j))
#define XB_XSUB(j)  (1280 + 64 * (j))
#define XB_XGEN(j)  (2304 + 64 * (j))
#define XB_TOP      3328
#define XB_TOPGEN   3392
#define XB_SPIN_CAP (1u << 18)
DI unsigned xb_ld(unsigned* p) { return __hip_atomic_load(p, __ATOMIC_RELAXED, __HIP_MEMORY_SCOPE_AGENT); }
DI unsigned xb_add(unsigned* p, unsigned v) { return __hip_atomic_fetch_add(p, v, __ATOMIC_RELAXED, __HIP_MEMORY_SCOPE_AGENT); }
DI unsigned xb_xcc_id() { return (unsigned)__builtin_amdgcn_s_getreg((3 << 11) | 20) & 0xFu; }
#define XB_SPIN(cond, bar) do { unsigned _sp = 0; while (cond) { __builtin_amdgcn_s_sleep(1); \
    if ((++_sp & 255u) == 0u) { if (xb_ld(&(bar)[XB_TMO])) break; if (_sp > XB_SPIN_CAP) { atomicAdd(&(bar)[XB_TMO], 1u); break; } } } } while (0)
DI void xcd_barrier_complete(unsigned* bar, unsigned x, unsigned& nloc, unsigned& nx) {
    const unsigned G = gridDim.x;
    unsigned sum, cnt, mine, sp = 0u;
    for (;;) {
        sum = 0u; cnt = 0u; mine = 0u;
#pragma unroll
        for (unsigned j = 0; j < 16; ++j) { const unsigned c = xb_ld(&bar[XB_XCNT(j)]); sum += c; cnt += (c > 0u) ? 1u : 0u; mine = (j == x) ? c : mine; }
        if (sum == G) break;
        __builtin_amdgcn_s_sleep(1);
        if ((++sp & 255u) == 0u) { if (xb_ld(&bar[XB_TMO])) break; if (sp > XB_SPIN_CAP) { atomicAdd(&bar[XB_TMO], 1u); break; } }
    }
    nloc = mine > 0u ? mine : 1u; nx = cnt > 0u ? cnt : 1u;
}
DI void xcd_barrier(int wv, unsigned* bar, volatile LAS unsigned* st) {
    asm volatile("s_waitcnt vmcnt(0)" ::: "memory");
    __syncthreads();
    if (ltid(wv) == 0) {
        const unsigned x = xb_xcc_id();
        __builtin_amdgcn_s_waitcnt(0);
        unsigned nloc = st[0], nx = st[1];
        if (nloc == 0u) { xcd_barrier_complete(bar, x, nloc, nx); st[0] = nloc; st[1] = nx; }
        const unsigned old = xb_add(&bar[XB_XSUB(x)], 1u);
        const unsigned gen = old / nloc;
        if (old + 1u == (gen + 1u) * nloc) {
            __builtin_amdgcn_fence(__ATOMIC_RELEASE, "agent");
            asm volatile("s_waitcnt vmcnt(0)" ::: "memory");
            const unsigned og = xb_add(&bar[XB_TOP], 1u);
            const unsigned tg = og / nx;
            if (og + 1u == (tg + 1u) * nx) xb_add(&bar[XB_TOPGEN], 1u);
            else XB_SPIN(xb_ld(&bar[XB_TOPGEN]) == tg, bar);
            __builtin_amdgcn_fence(__ATOMIC_ACQUIRE, "agent");
            xb_add(&bar[XB_XGEN(x)], 1u);
            asm volatile("s_waitcnt vmcnt(0)" ::: "memory");
        } else {
            XB_SPIN(xb_ld(&bar[XB_XGEN(x)]) == gen, bar);
            __builtin_amdgcn_fence(__ATOMIC_ACQUIRE, "agent");
            asm volatile("s_waitcnt vmcnt(0)" ::: "memory");
        }
    }
    __syncthreads();
}
DI ArgP getargs() { ArgP r; r.p = (const __attribute__((address_space(4))) Args*)__builtin_amdgcn_kernarg_segment_ptr(); asm volatile("" : "+s"(r.p)); return r; }
#define WSB (getargs().ws())
#define XBP ((bf16_t*)(getargs().ws() + O_XB) + 2 * 1024)
#define RSS ((u64*)(getargs().ws() + O_ROWSS))
#define HFP (getargs().out())
__global__ void __launch_bounds__(512, 2) fwd_kernel(Args a_unused) {
    extern __shared__ __attribute__((aligned(16))) unsigned char shm[];
    LAS unsigned char* lds = (LAS unsigned char*)shm;
    const int wv = __builtin_amdgcn_readfirstlane(threadIdx.x >> 6);
#define BARW ((unsigned*)(getargs().ws() + O_BAR))
#define BARST ((volatile LAS unsigned*)(lds + 139264))
#define GSYNC() xcd_barrier(wv, BARW, BARST)
    { unsigned* barw0 = BARW; if (threadIdx.x == 0) { BARST[0] = 0u; BARST[1] = 0u; (void)xb_add(&barw0[XB_XCNT(xb_xcc_id())], 1u); } }
    if (getargs().p->pad == 0x7fffffff) cg::this_grid().sync();

#if !(DIS & (1u << 0))
    for (int rep_ = 0; rep_ < ((REP >> 0) & 1u) + 1; ++rep_) { const int dry_ = rep_ < (int)((REP >> 0) & 1u); (void)dry_;
    phase_prologue(wv, getargs(), lds, dry_ ? PROPART : 7);
    }
#endif
    GSYNC();
#if !(DIS & (1u << 1))
    for (int rep_ = 0; rep_ < ((REP >> 1) & 1u) + 1; ++rep_) { const int dry_ = rep_ < (int)((REP >> 1) & 1u); (void)dry_;
    { EpiRowBf16<1> E{(bf16_t*)(WSB + O_Z), 1536, RSS};
      pg8::gemm_phase<false>(wv, lds, XBP, 1024, (const bf16_t*)(WSB + O_W1T), 1024, 1024, 64, 6, E); }
    }
#endif
    GSYNC();
#if !(DIS & (1u << 2))
    for (int rep_ = 0; rep_ < ((REP >> 2) & 1u) + 1; ++rep_) { const int dry_ = rep_ < (int)((REP >> 2) & 1u); (void)dry_;
    phase_l0_prep(wv, getargs());
    }
#endif
    GSYNC();
#if !(DIS & (1u << 3))
    for (int rep_ = 0; rep_ < ((REP >> 3) & 1u) + 1; ++rep_) { const int dry_ = rep_ < (int)((REP >> 3) & 1u); (void)dry_;
    { EpiRowBf16<0> E{(bf16_t*)(WSB + O_RI), 1024, nullptr};
      pg8::gemm_phase<false, EpiRowBf16<0>, true>(wv, lds, (const bf16_t*)(WSB + O_XC), 512, (const bf16_t*)(WSB + O_WRIT), 512, 256, 64, 4, E); }
    }
#endif
#if !(DIS & (1u << 4))
    for (int rep_ = 0; rep_ < ((REP >> 4) & 1u) + 1; ++rep_) { const int dry_ = rep_ < (int)((REP >> 4) & 1u); (void)dry_;
    { EpiQ E{(bf16_t*)(WSB + O_QB), (const float*)(WSB + O_RSQ), (const float*)(WSB + O_CSTAB)};
      pg8::gemm_phase<false>(wv, lds, (const bf16_t*)(WSB + O_Z) + 1024, 1536, (const bf16_t*)(WSB + O_WQT), 256, 256, 64, 3, E); }
    }
#endif
#if !(DIS & (1u << 5))
    for (int rep_ = 0; rep_ < ((REP >> 5) & 1u) + 1; ++rep_) { const int dry_ = rep_ < (int)((REP >> 5) & 1u); (void)dry_;
    { EpiK E{(bf16_t*)(WSB + O_KB), (const float*)(WSB + O_RSKV)};
      pg8::gemm_phase<false>(wv, lds, (const bf16_t*)(WSB + O_Z) + 1280, 1536, (const bf16_t*)(WSB + O_WKT), 256, 256, 64, 2, E, 192); }
    }
#endif
#if !(DIS & (1u << 6))
    for (int rep_ = 0; rep_ < ((REP >> 6) & 1u) + 1; ++rep_) { const int dry_ = rep_ < (int)((REP >> 6) & 1u); (void)dry_;
    { EpiColBf16<2> E{(bf16_t*)(WSB + O_VT), S, (const float*)(WSB + O_RSKV)};
      pg8::gemm_phase<false>(wv, lds, (const bf16_t*)(WSB + O_WVT), 256, (const bf16_t*)(WSB + O_Z) + 1280, 1536, 256, 2, 64, E, 64); }
    }
#endif
    GSYNC();
#if !(DIS & (1u << 7))
    for (int rep_ = 0; rep_ < ((REP >> 7) & 1u) + 1; ++rep_) { const int dry_ = rep_ < (int)((REP >> 7) & 1u); (void)dry_;
    phase_lru_s1(wv, getargs());
    }
#endif
    GSYNC();
#if !(DIS & (1u << 8))
    for (int rep_ = 0; rep_ < ((REP >> 8) & 1u) + 1; ++rep_) { const int dry_ = rep_ < (int)((REP >> 8) & 1u); (void)dry_;
    phase_lru_s3(wv, getargs());
    }
#endif
#if !(DIS & (1u << 9))
    for (int rep_ = 0; rep_ < ((REP >> 9) & 1u) + 1; ++rep_) { const int dry_ = rep_ < (int)((REP >> 9) & 1u); (void)dry_;
    phase_attn(wv, getargs(), lds);
    }
#endif
    GSYNC();
#if !(DIS & (1u << 10))
    for (int rep_ = 0; rep_ < ((REP >> 10) & 1u) + 1; ++rep_) { const int dry_ = rep_ < (int)((REP >> 10) & 1u); (void)dry_;
    { EpiRes<false> E{getargs().in(0), XBP, RSS + 1 * S, dry_};
      pg8::gemm_phase<false>(wv, lds, (const bf16_t*)(WSB + O_MIX), 1024, (const bf16_t*)(WSB + O_WO1T), 1024, 1024, 64, 4, E); }
    }
#endif
    GSYNC();
#if !(DIS & (1u << 11))
    for (int rep_ = 0; rep_ < ((REP >> 11) & 1u) + 1; ++rep_) { const int dry_ = rep_ < (int)((REP >> 11) & 1u); (void)dry_;
    { EpiUp E{(bf16_t*)(WSB + O_ACT), RSS + 1 * S, getargs().in(24), getargs().in(25), lds + 131072};
      pg8::gemm_phase<true>(wv, lds, XBP, 1024, (const bf16_t*)(WSB + O_WUPT0), 1024, 1024, 67, 22, E); }
    }
#endif
    GSYNC();
#if !(DIS & (1u << 12))
    for (int rep_ = 0; rep_ < ((REP >> 12) & 1u) + 1; ++rep_) { const int dry_ = rep_ < (int)((REP >> 12) & 1u); (void)dry_;
    { EpiRes<true> E{nullptr, XBP, RSS + 2 * S, dry_};
      pg8::gemm_phase<false>(wv, lds, (const bf16_t*)(WSB + O_ACT), 2816, (const bf16_t*)(WSB + O_WDNT0), 2816, 2816, 64, 4, E); }
    }
#endif
    GSYNC();
#if !(DIS & (1u << 13))
    for (int rep_ = 0; rep_ < ((REP >> 13) & 1u) + 1; ++rep_) { const int dry_ = rep_ < (int)((REP >> 13) & 1u); (void)dry_;
    { EpiQOK E{(bf16_t*)(WSB + O_QOK), RSS + 2 * S, (bf16_t*)(WSB + O_KVT)};
      pg8::gemm_phase<false>(wv, lds, XBP, 1024, (const bf16_t*)(WSB + O_WOINT), 1024, 1024, 64, 8, E); }
    }
#endif
#if !(DIS & (1u << 14))
    for (int rep_ = 0; rep_ < ((REP >> 14) & 1u) + 1; ++rep_) { const int dry_ = rep_ < (int)((REP >> 14) & 1u); (void)dry_;
    { EpiColBf16<1> E{(bf16_t*)(WSB + O_KVT) + (size_t)512 * S, S, RSS + 2 * S};
      pg8::gemm_phase<false>(wv, lds, (const bf16_t*)(WSB + O_WOINT) + (size_t)2048 * 1024, 1024, XBP, 1024, 1024, 4, 64, E); }
    }
#endif
#if !(DIS & (1u << 15))
    for (int rep_ = 0; rep_ < ((REP >> 15) & 1u) + 1; ++rep_) { const int dry_ = rep_ < (int)((REP >> 15) & 1u); (void)dry_;
    phase_m_gates(wv, getargs(), lds);
    }
#endif
    GSYNC();
#if !(DIS & (1u << 16))
    for (int rep_ = 0; rep_ < ((REP >> 16) & 1u) + 1; ++rep_) { const int dry_ = rep_ < (int)((REP >> 16) & 1u); (void)dry_;
    phase_m_dc(wv, getargs());
    }
#endif
    GSYNC();
#if !(DIS & (1u << 22))
    for (int rep_ = 0; rep_ < ((REP >> 22) & 1u) + 1; ++rep_) { const int dry_ = rep_ < (int)((REP >> 22) & 1u); (void)dry_;
    phase_m_comb(wv, getargs(), lds, dry_);
    }
#endif
    GSYNC();
#if !(DIS & (1u << 17))
    for (int rep_ = 0; rep_ < ((REP >> 17) & 1u) + 1; ++rep_) { const int dry_ = rep_ < (int)((REP >> 17) & 1u); (void)dry_;
    phase_m_out(wv, getargs(), lds, dry_);
    }
#endif
    GSYNC();
#if !(DIS & (1u << 18))
    for (int rep_ = 0; rep_ < ((REP >> 18) & 1u) + 1; ++rep_) { const int dry_ = rep_ < (int)((REP >> 18) & 1u); (void)dry_;
    { EpiRes<true> E{nullptr, XBP, RSS + 3 * S, dry_};
      pg8::gemm_phase<false>(wv, lds, (const bf16_t*)(WSB + O_QOK) + 512, 2048, (const bf16_t*)(WSB + O_WO2T), 1024, 1024, 64, 4, E); }
    }
#endif
    GSYNC();
#if !(DIS & (1u << 19))
    for (int rep_ = 0; rep_ < ((REP >> 19) & 1u) + 1; ++rep_) { const int dry_ = rep_ < (int)((REP >> 19) & 1u); (void)dry_;
    { EpiUp E{(bf16_t*)(WSB + O_ACT), RSS + 3 * S, getargs().in(24) + 3 * 5632, getargs().in(25) + 5632, lds + 131072};
      pg8::gemm_phase<true>(wv, lds, XBP, 1024, (const bf16_t*)(WSB + O_WUPT1), 1024, 1024, 67, 22, E); }
    }
#endif
    GSYNC();
#if !(DIS & (1u << 20))
    for (int rep_ = 0; rep_ < ((REP >> 20) & 1u) + 1; ++rep_) { const int dry_ = rep_ < (int)((REP >> 20) & 1u); (void)dry_;
    { EpiRes<true> E{nullptr, XBP, RSS + 4 * S, dry_};
      pg8::gemm_phase<false>(wv, lds, (const bf16_t*)(WSB + O_ACT), 2816, (const bf16_t*)(WSB + O_WDNT1), 2816, 2816, 64, 4, E); }
    }
#endif
    GSYNC();
#if !(DIS & (1u << 21))
    for (int rep_ = 0; rep_ < ((REP >> 21) & 1u) + 1; ++rep_) { const int dry_ = rep_ < (int)((REP >> 21) & 1u); (void)dry_;
    phase_final(wv, getargs());
    }
#endif
    for (int i = 0; i < XSYNC; ++i) GSYNC();
}

extern "C" void kernel_launch(void* const* d_in, const int* in_sizes, int n_in, void* d_out, int out_size, void* d_ws, size_t ws_size, hipStream_t stream) {
    static int grid = 0;
    if (grid == 0) {
        if (n_in != 28 || out_size != S * 1024 || ws_size < WS_NEED) { fprintf(stderr, "kernel_launch: unexpected shapes (n_in %d out %d ws %zu need %zu)\n", n_in, out_size, ws_size, (size_t)WS_NEED); grid = -1; return; }
        int dev = 0, cus = 0, per_cu = 0;
        (void)hipGetDevice(&dev);
        (void)hipDeviceGetAttribute(&cus, hipDeviceAttributeMultiprocessorCount, dev);
        if (hipFuncSetAttribute((const void*)fwd_kernel, hipFuncAttributeMaxDynamicSharedMemorySize, LDS_BYTES) != hipSuccess) { fprintf(stderr, "kernel_launch: hipFuncSetAttribute failed\n"); grid = -1; return; }
        if (hipOccupancyMaxActiveBlocksPerMultiprocessor(&per_cu, (const void*)fwd_kernel, 512, LDS_BYTES) != hipSuccess || per_cu < 1) { fprintf(stderr, "kernel_launch: occupancy query says %d\n", per_cu); per_cu = 1; }
        (void)hipGetLastError();
        grid = cus * 1;
        if (grid > 256) grid = 256;
    }
    if (grid < 0) return;
    Args a{};
    for (int i = 0; i < 28; ++i) a.in[i] = (const float*)d_in[i];
    a.out = (float*)d_out; a.ws = (unsigned char*)d_ws;
    if (hipMemsetAsync((char*)d_ws + O_BAR, 0, BAR_BYTES, stream) != hipSuccess) { fprintf(stderr, "kernel_launch: memset failed\n"); return; }
    void* args[] = {&a};
    hipError_t e = hipLaunchCooperativeKernel((void*)fwd_kernel, dim3(grid), dim3(512), args, LDS_BYTES, stream);
    if (e != hipSuccess) fprintf(stderr, "kernel_launch: cooperative launch failed: %s (grid %d)\n", hipGetErrorString(e), grid);
}
```
